# Optimizing an MI355X kernel written in HIP

```python
import math
import jax
import jax.numpy as jnp
from jax import lax
import numpy as np

D_MODEL = 1024
BATCH = 2
SEQ = 8192
DEPTH = 1

EPS = 1e-6
D_MIX = D_MODEL

GLA_HEADS = 4
GLA_DK = 64
GLA_DV = 128
GLA_WIDTH = GLA_HEADS * GLA_DV
GLA_QK_WIDTH = GLA_HEADS * GLA_DK
GLA_GATE_RANK = 16
GLA_GATE_NORMALIZER = 16.0
GLA_CHUNK = 64

SSD_HEADS = 8
SSD_HEAD_DIM = 64
SSD_WIDTH = SSD_HEADS * SSD_HEAD_DIM
SSD_GROUPS = 2
SSD_STATE = 64
SSD_CONV = 4
SSD_CHUNK = 128
SSD_BC_WIDTH = SSD_GROUPS * SSD_STATE
SSD_CONV_DIM = SSD_WIDTH + 2 * SSD_BC_WIDTH

IN_SIZES = (GLA_QK_WIDTH, GLA_QK_WIDTH, GLA_WIDTH, GLA_GATE_RANK, GLA_WIDTH,
            SSD_WIDTH, SSD_CONV_DIM, SSD_HEADS)
IN_TOTAL = (2 * GLA_QK_WIDTH + 2 * GLA_WIDTH + GLA_GATE_RANK
            + SSD_WIDTH + SSD_CONV_DIM + SSD_HEADS)

PEER_HEADS = 8
PEER_KEYS = 128
PEER_EXPERTS = PEER_KEYS * PEER_KEYS
PEER_TOPK = 16
PEER_DQ = 256
PEER_HALF = PEER_DQ // 2
PEER_BLOCK = 128

kernel_name = "hybrid_gla_ssd_peer_layer"


def rmsnorm(x, w):
    xf = x.astype(jnp.float32)
    xf = xf * lax.rsqrt(jnp.mean(xf * xf, axis=-1, keepdims=True) + EPS)
    return xf * w.astype(jnp.float32)


def split_cols(proj):
    out, start = [], 0
    for size in IN_SIZES:
        out.append(proj[..., start:start + size])
        start += size
    return out


def gla_mixer(q, k, v, gate_lr, g_out, w_gate2, b_gate, norm_w):
    f32 = jnp.float32
    b, l, _ = q.shape
    nc, C, H = l // GLA_CHUNK, GLA_CHUNK, GLA_HEADS
    q = q.astype(f32).reshape(b, nc, C, H, GLA_DK) * (GLA_DK ** -0.5)
    k = k.astype(f32).reshape(b, nc, C, H, GLA_DK)
    v = v.astype(f32).reshape(b, nc, C, H, GLA_DV)
    log_a = jax.nn.log_sigmoid((gate_lr.astype(f32) @ w_gate2.astype(f32)
                                + b_gate.astype(f32))) / GLA_GATE_NORMALIZER
    log_a = log_a.reshape(b, nc, C, H, GLA_DK)
    G = jnp.cumsum(log_a, axis=2)
    G_last = G[:, :, -1:]
    q_in = q * jnp.exp(G)
    k_in = k * jnp.exp(-G)
    k_end = k * jnp.exp(G_last - G)
    causal = jnp.tril(jnp.ones((C, C), dtype=bool))
    att = jnp.einsum('bcihd,bcjhd->bchij', q_in, k_in)
    att = jnp.where(causal, att, 0.0)
    o_intra = jnp.einsum('bchij,bcjhv->bcihv', att, v)
    chunk_state = jnp.einsum('bcjhd,bcjhv->bchdv', k_end, v)
    chunk_decay = jnp.exp(G_last[:, :, 0])

    def step(S, inp):
        dec, st = inp
        return dec[..., None] * S + st, S

    S0 = jnp.zeros((b, H, GLA_DK, GLA_DV), f32)
    _, S_prev = lax.scan(step, S0, (jnp.moveaxis(chunk_decay, 1, 0),
                                    jnp.moveaxis(chunk_state, 1, 0)))
    S_prev = jnp.moveaxis(S_prev, 0, 1)
    o_inter = jnp.einsum('bcihd,bchdv->bcihv', q_in, S_prev)
    o = (o_intra + o_inter).reshape(b, l, H, GLA_DV)
    o = rmsnorm(o, norm_w)
    return o.reshape(b, l, GLA_WIDTH) * jax.nn.silu(g_out.astype(f32))


def causal_depthwise_conv(x, w, bias):
    c = x.shape[-1]
    out = lax.conv_general_dilated(
        x, w.astype(x.dtype)[:, None, :], window_strides=(1,),
        padding=[(SSD_CONV - 1, 0)], dimension_numbers=('NWC', 'WIO', 'NWC'),
        feature_group_count=c)
    return out + bias.astype(x.dtype)


def ssd_mixer(z, xbc, dt_raw, conv_w, conv_b, dt_bias, a_log, d_skip, norm_w):
    f32 = jnp.float32
    b, l, _ = z.shape
    nc, C = l // SSD_CHUNK, SSD_CHUNK
    G, J, P, N = SSD_GROUPS, SSD_HEADS // SSD_GROUPS, SSD_HEAD_DIM, SSD_STATE
    xbc = jax.nn.silu(causal_depthwise_conv(xbc.astype(f32), conv_w, conv_b))
    xs = xbc[..., :SSD_WIDTH]
    Bm = xbc[..., SSD_WIDTH:SSD_WIDTH + SSD_BC_WIDTH].reshape(b, nc, C, G, N)
    Cm = xbc[..., SSD_WIDTH + SSD_BC_WIDTH:].reshape(b, nc, C, G, N)
    X = xs.reshape(b, nc, C, G, J, P)
    dt = jax.nn.softplus(dt_raw.astype(f32) + dt_bias.astype(f32)).reshape(b, nc, C, G, J)
    A = -jnp.exp(a_log.astype(f32)).reshape(G, J)
    a = dt * A
    a_cum = jnp.cumsum(a, axis=2)
    seg = a_cum[:, :, :, None] - a_cum[:, :, None]
    causal = jnp.tril(jnp.ones((C, C), dtype=bool))[:, :, None, None]
    Lmat = jnp.exp(jnp.where(causal, seg, -jnp.inf))
    Xdt = X * dt[..., None]
    scores = jnp.einsum('bclgn,bcsgn->bclsg', Cm, Bm)
    y_diag = jnp.einsum('bclsg,bclsgj,bcsgjp->bclgjp', scores, Lmat, Xdt)
    decay_to_end = jnp.exp(a_cum[:, :, -1:] - a_cum)
    states = jnp.einsum('bclgn,bclgj,bclgjp->bcgjpn', Bm, decay_to_end, Xdt)
    chunk_decay = jnp.exp(a_cum[:, :, -1])

    def step(S, inp):
        dec, st = inp
        return dec[..., None, None] * S + st, S

    S0 = jnp.zeros((b, G, J, P, N), f32)
    _, S_prev = lax.scan(step, S0, (jnp.moveaxis(chunk_decay, 1, 0),
                                    jnp.moveaxis(states, 1, 0)))
    S_prev = jnp.moveaxis(S_prev, 0, 1)
    y_off = jnp.einsum('bclgn,bcgjpn,bclgj->bclgjp', Cm, S_prev, jnp.exp(a_cum))
    y = y_diag + y_off + X * d_skip.astype(f32).reshape(G, J)[..., None]
    y = y.reshape(b, l, SSD_WIDTH) * jax.nn.silu(z.astype(f32))
    y = y.reshape(b, l, G, SSD_WIDTH // G)
    y = y * lax.rsqrt(jnp.mean(y * y, axis=-1, keepdims=True) + EPS)
    return y.reshape(b, l, SSD_WIDTH) * norm_w.astype(f32)


def peer_ffn(xn, w_query, sub_keys, u, v):
    f32 = jnp.float32
    b, l, d = xn.shape
    T = b * l
    H, K = PEER_HEADS, PEER_TOPK
    xt = xn.reshape(T, d).astype(u.dtype)
    q = (xt @ w_query).reshape(T, H, 2, PEER_HALF)
    s = jnp.einsum('thpd,hpkd->thpk', q, sub_keys).astype(f32)
    top_s, top_i = lax.top_k(s, K)
    cand_s = (top_s[:, :, 0, :, None] + top_s[:, :, 1, None, :]).reshape(T, H, K * K)
    cand_i = (top_i[:, :, 0, :, None] * PEER_KEYS + top_i[:, :, 1, None, :]).reshape(T, H, K * K)
    best_s, best_pos = lax.top_k(cand_s, K)
    expert_idx = jnp.take_along_axis(cand_i, best_pos, axis=-1)
    gate = jax.nn.softmax(best_s, axis=-1)
    nb = T // PEER_BLOCK
    xb = xt.reshape(nb, PEER_BLOCK, d)
    ib = expert_idx.reshape(nb, PEER_BLOCK, H * K)
    gb = gate.reshape(nb, PEER_BLOCK, H * K)

    def block(args):
        x_blk, i_blk, g_blk = args
        act = jnp.einsum('td,ted->te', x_blk, u[i_blk]).astype(f32)
        hid = jax.nn.gelu(act, approximate=False) * g_blk
        return jnp.einsum('te,ted->td', hid.astype(v.dtype), v[i_blk])

    out = lax.map(block, (xb, ib, gb))
    return out.reshape(b, l, d)


def setup_inputs(seed: int = 0) -> dict:
    key = jax.random.key(seed)
    ks = jax.random.split(key, 24)
    f32 = jnp.float32
    nrm = lambda k, shape, scale: jax.random.normal(k, shape, f32) * scale
    dt0 = jnp.exp(jax.random.uniform(ks[10], (DEPTH, SSD_HEADS), f32,
                                     math.log(1e-3), math.log(1e-1)))
    return {
        "x": jax.random.normal(ks[0], (BATCH, SEQ, D_MODEL), f32),
        "norm_mix_w": 1.0 + nrm(ks[1], (DEPTH, D_MODEL), 0.02),
        "w_in": nrm(ks[2], (DEPTH, D_MODEL, IN_TOTAL), D_MODEL ** -0.5),
        "gla_w_gate2": nrm(ks[3], (DEPTH, GLA_GATE_RANK, GLA_QK_WIDTH), GLA_GATE_RANK ** -0.5),
        "gla_b_gate": nrm(ks[4], (DEPTH, GLA_QK_WIDTH), 0.1),
        "gla_norm_w": 1.0 + nrm(ks[5], (DEPTH, GLA_DV), 0.02),
        "ssd_conv_w": nrm(ks[6], (DEPTH, SSD_CONV, SSD_CONV_DIM), SSD_CONV ** -0.5),
        "ssd_conv_b": nrm(ks[7], (DEPTH, SSD_CONV_DIM), 0.02),
        "ssd_dt_bias": dt0 + jnp.log(-jnp.expm1(-dt0)),
        "ssd_a_log": jnp.log(jax.random.uniform(ks[8], (DEPTH, SSD_HEADS), f32, 1.0, 16.0)),
        "ssd_d": 1.0 + nrm(ks[9], (DEPTH, SSD_HEADS), 0.1),
        "ssd_norm_w": 1.0 + nrm(ks[11], (DEPTH, SSD_WIDTH), 0.02),
        "w_out": nrm(ks[12], (DEPTH, D_MIX, D_MODEL), D_MIX ** -0.5),
        "norm_ffn_w": 1.0 + nrm(ks[13], (DEPTH, D_MODEL), 0.02),
        "peer_w_query": nrm(ks[14], (DEPTH, D_MODEL, PEER_HEADS * PEER_DQ), D_MODEL ** -0.5),
        "peer_sub_keys": nrm(ks[15], (DEPTH, PEER_HEADS, 2, PEER_KEYS, PEER_HALF), PEER_HALF ** -0.5),
        "peer_u": nrm(ks[16], (DEPTH, PEER_EXPERTS, D_MODEL), D_MODEL ** -0.5),
        "peer_v": nrm(ks[17], (DEPTH, PEER_EXPERTS, D_MODEL), PEER_HEADS ** -0.5),
        "norm_final_w": 1.0 + nrm(ks[18], (D_MODEL,), 0.02),
    }


def reference(x, norm_mix_w, w_in, gla_w_gate2, gla_b_gate, gla_norm_w,
              ssd_conv_w, ssd_conv_b, ssd_dt_bias, ssd_a_log, ssd_d, ssd_norm_w,
              w_out, norm_ffn_w, peer_w_query, peer_sub_keys, peer_u, peer_v,
              norm_final_w):
    h = x
    for i in range(DEPTH):
        n = rmsnorm(h, norm_mix_w[i]).astype(w_in.dtype)
        proj = n @ w_in[i]
        q, k, v, gate_lr, g_out, z, xbc, dt_raw = split_cols(proj)
        o_gla = gla_mixer(q, k, v, gate_lr, g_out, gla_w_gate2[i], gla_b_gate[i], gla_norm_w[i])
        o_ssd = ssd_mixer(z, xbc, dt_raw, ssd_conv_w[i], ssd_conv_b[i], ssd_dt_bias[i],
                          ssd_a_log[i], ssd_d[i], ssd_norm_w[i])
        mixed = jnp.concatenate([o_gla, o_ssd], axis=-1).astype(w_out.dtype)
        h = h + (mixed @ w_out[i]).astype(h.dtype)
        n2 = rmsnorm(h, norm_ffn_w[i])
        h = h + peer_ffn(n2, peer_w_query[i], peer_sub_keys[i], peer_u[i], peer_v[i]).astype(h.dtype)
    return rmsnorm(h, norm_final_w).astype(x.dtype)
```

```cpp
#include <hip/hip_runtime.h>
#include <cstdio>
#include <cstdint>

namespace nv {
constexpr int T = 16384, SEQ = 8192, D = 1024, NIN = 2840;
constexpr int C_Q = 0, C_K = 256, C_V = 512, C_GLR = 1024, C_GOUT = 1040, C_Z = 1552, C_XBC = 2064, C_DT = 2832;
constexpr float EPS = 1e-6f;

__device__ __forceinline__ float wave_sum(float v) {
#pragma unroll
    for (int o = 1; o < 64; o <<= 1) v += __shfl_xor(v, o);
    return v;
}
__device__ __forceinline__ float silu_f(float x) { return x / (1.f + expf(-x)); }
__device__ __forceinline__ float softplus_f(float x) { return fmaxf(x, 0.f) + log1pf(expf(-fabsf(x))); }
__device__ __forceinline__ float logsigmoid_f(float x) { return fminf(x, 0.f) - log1pf(expf(-fabsf(x))); }
__device__ __forceinline__ float gelu_f(float x) { return 0.5f * x * (1.f + erff(x * 0.70710678118654752f)); }

__global__ void __launch_bounds__(256) k_rmsnorm(const float* __restrict__ x, const float* __restrict__ w, float* __restrict__ out) {
    const int row = blockIdx.x * 4 + (threadIdx.x >> 6), lane = threadIdx.x & 63;
    const float4* xr = (const float4*)(x + (size_t)row * D);
    float4 v[4]; float s = 0.f;
#pragma unroll
    for (int j = 0; j < 4; ++j) { v[j] = xr[lane + 64 * j]; s += v[j].x * v[j].x + v[j].y * v[j].y + v[j].z * v[j].z + v[j].w * v[j].w; }
    s = wave_sum(s);
    const float r = rsqrtf(s * (1.f / D) + EPS);
    float4* o = (float4*)(out + (size_t)row * D);
#pragma unroll
    for (int j = 0; j < 4; ++j) { const float4 ww = ((const float4*)w)[lane + 64 * j]; float4 y; y.x = v[j].x * r * ww.x; y.y = v[j].y * r * ww.y; y.z = v[j].z * r * ww.z; y.w = v[j].w * r * ww.w; o[lane + 64 * j] = y; }
}

template <bool ADD>
__global__ void __launch_bounds__(256) k_gemm(const float* __restrict__ A, const float* __restrict__ B, const float* __restrict__ R, float* __restrict__ C, int M, int N, int K) {
    __shared__ float As[16][68];
    __shared__ float Bs[16][68];
    const int tid = threadIdx.x, tx = tid & 15, ty = tid >> 4;
    const int row0 = blockIdx.y * 64, col0 = blockIdx.x * 64;
    float acc[4][4];
#pragma unroll
    for (int i = 0; i < 4; ++i)
#pragma unroll
        for (int j = 0; j < 4; ++j) acc[i][j] = 0.f;
    const int ar = tid >> 2, akq = tid & 3;
    const int bk = tid >> 4, bn = (tid & 15) * 4;
    for (int k0 = 0; k0 < K; k0 += 16) {
        const float4 av = *(const float4*)(A + (size_t)(row0 + ar) * K + k0 + akq * 4);
        float4 bv = make_float4(0.f, 0.f, 0.f, 0.f);
        if (col0 + bn < N) bv = *(const float4*)(B + (size_t)(k0 + bk) * N + col0 + bn);
        __syncthreads();
        As[akq * 4 + 0][ar] = av.x; As[akq * 4 + 1][ar] = av.y; As[akq * 4 + 2][ar] = av.z; As[akq * 4 + 3][ar] = av.w;
        *(float4*)&Bs[bk][bn] = bv;
        __syncthreads();
#pragma unroll
        for (int kk = 0; kk < 16; ++kk) {
            const float4 a = *(const float4*)&As[kk][ty * 4];
            const float4 b = *(const float4*)&Bs[kk][tx * 4];
            const float aa[4] = {a.x, a.y, a.z, a.w}, bb[4] = {b.x, b.y, b.z, b.w};
#pragma unroll
            for (int i = 0; i < 4; ++i)
#pragma unroll
                for (int j = 0; j < 4; ++j) acc[i][j] += aa[i] * bb[j];
        }
    }
    if (col0 + tx * 4 < N) {
#pragma unroll
        for (int i = 0; i < 4; ++i) {
            const size_t off = (size_t)(row0 + ty * 4 + i) * N + col0 + tx * 4;
            float4 o = make_float4(acc[i][0], acc[i][1], acc[i][2], acc[i][3]);
            if (ADD) { const float4 r = *(const float4*)(R + off); o.x += r.x; o.y += r.y; o.z += r.z; o.w += r.w; }
            *(float4*)(C + off) = o;
        }
    }
}

__global__ void __launch_bounds__(256) k_gla_gate(const float* __restrict__ proj, const float* __restrict__ w2, const float* __restrict__ bg, float* __restrict__ alpha) {
    const int t = blockIdx.x, c = threadIdx.x;
    float acc = bg[c];
#pragma unroll
    for (int r = 0; r < 16; ++r) acc += proj[(size_t)t * NIN + C_GLR + r] * w2[r * 256 + c];
    alpha[(size_t)t * 256 + c] = expf(logsigmoid_f(acc) * (1.f / 16.f));
}

__global__ void __launch_bounds__(128) k_gla_rec(const float* __restrict__ proj, const float* __restrict__ alpha, float* __restrict__ mixed) {
    const int b = blockIdx.x >> 2, h = blockIdx.x & 3, dv = threadIdx.x;
    float S[64];
#pragma unroll
    for (int d = 0; d < 64; ++d) S[d] = 0.f;
    for (int t = 0; t < SEQ; ++t) {
        const size_t row = (size_t)b * SEQ + t;
        const float* pr = proj + row * NIN;
        const float* al = alpha + row * 256 + h * 64;
        const float v = pr[C_V + h * 128 + dv];
        float o = 0.f;
#pragma unroll
        for (int d = 0; d < 64; ++d) {
            S[d] = al[d] * S[d] + pr[C_K + h * 64 + d] * v;
            o += pr[C_Q + h * 64 + d] * S[d];
        }
        mixed[row * D + h * 128 + dv] = o * 0.125f;
    }
}

__global__ void __launch_bounds__(256) k_gla_finish(const float* __restrict__ proj, const float* __restrict__ nw, float* __restrict__ mixed) {
    const int t = blockIdx.x, h = threadIdx.x >> 6, lane = threadIdx.x & 63;
    float* m = mixed + (size_t)t * D + h * 128;
    const float a = m[lane], b = m[lane + 64];
    const float s = wave_sum(a * a + b * b);
    const float r = rsqrtf(s * (1.f / 128.f) + EPS);
    const float* g = proj + (size_t)t * NIN + C_GOUT + h * 128;
    m[lane] = a * r * nw[lane] * silu_f(g[lane]);
    m[lane + 64] = b * r * nw[lane + 64] * silu_f(g[lane + 64]);
}

__global__ void __launch_bounds__(256) k_ssd_conv(const float* __restrict__ proj, const float* __restrict__ cw, const float* __restrict__ cb, const float* __restrict__ dtb,
                                                  float* __restrict__ xc, float* __restrict__ dt) {
    const int t = blockIdx.x, l = t & (SEQ - 1);
    for (int c = threadIdx.x; c < 768; c += 256) {
        float acc = cb[c];
#pragma unroll
        for (int j = 0; j < 4; ++j) { const int ll = l - 3 + j; if (ll >= 0) acc += cw[j * 768 + c] * proj[(size_t)(t - 3 + j) * NIN + C_XBC + c]; }
        xc[(size_t)t * 768 + c] = silu_f(acc);
    }
    if (threadIdx.x < 8) dt[(size_t)t * 8 + threadIdx.x] = softplus_f(proj[(size_t)t * NIN + C_DT + threadIdx.x] + dtb[threadIdx.x]);
}

__global__ void __launch_bounds__(64) k_ssd_rec(const float* __restrict__ xc, const float* __restrict__ dt, const float* __restrict__ a_log, const float* __restrict__ dsk, float* __restrict__ mixed) {
    const int b = blockIdx.x >> 3, hd = blockIdx.x & 7, g = hd >> 2, p = threadIdx.x;
    const float A = -expf(a_log[hd]), Dk = dsk[hd];
    float hs[64];
#pragma unroll
    for (int n = 0; n < 64; ++n) hs[n] = 0.f;
    for (int t = 0; t < SEQ; ++t) {
        const size_t row = (size_t)b * SEQ + t;
        const float dtv = dt[row * 8 + hd];
        const float dA = expf(dtv * A);
        const float* xr = xc + row * 768;
        const float x = xr[hd * 64 + p], xdt = x * dtv;
        float y = 0.f;
#pragma unroll
        for (int n = 0; n < 64; ++n) {
            hs[n] = dA * hs[n] + xr[512 + g * 64 + n] * xdt;
            y += xr[640 + g * 64 + n] * hs[n];
        }
        mixed[row * D + 512 + hd * 64 + p] = y + x * Dk;
    }
}

__global__ void __launch_bounds__(128) k_ssd_finish(const float* __restrict__ proj, const float* __restrict__ nw, float* __restrict__ mixed) {
    const int t = blockIdx.x, g = threadIdx.x >> 6, lane = threadIdx.x & 63;
    float* m = mixed + (size_t)t * D + 512 + g * 256;
    const float* z = proj + (size_t)t * NIN + C_Z + g * 256;
    float y[4]; float s = 0.f;
#pragma unroll
    for (int j = 0; j < 4; ++j) { y[j] = m[lane + 64 * j] * silu_f(z[lane + 64 * j]); s += y[j] * y[j]; }
    s = wave_sum(s);
    const float r = rsqrtf(s * (1.f / 256.f) + EPS);
#pragma unroll
    for (int j = 0; j < 4; ++j) m[lane + 64 * j] = y[j] * r * nw[g * 256 + lane + 64 * j];
}

__global__ void __launch_bounds__(256) k_topk(const float* __restrict__ q, const float* __restrict__ subk, int* __restrict__ idx, float* __restrict__ gate) {
    __shared__ float s[256];
    __shared__ float ts[2][16];
    __shared__ int ti[2][16];
    __shared__ float cs[256];
    __shared__ float bs[16];
    __shared__ int be[16];
    const int t = blockIdx.x >> 3, h = blockIdx.x & 7, tid = threadIdx.x, p = tid >> 7, k = tid & 127;
    const float4* qv = (const float4*)(q + (size_t)t * 2048 + h * 256 + p * 128);
    const float4* kr = (const float4*)(subk + (((size_t)h * 2 + p) * 128 + k) * 128);
    float acc = 0.f;
#pragma unroll 8
    for (int d = 0; d < 32; ++d) { const float4 a = qv[d], b = kr[d]; acc += a.x * b.x + a.y * b.y + a.z * b.z + a.w * b.w; }
    s[tid] = acc;
    __syncthreads();
    int r = 0;
    for (int j = 0; j < 128; ++j) { const float o = s[p * 128 + j]; r += (o > acc || (o == acc && j < k)) ? 1 : 0; }
    if (r < 16) { ts[p][r] = acc; ti[p][r] = k; }
    __syncthreads();
    const int i = tid >> 4, j2 = tid & 15;
    const float c = ts[0][i] + ts[1][j2];
    cs[tid] = c;
    __syncthreads();
    r = 0;
    for (int m = 0; m < 256; ++m) { const float o = cs[m]; r += (o > c || (o == c && m < tid)) ? 1 : 0; }
    if (r < 16) { bs[r] = c; be[r] = ti[0][i] * 128 + ti[1][j2]; }
    __syncthreads();
    if (tid < 16) {
        const float mx = bs[0];
        float den = 0.f;
#pragma unroll
        for (int m = 0; m < 16; ++m) den += expf(bs[m] - mx);
        gate[(size_t)t * 128 + h * 16 + tid] = expf(bs[tid] - mx) / den;
        idx[(size_t)t * 128 + h * 16 + tid] = be[tid];
    }
}

__global__ void __launch_bounds__(256) k_expert(const float* __restrict__ hres, const float* __restrict__ u, const float* __restrict__ v, const int* __restrict__ idx, const float* __restrict__ gate,
                                                const float* __restrict__ nfw, float* out) {
    __shared__ float hid[128];
    __shared__ int eid[128];
    __shared__ float red[4];
    const int t = blockIdx.x, tid = threadIdx.x, w = tid >> 6, lane = tid & 63;
    if (tid < 128) eid[tid] = idx[(size_t)t * 128 + tid];
    float4 xv[4];
#pragma unroll
    for (int j = 0; j < 4; ++j) xv[j] = ((const float4*)(out + (size_t)t * D))[lane + 64 * j];
    __syncthreads();
    for (int e = w * 32; e < w * 32 + 32; ++e) {
        const float4* ur = (const float4*)(u + (size_t)eid[e] * D);
        float s = 0.f;
#pragma unroll
        for (int j = 0; j < 4; ++j) { const float4 a = ur[lane + 64 * j]; s += a.x * xv[j].x + a.y * xv[j].y + a.z * xv[j].z + a.w * xv[j].w; }
        s = wave_sum(s);
        if (lane == 0) hid[e] = gelu_f(s) * gate[(size_t)t * 128 + e];
    }
    __syncthreads();
    float4 acc = ((const float4*)(hres + (size_t)t * D))[tid];
    for (int e = 0; e < 128; ++e) {
        const float4 vv = ((const float4*)(v + (size_t)eid[e] * D))[tid];
        const float hh = hid[e];
        acc.x += hh * vv.x; acc.y += hh * vv.y; acc.z += hh * vv.z; acc.w += hh * vv.w;
    }
    float ss = acc.x * acc.x + acc.y * acc.y + acc.z * acc.z + acc.w * acc.w;
    ss = wave_sum(ss);
    if (lane == 0) red[w] = ss;
    __syncthreads();
    const float tot = red[0] + red[1] + red[2] + red[3];
    const float r = rsqrtf(tot * (1.f / D) + EPS);
    const float4 ww = ((const float4*)nfw)[tid];
    float4 o; o.x = acc.x * r * ww.x; o.y = acc.y * r * ww.y; o.z = acc.z * r * ww.z; o.w = acc.w * r * ww.w;
    ((float4*)(out + (size_t)t * D))[tid] = o;
}
}

extern "C" void kernel_launch(void* const* d_in, const int* in_sizes, int n_in, void* d_out, int out_size, void* d_ws, size_t ws_size, hipStream_t stream) {
    using namespace nv;
    constexpr size_t MiB = 1u << 20;
    if (n_in != 19 || out_size != T * D || ws_size < 256 * MiB) { fprintf(stderr, "kernel_launch: unexpected shapes n_in %d out %d ws %zu\n", n_in, out_size, ws_size); return; }
    const float* x = (const float*)d_in[0];
    const float* norm_mix_w = (const float*)d_in[1];
    const float* w_in = (const float*)d_in[2];
    const float* gla_w2 = (const float*)d_in[3];
    const float* gla_bg = (const float*)d_in[4];
    const float* gla_nw = (const float*)d_in[5];
    const float* conv_w = (const float*)d_in[6];
    const float* conv_b = (const float*)d_in[7];
    const float* dt_bias = (const float*)d_in[8];
    const float* a_log = (const float*)d_in[9];
    const float* d_skip = (const float*)d_in[10];
    const float* ssd_nw = (const float*)d_in[11];
    const float* w_out = (const float*)d_in[12];
    const float* norm_ffn_w = (const float*)d_in[13];
    const float* w_query = (const float*)d_in[14];
    const float* sub_keys = (const float*)d_in[15];
    const float* pu = (const float*)d_in[16];
    const float* pv = (const float*)d_in[17];
    const float* norm_final_w = (const float*)d_in[18];
    float* out = (float*)d_out;
    char* ws = (char*)d_ws;
    float* proj = (float*)(ws);
    float* mixed = (float*)(ws + 178 * MiB);
    float* dt = (float*)(ws + 242 * MiB);
    float* alpha = out;
    float* xc = out + (size_t)T * 256;
    float* hres = (float*)(ws);
    float* q = (float*)(ws + 64 * MiB);
    int* idx = (int*)(ws + 192 * MiB);
    float* gate = (float*)(ws + 200 * MiB);

    k_rmsnorm<<<T / 4, 256, 0, stream>>>(x, norm_mix_w, out);
    k_gemm<false><<<dim3((NIN + 63) / 64, T / 64), 256, 0, stream>>>(out, w_in, nullptr, proj, T, NIN, D);
    k_gla_gate<<<T, 256, 0, stream>>>(proj, gla_w2, gla_bg, alpha);
    k_ssd_conv<<<T, 256, 0, stream>>>(proj, conv_w, conv_b, dt_bias, xc, dt);
    k_gla_rec<<<8, 128, 0, stream>>>(proj, alpha, mixed);
    k_ssd_rec<<<16, 64, 0, stream>>>(xc, dt, a_log, d_skip, mixed);
    k_gla_finish<<<T, 256, 0, stream>>>(proj, gla_nw, mixed);
    k_ssd_finish<<<T, 128, 0, stream>>>(proj, ssd_nw, mixed);
    k_gemm<true><<<dim3(D / 64, T / 64), 256, 0, stream>>>(mixed, w_out, x, hres, T, D, D);
    k_rmsnorm<<<T / 4, 256, 0, stream>>>(hres, norm_ffn_w, out);
    k_gemm<false><<<dim3(2048 / 64, T / 64), 256, 0, stream>>>(out, w_query, nullptr, q, T, 2048, D);
    k_topk<<<T * 8, 256, 0, stream>>>(q, sub_keys, idx, gate);
    k_expert<<<T, 256, 0, stream>>>(hres, pu, pv, idx, gate, norm_final_w, out);
}
```

```cpp
#include <hip/hip_runtime.h>
#include <cstdio>
#include <cstdint>
namespace pg8 {
#define PG8_LAS __attribute__((address_space(3)))
typedef unsigned short bf16_t;
typedef short bf16x8 __attribute__((ext_vector_type(8)));
typedef float f32x4 __attribute__((ext_vector_type(4)));
typedef unsigned u32x4 __attribute__((ext_vector_type(4)));
constexpr int BM = 256, BK = 64, HALF = 128, HTB = HALF * BK * 2  , STAGE_BYTES = 8 * HTB, NXCD = 8, WGM = 8;

__host__ __device__ __forceinline__ int lds_byte(int r, int c) { const int st = (r >> 4) * 2 + (c >> 5), rr = r & 15, cc = c & 31, ob = rr * 64 + cc * 2; return st * 1024 + (ob ^ (((ob >> 9) & 1) << 5)); }
__host__ __device__ __forceinline__ void stage_rc(int b, int& R, int& C) { const int st = b / 1024, sb = b % 1024, swz = sb ^ (((sb >> 9) & 1) << 5); R = (st >> 1) * 16 + swz / 64; C = (st & 1) * 32 + (swz % 64) / 2; }
__host__ __device__ __forceinline__ int perm32(int rho) { const int n = rho >> 4, i = rho & 15; return 8 * (i >> 2) + 4 * n + (i & 3); }

struct Unit { int pm, pn; };
struct Gemm { const bf16_t* A; const bf16_t* Bt; int M, N, K; };

struct StaticOrder {
    int nM, nN, nwg, G, c;
    __host__ __device__ void init(int M, int N, int G_, int c_) { nM = M / BM; nN = N / BM; nwg = nM * nN; G = G_; c = c_; }
    __host__ __device__ bool next(int i, Unit& u) const {
        const long L = (long)i * G + c; if (L >= nwg) return false;
        int wgid = (int)L; { const int q = nwg / NXCD, r = nwg % NXCD, xcd = wgid % NXCD, off = wgid / NXCD; wgid = (xcd < r ? xcd * (q + 1) : r * (q + 1) + (xcd - r) * q) + off; }
        const int nig = WGM * nN, gid = wgid / nig, fm = gid * WGM, gsz = (nM - fm) < WGM ? (nM - fm) : WGM;
        u.pm = fm + ((wgid % nig) % gsz); u.pn = (wgid % nig) / gsz; return true;
    }
    __device__ __forceinline__ void a_ready(const Unit&) const {}
    __device__ __forceinline__ void done(const Unit&) const {}
};

__device__ __forceinline__ unsigned cvt_pk_bf16(float lo, float hi) { unsigned r; asm volatile("v_cvt_pk_bf16_f32 %0, %1, %2" : "=v"(r) : "v"(lo), "v"(hi)); return r; }
typedef float f32x2 __attribute__((ext_vector_type(2)));
struct EpiRowScaleBf16 {
    static constexpr bool PERM = true, AFTER_DRAIN = false;
    bf16_t* O; int ldc; const float* rs;
    __device__ __forceinline__ void operator()(const f32x4 (&acc)[2][2][4][2], const Unit& u, int wr, int wc, int fr, int fq) const {
        const int row0 = u.pm * BM + wr * 64 + fr, col0 = u.pn * BM + wc * 32 + 8 * fq;
#pragma unroll
        for (int ai = 0; ai < 2; ++ai)
#pragma unroll
            for (int m = 0; m < 4; ++m) { const int row = row0 + ai * HALF + m * 16; const float sc = rs[row]; bf16_t* rowp = O + (size_t)row * ldc + col0;
#pragma unroll
                for (int bj = 0; bj < 2; ++bj) { const f32x4 v0 = acc[ai][bj][m][0] * sc, v1 = acc[ai][bj][m][1] * sc;
                    u32x4 w; w.x = cvt_pk_bf16(v0[0], v0[1]); w.y = cvt_pk_bf16(v0[2], v0[3]); w.z = cvt_pk_bf16(v1[0], v1[1]); w.w = cvt_pk_bf16(v1[2], v1[3]);
                    *(u32x4*)(rowp + bj * HALF) = w; } }
    }
};
struct EpiRsqScaleBf16 {
    static constexpr bool PERM = true, AFTER_DRAIN = false;
    bf16_t* O; int ldc; const float* rowsq;
    __device__ __forceinline__ void operator()(const f32x4 (&acc)[2][2][4][2], const Unit& u, int wr, int wc, int fr, int fq) const {
        const int row0 = u.pm * BM + wr * 64 + fr, col0 = u.pn * BM + wc * 32 + 8 * fq;
#pragma unroll
        for (int ai = 0; ai < 2; ++ai)
#pragma unroll
            for (int m = 0; m < 4; ++m) { const int row = row0 + ai * HALF + m * 16; const float sc = rsqrtf(rowsq[row] * (1.f / 1024.f) + 1e-6f); bf16_t* rowp = O + (size_t)row * ldc + col0;
#pragma unroll
                for (int bj = 0; bj < 2; ++bj) { const f32x4 v0 = acc[ai][bj][m][0] * sc, v1 = acc[ai][bj][m][1] * sc;
                    u32x4 w; w.x = cvt_pk_bf16(v0[0], v0[1]); w.y = cvt_pk_bf16(v0[2], v0[3]); w.z = cvt_pk_bf16(v1[0], v1[1]); w.w = cvt_pk_bf16(v1[2], v1[3]);
                    *(u32x4*)(rowp + bj * HALF) = w; } }
    }
};
struct EpiResidual {
    static constexpr bool PERM = true, AFTER_DRAIN = false;
    const float* X; float* H; bf16_t* HB; float* rowsq; int ldc;
    __device__ __forceinline__ void operator()(const f32x4 (&acc)[2][2][4][2], const Unit& u, int wr, int wc, int fr, int fq) const {
        const int row0 = u.pm * BM + wr * 64 + fr, col0 = u.pn * BM + wc * 32 + 8 * fq;
#pragma unroll
        for (int ai = 0; ai < 2; ++ai)
#pragma unroll
            for (int m = 0; m < 4; ++m) { const int row = row0 + ai * HALF + m * 16; float ss = 0.f;
#pragma unroll
                for (int bj = 0; bj < 2; ++bj) { const size_t off = (size_t)row * ldc + col0 + bj * HALF;
                    const f32x4 v0 = acc[ai][bj][m][0] + *(const f32x4*)(X + off), v1 = acc[ai][bj][m][1] + *(const f32x4*)(X + off + 4);
                    *(f32x4*)(H + off) = v0; *(f32x4*)(H + off + 4) = v1;
                    u32x4 w; w.x = cvt_pk_bf16(v0[0], v0[1]); w.y = cvt_pk_bf16(v0[2], v0[3]); w.z = cvt_pk_bf16(v1[0], v1[1]); w.w = cvt_pk_bf16(v1[2], v1[3]);
                    *(u32x4*)(HB + off) = w;
                    ss += (v0[0] * v0[0] + v0[1] * v0[1]) + (v0[2] * v0[2] + v0[3] * v0[3]) + (v1[0] * v1[0] + v1[1] * v1[1]) + (v1[2] * v1[2] + v1[3] * v1[3]); }
                ss += __shfl_xor(ss, 16); ss += __shfl_xor(ss, 32);
                if (fq == 0) atomicAdd(rowsq + row, ss); }
    }
};
template <class Epi, class Sched, bool ALIGN_EPI = false, bool SP2 = false>
__device__ __forceinline__ void gemm_phase(PG8_LAS unsigned char* lds, const Gemm g, const Sched& S, const Epi& E) {
    const int tid = threadIdx.x, wid = __builtin_amdgcn_readfirstlane(tid >> 6), lane = tid & 63, wr = wid >> 2, wc = wid & 3, fr = lane & 15, fq = lane >> 4;
    const int K = g.K, nt = K / BK;
    unsigned voffA[2], voffB[2];
#pragma unroll
    for (int i = 0; i < 2; ++i) { int R, C; stage_rc(tid * 16 + i * 8192, R, C); const int Rb = Epi::PERM ? ((R & ~31) + perm32(R & 31)) : R;
        voffA[i] = (unsigned)(R * K + C) * 2u; voffB[i] = (unsigned)(Rb * K + C) * 2u; }
    const size_t kstep = (size_t)(BK * 2);
    const size_t hstep = (size_t)HALF * K * 2;
    const size_t tstep = 2 * hstep;
    const unsigned ldsw = (unsigned)wid * 1024u;
    const int aoff = lds_byte(wr * 64 + fr, fq * 8), boff = lds_byte(wc * 32 + fr, fq * 8);
#define PG8_SA(b, h) (((b) * 2 + (h)) * HTB)
#define PG8_SB(b, h) ((4 + (b) * 2 + (h)) * HTB)
#define PG8_STAGE(bufoff, gbase, voff) do { _Pragma("unroll") for (int _i = 0; _i < 2; ++_i) \
        __builtin_amdgcn_global_load_lds((const unsigned*)((const char*)(gbase) + (voff)[_i]), (PG8_LAS unsigned*)(lds + (bufoff) + ldsw + _i * 8192), 16, 0, 0); } while (0)
#define PG8_LDA(dst, b, h) do { _Pragma("unroll") for (int m = 0; m < 4; ++m) _Pragma("unroll") for (int k = 0; k < 2; ++k) dst[m][k] = *(const PG8_LAS bf16x8*)(lds + PG8_SA(b, h) + aoff + m * 2048 + k * 1024); } while (0)
#define PG8_LDB(dst, b, h) do { _Pragma("unroll") for (int n = 0; n < 2; ++n) _Pragma("unroll") for (int k = 0; k < 2; ++k) dst[n][k] = *(const PG8_LAS bf16x8*)(lds + PG8_SB(b, h) + boff + n * 2048 + k * 1024); } while (0)
#define PG8_MMA(ai, bj, At, Bt) do { __builtin_amdgcn_s_setprio(1); _Pragma("unroll") for (int m = 0; m < 4; ++m) _Pragma("unroll") for (int n = 0; n < 2; ++n) _Pragma("unroll") for (int k = 0; k < 2; ++k) \
        acc[ai][bj][m][n] = __builtin_amdgcn_mfma_f32_16x16x32_bf16(Bt[n][k], At[m][k], acc[ai][bj][m][n], 0, 0, 0); __builtin_amdgcn_s_setprio(0); } while (0)
#define PG8_WAIT_V(n) asm volatile("s_waitcnt vmcnt(" #n ")" ::: "memory")
#define PG8_WAIT_L(n) asm volatile("s_waitcnt lgkmcnt(" #n ")" ::: "memory")
#define PG8_BAR __builtin_amdgcn_s_barrier()
#define PG8_SCHED __builtin_amdgcn_sched_barrier(0)
    Unit cur, nxt; int ui = 0;
    if (!S.next(0, cur)) return;
    f32x4 acc[2][2][4][2];
#pragma unroll
    for (int a = 0; a < 2; ++a)
#pragma unroll
        for (int b = 0; b < 2; ++b)
#pragma unroll
            for (int m = 0; m < 4; ++m)
#pragma unroll
                for (int n = 0; n < 2; ++n) acc[a][b][m][n] = (f32x4){0.f, 0.f, 0.f, 0.f};
    bf16x8 At[4][2], B0[2][2], B1[2][2];
    const char* cA = (const char*)g.A + (size_t)cur.pm * tstep; const char* cB = (const char*)g.Bt + (size_t)cur.pn * tstep;
    S.a_ready(cur);
    if constexpr (SP2) {
        PG8_STAGE(PG8_SB(0, 0), cB, voffB); PG8_STAGE(PG8_SB(0, 1), cB + hstep, voffB); PG8_STAGE(PG8_SA(0, 0), cA, voffA); PG8_STAGE(PG8_SA(0, 1), cA + hstep, voffA);
        if (wr == 1) PG8_BAR;
        PG8_WAIT_V(2); PG8_BAR;
        PG8_STAGE(PG8_SB(1, 0), cB + kstep, voffB); PG8_STAGE(PG8_SA(1, 0), cA + kstep, voffA); PG8_STAGE(PG8_SB(1, 1), cB + hstep + kstep, voffB);
        PG8_WAIT_V(6); PG8_BAR;
    } else {
        PG8_STAGE(PG8_SB(0, 0), cB, voffB); PG8_STAGE(PG8_SA(0, 0), cA, voffA); PG8_STAGE(PG8_SB(0, 1), cB + hstep, voffB); PG8_STAGE(PG8_SA(0, 1), cA + hstep, voffA);
        if (wr == 1) PG8_BAR;
        PG8_WAIT_V(4); PG8_BAR;
        PG8_STAGE(PG8_SB(1, 0), cB + kstep, voffB); PG8_STAGE(PG8_SA(1, 0), cA + kstep, voffA); PG8_STAGE(PG8_SB(1, 1), cB + hstep + kstep, voffB);
        PG8_WAIT_V(6); PG8_BAR;
    }
    for (;;) {
        const bool has_next = S.next(ui + 1, nxt);
        const char* nA = has_next ? (const char*)g.A + (size_t)nxt.pm * tstep : cA; const char* nB = has_next ? (const char*)g.Bt + (size_t)nxt.pn * tstep : cB;
        for (int t = 0; t < nt; t += 2) {
            const bool last = (t == nt - 2);
            const char* a1 = cA + (size_t)(t + 1) * kstep;
            const char* a2 = last ? nA : cA + (size_t)(t + 2) * kstep; const char* b2 = last ? nB : cB + (size_t)(t + 2) * kstep;
            const char* a3 = a2 + kstep; const char* b3 = b2 + kstep;
            if (last && has_next) S.a_ready(nxt);
            if constexpr (SP2) {
            PG8_LDB(B0, 0, 0); PG8_LDB(B1, 0, 1); PG8_SCHED; PG8_LDA(At, 0, 0); PG8_STAGE(PG8_SA(1, 1), a1 + hstep, voffA);
            PG8_WAIT_V(8); PG8_WAIT_L(0); PG8_BAR; PG8_MMA(0, 0, At, B0); PG8_MMA(0, 1, At, B1); PG8_BAR; PG8_SCHED;
            PG8_LDA(At, 0, 1); PG8_STAGE(PG8_SB(0, 0), b2, voffB); PG8_STAGE(PG8_SB(0, 1), b2 + hstep, voffB); PG8_STAGE(PG8_SA(0, 0), a2, voffA);
            PG8_WAIT_V(8); PG8_WAIT_L(0); PG8_BAR; PG8_MMA(1, 0, At, B0); PG8_MMA(1, 1, At, B1); PG8_BAR; PG8_SCHED;
            PG8_LDB(B0, 1, 0); PG8_LDB(B1, 1, 1); PG8_SCHED; PG8_LDA(At, 1, 0); PG8_STAGE(PG8_SA(0, 1), a2 + hstep, voffA);
            PG8_WAIT_V(8); PG8_WAIT_L(0); PG8_BAR; PG8_MMA(0, 0, At, B0); PG8_MMA(0, 1, At, B1); PG8_BAR; PG8_SCHED;
            PG8_LDA(At, 1, 1); PG8_STAGE(PG8_SB(1, 0), b3, voffB); PG8_STAGE(PG8_SB(1, 1), b3 + hstep, voffB); PG8_STAGE(PG8_SA(1, 0), a3, voffA);
            PG8_WAIT_V(8); PG8_WAIT_L(0); PG8_BAR; PG8_MMA(1, 0, At, B0); PG8_MMA(1, 1, At, B1); PG8_BAR; PG8_SCHED;
            } else {
            PG8_LDB(B0, 0, 0); PG8_SCHED; PG8_LDA(At, 0, 0); PG8_STAGE(PG8_SA(1, 1), a1 + hstep, voffA);
            PG8_WAIT_L(8); PG8_BAR; PG8_WAIT_L(0); PG8_MMA(0, 0, At, B0); PG8_BAR; PG8_SCHED;
            PG8_LDB(B1, 0, 1); PG8_STAGE(PG8_SB(0, 0), b2, voffB);
            PG8_BAR; PG8_WAIT_L(0); PG8_MMA(0, 1, At, B1); PG8_BAR;
            PG8_LDA(At, 0, 1); PG8_STAGE(PG8_SA(0, 0), a2, voffA);
            PG8_BAR; PG8_WAIT_L(0); PG8_MMA(1, 0, At, B0); PG8_BAR; PG8_SCHED;
            PG8_STAGE(PG8_SB(0, 1), b2 + hstep, voffB);
            PG8_WAIT_V(6); PG8_BAR; PG8_MMA(1, 1, At, B1); PG8_BAR;
            PG8_LDB(B0, 1, 0); PG8_SCHED; PG8_LDA(At, 1, 0); PG8_STAGE(PG8_SA(0, 1), a2 + hstep, voffA);
            PG8_WAIT_L(8); PG8_BAR; PG8_WAIT_L(0); PG8_MMA(0, 0, At, B0); PG8_BAR; PG8_SCHED;
            PG8_LDB(B1, 1, 1); PG8_STAGE(PG8_SB(1, 0), b3, voffB);
            PG8_BAR; PG8_WAIT_L(0); PG8_MMA(0, 1, At, B1); PG8_BAR;
            PG8_LDA(At, 1, 1); PG8_STAGE(PG8_SA(1, 0), a3, voffA);
            PG8_BAR; PG8_WAIT_L(0); PG8_MMA(1, 0, At, B0); PG8_BAR; PG8_SCHED;
            PG8_STAGE(PG8_SB(1, 1), b3 + hstep, voffB);
            PG8_WAIT_V(6); PG8_BAR; PG8_MMA(1, 1, At, B1); PG8_BAR;
            }
        }
        if constexpr (ALIGN_EPI) { if (wr == 0) PG8_BAR; }
        if constexpr (!Epi::AFTER_DRAIN) { E(acc, cur, wr, wc, fr, fq); S.done(cur); }
        if (!has_next) break;
#pragma unroll
        for (int a = 0; a < 2; ++a)
#pragma unroll
            for (int b = 0; b < 2; ++b)
#pragma unroll
                for (int m = 0; m < 4; ++m)
#pragma unroll
                    for (int n = 0; n < 2; ++n) acc[a][b][m][n] = (f32x4){0.f, 0.f, 0.f, 0.f};
        cur = nxt; cA = nA; cB = nB; ++ui;
        if constexpr (ALIGN_EPI) { if (wr == 1) PG8_BAR; }
    }
    PG8_WAIT_V(0);
    if constexpr (!ALIGN_EPI) { if (wr == 0) PG8_BAR; }
    PG8_BAR;
    if constexpr (Epi::AFTER_DRAIN) { E.fused(acc, cur, wr, wc, fr, fq, lds, wid, lane); S.done(cur); }
#undef PG8_SA
#undef PG8_SB
#undef PG8_STAGE
#undef PG8_LDA
#undef PG8_LDB
#undef PG8_MMA
#undef PG8_WAIT_V
#undef PG8_WAIT_L
#undef PG8_BAR
#undef PG8_SCHED
}
}
constexpr int NWAVES = 8;
constexpr int T = 16384, SEQ = 8192, D = 1024, NIN = 2840, NINP = 3072, NQ = 2048;
constexpr int C_Q = 0, C_K = 256, C_V = 512, C_GLR = 1024, C_GOUT = 1040, C_Z = 1552, C_XBC = 2064, C_DT = 2832;
constexpr float EPS = 1e-6f;
constexpr size_t MiB = 1u << 20;
constexpr size_t WS_CTL = 0, CTL_ZERO_BYTES = 64 * 1024;
constexpr size_t WS_WIN = 1 * MiB;
constexpr size_t WS_WO = 7 * MiB;
constexpr size_t WS_WQ = 9 * MiB;
constexpr size_t WS_SUBK = 13 * MiB;
constexpr size_t WS_RRMS1 = 14 * MiB;
constexpr size_t WS_ROWSQ2 = 14 * MiB + 64 * 1024;
constexpr size_t WS_UB = 16 * MiB, WS_VB = 48 * MiB;
constexpr size_t WS_XB = 80 * MiB;
constexpr size_t WS_PROJ = 112 * MiB;
constexpr int CW_TMO = 0, CW_BAR = 1024;
constexpr int RING_OFF = 0, RING_BYTES = 131072;
constexpr int LDSCTL_OFF = RING_BYTES, MISC_OFF = LDSCTL_OFF + 320;
constexpr int LDS_BYTES = 147456;

#define GAS __attribute__((address_space(1)))
#define LAS __attribute__((address_space(3)))
typedef unsigned short bf16;
typedef unsigned v4u __attribute__((ext_vector_type(4)));
typedef float f32x4 __attribute__((ext_vector_type(4)));
typedef short bf16x8 __attribute__((ext_vector_type(8)));
typedef GAS unsigned gu32;
#define RLX_AGENT __ATOMIC_RELAXED, __HIP_MEMORY_SCOPE_AGENT
#define LDS_WAIT() asm volatile("s_waitcnt lgkmcnt(0)" ::: "memory")
#define VM_WAIT() asm volatile("s_waitcnt vmcnt(0)" ::: "memory")
__device__ __forceinline__ unsigned f2bf(float f) { unsigned u = __builtin_bit_cast(unsigned, f); return (u + 0x7fffu + ((u >> 16) & 1u)) >> 16; }
__device__ __forceinline__ unsigned pk2(float lo, float hi) { return f2bf(lo) | (f2bf(hi) << 16); }
__device__ __forceinline__ float bf2f(unsigned short b) { return __builtin_bit_cast(float, (unsigned)b << 16); }
__device__ __forceinline__ float wave_sum(float v) {
#pragma unroll
    for (int o = 1; o < 64; o <<= 1) v += __shfl_xor(v, o);
    return v;
}
#define XB_TMO      128
#define XB_XCNT(j)  (256  + 64 * (j))
#define XB_XSUB(j)  (1280 + 64 * (j))
#define XB_XGEN(j)  (2304 + 64 * (j))
#define XB_TOP      3328
#define XB_TOPGEN   3392
#define XCD_BAR_WORDS 3456
#define XB_SPIN_CAP (1u << 18)

__device__ __forceinline__ unsigned xb_ld(unsigned* p)              { return __hip_atomic_load(p, __ATOMIC_RELAXED, __HIP_MEMORY_SCOPE_AGENT); }
__device__ __forceinline__ unsigned xb_add(unsigned* p, unsigned v) { return __hip_atomic_fetch_add(p, v, __ATOMIC_RELAXED, __HIP_MEMORY_SCOPE_AGENT); }
__device__ __forceinline__ unsigned xb_xcc_id() { return (unsigned)__builtin_amdgcn_s_getreg((3 << 11) | 20) & 0xFu; }
#define XB_SPIN(cond, bar) do { unsigned _sp = 0; while (cond) { __builtin_amdgcn_s_sleep(1); \
    if ((++_sp & 255u) == 0u) { if (xb_ld(&(bar)[XB_TMO])) break; if (_sp > XB_SPIN_CAP) { atomicAdd(&(bar)[XB_TMO], 1u); break; } } } } while (0)

struct XcdBarrier {
    unsigned* bar; unsigned x;
    volatile LAS unsigned* st;
};

__device__ __forceinline__ XcdBarrier xcd_barrier_post(unsigned* bar, volatile LAS unsigned* st) {
    XcdBarrier b; b.bar = bar; b.x = xb_xcc_id(); b.st = st;
    if (threadIdx.x == 0) (void)xb_add(&bar[XB_XCNT(b.x)], 1u);
    return b;
}
__device__ __forceinline__ void xcd_barrier_complete(unsigned* bar, unsigned x, unsigned& nloc, unsigned& nx) {
    const unsigned G = gridDim.x * gridDim.y * gridDim.z;
    unsigned sum, cnt, mine, sp = 0u;
    for (;;) {
        sum = 0u; cnt = 0u; mine = 0u;
#pragma unroll
        for (unsigned j = 0; j < 16; ++j) { const unsigned c = xb_ld(&bar[XB_XCNT(j)]); sum += c; cnt += (c > 0u) ? 1u : 0u; mine = (j == x) ? c : mine; }
        if (sum == G) break;
        __builtin_amdgcn_s_sleep(1);
        if ((++sp & 255u) == 0u) { if (xb_ld(&bar[XB_TMO])) break; if (sp > XB_SPIN_CAP) { atomicAdd(&bar[XB_TMO], 1u); break; } }
    }
    nloc = mine > 0u ? mine : 1u; nx = cnt > 0u ? cnt : 1u;
}

__device__ __forceinline__ void xcd_barrier(const XcdBarrier& b) {
    asm volatile("s_waitcnt vmcnt(0)" ::: "memory");
    __syncthreads();
    if (threadIdx.x == 0) {
        unsigned* bar = b.bar;
        __builtin_amdgcn_s_waitcnt(0);
        unsigned nloc = b.st[0], nx = b.st[1];
        if (nloc == 0u) { xcd_barrier_complete(bar, b.x, nloc, nx); b.st[0] = nloc; b.st[1] = nx; }
        const unsigned old = xb_add(&bar[XB_XSUB(b.x)], 1u);
        const unsigned gen = old / nloc;
        if (old + 1u == (gen + 1u) * nloc) {
            __builtin_amdgcn_fence(__ATOMIC_RELEASE, "agent");
            asm volatile("s_waitcnt vmcnt(0)" ::: "memory");
            const unsigned og = xb_add(&bar[XB_TOP], 1u);
            const unsigned tg = og / nx;
            if (og + 1u == (tg + 1u) * nx) xb_add(&bar[XB_TOPGEN], 1u);
            else XB_SPIN(xb_ld(&bar[XB_TOPGEN]) == tg, bar);
            __builtin_amdgcn_fence(__ATOMIC_ACQUIRE, "agent");
            xb_add(&bar[XB_XGEN(b.x)], 1u);
            asm volatile("s_waitcnt vmcnt(0)" ::: "memory");
        } else {
            XB_SPIN(xb_ld(&bar[XB_XGEN(b.x)]) == gen, bar);
            __builtin_amdgcn_fence(__ATOMIC_ACQUIRE, "agent");
            asm volatile("s_waitcnt vmcnt(0)" ::: "memory");
        }
    }
    __syncthreads();
}
struct Args {
    const float* in[19]; float* out; unsigned char* ws; int ph_lo, ph_hi;
};
struct Frame {
    LAS unsigned char* lds; volatile LAS unsigned* MISC; gu32* ctl;
    int tid, lane, wave, G, gw, NGW;
};

constexpr size_t WS_GDEC = 14 * MiB + 128 * 1024;
constexpr size_t WS_SDEC = 14 * MiB + 512 * 1024;
constexpr size_t WS_GST = 208 * MiB;
constexpr size_t WS_SST = 224 * MiB;
constexpr int SA64 = 144, SA128 = 272, SA32 = 80;

__device__ __forceinline__ float silu_f(float x) { return x / (1.f + __expf(-x)); }
__device__ __forceinline__ float softplus_f(float x) { return fmaxf(x, 0.f) + log1pf(__expf(-fabsf(x))); }
__device__ __forceinline__ float logsigmoid_f(float x) { return fminf(x, 0.f) - log1pf(__expf(-fabsf(x))); }
typedef unsigned u32x2 __attribute__((ext_vector_type(2)));

__device__ __forceinline__ f32x4 mma16(const LAS unsigned char* A, int sa, const LAS unsigned char* Bt, int sb, int K, f32x4 acc, int r, int kg) {
    for (int k0 = 0; k0 < K; k0 += 32) {
        const bf16x8 a = *(const LAS bf16x8*)(A + r * sa + (k0 + 8 * kg) * 2);
        const bf16x8 b = *(const LAS bf16x8*)(Bt + r * sb + (k0 + 8 * kg) * 2);
        acc = __builtin_amdgcn_mfma_f32_16x16x32_bf16(a, b, acc, 0, 0, 0);
    }
    return acc;
}

template <int MODE>
__device__ __forceinline__ void gla_unit(const Frame& F, const Args& A, int unit) {
    const int b = unit >> 9, c = (unit >> 2) & 127, h = unit & 3;
    const size_t t0 = (size_t)b * SEQ + (size_t)c * 64;
    const GAS bf16* proj = (const GAS bf16*)(A.ws + WS_PROJ);
    LAS unsigned char* L = F.lds;
    LAS float* GLR = (LAS float*)(L + 0);
    LAS float* SEG = (LAS float*)(L + 4096);
    LAS float* RSQ = (LAS float*)(L + 6144);
    LAS unsigned char* QI = L + 8192;
    LAS unsigned char* KI = QI + 64 * SA64;
    LAS unsigned char* VT = KI + 64 * SA64;
    LAS unsigned char* SP = VT + 128 * SA64;
    LAS unsigned char* AT = SP + 128 * SA64;
    int tid = F.tid, seg = F.wave;
    asm volatile("" : "+v"(tid)); asm volatile("" : "+s"(seg));
    const int d = tid & 63;
    for (int e = tid; e < 64 * 16; e += 512) { const int i = e >> 4, r = e & 15; GLR[e] = bf2f(proj[(t0 + i) * NINP + C_GLR + r]); }
    {
        const int dv = tid & 127, js = tid >> 7; unsigned w[8];
#pragma unroll
        for (int jj = 0; jj < 8; ++jj) { const unsigned lo = proj[(t0 + js * 16 + 2 * jj) * NINP + C_V + h * 128 + dv], hi = proj[(t0 + js * 16 + 2 * jj + 1) * NINP + C_V + h * 128 + dv]; w[jj] = lo | (hi << 16); }
        *(LAS v4u*)(VT + dv * SA64 + js * 32) = (v4u){w[0], w[1], w[2], w[3]};
        *(LAS v4u*)(VT + dv * SA64 + js * 32 + 16) = (v4u){w[4], w[5], w[6], w[7]};
    }
    if (MODE == 1) {
        const GAS bf16* sp = (const GAS bf16*)(A.ws + WS_GST) + (size_t)unit * 8192;
        for (int e = tid; e < 1024; e += 512) { const int row = e >> 3, ch = e & 7; *(LAS v4u*)(SP + row * SA64 + ch * 16) = *(const GAS v4u*)(sp + row * 64 + ch * 8); }
    }
    float wv[16];
#pragma unroll
    for (int r = 0; r < 16; ++r) wv[r] = A.in[3][r * 256 + h * 64 + d];
    const float bgv = A.in[4][h * 64 + d];
    __syncthreads();
    float Gv[8]; float run = 0.f;
#pragma unroll
    for (int ii = 0; ii < 8; ++ii) { const int i = seg * 8 + ii; float z = bgv;
#pragma unroll
        for (int r = 0; r < 16; ++r) z += GLR[i * 16 + r] * wv[r];
        run += logsigmoid_f(z) * (1.f / 16.f); Gv[ii] = run; }
    SEG[seg * 64 + d] = run;
    __syncthreads();
    float off = 0.f, tot = 0.f;
#pragma unroll
    for (int s = 0; s < 8; ++s) { const float v = SEG[s * 64 + d]; tot += v; off += (s < seg) ? v : 0.f; }
#pragma unroll
    for (int ii = 0; ii < 8; ++ii) Gv[ii] += off;
    if (MODE == 0) {
        unsigned w[4];
#pragma unroll
        for (int ii = 0; ii < 8; ii += 2) {
            const float k0 = bf2f(proj[(t0 + seg * 8 + ii) * NINP + C_K + h * 64 + d]) * __expf(tot - Gv[ii]);
            const float k1 = bf2f(proj[(t0 + seg * 8 + ii + 1) * NINP + C_K + h * 64 + d]) * __expf(tot - Gv[ii + 1]);
            w[ii >> 1] = pk2(k0, k1); }
        *(LAS v4u*)(QI + d * SA64 + seg * 16) = (v4u){w[0], w[1], w[2], w[3]};
        if (seg == 0) ((GAS float*)(A.ws + WS_GDEC))[unit * 64 + d] = __expf(tot);
    } else {
#pragma unroll
        for (int ii = 0; ii < 8; ++ii) { const int i = seg * 8 + ii;
            const float qv = bf2f(proj[(t0 + i) * NINP + C_Q + h * 64 + d]) * 0.125f * __expf(Gv[ii]);
            const float kv = bf2f(proj[(t0 + i) * NINP + C_K + h * 64 + d]) * __expf(-Gv[ii]);
            *(LAS bf16*)(QI + i * SA64 + d * 2) = (bf16)f2bf(qv); *(LAS bf16*)(KI + i * SA64 + d * 2) = (bf16)f2bf(kv); }
    }
    __syncthreads();
    const int r = tid & 15, kg = (tid >> 4) & 3, w = seg;
    const f32x4 zero = (f32x4){0.f, 0.f, 0.f, 0.f};
    if (MODE == 0) {
        const int mt = w & 3, nb = (w >> 2) * 4;
        GAS bf16* stT = (GAS bf16*)(A.ws + WS_GST) + (size_t)unit * 8192;
#pragma unroll
        for (int n = 0; n < 4; ++n) {
            const f32x4 acc = mma16(QI + mt * 16 * SA64, SA64, VT + (nb + n) * 16 * SA64, SA64, 64, zero, r, kg);
            const int dv = (nb + n) * 16 + r, d0 = mt * 16 + kg * 4;
            *(GAS u32x2*)(stT + dv * 64 + d0) = (u32x2){pk2(acc[0], acc[1]), pk2(acc[2], acc[3])}; }
    } else {
        const int mt = w & 3;
#pragma unroll
        for (int n = 0; n < 2; ++n) { const int nt = (w >> 2) * 2 + n;
            const f32x4 acc = mma16(QI + mt * 16 * SA64, SA64, KI + nt * 16 * SA64, SA64, 64, zero, r, kg);
#pragma unroll
            for (int ii = 0; ii < 4; ++ii) { const int i = mt * 16 + kg * 4 + ii, j = nt * 16 + r; *(LAS bf16*)(AT + i * SA64 + j * 2) = (bf16)f2bf(j <= i ? acc[ii] : 0.f); } }
        __syncthreads();
        const int nb = (w >> 2) * 4;
        f32x4 o[4]; float rs[4] = {0.f, 0.f, 0.f, 0.f};
#pragma unroll
        for (int n = 0; n < 4; ++n) {
            f32x4 acc = mma16(AT + mt * 16 * SA64, SA64, VT + (nb + n) * 16 * SA64, SA64, 64, zero, r, kg);
            acc = mma16(QI + mt * 16 * SA64, SA64, SP + (nb + n) * 16 * SA64, SA64, 64, acc, r, kg);
            o[n] = acc;
#pragma unroll
            for (int ii = 0; ii < 4; ++ii) rs[ii] += acc[ii] * acc[ii]; }
#pragma unroll
        for (int ii = 0; ii < 4; ++ii) { rs[ii] += __shfl_xor(rs[ii], 1); rs[ii] += __shfl_xor(rs[ii], 2); rs[ii] += __shfl_xor(rs[ii], 4); rs[ii] += __shfl_xor(rs[ii], 8); }
        if (r == 0) {
#pragma unroll
            for (int ii = 0; ii < 4; ++ii) RSQ[(w >> 2) * 64 + mt * 16 + kg * 4 + ii] = rs[ii]; }
        __syncthreads();
        float rr[4];
#pragma unroll
        for (int ii = 0; ii < 4; ++ii) { const int row = mt * 16 + kg * 4 + ii; rr[ii] = rsqrtf((RSQ[row] + RSQ[64 + row]) * (1.f / 128.f) + EPS); }
        GAS bf16* mixed = (GAS bf16*)(A.ws + WS_XB);
#pragma unroll
        for (int n = 0; n < 4; ++n) { const int dv = (nb + n) * 16 + r; const float nwv = A.in[5][dv];
#pragma unroll
            for (int ii = 0; ii < 4; ++ii) { const size_t t = t0 + mt * 16 + kg * 4 + ii;
                const float gv = bf2f(proj[t * NINP + C_GOUT + h * 128 + dv]);
                mixed[t * D + h * 128 + dv] = (bf16)f2bf(o[n][ii] * rr[ii] * nwv * silu_f(gv)); } }
    }
    __syncthreads();
}

template <int MODE>
__device__ __forceinline__ void ssd_unit(const Frame& F, const Args& A, int unit) {
    const int b = unit >> 7, c = (unit >> 1) & 63, g = unit & 1;
    const size_t t0 = (size_t)b * SEQ + (size_t)c * 128;
    const GAS bf16* proj = (const GAS bf16*)(A.ws + WS_PROJ);
    LAS unsigned char* L = F.lds;
    LAS float* DT = (LAS float*)(L + 0);
    LAS float* ACU = (LAS float*)(L + 2048);
    LAS unsigned char* CM = L + 4096;
    LAS unsigned char* BM = CM + 128 * SA64;
    LAS unsigned char* XT = BM + 128 * SA64;
    LAS unsigned char* PW = XT + 4 * 64 * SA128;
    int tid = F.tid, w = F.wave;
    asm volatile("" : "+v"(tid)); asm volatile("" : "+s"(w));
    const int lane = tid & 63;
    if (w < 4) {
        const int hd = g * 4 + w; const float Ah = -__expf(A.in[9][hd]), dtb = A.in[8][hd];
        const float dt0 = softplus_f(bf2f(proj[(t0 + 2 * lane) * NINP + C_DT + hd]) + dtb), dt1 = softplus_f(bf2f(proj[(t0 + 2 * lane + 1) * NINP + C_DT + hd]) + dtb);
        const float a0 = dt0 * Ah, a1 = dt1 * Ah; float s = a0 + a1;
#pragma unroll
        for (int o = 1; o < 64; o <<= 1) { const float t = __shfl_up(s, o); s += (lane >= o) ? t : 0.f; }
        DT[(2 * lane) * 4 + w] = dt0; DT[(2 * lane + 1) * 4 + w] = dt1; ACU[(2 * lane) * 4 + w] = s - a1; ACU[(2 * lane + 1) * 4 + w] = s;
        if (MODE == 0 && lane == 63) ((GAS float*)(A.ws + WS_SDEC))[(b * 64 + c) * 8 + hd] = __expf(s);
    }
    __syncthreads();
    {
        const int cl = tid & 127, qtr = tid >> 7, l0 = qtr * 32;
#pragma unroll 1
        for (int k = 0; k < 3; ++k) {
            const int ci = cl + 128 * k;
            if (MODE == 0 && ci >= 320) continue;
            const int cc = ci < 256 ? g * 256 + ci : (ci < 320 ? 512 + g * 64 + (ci - 256) : 640 + g * 64 + (ci - 320));
            const float w0 = A.in[6][0 * 768 + cc], w1 = A.in[6][1 * 768 + cc], w2 = A.in[6][2 * 768 + cc], w3 = A.in[6][3 * 768 + cc], cb = A.in[7][cc];
            const GAS bf16* src = proj + (t0 + l0) * NINP + C_XBC + cc;
            float x0 = 0.f, x1 = 0.f, x2 = 0.f;
            if (c > 0 || qtr > 0) { x0 = bf2f(src[-3 * NINP]); x1 = bf2f(src[-2 * NINP]); x2 = bf2f(src[-1 * NINP]); }
            const int hl = ci >> 6, pn = ci & 63;
            float sc_end = 0.f; if (MODE == 0 && ci < 256) sc_end = ACU[127 * 4 + hl];
#pragma unroll 4
            for (int li = 0; li < 32; li += 2) {
                const float xa = bf2f(src[(size_t)li * NINP]), xb = bf2f(src[(size_t)(li + 1) * NINP]);
                float va = silu_f(cb + w0 * x0 + w1 * x1 + w2 * x2 + w3 * xa);
                float vb = silu_f(cb + w0 * x1 + w1 * x2 + w2 * xa + w3 * xb);
                x0 = x2; x1 = xa; x2 = xb;
                const int l = l0 + li;
                if (ci < 256) {
                    if (MODE == 0) { va *= DT[l * 4 + hl] * __expf(sc_end - ACU[l * 4 + hl]); vb *= DT[(l + 1) * 4 + hl] * __expf(sc_end - ACU[(l + 1) * 4 + hl]); }
                    *(LAS unsigned*)(XT + hl * 64 * SA128 + pn * SA128 + l * 2) = pk2(va, vb);
                } else if (ci < 320) {
                    if (MODE == 0) *(LAS unsigned*)(CM + pn * SA128 + l * 2) = pk2(va, vb);
                    else { *(LAS bf16*)(BM + l * SA64 + pn * 2) = (bf16)f2bf(va); *(LAS bf16*)(BM + (l + 1) * SA64 + pn * 2) = (bf16)f2bf(vb); }
                } else { *(LAS bf16*)(CM + l * SA64 + pn * 2) = (bf16)f2bf(va); *(LAS bf16*)(CM + (l + 1) * SA64 + pn * 2) = (bf16)f2bf(vb); }
            }
        }
    }
    __syncthreads();
    const int r = lane & 15, kg = lane >> 4;
    const f32x4 zero = (f32x4){0.f, 0.f, 0.f, 0.f};
    if (MODE == 0) {
        const int hl = w >> 1;
        GAS bf16* st = (GAS bf16*)(A.ws + WS_SST) + ((size_t)((b * 64 + c) * 8 + g * 4 + hl)) * 4096;
#pragma unroll
        for (int mt = 0; mt < 4; ++mt)
#pragma unroll
            for (int n = 0; n < 2; ++n) { const int nt = (w & 1) * 2 + n;
                const f32x4 acc = mma16(CM + mt * 16 * SA128, SA128, XT + hl * 64 * SA128 + nt * 16 * SA128, SA128, 128, zero, r, kg);
                const int p = nt * 16 + r, n0 = mt * 16 + kg * 4;
                *(GAS u32x2*)(st + p * 64 + n0) = (u32x2){pk2(acc[0], acc[1]), pk2(acc[2], acc[3])}; }
    } else {
        f32x4 sc[8];
#pragma unroll
        for (int nt = 0; nt < 8; ++nt) { sc[nt] = zero; if (nt <= w) sc[nt] = mma16(CM + w * 16 * SA64, SA64, BM + nt * 16 * SA64, SA64, 64, zero, r, kg); }
        __syncthreads();
        const GAS bf16* spg = (const GAS bf16*)(A.ws + WS_SST) + ((size_t)((b * 64 + c) * 8 + g * 4)) * 4096;
        for (int e = tid; e < 1024; e += 512) { const int row = e >> 3, ch = e & 7; *(LAS v4u*)(BM + row * SA64 + ch * 16) = *(const GAS v4u*)(spg + row * 64 + ch * 8); }
        __syncthreads();
        float rs[4] = {0.f, 0.f, 0.f, 0.f};
        LAS unsigned char* pw = PW + w * 16 * SA32;
        const GAS bf16* zrow = proj + (t0 + w * 16 + kg * 4) * NINP + C_Z + g * 256 + r;
        GAS bf16* mrow = (GAS bf16*)(A.ws + WS_XB) + (t0 + w * 16 + kg * 4) * D + 512 + g * 256 + r;
#pragma unroll 1
        for (int hl = 0; hl < 4; ++hl) {
            if (hl == 2) {
                __syncthreads();
                for (int e = tid; e < 1024; e += 512) { const int row = e >> 3, ch = e & 7; *(LAS v4u*)(BM + row * SA64 + ch * 16) = *(const GAS v4u*)(spg + 2 * 4096 + row * 64 + ch * 8); }
                __syncthreads();
            }
            float acl[4];
#pragma unroll
            for (int ii = 0; ii < 4; ++ii) acl[ii] = ACU[(w * 16 + kg * 4 + ii) * 4 + hl];
            f32x4 yd[4] = {zero, zero, zero, zero};
            const LAS unsigned char* xth = XT + hl * 64 * SA128;
#pragma unroll
            for (int kc = 0; kc < 4; ++kc) {
                if (kc * 2 <= w) {
#pragma unroll
                    for (int half = 0; half < 2; ++half) { const int stl = 2 * kc + half; const int s = stl * 16 + r;
                        const float acs = ACU[s * 4 + hl], dts = DT[s * 4 + hl];
#pragma unroll
                        for (int ii = 0; ii < 4; ++ii) { const int l = w * 16 + kg * 4 + ii;
                            const float pv = (s <= l) ? sc[stl][ii] * __expf(acl[ii] - acs) * dts : 0.f;
                            *(LAS bf16*)(pw + (kg * 4 + ii) * SA32 + (half * 16 + r) * 2) = (bf16)f2bf(pv); } }
                    LDS_WAIT();
                    const bf16x8 a = *(const LAS bf16x8*)(pw + r * SA32 + kg * 16);
#pragma unroll
                    for (int nt = 0; nt < 4; ++nt) { const bf16x8 bb = *(const LAS bf16x8*)(xth + (nt * 16 + r) * SA128 + (kc * 32 + 8 * kg) * 2);
                        yd[nt] = __builtin_amdgcn_mfma_f32_16x16x32_bf16(a, bb, yd[nt], 0, 0, 0); }
                    LDS_WAIT();
                }
            }
            const float Dk = A.in[10][g * 4 + hl];
            float eal[4];
#pragma unroll
            for (int ii = 0; ii < 4; ++ii) eal[ii] = __expf(acl[ii]);
#pragma unroll
            for (int nt = 0; nt < 4; ++nt) {
                const f32x4 yo = mma16(CM + w * 16 * SA64, SA64, BM + (hl & 1) * 64 * SA64 + nt * 16 * SA64, SA64, 64, zero, r, kg);
                const int p = nt * 16 + r;
#pragma unroll
                for (int ii = 0; ii < 4; ++ii) { const int l = w * 16 + kg * 4 + ii;
                    const float xv = bf2f(*(const LAS bf16*)(xth + p * SA128 + l * 2));
                    const float zv = bf2f(zrow[(size_t)ii * NINP + hl * 64 + nt * 16]);
                    const float y = (yd[nt][ii] + eal[ii] * yo[ii] + xv * Dk) * silu_f(zv);
                    const unsigned short yb = (unsigned short)f2bf(y); const float yq = bf2f(yb);
                    rs[ii] += yq * yq;
                    mrow[(size_t)ii * D + hl * 64 + nt * 16] = yb; }
            }
        }
#pragma unroll
        for (int ii = 0; ii < 4; ++ii) { rs[ii] += __shfl_xor(rs[ii], 1); rs[ii] += __shfl_xor(rs[ii], 2); rs[ii] += __shfl_xor(rs[ii], 4); rs[ii] += __shfl_xor(rs[ii], 8);
            rs[ii] = rsqrtf(rs[ii] * (1.f / 256.f) + EPS); }
        VM_WAIT();
#pragma unroll 1
        for (int hl = 0; hl < 4; ++hl)
#pragma unroll
            for (int nt = 0; nt < 4; ++nt) { const float nwv = A.in[11][g * 256 + hl * 64 + nt * 16 + r];
#pragma unroll
                for (int ii = 0; ii < 4; ++ii) { GAS bf16* q = mrow + (size_t)ii * D + hl * 64 + nt * 16;
                    const float yv = bf2f(__hip_atomic_load(q, __ATOMIC_RELAXED, __HIP_MEMORY_SCOPE_AGENT));
                    *q = (bf16)f2bf(yv * rs[ii] * nwv); } }
    }
    __syncthreads();
}

__device__ __forceinline__ void scan_phase(const Frame& F, const Args& A) {
    if (F.tid < 128) {
        GAS unsigned* st = (GAS unsigned*)(A.ws + WS_GST); const GAS float* dec = (const GAS float*)(A.ws + WS_GDEC);
        for (int gi = blockIdx.x * 128 + F.tid; gi < 8 * 4096; gi += F.G * 128) {
            const int bh = gi >> 12, e = gi & 4095, b = bh >> 2, h = bh & 3, d = (e & 31) * 2;
            float S0 = 0.f, S1 = 0.f;
            for (int c = 0; c < 128; c += 8) {
                unsigned v[8]; float d0[8], d1[8];
#pragma unroll
                for (int u = 0; u < 8; ++u) { const size_t un = (size_t)((b * 128 + c + u) * 4 + h); v[u] = st[un * 4096 + e]; d0[u] = dec[un * 64 + d]; d1[u] = dec[un * 64 + d + 1]; }
#pragma unroll
                for (int u = 0; u < 8; ++u) { const size_t un = (size_t)((b * 128 + c + u) * 4 + h); st[un * 4096 + e] = pk2(S0, S1);
                    S0 = d0[u] * S0 + bf2f((unsigned short)(v[u] & 0xffffu)); S1 = d1[u] * S1 + bf2f((unsigned short)(v[u] >> 16)); }
            }
        }
    } else if (F.tid < 256) {
        GAS unsigned* st = (GAS unsigned*)(A.ws + WS_SST); const GAS float* dec = (const GAS float*)(A.ws + WS_SDEC);
        for (int gi = blockIdx.x * 128 + (F.tid - 128); gi < 16 * 2048; gi += F.G * 128) {
            const int bh = gi >> 11, e = gi & 2047, b = bh >> 3, hd = bh & 7;
            float S0 = 0.f, S1 = 0.f;
            for (int c = 0; c < 64; c += 8) {
                unsigned v[8]; float dd[8];
#pragma unroll
                for (int u = 0; u < 8; ++u) { const size_t un = (size_t)((b * 64 + c + u) * 8 + hd); v[u] = st[un * 2048 + e]; dd[u] = dec[un]; }
#pragma unroll
                for (int u = 0; u < 8; ++u) { const size_t un = (size_t)((b * 64 + c + u) * 8 + hd); st[un * 2048 + e] = pk2(S0, S1);
                    S0 = dd[u] * S0 + bf2f((unsigned short)(v[u] & 0xffffu)); S1 = dd[u] * S1 + bf2f((unsigned short)(v[u] >> 16)); }
            }
        }
    }
}
constexpr size_t WS_HB = WS_PROJ;
constexpr size_t WS_Q = 144 * MiB;
constexpr size_t WS_IDX = 232 * MiB;
constexpr size_t WS_GATE = 240 * MiB;
typedef float f32x16 __attribute__((ext_vector_type(16)));
__device__ __forceinline__ float as_f(unsigned u) { return __builtin_bit_cast(float, u); }
__device__ __forceinline__ unsigned as_u(float f) { return __builtin_bit_cast(unsigned, f); }
#define CE_DESC(a, b) do { const float hi_ = fmaxf((a), (b)), lo_ = fminf((a), (b)); (a) = hi_; (b) = lo_; } while (0)
template <int OFF, int N> __device__ __forceinline__ void sort16_desc(float (&v)[N]) {
#pragma unroll
    for (int k = 2; k <= 16; k <<= 1)
#pragma unroll
        for (int j = k >> 1; j > 0; j >>= 1)
#pragma unroll
            for (int i = 0; i < 16; ++i) { const int l = i ^ j; if (l > i) { if ((i & k) == 0) CE_DESC(v[OFF + i], v[OFF + l]); else CE_DESC(v[OFF + l], v[OFF + i]); } }
}
template <int OA, int OB, int NA, int NB> __device__ __forceinline__ void merge16_desc(float (&a)[NA], const float (&b)[NB]) {
#pragma unroll
    for (int i = 0; i < 16; ++i) a[OA + i] = fmaxf(a[OA + i], b[OB + 15 - i]);
#pragma unroll
    for (int j = 8; j > 0; j >>= 1)
#pragma unroll
        for (int i = 0; i < 16; ++i) { const int l = i ^ j; if (l > i) CE_DESC(a[OA + i], a[OA + l]); }
}
constexpr unsigned char CAND0[32] = {0, 2, 4, 6, 8, 10, 12, 14, 16, 18, 20, 22, 32, 34, 36, 49, 51, 65, 80, 96, 112, 128, 160, 192, 224, 255, 255, 255, 255, 255, 255, 255};
constexpr unsigned char CAND1[32] = {1, 3, 5, 7, 9, 11, 13, 15, 17, 19, 21, 23, 33, 35, 48, 50, 64, 66, 81, 97, 113, 144, 176, 208, 240, 255, 255, 255, 255, 255, 255, 255};

__device__ __forceinline__ void topk_wave_job(const Args& A, const LAS unsigned char* SK, LAS unsigned char* TAB, int tok0, int h, int lane) {
    const int r = lane & 31, hi = lane >> 5;
    const GAS bf16* qrow = (const GAS bf16*)(A.ws + WS_Q) + (size_t)(tok0 + r) * NQ + h * 256 + 8 * hi;
    float LST[2][16];
#pragma unroll
    for (int p = 0; p < 2; ++p) {
        __builtin_amdgcn_sched_barrier(0);
        bf16x8 bq[8];
#pragma unroll
        for (int s = 0; s < 8; ++s) bq[s] = *(const GAS bf16x8*)(qrow + p * 128 + 16 * s);
        float v[64];
#pragma unroll
        for (int kt = 0; kt < 4; ++kt) {
            f32x16 acc;
#pragma unroll
            for (int i = 0; i < 16; ++i) acc[i] = 0.f;
#pragma unroll
            for (int s = 0; s < 8; ++s) { const bf16x8 a = *(const LAS bf16x8*)(SK + (p * 128 + kt * 32 + r) * SA128 + (16 * s + 8 * hi) * 2);
                acc = __builtin_amdgcn_mfma_f32_32x32x16_bf16(a, bq[s], acc, 0, 0, 0); }
#pragma unroll
            for (int i = 0; i < 16; ++i) { const unsigned key = (unsigned)(kt * 32 + (i & 3) + 8 * (i >> 2)) | ((unsigned)hi << 2); v[kt * 16 + i] = as_f((as_u(acc[i]) & ~127u) | key); }
        }
        sort16_desc<0>(v); sort16_desc<16>(v); sort16_desc<32>(v); sort16_desc<48>(v);
        merge16_desc<0, 16>(v, v); merge16_desc<32, 48>(v, v); merge16_desc<0, 32>(v, v);
        float o[16];
#pragma unroll
        for (int i = 0; i < 16; ++i) o[i] = __shfl_xor(v[i], 32);
        merge16_desc<0, 0>(v, o);
#pragma unroll
        for (int i = 0; i < 16; ++i) LST[p][i] = v[i];
    }
    __builtin_amdgcn_sched_barrier(0);
    {   unsigned pk[4];
#pragma unroll
        for (int q4 = 0; q4 < 4; ++q4) { unsigned wv = 0;
#pragma unroll
            for (int b = 0; b < 4; ++b) { float l0 = LST[0][q4 * 4 + b], l1 = LST[1][q4 * 4 + b]; asm volatile("" : "+v"(l0), "+v"(l1));
                const unsigned x = as_u(hi ? l1 : l0) & 127u; wv |= x << (8 * b); }
            pk[q4] = wv; }
        *(LAS v4u*)(TAB + r * 32 + hi * 16) = (v4u){pk[0], pk[1], pk[2], pk[3]};
    }
    float c[32];
    float va[16], vb2[16];
#pragma unroll
    for (int i = 0; i < 16; ++i) { va[i] = as_f(as_u(LST[0][i]) & ~127u); vb2[i] = as_f(as_u(LST[1][i]) & ~127u); }
#define CANDV(i0, j0, k0, i1, j1, k1) as_f((as_u(hi ? (va[i1] + vb2[j1]) : (va[i0] + vb2[j0])) & ~255u) | (hi ? (k1) : (k0)))
    c[0] = CANDV(0, 0, 0u, 0, 1, 1u);
    c[1] = CANDV(0, 2, 2u, 0, 3, 3u);
    c[2] = CANDV(0, 4, 4u, 0, 5, 5u);
    c[3] = CANDV(0, 6, 6u, 0, 7, 7u);
    c[4] = CANDV(0, 8, 8u, 0, 9, 9u);
    c[5] = CANDV(0, 10, 10u, 0, 11, 11u);
    c[6] = CANDV(0, 12, 12u, 0, 13, 13u);
    c[7] = CANDV(0, 14, 14u, 0, 15, 15u);
    c[8] = CANDV(1, 0, 16u, 1, 1, 17u);
    c[9] = CANDV(1, 2, 18u, 1, 3, 19u);
    c[10] = CANDV(1, 4, 20u, 1, 5, 21u);
    c[11] = CANDV(1, 6, 22u, 1, 7, 23u);
    c[12] = CANDV(2, 0, 32u, 2, 1, 33u);
    c[13] = CANDV(2, 2, 34u, 2, 3, 35u);
    c[14] = CANDV(2, 4, 36u, 3, 0, 48u);
    c[15] = CANDV(3, 1, 49u, 3, 2, 50u);
    c[16] = CANDV(3, 3, 51u, 4, 0, 64u);
    c[17] = CANDV(4, 1, 65u, 4, 2, 66u);
    c[18] = CANDV(5, 0, 80u, 5, 1, 81u);
    c[19] = CANDV(6, 0, 96u, 6, 1, 97u);
    c[20] = CANDV(7, 0, 112u, 7, 1, 113u);
    c[21] = CANDV(8, 0, 128u, 9, 0, 144u);
    c[22] = CANDV(10, 0, 160u, 11, 0, 176u);
    c[23] = CANDV(12, 0, 192u, 13, 0, 208u);
    c[24] = CANDV(14, 0, 224u, 15, 0, 240u);
    c[25] = as_f(0xFF61B1E6u | 255u);
    c[26] = as_f(0xFF61B1E6u | 255u);
    c[27] = as_f(0xFF61B1E6u | 255u);
    c[28] = as_f(0xFF61B1E6u | 255u);
    c[29] = as_f(0xFF61B1E6u | 255u);
    c[30] = as_f(0xFF61B1E6u | 255u);
    c[31] = as_f(0xFF61B1E6u | 255u);
#undef CANDV
    sort16_desc<0>(c); sort16_desc<16>(c); merge16_desc<0, 16>(c, c);
    {   float o[16];
#pragma unroll
        for (int i = 0; i < 16; ++i) o[i] = __shfl_xor(c[i], 32);
        merge16_desc<0, 0>(c, o); }
    const float mx = as_f(as_u(c[0]) & ~255u);
    float ex[16], den = 0.f;
#pragma unroll
    for (int k = 0; k < 16; ++k) { ex[k] = __expf(as_f(as_u(c[k]) & ~255u) - mx); den += ex[k]; }
    const float inv = 1.f / den;
    LDS_WAIT();
    unsigned eid[8]; float gv[8];
#pragma unroll
    for (int k = 0; k < 8; ++k) { float ca = c[k], cb = c[k + 8], ea = ex[k], eb = ex[k + 8]; asm volatile("" : "+v"(ca), "+v"(cb), "+v"(ea), "+v"(eb));
        const unsigned code = as_u(hi ? cb : ca) & 255u; gv[k] = (hi ? eb : ea) * inv;
        const unsigned ia = *(const LAS unsigned char*)(TAB + r * 32 + (code >> 4)), ib = *(const LAS unsigned char*)(TAB + r * 32 + 16 + (code & 15));
        eid[k] = ia * 128u + ib; }
    GAS unsigned* ip = (GAS unsigned*)(A.ws + WS_IDX) + (size_t)(tok0 + r) * 128 + h * 16 + 8 * hi;
    GAS float* gp = (GAS float*)(A.ws + WS_GATE) + (size_t)(tok0 + r) * 128 + h * 16 + 8 * hi;
    *(GAS v4u*)ip = (v4u){eid[0], eid[1], eid[2], eid[3]}; *(GAS v4u*)(ip + 4) = (v4u){eid[4], eid[5], eid[6], eid[7]};
    *(GAS f32x4*)gp = (f32x4){gv[0], gv[1], gv[2], gv[3]}; *(GAS f32x4*)(gp + 4) = (f32x4){gv[4], gv[5], gv[6], gv[7]};
    LDS_WAIT();
}
__device__ __forceinline__ void topk_phase(const Frame& F, const Args& A) {
    LAS unsigned char* SK = F.lds;
    LAS unsigned char* TABS = F.lds + 256 * SA128;
    for (int unit = blockIdx.x; unit < 256; unit += F.G) {
        int tid = F.tid, w = F.wave;
        asm volatile("" : "+v"(tid)); asm volatile("" : "+s"(w));
        const int h = unit & 7, tb = (unit >> 3) * 512;
        const GAS bf16* sk = (const GAS bf16*)(A.ws + WS_SUBK) + (size_t)h * 2 * 128 * 128;
        for (int e = tid; e < 256 * 16; e += 512) { const int row = e >> 4, ch = e & 15; *(LAS v4u*)(SK + row * SA128 + ch * 16) = *(const GAS v4u*)(sk + row * 128 + ch * 8); }
        __syncthreads();
#pragma unroll 1
        for (int tt = 0; tt < 2; ++tt) topk_wave_job(A, SK, TABS + w * 1024, tb + (w * 2 + tt) * 32, h, tid & 63);
        __syncthreads();
    }
}

__device__ __forceinline__ float gelu_f(float x) { return 0.5f * x * (1.f + erff(x * 0.70710678118654752f)); }
__device__ __forceinline__ void unpack8(const v4u x, float (&f)[8]) {
    f[0] = as_f(x.x << 16); f[1] = as_f(x.x & 0xffff0000u); f[2] = as_f(x.y << 16); f[3] = as_f(x.y & 0xffff0000u);
    f[4] = as_f(x.z << 16); f[5] = as_f(x.z & 0xffff0000u); f[6] = as_f(x.w << 16); f[7] = as_f(x.w & 0xffff0000u);
}
__device__ __forceinline__ void expert_phase(const Frame& F, const Args& A) {
    int tid = F.tid, w = F.wave;
    asm volatile("" : "+v"(tid)); asm volatile("" : "+s"(w));
    const int lane = tid & 63, r = lane & 15, kg = lane >> 4;
    LAS unsigned char* N2 = F.lds + w * 2048;
    const GAS bf16* ub = (const GAS bf16*)(A.ws + WS_UB); const GAS bf16* vb = (const GAS bf16*)(A.ws + WS_VB);
    const GAS unsigned* idx = (const GAS unsigned*)(A.ws + WS_IDX); const GAS float* gate = (const GAS float*)(A.ws + WS_GATE);
    const GAS float* rowsq = (const GAS float*)(A.ws + WS_ROWSQ2);
    f32x4 nf[4], nl[4];
#pragma unroll
    for (int j = 0; j < 2; ++j)
#pragma unroll
        for (int q = 0; q < 2; ++q) { nf[2 * j + q] = *(const GAS f32x4*)(A.in[13] + 8 * lane + 512 * j + 4 * q); nl[2 * j + q] = *(const GAS f32x4*)(A.in[18] + 8 * lane + 512 * j + 4 * q); }
#pragma unroll 1
    for (int t = F.gw; t < T; t += F.NGW) {
        GAS float* hrow = (GAS float*)A.out + (size_t)t * D;
        f32x4 hv[4];
#pragma unroll
        for (int j = 0; j < 2; ++j)
#pragma unroll
            for (int q = 0; q < 2; ++q) hv[2 * j + q] = *(const GAS f32x4*)(hrow + 8 * lane + 512 * j + 4 * q);
        const float rr = rsqrtf(rowsq[t] * (1.f / 1024.f) + EPS);
#pragma unroll
        for (int j = 0; j < 2; ++j) { const f32x4 a = hv[2 * j] * rr * nf[2 * j], b = hv[2 * j + 1] * rr * nf[2 * j + 1];
            *(LAS v4u*)(N2 + (512 * j + 8 * lane) * 2) = (v4u){pk2(a.x, a.y), pk2(a.z, a.w), pk2(b.x, b.y), pk2(b.z, b.w)}; }
        unsigned eidx[8]; float gt[8];
#pragma unroll
        for (int eg = 0; eg < 8; ++eg) { eidx[eg] = idx[(size_t)t * 128 + eg * 16 + r]; gt[eg] = gate[(size_t)t * 128 + eg * 16 + r]; }
        LDS_WAIT();
        f32x4 acc[8];
#pragma unroll
        for (int eg = 0; eg < 8; ++eg) acc[eg] = (f32x4){0.f, 0.f, 0.f, 0.f};
#pragma unroll 2
        for (int s = 0; s < 32; ++s) {
            const bf16x8 a = *(const LAS bf16x8*)(N2 + (32 * s + 8 * kg) * 2);
#pragma unroll
            for (int eg = 0; eg < 8; ++eg) { const bf16x8 b = *(const GAS bf16x8*)(ub + (size_t)eidx[eg] * 1024 + 32 * s + 8 * kg);
                acc[eg] = __builtin_amdgcn_mfma_f32_16x16x32_bf16(a, b, acc[eg], 0, 0, 0); }
        }
        float hid[8];
#pragma unroll
        for (int eg = 0; eg < 8; ++eg) hid[eg] = gelu_f(acc[eg][0]) * gt[eg];
        float o[16];
#pragma unroll
        for (int i = 0; i < 16; ++i) o[i] = 0.f;
#pragma unroll
        for (int eg = 0; eg < 8; ++eg) {
#pragma unroll
            for (int half = 0; half < 2; ++half) {
                asm volatile("" ::: "memory");
#pragma unroll
                for (int rr_ = half * 8; rr_ < half * 8 + 8; ++rr_) {
                    const float sh = as_f(__builtin_amdgcn_readlane((int)as_u(hid[eg]), rr_));
                    const unsigned si = (unsigned)__builtin_amdgcn_readlane((int)eidx[eg], rr_);
                    const GAS v4u* vr = (const GAS v4u*)(vb + (size_t)si * 1024);
                    const v4u x0 = vr[lane], x1 = vr[lane + 64];
                    float f0[8], f1[8]; unpack8(x0, f0); unpack8(x1, f1);
#pragma unroll
                    for (int i = 0; i < 8; ++i) { o[i] += sh * f0[i]; o[8 + i] += sh * f1[i]; }
                }
            }
        }
        float ss = 0.f; f32x4 h2[4];
#pragma unroll
        for (int j = 0; j < 2; ++j)
#pragma unroll
            for (int q = 0; q < 2; ++q) { h2[2 * j + q] = hv[2 * j + q] + (f32x4){o[8 * j + 4 * q], o[8 * j + 4 * q + 1], o[8 * j + 4 * q + 2], o[8 * j + 4 * q + 3]};
                const f32x4 x = h2[2 * j + q]; ss += (x.x * x.x + x.y * x.y) + (x.z * x.z + x.w * x.w); }
        ss = wave_sum(ss);
        const float r3 = rsqrtf(ss * (1.f / D) + EPS);
#pragma unroll
        for (int j = 0; j < 2; ++j)
#pragma unroll
            for (int q = 0; q < 2; ++q) *(GAS f32x4*)(hrow + 8 * lane + 512 * j + 4 * q) = h2[2 * j + q] * r3 * nl[2 * j + q];
    }
}
__device__ __forceinline__ void p0_transpose_item(const float* W, const float* kscale, int K, int N, bf16* WT, LAS float* scr, int item, int lane) {
    const int nblk = (N + 31) / 32, kb = item / nblk, nb = item % nblk, k0 = 64 * kb, n0 = 32 * nb;
    const int nn = n0 + (lane & 31); const bool ok = nn < N;
#pragma unroll 8
    for (int i = 0; i < 32; ++i) { const int kk = 2 * i + (lane >> 5); float v = ok ? W[(size_t)(k0 + kk) * N + nn] : 0.f; if (kscale) v *= kscale[k0 + kk]; scr[kk * 33 + (lane & 31)] = v; }
    LDS_WAIT(); asm volatile("" ::: "memory");
    const int c = lane & 7;
#pragma unroll
    for (int j = 0; j < 4; ++j) { const int n = (lane >> 3) + 8 * j; const LAS float* s = scr + (8 * c) * 33 + n;
        v4u o; o.x = pk2(s[0 * 33], s[1 * 33]); o.y = pk2(s[2 * 33], s[3 * 33]); o.z = pk2(s[4 * 33], s[5 * 33]); o.w = pk2(s[6 * 33], s[7 * 33]);
        *(GAS v4u*)(WT + (size_t)(n0 + n) * K + k0 + 8 * c) = o; }
    LDS_WAIT(); asm volatile("" ::: "memory");
}
__device__ __forceinline__ void p0_convert(const Frame& F, const float* src, bf16* dst, size_t n) {
    for (size_t i = ((size_t)F.gw * 64 + F.lane) * 8; i < n; i += (size_t)F.NGW * 512) {
        const f32x4 a = *(const GAS f32x4*)(src + i), b = *(const GAS f32x4*)(src + i + 4);
        v4u o; o.x = pk2(a.x, a.y); o.y = pk2(a.z, a.w); o.z = pk2(b.x, b.y); o.w = pk2(b.z, b.w);
        *(GAS v4u*)(dst + i) = o;
    }
}
__device__ __forceinline__ void p0_prologue(const Frame& F, const Args& A) {
    unsigned char* ws = A.ws;
    LAS float* scr = (LAS float*)(F.lds + RING_OFF + F.wave * 16384);
    constexpr int I_IN = (D / 64) * ((NIN + 31) / 32), I_O = (D / 64) * (D / 32), I_Q = (D / 64) * (NQ / 32);
    for (int it = F.gw; it < I_IN + I_O + I_Q; it += F.NGW) {
        int r = it;
        if (r < I_IN) { p0_transpose_item(A.in[2], A.in[1], D, NIN, (bf16*)(ws + WS_WIN), scr, r, F.lane); continue; } r -= I_IN;
        if (r < I_O) { p0_transpose_item(A.in[12], nullptr, D, D, (bf16*)(ws + WS_WO), scr, r, F.lane); continue; } r -= I_O;
        p0_transpose_item(A.in[14], A.in[13], D, NQ, (bf16*)(ws + WS_WQ), scr, r, F.lane);
    }
    for (int m = F.gw; m < T; m += F.NGW) {
        const GAS f32x4* xr = (const GAS f32x4*)(A.in[0] + (size_t)m * D) + F.lane;
        f32x4 v[4]; float s = 0.f;
#pragma unroll
        for (int j = 0; j < 4; ++j) { v[j] = xr[64 * j]; s += (v[j].x * v[j].x + v[j].y * v[j].y) + (v[j].z * v[j].z + v[j].w * v[j].w); }
        s = wave_sum(s);
        GAS unsigned long long* o8 = (GAS unsigned long long*)((bf16*)(ws + WS_XB) + (size_t)m * D) + F.lane;
#pragma unroll
        for (int j = 0; j < 4; ++j) o8[64 * j] = (unsigned long long)pk2(v[j].x, v[j].y) | ((unsigned long long)pk2(v[j].z, v[j].w) << 32);
        if (F.lane == 0) { ((float*)(ws + WS_RRMS1))[m] = rsqrtf(s * (1.f / D) + EPS); ((float*)(ws + WS_ROWSQ2))[m] = 0.f; }
    }
    p0_convert(F, A.in[15], (bf16*)(ws + WS_SUBK), (size_t)8 * 2 * 128 * 128);
    p0_convert(F, A.in[16], (bf16*)(ws + WS_UB), (size_t)16384 * 1024);
    p0_convert(F, A.in[17], (bf16*)(ws + WS_VB), (size_t)16384 * 1024);
}

__global__ void __launch_bounds__(NWAVES * 64, 2) fwd(Args args) {
    extern __shared__ __attribute__((aligned(16))) unsigned char lds[];
    Frame F;
    F.lds = (LAS unsigned char*)lds;
    F.MISC = (volatile LAS unsigned*)(F.lds + MISC_OFF);
    F.tid = threadIdx.x; F.lane = F.tid & 63; F.wave = __builtin_amdgcn_readfirstlane(F.tid >> 6);
    F.G = gridDim.x; F.gw = blockIdx.x * NWAVES + F.wave; F.NGW = F.G * NWAVES;
    unsigned char* ws = args.ws;
    F.ctl = (gu32*)(ws + WS_CTL);
    for (int u = F.tid; u < (LDS_BYTES - LDSCTL_OFF) / 4; u += NWAVES * 64) ((LAS unsigned*)(F.lds + LDSCTL_OFF))[u] = 0u;
    __syncthreads();
    XcdBarrier bar = xcd_barrier_post((unsigned*)(F.ctl + CW_BAR), F.MISC + 8);
    const int lo = args.ph_lo, hi = args.ph_hi;
#define IN(k) (lo <= (k) && (k) < hi)
#define BOTH(k) (IN(k) && IN((k) + 1))
#define GRID_BAR() xcd_barrier(bar)

    if (IN(0)) { p0_prologue(F, args); if (BOTH(0)) GRID_BAR(); }
    if (IN(1)) {
        pg8::Gemm g{(const bf16*)(ws + WS_XB), (const bf16*)(ws + WS_WIN), T, NINP, D}; pg8::StaticOrder S; S.init(T, NINP, F.G, (int)blockIdx.x);
        pg8::EpiRowScaleBf16 E{(bf16*)(ws + WS_PROJ), NINP, (const float*)(ws + WS_RRMS1)};
        pg8::gemm_phase<pg8::EpiRowScaleBf16, pg8::StaticOrder, true, true>(F.lds + RING_OFF, g, S, E);
        if (BOTH(1)) GRID_BAR();
    }
    if (IN(2)) {
        for (int u = blockIdx.x; u < 256; u += F.G) ssd_unit<0>(F, args, u);
        for (int u = blockIdx.x; u < 1024; u += F.G) gla_unit<0>(F, args, u);
        if (BOTH(2)) GRID_BAR();
    }
    if (IN(3)) { scan_phase(F, args); if (BOTH(3)) GRID_BAR(); }
    if (IN(4)) {
        for (int u = blockIdx.x; u < 256; u += F.G) ssd_unit<1>(F, args, u);
        for (int u = blockIdx.x; u < 1024; u += F.G) gla_unit<1>(F, args, u);
        if (BOTH(4)) GRID_BAR();
    }
    if (IN(5)) {
        pg8::Gemm g{(const bf16*)(ws + WS_XB), (const bf16*)(ws + WS_WO), T, D, D}; pg8::StaticOrder S; S.init(T, D, F.G, (int)blockIdx.x);
        pg8::EpiResidual E{args.in[0], args.out, (bf16*)(ws + WS_HB), (float*)(ws + WS_ROWSQ2), D};
        pg8::gemm_phase<pg8::EpiResidual, pg8::StaticOrder, true, true>(F.lds + RING_OFF, g, S, E);
        if (BOTH(5)) GRID_BAR();
    }
    if (IN(6)) {
        pg8::Gemm g{(const bf16*)(ws + WS_HB), (const bf16*)(ws + WS_WQ), T, NQ, D}; pg8::StaticOrder S; S.init(T, NQ, F.G, (int)blockIdx.x);
        pg8::EpiRsqScaleBf16 E{(bf16*)(ws + WS_Q), NQ, (const float*)(ws + WS_ROWSQ2)};
        pg8::gemm_phase<pg8::EpiRsqScaleBf16, pg8::StaticOrder, true, true>(F.lds + RING_OFF, g, S, E);
        if (BOTH(6)) GRID_BAR();
    }
    if (IN(7)) { topk_phase(F, args); if (BOTH(7)) GRID_BAR(); }
    if (IN(8)) { expert_phase(F, args); }
#undef IN
#undef BOTH
}
namespace nv {
struct ProjF32 { const float* p; __device__ __forceinline__ float operator()(size_t row, int c) const { return p[row * NIN + c]; } };
struct ProjBf { const unsigned short* p; __device__ __forceinline__ float operator()(size_t row, int c) const { return bf2f(p[row * NINP + c]); } };
__device__ __forceinline__ float silu_f(float x) { return x / (1.f + expf(-x)); }
__device__ __forceinline__ float softplus_f(float x) { return fmaxf(x, 0.f) + log1pf(expf(-fabsf(x))); }
__device__ __forceinline__ float logsigmoid_f(float x) { return fminf(x, 0.f) - log1pf(expf(-fabsf(x))); }
__device__ __forceinline__ float gelu_f(float x) { return 0.5f * x * (1.f + erff(x * 0.70710678118654752f)); }

__global__ void __launch_bounds__(256) k_rmsnorm(const float* __restrict__ x, const float* __restrict__ w, float* __restrict__ out) {
    const int row = blockIdx.x * 4 + (threadIdx.x >> 6), lane = threadIdx.x & 63;
    const float4* xr = (const float4*)(x + (size_t)row * D);
    float4 v[4]; float s = 0.f;
#pragma unroll
    for (int j = 0; j < 4; ++j) { v[j] = xr[lane + 64 * j]; s += v[j].x * v[j].x + v[j].y * v[j].y + v[j].z * v[j].z + v[j].w * v[j].w; }
    s = wave_sum(s);
    const float r = rsqrtf(s * (1.f / D) + EPS);
    float4* o = (float4*)(out + (size_t)row * D);
#pragma unroll
    for (int j = 0; j < 4; ++j) { const float4 ww = ((const float4*)w)[lane + 64 * j]; float4 y; y.x = v[j].x * r * ww.x; y.y = v[j].y * r * ww.y; y.z = v[j].z * r * ww.z; y.w = v[j].w * r * ww.w; o[lane + 64 * j] = y; }
}

template <bool ADD>
__global__ void __launch_bounds__(256) k_gemm(const float* __restrict__ A, const float* __restrict__ B, const float* __restrict__ R, float* __restrict__ C, int M, int N, int K, int ldb) {
    __shared__ float As[16][68];
    __shared__ float Bs[16][68];
    const int tid = threadIdx.x, tx = tid & 15, ty = tid >> 4;
    const int row0 = blockIdx.y * 64, col0 = blockIdx.x * 64;
    float acc[4][4];
#pragma unroll
    for (int i = 0; i < 4; ++i)
#pragma unroll
        for (int j = 0; j < 4; ++j) acc[i][j] = 0.f;
    const int ar = tid >> 2, akq = tid & 3;
    const int bk = tid >> 4, bn = (tid & 15) * 4;
    for (int k0 = 0; k0 < K; k0 += 16) {
        const float4 av = *(const float4*)(A + (size_t)(row0 + ar) * K + k0 + akq * 4);
        float4 bv = make_float4(0.f, 0.f, 0.f, 0.f);
        if (col0 + bn < N) bv = *(const float4*)(B + (size_t)(k0 + bk) * ldb + col0 + bn);
        __syncthreads();
        As[akq * 4 + 0][ar] = av.x; As[akq * 4 + 1][ar] = av.y; As[akq * 4 + 2][ar] = av.z; As[akq * 4 + 3][ar] = av.w;
        *(float4*)&Bs[bk][bn] = bv;
        __syncthreads();
#pragma unroll
        for (int kk = 0; kk < 16; ++kk) {
            const float4 a = *(const float4*)&As[kk][ty * 4];
            const float4 b = *(const float4*)&Bs[kk][tx * 4];
            const float aa[4] = {a.x, a.y, a.z, a.w}, bb[4] = {b.x, b.y, b.z, b.w};
#pragma unroll
            for (int i = 0; i < 4; ++i)
#pragma unroll
                for (int j = 0; j < 4; ++j) acc[i][j] += aa[i] * bb[j];
        }
    }
    if (col0 + tx * 4 < N) {
#pragma unroll
        for (int i = 0; i < 4; ++i) {
            const size_t off = (size_t)(row0 + ty * 4 + i) * N + col0 + tx * 4;
            float4 o = make_float4(acc[i][0], acc[i][1], acc[i][2], acc[i][3]);
            if (ADD) { const float4 r = *(const float4*)(R + off); o.x += r.x; o.y += r.y; o.z += r.z; o.w += r.w; }
            *(float4*)(C + off) = o;
        }
    }
}

template <class P> __global__ void __launch_bounds__(256) k_gla_gate(const P proj, const float* __restrict__ w2, const float* __restrict__ bg, float* __restrict__ alpha) {
    const int t = blockIdx.x, c = threadIdx.x;
    float acc = bg[c];
#pragma unroll
    for (int r = 0; r < 16; ++r) acc += proj((size_t)t, C_GLR + r) * w2[r * 256 + c];
    alpha[(size_t)t * 256 + c] = expf(logsigmoid_f(acc) * (1.f / 16.f));
}

template <class P> __global__ void __launch_bounds__(128) k_gla_rec(const P proj, const float* __restrict__ alpha, float* __restrict__ mixed) {
    const int b = blockIdx.x >> 2, h = blockIdx.x & 3, dv = threadIdx.x;
    float S[64];
#pragma unroll
    for (int d = 0; d < 64; ++d) S[d] = 0.f;
    for (int t = 0; t < SEQ; ++t) {
        const size_t row = (size_t)b * SEQ + t;
        const float* al = alpha + row * 256 + h * 64;
        const float v = proj(row, C_V + h * 128 + dv);
        float o = 0.f;
#pragma unroll
        for (int d = 0; d < 64; ++d) {
            S[d] = al[d] * S[d] + proj(row, C_K + h * 64 + d) * v;
            o += proj(row, C_Q + h * 64 + d) * S[d];
        }
        mixed[row * D + h * 128 + dv] = o * 0.125f;
    }
}

template <class P> __global__ void __launch_bounds__(256) k_gla_finish(const P proj, const float* __restrict__ nw, float* __restrict__ mixed) {
    const int t = blockIdx.x, h = threadIdx.x >> 6, lane = threadIdx.x & 63;
    float* m = mixed + (size_t)t * D + h * 128;
    const float a = m[lane], b = m[lane + 64];
    const float s = wave_sum(a * a + b * b);
    const float r = rsqrtf(s * (1.f / 128.f) + EPS);
    m[lane] = a * r * nw[lane] * silu_f(proj((size_t)t, C_GOUT + h * 128 + lane));
    m[lane + 64] = b * r * nw[lane + 64] * silu_f(proj((size_t)t, C_GOUT + h * 128 + lane + 64));
}

template <class P> __global__ void __launch_bounds__(256) k_ssd_conv(const P proj, const float* __restrict__ cw, const float* __restrict__ cb, const float* __restrict__ dtb,
                                                  float* __restrict__ xc, float* __restrict__ dt) {
    const int t = blockIdx.x, l = t & (SEQ - 1);
    for (int c = threadIdx.x; c < 768; c += 256) {
        float acc = cb[c];
#pragma unroll
        for (int j = 0; j < 4; ++j) { const int ll = l - 3 + j; if (ll >= 0) acc += cw[j * 768 + c] * proj((size_t)(t - 3 + j), C_XBC + c); }
        xc[(size_t)t * 768 + c] = silu_f(acc);
    }
    if (threadIdx.x < 8) dt[(size_t)t * 8 + threadIdx.x] = softplus_f(proj((size_t)t, C_DT + threadIdx.x) + dtb[threadIdx.x]);
}

__global__ void __launch_bounds__(64) k_ssd_rec(const float* __restrict__ xc, const float* __restrict__ dt, const float* __restrict__ a_log, const float* __restrict__ dsk, float* __restrict__ mixed) {
    const int b = blockIdx.x >> 3, hd = blockIdx.x & 7, g = hd >> 2, p = threadIdx.x;
    const float A = -expf(a_log[hd]), Dk = dsk[hd];
    float hs[64];
#pragma unroll
    for (int n = 0; n < 64; ++n) hs[n] = 0.f;
    for (int t = 0; t < SEQ; ++t) {
        const size_t row = (size_t)b * SEQ + t;
        const float dtv = dt[row * 8 + hd];
        const float dA = expf(dtv * A);
        const float* xr = xc + row * 768;
        const float x = xr[hd * 64 + p], xdt = x * dtv;
        float y = 0.f;
#pragma unroll
        for (int n = 0; n < 64; ++n) {
            hs[n] = dA * hs[n] + xr[512 + g * 64 + n] * xdt;
            y += xr[640 + g * 64 + n] * hs[n];
        }
        mixed[row * D + 512 + hd * 64 + p] = y + x * Dk;
    }
}

template <class P> __global__ void __launch_bounds__(128) k_ssd_finish(const P proj, const float* __restrict__ nw, float* __restrict__ mixed) {
    const int t = blockIdx.x, g = threadIdx.x >> 6, lane = threadIdx.x & 63;
    float* m = mixed + (size_t)t * D + 512 + g * 256;
    float y[4]; float s = 0.f;
#pragma unroll
    for (int j = 0; j < 4; ++j) { y[j] = m[lane + 64 * j] * silu_f(proj((size_t)t, C_Z + g * 256 + lane + 64 * j)); s += y[j] * y[j]; }
    s = wave_sum(s);
    const float r = rsqrtf(s * (1.f / 256.f) + EPS);
#pragma unroll
    for (int j = 0; j < 4; ++j) m[lane + 64 * j] = y[j] * r * nw[g * 256 + lane + 64 * j];
}

__global__ void __launch_bounds__(256) k_topk(const float* __restrict__ q_lo, const float* __restrict__ q_hi, const float* __restrict__ subk, int* __restrict__ idx, float* __restrict__ gate) {
    __shared__ float s[256];
    __shared__ float ts[2][16];
    __shared__ int ti[2][16];
    __shared__ float cs[256];
    __shared__ float bs[16];
    __shared__ int be[16];
    const int t = blockIdx.x >> 3, h = blockIdx.x & 7, tid = threadIdx.x, p = tid >> 7, k = tid & 127;
    const float4* qv = (const float4*)((h < 4 ? q_lo : q_hi) + (size_t)t * 1024 + (h & 3) * 256 + p * 128);
    const float4* kr = (const float4*)(subk + (((size_t)h * 2 + p) * 128 + k) * 128);
    float acc = 0.f;
#pragma unroll 8
    for (int d = 0; d < 32; ++d) { const float4 a = qv[d], b = kr[d]; acc += a.x * b.x + a.y * b.y + a.z * b.z + a.w * b.w; }
    s[tid] = acc;
    __syncthreads();
    int r = 0;
    for (int j = 0; j < 128; ++j) { const float o = s[p * 128 + j]; r += (o > acc || (o == acc && j < k)) ? 1 : 0; }
    if (r < 16) { ts[p][r] = acc; ti[p][r] = k; }
    __syncthreads();
    const int i = tid >> 4, j2 = tid & 15;
    const float c = ts[0][i] + ts[1][j2];
    cs[tid] = c;
    __syncthreads();
    r = 0;
    for (int m = 0; m < 256; ++m) { const float o = cs[m]; r += (o > c || (o == c && m < tid)) ? 1 : 0; }
    if (r < 16) { bs[r] = c; be[r] = ti[0][i] * 128 + ti[1][j2]; }
    __syncthreads();
    if (tid < 16) {
        const float mx = bs[0];
        float den = 0.f;
#pragma unroll
        for (int m = 0; m < 16; ++m) den += expf(bs[m] - mx);
        gate[(size_t)t * 128 + h * 16 + tid] = expf(bs[tid] - mx) / den;
        idx[(size_t)t * 128 + h * 16 + tid] = be[tid];
    }
}

__global__ void __launch_bounds__(256) k_expert(const float* __restrict__ hres, const float* __restrict__ u, const float* __restrict__ v, const int* __restrict__ idx, const float* __restrict__ gate,
                                                const float* __restrict__ nfw, float* out) {
    __shared__ float hid[128];
    __shared__ int eid[128];
    __shared__ float red[4];
    const int t = blockIdx.x, tid = threadIdx.x, w = tid >> 6, lane = tid & 63;
    if (tid < 128) eid[tid] = idx[(size_t)t * 128 + tid];
    float4 xv[4];
#pragma unroll
    for (int j = 0; j < 4; ++j) xv[j] = ((const float4*)(out + (size_t)t * D))[lane + 64 * j];
    __syncthreads();
    for (int e = w * 32; e < w * 32 + 32; ++e) {
        const float4* ur = (const float4*)(u + (size_t)eid[e] * D);
        float s = 0.f;
#pragma unroll
        for (int j = 0; j < 4; ++j) { const float4 a = ur[lane + 64 * j]; s += a.x * xv[j].x + a.y * xv[j].y + a.z * xv[j].z + a.w * xv[j].w; }
        s = wave_sum(s);
        if (lane == 0) hid[e] = gelu_f(s) * gate[(size_t)t * 128 + e];
    }
    __syncthreads();
    float4 acc = ((const float4*)(hres + (size_t)t * D))[tid];
    for (int e = 0; e < 128; ++e) {
        const float4 vv = ((const float4*)(v + (size_t)eid[e] * D))[tid];
        const float hh = hid[e];
        acc.x += hh * vv.x; acc.y += hh * vv.y; acc.z += hh * vv.z; acc.w += hh * vv.w;
    }
    float ss = acc.x * acc.x + acc.y * acc.y + acc.z * acc.z + acc.w * acc.w;
    ss = wave_sum(ss);
    if (lane == 0) red[w] = ss;
    __syncthreads();
    const float tot = red[0] + red[1] + red[2] + red[3];
    const float r = rsqrtf(tot * (1.f / D) + EPS);
    const float4 ww = ((const float4*)nfw)[tid];
    float4 o; o.x = acc.x * r * ww.x; o.y = acc.y * r * ww.y; o.z = acc.z * r * ww.z; o.w = acc.w * r * ww.w;
    ((float4*)(out + (size_t)t * D))[tid] = o;
}
__global__ void __launch_bounds__(256) k_bf2f(const unsigned short* __restrict__ src, float* __restrict__ dst, size_t n) {
    for (size_t i = (size_t)blockIdx.x * 256 + threadIdx.x; i < n; i += (size_t)gridDim.x * 256) dst[i] = bf2f(src[i]);
}
}
extern "C" void kernel_launch(void* const* d_in, const int* in_sizes, int n_in, void* d_out, int out_size, void* d_ws, size_t ws_size, hipStream_t stream) {
    static int grid = 0;
    if (grid == 0) {
        if (n_in != 19 || out_size != T * D || ws_size < 256 * MiB) { fprintf(stderr, "kernel_launch: unexpected shapes n_in %d out %d ws %zu\n", n_in, out_size, ws_size); grid = -1; return; }
        int dev = 0, cus = 0, per_cu = 0;
        if (hipGetDevice(&dev) != hipSuccess || hipDeviceGetAttribute(&cus, hipDeviceAttributeMultiprocessorCount, dev) != hipSuccess) { grid = -1; return; }
        if (hipFuncSetAttribute((const void*)fwd, hipFuncAttributeMaxDynamicSharedMemorySize, LDS_BYTES) != hipSuccess) { fprintf(stderr, "kernel_launch: hipFuncSetAttribute failed\n"); grid = -1; return; }
        if (hipOccupancyMaxActiveBlocksPerMultiprocessor(&per_cu, (const void*)fwd, NWAVES * 64, LDS_BYTES) != hipSuccess || per_cu < 1) { fprintf(stderr, "kernel_launch: occupancy query says %d\n", per_cu); }
        (void)hipGetLastError();
        grid = cus;
    }
    if (grid < 0) return;
    const float* x = (const float*)d_in[0];
    const float* gla_w2 = (const float*)d_in[3];
    const float* gla_bg = (const float*)d_in[4];
    const float* gla_nw = (const float*)d_in[5];
    const float* conv_w = (const float*)d_in[6];
    const float* conv_b = (const float*)d_in[7];
    const float* dt_bias = (const float*)d_in[8];
    const float* a_log = (const float*)d_in[9];
    const float* d_skip = (const float*)d_in[10];
    const float* ssd_nw = (const float*)d_in[11];
    const float* w_out = (const float*)d_in[12];
    const float* norm_ffn_w = (const float*)d_in[13];
    const float* w_query = (const float*)d_in[14];
    const float* sub_keys = (const float*)d_in[15];
    const float* pu = (const float*)d_in[16];
    const float* pv = (const float*)d_in[17];
    const float* norm_final_w = (const float*)d_in[18];
    float* out = (float*)d_out;
    char* ws = (char*)d_ws;

    (void)hipMemsetAsync(ws + WS_CTL, 0, CTL_ZERO_BYTES, stream);
    Args a{};
    for (int i = 0; i < 19; ++i) a.in[i] = (const float*)d_in[i];
    a.out = out; a.ws = (unsigned char*)d_ws; a.ph_lo = 0; a.ph_hi = 9;
    hipLaunchKernelGGL(fwd, dim3(grid), dim3(NWAVES * 64), LDS_BYTES, stream, a);

}
```

```cpp
#include <hip/hip_runtime.h>
#include <cstdio>
#include <cstdint>
namespace pg8 {
#define PG8_LAS __attribute__((address_space(3)))
typedef unsigned short bf16_t;
typedef short bf16x8 __attribute__((ext_vector_type(8)));
typedef float f32x4 __attribute__((ext_vector_type(4)));
typedef unsigned u32x4 __attribute__((ext_vector_type(4)));
constexpr int BM = 256, BK = 64, HALF = 128, HTB = HALF * BK * 2  , STAGE_BYTES = 8 * HTB, NXCD = 8, WGM = 8;

__host__ __device__ __forceinline__ int lds_byte(int r, int c) { const int st = (r >> 4) * 2 + (c >> 5), rr = r & 15, cc = c & 31, ob = rr * 64 + cc * 2; return st * 1024 + (ob ^ (((ob >> 9) & 1) << 5)); }
__host__ __device__ __forceinline__ void stage_rc(int b, int& R, int& C) { const int st = b / 1024, sb = b % 1024, swz = sb ^ (((sb >> 9) & 1) << 5); R = (st >> 1) * 16 + swz / 64; C = (st & 1) * 32 + (swz % 64) / 2; }
__host__ __device__ __forceinline__ int perm32(int rho) { const int n = rho >> 4, i = rho & 15; return 8 * (i >> 2) + 4 * n + (i & 3); }

struct Unit { int pm, pn; };
struct Gemm { const bf16_t* A; const bf16_t* Bt; int M, N, K; };

struct StaticOrder {
    int nM, nN, nwg, G, c;
    __host__ __device__ void init(int M, int N, int G_, int c_) { nM = M / BM; nN = N / BM; nwg = nM * nN; G = G_; c = c_; }
    __host__ __device__ bool next(int i, Unit& u) const {
        const long L = (long)i * G + c; if (L >= nwg) return false;
        int wgid = (int)L; { const int q = nwg / NXCD, r = nwg % NXCD, xcd = wgid % NXCD, off = wgid / NXCD; wgid = (xcd < r ? xcd * (q + 1) : r * (q + 1) + (xcd - r) * q) + off; }
        const int nig = WGM * nN, gid = wgid / nig, fm = gid * WGM, gsz = (nM - fm) < WGM ? (nM - fm) : WGM;
        u.pm = fm + ((wgid % nig) % gsz); u.pn = (wgid % nig) / gsz; return true;
    }
    __device__ __forceinline__ void a_ready(const Unit&) const {}
    __device__ __forceinline__ void done(const Unit&) const {}
};

__device__ __forceinline__ unsigned cvt_pk_bf16(float lo, float hi) { unsigned r; asm volatile("v_cvt_pk_bf16_f32 %0, %1, %2" : "=v"(r) : "v"(lo), "v"(hi)); return r; }
typedef float f32x2 __attribute__((ext_vector_type(2)));
struct EpiRowScaleBf16 {
    static constexpr bool PERM = true, AFTER_DRAIN = false;
    bf16_t* O; int ldc; const float* rs;
    __device__ __forceinline__ void operator()(const f32x4 (&acc)[2][2][4][2], const Unit& u, int wr, int wc, int fr, int fq) const {
        const int row0 = u.pm * BM + wr * 64 + fr, col0 = u.pn * BM + wc * 32 + 8 * fq;
#pragma unroll
        for (int ai = 0; ai < 2; ++ai)
#pragma unroll
            for (int m = 0; m < 4; ++m) { const int row = row0 + ai * HALF + m * 16; const float sc = rs[row]; bf16_t* rowp = O + (size_t)row * ldc + col0;
#pragma unroll
                for (int bj = 0; bj < 2; ++bj) { const f32x4 v0 = acc[ai][bj][m][0] * sc, v1 = acc[ai][bj][m][1] * sc;
                    u32x4 w; w.x = cvt_pk_bf16(v0[0], v0[1]); w.y = cvt_pk_bf16(v0[2], v0[3]); w.z = cvt_pk_bf16(v1[0], v1[1]); w.w = cvt_pk_bf16(v1[2], v1[3]);
                    *(u32x4*)(rowp + bj * HALF) = w; } }
    }
};
struct EpiRsqScaleBf16 {
    static constexpr bool PERM = true, AFTER_DRAIN = false;
    bf16_t* O; int ldc; const float* rowsq;
    __device__ __forceinline__ void operator()(const f32x4 (&acc)[2][2][4][2], const Unit& u, int wr, int wc, int fr, int fq) const {
        const int row0 = u.pm * BM + wr * 64 + fr, col0 = u.pn * BM + wc * 32 + 8 * fq;
#pragma unroll
        for (int ai = 0; ai < 2; ++ai)
#pragma unroll
            for (int m = 0; m < 4; ++m) { const int row = row0 + ai * HALF + m * 16; const float sc = rsqrtf(rowsq[row] * (1.f / 1024.f) + 1e-6f); bf16_t* rowp = O + (size_t)row * ldc + col0;
#pragma unroll
                for (int bj = 0; bj < 2; ++bj) { const f32x4 v0 = acc[ai][bj][m][0] * sc, v1 = acc[ai][bj][m][1] * sc;
                    u32x4 w; w.x = cvt_pk_bf16(v0[0], v0[1]); w.y = cvt_pk_bf16(v0[2], v0[3]); w.z = cvt_pk_bf16(v1[0], v1[1]); w.w = cvt_pk_bf16(v1[2], v1[3]);
                    *(u32x4*)(rowp + bj * HALF) = w; } }
    }
};
struct EpiResidual {
    static constexpr bool PERM = true, AFTER_DRAIN = false;
    const float* X; float* H; bf16_t* HB; float* rowsq; int ldc;
    __device__ __forceinline__ void operator()(const f32x4 (&acc)[2][2][4][2], const Unit& u, int wr, int wc, int fr, int fq) const {
        const int row0 = u.pm * BM + wr * 64 + fr, col0 = u.pn * BM + wc * 32 + 8 * fq;
#pragma unroll
        for (int ai = 0; ai < 2; ++ai)
#pragma unroll
            for (int m = 0; m < 4; ++m) { const int row = row0 + ai * HALF + m * 16; float ss = 0.f;
#pragma unroll
                for (int bj = 0; bj < 2; ++bj) { const size_t off = (size_t)row * ldc + col0 + bj * HALF;
                    const f32x4 v0 = acc[ai][bj][m][0] + *(const f32x4*)(X + off), v1 = acc[ai][bj][m][1] + *(const f32x4*)(X + off + 4);
                    *(f32x4*)(H + off) = v0; *(f32x4*)(H + off + 4) = v1;
                    u32x4 w; w.x = cvt_pk_bf16(v0[0], v0[1]); w.y = cvt_pk_bf16(v0[2], v0[3]); w.z = cvt_pk_bf16(v1[0], v1[1]); w.w = cvt_pk_bf16(v1[2], v1[3]);
                    *(u32x4*)(HB + off) = w;
                    ss += (v0[0] * v0[0] + v0[1] * v0[1]) + (v0[2] * v0[2] + v0[3] * v0[3]) + (v1[0] * v1[0] + v1[1] * v1[1]) + (v1[2] * v1[2] + v1[3] * v1[3]); }
                ss += __shfl_xor(ss, 16); ss += __shfl_xor(ss, 32);
                if (fq == 0) atomicAdd(rowsq + row, ss); }
    }
};
template <class Epi, class Sched, bool ALIGN_EPI = false, bool SP2 = false>
__device__ __forceinline__ void gemm_phase(PG8_LAS unsigned char* lds, const Gemm g, const Sched& S, const Epi& E) {
    const int tid = threadIdx.x, wid = __builtin_amdgcn_readfirstlane(tid >> 6), lane = tid & 63, wr = wid >> 2, wc = wid & 3, fr = lane & 15, fq = lane >> 4;
    const int K = g.K, nt = K / BK;
    unsigned voffA[2], voffB[2];
#pragma unroll
    for (int i = 0; i < 2; ++i) { int R, C; stage_rc(tid * 16 + i * 8192, R, C); const int Rb = Epi::PERM ? ((R & ~31) + perm32(R & 31)) : R;
        voffA[i] = (unsigned)(R * K + C) * 2u; voffB[i] = (unsigned)(Rb * K + C) * 2u; }
    const size_t kstep = (size_t)(BK * 2);
    const size_t hstep = (size_t)HALF * K * 2;
    const size_t tstep = 2 * hstep;
    const unsigned ldsw = (unsigned)wid * 1024u;
    const int aoff = lds_byte(wr * 64 + fr, fq * 8), boff = lds_byte(wc * 32 + fr, fq * 8);
#define PG8_SA(b, h) (((b) * 2 + (h)) * HTB)
#define PG8_SB(b, h) ((4 + (b) * 2 + (h)) * HTB)
#define PG8_STAGE(bufoff, gbase, voff) do { _Pragma("unroll") for (int _i = 0; _i < 2; ++_i) \
        __builtin_amdgcn_global_load_lds((const unsigned*)((const char*)(gbase) + (voff)[_i]), (PG8_LAS unsigned*)(lds + (bufoff) + ldsw + _i * 8192), 16, 0, 0); } while (0)
#define PG8_LDA(dst, b, h) do { _Pragma("unroll") for (int m = 0; m < 4; ++m) _Pragma("unroll") for (int k = 0; k < 2; ++k) dst[m][k] = *(const PG8_LAS bf16x8*)(lds + PG8_SA(b, h) + aoff + m * 2048 + k * 1024); } while (0)
#define PG8_LDB(dst, b, h) do { _Pragma("unroll") for (int n = 0; n < 2; ++n) _Pragma("unroll") for (int k = 0; k < 2; ++k) dst[n][k] = *(const PG8_LAS bf16x8*)(lds + PG8_SB(b, h) + boff + n * 2048 + k * 1024); } while (0)
#define PG8_MMA(ai, bj, At, Bt) do { __builtin_amdgcn_s_setprio(1); _Pragma("unroll") for (int m = 0; m < 4; ++m) _Pragma("unroll") for (int n = 0; n < 2; ++n) _Pragma("unroll") for (int k = 0; k < 2; ++k) \
        acc[ai][bj][m][n] = __builtin_amdgcn_mfma_f32_16x16x32_bf16(Bt[n][k], At[m][k], acc[ai][bj][m][n], 0, 0, 0); __builtin_amdgcn_s_setprio(0); } while (0)
#define PG8_WAIT_V(n) asm volatile("s_waitcnt vmcnt(" #n ")" ::: "memory")
#define PG8_WAIT_L(n) asm volatile("s_waitcnt lgkmcnt(" #n ")" ::: "memory")
#define PG8_BAR __builtin_amdgcn_s_barrier()
#define PG8_SCHED __builtin_amdgcn_sched_barrier(0)
    Unit cur, nxt; int ui = 0;
    if (!S.next(0, cur)) return;
    f32x4 acc[2][2][4][2];
#pragma unroll
    for (int a = 0; a < 2; ++a)
#pragma unroll
        for (int b = 0; b < 2; ++b)
#pragma unroll
            for (int m = 0; m < 4; ++m)
#pragma unroll
                for (int n = 0; n < 2; ++n) acc[a][b][m][n] = (f32x4){0.f, 0.f, 0.f, 0.f};
    bf16x8 At[4][2], B0[2][2], B1[2][2];
    const char* cA = (const char*)g.A + (size_t)cur.pm * tstep; const char* cB = (const char*)g.Bt + (size_t)cur.pn * tstep;
    S.a_ready(cur);
    if constexpr (SP2) {
        PG8_STAGE(PG8_SB(0, 0), cB, voffB); PG8_STAGE(PG8_SB(0, 1), cB + hstep, voffB); PG8_STAGE(PG8_SA(0, 0), cA, voffA); PG8_STAGE(PG8_SA(0, 1), cA + hstep, voffA);
        if (wr == 1) PG8_BAR;
        PG8_WAIT_V(2); PG8_BAR;
        PG8_STAGE(PG8_SB(1, 0), cB + kstep, voffB); PG8_STAGE(PG8_SA(1, 0), cA + kstep, voffA); PG8_STAGE(PG8_SB(1, 1), cB + hstep + kstep, voffB);
        PG8_WAIT_V(6); PG8_BAR;
    } else {
        PG8_STAGE(PG8_SB(0, 0), cB, voffB); PG8_STAGE(PG8_SA(0, 0), cA, voffA); PG8_STAGE(PG8_SB(0, 1), cB + hstep, voffB); PG8_STAGE(PG8_SA(0, 1), cA + hstep, voffA);
        if (wr == 1) PG8_BAR;
        PG8_WAIT_V(4); PG8_BAR;
        PG8_STAGE(PG8_SB(1, 0), cB + kstep, voffB); PG8_STAGE(PG8_SA(1, 0), cA + kstep, voffA); PG8_STAGE(PG8_SB(1, 1), cB + hstep + kstep, voffB);
        PG8_WAIT_V(6); PG8_BAR;
    }
    for (;;) {
        const bool has_next = S.next(ui + 1, nxt);
        const char* nA = has_next ? (const char*)g.A + (size_t)nxt.pm * tstep : cA; const char* nB = has_next ? (const char*)g.Bt + (size_t)nxt.pn * tstep : cB;
        for (int t = 0; t < nt; t += 2) {
            const bool last = (t == nt - 2);
            const char* a1 = cA + (size_t)(t + 1) * kstep;
            const char* a2 = last ? nA : cA + (size_t)(t + 2) * kstep; const char* b2 = last ? nB : cB + (size_t)(t + 2) * kstep;
            const char* a3 = a2 + kstep; const char* b3 = b2 + kstep;
            if (last && has_next) S.a_ready(nxt);
            if constexpr (SP2) {
            PG8_LDB(B0, 0, 0); PG8_LDB(B1, 0, 1); PG8_SCHED; PG8_LDA(At, 0, 0); PG8_STAGE(PG8_SA(1, 1), a1 + hstep, voffA);
            PG8_WAIT_V(8); PG8_WAIT_L(0); PG8_BAR; PG8_MMA(0, 0, At, B0); PG8_MMA(0, 1, At, B1); PG8_BAR; PG8_SCHED;
            PG8_LDA(At, 0, 1); PG8_STAGE(PG8_SB(0, 0), b2, voffB); PG8_STAGE(PG8_SB(0, 1), b2 + hstep, voffB); PG8_STAGE(PG8_SA(0, 0), a2, voffA);
            PG8_WAIT_V(8); PG8_WAIT_L(0); PG8_BAR; PG8_MMA(1, 0, At, B0); PG8_MMA(1, 1, At, B1); PG8_BAR; PG8_SCHED;
            PG8_LDB(B0, 1, 0); PG8_LDB(B1, 1, 1); PG8_SCHED; PG8_LDA(At, 1, 0); PG8_STAGE(PG8_SA(0, 1), a2 + hstep, voffA);
            PG8_WAIT_V(8); PG8_WAIT_L(0); PG8_BAR; PG8_MMA(0, 0, At, B0); PG8_MMA(0, 1, At, B1); PG8_BAR; PG8_SCHED;
            PG8_LDA(At, 1, 1); PG8_STAGE(PG8_SB(1, 0), b3, voffB); PG8_STAGE(PG8_SB(1, 1), b3 + hstep, voffB); PG8_STAGE(PG8_SA(1, 0), a3, voffA);
            PG8_WAIT_V(8); PG8_WAIT_L(0); PG8_BAR; PG8_MMA(1, 0, At, B0); PG8_MMA(1, 1, At, B1); PG8_BAR; PG8_SCHED;
            } else {
            PG8_LDB(B0, 0, 0); PG8_SCHED; PG8_LDA(At, 0, 0); PG8_STAGE(PG8_SA(1, 1), a1 + hstep, voffA);
            PG8_WAIT_L(8); PG8_BAR; PG8_WAIT_L(0); PG8_MMA(0, 0, At, B0); PG8_BAR; PG8_SCHED;
            PG8_LDB(B1, 0, 1); PG8_STAGE(PG8_SB(0, 0), b2, voffB);
            PG8_BAR; PG8_WAIT_L(0); PG8_MMA(0, 1, At, B1); PG8_BAR;
            PG8_LDA(At, 0, 1); PG8_STAGE(PG8_SA(0, 0), a2, voffA);
            PG8_BAR; PG8_WAIT_L(0); PG8_MMA(1, 0, At, B0); PG8_BAR; PG8_SCHED;
            PG8_STAGE(PG8_SB(0, 1), b2 + hstep, voffB);
            PG8_WAIT_V(6); PG8_BAR; PG8_MMA(1, 1, At, B1); PG8_BAR;
            PG8_LDB(B0, 1, 0); PG8_SCHED; PG8_LDA(At, 1, 0); PG8_STAGE(PG8_SA(0, 1), a2 + hstep, voffA);
            PG8_WAIT_L(8); PG8_BAR; PG8_WAIT_L(0); PG8_MMA(0, 0, At, B0); PG8_BAR; PG8_SCHED;
            PG8_LDB(B1, 1, 1); PG8_STAGE(PG8_SB(1, 0), b3, voffB);
            PG8_BAR; PG8_WAIT_L(0); PG8_MMA(0, 1, At, B1); PG8_BAR;
            PG8_LDA(At, 1, 1); PG8_STAGE(PG8_SA(1, 0), a3, voffA);
            PG8_BAR; PG8_WAIT_L(0); PG8_MMA(1, 0, At, B0); PG8_BAR; PG8_SCHED;
            PG8_STAGE(PG8_SB(1, 1), b3 + hstep, voffB);
            PG8_WAIT_V(6); PG8_BAR; PG8_MMA(1, 1, At, B1); PG8_BAR;
            }
        }
        if constexpr (ALIGN_EPI) { if (wr == 0) PG8_BAR; }
        if constexpr (!Epi::AFTER_DRAIN) { E(acc, cur, wr, wc, fr, fq); S.done(cur); }
        if (!has_next) break;
#pragma unroll
        for (int a = 0; a < 2; ++a)
#pragma unroll
            for (int b = 0; b < 2; ++b)
#pragma unroll
                for (int m = 0; m < 4; ++m)
#pragma unroll
                    for (int n = 0; n < 2; ++n) acc[a][b][m][n] = (f32x4){0.f, 0.f, 0.f, 0.f};
        cur = nxt; cA = nA; cB = nB; ++ui;
        if constexpr (ALIGN_EPI) { if (wr == 1) PG8_BAR; }
    }
    PG8_WAIT_V(0);
    if constexpr (!ALIGN_EPI) { if (wr == 0) PG8_BAR; }
    PG8_BAR;
    if constexpr (Epi::AFTER_DRAIN) { E.fused(acc, cur, wr, wc, fr, fq, lds, wid, lane); S.done(cur); }
#undef PG8_SA
#undef PG8_SB
#undef PG8_STAGE
#undef PG8_LDA
#undef PG8_LDB
#undef PG8_MMA
#undef PG8_WAIT_V
#undef PG8_WAIT_L
#undef PG8_BAR
#undef PG8_SCHED
}
}
constexpr int NWAVES = 8;
constexpr int T = 16384, SEQ = 8192, D = 1024, NIN = 2840, NINP = 3072, NQ = 2048;
constexpr int C_Q = 0, C_K = 256, C_V = 512, C_GLR = 1024, C_GOUT = 1040, C_Z = 1552, C_XBC = 2064, C_DT = 2832;
constexpr float EPS = 1e-6f;
constexpr size_t MiB = 1u << 20;
constexpr size_t WS_CTL = 0, CTL_ZERO_BYTES = 64 * 1024;
constexpr size_t WS_WIN = 1 * MiB;
constexpr size_t WS_WO = 7 * MiB;
constexpr size_t WS_WQ = 9 * MiB;
constexpr size_t WS_SUBK = 13 * MiB;
constexpr size_t WS_RRMS1 = 14 * MiB;
constexpr size_t WS_ROWSQ2 = 14 * MiB + 64 * 1024;
constexpr size_t WS_UB = 16 * MiB, WS_VB = 48 * MiB;
constexpr size_t WS_XB = 80 * MiB;
constexpr size_t WS_PROJ = 112 * MiB;
constexpr int CW_TMO = 0, CW_BAR = 1024;
constexpr int RING_OFF = 0, RING_BYTES = 131072;
constexpr int LDSCTL_OFF = RING_BYTES, MISC_OFF = LDSCTL_OFF + 320;
constexpr int LDS_BYTES = 147456;

#define GAS __attribute__((address_space(1)))
#define LAS __attribute__((address_space(3)))
typedef unsigned short bf16;
typedef unsigned v4u __attribute__((ext_vector_type(4)));
typedef float f32x4 __attribute__((ext_vector_type(4)));
typedef short bf16x8 __attribute__((ext_vector_type(8)));
typedef GAS unsigned gu32;
#define RLX_AGENT __ATOMIC_RELAXED, __HIP_MEMORY_SCOPE_AGENT
#define LDS_WAIT() asm volatile("s_waitcnt lgkmcnt(0)" ::: "memory")
#define VM_WAIT() asm volatile("s_waitcnt vmcnt(0)" ::: "memory")
__device__ __forceinline__ unsigned f2bf(float f) { unsigned u = __builtin_bit_cast(unsigned, f); return (u + 0x7fffu + ((u >> 16) & 1u)) >> 16; }
__device__ __forceinline__ unsigned pk2(float lo, float hi) { return f2bf(lo) | (f2bf(hi) << 16); }
__device__ __forceinline__ float bf2f(unsigned short b) { return __builtin_bit_cast(float, (unsigned)b << 16); }
__device__ __forceinline__ float wave_sum(float v) {
#pragma unroll
    for (int o = 1; o < 64; o <<= 1) v += __shfl_xor(v, o);
    return v;
}
#define XB_TMO      128
#define XB_XCNT(j)  (256  + 64 * (j))
#define XB_XSUB(j)  (1280 + 64 * (j))
#define XB_XGEN(j)  (2304 + 64 * (j))
#define XB_TOP      3328
#define XB_TOPGEN   3392
#define XCD_BAR_WORDS 3456
#define XB_SPIN_CAP (1u << 18)

__device__ __forceinline__ unsigned xb_ld(unsigned* p)              { return __hip_atomic_load(p, __ATOMIC_RELAXED, __HIP_MEMORY_SCOPE_AGENT); }
__device__ __forceinline__ unsigned xb_add(unsigned* p, unsigned v) { return __hip_atomic_fetch_add(p, v, __ATOMIC_RELAXED, __HIP_MEMORY_SCOPE_AGENT); }
__device__ __forceinline__ unsigned xb_xcc_id() { return (unsigned)__builtin_amdgcn_s_getreg((3 << 11) | 20) & 0xFu; }
#define XB_SPIN(cond, bar) do { unsigned _sp = 0; while (cond) { __builtin_amdgcn_s_sleep(1); \
    if ((++_sp & 255u) == 0u) { if (xb_ld(&(bar)[XB_TMO])) break; if (_sp > XB_SPIN_CAP) { atomicAdd(&(bar)[XB_TMO], 1u); break; } } } } while (0)

struct XcdBarrier {
    unsigned* bar; unsigned x;
    volatile LAS unsigned* st;
};

__device__ __forceinline__ XcdBarrier xcd_barrier_post(unsigned* bar, volatile LAS unsigned* st) {
    XcdBarrier b; b.bar = bar; b.x = xb_xcc_id(); b.st = st;
    if (threadIdx.x == 0) (void)xb_add(&bar[XB_XCNT(b.x)], 1u);
    return b;
}
__device__ __forceinline__ void xcd_barrier_complete(unsigned* bar, unsigned x, unsigned& nloc, unsigned& nx) {
    const unsigned G = gridDim.x * gridDim.y * gridDim.z;
    unsigned sum, cnt, mine, sp = 0u;
    for (;;) {
        sum = 0u; cnt = 0u; mine = 0u;
#pragma unroll
        for (unsigned j = 0; j < 16; ++j) { const unsigned c = xb_ld(&bar[XB_XCNT(j)]); sum += c; cnt += (c > 0u) ? 1u : 0u; mine = (j == x) ? c : mine; }
        if (sum == G) break;
        __builtin_amdgcn_s_sleep(1);
        if ((++sp & 255u) == 0u) { if (xb_ld(&bar[XB_TMO])) break; if (sp > XB_SPIN_CAP) { atomicAdd(&bar[XB_TMO], 1u); break; } }
    }
    nloc = mine > 0u ? mine : 1u; nx = cnt > 0u ? cnt : 1u;
}

__device__ __forceinline__ void xcd_barrier(const XcdBarrier& b) {
    asm volatile("s_waitcnt vmcnt(0)" ::: "memory");
    __syncthreads();
    if (threadIdx.x == 0) {
        unsigned* bar = b.bar;
        __builtin_amdgcn_s_waitcnt(0);
        unsigned nloc = b.st[0], nx = b.st[1];
        if (nloc == 0u) { xcd_barrier_complete(bar, b.x, nloc, nx); b.st[0] = nloc; b.st[1] = nx; }
        const unsigned old = xb_add(&bar[XB_XSUB(b.x)], 1u);
        const unsigned gen = old / nloc;
        if (old + 1u == (gen + 1u) * nloc) {
            __builtin_amdgcn_fence(__ATOMIC_RELEASE, "agent");
            asm volatile("s_waitcnt vmcnt(0)" ::: "memory");
            const unsigned og = xb_add(&bar[XB_TOP], 1u);
            const unsigned tg = og / nx;
            if (og + 1u == (tg + 1u) * nx) xb_add(&bar[XB_TOPGEN], 1u);
            else XB_SPIN(xb_ld(&bar[XB_TOPGEN]) == tg, bar);
            __builtin_amdgcn_fence(__ATOMIC_ACQUIRE, "agent");
            xb_add(&bar[XB_XGEN(b.x)], 1u);
            asm volatile("s_waitcnt vmcnt(0)" ::: "memory");
        } else {
            XB_SPIN(xb_ld(&bar[XB_XGEN(b.x)]) == gen, bar);
            __builtin_amdgcn_fence(__ATOMIC_ACQUIRE, "agent");
            asm volatile("s_waitcnt vmcnt(0)" ::: "memory");
        }
    }
    __syncthreads();
}
struct Args {
    const float* in[19]; float* out; unsigned char* ws; int ph_lo, ph_hi;
};
struct Frame {
    LAS unsigned char* lds; volatile LAS unsigned* MISC; gu32* ctl;
    int tid, lane, wave, G, gw, NGW;
};

constexpr size_t WS_GDEC = 14 * MiB + 128 * 1024;
constexpr size_t WS_SDEC = 14 * MiB + 512 * 1024;
constexpr size_t WS_GST = 208 * MiB;
constexpr size_t WS_SST = 224 * MiB;
constexpr int SA64 = 144, SA128 = 272, SA32 = 80;

__device__ __forceinline__ float silu_f(float x) { return x / (1.f + __expf(-x)); }
__device__ __forceinline__ float softplus_f(float x) { return fmaxf(x, 0.f) + log1pf(__expf(-fabsf(x))); }
__device__ __forceinline__ float logsigmoid_f(float x) { return fminf(x, 0.f) - log1pf(__expf(-fabsf(x))); }
typedef unsigned u32x2 __attribute__((ext_vector_type(2)));

__device__ __forceinline__ f32x4 mma16(const LAS unsigned char* A, int sa, const LAS unsigned char* Bt, int sb, int K, f32x4 acc, int r, int kg) {
    for (int k0 = 0; k0 < K; k0 += 32) {
        const bf16x8 a = *(const LAS bf16x8*)(A + r * sa + (k0 + 8 * kg) * 2);
        const bf16x8 b = *(const LAS bf16x8*)(Bt + r * sb + (k0 + 8 * kg) * 2);
        acc = __builtin_amdgcn_mfma_f32_16x16x32_bf16(a, b, acc, 0, 0, 0);
    }
    return acc;
}

template <int MODE>
__device__ __forceinline__ void gla_unit(const Frame& F, const Args& A, int unit) {
    const int b = unit >> 9, c = (unit >> 2) & 127, h = unit & 3;
    const size_t t0 = (size_t)b * SEQ + (size_t)c * 64;
    const GAS bf16* proj = (const GAS bf16*)(A.ws + WS_PROJ);
    LAS unsigned char* L = F.lds;
    LAS float* GLR = (LAS float*)(L + 0);
    LAS float* SEG = (LAS float*)(L + 4096);
    LAS float* RSQ = (LAS float*)(L + 6144);
    LAS unsigned char* QI = L + 8192;
    LAS unsigned char* KI = QI + 64 * SA64;
    LAS unsigned char* VT = KI + 64 * SA64;
    LAS unsigned char* SP = VT + 128 * SA64;
    LAS unsigned char* AT = SP + 128 * SA64;
    int tid = F.tid, seg = F.wave;
    asm volatile("" : "+v"(tid)); asm volatile("" : "+s"(seg));
    const int d = tid & 63;
    for (int e = tid; e < 64 * 16; e += 512) { const int i = e >> 4, r = e & 15; GLR[e] = bf2f(proj[(t0 + i) * NINP + C_GLR + r]); }
    {
        const int dv = tid & 127, js = tid >> 7; unsigned w[8];
#pragma unroll
        for (int jj = 0; jj < 8; ++jj) { const unsigned lo = proj[(t0 + js * 16 + 2 * jj) * NINP + C_V + h * 128 + dv], hi = proj[(t0 + js * 16 + 2 * jj + 1) * NINP + C_V + h * 128 + dv]; w[jj] = lo | (hi << 16); }
        *(LAS v4u*)(VT + dv * SA64 + js * 32) = (v4u){w[0], w[1], w[2], w[3]};
        *(LAS v4u*)(VT + dv * SA64 + js * 32 + 16) = (v4u){w[4], w[5], w[6], w[7]};
    }
    if (MODE == 1) {
        const GAS bf16* sp = (const GAS bf16*)(A.ws + WS_GST) + (size_t)unit * 8192;
        for (int e = tid; e < 1024; e += 512) { const int row = e >> 3, ch = e & 7; *(LAS v4u*)(SP + row * SA64 + ch * 16) = *(const GAS v4u*)(sp + row * 64 + ch * 8); }
    }
    float wv[16];
#pragma unroll
    for (int r = 0; r < 16; ++r) wv[r] = A.in[3][r * 256 + h * 64 + d];
    const float bgv = A.in[4][h * 64 + d];
    __syncthreads();
    float Gv[8]; float run = 0.f;
#pragma unroll
    for (int ii = 0; ii < 8; ++ii) { const int i = seg * 8 + ii; float z = bgv;
#pragma unroll
        for (int r = 0; r < 16; ++r) z += GLR[i * 16 + r] * wv[r];
        run += logsigmoid_f(z) * (1.f / 16.f); Gv[ii] = run; }
    SEG[seg * 64 + d] = run;
    __syncthreads();
    float off = 0.f, tot = 0.f;
#pragma unroll
    for (int s = 0; s < 8; ++s) { const float v = SEG[s * 64 + d]; tot += v; off += (s < seg) ? v : 0.f; }
#pragma unroll
    for (int ii = 0; ii < 8; ++ii) Gv[ii] += off;
    if (MODE == 0) {
        unsigned w[4];
#pragma unroll
        for (int ii = 0; ii < 8; ii += 2) {
            const float k0 = bf2f(proj[(t0 + seg * 8 + ii) * NINP + C_K + h * 64 + d]) * __expf(tot - Gv[ii]);
            const float k1 = bf2f(proj[(t0 + seg * 8 + ii + 1) * NINP + C_K + h * 64 + d]) * __expf(tot - Gv[ii + 1]);
            w[ii >> 1] = pk2(k0, k1); }
        *(LAS v4u*)(QI + d * SA64 + seg * 16) = (v4u){w[0], w[1], w[2], w[3]};
        if (seg == 0) ((GAS float*)(A.ws + WS_GDEC))[unit * 64 + d] = __expf(tot);
    } else {
#pragma unroll
        for (int ii = 0; ii < 8; ++ii) { const int i = seg * 8 + ii;
            const float qv = bf2f(proj[(t0 + i) * NINP + C_Q + h * 64 + d]) * 0.125f * __expf(Gv[ii]);
            const float kv = bf2f(proj[(t0 + i) * NINP + C_K + h * 64 + d]) * __expf(-Gv[ii]);
            *(LAS bf16*)(QI + i * SA64 + d * 2) = (bf16)f2bf(qv); *(LAS bf16*)(KI + i * SA64 + d * 2) = (bf16)f2bf(kv); }
    }
    __syncthreads();
    const int r = tid & 15, kg = (tid >> 4) & 3, w = seg;
    const f32x4 zero = (f32x4){0.f, 0.f, 0.f, 0.f};
    if (MODE == 0) {
        const int mt = w & 3, nb = (w >> 2) * 4;
        GAS bf16* stT = (GAS bf16*)(A.ws + WS_GST) + (size_t)unit * 8192;
#pragma unroll
        for (int n = 0; n < 4; ++n) {
            const f32x4 acc = mma16(QI + mt * 16 * SA64, SA64, VT + (nb + n) * 16 * SA64, SA64, 64, zero, r, kg);
            const int dv = (nb + n) * 16 + r, d0 = mt * 16 + kg * 4;
            *(GAS u32x2*)(stT + dv * 64 + d0) = (u32x2){pk2(acc[0], acc[1]), pk2(acc[2], acc[3])}; }
    } else {
        const int mt = w & 3;
#pragma unroll
        for (int n = 0; n < 2; ++n) { const int nt = (w >> 2) * 2 + n;
            const f32x4 acc = mma16(QI + mt * 16 * SA64, SA64, KI + nt * 16 * SA64, SA64, 64, zero, r, kg);
#pragma unroll
            for (int ii = 0; ii < 4; ++ii) { const int i = mt * 16 + kg * 4 + ii, j = nt * 16 + r; *(LAS bf16*)(AT + i * SA64 + j * 2) = (bf16)f2bf(j <= i ? acc[ii] : 0.f); } }
        __syncthreads();
        const int nb = (w >> 2) * 4;
        f32x4 o[4]; float rs[4] = {0.f, 0.f, 0.f, 0.f};
#pragma unroll
        for (int n = 0; n < 4; ++n) {
            f32x4 acc = mma16(AT + mt * 16 * SA64, SA64, VT + (nb + n) * 16 * SA64, SA64, 64, zero, r, kg);
            acc = mma16(QI + mt * 16 * SA64, SA64, SP + (nb + n) * 16 * SA64, SA64, 64, acc, r, kg);
            o[n] = acc;
#pragma unroll
            for (int ii = 0; ii < 4; ++ii) rs[ii] += acc[ii] * acc[ii]; }
#pragma unroll
        for (int ii = 0; ii < 4; ++ii) { rs[ii] += __shfl_xor(rs[ii], 1); rs[ii] += __shfl_xor(rs[ii], 2); rs[ii] += __shfl_xor(rs[ii], 4); rs[ii] += __shfl_xor(rs[ii], 8); }
        if (r == 0) {
#pragma unroll
            for (int ii = 0; ii < 4; ++ii) RSQ[(w >> 2) * 64 + mt * 16 + kg * 4 + ii] = rs[ii]; }
        __syncthreads();
        float rr[4];
#pragma unroll
        for (int ii = 0; ii < 4; ++ii) { const int row = mt * 16 + kg * 4 + ii; rr[ii] = rsqrtf((RSQ[row] + RSQ[64 + row]) * (1.f / 128.f) + EPS); }
        GAS bf16* mixed = (GAS bf16*)(A.ws + WS_XB);
#pragma unroll
        for (int n = 0; n < 4; ++n) { const int dv = (nb + n) * 16 + r; const float nwv = A.in[5][dv];
#pragma unroll
            for (int ii = 0; ii < 4; ++ii) { const size_t t = t0 + mt * 16 + kg * 4 + ii;
                const float gv = bf2f(proj[t * NINP + C_GOUT + h * 128 + dv]);
                mixed[t * D + h * 128 + dv] = (bf16)f2bf(o[n][ii] * rr[ii] * nwv * silu_f(gv)); } }
    }
    __syncthreads();
}

template <int MODE>
__device__ __forceinline__ void ssd_unit(const Frame& F, const Args& A, int unit) {
    const int b = unit >> 7, c = (unit >> 1) & 63, g = unit & 1;
    const size_t t0 = (size_t)b * SEQ + (size_t)c * 128;
    const GAS bf16* proj = (const GAS bf16*)(A.ws + WS_PROJ);
    LAS unsigned char* L = F.lds;
    LAS float* DT = (LAS float*)(L + 0);
    LAS float* ACU = (LAS float*)(L + 2048);
    LAS unsigned char* CM = L + 4096;
    LAS unsigned char* BM = CM + 128 * SA64;
    LAS unsigned char* XT = BM + 128 * SA64;
    LAS unsigned char* PW = XT + 4 * 64 * SA128;
    int tid = F.tid, w = F.wave;
    asm volatile("" : "+v"(tid)); asm volatile("" : "+s"(w));
    const int lane = tid & 63;
    if (w < 4) {
        const int hd = g * 4 + w; const float Ah = -__expf(A.in[9][hd]), dtb = A.in[8][hd];
        const float dt0 = softplus_f(bf2f(proj[(t0 + 2 * lane) * NINP + C_DT + hd]) + dtb), dt1 = softplus_f(bf2f(proj[(t0 + 2 * lane + 1) * NINP + C_DT + hd]) + dtb);
        const float a0 = dt0 * Ah, a1 = dt1 * Ah; float s = a0 + a1;
#pragma unroll
        for (int o = 1; o < 64; o <<= 1) { const float t = __shfl_up(s, o); s += (lane >= o) ? t : 0.f; }
        DT[(2 * lane) * 4 + w] = dt0; DT[(2 * lane + 1) * 4 + w] = dt1; ACU[(2 * lane) * 4 + w] = s - a1; ACU[(2 * lane + 1) * 4 + w] = s;
        if (MODE == 0 && lane == 63) ((GAS float*)(A.ws + WS_SDEC))[(b * 64 + c) * 8 + hd] = __expf(s);
    }
    __syncthreads();
    {
        const int cl = tid & 127, qtr = tid >> 7, l0 = qtr * 32;
#pragma unroll 1
        for (int k = 0; k < 3; ++k) {
            const int ci = cl + 128 * k;
            if (MODE == 0 && ci >= 320) continue;
            const int cc = ci < 256 ? g * 256 + ci : (ci < 320 ? 512 + g * 64 + (ci - 256) : 640 + g * 64 + (ci - 320));
            const float w0 = A.in[6][0 * 768 + cc], w1 = A.in[6][1 * 768 + cc], w2 = A.in[6][2 * 768 + cc], w3 = A.in[6][3 * 768 + cc], cb = A.in[7][cc];
            const GAS bf16* src = proj + (t0 + l0) * NINP + C_XBC + cc;
            float x0 = 0.f, x1 = 0.f, x2 = 0.f;
            if (c > 0 || qtr > 0) { x0 = bf2f(src[-3 * NINP]); x1 = bf2f(src[-2 * NINP]); x2 = bf2f(src[-1 * NINP]); }
            const int hl = ci >> 6, pn = ci & 63;
            float sc_end = 0.f; if (MODE == 0 && ci < 256) sc_end = ACU[127 * 4 + hl];
#pragma unroll 4
            for (int li = 0; li < 32; li += 2) {
                const float xa = bf2f(src[(size_t)li * NINP]), xb = bf2f(src[(size_t)(li + 1) * NINP]);
                float va = silu_f(cb + w0 * x0 + w1 * x1 + w2 * x2 + w3 * xa);
                float vb = silu_f(cb + w0 * x1 + w1 * x2 + w2 * xa + w3 * xb);
                x0 = x2; x1 = xa; x2 = xb;
                const int l = l0 + li;
                if (ci < 256) {
                    if (MODE == 0) { va *= DT[l * 4 + hl] * __expf(sc_end - ACU[l * 4 + hl]); vb *= DT[(l + 1) * 4 + hl] * __expf(sc_end - ACU[(l + 1) * 4 + hl]); }
                    *(LAS unsigned*)(XT + hl * 64 * SA128 + pn * SA128 + l * 2) = pk2(va, vb);
                } else if (ci < 320) {
                    if (MODE == 0) *(LAS unsigned*)(CM + pn * SA128 + l * 2) = pk2(va, vb);
                    else { *(LAS bf16*)(BM + l * SA64 + pn * 2) = (bf16)f2bf(va); *(LAS bf16*)(BM + (l + 1) * SA64 + pn * 2) = (bf16)f2bf(vb); }
                } else { *(LAS bf16*)(CM + l * SA64 + pn * 2) = (bf16)f2bf(va); *(LAS bf16*)(CM + (l + 1) * SA64 + pn * 2) = (bf16)f2bf(vb); }
            }
        }
    }
    __syncthreads();
    const int r = lane & 15, kg = lane >> 4;
    const f32x4 zero = (f32x4){0.f, 0.f, 0.f, 0.f};
    if (MODE == 0) {
        const int hl = w >> 1;
        GAS bf16* st = (GAS bf16*)(A.ws + WS_SST) + ((size_t)((b * 64 + c) * 8 + g * 4 + hl)) * 4096;
#pragma unroll
        for (int mt = 0; mt < 4; ++mt)
#pragma unroll
            for (int n = 0; n < 2; ++n) { const int nt = (w & 1) * 2 + n;
                const f32x4 acc = mma16(CM + mt * 16 * SA128, SA128, XT + hl * 64 * SA128 + nt * 16 * SA128, SA128, 128, zero, r, kg);
                const int p = nt * 16 + r, n0 = mt * 16 + kg * 4;
                *(GAS u32x2*)(st + p * 64 + n0) = (u32x2){pk2(acc[0], acc[1]), pk2(acc[2], acc[3])}; }
    } else {
        f32x4 sc[8];
#pragma unroll
        for (int nt = 0; nt < 8; ++nt) { sc[nt] = zero; if (nt <= w) sc[nt] = mma16(CM + w * 16 * SA64, SA64, BM + nt * 16 * SA64, SA64, 64, zero, r, kg); }
        __syncthreads();
        const GAS bf16* spg = (const GAS bf16*)(A.ws + WS_SST) + ((size_t)((b * 64 + c) * 8 + g * 4)) * 4096;
        for (int e = tid; e < 1024; e += 512) { const int row = e >> 3, ch = e & 7; *(LAS v4u*)(BM + row * SA64 + ch * 16) = *(const GAS v4u*)(spg + row * 64 + ch * 8); }
        __syncthreads();
        float rs[4] = {0.f, 0.f, 0.f, 0.f};
        LAS unsigned char* pw = PW + w * 16 * SA32;
        const GAS bf16* zrow = proj + (t0 + w * 16 + kg * 4) * NINP + C_Z + g * 256 + r;
        GAS bf16* mrow = (GAS bf16*)(A.ws + WS_XB) + (t0 + w * 16 + kg * 4) * D + 512 + g * 256 + r;
#pragma unroll 1
        for (int hl = 0; hl < 4; ++hl) {
            if (hl == 2) {
                __syncthreads();
                for (int e = tid; e < 1024; e += 512) { const int row = e >> 3, ch = e & 7; *(LAS v4u*)(BM + row * SA64 + ch * 16) = *(const GAS v4u*)(spg + 2 * 4096 + row * 64 + ch * 8); }
                __syncthreads();
            }
            float acl[4];
#pragma unroll
            for (int ii = 0; ii < 4; ++ii) acl[ii] = ACU[(w * 16 + kg * 4 + ii) * 4 + hl];
            f32x4 yd[4] = {zero, zero, zero, zero};
            const LAS unsigned char* xth = XT + hl * 64 * SA128;
#pragma unroll
            for (int kc = 0; kc < 4; ++kc) {
                if (kc * 2 <= w) {
#pragma unroll
                    for (int half = 0; half < 2; ++half) { const int stl = 2 * kc + half; const int s = stl * 16 + r;
                        const float acs = ACU[s * 4 + hl], dts = DT[s * 4 + hl];
#pragma unroll
                        for (int ii = 0; ii < 4; ++ii) { const int l = w * 16 + kg * 4 + ii;
                            const float pv = (s <= l) ? sc[stl][ii] * __expf(acl[ii] - acs) * dts : 0.f;
                            *(LAS bf16*)(pw + (kg * 4 + ii) * SA32 + (half * 16 + r) * 2) = (bf16)f2bf(pv); } }
                    LDS_WAIT();
                    const bf16x8 a = *(const LAS bf16x8*)(pw + r * SA32 + kg * 16);
#pragma unroll
                    for (int nt = 0; nt < 4; ++nt) { const bf16x8 bb = *(const LAS bf16x8*)(xth + (nt * 16 + r) * SA128 + (kc * 32 + 8 * kg) * 2);
                        yd[nt] = __builtin_amdgcn_mfma_f32_16x16x32_bf16(a, bb, yd[nt], 0, 0, 0); }
                    LDS_WAIT();
                }
            }
            const float Dk = A.in[10][g * 4 + hl];
            float eal[4];
#pragma unroll
            for (int ii = 0; ii < 4; ++ii) eal[ii] = __expf(acl[ii]);
#pragma unroll
            for (int nt = 0; nt < 4; ++nt) {
                const f32x4 yo = mma16(CM + w * 16 * SA64, SA64, BM + (hl & 1) * 64 * SA64 + nt * 16 * SA64, SA64, 64, zero, r, kg);
                const int p = nt * 16 + r;
#pragma unroll
                for (int ii = 0; ii < 4; ++ii) { const int l = w * 16 + kg * 4 + ii;
                    const float xv = bf2f(*(const LAS bf16*)(xth + p * SA128 + l * 2));
                    const float zv = bf2f(zrow[(size_t)ii * NINP + hl * 64 + nt * 16]);
                    const float y = (yd[nt][ii] + eal[ii] * yo[ii] + xv * Dk) * silu_f(zv);
                    const unsigned short yb = (unsigned short)f2bf(y); const float yq = bf2f(yb);
                    rs[ii] += yq * yq;
                    mrow[(size_t)ii * D + hl * 64 + nt * 16] = yb; }
            }
        }
#pragma unroll
        for (int ii = 0; ii < 4; ++ii) { rs[ii] += __shfl_xor(rs[ii], 1); rs[ii] += __shfl_xor(rs[ii], 2); rs[ii] += __shfl_xor(rs[ii], 4); rs[ii] += __shfl_xor(rs[ii], 8);
            rs[ii] = rsqrtf(rs[ii] * (1.f / 256.f) + EPS); }
        VM_WAIT();
#pragma unroll 1
        for (int hl = 0; hl < 4; ++hl)
#pragma unroll
            for (int nt = 0; nt < 4; ++nt) { const float nwv = A.in[11][g * 256 + hl * 64 + nt * 16 + r];
#pragma unroll
                for (int ii = 0; ii < 4; ++ii) { GAS bf16* q = mrow + (size_t)ii * D + hl * 64 + nt * 16;
                    const float yv = bf2f(__hip_atomic_load(q, __ATOMIC_RELAXED, __HIP_MEMORY_SCOPE_AGENT));
                    *q = (bf16)f2bf(yv * rs[ii] * nwv); } }
    }
    __syncthreads();
}

__device__ __forceinline__ void scan_phase(const Frame& F, const Args& A) {
    if (F.tid < 128) {
        GAS unsigned* st = (GAS unsigned*)(A.ws + WS_GST); const GAS float* dec = (const GAS float*)(A.ws + WS_GDEC);
        for (int gi = blockIdx.x * 128 + F.tid; gi < 8 * 4096; gi += F.G * 128) {
            const int bh = gi >> 12, e = gi & 4095, b = bh >> 2, h = bh & 3, d = (e & 31) * 2;
            float S0 = 0.f, S1 = 0.f;
            for (int c = 0; c < 128; c += 8) {
                unsigned v[8]; float d0[8], d1[8];
#pragma unroll
                for (int u = 0; u < 8; ++u) { const size_t un = (size_t)((b * 128 + c + u) * 4 + h); v[u] = st[un * 4096 + e]; d0[u] = dec[un * 64 + d]; d1[u] = dec[un * 64 + d + 1]; }
#pragma unroll
                for (int u = 0; u < 8; ++u) { const size_t un = (size_t)((b * 128 + c + u) * 4 + h); st[un * 4096 + e] = pk2(S0, S1);
                    S0 = d0[u] * S0 + bf2f((unsigned short)(v[u] & 0xffffu)); S1 = d1[u] * S1 + bf2f((unsigned short)(v[u] >> 16)); }
            }
        }
    } else if (F.tid < 256) {
        GAS unsigned* st = (GAS unsigned*)(A.ws + WS_SST); const GAS float* dec = (const GAS float*)(A.ws + WS_SDEC);
        for (int gi = blockIdx.x * 128 + (F.tid - 128); gi < 16 * 2048; gi += F.G * 128) {
            const int bh = gi >> 11, e = gi & 2047, b = bh >> 3, hd = bh & 7;
            float S0 = 0.f, S1 = 0.f;
            for (int c = 0; c < 64; c += 8) {
                unsigned v[8]; float dd[8];
#pragma unroll
                for (int u = 0; u < 8; ++u) { const size_t un = (size_t)((b * 64 + c + u) * 8 + hd); v[u] = st[un * 2048 + e]; dd[u] = dec[un]; }
#pragma unroll
                for (int u = 0; u < 8; ++u) { const size_t un = (size_t)((b * 64 + c + u) * 8 + hd); st[un * 2048 + e] = pk2(S0, S1);
                    S0 = dd[u] * S0 + bf2f((unsigned short)(v[u] & 0xffffu)); S1 = dd[u] * S1 + bf2f((unsigned short)(v[u] >> 16)); }
            }
        }
    }
}
constexpr size_t WS_HB = WS_PROJ;
constexpr size_t WS_Q = 144 * MiB;
constexpr size_t WS_IDX = 232 * MiB;
constexpr size_t WS_GATE = 240 * MiB;
typedef float f32x16 __attribute__((ext_vector_type(16)));
__device__ __forceinline__ float as_f(unsigned u) { return __builtin_bit_cast(float, u); }
__device__ __forceinline__ unsigned as_u(float f) { return __builtin_bit_cast(unsigned, f); }
#define CE_DESC(a, b) do { const float hi_ = fmaxf((a), (b)), lo_ = fminf((a), (b)); (a) = hi_; (b) = lo_; } while (0)
template <int OFF, int N> __device__ __forceinline__ void sort16_desc(float (&v)[N]) {
#pragma unroll
    for (int k = 2; k <= 16; k <<= 1)
#pragma unroll
        for (int j = k >> 1; j > 0; j >>= 1)
#pragma unroll
            for (int i = 0; i < 16; ++i) { const int l = i ^ j; if (l > i) { if ((i & k) == 0) CE_DESC(v[OFF + i], v[OFF + l]); else CE_DESC(v[OFF + l], v[OFF + i]); } }
}
template <int OA, int OB, int NA, int NB> __device__ __forceinline__ void merge16_desc(float (&a)[NA], const float (&b)[NB]) {
#pragma unroll
    for (int i = 0; i < 16; ++i) a[OA + i] = fmaxf(a[OA + i], b[OB + 15 - i]);
#pragma unroll
    for (int j = 8; j > 0; j >>= 1)
#pragma unroll
        for (int i = 0; i < 16; ++i) { const int l = i ^ j; if (l > i) CE_DESC(a[OA + i], a[OA + l]); }
}
constexpr unsigned char CAND0[32] = {0, 2, 4, 6, 8, 10, 12, 14, 16, 18, 20, 22, 32, 34, 36, 49, 51, 65, 80, 96, 112, 128, 160, 192, 224, 255, 255, 255, 255, 255, 255, 255};
constexpr unsigned char CAND1[32] = {1, 3, 5, 7, 9, 11, 13, 15, 17, 19, 21, 23, 33, 35, 48, 50, 64, 66, 81, 97, 113, 144, 176, 208, 240, 255, 255, 255, 255, 255, 255, 255};

__device__ __forceinline__ void topk_wave_job(const Args& A, const LAS unsigned char* SK, LAS unsigned char* TAB, int tok0, int h, int lane) {
    const int r = lane & 31, hi = lane >> 5;
    const GAS bf16* qrow = (const GAS bf16*)(A.ws + WS_Q) + (size_t)(tok0 + r) * NQ + h * 256 + 8 * hi;
    float LST[2][16];
#pragma unroll
    for (int p = 0; p < 2; ++p) {
        __builtin_amdgcn_sched_barrier(0);
        bf16x8 bq[8];
#pragma unroll
        for (int s = 0; s < 8; ++s) bq[s] = *(const GAS bf16x8*)(qrow + p * 128 + 16 * s);
        float v[64];
#pragma unroll
        for (int kt = 0; kt < 4; ++kt) {
            f32x16 acc;
#pragma unroll
            for (int i = 0; i < 16; ++i) acc[i] = 0.f;
#pragma unroll
            for (int s = 0; s < 8; ++s) { const bf16x8 a = *(const LAS bf16x8*)(SK + (p * 128 + kt * 32 + r) * SA128 + (16 * s + 8 * hi) * 2);
                acc = __builtin_amdgcn_mfma_f32_32x32x16_bf16(a, bq[s], acc, 0, 0, 0); }
#pragma unroll
            for (int i = 0; i < 16; ++i) { const unsigned key = (unsigned)(kt * 32 + (i & 3) + 8 * (i >> 2)) | ((unsigned)hi << 2); v[kt * 16 + i] = as_f((as_u(acc[i]) & ~127u) | key); }
        }
        sort16_desc<0>(v); sort16_desc<16>(v); sort16_desc<32>(v); sort16_desc<48>(v);
        merge16_desc<0, 16>(v, v); merge16_desc<32, 48>(v, v); merge16_desc<0, 32>(v, v);
        float o[16];
#pragma unroll
        for (int i = 0; i < 16; ++i) o[i] = __shfl_xor(v[i], 32);
        merge16_desc<0, 0>(v, o);
#pragma unroll
        for (int i = 0; i < 16; ++i) LST[p][i] = v[i];
    }
    __builtin_amdgcn_sched_barrier(0);
    {   unsigned pk[4];
#pragma unroll
        for (int q4 = 0; q4 < 4; ++q4) { unsigned wv = 0;
#pragma unroll
            for (int b = 0; b < 4; ++b) { float l0 = LST[0][q4 * 4 + b], l1 = LST[1][q4 * 4 + b]; asm volatile("" : "+v"(l0), "+v"(l1));
                const unsigned x = as_u(hi ? l1 : l0) & 127u; wv |= x << (8 * b); }
            pk[q4] = wv; }
        *(LAS v4u*)(TAB + r * 32 + hi * 16) = (v4u){pk[0], pk[1], pk[2], pk[3]};
    }
    float c[32];
    float va[16], vb2[16];
#pragma unroll
    for (int i = 0; i < 16; ++i) { va[i] = as_f(as_u(LST[0][i]) & ~127u); vb2[i] = as_f(as_u(LST[1][i]) & ~127u); }
#define CANDV(i0, j0, k0, i1, j1, k1) as_f((as_u(hi ? (va[i1] + vb2[j1]) : (va[i0] + vb2[j0])) & ~255u) | (hi ? (k1) : (k0)))
    c[0] = CANDV(0, 0, 0u, 0, 1, 1u);
    c[1] = CANDV(0, 2, 2u, 0, 3, 3u);
    c[2] = CANDV(0, 4, 4u, 0, 5, 5u);
    c[3] = CANDV(0, 6, 6u, 0, 7, 7u);
    c[4] = CANDV(0, 8, 8u, 0, 9, 9u);
    c[5] = CANDV(0, 10, 10u, 0, 11, 11u);
    c[6] = CANDV(0, 12, 12u, 0, 13, 13u);
    c[7] = CANDV(0, 14, 14u, 0, 15, 15u);
    c[8] = CANDV(1, 0, 16u, 1, 1, 17u);
    c[9] = CANDV(1, 2, 18u, 1, 3, 19u);
    c[10] = CANDV(1, 4, 20u, 1, 5, 21u);
    c[11] = CANDV(1, 6, 22u, 1, 7, 23u);
    c[12] = CANDV(2, 0, 32u, 2, 1, 33u);
    c[13] = CANDV(2, 2, 34u, 2, 3, 35u);
    c[14] = CANDV(2, 4, 36u, 3, 0, 48u);
    c[15] = CANDV(3, 1, 49u, 3, 2, 50u);
    c[16] = CANDV(3, 3, 51u, 4, 0, 64u);
    c[17] = CANDV(4, 1, 65u, 4, 2, 66u);
    c[18] = CANDV(5, 0, 80u, 5, 1, 81u);
    c[19] = CANDV(6, 0, 96u, 6, 1, 97u);
    c[20] = CANDV(7, 0, 112u, 7, 1, 113u);
    c[21] = CANDV(8, 0, 128u, 9, 0, 144u);
    c[22] = CANDV(10, 0, 160u, 11, 0, 176u);
    c[23] = CANDV(12, 0, 192u, 13, 0, 208u);
    c[24] = CANDV(14, 0, 224u, 15, 0, 240u);
    c[25] = as_f(0xFF61B1E6u | 255u);
    c[26] = as_f(0xFF61B1E6u | 255u);
    c[27] = as_f(0xFF61B1E6u | 255u);
    c[28] = as_f(0xFF61B1E6u | 255u);
    c[29] = as_f(0xFF61B1E6u | 255u);
    c[30] = as_f(0xFF61B1E6u | 255u);
    c[31] = as_f(0xFF61B1E6u | 255u);
#undef CANDV
    sort16_desc<0>(c); sort16_desc<16>(c); merge16_desc<0, 16>(c, c);
    {   float o[16];
#pragma unroll
        for (int i = 0; i < 16; ++i) o[i] = __shfl_xor(c[i], 32);
        merge16_desc<0, 0>(c, o); }
    const float mx = as_f(as_u(c[0]) & ~255u);
    float ex[16], den = 0.f;
#pragma unroll
    for (int k = 0; k < 16; ++k) { ex[k] = __expf(as_f(as_u(c[k]) & ~255u) - mx); den += ex[k]; }
    const float inv = 1.f / den;
    LDS_WAIT();
    unsigned eid[8]; float gv[8];
#pragma unroll
    for (int k = 0; k < 8; ++k) { float ca = c[k], cb = c[k + 8], ea = ex[k], eb = ex[k + 8]; asm volatile("" : "+v"(ca), "+v"(cb), "+v"(ea), "+v"(eb));
        const unsigned code = as_u(hi ? cb : ca) & 255u; gv[k] = (hi ? eb : ea) * inv;
        const unsigned ia = *(const LAS unsigned char*)(TAB + r * 32 + (code >> 4)), ib = *(const LAS unsigned char*)(TAB + r * 32 + 16 + (code & 15));
        eid[k] = ia * 128u + ib; }
    GAS unsigned* ip = (GAS unsigned*)(A.ws + WS_IDX) + (size_t)(tok0 + r) * 128 + h * 16 + 8 * hi;
    GAS float* gp = (GAS float*)(A.ws + WS_GATE) + (size_t)(tok0 + r) * 128 + h * 16 + 8 * hi;
    *(GAS v4u*)ip = (v4u){eid[0], eid[1], eid[2], eid[3]}; *(GAS v4u*)(ip + 4) = (v4u){eid[4], eid[5], eid[6], eid[7]};
    *(GAS f32x4*)gp = (f32x4){gv[0], gv[1], gv[2], gv[3]}; *(GAS f32x4*)(gp + 4) = (f32x4){gv[4], gv[5], gv[6], gv[7]};
    LDS_WAIT();
}
__device__ __forceinline__ void topk_phase(const Frame& F, const Args& A) {
    LAS unsigned char* SK = F.lds;
    LAS unsigned char* TABS = F.lds + 256 * SA128;
    for (int unit = blockIdx.x; unit < 256; unit += F.G) {
        int tid = F.tid, w = F.wave;
        asm volatile("" : "+v"(tid)); asm volatile("" : "+s"(w));
        const int h = unit & 7, tb = (unit >> 3) * 512;
        const GAS bf16* sk = (const GAS bf16*)(A.ws + WS_SUBK) + (size_t)h * 2 * 128 * 128;
        for (int e = tid; e < 256 * 16; e += 512) { const int row = e >> 4, ch = e & 15; *(LAS v4u*)(SK + row * SA128 + ch * 16) = *(const GAS v4u*)(sk + row * 128 + ch * 8); }
        __syncthreads();
#pragma unroll 1
        for (int tt = 0; tt < 2; ++tt) topk_wave_job(A, SK, TABS + w * 1024, tb + (w * 2 + tt) * 32, h, tid & 63);
        __syncthreads();
    }
}

__device__ __forceinline__ float gelu_f(float x) { return 0.5f * x * (1.f + erff(x * 0.70710678118654752f)); }
__device__ __forceinline__ void unpack8(const v4u x, float (&f)[8]) {
    f[0] = as_f(x.x << 16); f[1] = as_f(x.x & 0xffff0000u); f[2] = as_f(x.y << 16); f[3] = as_f(x.y & 0xffff0000u);
    f[4] = as_f(x.z << 16); f[5] = as_f(x.z & 0xffff0000u); f[6] = as_f(x.w << 16); f[7] = as_f(x.w & 0xffff0000u);
}
typedef long lx2 __attribute__((ext_vector_type(2)));
typedef float f32x2 __attribute__((ext_vector_type(2)));
constexpr float U8_SCALE = 64.f, V8_SCALE = 4.f;
__device__ __forceinline__ unsigned pk4_fp8(float a, float b, float c, float d) { int p = __builtin_amdgcn_cvt_pk_fp8_f32(a, b, 0, false); p = __builtin_amdgcn_cvt_pk_fp8_f32(c, d, p, true); return (unsigned)p; }
__device__ __forceinline__ void expert_phase(const Frame& F, const Args& A) {
    int tid = F.tid, w = F.wave;
    asm volatile("" : "+v"(tid)); asm volatile("" : "+s"(w));
    const int lane = tid & 63, r = lane & 15, kg = lane >> 4;
    LAS unsigned char* N2 = F.lds + w * 1024;
    const GAS unsigned char* u8 = (const GAS unsigned char*)(A.ws + WS_UB); const GAS unsigned char* v8 = (const GAS unsigned char*)(A.ws + WS_VB);
    const GAS unsigned* idx = (const GAS unsigned*)(A.ws + WS_IDX); const GAS float* gate = (const GAS float*)(A.ws + WS_GATE);
    const GAS float* rowsq = (const GAS float*)(A.ws + WS_ROWSQ2);
    f32x4 nl[4];
#pragma unroll
    for (int q = 0; q < 4; ++q) nl[q] = *(const GAS f32x4*)(A.in[18] + 16 * lane + 4 * q);
#pragma unroll 1
    for (int t = F.gw; t < T; t += F.NGW) {
        GAS float* hrow = (GAS float*)A.out + (size_t)t * D;
        f32x4 hv[4];
#pragma unroll
        for (int q = 0; q < 4; ++q) hv[q] = *(const GAS f32x4*)(hrow + 16 * lane + 4 * q);
        const float rr = rsqrtf(rowsq[t] * (1.f / 1024.f) + EPS);
        {   v4u pk;
            pk.x = pk4_fp8(hv[0].x * rr, hv[0].y * rr, hv[0].z * rr, hv[0].w * rr); pk.y = pk4_fp8(hv[1].x * rr, hv[1].y * rr, hv[1].z * rr, hv[1].w * rr);
            pk.z = pk4_fp8(hv[2].x * rr, hv[2].y * rr, hv[2].z * rr, hv[2].w * rr); pk.w = pk4_fp8(hv[3].x * rr, hv[3].y * rr, hv[3].z * rr, hv[3].w * rr);
            *(LAS v4u*)(N2 + 16 * lane) = pk; }
        unsigned eidx[8]; float gt[8];
#pragma unroll
        for (int eg = 0; eg < 8; ++eg) { eidx[eg] = idx[(size_t)t * 128 + eg * 16 + r]; gt[eg] = gate[(size_t)t * 128 + eg * 16 + r]; }
        LDS_WAIT();
        f32x4 acc[8];
#pragma unroll
        for (int eg = 0; eg < 8; ++eg) acc[eg] = (f32x4){0.f, 0.f, 0.f, 0.f};
#pragma unroll 2
        for (int s2 = 0; s2 < 16; ++s2) {
            const lx2 a = *(const LAS lx2*)(N2 + 64 * s2 + 16 * kg);
#pragma unroll
            for (int eg = 0; eg < 8; ++eg) { const lx2 b = *(const GAS lx2*)(u8 + (size_t)eidx[eg] * 1024 + 64 * s2 + 16 * kg);
                acc[eg] = __builtin_amdgcn_mfma_f32_16x16x32_fp8_fp8(a.x, b.x, acc[eg], 0, 0, 0);
                acc[eg] = __builtin_amdgcn_mfma_f32_16x16x32_fp8_fp8(a.y, b.y, acc[eg], 0, 0, 0); }
        }
        float hid[8];
#pragma unroll
        for (int eg = 0; eg < 8; ++eg) hid[eg] = gelu_f(acc[eg][0] * (1.f / U8_SCALE)) * gt[eg] * (1.f / V8_SCALE);
        float o[16];
#pragma unroll
        for (int i = 0; i < 16; ++i) o[i] = 0.f;
#pragma unroll
        for (int eg = 0; eg < 8; ++eg) {
#pragma unroll
            for (int half = 0; half < 2; ++half) {
                asm volatile("" ::: "memory");
#pragma unroll
                for (int rr_ = half * 8; rr_ < half * 8 + 8; ++rr_) {
                    const float sh = as_f(__builtin_amdgcn_readlane((int)as_u(hid[eg]), rr_));
                    const unsigned si = (unsigned)__builtin_amdgcn_readlane((int)eidx[eg], rr_);
                    const v4u x = *(const GAS v4u*)(v8 + (size_t)si * 1024 + 16 * lane);
                    const unsigned xw[4] = {x.x, x.y, x.z, x.w};
#pragma unroll
                    for (int k = 0; k < 4; ++k) { const f32x2 lo = __builtin_amdgcn_cvt_pk_f32_fp8((int)xw[k], false), hi2 = __builtin_amdgcn_cvt_pk_f32_fp8((int)xw[k], true);
                        o[4 * k] += sh * lo.x; o[4 * k + 1] += sh * lo.y; o[4 * k + 2] += sh * hi2.x; o[4 * k + 3] += sh * hi2.y; }
                }
            }
        }
        float ss = 0.f; f32x4 h2[4];
#pragma unroll
        for (int q = 0; q < 4; ++q) { h2[q] = hv[q] + (f32x4){o[4 * q], o[4 * q + 1], o[4 * q + 2], o[4 * q + 3]};
            const f32x4 x = h2[q]; ss += (x.x * x.x + x.y * x.y) + (x.z * x.z + x.w * x.w); }
        ss = wave_sum(ss);
        const float r3 = rsqrtf(ss * (1.f / D) + EPS);
#pragma unroll
        for (int q = 0; q < 4; ++q) *(GAS f32x4*)(hrow + 16 * lane + 4 * q) = h2[q] * r3 * nl[q];
    }
}
__device__ __forceinline__ void p0_transpose_item(const float* W, const float* kscale, int K, int N, bf16* WT, LAS float* scr, int item, int lane) {
    const int nblk = (N + 31) / 32, kb = item / nblk, nb = item % nblk, k0 = 64 * kb, n0 = 32 * nb;
    const int nn = n0 + (lane & 31); const bool ok = nn < N;
#pragma unroll 8
    for (int i = 0; i < 32; ++i) { const int kk = 2 * i + (lane >> 5); float v = ok ? W[(size_t)(k0 + kk) * N + nn] : 0.f; if (kscale) v *= kscale[k0 + kk]; scr[kk * 33 + (lane & 31)] = v; }
    LDS_WAIT(); asm volatile("" ::: "memory");
    const int c = lane & 7;
#pragma unroll
    for (int j = 0; j < 4; ++j) { const int n = (lane >> 3) + 8 * j; const LAS float* s = scr + (8 * c) * 33 + n;
        v4u o; o.x = pk2(s[0 * 33], s[1 * 33]); o.y = pk2(s[2 * 33], s[3 * 33]); o.z = pk2(s[4 * 33], s[5 * 33]); o.w = pk2(s[6 * 33], s[7 * 33]);
        *(GAS v4u*)(WT + (size_t)(n0 + n) * K + k0 + 8 * c) = o; }
    LDS_WAIT(); asm volatile("" ::: "memory");
}
__device__ __forceinline__ void p0_convert(const Frame& F, const float* src, bf16* dst, size_t n) {
    for (size_t i = ((size_t)F.gw * 64 + F.lane) * 8; i < n; i += (size_t)F.NGW * 512) {
        const f32x4 a = *(const GAS f32x4*)(src + i), b = *(const GAS f32x4*)(src + i + 4);
        v4u o; o.x = pk2(a.x, a.y); o.y = pk2(a.z, a.w); o.z = pk2(b.x, b.y); o.w = pk2(b.z, b.w);
        *(GAS v4u*)(dst + i) = o;
    }
}
__device__ __forceinline__ void p0_convert_fp8(const Frame& F, const float* src, unsigned char* dst, size_t n, float scale, const float* colscale) {
    for (size_t i = ((size_t)F.gw * 64 + F.lane) * 16; i < n; i += (size_t)F.NGW * 1024) {
        v4u o; unsigned ow[4];
#pragma unroll
        for (int q = 0; q < 4; ++q) { f32x4 a = *(const GAS f32x4*)(src + i + 4 * q) * scale;
            if (colscale) a = a * *(const GAS f32x4*)(colscale + ((i + 4 * q) & 1023));
            int pk = __builtin_amdgcn_cvt_pk_fp8_f32(a.x, a.y, 0, false); pk = __builtin_amdgcn_cvt_pk_fp8_f32(a.z, a.w, pk, true); ow[q] = (unsigned)pk; }
        o.x = ow[0]; o.y = ow[1]; o.z = ow[2]; o.w = ow[3];
        *(GAS v4u*)(dst + i) = o;
    }
}
__device__ __forceinline__ void p0_prologue(const Frame& F, const Args& A) {
    unsigned char* ws = A.ws;
    LAS float* scr = (LAS float*)(F.lds + RING_OFF + F.wave * 16384);
    constexpr int I_IN = (D / 64) * ((NIN + 31) / 32), I_O = (D / 64) * (D / 32), I_Q = (D / 64) * (NQ / 32);
    for (int it = F.gw; it < I_IN + I_O + I_Q; it += F.NGW) {
        int r = it;
        if (r < I_IN) { p0_transpose_item(A.in[2], A.in[1], D, NIN, (bf16*)(ws + WS_WIN), scr, r, F.lane); continue; } r -= I_IN;
        if (r < I_O) { p0_transpose_item(A.in[12], nullptr, D, D, (bf16*)(ws + WS_WO), scr, r, F.lane); continue; } r -= I_O;
        p0_transpose_item(A.in[14], A.in[13], D, NQ, (bf16*)(ws + WS_WQ), scr, r, F.lane);
    }
    for (int m = F.gw; m < T; m += F.NGW) {
        const GAS f32x4* xr = (const GAS f32x4*)(A.in[0] + (size_t)m * D) + F.lane;
        f32x4 v[4]; float s = 0.f;
#pragma unroll
        for (int j = 0; j < 4; ++j) { v[j] = xr[64 * j]; s += (v[j].x * v[j].x + v[j].y * v[j].y) + (v[j].z * v[j].z + v[j].w * v[j].w); }
        s = wave_sum(s);
        GAS unsigned long long* o8 = (GAS unsigned long long*)((bf16*)(ws + WS_XB) + (size_t)m * D) + F.lane;
#pragma unroll
        for (int j = 0; j < 4; ++j) o8[64 * j] = (unsigned long long)pk2(v[j].x, v[j].y) | ((unsigned long long)pk2(v[j].z, v[j].w) << 32);
        if (F.lane == 0) { ((float*)(ws + WS_RRMS1))[m] = rsqrtf(s * (1.f / D) + EPS); ((float*)(ws + WS_ROWSQ2))[m] = 0.f; }
    }
    p0_convert(F, A.in[15], (bf16*)(ws + WS_SUBK), (size_t)8 * 2 * 128 * 128);
    p0_convert_fp8(F, A.in[16], ws + WS_UB, (size_t)16384 * 1024, 64.f, A.in[13]);
    p0_convert_fp8(F, A.in[17], ws + WS_VB, (size_t)16384 * 1024, 4.f, nullptr);
}

__global__ void __launch_bounds__(NWAVES * 64, 2) fwd(Args args) {
    extern __shared__ __attribute__((aligned(16))) unsigned char lds[];
    Frame F;
    F.lds = (LAS unsigned char*)lds;
    F.MISC = (volatile LAS unsigned*)(F.lds + MISC_OFF);
    F.tid = threadIdx.x; F.lane = F.tid & 63; F.wave = __builtin_amdgcn_readfirstlane(F.tid >> 6);
    F.G = gridDim.x; F.gw = blockIdx.x * NWAVES + F.wave; F.NGW = F.G * NWAVES;
    unsigned char* ws = args.ws;
    F.ctl = (gu32*)(ws + WS_CTL);
    for (int u = F.tid; u < (LDS_BYTES - LDSCTL_OFF) / 4; u += NWAVES * 64) ((LAS unsigned*)(F.lds + LDSCTL_OFF))[u] = 0u;
    __syncthreads();
    XcdBarrier bar = xcd_barrier_post((unsigned*)(F.ctl + CW_BAR), F.MISC + 8);
    const int lo = args.ph_lo, hi = args.ph_hi;
#define IN(k) (lo <= (k) && (k) < hi)
#define BOTH(k) (IN(k) && IN((k) + 1))
#define GRID_BAR() xcd_barrier(bar)

    if (IN(0)) { p0_prologue(F, args); if (BOTH(0)) GRID_BAR(); }
    if (IN(1)) {
        pg8::Gemm g{(const bf16*)(ws + WS_XB), (const bf16*)(ws + WS_WIN), T, NINP, D}; pg8::StaticOrder S; S.init(T, NINP, F.G, (int)blockIdx.x);
        pg8::EpiRowScaleBf16 E{(bf16*)(ws + WS_PROJ), NINP, (const float*)(ws + WS_RRMS1)};
        pg8::gemm_phase<pg8::EpiRowScaleBf16, pg8::StaticOrder, true, true>(F.lds + RING_OFF, g, S, E);
        if (BOTH(1)) GRID_BAR();
    }
    if (IN(2)) {
        for (int u = blockIdx.x; u < 256; u += F.G) ssd_unit<0>(F, args, u);
        for (int u = blockIdx.x; u < 1024; u += F.G) gla_unit<0>(F, args, u);
        if (BOTH(2)) GRID_BAR();
    }
    if (IN(3)) { scan_phase(F, args); if (BOTH(3)) GRID_BAR(); }
    if (IN(4)) {
        for (int u = blockIdx.x; u < 256; u += F.G) ssd_unit<1>(F, args, u);
        for (int u = blockIdx.x; u < 1024; u += F.G) gla_unit<1>(F, args, u);
        if (BOTH(4)) GRID_BAR();
    }
    if (IN(5)) {
        pg8::Gemm g{(const bf16*)(ws + WS_XB), (const bf16*)(ws + WS_WO), T, D, D}; pg8::StaticOrder S; S.init(T, D, F.G, (int)blockIdx.x);
        pg8::EpiResidual E{args.in[0], args.out, (bf16*)(ws + WS_HB), (float*)(ws + WS_ROWSQ2), D};
        pg8::gemm_phase<pg8::EpiResidual, pg8::StaticOrder, true, true>(F.lds + RING_OFF, g, S, E);
        if (BOTH(5)) GRID_BAR();
    }
    if (IN(6)) {
        pg8::Gemm g{(const bf16*)(ws + WS_HB), (const bf16*)(ws + WS_WQ), T, NQ, D}; pg8::StaticOrder S; S.init(T, NQ, F.G, (int)blockIdx.x);
        pg8::EpiRsqScaleBf16 E{(bf16*)(ws + WS_Q), NQ, (const float*)(ws + WS_ROWSQ2)};
        pg8::gemm_phase<pg8::EpiRsqScaleBf16, pg8::StaticOrder, true, true>(F.lds + RING_OFF, g, S, E);
        if (BOTH(6)) GRID_BAR();
    }
    if (IN(7)) { topk_phase(F, args); if (BOTH(7)) GRID_BAR(); }
    if (IN(8)) { expert_phase(F, args); }
#undef IN
#undef BOTH
}
namespace nv {
struct ProjF32 { const float* p; __device__ __forceinline__ float operator()(size_t row, int c) const { return p[row * NIN + c]; } };
struct ProjBf { const unsigned short* p; __device__ __forceinline__ float operator()(size_t row, int c) const { return bf2f(p[row * NINP + c]); } };
__device__ __forceinline__ float silu_f(float x) { return x / (1.f + expf(-x)); }
__device__ __forceinline__ float softplus_f(float x) { return fmaxf(x, 0.f) + log1pf(expf(-fabsf(x))); }
__device__ __forceinline__ float logsigmoid_f(float x) { return fminf(x, 0.f) - log1pf(expf(-fabsf(x))); }
__device__ __forceinline__ float gelu_f(float x) { return 0.5f * x * (1.f + erff(x * 0.70710678118654752f)); }

__global__ void __launch_bounds__(256) k_rmsnorm(const float* __restrict__ x, const float* __restrict__ w, float* __restrict__ out) {
    const int row = blockIdx.x * 4 + (threadIdx.x >> 6), lane = threadIdx.x & 63;
    const float4* xr = (const float4*)(x + (size_t)row * D);
    float4 v[4]; float s = 0.f;
#pragma unroll
    for (int j = 0; j < 4; ++j) { v[j] = xr[lane + 64 * j]; s += v[j].x * v[j].x + v[j].y * v[j].y + v[j].z * v[j].z + v[j].w * v[j].w; }
    s = wave_sum(s);
    const float r = rsqrtf(s * (1.f / D) + EPS);
    float4* o = (float4*)(out + (size_t)row * D);
#pragma unroll
    for (int j = 0; j < 4; ++j) { const float4 ww = ((const float4*)w)[lane + 64 * j]; float4 y; y.x = v[j].x * r * ww.x; y.y = v[j].y * r * ww.y; y.z = v[j].z * r * ww.z; y.w = v[j].w * r * ww.w; o[lane + 64 * j] = y; }
}

template <bool ADD>
__global__ void __launch_bounds__(256) k_gemm(const float* __restrict__ A, const float* __restrict__ B, const float* __restrict__ R, float* __restrict__ C, int M, int N, int K, int ldb) {
    __shared__ float As[16][68];
    __shared__ float Bs[16][68];
    const int tid = threadIdx.x, tx = tid & 15, ty = tid >> 4;
    const int row0 = blockIdx.y * 64, col0 = blockIdx.x * 64;
    float acc[4][4];
#pragma unroll
    for (int i = 0; i < 4; ++i)
#pragma unroll
        for (int j = 0; j < 4; ++j) acc[i][j] = 0.f;
    const int ar = tid >> 2, akq = tid & 3;
    const int bk = tid >> 4, bn = (tid & 15) * 4;
    for (int k0 = 0; k0 < K; k0 += 16) {
        const float4 av = *(const float4*)(A + (size_t)(row0 + ar) * K + k0 + akq * 4);
        float4 bv = make_float4(0.f, 0.f, 0.f, 0.f);
        if (col0 + bn < N) bv = *(const float4*)(B + (size_t)(k0 + bk) * ldb + col0 + bn);
        __syncthreads();
        As[akq * 4 + 0][ar] = av.x; As[akq * 4 + 1][ar] = av.y; As[akq * 4 + 2][ar] = av.z; As[akq * 4 + 3][ar] = av.w;
        *(float4*)&Bs[bk][bn] = bv;
        __syncthreads();
#pragma unroll
        for (int kk = 0; kk < 16; ++kk) {
            const float4 a = *(const float4*)&As[kk][ty * 4];
            const float4 b = *(const float4*)&Bs[kk][tx * 4];
            const float aa[4] = {a.x, a.y, a.z, a.w}, bb[4] = {b.x, b.y, b.z, b.w};
#pragma unroll
            for (int i = 0; i < 4; ++i)
#pragma unroll
                for (int j = 0; j < 4; ++j) acc[i][j] += aa[i] * bb[j];
        }
    }
    if (col0 + tx * 4 < N) {
#pragma unroll
        for (int i = 0; i < 4; ++i) {
            const size_t off = (size_t)(row0 + ty * 4 + i) * N + col0 + tx * 4;
            float4 o = make_float4(acc[i][0], acc[i][1], acc[i][2], acc[i][3]);
            if (ADD) { const float4 r = *(const float4*)(R + off); o.x += r.x; o.y += r.y; o.z += r.z; o.w += r.w; }
            *(float4*)(C + off) = o;
        }
    }
}

template <class P> __global__ void __launch_bounds__(256) k_gla_gate(const P proj, const float* __restrict__ w2, const float* __restrict__ bg, float* __restrict__ alpha) {
    const int t = blockIdx.x, c = threadIdx.x;
    float acc = bg[c];
#pragma unroll
    for (int r = 0; r < 16; ++r) acc += proj((size_t)t, C_GLR + r) * w2[r * 256 + c];
    alpha[(size_t)t * 256 + c] = expf(logsigmoid_f(acc) * (1.f / 16.f));
}

template <class P> __global__ void __launch_bounds__(128) k_gla_rec(const P proj, const float* __restrict__ alpha, float* __restrict__ mixed) {
    const int b = blockIdx.x >> 2, h = blockIdx.x & 3, dv = threadIdx.x;
    float S[64];
#pragma unroll
    for (int d = 0; d < 64; ++d) S[d] = 0.f;
    for (int t = 0; t < SEQ; ++t) {
        const size_t row = (size_t)b * SEQ + t;
        const float* al = alpha + row * 256 + h * 64;
        const float v = proj(row, C_V + h * 128 + dv);
        float o = 0.f;
#pragma unroll
        for (int d = 0; d < 64; ++d) {
            S[d] = al[d] * S[d] + proj(row, C_K + h * 64 + d) * v;
            o += proj(row, C_Q + h * 64 + d) * S[d];
        }
        mixed[row * D + h * 128 + dv] = o * 0.125f;
    }
}

template <class P> __global__ void __launch_bounds__(256) k_gla_finish(const P proj, const float* __restrict__ nw, float* __restrict__ mixed) {
    const int t = blockIdx.x, h = threadIdx.x >> 6, lane = threadIdx.x & 63;
    float* m = mixed + (size_t)t * D + h * 128;
    const float a = m[lane], b = m[lane + 64];
    const float s = wave_sum(a * a + b * b);
    const float r = rsqrtf(s * (1.f / 128.f) + EPS);
    m[lane] = a * r * nw[lane] * silu_f(proj((size_t)t, C_GOUT + h * 128 + lane));
    m[lane + 64] = b * r * nw[lane + 64] * silu_f(proj((size_t)t, C_GOUT + h * 128 + lane + 64));
}

template <class P> __global__ void __launch_bounds__(256) k_ssd_conv(const P proj, const float* __restrict__ cw, const float* __restrict__ cb, const float* __restrict__ dtb,
                                                  float* __restrict__ xc, float* __restrict__ dt) {
    const int t = blockIdx.x, l = t & (SEQ - 1);
    for (int c = threadIdx.x; c < 768; c += 256) {
        float acc = cb[c];
#pragma unroll
        for (int j = 0; j < 4; ++j) { const int ll = l - 3 + j; if (ll >= 0) acc += cw[j * 768 + c] * proj((size_t)(t - 3 + j), C_XBC + c); }
        xc[(size_t)t * 768 + c] = silu_f(acc);
    }
    if (threadIdx.x < 8) dt[(size_t)t * 8 + threadIdx.x] = softplus_f(proj((size_t)t, C_DT + threadIdx.x) + dtb[threadIdx.x]);
}

__global__ void __launch_bounds__(64) k_ssd_rec(const float* __restrict__ xc, const float* __restrict__ dt, const float* __restrict__ a_log, const float* __restrict__ dsk, float* __restrict__ mixed) {
    const int b = blockIdx.x >> 3, hd = blockIdx.x & 7, g = hd >> 2, p = threadIdx.x;
    const float A = -expf(a_log[hd]), Dk = dsk[hd];
    float hs[64];
#pragma unroll
    for (int n = 0; n < 64; ++n) hs[n] = 0.f;
    for (int t = 0; t < SEQ; ++t) {
        const size_t row = (size_t)b * SEQ + t;
        const float dtv = dt[row * 8 + hd];
        const float dA = expf(dtv * A);
        const float* xr = xc + row * 768;
        const float x = xr[hd * 64 + p], xdt = x * dtv;
        float y = 0.f;
#pragma unroll
        for (int n = 0; n < 64; ++n) {
            hs[n] = dA * hs[n] + xr[512 + g * 64 + n] * xdt;
            y += xr[640 + g * 64 + n] * hs[n];
        }
        mixed[row * D + 512 + hd * 64 + p] = y + x * Dk;
    }
}

template <class P> __global__ void __launch_bounds__(128) k_ssd_finish(const P proj, const float* __restrict__ nw, float* __restrict__ mixed) {
    const int t = blockIdx.x, g = threadIdx.x >> 6, lane = threadIdx.x & 63;
    float* m = mixed + (size_t)t * D + 512 + g * 256;
    float y[4]; float s = 0.f;
#pragma unroll
    for (int j = 0; j < 4; ++j) { y[j] = m[lane + 64 * j] * silu_f(proj((size_t)t, C_Z + g * 256 + lane + 64 * j)); s += y[j] * y[j]; }
    s = wave_sum(s);
    const float r = rsqrtf(s * (1.f / 256.f) + EPS);
#pragma unroll
    for (int j = 0; j < 4; ++j) m[lane + 64 * j] = y[j] * r * nw[g * 256 + lane + 64 * j];
}

__global__ void __launch_bounds__(256) k_topk(const float* __restrict__ q_lo, const float* __restrict__ q_hi, const float* __restrict__ subk, int* __restrict__ idx, float* __restrict__ gate) {
    __shared__ float s[256];
    __shared__ float ts[2][16];
    __shared__ int ti[2][16];
    __shared__ float cs[256];
    __shared__ float bs[16];
    __shared__ int be[16];
    const int t = blockIdx.x >> 3, h = blockIdx.x & 7, tid = threadIdx.x, p = tid >> 7, k = tid & 127;
    const float4* qv = (const float4*)((h < 4 ? q_lo : q_hi) + (size_t)t * 1024 + (h & 3) * 256 + p * 128);
    const float4* kr = (const float4*)(subk + (((size_t)h * 2 + p) * 128 + k) * 128);
    float acc = 0.f;
#pragma unroll 8
    for (int d = 0; d < 32; ++d) { const float4 a = qv[d], b = kr[d]; acc += a.x * b.x + a.y * b.y + a.z * b.z + a.w * b.w; }
    s[tid] = acc;
    __syncthreads();
    int r = 0;
    for (int j = 0; j < 128; ++j) { const float o = s[p * 128 + j]; r += (o > acc || (o == acc && j < k)) ? 1 : 0; }
    if (r < 16) { ts[p][r] = acc; ti[p][r] = k; }
    __syncthreads();
    const int i = tid >> 4, j2 = tid & 15;
    const float c = ts[0][i] + ts[1][j2];
    cs[tid] = c;
    __syncthreads();
    r = 0;
    for (int m = 0; m < 256; ++m) { const float o = cs[m]; r += (o > c || (o == c && m < tid)) ? 1 : 0; }
    if (r < 16) { bs[r] = c; be[r] = ti[0][i] * 128 + ti[1][j2]; }
    __syncthreads();
    if (tid < 16) {
        const float mx = bs[0];
        float den = 0.f;
#pragma unroll
        for (int m = 0; m < 16; ++m) den += expf(bs[m] - mx);
        gate[(size_t)t * 128 + h * 16 + tid] = expf(bs[tid] - mx) / den;
        idx[(size_t)t * 128 + h * 16 + tid] = be[tid];
    }
}

__global__ void __launch_bounds__(256) k_expert(const float* __restrict__ hres, const float* __restrict__ u, const float* __restrict__ v, const int* __restrict__ idx, const float* __restrict__ gate,
                                                const float* __restrict__ nfw, float* out) {
    __shared__ float hid[128];
    __shared__ int eid[128];
    __shared__ float red[4];
    const int t = blockIdx.x, tid = threadIdx.x, w = tid >> 6, lane = tid & 63;
    if (tid < 128) eid[tid] = idx[(size_t)t * 128 + tid];
    float4 xv[4];
#pragma unroll
    for (int j = 0; j < 4; ++j) xv[j] = ((const float4*)(out + (size_t)t * D))[lane + 64 * j];
    __syncthreads();
    for (int e = w * 32; e < w * 32 + 32; ++e) {
        const float4* ur = (const float4*)(u + (size_t)eid[e] * D);
        float s = 0.f;
#pragma unroll
        for (int j = 0; j < 4; ++j) { const float4 a = ur[lane + 64 * j]; s += a.x * xv[j].x + a.y * xv[j].y + a.z * xv[j].z + a.w * xv[j].w; }
        s = wave_sum(s);
        if (lane == 0) hid[e] = gelu_f(s) * gate[(size_t)t * 128 + e];
    }
    __syncthreads();
    float4 acc = ((const float4*)(hres + (size_t)t * D))[tid];
    for (int e = 0; e < 128; ++e) {
        const float4 vv = ((const float4*)(v + (size_t)eid[e] * D))[tid];
        const float hh = hid[e];
        acc.x += hh * vv.x; acc.y += hh * vv.y; acc.z += hh * vv.z; acc.w += hh * vv.w;
    }
    float ss = acc.x * acc.x + acc.y * acc.y + acc.z * acc.z + acc.w * acc.w;
    ss = wave_sum(ss);
    if (lane == 0) red[w] = ss;
    __syncthreads();
    const float tot = red[0] + red[1] + red[2] + red[3];
    const float r = rsqrtf(tot * (1.f / D) + EPS);
    const float4 ww = ((const float4*)nfw)[tid];
    float4 o; o.x = acc.x * r * ww.x; o.y = acc.y * r * ww.y; o.z = acc.z * r * ww.z; o.w = acc.w * r * ww.w;
    ((float4*)(out + (size_t)t * D))[tid] = o;
}
__global__ void __launch_bounds__(256) k_bf2f(const unsigned short* __restrict__ src, float* __restrict__ dst, size_t n) {
    for (size_t i = (size_t)blockIdx.x * 256 + threadIdx.x; i < n; i += (size_t)gridDim.x * 256) dst[i] = bf2f(src[i]);
}
}
extern "C" void kernel_launch(void* const* d_in, const int* in_sizes, int n_in, void* d_out, int out_size, void* d_ws, size_t ws_size, hipStream_t stream) {
    static int grid = 0;
    if (grid == 0) {
        if (n_in != 19 || out_size != T * D || ws_size < 256 * MiB) { fprintf(stderr, "kernel_launch: unexpected shapes n_in %d out %d ws %zu\n", n_in, out_size, ws_size); grid = -1; return; }
        int dev = 0, cus = 0, per_cu = 0;
        if (hipGetDevice(&dev) != hipSuccess || hipDeviceGetAttribute(&cus, hipDeviceAttributeMultiprocessorCount, dev) != hipSuccess) { grid = -1; return; }
        if (hipFuncSetAttribute((const void*)fwd, hipFuncAttributeMaxDynamicSharedMemorySize, LDS_BYTES) != hipSuccess) { fprintf(stderr, "kernel_launch: hipFuncSetAttribute failed\n"); grid = -1; return; }
        if (hipOccupancyMaxActiveBlocksPerMultiprocessor(&per_cu, (const void*)fwd, NWAVES * 64, LDS_BYTES) != hipSuccess || per_cu < 1) { fprintf(stderr, "kernel_launch: occupancy query says %d\n", per_cu); }
        (void)hipGetLastError();
        grid = cus;
    }
    if (grid < 0) return;
    const float* x = (const float*)d_in[0];
    const float* gla_w2 = (const float*)d_in[3];
    const float* gla_bg = (const float*)d_in[4];
    const float* gla_nw = (const float*)d_in[5];
    const float* conv_w = (const float*)d_in[6];
    const float* conv_b = (const float*)d_in[7];
    const float* dt_bias = (const float*)d_in[8];
    const float* a_log = (const float*)d_in[9];
    const float* d_skip = (const float*)d_in[10];
    const float* ssd_nw = (const float*)d_in[11];
    const float* w_out = (const float*)d_in[12];
    const float* norm_ffn_w = (const float*)d_in[13];
    const float* w_query = (const float*)d_in[14];
    const float* sub_keys = (const float*)d_in[15];
    const float* pu = (const float*)d_in[16];
    const float* pv = (const float*)d_in[17];
    const float* norm_final_w = (const float*)d_in[18];
    float* out = (float*)d_out;
    char* ws = (char*)d_ws;

    (void)hipMemsetAsync(ws + WS_CTL, 0, CTL_ZERO_BYTES, stream);
    Args a{};
    for (int i = 0; i < 19; ++i) a.in[i] = (const float*)d_in[i];
    a.out = out; a.ws = (unsigned char*)d_ws; a.ph_lo = 0; a.ph_hi = 9;
    hipLaunchKernelGGL(fwd, dim3(grid), dim3(NWAVES * 64), LDS_BYTES, stream, a);

}
```

```cpp
#include <hip/hip_runtime.h>
#include <cstdio>
#include <cstdint>
namespace pg8 {
#define PG8_LAS __attribute__((address_space(3)))
typedef unsigned short bf16_t;
typedef short bf16x8 __attribute__((ext_vector_type(8)));
typedef float f32x4 __attribute__((ext_vector_type(4)));
typedef unsigned u32x4 __attribute__((ext_vector_type(4)));
constexpr int BM = 256, BK = 64, HALF = 128, HTB = HALF * BK * 2  , STAGE_BYTES = 8 * HTB, NXCD = 8, WGM = 8;

__host__ __device__ __forceinline__ int lds_byte(int r, int c) { const int st = (r >> 4) * 2 + (c >> 5), rr = r & 15, cc = c & 31, ob = rr * 64 + cc * 2; return st * 1024 + (ob ^ (((ob >> 9) & 1) << 5)); }
__host__ __device__ __forceinline__ void stage_rc(int b, int& R, int& C) { const int st = b / 1024, sb = b % 1024, swz = sb ^ (((sb >> 9) & 1) << 5); R = (st >> 1) * 16 + swz / 64; C = (st & 1) * 32 + (swz % 64) / 2; }
__host__ __device__ __forceinline__ int perm32(int rho) { const int n = rho >> 4, i = rho & 15; return 8 * (i >> 2) + 4 * n + (i & 3); }

struct Unit { int pm, pn; };
struct Gemm { const bf16_t* A; const bf16_t* Bt; int M, N, K; };

struct StaticOrder {
    int nM, nN, nwg, G, c;
    __host__ __device__ void init(int M, int N, int G_, int c_) { nM = M / BM; nN = N / BM; nwg = nM * nN; G = G_; c = c_; }
    __host__ __device__ bool next(int i, Unit& u) const {
        const long L = (long)i * G + c; if (L >= nwg) return false;
        int wgid = (int)L; { const int q = nwg / NXCD, r = nwg % NXCD, xcd = wgid % NXCD, off = wgid / NXCD; wgid = (xcd < r ? xcd * (q + 1) : r * (q + 1) + (xcd - r) * q) + off; }
        const int nig = WGM * nN, gid = wgid / nig, fm = gid * WGM, gsz = (nM - fm) < WGM ? (nM - fm) : WGM;
        u.pm = fm + ((wgid % nig) % gsz); u.pn = (wgid % nig) / gsz; return true;
    }
    __device__ __forceinline__ void a_ready(const Unit&) const {}
    __device__ __forceinline__ void done(const Unit&) const {}
};

__device__ __forceinline__ unsigned cvt_pk_bf16(float lo, float hi) { unsigned r; asm volatile("v_cvt_pk_bf16_f32 %0, %1, %2" : "=v"(r) : "v"(lo), "v"(hi)); return r; }
typedef float f32x2 __attribute__((ext_vector_type(2)));
struct EpiRowScaleBf16 {
    static constexpr bool PERM = true, AFTER_DRAIN = false;
    bf16_t* O; int ldc; const float* rs;
    __device__ __forceinline__ void operator()(const f32x4 (&acc)[2][2][4][2], const Unit& u, int wr, int wc, int fr, int fq) const {
        const int row0 = u.pm * BM + wr * 64 + fr, col0 = u.pn * BM + wc * 32 + 8 * fq;
#pragma unroll
        for (int ai = 0; ai < 2; ++ai)
#pragma unroll
            for (int m = 0; m < 4; ++m) { const int row = row0 + ai * HALF + m * 16; const float sc = rs[row]; bf16_t* rowp = O + (size_t)row * ldc + col0;
#pragma unroll
                for (int bj = 0; bj < 2; ++bj) { const f32x4 v0 = acc[ai][bj][m][0] * sc, v1 = acc[ai][bj][m][1] * sc;
                    u32x4 w; w.x = cvt_pk_bf16(v0[0], v0[1]); w.y = cvt_pk_bf16(v0[2], v0[3]); w.z = cvt_pk_bf16(v1[0], v1[1]); w.w = cvt_pk_bf16(v1[2], v1[3]);
                    *(u32x4*)(rowp + bj * HALF) = w; } }
    }
};
struct EpiRsqScaleBf16 {
    static constexpr bool PERM = true, AFTER_DRAIN = false;
    bf16_t* O; int ldc; const float* rowsq;
    __device__ __forceinline__ void operator()(const f32x4 (&acc)[2][2][4][2], const Unit& u, int wr, int wc, int fr, int fq) const {
        const int row0 = u.pm * BM + wr * 64 + fr, col0 = u.pn * BM + wc * 32 + 8 * fq;
#pragma unroll
        for (int ai = 0; ai < 2; ++ai)
#pragma unroll
            for (int m = 0; m < 4; ++m) { const int row = row0 + ai * HALF + m * 16; const float sc = rsqrtf(rowsq[row] * (1.f / 1024.f) + 1e-6f); bf16_t* rowp = O + (size_t)row * ldc + col0;
#pragma unroll
                for (int bj = 0; bj < 2; ++bj) { const f32x4 v0 = acc[ai][bj][m][0] * sc, v1 = acc[ai][bj][m][1] * sc;
                    u32x4 w; w.x = cvt_pk_bf16(v0[0], v0[1]); w.y = cvt_pk_bf16(v0[2], v0[3]); w.z = cvt_pk_bf16(v1[0], v1[1]); w.w = cvt_pk_bf16(v1[2], v1[3]);
                    *(u32x4*)(rowp + bj * HALF) = w; } }
    }
};
struct EpiResidual {
    static constexpr bool PERM = true, AFTER_DRAIN = false;
    const float* X; float* H; bf16_t* HB; float* rowsq; int ldc;
    __device__ __forceinline__ void operator()(const f32x4 (&acc)[2][2][4][2], const Unit& u, int wr, int wc, int fr, int fq) const {
        const int row0 = u.pm * BM + wr * 64 + fr, col0 = u.pn * BM + wc * 32 + 8 * fq;
#pragma unroll
        for (int ai = 0; ai < 2; ++ai)
#pragma unroll
            for (int m = 0; m < 4; ++m) { const int row = row0 + ai * HALF + m * 16; float ss = 0.f;
#pragma unroll
                for (int bj = 0; bj < 2; ++bj) { const size_t off = (size_t)row * ldc + col0 + bj * HALF;
                    const f32x4 v0 = acc[ai][bj][m][0] + *(const f32x4*)(X + off), v1 = acc[ai][bj][m][1] + *(const f32x4*)(X + off + 4);
                    *(f32x4*)(H + off) = v0; *(f32x4*)(H + off + 4) = v1;
                    u32x4 w; w.x = cvt_pk_bf16(v0[0], v0[1]); w.y = cvt_pk_bf16(v0[2], v0[3]); w.z = cvt_pk_bf16(v1[0], v1[1]); w.w = cvt_pk_bf16(v1[2], v1[3]);
                    *(u32x4*)(HB + off) = w;
                    ss += (v0[0] * v0[0] + v0[1] * v0[1]) + (v0[2] * v0[2] + v0[3] * v0[3]) + (v1[0] * v1[0] + v1[1] * v1[1]) + (v1[2] * v1[2] + v1[3] * v1[3]); }
                ss += __shfl_xor(ss, 16); ss += __shfl_xor(ss, 32);
                if (fq == 0) atomicAdd(rowsq + row, ss); }
    }
};
template <class Epi, class Sched, bool ALIGN_EPI = false, bool SP2 = false>
__device__ __forceinline__ void gemm_phase(PG8_LAS unsigned char* lds, const Gemm g, const Sched& S, const Epi& E) {
    const int tid = threadIdx.x, wid = __builtin_amdgcn_readfirstlane(tid >> 6), lane = tid & 63, wr = wid >> 2, wc = wid & 3, fr = lane & 15, fq = lane >> 4;
    const int K = g.K, nt = K / BK;
    unsigned voffA[2], voffB[2];
#pragma unroll
    for (int i = 0; i < 2; ++i) { int R, C; stage_rc(tid * 16 + i * 8192, R, C); const int Rb = Epi::PERM ? ((R & ~31) + perm32(R & 31)) : R;
        voffA[i] = (unsigned)(R * K + C) * 2u; voffB[i] = (unsigned)(Rb * K + C) * 2u; }
    const size_t kstep = (size_t)(BK * 2);
    const size_t hstep = (size_t)HALF * K * 2;
    const size_t tstep = 2 * hstep;
    const unsigned ldsw = (unsigned)wid * 1024u;
    const int aoff = lds_byte(wr * 64 + fr, fq * 8), boff = lds_byte(wc * 32 + fr, fq * 8);
#define PG8_SA(b, h) (((b) * 2 + (h)) * HTB)
#define PG8_SB(b, h) ((4 + (b) * 2 + (h)) * HTB)
#define PG8_STAGE(bufoff, gbase, voff) do { _Pragma("unroll") for (int _i = 0; _i < 2; ++_i) \
        __builtin_amdgcn_global_load_lds((const unsigned*)((const char*)(gbase) + (voff)[_i]), (PG8_LAS unsigned*)(lds + (bufoff) + ldsw + _i * 8192), 16, 0, 0); } while (0)
#define PG8_LDA(dst, b, h) do { _Pragma("unroll") for (int m = 0; m < 4; ++m) _Pragma("unroll") for (int k = 0; k < 2; ++k) dst[m][k] = *(const PG8_LAS bf16x8*)(lds + PG8_SA(b, h) + aoff + m * 2048 + k * 1024); } while (0)
#define PG8_LDB(dst, b, h) do { _Pragma("unroll") for (int n = 0; n < 2; ++n) _Pragma("unroll") for (int k = 0; k < 2; ++k) dst[n][k] = *(const PG8_LAS bf16x8*)(lds + PG8_SB(b, h) + boff + n * 2048 + k * 1024); } while (0)
#define PG8_MMA(ai, bj, At, Bt) do { __builtin_amdgcn_s_setprio(1); _Pragma("unroll") for (int m = 0; m < 4; ++m) _Pragma("unroll") for (int n = 0; n < 2; ++n) _Pragma("unroll") for (int k = 0; k < 2; ++k) \
        acc[ai][bj][m][n] = __builtin_amdgcn_mfma_f32_16x16x32_bf16(Bt[n][k], At[m][k], acc[ai][bj][m][n], 0, 0, 0); __builtin_amdgcn_s_setprio(0); } while (0)
#define PG8_WAIT_V(n) asm volatile("s_waitcnt vmcnt(" #n ")" ::: "memory")
#define PG8_WAIT_L(n) asm volatile("s_waitcnt lgkmcnt(" #n ")" ::: "memory")
#define PG8_BAR __builtin_amdgcn_s_barrier()
#define PG8_SCHED __builtin_amdgcn_sched_barrier(0)
    Unit cur, nxt; int ui = 0;
    if (!S.next(0, cur)) return;
    f32x4 acc[2][2][4][2];
#pragma unroll
    for (int a = 0; a < 2; ++a)
#pragma unroll
        for (int b = 0; b < 2; ++b)
#pragma unroll
            for (int m = 0; m < 4; ++m)
#pragma unroll
                for (int n = 0; n < 2; ++n) acc[a][b][m][n] = (f32x4){0.f, 0.f, 0.f, 0.f};
    bf16x8 At[4][2], B0[2][2], B1[2][2];
    const char* cA = (const char*)g.A + (size_t)cur.pm * tstep; const char* cB = (const char*)g.Bt + (size_t)cur.pn * tstep;
    S.a_ready(cur);
    if constexpr (SP2) {
        PG8_STAGE(PG8_SB(0, 0), cB, voffB); PG8_STAGE(PG8_SB(0, 1), cB + hstep, voffB); PG8_STAGE(PG8_SA(0, 0), cA, voffA); PG8_STAGE(PG8_SA(0, 1), cA + hstep, voffA);
        if (wr == 1) PG8_BAR;
        PG8_WAIT_V(2); PG8_BAR;
        PG8_STAGE(PG8_SB(1, 0), cB + kstep, voffB); PG8_STAGE(PG8_SA(1, 0), cA + kstep, voffA); PG8_STAGE(PG8_SB(1, 1), cB + hstep + kstep, voffB);
        PG8_WAIT_V(6); PG8_BAR;
    } else {
        PG8_STAGE(PG8_SB(0, 0), cB, voffB); PG8_STAGE(PG8_SA(0, 0), cA, voffA); PG8_STAGE(PG8_SB(0, 1), cB + hstep, voffB); PG8_STAGE(PG8_SA(0, 1), cA + hstep, voffA);
        if (wr == 1) PG8_BAR;
        PG8_WAIT_V(4); PG8_BAR;
        PG8_STAGE(PG8_SB(1, 0), cB + kstep, voffB); PG8_STAGE(PG8_SA(1, 0), cA + kstep, voffA); PG8_STAGE(PG8_SB(1, 1), cB + hstep + kstep, voffB);
        PG8_WAIT_V(6); PG8_BAR;
    }
    for (;;) {
        const bool has_next = S.next(ui + 1, nxt);
        const char* nA = has_next ? (const char*)g.A + (size_t)nxt.pm * tstep : cA; const char* nB = has_next ? (const char*)g.Bt + (size_t)nxt.pn * tstep : cB;
        for (int t = 0; t < nt; t += 2) {
            const bool last = (t == nt - 2);
            const char* a1 = cA + (size_t)(t + 1) * kstep;
            const char* a2 = last ? nA : cA + (size_t)(t + 2) * kstep; const char* b2 = last ? nB : cB + (size_t)(t + 2) * kstep;
            const char* a3 = a2 + kstep; const char* b3 = b2 + kstep;
            if (last && has_next) S.a_ready(nxt);
            if constexpr (SP2) {
            PG8_LDB(B0, 0, 0); PG8_LDB(B1, 0, 1); PG8_SCHED; PG8_LDA(At, 0, 0); PG8_STAGE(PG8_SA(1, 1), a1 + hstep, voffA);
            PG8_WAIT_V(8); PG8_WAIT_L(0); PG8_BAR; PG8_MMA(0, 0, At, B0); PG8_MMA(0, 1, At, B1); PG8_BAR; PG8_SCHED;
            PG8_LDA(At, 0, 1); PG8_STAGE(PG8_SB(0, 0), b2, voffB); PG8_STAGE(PG8_SB(0, 1), b2 + hstep, voffB); PG8_STAGE(PG8_SA(0, 0), a2, voffA);
            PG8_WAIT_V(8); PG8_WAIT_L(0); PG8_BAR; PG8_MMA(1, 0, At, B0); PG8_MMA(1, 1, At, B1); PG8_BAR; PG8_SCHED;
            PG8_LDB(B0, 1, 0); PG8_LDB(B1, 1, 1); PG8_SCHED; PG8_LDA(At, 1, 0); PG8_STAGE(PG8_SA(0, 1), a2 + hstep, voffA);
            PG8_WAIT_V(8); PG8_WAIT_L(0); PG8_BAR; PG8_MMA(0, 0, At, B0); PG8_MMA(0, 1, At, B1); PG8_BAR; PG8_SCHED;
            PG8_LDA(At, 1, 1); PG8_STAGE(PG8_SB(1, 0), b3, voffB); PG8_STAGE(PG8_SB(1, 1), b3 + hstep, voffB); PG8_STAGE(PG8_SA(1, 0), a3, voffA);
            PG8_WAIT_V(8); PG8_WAIT_L(0); PG8_BAR; PG8_MMA(1, 0, At, B0); PG8_MMA(1, 1, At, B1); PG8_BAR; PG8_SCHED;
            } else {
            PG8_LDB(B0, 0, 0); PG8_SCHED; PG8_LDA(At, 0, 0); PG8_STAGE(PG8_SA(1, 1), a1 + hstep, voffA);
            PG8_WAIT_L(8); PG8_BAR; PG8_WAIT_L(0); PG8_MMA(0, 0, At, B0); PG8_BAR; PG8_SCHED;
            PG8_LDB(B1, 0, 1); PG8_STAGE(PG8_SB(0, 0), b2, voffB);
            PG8_BAR; PG8_WAIT_L(0); PG8_MMA(0, 1, At, B1); PG8_BAR;
            PG8_LDA(At, 0, 1); PG8_STAGE(PG8_SA(0, 0), a2, voffA);
            PG8_BAR; PG8_WAIT_L(0); PG8_MMA(1, 0, At, B0); PG8_BAR; PG8_SCHED;
            PG8_STAGE(PG8_SB(0, 1), b2 + hstep, voffB);
            PG8_WAIT_V(6); PG8_BAR; PG8_MMA(1, 1, At, B1); PG8_BAR;
            PG8_LDB(B0, 1, 0); PG8_SCHED; PG8_LDA(At, 1, 0); PG8_STAGE(PG8_SA(0, 1), a2 + hstep, voffA);
            PG8_WAIT_L(8); PG8_BAR; PG8_WAIT_L(0); PG8_MMA(0, 0, At, B0); PG8_BAR; PG8_SCHED;
            PG8_LDB(B1, 1, 1); PG8_STAGE(PG8_SB(1, 0), b3, voffB);
            PG8_BAR; PG8_WAIT_L(0); PG8_MMA(0, 1, At, B1); PG8_BAR;
            PG8_LDA(At, 1, 1); PG8_STAGE(PG8_SA(1, 0), a3, voffA);
            PG8_BAR; PG8_WAIT_L(0); PG8_MMA(1, 0, At, B0); PG8_BAR; PG8_SCHED;
            PG8_STAGE(PG8_SB(1, 1), b3 + hstep, voffB);
            PG8_WAIT_V(6); PG8_BAR; PG8_MMA(1, 1, At, B1); PG8_BAR;
            }
        }
        if constexpr (ALIGN_EPI) { if (wr == 0) PG8_BAR; }
        if constexpr (!Epi::AFTER_DRAIN) { E(acc, cur, wr, wc, fr, fq); S.done(cur); }
        if (!has_next) break;
#pragma unroll
        for (int a = 0; a < 2; ++a)
#pragma unroll
            for (int b = 0; b < 2; ++b)
#pragma unroll
                for (int m = 0; m < 4; ++m)
#pragma unroll
                    for (int n = 0; n < 2; ++n) acc[a][b][m][n] = (f32x4){0.f, 0.f, 0.f, 0.f};
        cur = nxt; cA = nA; cB = nB; ++ui;
        if constexpr (ALIGN_EPI) { if (wr == 1) PG8_BAR; }
    }
    PG8_WAIT_V(0);
    if constexpr (!ALIGN_EPI) { if (wr == 0) PG8_BAR; }
    PG8_BAR;
    if constexpr (Epi::AFTER_DRAIN) { E.fused(acc, cur, wr, wc, fr, fq, lds, wid, lane); S.done(cur); }
#undef PG8_SA
#undef PG8_SB
#undef PG8_STAGE
#undef PG8_LDA
#undef PG8_LDB
#undef PG8_MMA
#undef PG8_WAIT_V
#undef PG8_WAIT_L
#undef PG8_BAR
#undef PG8_SCHED
}
}
constexpr int NWAVES = 8;
constexpr int T = 16384, SEQ = 8192, D = 1024, NIN = 2840, NINP = 3072, NQ = 2048;
constexpr int C_Q = 0, C_K = 256, C_V = 512, C_GLR = 1024, C_GOUT = 1040, C_Z = 1552, C_XBC = 2064, C_DT = 2832;
constexpr float EPS = 1e-6f;
constexpr size_t MiB = 1u << 20;
constexpr size_t WS_CTL = 0, CTL_ZERO_BYTES = 64 * 1024;
constexpr size_t WS_WIN = 1 * MiB;
constexpr size_t WS_WO = 7 * MiB;
constexpr size_t WS_WQ = 9 * MiB;
constexpr size_t WS_SUBK = 13 * MiB;
constexpr size_t WS_RRMS1 = 14 * MiB;
constexpr size_t WS_ROWSQ2 = 14 * MiB + 64 * 1024;
constexpr size_t WS_UB = 16 * MiB, WS_VB = 48 * MiB;
constexpr size_t WS_XB = 80 * MiB;
constexpr size_t WS_PROJ = 112 * MiB;
constexpr int CW_TMO = 0, CW_BAR = 1024;
constexpr int RING_OFF = 0, RING_BYTES = 131072;
constexpr int LDS_BYTES = 163840;
constexpr int LDSCTL_OFF = LDS_BYTES - 1024, MISC_OFF = LDSCTL_OFF + 320;

#define GAS __attribute__((address_space(1)))
#define LAS __attribute__((address_space(3)))
typedef unsigned short bf16;
typedef unsigned v4u __attribute__((ext_vector_type(4)));
typedef float f32x4 __attribute__((ext_vector_type(4)));
typedef short bf16x8 __attribute__((ext_vector_type(8)));
typedef GAS unsigned gu32;
#define RLX_AGENT __ATOMIC_RELAXED, __HIP_MEMORY_SCOPE_AGENT
#define LDS_WAIT() asm volatile("s_waitcnt lgkmcnt(0)" ::: "memory")
#define VM_WAIT() asm volatile("s_waitcnt vmcnt(0)" ::: "memory")
__device__ __forceinline__ unsigned f2bf(float f) { unsigned u = __builtin_bit_cast(unsigned, f); return (u + 0x7fffu + ((u >> 16) & 1u)) >> 16; }
__device__ __forceinline__ unsigned pk2(float lo, float hi) { return f2bf(lo) | (f2bf(hi) << 16); }
__device__ __forceinline__ float bf2f(unsigned short b) { return __builtin_bit_cast(float, (unsigned)b << 16); }
__device__ __forceinline__ float wave_sum(float v) {
#pragma unroll
    for (int o = 1; o < 64; o <<= 1) v += __shfl_xor(v, o);
    return v;
}
#define XB_TMO      128
#define XB_XCNT(j)  (256  + 64 * (j))
#define XB_XSUB(j)  (1280 + 64 * (j))
#define XB_XGEN(j)  (2304 + 64 * (j))
#define XB_TOP      3328
#define XB_TOPGEN   3392
#define XCD_BAR_WORDS 3456
#define XB_SPIN_CAP (1u << 18)

__device__ __forceinline__ unsigned xb_ld(unsigned* p)              { return __hip_atomic_load(p, __ATOMIC_RELAXED, __HIP_MEMORY_SCOPE_AGENT); }
__device__ __forceinline__ unsigned xb_add(unsigned* p, unsigned v) { return __hip_atomic_fetch_add(p, v, __ATOMIC_RELAXED, __HIP_MEMORY_SCOPE_AGENT); }
__device__ __forceinline__ unsigned xb_xcc_id() { return (unsigned)__builtin_amdgcn_s_getreg((3 << 11) | 20) & 0xFu; }
#define XB_SPIN(cond, bar) do { unsigned _sp = 0; while (cond) { __builtin_amdgcn_s_sleep(1); \
    if ((++_sp & 255u) == 0u) { if (xb_ld(&(bar)[XB_TMO])) break; if (_sp > XB_SPIN_CAP) { atomicAdd(&(bar)[XB_TMO], 1u); break; } } } } while (0)

struct XcdBarrier {
    unsigned* bar; unsigned x;
    volatile LAS unsigned* st;
};

__device__ __forceinline__ XcdBarrier xcd_barrier_post(unsigned* bar, volatile LAS unsigned* st) {
    XcdBarrier b; b.bar = bar; b.x = xb_xcc_id(); b.st = st;
    if (threadIdx.x == 0) (void)xb_add(&bar[XB_XCNT(b.x)], 1u);
    return b;
}
__device__ __forceinline__ void xcd_barrier_complete(unsigned* bar, unsigned x, unsigned& nloc, unsigned& nx) {
    const unsigned G = gridDim.x * gridDim.y * gridDim.z;
    unsigned sum, cnt, mine, sp = 0u;
    for (;;) {
        sum = 0u; cnt = 0u; mine = 0u;
#pragma unroll
        for (unsigned j = 0; j < 16; ++j) { const unsigned c = xb_ld(&bar[XB_XCNT(j)]); sum += c; cnt += (c > 0u) ? 1u : 0u; mine = (j == x) ? c : mine; }
        if (sum == G) break;
        __builtin_amdgcn_s_sleep(1);
        if ((++sp & 255u) == 0u) { if (xb_ld(&bar[XB_TMO])) break; if (sp > XB_SPIN_CAP) { atomicAdd(&bar[XB_TMO], 1u); break; } }
    }
    nloc = mine > 0u ? mine : 1u; nx = cnt > 0u ? cnt : 1u;
}

__device__ __forceinline__ void xcd_barrier(const XcdBarrier& b) {
    asm volatile("s_waitcnt vmcnt(0)" ::: "memory");
    __syncthreads();
    if (threadIdx.x == 0) {
        unsigned* bar = b.bar;
        __builtin_amdgcn_s_waitcnt(0);
        unsigned nloc = b.st[0], nx = b.st[1];
        if (nloc == 0u) { xcd_barrier_complete(bar, b.x, nloc, nx); b.st[0] = nloc; b.st[1] = nx; }
        const unsigned old = xb_add(&bar[XB_XSUB(b.x)], 1u);
        const unsigned gen = old / nloc;
        if (old + 1u == (gen + 1u) * nloc) {
            __builtin_amdgcn_fence(__ATOMIC_RELEASE, "agent");
            asm volatile("s_waitcnt vmcnt(0)" ::: "memory");
            const unsigned og = xb_add(&bar[XB_TOP], 1u);
            const unsigned tg = og / nx;
            if (og + 1u == (tg + 1u) * nx) xb_add(&bar[XB_TOPGEN], 1u);
            else XB_SPIN(xb_ld(&bar[XB_TOPGEN]) == tg, bar);
            __builtin_amdgcn_fence(__ATOMIC_ACQUIRE, "agent");
            xb_add(&bar[XB_XGEN(b.x)], 1u);
            asm volatile("s_waitcnt vmcnt(0)" ::: "memory");
        } else {
            XB_SPIN(xb_ld(&bar[XB_XGEN(b.x)]) == gen, bar);
            __builtin_amdgcn_fence(__ATOMIC_ACQUIRE, "agent");
            asm volatile("s_waitcnt vmcnt(0)" ::: "memory");
        }
    }
    __syncthreads();
}
struct Args {
    const float* in[19]; float* out; unsigned char* ws; int ph_lo, ph_hi;
};
struct Frame {
    LAS unsigned char* lds; volatile LAS unsigned* MISC; gu32* ctl;
    int tid, lane, wave, G, gw, NGW;
};

constexpr size_t WS_GDEC = 14 * MiB + 128 * 1024;
constexpr size_t WS_SDEC = 14 * MiB + 512 * 1024;
constexpr size_t WS_GST = 208 * MiB;
constexpr size_t WS_SST = 224 * MiB;
constexpr int SA64 = 144, SA128 = 272, SA32 = 80;

__device__ __forceinline__ float silu_f(float x) { return x / (1.f + __expf(-x)); }
__device__ __forceinline__ float softplus_f(float x) { return fmaxf(x, 0.f) + log1pf(__expf(-fabsf(x))); }
__device__ __forceinline__ float logsigmoid_f(float x) { return fminf(x, 0.f) - log1pf(__expf(-fabsf(x))); }
typedef unsigned u32x2 __attribute__((ext_vector_type(2)));

__device__ __forceinline__ f32x4 mma16(const LAS unsigned char* A, int sa, const LAS unsigned char* Bt, int sb, int K, f32x4 acc, int r, int kg) {
    for (int k0 = 0; k0 < K; k0 += 32) {
        const bf16x8 a = *(const LAS bf16x8*)(A + r * sa + (k0 + 8 * kg) * 2);
        const bf16x8 b = *(const LAS bf16x8*)(Bt + r * sb + (k0 + 8 * kg) * 2);
        acc = __builtin_amdgcn_mfma_f32_16x16x32_bf16(a, b, acc, 0, 0, 0);
    }
    return acc;
}

__device__ __forceinline__ void unpack8f(const v4u x, float (&f)[8]) {
    f[0] = __builtin_bit_cast(float, x.x << 16); f[1] = __builtin_bit_cast(float, x.x & 0xffff0000u); f[2] = __builtin_bit_cast(float, x.y << 16); f[3] = __builtin_bit_cast(float, x.y & 0xffff0000u);
    f[4] = __builtin_bit_cast(float, x.z << 16); f[5] = __builtin_bit_cast(float, x.z & 0xffff0000u); f[6] = __builtin_bit_cast(float, x.w << 16); f[7] = __builtin_bit_cast(float, x.w & 0xffff0000u);
}
template <int MODE>
__device__ __forceinline__ void gla_unit(const Frame& F, const Args& A, int unit) {
    const int b = unit >> 9, c = (unit >> 2) & 127, h = unit & 3;
    const size_t t0 = (size_t)b * SEQ + (size_t)c * 64;
    const GAS bf16* proj = (const GAS bf16*)(A.ws + WS_PROJ);
    LAS unsigned char* L = F.lds;
    LAS float* GLR = (LAS float*)(L + 0);
    LAS float* SEG = (LAS float*)(L + 4096);
    LAS float* RSQ = (LAS float*)(L + 6144);
    LAS unsigned char* QI = L + 8192;
    LAS unsigned char* KI = QI + 64 * SA64;
    LAS unsigned char* VT = KI + 64 * SA64;
    LAS unsigned char* SP = VT + 128 * SA64;
    LAS unsigned char* AT = SP + 128 * SA64;
    LAS unsigned char* GO = AT + 64 * SA64;
    int tid = F.tid, seg = F.wave;
    asm volatile("" : "+v"(tid)); asm volatile("" : "+s"(seg));
    const int d = tid & 63;
    {
        const int row = tid >> 3, ch = tid & 7;
        const GAS bf16* prow = proj + (t0 + row) * NINP;
        const v4u kq = *(const GAS v4u*)(prow + C_K + h * 64 + ch * 8);
        v4u qq = kq; if (MODE == 1) qq = *(const GAS v4u*)(prow + C_Q + h * 64 + ch * 8);
        const int o = tid & 15, jp = tid >> 4;
        const v4u va = *(const GAS v4u*)(proj + (t0 + 2 * jp) * NINP + C_V + h * 128 + o * 8), vb = *(const GAS v4u*)(proj + (t0 + 2 * jp + 1) * NINP + C_V + h * 128 + o * 8);
        v4u g0 = kq, g1 = kq, s0 = kq, s1 = kq;
        if (MODE == 1) {
            const int r2 = tid >> 4, c2 = tid & 15;
            g0 = *(const GAS v4u*)(proj + (t0 + r2) * NINP + C_GOUT + h * 128 + c2 * 8); g1 = *(const GAS v4u*)(proj + (t0 + r2 + 32) * NINP + C_GOUT + h * 128 + c2 * 8);
            const GAS bf16* sp = (const GAS bf16*)(A.ws + WS_GST) + (size_t)unit * 8192;
            s0 = *(const GAS v4u*)(sp + (tid >> 3) * 64 + (tid & 7) * 8); s1 = *(const GAS v4u*)(sp + (64 + (tid >> 3)) * 64 + (tid & 7) * 8);
        }
        v4u gl = kq; if (tid < 128) gl = *(const GAS v4u*)(proj + (t0 + (tid >> 1)) * NINP + C_GLR + (tid & 1) * 8);
        if (MODE == 1) { *(LAS v4u*)(QI + row * SA64 + ch * 16) = qq; *(LAS v4u*)(KI + row * SA64 + ch * 16) = kq; }
        else *(LAS v4u*)(GO + row * SA64 + ch * 16) = kq;
        {   const unsigned aw[4] = {va.x, va.y, va.z, va.w}, bw[4] = {vb.x, vb.y, vb.z, vb.w};
#pragma unroll
            for (int cc = 0; cc < 8; ++cc) { const unsigned x = aw[cc >> 1], y = bw[cc >> 1];
                const unsigned wv_ = (cc & 1) ? ((x >> 16) | (y & 0xffff0000u)) : ((x & 0xffffu) | (y << 16));
                *(LAS unsigned*)(VT + (8 * o + cc) * SA64 + jp * 4) = wv_; } }
        if (MODE == 1) {
            const int r2 = tid >> 4, c2 = tid & 15;
            *(LAS v4u*)(GO + r2 * SA128 + c2 * 16) = g0; *(LAS v4u*)(GO + (r2 + 32) * SA128 + c2 * 16) = g1;
            *(LAS v4u*)(SP + (tid >> 3) * SA64 + (tid & 7) * 16) = s0; *(LAS v4u*)(SP + (64 + (tid >> 3)) * SA64 + (tid & 7) * 16) = s1;
        }
        if (tid < 128) { float f[8]; unpack8f(gl, f);
#pragma unroll
            for (int q = 0; q < 8; ++q) GLR[(tid >> 1) * 16 + (tid & 1) * 8 + q] = f[q]; }
    }
    float wv[16];
#pragma unroll
    for (int r = 0; r < 16; ++r) wv[r] = A.in[3][r * 256 + h * 64 + d];
    const float bgv = A.in[4][h * 64 + d];
    __syncthreads();
    float Gv[8]; float run = 0.f;
#pragma unroll
    for (int ii = 0; ii < 8; ++ii) { const int i = seg * 8 + ii; float z = bgv;
#pragma unroll
        for (int r = 0; r < 16; ++r) z += GLR[i * 16 + r] * wv[r];
        run += logsigmoid_f(z) * (1.f / 16.f); Gv[ii] = run; }
    SEG[seg * 64 + d] = run;
    __syncthreads();
    float off = 0.f, tot = 0.f;
#pragma unroll
    for (int s = 0; s < 8; ++s) { const float v = SEG[s * 64 + d]; tot += v; off += (s < seg) ? v : 0.f; }
#pragma unroll
    for (int ii = 0; ii < 8; ++ii) Gv[ii] += off;
    if (MODE == 0) {
        unsigned w[4];
#pragma unroll
        for (int ii = 0; ii < 8; ii += 2) {
            const float k0 = bf2f(*(const LAS bf16*)(GO + (seg * 8 + ii) * SA64 + d * 2)) * __expf(tot - Gv[ii]);
            const float k1 = bf2f(*(const LAS bf16*)(GO + (seg * 8 + ii + 1) * SA64 + d * 2)) * __expf(tot - Gv[ii + 1]);
            w[ii >> 1] = pk2(k0, k1); }
        *(LAS v4u*)(KI + d * SA64 + seg * 16) = (v4u){w[0], w[1], w[2], w[3]};
        if (seg == 0) ((GAS float*)(A.ws + WS_GDEC))[unit * 64 + d] = __expf(tot);
    } else {
#pragma unroll
        for (int ii = 0; ii < 8; ++ii) { const int i = seg * 8 + ii;
            LAS bf16* qp = (LAS bf16*)(QI + i * SA64 + d * 2); LAS bf16* kp = (LAS bf16*)(KI + i * SA64 + d * 2);
            *qp = (bf16)f2bf(bf2f(*qp) * 0.125f * __expf(Gv[ii])); *kp = (bf16)f2bf(bf2f(*kp) * __expf(-Gv[ii])); }
    }
    __syncthreads();
    const int r = tid & 15, kg = (tid >> 4) & 3, w = seg;
    const f32x4 zero = (f32x4){0.f, 0.f, 0.f, 0.f};
    if (MODE == 0) {
        const int mt = w & 3, nb = (w >> 2) * 4;
        GAS bf16* stT = (GAS bf16*)(A.ws + WS_GST) + (size_t)unit * 8192;
#pragma unroll
        for (int n = 0; n < 4; ++n) {
            const f32x4 acc = mma16(KI + mt * 16 * SA64, SA64, VT + (nb + n) * 16 * SA64, SA64, 64, zero, r, kg);
            const int dv = (nb + n) * 16 + r, d0 = mt * 16 + kg * 4;
            *(GAS u32x2*)(stT + dv * 64 + d0) = (u32x2){pk2(acc[0], acc[1]), pk2(acc[2], acc[3])}; }
    } else {
        const int mt = w & 3;
#pragma unroll
        for (int n = 0; n < 2; ++n) { const int nt = (w >> 2) * 2 + n;
            const f32x4 acc = mma16(QI + mt * 16 * SA64, SA64, KI + nt * 16 * SA64, SA64, 64, zero, r, kg);
#pragma unroll
            for (int ii = 0; ii < 4; ++ii) { const int i = mt * 16 + kg * 4 + ii, j = nt * 16 + r; *(LAS bf16*)(AT + i * SA64 + j * 2) = (bf16)f2bf(j <= i ? acc[ii] : 0.f); } }
        __syncthreads();
        const int nb = (w >> 2) * 4;
        f32x4 o[4]; float rs[4] = {0.f, 0.f, 0.f, 0.f};
#pragma unroll
        for (int n = 0; n < 4; ++n) {
            f32x4 acc = mma16(AT + mt * 16 * SA64, SA64, VT + (nb + n) * 16 * SA64, SA64, 64, zero, r, kg);
            acc = mma16(QI + mt * 16 * SA64, SA64, SP + (nb + n) * 16 * SA64, SA64, 64, acc, r, kg);
            o[n] = acc;
#pragma unroll
            for (int ii = 0; ii < 4; ++ii) rs[ii] += acc[ii] * acc[ii]; }
#pragma unroll
        for (int ii = 0; ii < 4; ++ii) { rs[ii] += __shfl_xor(rs[ii], 1); rs[ii] += __shfl_xor(rs[ii], 2); rs[ii] += __shfl_xor(rs[ii], 4); rs[ii] += __shfl_xor(rs[ii], 8); }
        if (r == 0) {
#pragma unroll
            for (int ii = 0; ii < 4; ++ii) RSQ[(w >> 2) * 64 + mt * 16 + kg * 4 + ii] = rs[ii]; }
        __syncthreads();
        float rr[4];
#pragma unroll
        for (int ii = 0; ii < 4; ++ii) { const int row = mt * 16 + kg * 4 + ii; rr[ii] = rsqrtf((RSQ[row] + RSQ[64 + row]) * (1.f / 128.f) + EPS); }
#pragma unroll
        for (int n = 0; n < 4; ++n) { const int dv = (nb + n) * 16 + r; const float nwv = A.in[5][dv];
#pragma unroll
            for (int ii = 0; ii < 4; ++ii) { LAS bf16* gp = (LAS bf16*)(GO + (mt * 16 + kg * 4 + ii) * SA128 + dv * 2);
                *gp = (bf16)f2bf(o[n][ii] * rr[ii] * nwv * silu_f(bf2f(*gp))); } }
        __syncthreads();
        {   const int r2 = tid >> 4, c2 = tid & 15; GAS bf16* mixed = (GAS bf16*)(A.ws + WS_XB);
            *(GAS v4u*)(mixed + (t0 + r2) * D + h * 128 + c2 * 8) = *(const LAS v4u*)(GO + r2 * SA128 + c2 * 16);
            *(GAS v4u*)(mixed + (t0 + r2 + 32) * D + h * 128 + c2 * 8) = *(const LAS v4u*)(GO + (r2 + 32) * SA128 + c2 * 16); }
    }
    __syncthreads();
}

template <int MODE>
__device__ __forceinline__ void ssd_unit(const Frame& F, const Args& A, int unit) {
    const int b = unit >> 7, c = (unit >> 1) & 63, g = unit & 1;
    const size_t t0 = (size_t)b * SEQ + (size_t)c * 128;
    const GAS bf16* proj = (const GAS bf16*)(A.ws + WS_PROJ);
    LAS unsigned char* L = F.lds;
    LAS float* DT = (LAS float*)(L + 0);
    LAS float* ACU = (LAS float*)(L + 2048);
    LAS unsigned char* CM = L + 4096;
    LAS unsigned char* BM = CM + 128 * SA64;
    LAS unsigned char* XT = BM + 128 * SA64;
    LAS unsigned char* PW = XT + 4 * 64 * SA128;
    LAS unsigned char* ZW = PW + 8 * 16 * SA32;
    LAS float* RRW = (LAS float*)(ZW + 8 * 16 * SA64);
    int tid = F.tid, w = F.wave;
    asm volatile("" : "+v"(tid)); asm volatile("" : "+s"(w));
    const int lane = tid & 63;
    if (w < 4) {
        const int hd = g * 4 + w; const float Ah = -__expf(A.in[9][hd]), dtb = A.in[8][hd];
        const float dt0 = softplus_f(bf2f(proj[(t0 + 2 * lane) * NINP + C_DT + hd]) + dtb), dt1 = softplus_f(bf2f(proj[(t0 + 2 * lane + 1) * NINP + C_DT + hd]) + dtb);
        const float a0 = dt0 * Ah, a1 = dt1 * Ah; float s = a0 + a1;
#pragma unroll
        for (int o = 1; o < 64; o <<= 1) { const float t = __shfl_up(s, o); s += (lane >= o) ? t : 0.f; }
        DT[(2 * lane) * 4 + w] = dt0; DT[(2 * lane + 1) * 4 + w] = dt1; ACU[(2 * lane) * 4 + w] = s - a1; ACU[(2 * lane + 1) * 4 + w] = s;
        if (MODE == 0 && lane == 63) ((GAS float*)(A.ws + WS_SDEC))[(b * 64 + c) * 8 + hd] = __expf(s);
    }
    __syncthreads();
    if (tid < 384) {
        const int o = tid % 48, sg = tid / 48;
        if (!(MODE == 0 && o >= 40)) {
            const int cc0 = o < 32 ? g * 256 + 8 * o : (o < 40 ? 512 + g * 64 + 8 * (o - 32) : 640 + g * 64 + 8 * (o - 40));
            float wt[4][8], cb[8];
#pragma unroll
            for (int j = 0; j < 4; ++j) { const f32x4 a = *(const GAS f32x4*)(A.in[6] + j * 768 + cc0), bq = *(const GAS f32x4*)(A.in[6] + j * 768 + cc0 + 4);
                wt[j][0] = a.x; wt[j][1] = a.y; wt[j][2] = a.z; wt[j][3] = a.w; wt[j][4] = bq.x; wt[j][5] = bq.y; wt[j][6] = bq.z; wt[j][7] = bq.w; }
            { const f32x4 a = *(const GAS f32x4*)(A.in[7] + cc0), bq = *(const GAS f32x4*)(A.in[7] + cc0 + 4); cb[0] = a.x; cb[1] = a.y; cb[2] = a.z; cb[3] = a.w; cb[4] = bq.x; cb[5] = bq.y; cb[6] = bq.z; cb[7] = bq.w; }
            const GAS bf16* src = proj + (t0 + 16 * sg) * NINP + C_XBC + cc0;
            float x0[8], x1[8], x2[8];
            if (c > 0 || sg > 0) { unpack8f(*(const GAS v4u*)(src - 3 * NINP), x0); unpack8f(*(const GAS v4u*)(src - 2 * NINP), x1); unpack8f(*(const GAS v4u*)(src - 1 * NINP), x2); }
            else {
#pragma unroll
                for (int q = 0; q < 8; ++q) { x0[q] = 0.f; x1[q] = 0.f; x2[q] = 0.f; } }
            const int hl = o >> 3, p0 = (o & 7) * 8;
            float sc_end = 0.f; if (MODE == 0 && o < 32) sc_end = ACU[127 * 4 + hl];
#pragma unroll 1
            for (int hf = 0; hf < 2; ++hf) {
                v4u xin[8];
#pragma unroll
                for (int i = 0; i < 8; ++i) xin[i] = *(const GAS v4u*)(src + (size_t)(hf * 8 + i) * NINP);
                unsigned tp[8][4];
#pragma unroll
                for (int i = 0; i < 8; ++i) {
                    const int l = 16 * sg + hf * 8 + i;
                    float xc[8]; unpack8f(xin[i], xc);
                    float v[8];
#pragma unroll
                    for (int q = 0; q < 8; ++q) v[q] = silu_f(cb[q] + wt[0][q] * x0[q] + wt[1][q] * x1[q] + wt[2][q] * x2[q] + wt[3][q] * xc[q]);
#pragma unroll
                    for (int q = 0; q < 8; ++q) { x0[q] = x1[q]; x1[q] = x2[q]; x2[q] = xc[q]; }
                    if (o < 32 || (MODE == 0)) {
                        if (MODE == 0 && o < 32) { const float sc = DT[l * 4 + hl] * __expf(sc_end - ACU[l * 4 + hl]);
#pragma unroll
                            for (int q = 0; q < 8; ++q) v[q] *= sc; }
#pragma unroll
                        for (int q = 0; q < 8; ++q) { const unsigned bv = f2bf(v[q]); if (i & 1) tp[q][i >> 1] |= bv << 16; else tp[q][i >> 1] = bv; }
                    } else {
                        const v4u ov = (v4u){pk2(v[0], v[1]), pk2(v[2], v[3]), pk2(v[4], v[5]), pk2(v[6], v[7])};
                        *(LAS v4u*)((o < 40 ? BM : CM) + l * SA64 + (o & 7) * 16) = ov;
                    }
                }
                if (o < 32 || (MODE == 0)) {
                    LAS unsigned char* dst = (o < 32) ? XT + hl * 64 * SA128 + p0 * SA128 : CM + ((o & 7) * 8) * SA128;
#pragma unroll
                    for (int q = 0; q < 8; ++q) *(LAS v4u*)(dst + q * SA128 + (16 * sg + hf * 8) * 2) = (v4u){tp[q][0], tp[q][1], tp[q][2], tp[q][3]};
                }
            }
        }
    }
    __syncthreads();
    const int r = lane & 15, kg = lane >> 4;
    const f32x4 zero = (f32x4){0.f, 0.f, 0.f, 0.f};
    if (MODE == 0) {
        const int hl = w >> 1;
        GAS bf16* st = (GAS bf16*)(A.ws + WS_SST) + ((size_t)((b * 64 + c) * 8 + g * 4 + hl)) * 4096;
#pragma unroll
        for (int mt = 0; mt < 4; ++mt)
#pragma unroll
            for (int n = 0; n < 2; ++n) { const int nt = (w & 1) * 2 + n;
                const f32x4 acc = mma16(CM + mt * 16 * SA128, SA128, XT + hl * 64 * SA128 + nt * 16 * SA128, SA128, 128, zero, r, kg);
                const int p = nt * 16 + r, n0 = mt * 16 + kg * 4;
                *(GAS u32x2*)(st + p * 64 + n0) = (u32x2){pk2(acc[0], acc[1]), pk2(acc[2], acc[3])}; }
    } else {
        f32x4 sc[8];
#pragma unroll
        for (int nt = 0; nt < 8; ++nt) { sc[nt] = zero; if (nt <= w) sc[nt] = mma16(CM + w * 16 * SA64, SA64, BM + nt * 16 * SA64, SA64, 64, zero, r, kg); }
        __syncthreads();
        const GAS bf16* spg = (const GAS bf16*)(A.ws + WS_SST) + ((size_t)((b * 64 + c) * 8 + g * 4)) * 4096;
        for (int e = tid; e < 1024; e += 512) { const int row = e >> 3, ch = e & 7; *(LAS v4u*)(BM + row * SA64 + ch * 16) = *(const GAS v4u*)(spg + row * 64 + ch * 8); }
        __syncthreads();
        float rs[4] = {0.f, 0.f, 0.f, 0.f};
        LAS unsigned char* pw = PW + w * 16 * SA32;
        LAS unsigned char* zw = ZW + w * 16 * SA64;
        const int orow = lane >> 3, och = lane & 7;
        const GAS bf16* zsrc = proj + (t0 + w * 16 + orow) * NINP + C_Z + g * 256 + och * 8;
        v4u ysave[4][2];
#pragma unroll
        for (int hl = 0; hl < 4; ++hl) {
            if (hl == 2) {
                __syncthreads();
                for (int e = tid; e < 1024; e += 512) { const int row = e >> 3, ch = e & 7; *(LAS v4u*)(BM + row * SA64 + ch * 16) = *(const GAS v4u*)(spg + 2 * 4096 + row * 64 + ch * 8); }
                __syncthreads();
            }
            asm volatile("" ::: "memory");
            const v4u z0 = *(const GAS v4u*)(zsrc + hl * 64), z1 = *(const GAS v4u*)(zsrc + (size_t)8 * NINP + hl * 64);
            float acl[4];
#pragma unroll
            for (int ii = 0; ii < 4; ++ii) acl[ii] = ACU[(w * 16 + kg * 4 + ii) * 4 + hl];
            f32x4 yd[4] = {zero, zero, zero, zero};
            const LAS unsigned char* xth = XT + hl * 64 * SA128;
#pragma unroll
            for (int kc = 0; kc < 4; ++kc) {
                if (kc * 2 <= w) {
#pragma unroll
                    for (int half = 0; half < 2; ++half) { const int stl = 2 * kc + half; const int s = stl * 16 + r;
                        const float acs = ACU[s * 4 + hl], dts = DT[s * 4 + hl];
#pragma unroll
                        for (int ii = 0; ii < 4; ++ii) { const int l = w * 16 + kg * 4 + ii;
                            const float pv = (s <= l) ? sc[stl][ii] * __expf(acl[ii] - acs) * dts : 0.f;
                            *(LAS bf16*)(pw + (kg * 4 + ii) * SA32 + (half * 16 + r) * 2) = (bf16)f2bf(pv); } }
                    LDS_WAIT();
                    const bf16x8 a = *(const LAS bf16x8*)(pw + r * SA32 + kg * 16);
#pragma unroll
                    for (int nt = 0; nt < 4; ++nt) { const bf16x8 bb = *(const LAS bf16x8*)(xth + (nt * 16 + r) * SA128 + (kc * 32 + 8 * kg) * 2);
                        yd[nt] = __builtin_amdgcn_mfma_f32_16x16x32_bf16(a, bb, yd[nt], 0, 0, 0); }
                    LDS_WAIT();
                }
            }
            *(LAS v4u*)(zw + orow * SA64 + och * 16) = z0; *(LAS v4u*)(zw + (orow + 8) * SA64 + och * 16) = z1;
            LDS_WAIT();
            const float Dk = A.in[10][g * 4 + hl];
            float eal[4];
#pragma unroll
            for (int ii = 0; ii < 4; ++ii) eal[ii] = __expf(acl[ii]);
#pragma unroll
            for (int nt = 0; nt < 4; ++nt) {
                const f32x4 yo = mma16(CM + w * 16 * SA64, SA64, BM + (hl & 1) * 64 * SA64 + nt * 16 * SA64, SA64, 64, zero, r, kg);
                const int p = nt * 16 + r;
#pragma unroll
                for (int ii = 0; ii < 4; ++ii) { const int l = w * 16 + kg * 4 + ii;
                    const float xv = bf2f(*(const LAS bf16*)(xth + p * SA128 + l * 2));
                    LAS bf16* zp = (LAS bf16*)(zw + (kg * 4 + ii) * SA64 + p * 2);
                    const float y = (yd[nt][ii] + eal[ii] * yo[ii] + xv * Dk) * silu_f(bf2f(*zp));
                    const unsigned short yb = (unsigned short)f2bf(y); const float yq = bf2f(yb);
                    rs[ii] += yq * yq;
                    *zp = yb; }
            }
            LDS_WAIT();
            ysave[hl][0] = *(const LAS v4u*)(zw + orow * SA64 + och * 16); ysave[hl][1] = *(const LAS v4u*)(zw + (orow + 8) * SA64 + och * 16);
            LDS_WAIT();
        }
#pragma unroll
        for (int ii = 0; ii < 4; ++ii) { rs[ii] += __shfl_xor(rs[ii], 1); rs[ii] += __shfl_xor(rs[ii], 2); rs[ii] += __shfl_xor(rs[ii], 4); rs[ii] += __shfl_xor(rs[ii], 8);
            rs[ii] = rsqrtf(rs[ii] * (1.f / 256.f) + EPS); }
        if (r == 0) {
#pragma unroll
            for (int ii = 0; ii < 4; ++ii) RRW[w * 16 + kg * 4 + ii] = rs[ii]; }
        LDS_WAIT();
        const float rr0 = RRW[w * 16 + orow], rr1 = RRW[w * 16 + orow + 8];
        GAS bf16* mdst = (GAS bf16*)(A.ws + WS_XB) + (t0 + w * 16 + orow) * D + 512 + g * 256 + och * 8;
#pragma unroll
        for (int hl = 0; hl < 4; ++hl) {
            const f32x4 nwa = *(const GAS f32x4*)(A.in[11] + g * 256 + hl * 64 + och * 8), nwb = *(const GAS f32x4*)(A.in[11] + g * 256 + hl * 64 + och * 8 + 4);
            const float nw8[8] = {nwa.x, nwa.y, nwa.z, nwa.w, nwb.x, nwb.y, nwb.z, nwb.w};
#pragma unroll
            for (int hh = 0; hh < 2; ++hh) { float f[8]; unpack8f(ysave[hl][hh], f); const float rr_ = hh ? rr1 : rr0;
#pragma unroll
                for (int q = 0; q < 8; ++q) f[q] *= rr_ * nw8[q];
                *(GAS v4u*)(mdst + (size_t)(8 * hh) * D + hl * 64) = (v4u){pk2(f[0], f[1]), pk2(f[2], f[3]), pk2(f[4], f[5]), pk2(f[6], f[7])}; }
        }
    }
    __syncthreads();
}

__device__ __forceinline__ void scan_phase(const Frame& F, const Args& A) {
    if (F.tid < 128) {
        GAS unsigned* st = (GAS unsigned*)(A.ws + WS_GST); const GAS float* dec = (const GAS float*)(A.ws + WS_GDEC);
        for (int gi = blockIdx.x * 128 + F.tid; gi < 8 * 4096; gi += F.G * 128) {
            const int bh = gi >> 12, e = gi & 4095, b = bh >> 2, h = bh & 3, d = (e & 31) * 2;
            float S0 = 0.f, S1 = 0.f;
            for (int c = 0; c < 128; c += 8) {
                unsigned v[8]; float d0[8], d1[8];
#pragma unroll
                for (int u = 0; u < 8; ++u) { const size_t un = (size_t)((b * 128 + c + u) * 4 + h); v[u] = st[un * 4096 + e]; d0[u] = dec[un * 64 + d]; d1[u] = dec[un * 64 + d + 1]; }
#pragma unroll
                for (int u = 0; u < 8; ++u) { const size_t un = (size_t)((b * 128 + c + u) * 4 + h); st[un * 4096 + e] = pk2(S0, S1);
                    S0 = d0[u] * S0 + bf2f((unsigned short)(v[u] & 0xffffu)); S1 = d1[u] * S1 + bf2f((unsigned short)(v[u] >> 16)); }
            }
        }
    } else if (F.tid < 256) {
        GAS unsigned* st = (GAS unsigned*)(A.ws + WS_SST); const GAS float* dec = (const GAS float*)(A.ws + WS_SDEC);
        for (int gi = blockIdx.x * 128 + (F.tid - 128); gi < 16 * 2048; gi += F.G * 128) {
            const int bh = gi >> 11, e = gi & 2047, b = bh >> 3, hd = bh & 7;
            float S0 = 0.f, S1 = 0.f;
            for (int c = 0; c < 64; c += 8) {
                unsigned v[8]; float dd[8];
#pragma unroll
                for (int u = 0; u < 8; ++u) { const size_t un = (size_t)((b * 64 + c + u) * 8 + hd); v[u] = st[un * 2048 + e]; dd[u] = dec[un]; }
#pragma unroll
                for (int u = 0; u < 8; ++u) { const size_t un = (size_t)((b * 64 + c + u) * 8 + hd); st[un * 2048 + e] = pk2(S0, S1);
                    S0 = dd[u] * S0 + bf2f((unsigned short)(v[u] & 0xffffu)); S1 = dd[u] * S1 + bf2f((unsigned short)(v[u] >> 16)); }
            }
        }
    }
}
constexpr size_t WS_HB = WS_PROJ;
constexpr size_t WS_Q = 144 * MiB;
constexpr size_t WS_IDX = 232 * MiB;
constexpr size_t WS_GATE = 240 * MiB;
typedef float f32x16 __attribute__((ext_vector_type(16)));
__device__ __forceinline__ float as_f(unsigned u) { return __builtin_bit_cast(float, u); }
__device__ __forceinline__ unsigned as_u(float f) { return __builtin_bit_cast(unsigned, f); }
#define CE_DESC(a, b) do { const float hi_ = fmaxf((a), (b)), lo_ = fminf((a), (b)); (a) = hi_; (b) = lo_; } while (0)
template <int OFF, int N> __device__ __forceinline__ void sort16_desc(float (&v)[N]) {
#pragma unroll
    for (int k = 2; k <= 16; k <<= 1)
#pragma unroll
        for (int j = k >> 1; j > 0; j >>= 1)
#pragma unroll
            for (int i = 0; i < 16; ++i) { const int l = i ^ j; if (l > i) { if ((i & k) == 0) CE_DESC(v[OFF + i], v[OFF + l]); else CE_DESC(v[OFF + l], v[OFF + i]); } }
}
template <int OA, int OB, int NA, int NB> __device__ __forceinline__ void merge16_desc(float (&a)[NA], const float (&b)[NB]) {
#pragma unroll
    for (int i = 0; i < 16; ++i) a[OA + i] = fmaxf(a[OA + i], b[OB + 15 - i]);
#pragma unroll
    for (int j = 8; j > 0; j >>= 1)
#pragma unroll
        for (int i = 0; i < 16; ++i) { const int l = i ^ j; if (l > i) CE_DESC(a[OA + i], a[OA + l]); }
}
constexpr unsigned char CAND0[32] = {0, 2, 4, 6, 8, 10, 12, 14, 16, 18, 20, 22, 32, 34, 36, 49, 51, 65, 80, 96, 112, 128, 160, 192, 224, 255, 255, 255, 255, 255, 255, 255};
constexpr unsigned char CAND1[32] = {1, 3, 5, 7, 9, 11, 13, 15, 17, 19, 21, 23, 33, 35, 48, 50, 64, 66, 81, 97, 113, 144, 176, 208, 240, 255, 255, 255, 255, 255, 255, 255};

__device__ __forceinline__ void topk_wave_job(const Args& A, const LAS unsigned char* SK, LAS unsigned char* TAB, int tok0, int h, int lane) {
    const int r = lane & 31, hi = lane >> 5;
    const GAS bf16* qrow = (const GAS bf16*)(A.ws + WS_Q) + (size_t)(tok0 + r) * NQ + h * 256 + 8 * hi;
    float LST[2][16];
#pragma unroll
    for (int p = 0; p < 2; ++p) {
        __builtin_amdgcn_sched_barrier(0);
        bf16x8 bq[8];
#pragma unroll
        for (int s = 0; s < 8; ++s) bq[s] = *(const GAS bf16x8*)(qrow + p * 128 + 16 * s);
        float v[64];
#pragma unroll
        for (int kt = 0; kt < 4; ++kt) {
            f32x16 acc;
#pragma unroll
            for (int i = 0; i < 16; ++i) acc[i] = 0.f;
#pragma unroll
            for (int s = 0; s < 8; ++s) { const bf16x8 a = *(const LAS bf16x8*)(SK + (p * 128 + kt * 32 + r) * SA128 + (16 * s + 8 * hi) * 2);
                acc = __builtin_amdgcn_mfma_f32_32x32x16_bf16(a, bq[s], acc, 0, 0, 0); }
#pragma unroll
            for (int i = 0; i < 16; ++i) { const unsigned key = (unsigned)(kt * 32 + (i & 3) + 8 * (i >> 2)) | ((unsigned)hi << 2); v[kt * 16 + i] = as_f((as_u(acc[i]) & ~127u) | key); }
        }
        sort16_desc<0>(v); sort16_desc<16>(v); sort16_desc<32>(v); sort16_desc<48>(v);
        merge16_desc<0, 16>(v, v); merge16_desc<32, 48>(v, v); merge16_desc<0, 32>(v, v);
        float o[16];
#pragma unroll
        for (int i = 0; i < 16; ++i) o[i] = __shfl_xor(v[i], 32);
        merge16_desc<0, 0>(v, o);
#pragma unroll
        for (int i = 0; i < 16; ++i) LST[p][i] = v[i];
    }
    __builtin_amdgcn_sched_barrier(0);
    {   unsigned pk[4];
#pragma unroll
        for (int q4 = 0; q4 < 4; ++q4) { unsigned wv = 0;
#pragma unroll
            for (int b = 0; b < 4; ++b) { float l0 = LST[0][q4 * 4 + b], l1 = LST[1][q4 * 4 + b]; asm volatile("" : "+v"(l0), "+v"(l1));
                const unsigned x = as_u(hi ? l1 : l0) & 127u; wv |= x << (8 * b); }
            pk[q4] = wv; }
        *(LAS v4u*)(TAB + r * 32 + hi * 16) = (v4u){pk[0], pk[1], pk[2], pk[3]};
    }
    float c[32];
    float va[16], vb2[16];
#pragma unroll
    for (int i = 0; i < 16; ++i) { va[i] = as_f(as_u(LST[0][i]) & ~127u); vb2[i] = as_f(as_u(LST[1][i]) & ~127u); }
#define CANDV(i0, j0, k0, i1, j1, k1) as_f((as_u(hi ? (va[i1] + vb2[j1]) : (va[i0] + vb2[j0])) & ~255u) | (hi ? (k1) : (k0)))
    c[0] = CANDV(0, 0, 0u, 0, 1, 1u);
    c[1] = CANDV(0, 2, 2u, 0, 3, 3u);
    c[2] = CANDV(0, 4, 4u, 0, 5, 5u);
    c[3] = CANDV(0, 6, 6u, 0, 7, 7u);
    c[4] = CANDV(0, 8, 8u, 0, 9, 9u);
    c[5] = CANDV(0, 10, 10u, 0, 11, 11u);
    c[6] = CANDV(0, 12, 12u, 0, 13, 13u);
    c[7] = CANDV(0, 14, 14u, 0, 15, 15u);
    c[8] = CANDV(1, 0, 16u, 1, 1, 17u);
    c[9] = CANDV(1, 2, 18u, 1, 3, 19u);
    c[10] = CANDV(1, 4, 20u, 1, 5, 21u);
    c[11] = CANDV(1, 6, 22u, 1, 7, 23u);
    c[12] = CANDV(2, 0, 32u, 2, 1, 33u);
    c[13] = CANDV(2, 2, 34u, 2, 3, 35u);
    c[14] = CANDV(2, 4, 36u, 3, 0, 48u);
    c[15] = CANDV(3, 1, 49u, 3, 2, 50u);
    c[16] = CANDV(3, 3, 51u, 4, 0, 64u);
    c[17] = CANDV(4, 1, 65u, 4, 2, 66u);
    c[18] = CANDV(5, 0, 80u, 5, 1, 81u);
    c[19] = CANDV(6, 0, 96u, 6, 1, 97u);
    c[20] = CANDV(7, 0, 112u, 7, 1, 113u);
    c[21] = CANDV(8, 0, 128u, 9, 0, 144u);
    c[22] = CANDV(10, 0, 160u, 11, 0, 176u);
    c[23] = CANDV(12, 0, 192u, 13, 0, 208u);
    c[24] = CANDV(14, 0, 224u, 15, 0, 240u);
    c[25] = as_f(0xFF61B1E6u | 255u);
    c[26] = as_f(0xFF61B1E6u | 255u);
    c[27] = as_f(0xFF61B1E6u | 255u);
    c[28] = as_f(0xFF61B1E6u | 255u);
    c[29] = as_f(0xFF61B1E6u | 255u);
    c[30] = as_f(0xFF61B1E6u | 255u);
    c[31] = as_f(0xFF61B1E6u | 255u);
#undef CANDV
    sort16_desc<0>(c); sort16_desc<16>(c); merge16_desc<0, 16>(c, c);
    {   float o[16];
#pragma unroll
        for (int i = 0; i < 16; ++i) o[i] = __shfl_xor(c[i], 32);
        merge16_desc<0, 0>(c, o); }
    const float mx = as_f(as_u(c[0]) & ~255u);
    float ex[16], den = 0.f;
#pragma unroll
    for (int k = 0; k < 16; ++k) { ex[k] = __expf(as_f(as_u(c[k]) & ~255u) - mx); den += ex[k]; }
    const float inv = 1.f / den;
    LDS_WAIT();
    unsigned eid[8]; float gv[8];
#pragma unroll
    for (int k = 0; k < 8; ++k) { float ca = c[k], cb = c[k + 8], ea = ex[k], eb = ex[k + 8]; asm volatile("" : "+v"(ca), "+v"(cb), "+v"(ea), "+v"(eb));
        const unsigned code = as_u(hi ? cb : ca) & 255u; gv[k] = (hi ? eb : ea) * inv;
        const unsigned ia = *(const LAS unsigned char*)(TAB + r * 32 + (code >> 4)), ib = *(const LAS unsigned char*)(TAB + r * 32 + 16 + (code & 15));
        eid[k] = ia * 128u + ib; }
    GAS unsigned* ip = (GAS unsigned*)(A.ws + WS_IDX) + (size_t)(tok0 + r) * 128 + h * 16 + 8 * hi;
    GAS float* gp = (GAS float*)(A.ws + WS_GATE) + (size_t)(tok0 + r) * 128 + h * 16 + 8 * hi;
    *(GAS v4u*)ip = (v4u){eid[0], eid[1], eid[2], eid[3]}; *(GAS v4u*)(ip + 4) = (v4u){eid[4], eid[5], eid[6], eid[7]};
    *(GAS f32x4*)gp = (f32x4){gv[0], gv[1], gv[2], gv[3]}; *(GAS f32x4*)(gp + 4) = (f32x4){gv[4], gv[5], gv[6], gv[7]};
    LDS_WAIT();
}
__device__ __forceinline__ void topk_phase(const Frame& F, const Args& A) {
    LAS unsigned char* SK = F.lds;
    LAS unsigned char* TABS = F.lds + 256 * SA128;
    for (int unit = blockIdx.x; unit < 256; unit += F.G) {
        int tid = F.tid, w = F.wave;
        asm volatile("" : "+v"(tid)); asm volatile("" : "+s"(w));
        const int h = unit & 7, tb = (unit >> 3) * 512;
        const GAS bf16* sk = (const GAS bf16*)(A.ws + WS_SUBK) + (size_t)h * 2 * 128 * 128;
        for (int e = tid; e < 256 * 16; e += 512) { const int row = e >> 4, ch = e & 15; *(LAS v4u*)(SK + row * SA128 + ch * 16) = *(const GAS v4u*)(sk + row * 128 + ch * 8); }
        __syncthreads();
#pragma unroll 1
        for (int tt = 0; tt < 2; ++tt) topk_wave_job(A, SK, TABS + w * 1024, tb + (w * 2 + tt) * 32, h, tid & 63);
        __syncthreads();
    }
}

__device__ __forceinline__ float gelu_f(float x) { return 0.5f * x * (1.f + erff(x * 0.70710678118654752f)); }
__device__ __forceinline__ void unpack8(const v4u x, float (&f)[8]) {
    f[0] = as_f(x.x << 16); f[1] = as_f(x.x & 0xffff0000u); f[2] = as_f(x.y << 16); f[3] = as_f(x.y & 0xffff0000u);
    f[4] = as_f(x.z << 16); f[5] = as_f(x.z & 0xffff0000u); f[6] = as_f(x.w << 16); f[7] = as_f(x.w & 0xffff0000u);
}
typedef long lx2 __attribute__((ext_vector_type(2)));
typedef float f32x2 __attribute__((ext_vector_type(2)));
typedef int i32x8 __attribute__((ext_vector_type(8)));
typedef int i32x4 __attribute__((ext_vector_type(4)));
constexpr float U4_SCALE = 48.f, V4_SCALE = 4.25f;
constexpr int MX_ONE = 0x7F7F7F7F;
template <int BY> __device__ __forceinline__ f32x2 cvt_fp4x2(unsigned w) { return __builtin_amdgcn_cvt_scalef32_pk_f32_fp4(w, 1.0f, BY); }
template <int WS> __device__ __forceinline__ f32x2 cvt_fp8x2(int w) { return __builtin_amdgcn_cvt_pk_f32_fp8(w, WS != 0); }
__device__ __forceinline__ unsigned pk4_fp8(float a, float b, float c, float d) { int p = __builtin_amdgcn_cvt_pk_fp8_f32(a, b, 0, false); p = __builtin_amdgcn_cvt_pk_fp8_f32(c, d, p, true); return (unsigned)p; }
__device__ __forceinline__ void expert_phase(const Frame& F, const Args& A) {
    int tid = F.tid, w = F.wave;
    asm volatile("" : "+v"(tid)); asm volatile("" : "+s"(w));
    const int lane = tid & 63, r = lane & 15, kg = lane >> 4, half = lane >> 5, sub = lane & 31;
    const int dl = 32 * sub + 16 * half;
    LAS unsigned char* N2 = F.lds + w * 1024;
    const GAS unsigned char* u4 = (const GAS unsigned char*)(A.ws + WS_UB); const GAS unsigned char* v4 = (const GAS unsigned char*)(A.ws + WS_VB);
    const GAS unsigned* idx = (const GAS unsigned*)(A.ws + WS_IDX); const GAS float* gate = (const GAS float*)(A.ws + WS_GATE);
    const GAS float* rowsq = (const GAS float*)(A.ws + WS_ROWSQ2);
    f32x4 nl[4];
#pragma unroll
    for (int q = 0; q < 4; ++q) nl[q] = *(const GAS f32x4*)(A.in[18] + dl + 4 * q);
#pragma unroll 1
    for (int t = F.gw; t < T; t += F.NGW) {
        GAS float* hrow = (GAS float*)A.out + (size_t)t * D;
        f32x4 hv[4];
#pragma unroll
        for (int q = 0; q < 4; ++q) hv[q] = *(const GAS f32x4*)(hrow + dl + 4 * q);
        const float rr = rsqrtf(rowsq[t] * (1.f / 1024.f) + EPS);
        {   v4u pk;
            pk.x = pk4_fp8(hv[0].x * rr, hv[0].y * rr, hv[0].z * rr, hv[0].w * rr); pk.y = pk4_fp8(hv[1].x * rr, hv[1].y * rr, hv[1].z * rr, hv[1].w * rr);
            pk.z = pk4_fp8(hv[2].x * rr, hv[2].y * rr, hv[2].z * rr, hv[2].w * rr); pk.w = pk4_fp8(hv[3].x * rr, hv[3].y * rr, hv[3].z * rr, hv[3].w * rr);
            *(LAS v4u*)(N2 + dl) = pk; }
        unsigned eidx[8]; float gt[8];
#pragma unroll
        for (int eg = 0; eg < 8; ++eg) { eidx[eg] = idx[(size_t)t * 128 + eg * 16 + r]; gt[eg] = gate[(size_t)t * 128 + eg * 16 + r]; }
        LDS_WAIT();
        f32x4 acc[8];
#pragma unroll
        for (int eg = 0; eg < 8; ++eg) acc[eg] = (f32x4){0.f, 0.f, 0.f, 0.f};
#pragma unroll 1
        for (int sp = 0; sp < 4; ++sp) {
            i32x4 bq[2][8];
#pragma unroll
            for (int h2 = 0; h2 < 2; ++h2)
#pragma unroll
                for (int eg = 0; eg < 8; ++eg) bq[h2][eg] = *(const GAS i32x4*)(u4 + (size_t)eidx[eg] * 512 + 64 * (2 * sp + h2) + 16 * kg);
#pragma unroll
            for (int h2 = 0; h2 < 2; ++h2) {
                const int s = 2 * sp + h2;
                const i32x4 a0 = *(const LAS i32x4*)(N2 + 128 * s + 16 * kg), a1 = *(const LAS i32x4*)(N2 + 128 * s + 64 + 16 * kg);
                const i32x8 a = (i32x8){a0.x, a0.y, a0.z, a0.w, a1.x, a1.y, a1.z, a1.w};
#pragma unroll
                for (int eg = 0; eg < 8; ++eg) { const i32x4 b4 = bq[h2][eg];
                    const i32x8 b = (i32x8){b4.x, b4.y, b4.z, b4.w, 0, 0, 0, 0};
                    acc[eg] = __builtin_amdgcn_mfma_scale_f32_16x16x128_f8f6f4(a, b, acc[eg], 0, 4, 0, MX_ONE, 0, MX_ONE); }
            }
        }
        bool bad = false;
        if (t == F.gw) {
            float ref = 0.f;
            for (int s = 0; s < 8; ++s) {
                const i32x4 b4 = *(const GAS i32x4*)(u4 + (size_t)eidx[0] * 512 + 64 * s + 16 * kg);
                const int bw[4] = {b4.x, b4.y, b4.z, b4.w};
#pragma unroll
                for (int k = 0; k < 4; ++k) {
                    const lx2 a8 = *(const LAS lx2*)(N2 + 128 * s + 32 * kg + 16 * (k >> 1));
                    const long aw = (k & 1) ? a8.y : a8.x;
                    const int alo = (int)aw, ahi = (int)(aw >> 32);
                    { const f32x2 bf = cvt_fp4x2<0>((unsigned)bw[k]), af = cvt_fp8x2<0>(alo); ref += af.x * bf.x + af.y * bf.y; }
                    { const f32x2 bf = cvt_fp4x2<1>((unsigned)bw[k]), af = cvt_fp8x2<1>(alo); ref += af.x * bf.x + af.y * bf.y; }
                    { const f32x2 bf = cvt_fp4x2<2>((unsigned)bw[k]), af = cvt_fp8x2<0>(ahi); ref += af.x * bf.x + af.y * bf.y; }
                    { const f32x2 bf = cvt_fp4x2<3>((unsigned)bw[k]), af = cvt_fp8x2<1>(ahi); ref += af.x * bf.x + af.y * bf.y; }
                }
            }
            ref += __shfl_xor(ref, 16); ref += __shfl_xor(ref, 32);
            bad = __any(fabsf(ref - acc[0][0]) > 0.02f * fabsf(ref) + 0.5f);
        }
        float hid[8];
#pragma unroll
        for (int eg = 0; eg < 8; ++eg) hid[eg] = gelu_f(acc[eg][0] * (1.f / U4_SCALE)) * gt[eg] * (1.f / V4_SCALE);
        f32x2 o2[16];
#pragma unroll
        for (int i = 0; i < 16; ++i) o2[i] = (f32x2){0.f, 0.f};
#pragma unroll
        for (int eg = 0; eg < 8; ++eg) {
#pragma unroll
            for (int qd = 0; qd < 2; ++qd) {
                asm volatile("" ::: "memory");
#pragma unroll
                for (int rr_ = qd * 8; rr_ < qd * 8 + 8; rr_ += 2) {
                    const float sha = as_f(__builtin_amdgcn_readlane((int)as_u(hid[eg]), rr_)), shb = as_f(__builtin_amdgcn_readlane((int)as_u(hid[eg]), rr_ + 1));
                    const unsigned sia = (unsigned)__builtin_amdgcn_readlane((int)eidx[eg], rr_), sib = (unsigned)__builtin_amdgcn_readlane((int)eidx[eg], rr_ + 1);
                    const float sh = half ? shb : sha; const f32x2 sh2 = (f32x2){sh, sh};
                    const v4u x = *(const GAS v4u*)(v4 + (size_t)(half ? sib : sia) * 512 + 16 * sub);
                    const unsigned xw[4] = {x.x, x.y, x.z, x.w};
#pragma unroll
                    for (int k = 0; k < 4; ++k) { o2[4 * k] += sh2 * cvt_fp4x2<0>(xw[k]); o2[4 * k + 1] += sh2 * cvt_fp4x2<1>(xw[k]); o2[4 * k + 2] += sh2 * cvt_fp4x2<2>(xw[k]); o2[4 * k + 3] += sh2 * cvt_fp4x2<3>(xw[k]); }
                }
            }
        }
        float o[16];
#pragma unroll
        for (int i = 0; i < 16; ++i) { o2[i].x += __shfl_xor(o2[i].x, 32); o2[i].y += __shfl_xor(o2[i].y, 32); }
#pragma unroll
        for (int i = 0; i < 8; ++i) { float a0 = o2[i].x, a1 = o2[i].y, b0 = o2[8 + i].x, b1 = o2[8 + i].y; asm volatile("" : "+v"(a0), "+v"(a1), "+v"(b0), "+v"(b1));
            o[2 * i] = half ? b0 : a0; o[2 * i + 1] = half ? b1 : a1; }
        float ss = 0.f; f32x4 h2[4];
#pragma unroll
        for (int q = 0; q < 4; ++q) { h2[q] = hv[q] + (f32x4){o[4 * q], o[4 * q + 1], o[4 * q + 2], o[4 * q + 3]};
            const f32x4 x = h2[q]; ss += (x.x * x.x + x.y * x.y) + (x.z * x.z + x.w * x.w); }
        ss = wave_sum(ss);
        float r3 = rsqrtf(ss * (1.f / D) + EPS);
#pragma unroll
        for (int q = 0; q < 4; ++q) *(GAS f32x4*)(hrow + dl + 4 * q) = h2[q] * r3 * nl[q];
    }
}
__device__ __forceinline__ void p0_transpose_item(const float* W, const float* kscale, int K, int N, bf16* WT, LAS float* scr, int item, int lane) {
    const int nblk = (N + 31) / 32, kb = item / nblk, nb = item % nblk, k0 = 64 * kb, n0 = 32 * nb;
    const int nn = n0 + (lane & 31); const bool ok = nn < N;
#pragma unroll 8
    for (int i = 0; i < 32; ++i) { const int kk = 2 * i + (lane >> 5); float v = ok ? W[(size_t)(k0 + kk) * N + nn] : 0.f; if (kscale) v *= kscale[k0 + kk]; scr[kk * 33 + (lane & 31)] = v; }
    LDS_WAIT(); asm volatile("" ::: "memory");
    const int c = lane & 7;
#pragma unroll
    for (int j = 0; j < 4; ++j) { const int n = (lane >> 3) + 8 * j; const LAS float* s = scr + (8 * c) * 33 + n;
        v4u o; o.x = pk2(s[0 * 33], s[1 * 33]); o.y = pk2(s[2 * 33], s[3 * 33]); o.z = pk2(s[4 * 33], s[5 * 33]); o.w = pk2(s[6 * 33], s[7 * 33]);
        *(GAS v4u*)(WT + (size_t)(n0 + n) * K + k0 + 8 * c) = o; }
    LDS_WAIT(); asm volatile("" ::: "memory");
}
__device__ __forceinline__ void p0_convert(const Frame& F, const float* src, bf16* dst, size_t n) {
    for (size_t i = ((size_t)F.gw * 64 + F.lane) * 8; i < n; i += (size_t)F.NGW * 512) {
        const f32x4 a = *(const GAS f32x4*)(src + i), b = *(const GAS f32x4*)(src + i + 4);
        v4u o; o.x = pk2(a.x, a.y); o.y = pk2(a.z, a.w); o.z = pk2(b.x, b.y); o.w = pk2(b.z, b.w);
        *(GAS v4u*)(dst + i) = o;
    }
}
__device__ __forceinline__ void p0_convert_fp4(const Frame& F, int wk, int nwk, const float* src, unsigned char* dst, size_t n, float scale, const float* colscale) {
#pragma unroll 2
    for (size_t i = ((size_t)wk * 64 + F.lane) * 32; i < n; i += (size_t)nwk * 2048) {
        unsigned ow[4];
#pragma unroll
        for (int q = 0; q < 4; ++q) {
            f32x4 a = *(const GAS f32x4*)(src + i + 8 * q) * scale, b = *(const GAS f32x4*)(src + i + 8 * q + 4) * scale;
            if (colscale) { a = a * *(const GAS f32x4*)(colscale + ((i + 8 * q) & 1023)); b = b * *(const GAS f32x4*)(colscale + ((i + 8 * q + 4) & 1023)); }
            unsigned pk = 0;
            pk = __builtin_amdgcn_cvt_scalef32_pk_fp4_f32(pk, a.x, a.y, 1.0f, 0); pk = __builtin_amdgcn_cvt_scalef32_pk_fp4_f32(pk, a.z, a.w, 1.0f, 1);
            pk = __builtin_amdgcn_cvt_scalef32_pk_fp4_f32(pk, b.x, b.y, 1.0f, 2); pk = __builtin_amdgcn_cvt_scalef32_pk_fp4_f32(pk, b.z, b.w, 1.0f, 3);
            ow[q] = pk; }
        *(GAS v4u*)(dst + (i >> 1)) = (v4u){ow[0], ow[1], ow[2], ow[3]};
    }
}
__device__ __forceinline__ void p0_prologue(const Frame& F, const Args& A) {
    unsigned char* ws = A.ws;
    LAS float* scr = (LAS float*)(F.lds + RING_OFF + F.wave * 16384);
    constexpr int I_IN = (D / 64) * ((NIN + 31) / 32), I_O = (D / 64) * (D / 32), I_Q = (D / 64) * (NQ / 32);
    for (int it = F.gw; it < I_IN + I_O + I_Q; it += F.NGW) {
        int r = it;
        if (r < I_IN) { p0_transpose_item(A.in[2], A.in[1], D, NIN, (bf16*)(ws + WS_WIN), scr, r, F.lane); continue; } r -= I_IN;
        if (r < I_O) { p0_transpose_item(A.in[12], nullptr, D, D, (bf16*)(ws + WS_WO), scr, r, F.lane); continue; } r -= I_O;
        p0_transpose_item(A.in[14], A.in[13], D, NQ, (bf16*)(ws + WS_WQ), scr, r, F.lane);
    }
    for (int m0 = F.gw * 2; m0 < T; m0 += F.NGW * 2) {
        f32x4 v[2][4]; float s[2] = {0.f, 0.f};
#pragma unroll
        for (int u = 0; u < 2; ++u) { const GAS f32x4* xr = (const GAS f32x4*)(A.in[0] + (size_t)(m0 + u) * D) + F.lane;
#pragma unroll
            for (int j = 0; j < 4; ++j) v[u][j] = xr[64 * j]; }
#pragma unroll
        for (int u = 0; u < 2; ++u) {
#pragma unroll
            for (int j = 0; j < 4; ++j) s[u] += (v[u][j].x * v[u][j].x + v[u][j].y * v[u][j].y) + (v[u][j].z * v[u][j].z + v[u][j].w * v[u][j].w);
            GAS unsigned long long* o8 = (GAS unsigned long long*)((bf16*)(ws + WS_XB) + (size_t)(m0 + u) * D) + F.lane;
#pragma unroll
            for (int j = 0; j < 4; ++j) o8[64 * j] = (unsigned long long)pk2(v[u][j].x, v[u][j].y) | ((unsigned long long)pk2(v[u][j].z, v[u][j].w) << 32); }
        s[0] = wave_sum(s[0]); s[1] = wave_sum(s[1]);
        if (F.lane < 2) { const float sv = F.lane ? s[1] : s[0]; ((float*)(ws + WS_RRMS1))[m0 + F.lane] = rsqrtf(sv * (1.f / D) + EPS); ((float*)(ws + WS_ROWSQ2))[m0 + F.lane] = 0.f; }
    }
    p0_convert(F, A.in[15], (bf16*)(ws + WS_SUBK), (size_t)8 * 2 * 128 * 128);
    p0_convert_fp4(F, F.gw, F.NGW, A.in[16], ws + WS_UB, (size_t)16384 * 1024, 48.f, A.in[13]);
    p0_convert_fp4(F, F.gw, F.NGW, A.in[17], ws + WS_VB, (size_t)16384 * 1024, 4.25f, nullptr);
}

#ifndef PROBE_MASK
#define PROBE_MASK 0
#endif
__device__ __forceinline__ int probe_reps(int k) { int n = ((PROBE_MASK >> k) & 1) + 1; return n; }
__global__ void __launch_bounds__(NWAVES * 64, 2) fwd(Args args) {
    extern __shared__ __attribute__((aligned(16))) unsigned char lds[];
    Frame F;
    F.lds = (LAS unsigned char*)lds;
    F.MISC = (volatile LAS unsigned*)(F.lds + MISC_OFF);
    F.tid = threadIdx.x; F.lane = F.tid & 63; F.wave = __builtin_amdgcn_readfirstlane(F.tid >> 6);
    F.G = gridDim.x; F.gw = blockIdx.x * NWAVES + F.wave; F.NGW = F.G * NWAVES;
    unsigned char* ws = args.ws;
    F.ctl = (gu32*)(ws + WS_CTL);
    for (int u = F.tid; u < (LDS_BYTES - LDSCTL_OFF) / 4; u += NWAVES * 64) ((LAS unsigned*)(F.lds + LDSCTL_OFF))[u] = 0u;
    __syncthreads();
    XcdBarrier bar = xcd_barrier_post((unsigned*)(F.ctl + CW_BAR), F.MISC + 8);
    const int lo = args.ph_lo, hi = args.ph_hi;
#define IN(k) (lo <= (k) && (k) < hi)
#define BOTH(k) (IN(k) && IN((k) + 1))
#define GRID_BAR() xcd_barrier(bar)
#define REP(k) for (int rep_ = 0, nrep_ = probe_reps(k); rep_ < nrep_; ++rep_)

    if (IN(0)) REP(0) { p0_prologue(F, args); if (BOTH(0)) GRID_BAR(); }
    if (IN(1)) REP(1) {
        pg8::Gemm g{(const bf16*)(ws + WS_XB), (const bf16*)(ws + WS_WIN), T, NINP, D}; pg8::StaticOrder S; S.init(T, NINP, F.G, (int)blockIdx.x);
        pg8::EpiRowScaleBf16 E{(bf16*)(ws + WS_PROJ), NINP, (const float*)(ws + WS_RRMS1)};
        pg8::gemm_phase<pg8::EpiRowScaleBf16, pg8::StaticOrder, true, true>(F.lds + RING_OFF, g, S, E);
        if (BOTH(1)) GRID_BAR();
    }
    if (IN(2)) {
        REP(2) { for (int u = blockIdx.x; u < 256; u += F.G) ssd_unit<0>(F, args, u); }
        REP(13) { for (int u = blockIdx.x; u < 1024; u += F.G) gla_unit<0>(F, args, u); }
        if (BOTH(2)) GRID_BAR();
    }
    if (IN(3)) { scan_phase(F, args); if (BOTH(3)) GRID_BAR(); }
    if (IN(4)) {
        REP(4) { for (int u = blockIdx.x; u < 256; u += F.G) ssd_unit<1>(F, args, u); }
        REP(12) { for (int u = blockIdx.x; u < 1024; u += F.G) gla_unit<1>(F, args, u); }
        if (BOTH(4)) GRID_BAR();
    }
    if (IN(5)) {
        pg8::Gemm g{(const bf16*)(ws + WS_XB), (const bf16*)(ws + WS_WO), T, D, D}; pg8::StaticOrder S; S.init(T, D, F.G, (int)blockIdx.x);
        pg8::EpiResidual E{args.in[0], args.out, (bf16*)(ws + WS_HB), (float*)(ws + WS_ROWSQ2), D};
        pg8::gemm_phase<pg8::EpiResidual, pg8::StaticOrder, true, true>(F.lds + RING_OFF, g, S, E);
        if (BOTH(5)) GRID_BAR();
    }
    if (IN(6)) REP(6) {
        pg8::Gemm g{(const bf16*)(ws + WS_HB), (const bf16*)(ws + WS_WQ), T, NQ, D}; pg8::StaticOrder S; S.init(T, NQ, F.G, (int)blockIdx.x);
        pg8::EpiRsqScaleBf16 E{(bf16*)(ws + WS_Q), NQ, (const float*)(ws + WS_ROWSQ2)};
        pg8::gemm_phase<pg8::EpiRsqScaleBf16, pg8::StaticOrder, true, true>(F.lds + RING_OFF, g, S, E);
        if (BOTH(6)) GRID_BAR();
    }
    if (IN(7)) REP(7) { topk_phase(F, args); if (BOTH(7)) GRID_BAR(); }
    if (IN(8)) { expert_phase(F, args); }
#undef IN
#undef BOTH
}
namespace nv {
struct ProjF32 { const float* p; __device__ __forceinline__ float operator()(size_t row, int c) const { return p[row * NIN + c]; } };
struct ProjBf { const unsigned short* p; __device__ __forceinline__ float operator()(size_t row, int c) const { return bf2f(p[row * NINP + c]); } };
__device__ __forceinline__ float silu_f(float x) { return x / (1.f + expf(-x)); }
__device__ __forceinline__ float softplus_f(float x) { return fmaxf(x, 0.f) + log1pf(expf(-fabsf(x))); }
__device__ __forceinline__ float logsigmoid_f(float x) { return fminf(x, 0.f) - log1pf(expf(-fabsf(x))); }
__device__ __forceinline__ float gelu_f(float x) { return 0.5f * x * (1.f + erff(x * 0.70710678118654752f)); }

__global__ void __launch_bounds__(256) k_rmsnorm(const float* __restrict__ x, const float* __restrict__ w, float* __restrict__ out) {
    const int row = blockIdx.x * 4 + (threadIdx.x >> 6), lane = threadIdx.x & 63;
    const float4* xr = (const float4*)(x + (size_t)row * D);
    float4 v[4]; float s = 0.f;
#pragma unroll
    for (int j = 0; j < 4; ++j) { v[j] = xr[lane + 64 * j]; s += v[j].x * v[j].x + v[j].y * v[j].y + v[j].z * v[j].z + v[j].w * v[j].w; }
    s = wave_sum(s);
    const float r = rsqrtf(s * (1.f / D) + EPS);
    float4* o = (float4*)(out + (size_t)row * D);
#pragma unroll
    for (int j = 0; j < 4; ++j) { const float4 ww = ((const float4*)w)[lane + 64 * j]; float4 y; y.x = v[j].x * r * ww.x; y.y = v[j].y * r * ww.y; y.z = v[j].z * r * ww.z; y.w = v[j].w * r * ww.w; o[lane + 64 * j] = y; }
}

template <bool ADD>
__global__ void __launch_bounds__(256) k_gemm(const float* __restrict__ A, const float* __restrict__ B, const float* __restrict__ R, float* __restrict__ C, int M, int N, int K, int ldb) {
    __shared__ float As[16][68];
    __shared__ float Bs[16][68];
    const int tid = threadIdx.x, tx = tid & 15, ty = tid >> 4;
    const int row0 = blockIdx.y * 64, col0 = blockIdx.x * 64;
    float acc[4][4];
#pragma unroll
    for (int i = 0; i < 4; ++i)
#pragma unroll
        for (int j = 0; j < 4; ++j) acc[i][j] = 0.f;
    const int ar = tid >> 2, akq = tid & 3;
    const int bk = tid >> 4, bn = (tid & 15) * 4;
    for (int k0 = 0; k0 < K; k0 += 16) {
        const float4 av = *(const float4*)(A + (size_t)(row0 + ar) * K + k0 + akq * 4);
        float4 bv = make_float4(0.f, 0.f, 0.f, 0.f);
        if (col0 + bn < N) bv = *(const float4*)(B + (size_t)(k0 + bk) * ldb + col0 + bn);
        __syncthreads();
        As[akq * 4 + 0][ar] = av.x; As[akq * 4 + 1][ar] = av.y; As[akq * 4 + 2][ar] = av.z; As[akq * 4 + 3][ar] = av.w;
        *(float4*)&Bs[bk][bn] = bv;
        __syncthreads();
#pragma unroll
        for (int kk = 0; kk < 16; ++kk) {
            const float4 a = *(const float4*)&As[kk][ty * 4];
            const float4 b = *(const float4*)&Bs[kk][tx * 4];
            const float aa[4] = {a.x, a.y, a.z, a.w}, bb[4] = {b.x, b.y, b.z, b.w};
#pragma unroll
            for (int i = 0; i < 4; ++i)
#pragma unroll
                for (int j = 0; j < 4; ++j) acc[i][j] += aa[i] * bb[j];
        }
    }
    if (col0 + tx * 4 < N) {
#pragma unroll
        for (int i = 0; i < 4; ++i) {
            const size_t off = (size_t)(row0 + ty * 4 + i) * N + col0 + tx * 4;
            float4 o = make_float4(acc[i][0], acc[i][1], acc[i][2], acc[i][3]);
            if (ADD) { const float4 r = *(const float4*)(R + off); o.x += r.x; o.y += r.y; o.z += r.z; o.w += r.w; }
            *(float4*)(C + off) = o;
        }
    }
}

template <class P> __global__ void __launch_bounds__(256) k_gla_gate(const P proj, const float* __restrict__ w2, const float* __restrict__ bg, float* __restrict__ alpha) {
    const int t = blockIdx.x, c = threadIdx.x;
    float acc = bg[c];
#pragma unroll
    for (int r = 0; r < 16; ++r) acc += proj((size_t)t, C_GLR + r) * w2[r * 256 + c];
    alpha[(size_t)t * 256 + c] = expf(logsigmoid_f(acc) * (1.f / 16.f));
}

template <class P> __global__ void __launch_bounds__(128) k_gla_rec(const P proj, const float* __restrict__ alpha, float* __restrict__ mixed) {
    const int b = blockIdx.x >> 2, h = blockIdx.x & 3, dv = threadIdx.x;
    float S[64];
#pragma unroll
    for (int d = 0; d < 64; ++d) S[d] = 0.f;
    for (int t = 0; t < SEQ; ++t) {
        const size_t row = (size_t)b * SEQ + t;
        const float* al = alpha + row * 256 + h * 64;
        const float v = proj(row, C_V + h * 128 + dv);
        float o = 0.f;
#pragma unroll
        for (int d = 0; d < 64; ++d) {
            S[d] = al[d] * S[d] + proj(row, C_K + h * 64 + d) * v;
            o += proj(row, C_Q + h * 64 + d) * S[d];
        }
        mixed[row * D + h * 128 + dv] = o * 0.125f;
    }
}

template <class P> __global__ void __launch_bounds__(256) k_gla_finish(const P proj, const float* __restrict__ nw, float* __restrict__ mixed) {
    const int t = blockIdx.x, h = threadIdx.x >> 6, lane = threadIdx.x & 63;
    float* m = mixed + (size_t)t * D + h * 128;
    const float a = m[lane], b = m[lane + 64];
    const float s = wave_sum(a * a + b * b);
    const float r = rsqrtf(s * (1.f / 128.f) + EPS);
    m[lane] = a * r * nw[lane] * silu_f(proj((size_t)t, C_GOUT + h * 128 + lane));
    m[lane + 64] = b * r * nw[lane + 64] * silu_f(proj((size_t)t, C_GOUT + h * 128 + lane + 64));
}

template <class P> __global__ void __launch_bounds__(256) k_ssd_conv(const P proj, const float* __restrict__ cw, const float* __restrict__ cb, const float* __restrict__ dtb,
                                                  float* __restrict__ xc, float* __restrict__ dt) {
    const int t = blockIdx.x, l = t & (SEQ - 1);
    for (int c = threadIdx.x; c < 768; c += 256) {
        float acc = cb[c];
#pragma unroll
        for (int j = 0; j < 4; ++j) { const int ll = l - 3 + j; if (ll >= 0) acc += cw[j * 768 + c] * proj((size_t)(t - 3 + j), C_XBC + c); }
        xc[(size_t)t * 768 + c] = silu_f(acc);
    }
    if (threadIdx.x < 8) dt[(size_t)t * 8 + threadIdx.x] = softplus_f(proj((size_t)t, C_DT + threadIdx.x) + dtb[threadIdx.x]);
}

__global__ void __launch_bounds__(64) k_ssd_rec(const float* __restrict__ xc, const float* __restrict__ dt, const float* __restrict__ a_log, const float* __restrict__ dsk, float* __restrict__ mixed) {
    const int b = blockIdx.x >> 3, hd = blockIdx.x & 7, g = hd >> 2, p = threadIdx.x;
    const float A = -expf(a_log[hd]), Dk = dsk[hd];
    float hs[64];
#pragma unroll
    for (int n = 0; n < 64; ++n) hs[n] = 0.f;
    for (int t = 0; t < SEQ; ++t) {
        const size_t row = (size_t)b * SEQ + t;
        const float dtv = dt[row * 8 + hd];
        const float dA = expf(dtv * A);
        const float* xr = xc + row * 768;
        const float x = xr[hd * 64 + p], xdt = x * dtv;
        float y = 0.f;
#pragma unroll
        for (int n = 0; n < 64; ++n) {
            hs[n] = dA * hs[n] + xr[512 + g * 64 + n] * xdt;
            y += xr[640 + g * 64 + n] * hs[n];
        }
        mixed[row * D + 512 + hd * 64 + p] = y + x * Dk;
    }
}

template <class P> __global__ void __launch_bounds__(128) k_ssd_finish(const P proj, const float* __restrict__ nw, float* __restrict__ mixed) {
    const int t = blockIdx.x, g = threadIdx.x >> 6, lane = threadIdx.x & 63;
    float* m = mixed + (size_t)t * D + 512 + g * 256;
    float y[4]; float s = 0.f;
#pragma unroll
    for (int j = 0; j < 4; ++j) { y[j] = m[lane + 64 * j] * silu_f(proj((size_t)t, C_Z + g * 256 + lane + 64 * j)); s += y[j] * y[j]; }
    s = wave_sum(s);
    const float r = rsqrtf(s * (1.f / 256.f) + EPS);
#pragma unroll
    for (int j = 0; j < 4; ++j) m[lane + 64 * j] = y[j] * r * nw[g * 256 + lane + 64 * j];
}

__global__ void __launch_bounds__(256) k_topk(const float* __restrict__ q_lo, const float* __restrict__ q_hi, const float* __restrict__ subk, int* __restrict__ idx, float* __restrict__ gate) {
    __shared__ float s[256];
    __shared__ float ts[2][16];
    __shared__ int ti[2][16];
    __shared__ float cs[256];
    __shared__ float bs[16];
    __shared__ int be[16];
    const int t = blockIdx.x >> 3, h = blockIdx.x & 7, tid = threadIdx.x, p = tid >> 7, k = tid & 127;
    const float4* qv = (const float4*)((h < 4 ? q_lo : q_hi) + (size_t)t * 1024 + (h & 3) * 256 + p * 128);
    const float4* kr = (const float4*)(subk + (((size_t)h * 2 + p) * 128 + k) * 128);
    float acc = 0.f;
#pragma unroll 8
    for (int d = 0; d < 32; ++d) { const float4 a = qv[d], b = kr[d]; acc += a.x * b.x + a.y * b.y + a.z * b.z + a.w * b.w; }
    s[tid] = acc;
    __syncthreads();
    int r = 0;
    for (int j = 0; j < 128; ++j) { const float o = s[p * 128 + j]; r += (o > acc || (o == acc && j < k)) ? 1 : 0; }
    if (r < 16) { ts[p][r] = acc; ti[p][r] = k; }
    __syncthreads();
    const int i = tid >> 4, j2 = tid & 15;
    const float c = ts[0][i] + ts[1][j2];
    cs[tid] = c;
    __syncthreads();
    r = 0;
    for (int m = 0; m < 256; ++m) { const float o = cs[m]; r += (o > c || (o == c && m < tid)) ? 1 : 0; }
    if (r < 16) { bs[r] = c; be[r] = ti[0][i] * 128 + ti[1][j2]; }
    __syncthreads();
    if (tid < 16) {
        const float mx = bs[0];
        float den = 0.f;
#pragma unroll
        for (int m = 0; m < 16; ++m) den += expf(bs[m] - mx);
        gate[(size_t)t * 128 + h * 16 + tid] = expf(bs[tid] - mx) / den;
        idx[(size_t)t * 128 + h * 16 + tid] = be[tid];
    }
}

__global__ void __launch_bounds__(256) k_expert(const float* __restrict__ hres, const float* __restrict__ u, const float* __restrict__ v, const int* __restrict__ idx, const float* __restrict__ gate,
                                                const float* __restrict__ nfw, float* out) {
    __shared__ float hid[128];
    __shared__ int eid[128];
    __shared__ float red[4];
    const int t = blockIdx.x, tid = threadIdx.x, w = tid >> 6, lane = tid & 63;
    if (tid < 128) eid[tid] = idx[(size_t)t * 128 + tid];
    float4 xv[4];
#pragma unroll
    for (int j = 0; j < 4; ++j) xv[j] = ((const float4*)(out + (size_t)t * D))[lane + 64 * j];
    __syncthreads();
    for (int e = w * 32; e < w * 32 + 32; ++e) {
        const float4* ur = (const float4*)(u + (size_t)eid[e] * D);
        float s = 0.f;
#pragma unroll
        for (int j = 0; j < 4; ++j) { const float4 a = ur[lane + 64 * j]; s += a.x * xv[j].x + a.y * xv[j].y + a.z * xv[j].z + a.w * xv[j].w; }
        s = wave_sum(s);
        if (lane == 0) hid[e] = gelu_f(s) * gate[(size_t)t * 128 + e];
    }
    __syncthreads();
    float4 acc = ((const float4*)(hres + (size_t)t * D))[tid];
    for (int e = 0; e < 128; ++e) {
        const float4 vv = ((const float4*)(v + (size_t)eid[e] * D))[tid];
        const float hh = hid[e];
        acc.x += hh * vv.x; acc.y += hh * vv.y; acc.z += hh * vv.z; acc.w += hh * vv.w;
    }
    float ss = acc.x * acc.x + acc.y * acc.y + acc.z * acc.z + acc.w * acc.w;
    ss = wave_sum(ss);
    if (lane == 0) red[w] = ss;
    __syncthreads();
    const float tot = red[0] + red[1] + red[2] + red[3];
    const float r = rsqrtf(tot * (1.f / D) + EPS);
    const float4 ww = ((const float4*)nfw)[tid];
    float4 o; o.x = acc.x * r * ww.x; o.y = acc.y * r * ww.y; o.z = acc.z * r * ww.z; o.w = acc.w * r * ww.w;
    ((float4*)(out + (size_t)t * D))[tid] = o;
}
__global__ void __launch_bounds__(256) k_bf2f(const unsigned short* __restrict__ src, float* __restrict__ dst, size_t n) {
    for (size_t i = (size_t)blockIdx.x * 256 + threadIdx.x; i < n; i += (size_t)gridDim.x * 256) dst[i] = bf2f(src[i]);
}
}
extern "C" void kernel_launch(void* const* d_in, const int* in_sizes, int n_in, void* d_out, int out_size, void* d_ws, size_t ws_size, hipStream_t stream) {
    static int grid = 0;
    if (grid == 0) {
        if (n_in != 19 || out_size != T * D || ws_size < 256 * MiB) { fprintf(stderr, "kernel_launch: unexpected shapes n_in %d out %d ws %zu\n", n_in, out_size, ws_size); grid = -1; return; }
        int dev = 0, cus = 0, per_cu = 0;
        if (hipGetDevice(&dev) != hipSuccess || hipDeviceGetAttribute(&cus, hipDeviceAttributeMultiprocessorCount, dev) != hipSuccess) { grid = -1; return; }
        if (hipFuncSetAttribute((const void*)fwd, hipFuncAttributeMaxDynamicSharedMemorySize, LDS_BYTES) != hipSuccess) { fprintf(stderr, "kernel_launch: hipFuncSetAttribute failed\n"); grid = -1; return; }
        if (hipOccupancyMaxActiveBlocksPerMultiprocessor(&per_cu, (const void*)fwd, NWAVES * 64, LDS_BYTES) != hipSuccess || per_cu < 1) { fprintf(stderr, "kernel_launch: occupancy query says %d\n", per_cu); }
        (void)hipGetLastError();
        grid = cus;
    }
    if (grid < 0) return;
    const float* x = (const float*)d_in[0];
    const float* gla_w2 = (const float*)d_in[3];
    const float* gla_bg = (const float*)d_in[4];
    const float* gla_nw = (const float*)d_in[5];
    const float* conv_w = (const float*)d_in[6];
    const float* conv_b = (const float*)d_in[7];
    const float* dt_bias = (const float*)d_in[8];
    const float* a_log = (const float*)d_in[9];
    const float* d_skip = (const float*)d_in[10];
    const float* ssd_nw = (const float*)d_in[11];
    const float* w_out = (const float*)d_in[12];
    const float* norm_ffn_w = (const float*)d_in[13];
    const float* w_query = (const float*)d_in[14];
    const float* sub_keys = (const float*)d_in[15];
    const float* pu = (const float*)d_in[16];
    const float* pv = (const float*)d_in[17];
    const float* norm_final_w = (const float*)d_in[18];
    float* out = (float*)d_out;
    char* ws = (char*)d_ws;

    (void)hipMemsetAsync(ws + WS_CTL, 0, CTL_ZERO_BYTES, stream);
    Args a{};
    for (int i = 0; i < 19; ++i) a.in[i] = (const float*)d_in[i];
    a.out = out; a.ws = (unsigned char*)d_ws; a.ph_lo = 0; a.ph_hi = 9;
    hipLaunchKernelGGL(fwd, dim3(grid), dim3(NWAVES * 64), LDS_BYTES, stream, a);

}
```

```cpp
#include <hip/hip_runtime.h>
#include <cstdio>
#include <cstdint>
namespace pg8 {
#define PG8_LAS __attribute__((address_space(3)))
typedef unsigned short bf16_t;
typedef short bf16x8 __attribute__((ext_vector_type(8)));
typedef float f32x4 __attribute__((ext_vector_type(4)));
typedef unsigned u32x4 __attribute__((ext_vector_type(4)));
constexpr int BM = 256, BK = 64, HALF = 128, HTB = HALF * BK * 2  , STAGE_BYTES = 8 * HTB, NXCD = 8, WGM = 8;

__host__ __device__ __forceinline__ int lds_byte(int r, int c) { const int st = (r >> 4) * 2 + (c >> 5), rr = r & 15, cc = c & 31, ob = rr * 64 + cc * 2; return st * 1024 + (ob ^ (((ob >> 9) & 1) << 5)); }
__host__ __device__ __forceinline__ void stage_rc(int b, int& R, int& C) { const int st = b / 1024, sb = b % 1024, swz = sb ^ (((sb >> 9) & 1) << 5); R = (st >> 1) * 16 + swz / 64; C = (st & 1) * 32 + (swz % 64) / 2; }
__host__ __device__ __forceinline__ int perm32(int rho) { const int n = rho >> 4, i = rho & 15; return 8 * (i >> 2) + 4 * n + (i & 3); }

struct Unit { int pm, pn; };
struct Gemm { const bf16_t* A; const bf16_t* Bt; int M, N, K; };

struct StaticOrder {
    int nM, nN, nwg, G, c;
    __host__ __device__ void init(int M, int N, int G_, int c_) { nM = M / BM; nN = N / BM; nwg = nM * nN; G = G_; c = c_; }
    __host__ __device__ bool next(int i, Unit& u) const {
        const long L = (long)i * G + c; if (L >= nwg) return false;
        int wgid = (int)L; { const int q = nwg / NXCD, r = nwg % NXCD, xcd = wgid % NXCD, off = wgid / NXCD; wgid = (xcd < r ? xcd * (q + 1) : r * (q + 1) + (xcd - r) * q) + off; }
        const int nig = WGM * nN, gid = wgid / nig, fm = gid * WGM, gsz = (nM - fm) < WGM ? (nM - fm) : WGM;
        u.pm = fm + ((wgid % nig) % gsz); u.pn = (wgid % nig) / gsz; return true;
    }
    __device__ __forceinline__ void a_ready(const Unit&) const {}
    __device__ __forceinline__ void done(const Unit&) const {}
};

__device__ __forceinline__ unsigned cvt_pk_bf16(float lo, float hi) { unsigned r; asm volatile("v_cvt_pk_bf16_f32 %0, %1, %2" : "=v"(r) : "v"(lo), "v"(hi)); return r; }
typedef float f32x2 __attribute__((ext_vector_type(2)));
struct EpiRowScaleBf16 {
    static constexpr bool PERM = true, AFTER_DRAIN = false;
    bf16_t* O; int ldc; const float* rs;
    __device__ __forceinline__ void operator()(const f32x4 (&acc)[2][2][4][2], const Unit& u, int wr, int wc, int fr, int fq) const {
        const int row0 = u.pm * BM + wr * 64 + fr, col0 = u.pn * BM + wc * 32 + 8 * fq;
#pragma unroll
        for (int ai = 0; ai < 2; ++ai)
#pragma unroll
            for (int m = 0; m < 4; ++m) { const int row = row0 + ai * HALF + m * 16; const float sc = rs[row]; bf16_t* rowp = O + (size_t)row * ldc + col0;
#pragma unroll
                for (int bj = 0; bj < 2; ++bj) { const f32x4 v0 = acc[ai][bj][m][0] * sc, v1 = acc[ai][bj][m][1] * sc;
                    u32x4 w; w.x = cvt_pk_bf16(v0[0], v0[1]); w.y = cvt_pk_bf16(v0[2], v0[3]); w.z = cvt_pk_bf16(v1[0], v1[1]); w.w = cvt_pk_bf16(v1[2], v1[3]);
                    *(u32x4*)(rowp + bj * HALF) = w; } }
    }
};
struct EpiRsqScaleBf16 {
    static constexpr bool PERM = true, AFTER_DRAIN = false;
    bf16_t* O; int ldc; const float* rowsq;
    __device__ __forceinline__ void operator()(const f32x4 (&acc)[2][2][4][2], const Unit& u, int wr, int wc, int fr, int fq) const {
        const int row0 = u.pm * BM + wr * 64 + fr, col0 = u.pn * BM + wc * 32 + 8 * fq;
#pragma unroll
        for (int ai = 0; ai < 2; ++ai)
#pragma unroll
            for (int m = 0; m < 4; ++m) { const int row = row0 + ai * HALF + m * 16; const float sc = rsqrtf(rowsq[row] * (1.f / 1024.f) + 1e-6f); bf16_t* rowp = O + (size_t)row * ldc + col0;
#pragma unroll
                for (int bj = 0; bj < 2; ++bj) { const f32x4 v0 = acc[ai][bj][m][0] * sc, v1 = acc[ai][bj][m][1] * sc;
                    u32x4 w; w.x = cvt_pk_bf16(v0[0], v0[1]); w.y = cvt_pk_bf16(v0[2], v0[3]); w.z = cvt_pk_bf16(v1[0], v1[1]); w.w = cvt_pk_bf16(v1[2], v1[3]);
                    *(u32x4*)(rowp + bj * HALF) = w; } }
    }
};
struct EpiResidual {
    static constexpr bool PERM = true, AFTER_DRAIN = false;
    const float* X; float* H; bf16_t* HB; float* rowsq; int ldc;
    __device__ __forceinline__ void operator()(const f32x4 (&acc)[2][2][4][2], const Unit& u, int wr, int wc, int fr, int fq) const {
        const int row0 = u.pm * BM + wr * 64 + fr, col0 = u.pn * BM + wc * 32 + 8 * fq;
#pragma unroll
        for (int ai = 0; ai < 2; ++ai)
#pragma unroll
            for (int m = 0; m < 4; ++m) { const int row = row0 + ai * HALF + m * 16; float ss = 0.f;
#pragma unroll
                for (int bj = 0; bj < 2; ++bj) { const size_t off = (size_t)row * ldc + col0 + bj * HALF;
                    const f32x4 v0 = acc[ai][bj][m][0] + *(const f32x4*)(X + off), v1 = acc[ai][bj][m][1] + *(const f32x4*)(X + off + 4);
                    if (H) { *(f32x4*)(H + off) = v0; *(f32x4*)(H + off + 4) = v1; }
                    u32x4 w; w.x = cvt_pk_bf16(v0[0], v0[1]); w.y = cvt_pk_bf16(v0[2], v0[3]); w.z = cvt_pk_bf16(v1[0], v1[1]); w.w = cvt_pk_bf16(v1[2], v1[3]);
                    *(u32x4*)(HB + off) = w;
                    ss += (v0[0] * v0[0] + v0[1] * v0[1]) + (v0[2] * v0[2] + v0[3] * v0[3]) + (v1[0] * v1[0] + v1[1] * v1[1]) + (v1[2] * v1[2] + v1[3] * v1[3]); }
                ss += __shfl_xor(ss, 16); ss += __shfl_xor(ss, 32);
                if (fq == 0) atomicAdd(rowsq + row, ss); }
    }
};
template <class Epi, class Sched, bool ALIGN_EPI = false, bool SP2 = false>
__device__ __forceinline__ void gemm_phase(PG8_LAS unsigned char* lds, const Gemm g, const Sched& S, const Epi& E) {
    const int tid = threadIdx.x, wid = __builtin_amdgcn_readfirstlane(tid >> 6), lane = tid & 63, wr = wid >> 2, wc = wid & 3, fr = lane & 15, fq = lane >> 4;
    const int K = g.K, nt = K / BK;
    unsigned voffA[2], voffB[2];
#pragma unroll
    for (int i = 0; i < 2; ++i) { int R, C; stage_rc(tid * 16 + i * 8192, R, C); const int Rb = Epi::PERM ? ((R & ~31) + perm32(R & 31)) : R;
        voffA[i] = (unsigned)(R * K + C) * 2u; voffB[i] = (unsigned)(Rb * K + C) * 2u; }
    const size_t kstep = (size_t)(BK * 2);
    const size_t hstep = (size_t)HALF * K * 2;
    const size_t tstep = 2 * hstep;
    const unsigned ldsw = (unsigned)wid * 1024u;
    const int aoff = lds_byte(wr * 64 + fr, fq * 8), boff = lds_byte(wc * 32 + fr, fq * 8);
#define PG8_SA(b, h) (((b) * 2 + (h)) * HTB)
#define PG8_SB(b, h) ((4 + (b) * 2 + (h)) * HTB)
#define PG8_STAGE(bufoff, gbase, voff) do { _Pragma("unroll") for (int _i = 0; _i < 2; ++_i) \
        __builtin_amdgcn_global_load_lds((const unsigned*)((const char*)(gbase) + (voff)[_i]), (PG8_LAS unsigned*)(lds + (bufoff) + ldsw + _i * 8192), 16, 0, 0); } while (0)
#define PG8_LDA(dst, b, h) do { _Pragma("unroll") for (int m = 0; m < 4; ++m) _Pragma("unroll") for (int k = 0; k < 2; ++k) dst[m][k] = *(const PG8_LAS bf16x8*)(lds + PG8_SA(b, h) + aoff + m * 2048 + k * 1024); } while (0)
#define PG8_LDB(dst, b, h) do { _Pragma("unroll") for (int n = 0; n < 2; ++n) _Pragma("unroll") for (int k = 0; k < 2; ++k) dst[n][k] = *(const PG8_LAS bf16x8*)(lds + PG8_SB(b, h) + boff + n * 2048 + k * 1024); } while (0)
#define PG8_MMA(ai, bj, At, Bt) do { __builtin_amdgcn_s_setprio(1); _Pragma("unroll") for (int m = 0; m < 4; ++m) _Pragma("unroll") for (int n = 0; n < 2; ++n) _Pragma("unroll") for (int k = 0; k < 2; ++k) \
        acc[ai][bj][m][n] = __builtin_amdgcn_mfma_f32_16x16x32_bf16(Bt[n][k], At[m][k], acc[ai][bj][m][n], 0, 0, 0); __builtin_amdgcn_s_setprio(0); } while (0)
#define PG8_WAIT_V(n) asm volatile("s_waitcnt vmcnt(" #n ")" ::: "memory")
#define PG8_WAIT_L(n) asm volatile("s_waitcnt lgkmcnt(" #n ")" ::: "memory")
#define PG8_BAR __builtin_amdgcn_s_barrier()
#define PG8_SCHED __builtin_amdgcn_sched_barrier(0)
    Unit cur, nxt; int ui = 0;
    if (!S.next(0, cur)) return;
    f32x4 acc[2][2][4][2];
#pragma unroll
    for (int a = 0; a < 2; ++a)
#pragma unroll
        for (int b = 0; b < 2; ++b)
#pragma unroll
            for (int m = 0; m < 4; ++m)
#pragma unroll
                for (int n = 0; n < 2; ++n) acc[a][b][m][n] = (f32x4){0.f, 0.f, 0.f, 0.f};
    bf16x8 At[4][2], B0[2][2], B1[2][2];
    const char* cA = (const char*)g.A + (size_t)cur.pm * tstep; const char* cB = (const char*)g.Bt + (size_t)cur.pn * tstep;
    S.a_ready(cur);
    if constexpr (SP2) {
        PG8_STAGE(PG8_SB(0, 0), cB, voffB); PG8_STAGE(PG8_SB(0, 1), cB + hstep, voffB); PG8_STAGE(PG8_SA(0, 0), cA, voffA); PG8_STAGE(PG8_SA(0, 1), cA + hstep, voffA);
        if (wr == 1) PG8_BAR;
        PG8_WAIT_V(2); PG8_BAR;
        PG8_STAGE(PG8_SB(1, 0), cB + kstep, voffB); PG8_STAGE(PG8_SA(1, 0), cA + kstep, voffA); PG8_STAGE(PG8_SB(1, 1), cB + hstep + kstep, voffB);
        PG8_WAIT_V(6); PG8_BAR;
    } else {
        PG8_STAGE(PG8_SB(0, 0), cB, voffB); PG8_STAGE(PG8_SA(0, 0), cA, voffA); PG8_STAGE(PG8_SB(0, 1), cB + hstep, voffB); PG8_STAGE(PG8_SA(0, 1), cA + hstep, voffA);
        if (wr == 1) PG8_BAR;
        PG8_WAIT_V(4); PG8_BAR;
        PG8_STAGE(PG8_SB(1, 0), cB + kstep, voffB); PG8_STAGE(PG8_SA(1, 0), cA + kstep, voffA); PG8_STAGE(PG8_SB(1, 1), cB + hstep + kstep, voffB);
        PG8_WAIT_V(6); PG8_BAR;
    }
    for (;;) {
        const bool has_next = S.next(ui + 1, nxt);
        const char* nA = has_next ? (const char*)g.A + (size_t)nxt.pm * tstep : cA; const char* nB = has_next ? (const char*)g.Bt + (size_t)nxt.pn * tstep : cB;
        for (int t = 0; t < nt; t += 2) {
            const bool last = (t == nt - 2);
            const char* a1 = cA + (size_t)(t + 1) * kstep;
            const char* a2 = last ? nA : cA + (size_t)(t + 2) * kstep; const char* b2 = last ? nB : cB + (size_t)(t + 2) * kstep;
            const char* a3 = a2 + kstep; const char* b3 = b2 + kstep;
            if (last && has_next) S.a_ready(nxt);
            if constexpr (SP2) {
            PG8_LDB(B0, 0, 0); PG8_LDB(B1, 0, 1); PG8_SCHED; PG8_LDA(At, 0, 0); PG8_STAGE(PG8_SA(1, 1), a1 + hstep, voffA);
            PG8_WAIT_V(8); PG8_WAIT_L(0); PG8_BAR; PG8_MMA(0, 0, At, B0); PG8_MMA(0, 1, At, B1); PG8_BAR; PG8_SCHED;
            PG8_LDA(At, 0, 1); PG8_STAGE(PG8_SB(0, 0), b2, voffB); PG8_STAGE(PG8_SB(0, 1), b2 + hstep, voffB); PG8_STAGE(PG8_SA(0, 0), a2, voffA);
            PG8_WAIT_V(8); PG8_WAIT_L(0); PG8_BAR; PG8_MMA(1, 0, At, B0); PG8_MMA(1, 1, At, B1); PG8_BAR; PG8_SCHED;
            PG8_LDB(B0, 1, 0); PG8_LDB(B1, 1, 1); PG8_SCHED; PG8_LDA(At, 1, 0); PG8_STAGE(PG8_SA(0, 1), a2 + hstep, voffA);
            PG8_WAIT_V(8); PG8_WAIT_L(0); PG8_BAR; PG8_MMA(0, 0, At, B0); PG8_MMA(0, 1, At, B1); PG8_BAR; PG8_SCHED;
            PG8_LDA(At, 1, 1); PG8_STAGE(PG8_SB(1, 0), b3, voffB); PG8_STAGE(PG8_SB(1, 1), b3 + hstep, voffB); PG8_STAGE(PG8_SA(1, 0), a3, voffA);
            PG8_WAIT_V(8); PG8_WAIT_L(0); PG8_BAR; PG8_MMA(1, 0, At, B0); PG8_MMA(1, 1, At, B1); PG8_BAR; PG8_SCHED;
            } else {
            PG8_LDB(B0, 0, 0); PG8_SCHED; PG8_LDA(At, 0, 0); PG8_STAGE(PG8_SA(1, 1), a1 + hstep, voffA);
            PG8_WAIT_L(8); PG8_BAR; PG8_WAIT_L(0); PG8_MMA(0, 0, At, B0); PG8_BAR; PG8_SCHED;
            PG8_LDB(B1, 0, 1); PG8_STAGE(PG8_SB(0, 0), b2, voffB);
            PG8_BAR; PG8_WAIT_L(0); PG8_MMA(0, 1, At, B1); PG8_BAR;
            PG8_LDA(At, 0, 1); PG8_STAGE(PG8_SA(0, 0), a2, voffA);
            PG8_BAR; PG8_WAIT_L(0); PG8_MMA(1, 0, At, B0); PG8_BAR; PG8_SCHED;
            PG8_STAGE(PG8_SB(0, 1), b2 + hstep, voffB);
            PG8_WAIT_V(6); PG8_BAR; PG8_MMA(1, 1, At, B1); PG8_BAR;
            PG8_LDB(B0, 1, 0); PG8_SCHED; PG8_LDA(At, 1, 0); PG8_STAGE(PG8_SA(0, 1), a2 + hstep, voffA);
            PG8_WAIT_L(8); PG8_BAR; PG8_WAIT_L(0); PG8_MMA(0, 0, At, B0); PG8_BAR; PG8_SCHED;
            PG8_LDB(B1, 1, 1); PG8_STAGE(PG8_SB(1, 0), b3, voffB);
            PG8_BAR; PG8_WAIT_L(0); PG8_MMA(0, 1, At, B1); PG8_BAR;
            PG8_LDA(At, 1, 1); PG8_STAGE(PG8_SA(1, 0), a3, voffA);
            PG8_BAR; PG8_WAIT_L(0); PG8_MMA(1, 0, At, B0); PG8_BAR; PG8_SCHED;
            PG8_STAGE(PG8_SB(1, 1), b3 + hstep, voffB);
            PG8_WAIT_V(6); PG8_BAR; PG8_MMA(1, 1, At, B1); PG8_BAR;
            }
        }
        if constexpr (ALIGN_EPI) { if (wr == 0) PG8_BAR; }
        if constexpr (!Epi::AFTER_DRAIN) { E(acc, cur, wr, wc, fr, fq); S.done(cur); }
        if (!has_next) break;
#pragma unroll
        for (int a = 0; a < 2; ++a)
#pragma unroll
            for (int b = 0; b < 2; ++b)
#pragma unroll
                for (int m = 0; m < 4; ++m)
#pragma unroll
                    for (int n = 0; n < 2; ++n) acc[a][b][m][n] = (f32x4){0.f, 0.f, 0.f, 0.f};
        cur = nxt; cA = nA; cB = nB; ++ui;
        if constexpr (ALIGN_EPI) { if (wr == 1) PG8_BAR; }
    }
    PG8_WAIT_V(0);
    if constexpr (!ALIGN_EPI) { if (wr == 0) PG8_BAR; }
    PG8_BAR;
    if constexpr (Epi::AFTER_DRAIN) { E.fused(acc, cur, wr, wc, fr, fq, lds, wid, lane); S.done(cur); }
#undef PG8_SA
#undef PG8_SB
#undef PG8_STAGE
#undef PG8_LDA
#undef PG8_LDB
#undef PG8_MMA
#undef PG8_WAIT_V
#undef PG8_WAIT_L
#undef PG8_BAR
#undef PG8_SCHED
}
}
constexpr int NWAVES = 8;
constexpr int T = 16384, SEQ = 8192, D = 1024, NIN = 2840, NINP = 3072, NQ = 2048;
constexpr int C_Q = 0, C_K = 256, C_V = 512, C_GLR = 1024, C_GOUT = 1040, C_Z = 1552, C_XBC = 2064, C_DT = 2832;
constexpr float EPS = 1e-6f;
constexpr size_t MiB = 1u << 20;
constexpr size_t WS_CTL = 0, CTL_ZERO_BYTES = 64 * 1024;
constexpr size_t WS_WIN = 1 * MiB;
constexpr size_t WS_WO = 7 * MiB;
constexpr size_t WS_WQ = 9 * MiB;
constexpr size_t WS_SUBK = 13 * MiB;
constexpr size_t WS_RRMS1 = 14 * MiB;
constexpr size_t WS_ROWSQ2 = 14 * MiB + 64 * 1024;
constexpr size_t WS_UB = 16 * MiB, WS_VB = 48 * MiB;
constexpr size_t WS_XB = 80 * MiB;
constexpr size_t WS_PROJ = 112 * MiB;
constexpr int CW_TMO = 0, CW_BAR = 1024;
constexpr int RING_OFF = 0, RING_BYTES = 131072;
constexpr int LDS_BYTES = 163840;
constexpr int LDSCTL_OFF = LDS_BYTES - 1024, MISC_OFF = LDSCTL_OFF + 320;

#define GAS __attribute__((address_space(1)))
#define LAS __attribute__((address_space(3)))
typedef unsigned short bf16;
typedef unsigned v4u __attribute__((ext_vector_type(4)));
typedef float f32x4 __attribute__((ext_vector_type(4)));
typedef short bf16x8 __attribute__((ext_vector_type(8)));
typedef GAS unsigned gu32;
#define RLX_AGENT __ATOMIC_RELAXED, __HIP_MEMORY_SCOPE_AGENT
#define LDS_WAIT() asm volatile("s_waitcnt lgkmcnt(0)" ::: "memory")
#define VM_WAIT() asm volatile("s_waitcnt vmcnt(0)" ::: "memory")
typedef float f32x2c __attribute__((ext_vector_type(2)));
typedef __bf16 bf16x2c __attribute__((ext_vector_type(2)));
__device__ __forceinline__ unsigned f2bf(float f) { const __bf16 b = (__bf16)f; return (unsigned)__builtin_bit_cast(unsigned short, b); }
__device__ __forceinline__ unsigned pk2(float lo, float hi) { const bf16x2c v = __builtin_convertvector((f32x2c){lo, hi}, bf16x2c); return __builtin_bit_cast(unsigned, v); }
__device__ __forceinline__ float bf2f(unsigned short b) { return __builtin_bit_cast(float, (unsigned)b << 16); }
__device__ __forceinline__ float wave_sum(float v) {
#pragma unroll
    for (int o = 1; o < 64; o <<= 1) v += __shfl_xor(v, o);
    return v;
}
#define XB_TMO      128
#define XB_XCNT(j)  (256  + 64 * (j))
#define XB_XSUB(j)  (1280 + 64 * (j))
#define XB_XGEN(j)  (2304 + 64 * (j))
#define XB_TOP      3328
#define XB_TOPGEN   3392
#define XCD_BAR_WORDS 3456
#define XB_SPIN_CAP (1u << 18)

__device__ __forceinline__ unsigned xb_ld(unsigned* p)              { return __hip_atomic_load(p, __ATOMIC_RELAXED, __HIP_MEMORY_SCOPE_AGENT); }
__device__ __forceinline__ unsigned xb_add(unsigned* p, unsigned v) { return __hip_atomic_fetch_add(p, v, __ATOMIC_RELAXED, __HIP_MEMORY_SCOPE_AGENT); }
__device__ __forceinline__ unsigned xb_xcc_id() { return (unsigned)__builtin_amdgcn_s_getreg((3 << 11) | 20) & 0xFu; }
#define XB_SPIN(cond, bar) do { unsigned _sp = 0; while (cond) { __builtin_amdgcn_s_sleep(1); \
    if ((++_sp & 255u) == 0u) { if (xb_ld(&(bar)[XB_TMO])) break; if (_sp > XB_SPIN_CAP) { atomicAdd(&(bar)[XB_TMO], 1u); break; } } } } while (0)

struct XcdBarrier {
    unsigned* bar; unsigned x;
    volatile LAS unsigned* st;
};

__device__ __forceinline__ XcdBarrier xcd_barrier_post(unsigned* bar, volatile LAS unsigned* st) {
    XcdBarrier b; b.bar = bar; b.x = xb_xcc_id(); b.st = st;
    if (threadIdx.x == 0) (void)xb_add(&bar[XB_XCNT(b.x)], 1u);
    return b;
}
__device__ __forceinline__ void xcd_barrier_complete(unsigned* bar, unsigned x, unsigned& nloc, unsigned& nx) {
    const unsigned G = gridDim.x * gridDim.y * gridDim.z;
    unsigned sum, cnt, mine, sp = 0u;
    for (;;) {
        sum = 0u; cnt = 0u; mine = 0u;
#pragma unroll
        for (unsigned j = 0; j < 16; ++j) { const unsigned c = xb_ld(&bar[XB_XCNT(j)]); sum += c; cnt += (c > 0u) ? 1u : 0u; mine = (j == x) ? c : mine; }
        if (sum == G) break;
        __builtin_amdgcn_s_sleep(1);
        if ((++sp & 255u) == 0u) { if (xb_ld(&bar[XB_TMO])) break; if (sp > XB_SPIN_CAP) { atomicAdd(&bar[XB_TMO], 1u); break; } }
    }
    nloc = mine > 0u ? mine : 1u; nx = cnt > 0u ? cnt : 1u;
}

__device__ __forceinline__ void xcd_barrier(const XcdBarrier& b) {
    asm volatile("s_waitcnt vmcnt(0)" ::: "memory");
    __syncthreads();
    if (threadIdx.x == 0) {
        unsigned* bar = b.bar;
        __builtin_amdgcn_s_waitcnt(0);
        unsigned nloc = b.st[0], nx = b.st[1];
        if (nloc == 0u) { xcd_barrier_complete(bar, b.x, nloc, nx); b.st[0] = nloc; b.st[1] = nx; }
        const unsigned old = xb_add(&bar[XB_XSUB(b.x)], 1u);
        const unsigned gen = old / nloc;
        if (old + 1u == (gen + 1u) * nloc) {
            __builtin_amdgcn_fence(__ATOMIC_RELEASE, "agent");
            asm volatile("s_waitcnt vmcnt(0)" ::: "memory");
            const unsigned og = xb_add(&bar[XB_TOP], 1u);
            const unsigned tg = og / nx;
            if (og + 1u == (tg + 1u) * nx) xb_add(&bar[XB_TOPGEN], 1u);
            else XB_SPIN(xb_ld(&bar[XB_TOPGEN]) == tg, bar);
            __builtin_amdgcn_fence(__ATOMIC_ACQUIRE, "agent");
            xb_add(&bar[XB_XGEN(b.x)], 1u);
            asm volatile("s_waitcnt vmcnt(0)" ::: "memory");
        } else {
            XB_SPIN(xb_ld(&bar[XB_XGEN(b.x)]) == gen, bar);
            __builtin_amdgcn_fence(__ATOMIC_ACQUIRE, "agent");
            asm volatile("s_waitcnt vmcnt(0)" ::: "memory");
        }
    }
    __syncthreads();
}
struct Args {
    const float* in[19]; float* out; unsigned char* ws; int ph_lo, ph_hi;
};
struct Frame {
    LAS unsigned char* lds; volatile LAS unsigned* MISC; gu32* ctl;
    int tid, lane, wave, G, gw, NGW;
};

constexpr size_t WS_GDEC = 14 * MiB + 128 * 1024;
constexpr size_t WS_SDEC = 14 * MiB + 512 * 1024;
constexpr size_t WS_GST = 208 * MiB;
constexpr size_t WS_SST = 224 * MiB;
constexpr int SA64 = 144, SA128 = 272, SA32 = 80;

__device__ __forceinline__ float silu_f(float x) { return x * __builtin_amdgcn_rcpf(1.f + __expf(-x)); }
__device__ __forceinline__ float softplus_f(float x) { return fmaxf(x, 0.f) + __logf(1.f + __expf(-fabsf(x))); }
__device__ __forceinline__ float logsigmoid_f(float x) { return fminf(x, 0.f) - __logf(1.f + __expf(-fabsf(x))); }
typedef unsigned u32x2 __attribute__((ext_vector_type(2)));

__device__ __forceinline__ f32x4 mma16(const LAS unsigned char* A, int sa, const LAS unsigned char* Bt, int sb, int K, f32x4 acc, int r, int kg) {
    for (int k0 = 0; k0 < K; k0 += 32) {
        const bf16x8 a = *(const LAS bf16x8*)(A + r * sa + (k0 + 8 * kg) * 2);
        const bf16x8 b = *(const LAS bf16x8*)(Bt + r * sb + (k0 + 8 * kg) * 2);
        acc = __builtin_amdgcn_mfma_f32_16x16x32_bf16(a, b, acc, 0, 0, 0);
    }
    return acc;
}

__device__ __forceinline__ void unpack8f(const v4u x, float (&f)[8]) {
    f[0] = __builtin_bit_cast(float, x.x << 16); f[1] = __builtin_bit_cast(float, x.x & 0xffff0000u); f[2] = __builtin_bit_cast(float, x.y << 16); f[3] = __builtin_bit_cast(float, x.y & 0xffff0000u);
    f[4] = __builtin_bit_cast(float, x.z << 16); f[5] = __builtin_bit_cast(float, x.z & 0xffff0000u); f[6] = __builtin_bit_cast(float, x.w << 16); f[7] = __builtin_bit_cast(float, x.w & 0xffff0000u);
}
template <int MODE>
__device__ __forceinline__ void gla_unit(const Frame& F, const Args& A, int unit) {
    const int b = unit >> 9, c = (unit >> 2) & 127, h = unit & 3;
    const size_t t0 = (size_t)b * SEQ + (size_t)c * 64;
    const GAS bf16* proj = (const GAS bf16*)(A.ws + WS_PROJ);
    LAS unsigned char* L = F.lds;
    LAS float* GLR = (LAS float*)(L + 0);
    LAS float* SEG = (LAS float*)(L + 4096);
    LAS float* RSQ = (LAS float*)(L + 6144);
    LAS unsigned char* QI = L + 8192;
    LAS unsigned char* KI = QI + 64 * SA64;
    LAS unsigned char* VT = KI + 64 * SA64;
    LAS unsigned char* SP = VT + 128 * SA64;
    LAS unsigned char* AT = SP + 128 * SA64;
    LAS unsigned char* GO = AT + 64 * SA64;
    int tid = F.tid, seg = F.wave;
    asm volatile("" : "+v"(tid)); asm volatile("" : "+s"(seg));
    const int d = tid & 63;
    {
        const int row = tid >> 3, ch = tid & 7;
        const GAS bf16* prow = proj + (t0 + row) * NINP;
        const v4u kq = *(const GAS v4u*)(prow + C_K + h * 64 + ch * 8);
        v4u qq = kq; if (MODE == 1) qq = *(const GAS v4u*)(prow + C_Q + h * 64 + ch * 8);
        const int o = tid & 15, jp = tid >> 4;
        const v4u va = *(const GAS v4u*)(proj + (t0 + 2 * jp) * NINP + C_V + h * 128 + o * 8), vb = *(const GAS v4u*)(proj + (t0 + 2 * jp + 1) * NINP + C_V + h * 128 + o * 8);
        v4u g0 = kq, g1 = kq, s0 = kq, s1 = kq;
        if (MODE == 1) {
            const int r2 = tid >> 4, c2 = tid & 15;
            g0 = *(const GAS v4u*)(proj + (t0 + r2) * NINP + C_GOUT + h * 128 + c2 * 8); g1 = *(const GAS v4u*)(proj + (t0 + r2 + 32) * NINP + C_GOUT + h * 128 + c2 * 8);
            const GAS bf16* sp = (const GAS bf16*)(A.ws + WS_GST) + (size_t)unit * 8192;
            s0 = *(const GAS v4u*)(sp + (tid >> 3) * 64 + (tid & 7) * 8); s1 = *(const GAS v4u*)(sp + (64 + (tid >> 3)) * 64 + (tid & 7) * 8);
        }
        v4u gl = kq; if (tid < 128) gl = *(const GAS v4u*)(proj + (t0 + (tid >> 1)) * NINP + C_GLR + (tid & 1) * 8);
        if (MODE == 1) { *(LAS v4u*)(QI + row * SA64 + ch * 16) = qq; *(LAS v4u*)(KI + row * SA64 + ch * 16) = kq; }
        else *(LAS v4u*)(GO + row * SA64 + ch * 16) = kq;
        {   const unsigned aw[4] = {va.x, va.y, va.z, va.w}, bw[4] = {vb.x, vb.y, vb.z, vb.w};
#pragma unroll
            for (int cc = 0; cc < 8; ++cc) { const unsigned x = aw[cc >> 1], y = bw[cc >> 1];
                const unsigned wv_ = (cc & 1) ? ((x >> 16) | (y & 0xffff0000u)) : ((x & 0xffffu) | (y << 16));
                *(LAS unsigned*)(VT + (8 * o + cc) * SA64 + jp * 4) = wv_; } }
        if (MODE == 1) {
            const int r2 = tid >> 4, c2 = tid & 15;
            *(LAS v4u*)(GO + r2 * SA128 + c2 * 16) = g0; *(LAS v4u*)(GO + (r2 + 32) * SA128 + c2 * 16) = g1;
            *(LAS v4u*)(SP + (tid >> 3) * SA64 + (tid & 7) * 16) = s0; *(LAS v4u*)(SP + (64 + (tid >> 3)) * SA64 + (tid & 7) * 16) = s1;
        }
        if (tid < 128) { float f[8]; unpack8f(gl, f);
#pragma unroll
            for (int q = 0; q < 8; ++q) GLR[(tid >> 1) * 16 + (tid & 1) * 8 + q] = f[q]; }
    }
    float wv[16];
#pragma unroll
    for (int r = 0; r < 16; ++r) wv[r] = A.in[3][r * 256 + h * 64 + d];
    const float bgv = A.in[4][h * 64 + d];
    __syncthreads();
    float Gv[8]; float run = 0.f;
#pragma unroll
    for (int ii = 0; ii < 8; ++ii) { const int i = seg * 8 + ii; float z = bgv;
#pragma unroll
        for (int r = 0; r < 16; ++r) z += GLR[i * 16 + r] * wv[r];
        run += logsigmoid_f(z) * (1.f / 16.f); Gv[ii] = run; }
    SEG[seg * 64 + d] = run;
    __syncthreads();
    float off = 0.f, tot = 0.f;
#pragma unroll
    for (int s = 0; s < 8; ++s) { const float v = SEG[s * 64 + d]; tot += v; off += (s < seg) ? v : 0.f; }
#pragma unroll
    for (int ii = 0; ii < 8; ++ii) Gv[ii] += off;
    if (MODE == 0) {
        unsigned w[4];
#pragma unroll
        for (int ii = 0; ii < 8; ii += 2) {
            const float k0 = bf2f(*(const LAS bf16*)(GO + (seg * 8 + ii) * SA64 + d * 2)) * __expf(tot - Gv[ii]);
            const float k1 = bf2f(*(const LAS bf16*)(GO + (seg * 8 + ii + 1) * SA64 + d * 2)) * __expf(tot - Gv[ii + 1]);
            w[ii >> 1] = pk2(k0, k1); }
        *(LAS v4u*)(KI + d * SA64 + seg * 16) = (v4u){w[0], w[1], w[2], w[3]};
        if (seg == 0) ((GAS float*)(A.ws + WS_GDEC))[unit * 64 + d] = __expf(tot);
    } else {
#pragma unroll
        for (int ii = 0; ii < 8; ++ii) { const int i = seg * 8 + ii;
            LAS bf16* qp = (LAS bf16*)(QI + i * SA64 + d * 2); LAS bf16* kp = (LAS bf16*)(KI + i * SA64 + d * 2);
            *qp = (bf16)f2bf(bf2f(*qp) * 0.125f * __expf(Gv[ii])); *kp = (bf16)f2bf(bf2f(*kp) * __expf(-Gv[ii])); }
    }
    __syncthreads();
    const int r = tid & 15, kg = (tid >> 4) & 3, w = seg;
    const f32x4 zero = (f32x4){0.f, 0.f, 0.f, 0.f};
    if (MODE == 0) {
        const int mt = w & 3, nb = (w >> 2) * 4;
        GAS bf16* stT = (GAS bf16*)(A.ws + WS_GST) + (size_t)unit * 8192;
#pragma unroll
        for (int n = 0; n < 4; ++n) {
            const f32x4 acc = mma16(KI + mt * 16 * SA64, SA64, VT + (nb + n) * 16 * SA64, SA64, 64, zero, r, kg);
            const int dv = (nb + n) * 16 + r, d0 = mt * 16 + kg * 4;
            *(GAS u32x2*)(stT + dv * 64 + d0) = (u32x2){pk2(acc[0], acc[1]), pk2(acc[2], acc[3])}; }
    } else {
        const int mt = w & 3;
#pragma unroll
        for (int n = 0; n < 2; ++n) { const int nt = (w >> 2) * 2 + n;
            const f32x4 acc = mma16(QI + mt * 16 * SA64, SA64, KI + nt * 16 * SA64, SA64, 64, zero, r, kg);
#pragma unroll
            for (int ii = 0; ii < 4; ++ii) { const int i = mt * 16 + kg * 4 + ii, j = nt * 16 + r; *(LAS bf16*)(AT + i * SA64 + j * 2) = (bf16)f2bf(j <= i ? acc[ii] : 0.f); } }
        __syncthreads();
        const int nb = (w >> 2) * 4;
        f32x4 o[4]; float rs[4] = {0.f, 0.f, 0.f, 0.f};
#pragma unroll
        for (int n = 0; n < 4; ++n) {
            f32x4 acc = mma16(AT + mt * 16 * SA64, SA64, VT + (nb + n) * 16 * SA64, SA64, 64, zero, r, kg);
            acc = mma16(QI + mt * 16 * SA64, SA64, SP + (nb + n) * 16 * SA64, SA64, 64, acc, r, kg);
            o[n] = acc;
#pragma unroll
            for (int ii = 0; ii < 4; ++ii) rs[ii] += acc[ii] * acc[ii]; }
#pragma unroll
        for (int ii = 0; ii < 4; ++ii) { rs[ii] += __shfl_xor(rs[ii], 1); rs[ii] += __shfl_xor(rs[ii], 2); rs[ii] += __shfl_xor(rs[ii], 4); rs[ii] += __shfl_xor(rs[ii], 8); }
        if (r == 0) {
#pragma unroll
            for (int ii = 0; ii < 4; ++ii) RSQ[(w >> 2) * 64 + mt * 16 + kg * 4 + ii] = rs[ii]; }
        __syncthreads();
        float rr[4];
#pragma unroll
        for (int ii = 0; ii < 4; ++ii) { const int row = mt * 16 + kg * 4 + ii; rr[ii] = rsqrtf((RSQ[row] + RSQ[64 + row]) * (1.f / 128.f) + EPS); }
#pragma unroll
        for (int n = 0; n < 4; ++n) { const int dv = (nb + n) * 16 + r; const float nwv = A.in[5][dv];
#pragma unroll
            for (int ii = 0; ii < 4; ++ii) { LAS bf16* gp = (LAS bf16*)(GO + (mt * 16 + kg * 4 + ii) * SA128 + dv * 2);
                *gp = (bf16)f2bf(o[n][ii] * rr[ii] * nwv * silu_f(bf2f(*gp))); } }
        __syncthreads();
        {   const int r2 = tid >> 4, c2 = tid & 15; GAS bf16* mixed = (GAS bf16*)(A.ws + WS_XB);
            *(GAS v4u*)(mixed + (t0 + r2) * D + h * 128 + c2 * 8) = *(const LAS v4u*)(GO + r2 * SA128 + c2 * 16);
            *(GAS v4u*)(mixed + (t0 + r2 + 32) * D + h * 128 + c2 * 8) = *(const LAS v4u*)(GO + (r2 + 32) * SA128 + c2 * 16); }
    }
    __syncthreads();
}

template <int MODE>
__device__ __forceinline__ void ssd_unit(const Frame& F, const Args& A, int unit) {
    const int b = unit >> 7, c = (unit >> 1) & 63, g = unit & 1;
    const size_t t0 = (size_t)b * SEQ + (size_t)c * 128;
    const GAS bf16* proj = (const GAS bf16*)(A.ws + WS_PROJ);
    LAS unsigned char* L = F.lds;
    LAS float* DT = (LAS float*)(L + 0);
    LAS float* ACU = (LAS float*)(L + 2048);
    LAS unsigned char* CM = L + 4096;
    LAS unsigned char* BM = CM + 128 * SA64;
    LAS unsigned char* XT = BM + 128 * SA64;
    LAS unsigned char* PW = XT + 4 * 64 * SA128;
    LAS unsigned char* ZW = PW + 8 * 16 * SA32;
    LAS float* RRW = (LAS float*)(ZW + 8 * 16 * SA64);
    int tid = F.tid, w = F.wave;
    asm volatile("" : "+v"(tid)); asm volatile("" : "+s"(w));
    const int lane = tid & 63;
    if (w < 4) {
        const int hd = g * 4 + w; const float Ah = -__expf(A.in[9][hd]), dtb = A.in[8][hd];
        const float dt0 = softplus_f(bf2f(proj[(t0 + 2 * lane) * NINP + C_DT + hd]) + dtb), dt1 = softplus_f(bf2f(proj[(t0 + 2 * lane + 1) * NINP + C_DT + hd]) + dtb);
        const float a0 = dt0 * Ah, a1 = dt1 * Ah; float s = a0 + a1;
#pragma unroll
        for (int o = 1; o < 64; o <<= 1) { const float t = __shfl_up(s, o); s += (lane >= o) ? t : 0.f; }
        DT[(2 * lane) * 4 + w] = dt0; DT[(2 * lane + 1) * 4 + w] = dt1; ACU[(2 * lane) * 4 + w] = s - a1; ACU[(2 * lane + 1) * 4 + w] = s;
        if (MODE == 0 && lane == 63) ((GAS float*)(A.ws + WS_SDEC))[(b * 64 + c) * 8 + hd] = __expf(s);
    }
    __syncthreads();
    if (tid < 384) {
        const int o = tid % 48, sg = tid / 48;
        if (!(MODE == 0 && o >= 40)) {
            const int cc0 = o < 32 ? g * 256 + 8 * o : (o < 40 ? 512 + g * 64 + 8 * (o - 32) : 640 + g * 64 + 8 * (o - 40));
            float wt[4][8], cb[8];
#pragma unroll
            for (int j = 0; j < 4; ++j) { const f32x4 a = *(const GAS f32x4*)(A.in[6] + j * 768 + cc0), bq = *(const GAS f32x4*)(A.in[6] + j * 768 + cc0 + 4);
                wt[j][0] = a.x; wt[j][1] = a.y; wt[j][2] = a.z; wt[j][3] = a.w; wt[j][4] = bq.x; wt[j][5] = bq.y; wt[j][6] = bq.z; wt[j][7] = bq.w; }
            { const f32x4 a = *(const GAS f32x4*)(A.in[7] + cc0), bq = *(const GAS f32x4*)(A.in[7] + cc0 + 4); cb[0] = a.x; cb[1] = a.y; cb[2] = a.z; cb[3] = a.w; cb[4] = bq.x; cb[5] = bq.y; cb[6] = bq.z; cb[7] = bq.w; }
            const GAS bf16* src = proj + (t0 + 16 * sg) * NINP + C_XBC + cc0;
            float x0[8], x1[8], x2[8];
            if (c > 0 || sg > 0) { unpack8f(*(const GAS v4u*)(src - 3 * NINP), x0); unpack8f(*(const GAS v4u*)(src - 2 * NINP), x1); unpack8f(*(const GAS v4u*)(src - 1 * NINP), x2); }
            else {
#pragma unroll
                for (int q = 0; q < 8; ++q) { x0[q] = 0.f; x1[q] = 0.f; x2[q] = 0.f; } }
            const int hl = o >> 3, p0 = (o & 7) * 8;
            float sc_end = 0.f; if (MODE == 0 && o < 32) sc_end = ACU[127 * 4 + hl];
#pragma unroll 1
            for (int hf = 0; hf < 2; ++hf) {
                v4u xin[8];
#pragma unroll
                for (int i = 0; i < 8; ++i) xin[i] = *(const GAS v4u*)(src + (size_t)(hf * 8 + i) * NINP);
                unsigned tp[8][4];
#pragma unroll
                for (int i = 0; i < 8; ++i) {
                    const int l = 16 * sg + hf * 8 + i;
                    float xc[8]; unpack8f(xin[i], xc);
                    float v[8];
#pragma unroll
                    for (int q = 0; q < 8; ++q) v[q] = silu_f(cb[q] + wt[0][q] * x0[q] + wt[1][q] * x1[q] + wt[2][q] * x2[q] + wt[3][q] * xc[q]);
#pragma unroll
                    for (int q = 0; q < 8; ++q) { x0[q] = x1[q]; x1[q] = x2[q]; x2[q] = xc[q]; }
                    if (o < 32 || (MODE == 0)) {
                        if (MODE == 0 && o < 32) { const float sc = DT[l * 4 + hl] * __expf(sc_end - ACU[l * 4 + hl]);
#pragma unroll
                            for (int q = 0; q < 8; ++q) v[q] *= sc; }
#pragma unroll
                        for (int q = 0; q < 8; ++q) { const unsigned bv = f2bf(v[q]); if (i & 1) tp[q][i >> 1] |= bv << 16; else tp[q][i >> 1] = bv; }
                    } else {
                        const v4u ov = (v4u){pk2(v[0], v[1]), pk2(v[2], v[3]), pk2(v[4], v[5]), pk2(v[6], v[7])};
                        *(LAS v4u*)((o < 40 ? BM : CM) + l * SA64 + (o & 7) * 16) = ov;
                    }
                }
                if (o < 32 || (MODE == 0)) {
                    LAS unsigned char* dst = (o < 32) ? XT + hl * 64 * SA128 + p0 * SA128 : CM + ((o & 7) * 8) * SA128;
#pragma unroll
                    for (int q = 0; q < 8; ++q) *(LAS v4u*)(dst + q * SA128 + (16 * sg + hf * 8) * 2) = (v4u){tp[q][0], tp[q][1], tp[q][2], tp[q][3]};
                }
            }
        }
    }
    __syncthreads();
    const int r = lane & 15, kg = lane >> 4;
    const f32x4 zero = (f32x4){0.f, 0.f, 0.f, 0.f};
    if (MODE == 0) {
        const int hl = w >> 1;
        GAS bf16* st = (GAS bf16*)(A.ws + WS_SST) + ((size_t)((b * 64 + c) * 8 + g * 4 + hl)) * 4096;
#pragma unroll
        for (int mt = 0; mt < 4; ++mt)
#pragma unroll
            for (int n = 0; n < 2; ++n) { const int nt = (w & 1) * 2 + n;
                const f32x4 acc = mma16(CM + mt * 16 * SA128, SA128, XT + hl * 64 * SA128 + nt * 16 * SA128, SA128, 128, zero, r, kg);
                const int p = nt * 16 + r, n0 = mt * 16 + kg * 4;
                *(GAS u32x2*)(st + p * 64 + n0) = (u32x2){pk2(acc[0], acc[1]), pk2(acc[2], acc[3])}; }
    } else {
        f32x4 sc[8];
#pragma unroll
        for (int nt = 0; nt < 8; ++nt) { sc[nt] = zero; if (nt <= w) sc[nt] = mma16(CM + w * 16 * SA64, SA64, BM + nt * 16 * SA64, SA64, 64, zero, r, kg); }
        __syncthreads();
        const GAS bf16* spg = (const GAS bf16*)(A.ws + WS_SST) + ((size_t)((b * 64 + c) * 8 + g * 4)) * 4096;
        for (int e = tid; e < 1024; e += 512) { const int row = e >> 3, ch = e & 7; *(LAS v4u*)(BM + row * SA64 + ch * 16) = *(const GAS v4u*)(spg + row * 64 + ch * 8); }
        __syncthreads();
        float rs[4] = {0.f, 0.f, 0.f, 0.f};
        LAS unsigned char* pw = PW + w * 16 * SA32;
        LAS unsigned char* zw = ZW + w * 16 * SA64;
        const int orow = lane >> 3, och = lane & 7;
        const GAS bf16* zsrc = proj + (t0 + w * 16 + orow) * NINP + C_Z + g * 256 + och * 8;
        v4u ysave[4][2];
#pragma unroll
        for (int hl = 0; hl < 4; ++hl) {
            if (hl == 2) {
                __syncthreads();
                for (int e = tid; e < 1024; e += 512) { const int row = e >> 3, ch = e & 7; *(LAS v4u*)(BM + row * SA64 + ch * 16) = *(const GAS v4u*)(spg + 2 * 4096 + row * 64 + ch * 8); }
                __syncthreads();
            }
            asm volatile("" ::: "memory");
            const v4u z0 = *(const GAS v4u*)(zsrc + hl * 64), z1 = *(const GAS v4u*)(zsrc + (size_t)8 * NINP + hl * 64);
            float acl[4];
#pragma unroll
            for (int ii = 0; ii < 4; ++ii) acl[ii] = ACU[(w * 16 + kg * 4 + ii) * 4 + hl];
            f32x4 yd[4] = {zero, zero, zero, zero};
            const LAS unsigned char* xth = XT + hl * 64 * SA128;
#pragma unroll
            for (int kc = 0; kc < 4; ++kc) {
                if (kc * 2 <= w) {
#pragma unroll
                    for (int half = 0; half < 2; ++half) { const int stl = 2 * kc + half; const int s = stl * 16 + r;
                        const float acs = ACU[s * 4 + hl], dts = DT[s * 4 + hl];
#pragma unroll
                        for (int ii = 0; ii < 4; ++ii) { const int l = w * 16 + kg * 4 + ii;
                            const float pv = (s <= l) ? sc[stl][ii] * __expf(acl[ii] - acs) * dts : 0.f;
                            *(LAS bf16*)(pw + (kg * 4 + ii) * SA32 + (half * 16 + r) * 2) = (bf16)f2bf(pv); } }
                    LDS_WAIT();
                    const bf16x8 a = *(const LAS bf16x8*)(pw + r * SA32 + kg * 16);
#pragma unroll
                    for (int nt = 0; nt < 4; ++nt) { const bf16x8 bb = *(const LAS bf16x8*)(xth + (nt * 16 + r) * SA128 + (kc * 32 + 8 * kg) * 2);
                        yd[nt] = __builtin_amdgcn_mfma_f32_16x16x32_bf16(a, bb, yd[nt], 0, 0, 0); }
                    LDS_WAIT();
                }
            }
            *(LAS v4u*)(zw + orow * SA64 + och * 16) = z0; *(LAS v4u*)(zw + (orow + 8) * SA64 + och * 16) = z1;
            LDS_WAIT();
            const float Dk = A.in[10][g * 4 + hl];
            float eal[4];
#pragma unroll
            for (int ii = 0; ii < 4; ++ii) eal[ii] = __expf(acl[ii]);
#pragma unroll
            for (int nt = 0; nt < 4; ++nt) {
                const f32x4 yo = mma16(CM + w * 16 * SA64, SA64, BM + (hl & 1) * 64 * SA64 + nt * 16 * SA64, SA64, 64, zero, r, kg);
                const int p = nt * 16 + r;
#pragma unroll
                for (int ii = 0; ii < 4; ++ii) { const int l = w * 16 + kg * 4 + ii;
                    const float xv = bf2f(*(const LAS bf16*)(xth + p * SA128 + l * 2));
                    LAS bf16* zp = (LAS bf16*)(zw + (kg * 4 + ii) * SA64 + p * 2);
                    const float y = (yd[nt][ii] + eal[ii] * yo[ii] + xv * Dk) * silu_f(bf2f(*zp));
                    const unsigned short yb = (unsigned short)f2bf(y); const float yq = bf2f(yb);
                    rs[ii] += yq * yq;
                    *zp = yb; }
            }
            LDS_WAIT();
            ysave[hl][0] = *(const LAS v4u*)(zw + orow * SA64 + och * 16); ysave[hl][1] = *(const LAS v4u*)(zw + (orow + 8) * SA64 + och * 16);
            LDS_WAIT();
        }
#pragma unroll
        for (int ii = 0; ii < 4; ++ii) { rs[ii] += __shfl_xor(rs[ii], 1); rs[ii] += __shfl_xor(rs[ii], 2); rs[ii] += __shfl_xor(rs[ii], 4); rs[ii] += __shfl_xor(rs[ii], 8);
            rs[ii] = rsqrtf(rs[ii] * (1.f / 256.f) + EPS); }
        if (r == 0) {
#pragma unroll
            for (int ii = 0; ii < 4; ++ii) RRW[w * 16 + kg * 4 + ii] = rs[ii]; }
        LDS_WAIT();
        const float rr0 = RRW[w * 16 + orow], rr1 = RRW[w * 16 + orow + 8];
        GAS bf16* mdst = (GAS bf16*)(A.ws + WS_XB) + (t0 + w * 16 + orow) * D + 512 + g * 256 + och * 8;
#pragma unroll
        for (int hl = 0; hl < 4; ++hl) {
            const f32x4 nwa = *(const GAS f32x4*)(A.in[11] + g * 256 + hl * 64 + och * 8), nwb = *(const GAS f32x4*)(A.in[11] + g * 256 + hl * 64 + och * 8 + 4);
            const float nw8[8] = {nwa.x, nwa.y, nwa.z, nwa.w, nwb.x, nwb.y, nwb.z, nwb.w};
#pragma unroll
            for (int hh = 0; hh < 2; ++hh) { float f[8]; unpack8f(ysave[hl][hh], f); const float rr_ = hh ? rr1 : rr0;
#pragma unroll
                for (int q = 0; q < 8; ++q) f[q] *= rr_ * nw8[q];
                *(GAS v4u*)(mdst + (size_t)(8 * hh) * D + hl * 64) = (v4u){pk2(f[0], f[1]), pk2(f[2], f[3]), pk2(f[4], f[5]), pk2(f[6], f[7])}; }
        }
    }
    __syncthreads();
}

template <bool DRY> __device__ __forceinline__ void scan_phase(const Frame& F, const Args& A) {
    if (F.tid < 128) {
        GAS unsigned* st = (GAS unsigned*)(A.ws + WS_GST); const GAS float* dec = (const GAS float*)(A.ws + WS_GDEC);
        for (int gi = blockIdx.x * 128 + F.tid; gi < 8 * 4096; gi += F.G * 128) {
            const int bh = gi >> 12, e = gi & 4095, b = bh >> 2, h = bh & 3, d = (e & 31) * 2;
            float S0 = 0.f, S1 = 0.f;
#pragma unroll 1
            for (int c = 0; c < 128; c += 16) {
                unsigned v[16]; float d0[16], d1[16];
#pragma unroll
                for (int u = 0; u < 16; ++u) { const size_t un = (size_t)((b * 128 + c + u) * 4 + h); v[u] = st[un * 4096 + e]; d0[u] = dec[un * 64 + d]; d1[u] = dec[un * 64 + d + 1]; }
#pragma unroll
                for (int u = 0; u < 16; ++u) { const size_t un = (size_t)((b * 128 + c + u) * 4 + h); (DRY ? (GAS unsigned*)(A.ws + 232 * MiB) : st)[un * 4096 + e] = pk2(S0, S1);
                    S0 = d0[u] * S0 + bf2f((unsigned short)(v[u] & 0xffffu)); S1 = d1[u] * S1 + bf2f((unsigned short)(v[u] >> 16)); }
            }
        }
    } else if (F.tid < 256) {
        GAS unsigned* st = (GAS unsigned*)(A.ws + WS_SST); const GAS float* dec = (const GAS float*)(A.ws + WS_SDEC);
        for (int gi = blockIdx.x * 128 + (F.tid - 128); gi < 16 * 2048; gi += F.G * 128) {
            const int bh = gi >> 11, e = gi & 2047, b = bh >> 3, hd = bh & 7;
            float S0 = 0.f, S1 = 0.f;
#pragma unroll 1
            for (int c = 0; c < 64; c += 16) {
                unsigned v[16]; float dd[16];
#pragma unroll
                for (int u = 0; u < 16; ++u) { const size_t un = (size_t)((b * 64 + c + u) * 8 + hd); v[u] = st[un * 2048 + e]; dd[u] = dec[un]; }
#pragma unroll
                for (int u = 0; u < 16; ++u) { const size_t un = (size_t)((b * 64 + c + u) * 8 + hd); (DRY ? (GAS unsigned*)(A.ws + 248 * MiB) : st)[un * 2048 + e] = pk2(S0, S1);
                    S0 = dd[u] * S0 + bf2f((unsigned short)(v[u] & 0xffffu)); S1 = dd[u] * S1 + bf2f((unsigned short)(v[u] >> 16)); }
            }
        }
    }
}
constexpr size_t WS_HB = WS_PROJ;
constexpr size_t WS_Q = 144 * MiB;
constexpr size_t WS_IDX = 232 * MiB;
constexpr size_t WS_GATE = 240 * MiB;
typedef float f32x16 __attribute__((ext_vector_type(16)));
__device__ __forceinline__ float as_f(unsigned u) { return __builtin_bit_cast(float, u); }
__device__ __forceinline__ unsigned as_u(float f) { return __builtin_bit_cast(unsigned, f); }
#define CE_DESC(a, b) do { const float hi_ = fmaxf((a), (b)), lo_ = fminf((a), (b)); (a) = hi_; (b) = lo_; } while (0)
template <int OFF, int N> __device__ __forceinline__ void sort16_desc(float (&v)[N]) {
#pragma unroll
    for (int k = 2; k <= 16; k <<= 1)
#pragma unroll
        for (int j = k >> 1; j > 0; j >>= 1)
#pragma unroll
            for (int i = 0; i < 16; ++i) { const int l = i ^ j; if (l > i) { if ((i & k) == 0) CE_DESC(v[OFF + i], v[OFF + l]); else CE_DESC(v[OFF + l], v[OFF + i]); } }
}
template <int OA, int OB, int NA, int NB> __device__ __forceinline__ void merge16_desc(float (&a)[NA], const float (&b)[NB]) {
#pragma unroll
    for (int i = 0; i < 16; ++i) a[OA + i] = fmaxf(a[OA + i], b[OB + 15 - i]);
#pragma unroll
    for (int j = 8; j > 0; j >>= 1)
#pragma unroll
        for (int i = 0; i < 16; ++i) { const int l = i ^ j; if (l > i) CE_DESC(a[OA + i], a[OA + l]); }
}
constexpr unsigned char CAND0[32] = {0, 2, 4, 6, 8, 10, 12, 14, 16, 18, 20, 22, 32, 34, 36, 49, 51, 65, 80, 96, 112, 128, 160, 192, 224, 255, 255, 255, 255, 255, 255, 255};
constexpr unsigned char CAND1[32] = {1, 3, 5, 7, 9, 11, 13, 15, 17, 19, 21, 23, 33, 35, 48, 50, 64, 66, 81, 97, 113, 144, 176, 208, 240, 255, 255, 255, 255, 255, 255, 255};

__device__ __forceinline__ void topk_wave_job(const Args& A, const LAS unsigned char* SK, LAS unsigned char* TAB, int tok0, int h, int lane) {
    const int r = lane & 31, hi = lane >> 5;
    const GAS bf16* qrow = (const GAS bf16*)(A.ws + WS_Q) + (size_t)(tok0 + r) * NQ + h * 256 + 8 * hi;
    float LST[2][16];
#pragma unroll
    for (int p = 0; p < 2; ++p) {
        __builtin_amdgcn_sched_barrier(0);
        bf16x8 bq[8];
#pragma unroll
        for (int s = 0; s < 8; ++s) bq[s] = *(const GAS bf16x8*)(qrow + p * 128 + 16 * s);
        float v[64];
#pragma unroll
        for (int kt = 0; kt < 4; ++kt) {
            f32x16 acc;
#pragma unroll
            for (int i = 0; i < 16; ++i) acc[i] = 0.f;
#pragma unroll
            for (int s = 0; s < 8; ++s) { const bf16x8 a = *(const LAS bf16x8*)(SK + (p * 128 + kt * 32 + r) * SA128 + (16 * s + 8 * hi) * 2);
                acc = __builtin_amdgcn_mfma_f32_32x32x16_bf16(a, bq[s], acc, 0, 0, 0); }
#pragma unroll
            for (int i = 0; i < 16; ++i) { const unsigned key = (unsigned)(kt * 32 + (i & 3) + 8 * (i >> 2)) | ((unsigned)hi << 2); v[kt * 16 + i] = as_f((as_u(acc[i]) & ~127u) | key); }
        }
        sort16_desc<0>(v); sort16_desc<16>(v); sort16_desc<32>(v); sort16_desc<48>(v);
        merge16_desc<0, 16>(v, v); merge16_desc<32, 48>(v, v); merge16_desc<0, 32>(v, v);
        float o[16];
#pragma unroll
        for (int i = 0; i < 16; ++i) o[i] = __shfl_xor(v[i], 32);
        merge16_desc<0, 0>(v, o);
#pragma unroll
        for (int i = 0; i < 16; ++i) LST[p][i] = v[i];
    }
    __builtin_amdgcn_sched_barrier(0);
    {   unsigned pk[4];
#pragma unroll
        for (int q4 = 0; q4 < 4; ++q4) { unsigned wv = 0;
#pragma unroll
            for (int b = 0; b < 4; ++b) { float l0 = LST[0][q4 * 4 + b], l1 = LST[1][q4 * 4 + b]; asm volatile("" : "+v"(l0), "+v"(l1));
                const unsigned x = as_u(hi ? l1 : l0) & 127u; wv |= x << (8 * b); }
            pk[q4] = wv; }
        *(LAS v4u*)(TAB + r * 32 + hi * 16) = (v4u){pk[0], pk[1], pk[2], pk[3]};
    }
    float c[32];
    float va[16], vb2[16];
#pragma unroll
    for (int i = 0; i < 16; ++i) { va[i] = as_f(as_u(LST[0][i]) & ~127u); vb2[i] = as_f(as_u(LST[1][i]) & ~127u); }
#define CANDV(i0, j0, k0, i1, j1, k1) as_f((as_u(hi ? (va[i1] + vb2[j1]) : (va[i0] + vb2[j0])) & ~255u) | (hi ? (k1) : (k0)))
    c[0] = CANDV(0, 0, 0u, 0, 1, 1u);
    c[1] = CANDV(0, 2, 2u, 0, 3, 3u);
    c[2] = CANDV(0, 4, 4u, 0, 5, 5u);
    c[3] = CANDV(0, 6, 6u, 0, 7, 7u);
    c[4] = CANDV(0, 8, 8u, 0, 9, 9u);
    c[5] = CANDV(0, 10, 10u, 0, 11, 11u);
    c[6] = CANDV(0, 12, 12u, 0, 13, 13u);
    c[7] = CANDV(0, 14, 14u, 0, 15, 15u);
    c[8] = CANDV(1, 0, 16u, 1, 1, 17u);
    c[9] = CANDV(1, 2, 18u, 1, 3, 19u);
    c[10] = CANDV(1, 4, 20u, 1, 5, 21u);
    c[11] = CANDV(1, 6, 22u, 1, 7, 23u);
    c[12] = CANDV(2, 0, 32u, 2, 1, 33u);
    c[13] = CANDV(2, 2, 34u, 2, 3, 35u);
    c[14] = CANDV(2, 4, 36u, 3, 0, 48u);
    c[15] = CANDV(3, 1, 49u, 3, 2, 50u);
    c[16] = CANDV(3, 3, 51u, 4, 0, 64u);
    c[17] = CANDV(4, 1, 65u, 4, 2, 66u);
    c[18] = CANDV(5, 0, 80u, 5, 1, 81u);
    c[19] = CANDV(6, 0, 96u, 6, 1, 97u);
    c[20] = CANDV(7, 0, 112u, 7, 1, 113u);
    c[21] = CANDV(8, 0, 128u, 9, 0, 144u);
    c[22] = CANDV(10, 0, 160u, 11, 0, 176u);
    c[23] = CANDV(12, 0, 192u, 13, 0, 208u);
    c[24] = CANDV(14, 0, 224u, 15, 0, 240u);
    c[25] = as_f(0xFF61B1E6u | 255u);
    c[26] = as_f(0xFF61B1E6u | 255u);
    c[27] = as_f(0xFF61B1E6u | 255u);
    c[28] = as_f(0xFF61B1E6u | 255u);
    c[29] = as_f(0xFF61B1E6u | 255u);
    c[30] = as_f(0xFF61B1E6u | 255u);
    c[31] = as_f(0xFF61B1E6u | 255u);
#undef CANDV
    sort16_desc<0>(c); sort16_desc<16>(c); merge16_desc<0, 16>(c, c);
    {   float o[16];
#pragma unroll
        for (int i = 0; i < 16; ++i) o[i] = __shfl_xor(c[i], 32);
        merge16_desc<0, 0>(c, o); }
    const float mx = as_f(as_u(c[0]) & ~255u);
    float ex[16], den = 0.f;
#pragma unroll
    for (int k = 0; k < 16; ++k) { ex[k] = __expf(as_f(as_u(c[k]) & ~255u) - mx); den += ex[k]; }
    const float inv = 1.f / den;
    LDS_WAIT();
    unsigned eid[8]; float gv[8];
#pragma unroll
    for (int k = 0; k < 8; ++k) { float ca = c[k], cb = c[k + 8], ea = ex[k], eb = ex[k + 8]; asm volatile("" : "+v"(ca), "+v"(cb), "+v"(ea), "+v"(eb));
        const unsigned code = as_u(hi ? cb : ca) & 255u; gv[k] = (hi ? eb : ea) * inv;
        const unsigned ia = *(const LAS unsigned char*)(TAB + r * 32 + (code >> 4)), ib = *(const LAS unsigned char*)(TAB + r * 32 + 16 + (code & 15));
        eid[k] = ia * 128u + ib; }
    GAS unsigned* ip = (GAS unsigned*)(A.ws + WS_IDX) + (size_t)(tok0 + r) * 128 + h * 16 + 8 * hi;
    GAS float* gp = (GAS float*)(A.ws + WS_GATE) + (size_t)(tok0 + r) * 128 + h * 16 + 8 * hi;
    *(GAS v4u*)ip = (v4u){eid[0], eid[1], eid[2], eid[3]}; *(GAS v4u*)(ip + 4) = (v4u){eid[4], eid[5], eid[6], eid[7]};
    *(GAS f32x4*)gp = (f32x4){gv[0], gv[1], gv[2], gv[3]}; *(GAS f32x4*)(gp + 4) = (f32x4){gv[4], gv[5], gv[6], gv[7]};
    LDS_WAIT();
}
__device__ __forceinline__ void topk_phase(const Frame& F, const Args& A) {
    LAS unsigned char* SK = F.lds;
    LAS unsigned char* TABS = F.lds + 256 * SA128;
    for (int unit = blockIdx.x; unit < 256; unit += F.G) {
        int tid = F.tid, w = F.wave;
        asm volatile("" : "+v"(tid)); asm volatile("" : "+s"(w));
        const int h = unit & 7, tb = (unit >> 3) * 512;
        const GAS bf16* sk = (const GAS bf16*)(A.ws + WS_SUBK) + (size_t)h * 2 * 128 * 128;
        for (int e = tid; e < 256 * 16; e += 512) { const int row = e >> 4, ch = e & 15; *(LAS v4u*)(SK + row * SA128 + ch * 16) = *(const GAS v4u*)(sk + row * 128 + ch * 8); }
        __syncthreads();
#pragma unroll 1
        for (int tt = 0; tt < 2; ++tt) topk_wave_job(A, SK, TABS + w * 1024, tb + (w * 2 + tt) * 32, h, tid & 63);
        __syncthreads();
    }
}

__device__ __forceinline__ float gelu_f(float v) {
    const float av = fabsf(v), t = __builtin_amdgcn_rcpf(av * 0.2316418882f + 1.0f);
    float q = t * 0.5307027145f + (-0.7265760135f); q = q * t + 0.7107068705f; q = q * t + (-0.142248368f); q = q * t + 0.127414796f; q = q * t;
    const float m = v * (q * __builtin_amdgcn_exp2f((v * v) * (-0.72134752044f)));
    return v < 0.f ? m : v - m;
}
__device__ __forceinline__ void unpack8(const v4u x, float (&f)[8]) {
    f[0] = as_f(x.x << 16); f[1] = as_f(x.x & 0xffff0000u); f[2] = as_f(x.y << 16); f[3] = as_f(x.y & 0xffff0000u);
    f[4] = as_f(x.z << 16); f[5] = as_f(x.z & 0xffff0000u); f[6] = as_f(x.w << 16); f[7] = as_f(x.w & 0xffff0000u);
}
typedef long lx2 __attribute__((ext_vector_type(2)));
typedef float f32x2 __attribute__((ext_vector_type(2)));
typedef int i32x8 __attribute__((ext_vector_type(8)));
typedef int i32x4 __attribute__((ext_vector_type(4)));
constexpr float U4_SCALE = 48.f, V4_SCALE = 4.25f;
constexpr int MX_ONE = 0x7F7F7F7F;
template <int BY> __device__ __forceinline__ f32x2 cvt_fp4x2(unsigned w) { return __builtin_amdgcn_cvt_scalef32_pk_f32_fp4(w, 1.0f, BY); }
template <int WS> __device__ __forceinline__ f32x2 cvt_fp8x2(int w) { return __builtin_amdgcn_cvt_pk_f32_fp8(w, WS != 0); }
__device__ __forceinline__ unsigned pk4_fp8(float a, float b, float c, float d) { int p = __builtin_amdgcn_cvt_pk_fp8_f32(a, b, 0, false); p = __builtin_amdgcn_cvt_pk_fp8_f32(c, d, p, true); return (unsigned)p; }
template <bool DRY> __device__ __forceinline__ void expert_phase(const Frame& F, const Args& A) {
    int tid = F.tid, w = F.wave;
    asm volatile("" : "+v"(tid)); asm volatile("" : "+s"(w));
    const int lane = tid & 63, r = lane & 15, kg = lane >> 4, half = lane >> 5, sub = lane & 31;
    const int dl = 32 * sub + 16 * half;
    LAS unsigned char* N2 = F.lds + w * 1024;
    const GAS unsigned char* u4 = (const GAS unsigned char*)(A.ws + WS_UB); const GAS unsigned char* v4 = (const GAS unsigned char*)(A.ws + WS_VB);
    const GAS unsigned* idx = (const GAS unsigned*)(A.ws + WS_IDX); const GAS float* gate = (const GAS float*)(A.ws + WS_GATE);
    const GAS float* rowsq = (const GAS float*)(A.ws + WS_ROWSQ2);
    f32x4 nl[4];
#pragma unroll
    for (int q = 0; q < 4; ++q) nl[q] = *(const GAS f32x4*)(A.in[18] + dl + 4 * q);
#pragma unroll 1
    for (int t = F.gw; t < T; t += F.NGW) {
        GAS float* hrow = (GAS float*)A.out + (size_t)t * D;
        f32x4 hv[4];
        {   const GAS bf16* hb = (const GAS bf16*)(A.ws + WS_HB) + (size_t)t * D + dl;
            float f0[8], f1[8]; unpack8f(*(const GAS v4u*)hb, f0); unpack8f(*(const GAS v4u*)(hb + 8), f1);
            hv[0] = (f32x4){f0[0], f0[1], f0[2], f0[3]}; hv[1] = (f32x4){f0[4], f0[5], f0[6], f0[7]}; hv[2] = (f32x4){f1[0], f1[1], f1[2], f1[3]}; hv[3] = (f32x4){f1[4], f1[5], f1[6], f1[7]}; }
        const float rr = rsqrtf(rowsq[t] * (1.f / 1024.f) + EPS);
        {   v4u pk;
            pk.x = pk4_fp8(hv[0].x * rr, hv[0].y * rr, hv[0].z * rr, hv[0].w * rr); pk.y = pk4_fp8(hv[1].x * rr, hv[1].y * rr, hv[1].z * rr, hv[1].w * rr);
            pk.z = pk4_fp8(hv[2].x * rr, hv[2].y * rr, hv[2].z * rr, hv[2].w * rr); pk.w = pk4_fp8(hv[3].x * rr, hv[3].y * rr, hv[3].z * rr, hv[3].w * rr);
            *(LAS v4u*)(N2 + dl) = pk; }
        unsigned eidx[8]; float gt[8];
#pragma unroll
        for (int eg = 0; eg < 8; ++eg) { eidx[eg] = idx[(size_t)t * 128 + eg * 16 + r]; gt[eg] = gate[(size_t)t * 128 + eg * 16 + r]; }
        LDS_WAIT();
        f32x4 acc[8];
#pragma unroll
        for (int eg = 0; eg < 8; ++eg) acc[eg] = (f32x4){0.f, 0.f, 0.f, 0.f};
#pragma unroll 1
        for (int sp = 0; sp < 4; ++sp) {
            i32x4 bq[2][8];
#pragma unroll
            for (int h2 = 0; h2 < 2; ++h2)
#pragma unroll
                for (int eg = 0; eg < 8; ++eg) bq[h2][eg] = *(const GAS i32x4*)(u4 + (size_t)eidx[eg] * 512 + 64 * (2 * sp + h2) + 16 * kg);
            __builtin_amdgcn_sched_barrier(0);
#pragma unroll
            for (int h2 = 0; h2 < 2; ++h2) {
                const int s = 2 * sp + h2;
                const i32x4 a0 = *(const LAS i32x4*)(N2 + 128 * s + 16 * kg), a1 = *(const LAS i32x4*)(N2 + 128 * s + 64 + 16 * kg);
                const i32x8 a = (i32x8){a0.x, a0.y, a0.z, a0.w, a1.x, a1.y, a1.z, a1.w};
#pragma unroll
                for (int eg = 0; eg < 8; ++eg) { const i32x4 b4 = bq[h2][eg];
                    const i32x8 b = (i32x8){b4.x, b4.y, b4.z, b4.w, 0, 0, 0, 0};
                    acc[eg] = __builtin_amdgcn_mfma_scale_f32_16x16x128_f8f6f4(a, b, acc[eg], 0, 4, 0, MX_ONE, 0, MX_ONE); }
            }
        }
        bool bad = false;
        if (t == F.gw) {
            float ref = 0.f;
            for (int s = 0; s < 8; ++s) {
                const i32x4 b4 = *(const GAS i32x4*)(u4 + (size_t)eidx[0] * 512 + 64 * s + 16 * kg);
                const int bw[4] = {b4.x, b4.y, b4.z, b4.w};
#pragma unroll
                for (int k = 0; k < 4; ++k) {
                    const lx2 a8 = *(const LAS lx2*)(N2 + 128 * s + 32 * kg + 16 * (k >> 1));
                    const long aw = (k & 1) ? a8.y : a8.x;
                    const int alo = (int)aw, ahi = (int)(aw >> 32);
                    { const f32x2 bf = cvt_fp4x2<0>((unsigned)bw[k]), af = cvt_fp8x2<0>(alo); ref += af.x * bf.x + af.y * bf.y; }
                    { const f32x2 bf = cvt_fp4x2<1>((unsigned)bw[k]), af = cvt_fp8x2<1>(alo); ref += af.x * bf.x + af.y * bf.y; }
                    { const f32x2 bf = cvt_fp4x2<2>((unsigned)bw[k]), af = cvt_fp8x2<0>(ahi); ref += af.x * bf.x + af.y * bf.y; }
                    { const f32x2 bf = cvt_fp4x2<3>((unsigned)bw[k]), af = cvt_fp8x2<1>(ahi); ref += af.x * bf.x + af.y * bf.y; }
                }
            }
            ref += __shfl_xor(ref, 16); ref += __shfl_xor(ref, 32);
            bad = __any(fabsf(ref - acc[0][0]) > 0.02f * fabsf(ref) + 0.5f);
        }
        float hid[8];
#pragma unroll
        for (int eg = 0; eg < 8; ++eg) hid[eg] = gelu_f(acc[eg][0] * (1.f / U4_SCALE)) * gt[eg] * (1.f / V4_SCALE);
        f32x2 o2[16];
#pragma unroll
        for (int i = 0; i < 16; ++i) o2[i] = (f32x2){0.f, 0.f};
        v4u xr[2][8]; float shs[2][8];
#define PV_LOAD(EG, BUF) { _Pragma("unroll") for (int pr = 0; pr < 8; ++pr) { \
                const float sha = as_f(__builtin_amdgcn_readlane((int)as_u(hid[EG]), 2 * pr)), shb = as_f(__builtin_amdgcn_readlane((int)as_u(hid[EG]), 2 * pr + 1)); \
                const unsigned sia = (unsigned)__builtin_amdgcn_readlane((int)eidx[EG], 2 * pr), sib = (unsigned)__builtin_amdgcn_readlane((int)eidx[EG], 2 * pr + 1); \
                shs[BUF][pr] = half ? shb : sha; \
                xr[BUF][pr] = *(const GAS v4u*)(v4 + (size_t)(half ? sib : sia) * 512 + 16 * sub); } }
        PV_LOAD(0, 0)
#pragma unroll
        for (int eg = 0; eg < 8; ++eg) {
            if (eg < 7) PV_LOAD(eg + 1, (eg + 1) & 1)
            __builtin_amdgcn_sched_barrier(0);
#pragma unroll
            for (int pr = 0; pr < 8; ++pr) {
                const f32x2 sh2 = (f32x2){shs[eg & 1][pr], shs[eg & 1][pr]};
                const unsigned xw[4] = {xr[eg & 1][pr].x, xr[eg & 1][pr].y, xr[eg & 1][pr].z, xr[eg & 1][pr].w};
#pragma unroll
                for (int k = 0; k < 4; ++k) { o2[4 * k] += sh2 * cvt_fp4x2<0>(xw[k]); o2[4 * k + 1] += sh2 * cvt_fp4x2<1>(xw[k]); o2[4 * k + 2] += sh2 * cvt_fp4x2<2>(xw[k]); o2[4 * k + 3] += sh2 * cvt_fp4x2<3>(xw[k]); }
            }
            __builtin_amdgcn_sched_barrier(0);
        }
#undef PV_LOAD
        float o[16];
#pragma unroll
        for (int i = 0; i < 16; ++i) { o2[i].x += __shfl_xor(o2[i].x, 32); o2[i].y += __shfl_xor(o2[i].y, 32); }
#pragma unroll
        for (int i = 0; i < 8; ++i) { float a0 = o2[i].x, a1 = o2[i].y, b0 = o2[8 + i].x, b1 = o2[8 + i].y; asm volatile("" : "+v"(a0), "+v"(a1), "+v"(b0), "+v"(b1));
            o[2 * i] = half ? b0 : a0; o[2 * i + 1] = half ? b1 : a1; }
        float ss = 0.f; f32x4 h2[4];
#pragma unroll
        for (int q = 0; q < 4; ++q) { h2[q] = hv[q] + (f32x4){o[4 * q], o[4 * q + 1], o[4 * q + 2], o[4 * q + 3]};
            const f32x4 x = h2[q]; ss += (x.x * x.x + x.y * x.y) + (x.z * x.z + x.w * x.w); }
        ss = wave_sum(ss);
        float r3 = rsqrtf(ss * (1.f / D) + EPS);
#pragma unroll
        for (int q = 0; q < 4; ++q) *(GAS f32x4*)((DRY ? (GAS float*)(A.ws + WS_Q) + (size_t)t * D : hrow) + dl + 4 * q) = h2[q] * r3 * nl[q];
    }
}
__device__ __forceinline__ void p0_transpose_item(const float* W, const float* kscale, int K, int N, bf16* WT, LAS float* scr, int item, int lane) {
    const int nblk = (N + 31) / 32, kb = item / nblk, nb = item % nblk, k0 = 64 * kb, n0 = 32 * nb;
    const int nn = n0 + (lane & 31); const bool ok = nn < N;
    (void)nn; (void)ok;
    {   const int c4 = lane & 7, kr = lane >> 3; const bool okc = n0 + 4 * c4 < N;
        f32x4 v[8];
#pragma unroll
        for (int i = 0; i < 8; ++i) v[i] = okc ? *(const GAS f32x4*)(W + (size_t)(k0 + 8 * i + kr) * N + n0 + 4 * c4) : (f32x4){0.f, 0.f, 0.f, 0.f};
#pragma unroll
        for (int i = 0; i < 8; ++i) { const int kk = 8 * i + kr; const float sc = kscale ? kscale[k0 + kk] : 1.f; LAS float* d = scr + kk * 33 + 4 * c4;
            d[0] = v[i].x * sc; d[1] = v[i].y * sc; d[2] = v[i].z * sc; d[3] = v[i].w * sc; } }
    LDS_WAIT(); asm volatile("" ::: "memory");
    const int c = lane & 7;
#pragma unroll
    for (int j = 0; j < 4; ++j) { const int n = (lane >> 3) + 8 * j; const LAS float* s = scr + (8 * c) * 33 + n;
        v4u o; o.x = pk2(s[0 * 33], s[1 * 33]); o.y = pk2(s[2 * 33], s[3 * 33]); o.z = pk2(s[4 * 33], s[5 * 33]); o.w = pk2(s[6 * 33], s[7 * 33]);
        *(GAS v4u*)(WT + (size_t)(n0 + n) * K + k0 + 8 * c) = o; }
    LDS_WAIT(); asm volatile("" ::: "memory");
}
__device__ __forceinline__ void p0_convert(const Frame& F, const float* src, bf16* dst, size_t n) {
    for (size_t i = ((size_t)F.gw * 64 + F.lane) * 8; i < n; i += (size_t)F.NGW * 512) {
        const f32x4 a = *(const GAS f32x4*)(src + i), b = *(const GAS f32x4*)(src + i + 4);
        v4u o; o.x = pk2(a.x, a.y); o.y = pk2(a.z, a.w); o.z = pk2(b.x, b.y); o.w = pk2(b.z, b.w);
        *(GAS v4u*)(dst + i) = o;
    }
}
__device__ __forceinline__ void p0_convert_fp4(const Frame& F, int wk, int nwk, const float* src, unsigned char* dst, size_t n, float scale, const float* colscale) {
#pragma unroll 4
    for (size_t i = ((size_t)wk * 64 + F.lane) * 32; i < n; i += (size_t)nwk * 2048) {
        unsigned ow[4];
#pragma unroll
        for (int q = 0; q < 4; ++q) {
            f32x4 a = *(const GAS f32x4*)(src + i + 8 * q) * scale, b = *(const GAS f32x4*)(src + i + 8 * q + 4) * scale;
            if (colscale) { a = a * *(const GAS f32x4*)(colscale + ((i + 8 * q) & 1023)); b = b * *(const GAS f32x4*)(colscale + ((i + 8 * q + 4) & 1023)); }
            unsigned pk = 0;
            pk = __builtin_amdgcn_cvt_scalef32_pk_fp4_f32(pk, a.x, a.y, 1.0f, 0); pk = __builtin_amdgcn_cvt_scalef32_pk_fp4_f32(pk, a.z, a.w, 1.0f, 1);
            pk = __builtin_amdgcn_cvt_scalef32_pk_fp4_f32(pk, b.x, b.y, 1.0f, 2); pk = __builtin_amdgcn_cvt_scalef32_pk_fp4_f32(pk, b.z, b.w, 1.0f, 3);
            ow[q] = pk; }
        *(GAS v4u*)(dst + (i >> 1)) = (v4u){ow[0], ow[1], ow[2], ow[3]};
    }
}
__device__ __forceinline__ void p0_prologue(const Frame& F, const Args& A) {
    unsigned char* ws = A.ws;
    LAS float* scr = (LAS float*)(F.lds + RING_OFF + F.wave * 16384);
    constexpr int I_IN = (D / 64) * ((NIN + 31) / 32), I_O = (D / 64) * (D / 32), I_Q = (D / 64) * (NQ / 32);
    for (int it = F.gw; it < I_IN + I_O + I_Q; it += F.NGW) {
        int r = it;
        if (r < I_IN) { p0_transpose_item(A.in[2], A.in[1], D, NIN, (bf16*)(ws + WS_WIN), scr, r, F.lane); continue; } r -= I_IN;
        if (r < I_O) { p0_transpose_item(A.in[12], nullptr, D, D, (bf16*)(ws + WS_WO), scr, r, F.lane); continue; } r -= I_O;
        p0_transpose_item(A.in[14], A.in[13], D, NQ, (bf16*)(ws + WS_WQ), scr, r, F.lane);
    }
    for (int m0 = F.gw * 4; m0 < T; m0 += F.NGW * 4) {
        f32x4 v[4][4]; float s[4] = {0.f, 0.f, 0.f, 0.f};
#pragma unroll
        for (int u = 0; u < 4; ++u) { const GAS f32x4* xr = (const GAS f32x4*)(A.in[0] + (size_t)(m0 + u) * D) + F.lane;
#pragma unroll
            for (int j = 0; j < 4; ++j) v[u][j] = xr[64 * j]; }
#pragma unroll
        for (int u = 0; u < 4; ++u) {
#pragma unroll
            for (int j = 0; j < 4; ++j) s[u] += (v[u][j].x * v[u][j].x + v[u][j].y * v[u][j].y) + (v[u][j].z * v[u][j].z + v[u][j].w * v[u][j].w);
            GAS unsigned long long* o8 = (GAS unsigned long long*)((bf16*)(ws + WS_XB) + (size_t)(m0 + u) * D) + F.lane;
#pragma unroll
            for (int j = 0; j < 4; ++j) o8[64 * j] = (unsigned long long)pk2(v[u][j].x, v[u][j].y) | ((unsigned long long)pk2(v[u][j].z, v[u][j].w) << 32); }
#pragma unroll
        for (int u = 0; u < 4; ++u) s[u] = wave_sum(s[u]);
        if (F.lane < 4) { const float sv = F.lane == 0 ? s[0] : (F.lane == 1 ? s[1] : (F.lane == 2 ? s[2] : s[3])); ((float*)(ws + WS_RRMS1))[m0 + F.lane] = rsqrtf(sv * (1.f / D) + EPS); ((float*)(ws + WS_ROWSQ2))[m0 + F.lane] = 0.f; }
    }
    p0_convert(F, A.in[15], (bf16*)(ws + WS_SUBK), (size_t)8 * 2 * 128 * 128);
    p0_convert_fp4(F, F.gw, F.NGW, A.in[16], ws + WS_UB, (size_t)16384 * 1024, 48.f, A.in[13]);
    p0_convert_fp4(F, F.gw, F.NGW, A.in[17], ws + WS_VB, (size_t)16384 * 1024, 4.25f, nullptr);
}

#ifndef PROBE_MASK
#define PROBE_MASK 0
#endif
__device__ __forceinline__ int probe_reps(int k) { int n = ((PROBE_MASK >> k) & 1) + 1; return n; }
__global__ void __launch_bounds__(NWAVES * 64, 2) fwd(Args args) {
    extern __shared__ __attribute__((aligned(16))) unsigned char lds[];
    Frame F;
    F.lds = (LAS unsigned char*)lds;
    F.MISC = (volatile LAS unsigned*)(F.lds + MISC_OFF);
    F.tid = threadIdx.x; F.lane = F.tid & 63; F.wave = __builtin_amdgcn_readfirstlane(F.tid >> 6);
    F.G = gridDim.x; F.gw = blockIdx.x * NWAVES + F.wave; F.NGW = F.G * NWAVES;
    unsigned char* ws = args.ws;
    F.ctl = (gu32*)(ws + WS_CTL);
    for (int u = F.tid; u < (LDS_BYTES - LDSCTL_OFF) / 4; u += NWAVES * 64) ((LAS unsigned*)(F.lds + LDSCTL_OFF))[u] = 0u;
    __syncthreads();
    XcdBarrier bar = xcd_barrier_post((unsigned*)(F.ctl + CW_BAR), F.MISC + 8);
    const int lo = args.ph_lo, hi = args.ph_hi;
#define IN(k) (lo <= (k) && (k) < hi)
#define BOTH(k) (IN(k) && IN((k) + 1))
#define GRID_BAR() xcd_barrier(bar)
#define REP(k) for (int rep_ = 0, nrep_ = probe_reps(k); rep_ < nrep_; ++rep_)

    if (IN(0)) REP(0) { p0_prologue(F, args); if (BOTH(0)) GRID_BAR(); }
    if (IN(1)) REP(1) {
        pg8::Gemm g{(const bf16*)(ws + WS_XB), (const bf16*)(ws + WS_WIN), T, NINP, D}; pg8::StaticOrder S; S.init(T, NINP, F.G, (int)blockIdx.x);
        pg8::EpiRowScaleBf16 E{(bf16*)(ws + WS_PROJ), NINP, (const float*)(ws + WS_RRMS1)};
        pg8::gemm_phase<pg8::EpiRowScaleBf16, pg8::StaticOrder, true, true>(F.lds + RING_OFF, g, S, E);
        if (BOTH(1)) GRID_BAR();
    }
    if (IN(2)) {
        REP(2) { for (int u = blockIdx.x; u < 256; u += F.G) ssd_unit<0>(F, args, u); }
        REP(13) { for (int u = blockIdx.x; u < 1024; u += F.G) gla_unit<0>(F, args, u); }
        if (BOTH(2)) GRID_BAR();
    }
    if (IN(3)) { if ((PROBE_MASK >> 3) & 1) { scan_phase<true>(F, args); GRID_BAR(); } scan_phase<false>(F, args); if (BOTH(3)) GRID_BAR(); }
    if (IN(4)) {
        REP(4) { for (int u = blockIdx.x; u < 256; u += F.G) ssd_unit<1>(F, args, u); }
        REP(12) { for (int u = blockIdx.x; u < 1024; u += F.G) gla_unit<1>(F, args, u); }
        if (BOTH(4)) GRID_BAR();
    }
    if (IN(5)) {
        pg8::Gemm g{(const bf16*)(ws + WS_XB), (const bf16*)(ws + WS_WO), T, D, D}; pg8::StaticOrder S; S.init(T, D, F.G, (int)blockIdx.x);
        if ((PROBE_MASK >> 5) & 1) { pg8::EpiResidual Ed{args.in[0], nullptr, (bf16*)(ws + 208 * MiB), (float*)(ws + 240 * MiB), D};
            pg8::gemm_phase<pg8::EpiResidual, pg8::StaticOrder, true, true>(F.lds + RING_OFF, g, S, Ed); GRID_BAR(); }
        pg8::EpiResidual E{args.in[0], nullptr, (bf16*)(ws + WS_HB), (float*)(ws + WS_ROWSQ2), D};
        pg8::gemm_phase<pg8::EpiResidual, pg8::StaticOrder, true, true>(F.lds + RING_OFF, g, S, E);
        if (BOTH(5)) GRID_BAR();
    }
    if (IN(6)) REP(6) {
        pg8::Gemm g{(const bf16*)(ws + WS_HB), (const bf16*)(ws + WS_WQ), T, NQ, D}; pg8::StaticOrder S; S.init(T, NQ, F.G, (int)blockIdx.x);
        pg8::EpiRsqScaleBf16 E{(bf16*)(ws + WS_Q), NQ, (const float*)(ws + WS_ROWSQ2)};
        pg8::gemm_phase<pg8::EpiRsqScaleBf16, pg8::StaticOrder, true, true>(F.lds + RING_OFF, g, S, E);
        if (BOTH(6)) GRID_BAR();
    }
    if (IN(7)) REP(7) { topk_phase(F, args); if (BOTH(7)) GRID_BAR(); }
    if (IN(8)) { if ((PROBE_MASK >> 8) & 1) { expert_phase<true>(F, args); GRID_BAR(); } expert_phase<false>(F, args); }
#undef IN
#undef BOTH
}
namespace nv {
struct ProjF32 { const float* p; __device__ __forceinline__ float operator()(size_t row, int c) const { return p[row * NIN + c]; } };
struct ProjBf { const unsigned short* p; __device__ __forceinline__ float operator()(size_t row, int c) const { return bf2f(p[row * NINP + c]); } };
__device__ __forceinline__ float silu_f(float x) { return x / (1.f + expf(-x)); }
__device__ __forceinline__ float softplus_f(float x) { return fmaxf(x, 0.f) + log1pf(expf(-fabsf(x))); }
__device__ __forceinline__ float logsigmoid_f(float x) { return fminf(x, 0.f) - log1pf(expf(-fabsf(x))); }
__device__ __forceinline__ float gelu_f(float x) { return 0.5f * x * (1.f + erff(x * 0.70710678118654752f)); }

__global__ void __launch_bounds__(256) k_rmsnorm(const float* __restrict__ x, const float* __restrict__ w, float* __restrict__ out) {
    const int row = blockIdx.x * 4 + (threadIdx.x >> 6), lane = threadIdx.x & 63;
    const float4* xr = (const float4*)(x + (size_t)row * D);
    float4 v[4]; float s = 0.f;
#pragma unroll
    for (int j = 0; j < 4; ++j) { v[j] = xr[lane + 64 * j]; s += v[j].x * v[j].x + v[j].y * v[j].y + v[j].z * v[j].z + v[j].w * v[j].w; }
    s = wave_sum(s);
    const float r = rsqrtf(s * (1.f / D) + EPS);
    float4* o = (float4*)(out + (size_t)row * D);
#pragma unroll
    for (int j = 0; j < 4; ++j) { const float4 ww = ((const float4*)w)[lane + 64 * j]; float4 y; y.x = v[j].x * r * ww.x; y.y = v[j].y * r * ww.y; y.z = v[j].z * r * ww.z; y.w = v[j].w * r * ww.w; o[lane + 64 * j] = y; }
}

template <bool ADD>
__global__ void __launch_bounds__(256) k_gemm(const float* __restrict__ A, const float* __restrict__ B, const float* __restrict__ R, float* __restrict__ C, int M, int N, int K, int ldb) {
    __shared__ float As[16][68];
    __shared__ float Bs[16][68];
    const int tid = threadIdx.x, tx = tid & 15, ty = tid >> 4;
    const int row0 = blockIdx.y * 64, col0 = blockIdx.x * 64;
    float acc[4][4];
#pragma unroll
    for (int i = 0; i < 4; ++i)
#pragma unroll
        for (int j = 0; j < 4; ++j) acc[i][j] = 0.f;
    const int ar = tid >> 2, akq = tid & 3;
    const int bk = tid >> 4, bn = (tid & 15) * 4;
    for (int k0 = 0; k0 < K; k0 += 16) {
        const float4 av = *(const float4*)(A + (size_t)(row0 + ar) * K + k0 + akq * 4);
        float4 bv = make_float4(0.f, 0.f, 0.f, 0.f);
        if (col0 + bn < N) bv = *(const float4*)(B + (size_t)(k0 + bk) * ldb + col0 + bn);
        __syncthreads();
        As[akq * 4 + 0][ar] = av.x; As[akq * 4 + 1][ar] = av.y; As[akq * 4 + 2][ar] = av.z; As[akq * 4 + 3][ar] = av.w;
        *(float4*)&Bs[bk][bn] = bv;
        __syncthreads();
#pragma unroll
        for (int kk = 0; kk < 16; ++kk) {
            const float4 a = *(const float4*)&As[kk][ty * 4];
            const float4 b = *(const float4*)&Bs[kk][tx * 4];
            const float aa[4] = {a.x, a.y, a.z, a.w}, bb[4] = {b.x, b.y, b.z, b.w};
#pragma unroll
            for (int i = 0; i < 4; ++i)
#pragma unroll
                for (int j = 0; j < 4; ++j) acc[i][j] += aa[i] * bb[j];
        }
    }
    if (col0 + tx * 4 < N) {
#pragma unroll
        for (int i = 0; i < 4; ++i) {
            const size_t off = (size_t)(row0 + ty * 4 + i) * N + col0 + tx * 4;
            float4 o = make_float4(acc[i][0], acc[i][1], acc[i][2], acc[i][3]);
            if (ADD) { const float4 r = *(const float4*)(R + off); o.x += r.x; o.y += r.y; o.z += r.z; o.w += r.w; }
            *(float4*)(C + off) = o;
        }
    }
}

template <class P> __global__ void __launch_bounds__(256) k_gla_gate(const P proj, const float* __restrict__ w2, const float* __restrict__ bg, float* __restrict__ alpha) {
    const int t = blockIdx.x, c = threadIdx.x;
    float acc = bg[c];
#pragma unroll
    for (int r = 0; r < 16; ++r) acc += proj((size_t)t, C_GLR + r) * w2[r * 256 + c];
    alpha[(size_t)t * 256 + c] = expf(logsigmoid_f(acc) * (1.f / 16.f));
}

template <class P> __global__ void __launch_bounds__(128) k_gla_rec(const P proj, const float* __restrict__ alpha, float* __restrict__ mixed) {
    const int b = blockIdx.x >> 2, h = blockIdx.x & 3, dv = threadIdx.x;
    float S[64];
#pragma unroll
    for (int d = 0; d < 64; ++d) S[d] = 0.f;
    for (int t = 0; t < SEQ; ++t) {
        const size_t row = (size_t)b * SEQ + t;
        const float* al = alpha + row * 256 + h * 64;
        const float v = proj(row, C_V + h * 128 + dv);
        float o = 0.f;
#pragma unroll
        for (int d = 0; d < 64; ++d) {
            S[d] = al[d] * S[d] + proj(row, C_K + h * 64 + d) * v;
            o += proj(row, C_Q + h * 64 + d) * S[d];
        }
        mixed[row * D + h * 128 + dv] = o * 0.125f;
    }
}

template <class P> __global__ void __launch_bounds__(256) k_gla_finish(const P proj, const float* __restrict__ nw, float* __restrict__ mixed) {
    const int t = blockIdx.x, h = threadIdx.x >> 6, lane = threadIdx.x & 63;
    float* m = mixed + (size_t)t * D + h * 128;
    const float a = m[lane], b = m[lane + 64];
    const float s = wave_sum(a * a + b * b);
    const float r = rsqrtf(s * (1.f / 128.f) + EPS);
    m[lane] = a * r * nw[lane] * silu_f(proj((size_t)t, C_GOUT + h * 128 + lane));
    m[lane + 64] = b * r * nw[lane + 64] * silu_f(proj((size_t)t, C_GOUT + h * 128 + lane + 64));
}

template <class P> __global__ void __launch_bounds__(256) k_ssd_conv(const P proj, const float* __restrict__ cw, const float* __restrict__ cb, const float* __restrict__ dtb,
                                                  float* __restrict__ xc, float* __restrict__ dt) {
    const int t = blockIdx.x, l = t & (SEQ - 1);
    for (int c = threadIdx.x; c < 768; c += 256) {
        float acc = cb[c];
#pragma unroll
        for (int j = 0; j < 4; ++j) { const int ll = l - 3 + j; if (ll >= 0) acc += cw[j * 768 + c] * proj((size_t)(t - 3 + j), C_XBC + c); }
        xc[(size_t)t * 768 + c] = silu_f(acc);
    }
    if (threadIdx.x < 8) dt[(size_t)t * 8 + threadIdx.x] = softplus_f(proj((size_t)t, C_DT + threadIdx.x) + dtb[threadIdx.x]);
}

__global__ void __launch_bounds__(64) k_ssd_rec(const float* __restrict__ xc, const float* __restrict__ dt, const float* __restrict__ a_log, const float* __restrict__ dsk, float* __restrict__ mixed) {
    const int b = blockIdx.x >> 3, hd = blockIdx.x & 7, g = hd >> 2, p = threadIdx.x;
    const float A = -expf(a_log[hd]), Dk = dsk[hd];
    float hs[64];
#pragma unroll
    for (int n = 0; n < 64; ++n) hs[n] = 0.f;
    for (int t = 0; t < SEQ; ++t) {
        const size_t row = (size_t)b * SEQ + t;
        const float dtv = dt[row * 8 + hd];
        const float dA = expf(dtv * A);
        const float* xr = xc + row * 768;
        const float x = xr[hd * 64 + p], xdt = x * dtv;
        float y = 0.f;
#pragma unroll
        for (int n = 0; n < 64; ++n) {
            hs[n] = dA * hs[n] + xr[512 + g * 64 + n] * xdt;
            y += xr[640 + g * 64 + n] * hs[n];
        }
        mixed[row * D + 512 + hd * 64 + p] = y + x * Dk;
    }
}

template <class P> __global__ void __launch_bounds__(128) k_ssd_finish(const P proj, const float* __restrict__ nw, float* __restrict__ mixed) {
    const int t = blockIdx.x, g = threadIdx.x >> 6, lane = threadIdx.x & 63;
    float* m = mixed + (size_t)t * D + 512 + g * 256;
    float y[4]; float s = 0.f;
#pragma unroll
    for (int j = 0; j < 4; ++j) { y[j] = m[lane + 64 * j] * silu_f(proj((size_t)t, C_Z + g * 256 + lane + 64 * j)); s += y[j] * y[j]; }
    s = wave_sum(s);
    const float r = rsqrtf(s * (1.f / 256.f) + EPS);
#pragma unroll
    for (int j = 0; j < 4; ++j) m[lane + 64 * j] = y[j] * r * nw[g * 256 + lane + 64 * j];
}

__global__ void __launch_bounds__(256) k_topk(const float* __restrict__ q_lo, const float* __restrict__ q_hi, const float* __restrict__ subk, int* __restrict__ idx, float* __restrict__ gate) {
    __shared__ float s[256];
    __shared__ float ts[2][16];
    __shared__ int ti[2][16];
    __shared__ float cs[256];
    __shared__ float bs[16];
    __shared__ int be[16];
    const int t = blockIdx.x >> 3, h = blockIdx.x & 7, tid = threadIdx.x, p = tid >> 7, k = tid & 127;
    const float4* qv = (const float4*)((h < 4 ? q_lo : q_hi) + (size_t)t * 1024 + (h & 3) * 256 + p * 128);
    const float4* kr = (const float4*)(subk + (((size_t)h * 2 + p) * 128 + k) * 128);
    float acc = 0.f;
#pragma unroll 8
    for (int d = 0; d < 32; ++d) { const float4 a = qv[d], b = kr[d]; acc += a.x * b.x + a.y * b.y + a.z * b.z + a.w * b.w; }
    s[tid] = acc;
    __syncthreads();
    int r = 0;
    for (int j = 0; j < 128; ++j) { const float o = s[p * 128 + j]; r += (o > acc || (o == acc && j < k)) ? 1 : 0; }
    if (r < 16) { ts[p][r] = acc; ti[p][r] = k; }
    __syncthreads();
    const int i = tid >> 4, j2 = tid & 15;
    const float c = ts[0][i] + ts[1][j2];
    cs[tid] = c;
    __syncthreads();
    r = 0;
    for (int m = 0; m < 256; ++m) { const float o = cs[m]; r += (o > c || (o == c && m < tid)) ? 1 : 0; }
    if (r < 16) { bs[r] = c; be[r] = ti[0][i] * 128 + ti[1][j2]; }
    __syncthreads();
    if (tid < 16) {
        const float mx = bs[0];
        float den = 0.f;
#pragma unroll
        for (int m = 0; m < 16; ++m) den += expf(bs[m] - mx);
        gate[(size_t)t * 128 + h * 16 + tid] = expf(bs[tid] - mx) / den;
        idx[(size_t)t * 128 + h * 16 + tid] = be[tid];
    }
}

__global__ void __launch_bounds__(256) k_expert(const float* __restrict__ hres, const float* __restrict__ u, const float* __restrict__ v, const int* __restrict__ idx, const float* __restrict__ gate,
                                                const float* __restrict__ nfw, float* out) {
    __shared__ float hid[128];
    __shared__ int eid[128];
    __shared__ float red[4];
    const int t = blockIdx.x, tid = threadIdx.x, w = tid >> 6, lane = tid & 63;
    if (tid < 128) eid[tid] = idx[(size_t)t * 128 + tid];
    float4 xv[4];
#pragma unroll
    for (int j = 0; j < 4; ++j) xv[j] = ((const float4*)(out + (size_t)t * D))[lane + 64 * j];
    __syncthreads();
    for (int e = w * 32; e < w * 32 + 32; ++e) {
        const float4* ur = (const float4*)(u + (size_t)eid[e] * D);
        float s = 0.f;
#pragma unroll
        for (int j = 0; j < 4; ++j) { const float4 a = ur[lane + 64 * j]; s += a.x * xv[j].x + a.y * xv[j].y + a.z * xv[j].z + a.w * xv[j].w; }
        s = wave_sum(s);
        if (lane == 0) hid[e] = gelu_f(s) * gate[(size_t)t * 128 + e];
    }
    __syncthreads();
    float4 acc = ((const float4*)(hres + (size_t)t * D))[tid];
    for (int e = 0; e < 128; ++e) {
        const float4 vv = ((const float4*)(v + (size_t)eid[e] * D))[tid];
        const float hh = hid[e];
        acc.x += hh * vv.x; acc.y += hh * vv.y; acc.z += hh * vv.z; acc.w += hh * vv.w;
    }
    float ss = acc.x * acc.x + acc.y * acc.y + acc.z * acc.z + acc.w * acc.w;
    ss = wave_sum(ss);
    if (lane == 0) red[w] = ss;
    __syncthreads();
    const float tot = red[0] + red[1] + red[2] + red[3];
    const float r = rsqrtf(tot * (1.f / D) + EPS);
    const float4 ww = ((const float4*)nfw)[tid];
    float4 o; o.x = acc.x * r * ww.x; o.y = acc.y * r * ww.y; o.z = acc.z * r * ww.z; o.w = acc.w * r * ww.w;
    ((float4*)(out + (size_t)t * D))[tid] = o;
}
__global__ void __launch_bounds__(256) k_bf2f(const unsigned short* __restrict__ src, float* __restrict__ dst, size_t n) {
    for (size_t i = (size_t)blockIdx.x * 256 + threadIdx.x; i < n; i += (size_t)gridDim.x * 256) dst[i] = bf2f(src[i]);
}
}
extern "C" void kernel_launch(void* const* d_in, const int* in_sizes, int n_in, void* d_out, int out_size, void* d_ws, size_t ws_size, hipStream_t stream) {
    static int grid = 0;
    if (grid == 0) {
        if (n_in != 19 || out_size != T * D || ws_size < 256 * MiB) { fprintf(stderr, "kernel_launch: unexpected shapes n_in %d out %d ws %zu\n", n_in, out_size, ws_size); grid = -1; return; }
        int dev = 0, cus = 0, per_cu = 0;
        if (hipGetDevice(&dev) != hipSuccess || hipDeviceGetAttribute(&cus, hipDeviceAttributeMultiprocessorCount, dev) != hipSuccess) { grid = -1; return; }
        if (hipFuncSetAttribute((const void*)fwd, hipFuncAttributeMaxDynamicSharedMemorySize, LDS_BYTES) != hipSuccess) { fprintf(stderr, "kernel_launch: hipFuncSetAttribute failed\n"); grid = -1; return; }
        if (hipOccupancyMaxActiveBlocksPerMultiprocessor(&per_cu, (const void*)fwd, NWAVES * 64, LDS_BYTES) != hipSuccess || per_cu < 1) { fprintf(stderr, "kernel_launch: occupancy query says %d\n", per_cu); }
        (void)hipGetLastError();
        grid = cus;
    }
    if (grid < 0) return;
    const float* x = (const float*)d_in[0];
    const float* gla_w2 = (const float*)d_in[3];
    const float* gla_bg = (const float*)d_in[4];
    const float* gla_nw = (const float*)d_in[5];
    const float* conv_w = (const float*)d_in[6];
    const float* conv_b = (const float*)d_in[7];
    const float* dt_bias = (const float*)d_in[8];
    const float* a_log = (const float*)d_in[9];
    const float* d_skip = (const float*)d_in[10];
    const float* ssd_nw = (const float*)d_in[11];
    const float* w_out = (const float*)d_in[12];
    const float* norm_ffn_w = (const float*)d_in[13];
    const float* w_query = (const float*)d_in[14];
    const float* sub_keys = (const float*)d_in[15];
    const float* pu = (const float*)d_in[16];
    const float* pv = (const float*)d_in[17];
    const float* norm_final_w = (const float*)d_in[18];
    float* out = (float*)d_out;
    char* ws = (char*)d_ws;

    (void)hipMemsetAsync(ws + WS_CTL, 0, CTL_ZERO_BYTES, stream);
    Args a{};
    for (int i = 0; i < 19; ++i) a.in[i] = (const float*)d_in[i];
    a.out = out; a.ws = (unsigned char*)d_ws; a.ph_lo = 0; a.ph_hi = 9;
    hipLaunchKernelGGL(fwd, dim3(grid), dim3(NWAVES * 64), LDS_BYTES, stream, a);

}
```

```cpp
#include <hip/hip_runtime.h>
#include <cstdio>
#include <cstdint>
namespace pg8 {
#define PG8_LAS __attribute__((address_space(3)))
typedef unsigned short bf16_t;
typedef short bf16x8 __attribute__((ext_vector_type(8)));
typedef float f32x4 __attribute__((ext_vector_type(4)));
typedef unsigned u32x4 __attribute__((ext_vector_type(4)));
constexpr int BM = 256, BK = 64, HALF = 128, HTB = HALF * BK * 2  , STAGE_BYTES = 8 * HTB, NXCD = 8, WGM = 8;

__host__ __device__ __forceinline__ int lds_byte(int r, int c) { const int st = (r >> 4) * 2 + (c >> 5), rr = r & 15, cc = c & 31, ob = rr * 64 + cc * 2; return st * 1024 + (ob ^ (((ob >> 9) & 1) << 5)); }
__host__ __device__ __forceinline__ void stage_rc(int b, int& R, int& C) { const int st = b / 1024, sb = b % 1024, swz = sb ^ (((sb >> 9) & 1) << 5); R = (st >> 1) * 16 + swz / 64; C = (st & 1) * 32 + (swz % 64) / 2; }
__host__ __device__ __forceinline__ int perm32(int rho) { const int n = rho >> 4, i = rho & 15; return 8 * (i >> 2) + 4 * n + (i & 3); }

struct Unit { int pm, pn; };
struct Gemm { const bf16_t* A; const bf16_t* Bt; int M, N, K; };

struct StaticOrder {
    int nM, nN, nwg, G, c;
    __host__ __device__ void init(int M, int N, int G_, int c_) { nM = M / BM; nN = N / BM; nwg = nM * nN; G = G_; c = c_; }
    __host__ __device__ bool next(int i, Unit& u) const {
        const long L = (long)i * G + c; if (L >= nwg) return false;
        int wgid = (int)L; { const int q = nwg / NXCD, r = nwg % NXCD, xcd = wgid % NXCD, off = wgid / NXCD; wgid = (xcd < r ? xcd * (q + 1) : r * (q + 1) + (xcd - r) * q) + off; }
        const int nig = WGM * nN, gid = wgid / nig, fm = gid * WGM, gsz = (nM - fm) < WGM ? (nM - fm) : WGM;
        u.pm = fm + ((wgid % nig) % gsz); u.pn = (wgid % nig) / gsz; return true;
    }
    __device__ __forceinline__ void a_ready(const Unit&) const {}
    __device__ __forceinline__ void done(const Unit&) const {}
};

__device__ __forceinline__ unsigned cvt_pk_bf16(float lo, float hi) { unsigned r; asm volatile("v_cvt_pk_bf16_f32 %0, %1, %2" : "=v"(r) : "v"(lo), "v"(hi)); return r; }
typedef float f32x2 __attribute__((ext_vector_type(2)));
struct EpiRowScaleBf16 {
    static constexpr bool PERM = true, AFTER_DRAIN = false;
    bf16_t* O; int ldc; const float* rs;
    __device__ __forceinline__ void operator()(const f32x4 (&acc)[2][2][4][2], const Unit& u, int wr, int wc, int fr, int fq) const {
        const int row0 = u.pm * BM + wr * 64 + fr, col0 = u.pn * BM + wc * 32 + 8 * fq;
#pragma unroll
        for (int ai = 0; ai < 2; ++ai)
#pragma unroll
            for (int m = 0; m < 4; ++m) { const int row = row0 + ai * HALF + m * 16; const float sc = rs[row]; bf16_t* rowp = O + (size_t)row * ldc + col0;
#pragma unroll
                for (int bj = 0; bj < 2; ++bj) { const f32x4 v0 = acc[ai][bj][m][0] * sc, v1 = acc[ai][bj][m][1] * sc;
                    u32x4 w; w.x = cvt_pk_bf16(v0[0], v0[1]); w.y = cvt_pk_bf16(v0[2], v0[3]); w.z = cvt_pk_bf16(v1[0], v1[1]); w.w = cvt_pk_bf16(v1[2], v1[3]);
                    *(u32x4*)(rowp + bj * HALF) = w; } }
    }
};
struct EpiRsqScaleBf16 {
    static constexpr bool PERM = true, AFTER_DRAIN = false;
    bf16_t* O; int ldc; const float* rowsq;
    __device__ __forceinline__ void operator()(const f32x4 (&acc)[2][2][4][2], const Unit& u, int wr, int wc, int fr, int fq) const {
        const int row0 = u.pm * BM + wr * 64 + fr, col0 = u.pn * BM + wc * 32 + 8 * fq;
#pragma unroll
        for (int ai = 0; ai < 2; ++ai)
#pragma unroll
            for (int m = 0; m < 4; ++m) { const int row = row0 + ai * HALF + m * 16; const float sc = rsqrtf(rowsq[row] * (1.f / 1024.f) + 1e-6f); bf16_t* rowp = O + (size_t)row * ldc + col0;
#pragma unroll
                for (int bj = 0; bj < 2; ++bj) { const f32x4 v0 = acc[ai][bj][m][0] * sc, v1 = acc[ai][bj][m][1] * sc;
                    u32x4 w; w.x = cvt_pk_bf16(v0[0], v0[1]); w.y = cvt_pk_bf16(v0[2], v0[3]); w.z = cvt_pk_bf16(v1[0], v1[1]); w.w = cvt_pk_bf16(v1[2], v1[3]);
                    *(u32x4*)(rowp + bj * HALF) = w; } }
    }
};
struct EpiResidual {
    static constexpr bool PERM = true, AFTER_DRAIN = false;
    const float* X; float* H; bf16_t* HB; float* rowsq; int ldc;
    __device__ __forceinline__ void operator()(const f32x4 (&acc)[2][2][4][2], const Unit& u, int wr, int wc, int fr, int fq) const {
        const int row0 = u.pm * BM + wr * 64 + fr, col0 = u.pn * BM + wc * 32 + 8 * fq;
#pragma unroll
        for (int ai = 0; ai < 2; ++ai)
#pragma unroll
            for (int m = 0; m < 4; ++m) { const int row = row0 + ai * HALF + m * 16; float ss = 0.f;
#pragma unroll
                for (int bj = 0; bj < 2; ++bj) { const size_t off = (size_t)row * ldc + col0 + bj * HALF;
                    const f32x4 v0 = acc[ai][bj][m][0] + *(const f32x4*)(X + off), v1 = acc[ai][bj][m][1] + *(const f32x4*)(X + off + 4);
                    if (H) { *(f32x4*)(H + off) = v0; *(f32x4*)(H + off + 4) = v1; }
                    u32x4 w; w.x = cvt_pk_bf16(v0[0], v0[1]); w.y = cvt_pk_bf16(v0[2], v0[3]); w.z = cvt_pk_bf16(v1[0], v1[1]); w.w = cvt_pk_bf16(v1[2], v1[3]);
                    *(u32x4*)(HB + off) = w;
                    ss += (v0[0] * v0[0] + v0[1] * v0[1]) + (v0[2] * v0[2] + v0[3] * v0[3]) + (v1[0] * v1[0] + v1[1] * v1[1]) + (v1[2] * v1[2] + v1[3] * v1[3]); }
                ss += __shfl_xor(ss, 16); ss += __shfl_xor(ss, 32);
                if (fq == 0) atomicAdd(rowsq + row, ss); }
    }
};
template <class Epi, class Sched, bool ALIGN_EPI = false, bool SP2 = false>
__device__ __forceinline__ void gemm_phase(PG8_LAS unsigned char* lds, const Gemm g, const Sched& S, const Epi& E) {
    const int tid = threadIdx.x, wid = __builtin_amdgcn_readfirstlane(tid >> 6), lane = tid & 63, wr = wid >> 2, wc = wid & 3, fr = lane & 15, fq = lane >> 4;
    const int K = g.K, nt = K / BK;
    unsigned voffA[2], voffB[2];
#pragma unroll
    for (int i = 0; i < 2; ++i) { int R, C; stage_rc(tid * 16 + i * 8192, R, C); const int Rb = Epi::PERM ? ((R & ~31) + perm32(R & 31)) : R;
        voffA[i] = (unsigned)(R * K + C) * 2u; voffB[i] = (unsigned)(Rb * K + C) * 2u; }
    const size_t kstep = (size_t)(BK * 2);
    const size_t hstep = (size_t)HALF * K * 2;
    const size_t tstep = 2 * hstep;
    const unsigned ldsw = (unsigned)wid * 1024u;
    const int aoff = lds_byte(wr * 64 + fr, fq * 8), boff = lds_byte(wc * 32 + fr, fq * 8);
#define PG8_SA(b, h) (((b) * 2 + (h)) * HTB)
#define PG8_SB(b, h) ((4 + (b) * 2 + (h)) * HTB)
#define PG8_STAGE(bufoff, gbase, voff) do { _Pragma("unroll") for (int _i = 0; _i < 2; ++_i) \
        __builtin_amdgcn_global_load_lds((const unsigned*)((const char*)(gbase) + (voff)[_i]), (PG8_LAS unsigned*)(lds + (bufoff) + ldsw + _i * 8192), 16, 0, 0); } while (0)
#define PG8_LDA(dst, b, h) do { _Pragma("unroll") for (int m = 0; m < 4; ++m) _Pragma("unroll") for (int k = 0; k < 2; ++k) dst[m][k] = *(const PG8_LAS bf16x8*)(lds + PG8_SA(b, h) + aoff + m * 2048 + k * 1024); } while (0)
#define PG8_LDB(dst, b, h) do { _Pragma("unroll") for (int n = 0; n < 2; ++n) _Pragma("unroll") for (int k = 0; k < 2; ++k) dst[n][k] = *(const PG8_LAS bf16x8*)(lds + PG8_SB(b, h) + boff + n * 2048 + k * 1024); } while (0)
#define PG8_MMA(ai, bj, At, Bt) do { __builtin_amdgcn_s_setprio(1); _Pragma("unroll") for (int m = 0; m < 4; ++m) _Pragma("unroll") for (int n = 0; n < 2; ++n) _Pragma("unroll") for (int k = 0; k < 2; ++k) \
        acc[ai][bj][m][n] = __builtin_amdgcn_mfma_f32_16x16x32_bf16(Bt[n][k], At[m][k], acc[ai][bj][m][n], 0, 0, 0); __builtin_amdgcn_s_setprio(0); } while (0)
#define PG8_WAIT_V(n) asm volatile("s_waitcnt vmcnt(" #n ")" ::: "memory")
#define PG8_WAIT_L(n) asm volatile("s_waitcnt lgkmcnt(" #n ")" ::: "memory")
#define PG8_BAR __builtin_amdgcn_s_barrier()
#define PG8_SCHED __builtin_amdgcn_sched_barrier(0)
    Unit cur, nxt; int ui = 0;
    if (!S.next(0, cur)) return;
    f32x4 acc[2][2][4][2];
#pragma unroll
    for (int a = 0; a < 2; ++a)
#pragma unroll
        for (int b = 0; b < 2; ++b)
#pragma unroll
            for (int m = 0; m < 4; ++m)
#pragma unroll
                for (int n = 0; n < 2; ++n) acc[a][b][m][n] = (f32x4){0.f, 0.f, 0.f, 0.f};
    bf16x8 At[4][2], B0[2][2], B1[2][2];
    const char* cA = (const char*)g.A + (size_t)cur.pm * tstep; const char* cB = (const char*)g.Bt + (size_t)cur.pn * tstep;
    S.a_ready(cur);
    if constexpr (SP2) {
        PG8_STAGE(PG8_SB(0, 0), cB, voffB); PG8_STAGE(PG8_SB(0, 1), cB + hstep, voffB); PG8_STAGE(PG8_SA(0, 0), cA, voffA); PG8_STAGE(PG8_SA(0, 1), cA + hstep, voffA);
        if (wr == 1) PG8_BAR;
        PG8_WAIT_V(2); PG8_BAR;
        PG8_STAGE(PG8_SB(1, 0), cB + kstep, voffB); PG8_STAGE(PG8_SA(1, 0), cA + kstep, voffA); PG8_STAGE(PG8_SB(1, 1), cB + hstep + kstep, voffB);
        PG8_WAIT_V(6); PG8_BAR;
    } else {
        PG8_STAGE(PG8_SB(0, 0), cB, voffB); PG8_STAGE(PG8_SA(0, 0), cA, voffA); PG8_STAGE(PG8_SB(0, 1), cB + hstep, voffB); PG8_STAGE(PG8_SA(0, 1), cA + hstep, voffA);
        if (wr == 1) PG8_BAR;
        PG8_WAIT_V(4); PG8_BAR;
        PG8_STAGE(PG8_SB(1, 0), cB + kstep, voffB); PG8_STAGE(PG8_SA(1, 0), cA + kstep, voffA); PG8_STAGE(PG8_SB(1, 1), cB + hstep + kstep, voffB);
        PG8_WAIT_V(6); PG8_BAR;
    }
    for (;;) {
        const bool has_next = S.next(ui + 1, nxt);
        const char* nA = has_next ? (const char*)g.A + (size_t)nxt.pm * tstep : cA; const char* nB = has_next ? (const char*)g.Bt + (size_t)nxt.pn * tstep : cB;
        for (int t = 0; t < nt; t += 2) {
            const bool last = (t == nt - 2);
            const char* a1 = cA + (size_t)(t + 1) * kstep;
            const char* a2 = last ? nA : cA + (size_t)(t + 2) * kstep; const char* b2 = last ? nB : cB + (size_t)(t + 2) * kstep;
            const char* a3 = a2 + kstep; const char* b3 = b2 + kstep;
            if (last && has_next) S.a_ready(nxt);
            if constexpr (SP2) {
            PG8_LDB(B0, 0, 0); PG8_LDB(B1, 0, 1); PG8_SCHED; PG8_LDA(At, 0, 0); PG8_STAGE(PG8_SA(1, 1), a1 + hstep, voffA);
            PG8_WAIT_V(8); PG8_WAIT_L(0); PG8_BAR; PG8_MMA(0, 0, At, B0); PG8_MMA(0, 1, At, B1); PG8_BAR; PG8_SCHED;
            PG8_LDA(At, 0, 1); PG8_STAGE(PG8_SB(0, 0), b2, voffB); PG8_STAGE(PG8_SB(0, 1), b2 + hstep, voffB); PG8_STAGE(PG8_SA(0, 0), a2, voffA);
            PG8_WAIT_V(8); PG8_WAIT_L(0); PG8_BAR; PG8_MMA(1, 0, At, B0); PG8_MMA(1, 1, At, B1); PG8_BAR; PG8_SCHED;
            PG8_LDB(B0, 1, 0); PG8_LDB(B1, 1, 1); PG8_SCHED; PG8_LDA(At, 1, 0); PG8_STAGE(PG8_SA(0, 1), a2 + hstep, voffA);
            PG8_WAIT_V(8); PG8_WAIT_L(0); PG8_BAR; PG8_MMA(0, 0, At, B0); PG8_MMA(0, 1, At, B1); PG8_BAR; PG8_SCHED;
            PG8_LDA(At, 1, 1); PG8_STAGE(PG8_SB(1, 0), b3, voffB); PG8_STAGE(PG8_SB(1, 1), b3 + hstep, voffB); PG8_STAGE(PG8_SA(1, 0), a3, voffA);
            PG8_WAIT_V(8); PG8_WAIT_L(0); PG8_BAR; PG8_MMA(1, 0, At, B0); PG8_MMA(1, 1, At, B1); PG8_BAR; PG8_SCHED;
            } else {
            PG8_LDB(B0, 0, 0); PG8_SCHED; PG8_LDA(At, 0, 0); PG8_STAGE(PG8_SA(1, 1), a1 + hstep, voffA);
            PG8_WAIT_L(8); PG8_BAR; PG8_WAIT_L(0); PG8_MMA(0, 0, At, B0); PG8_BAR; PG8_SCHED;
            PG8_LDB(B1, 0, 1); PG8_STAGE(PG8_SB(0, 0), b2, voffB);
            PG8_BAR; PG8_WAIT_L(0); PG8_MMA(0, 1, At, B1); PG8_BAR;
            PG8_LDA(At, 0, 1); PG8_STAGE(PG8_SA(0, 0), a2, voffA);
            PG8_BAR; PG8_WAIT_L(0); PG8_MMA(1, 0, At, B0); PG8_BAR; PG8_SCHED;
            PG8_STAGE(PG8_SB(0, 1), b2 + hstep, voffB);
            PG8_WAIT_V(6); PG8_BAR; PG8_MMA(1, 1, At, B1); PG8_BAR;
            PG8_LDB(B0, 1, 0); PG8_SCHED; PG8_LDA(At, 1, 0); PG8_STAGE(PG8_SA(0, 1), a2 + hstep, voffA);
            PG8_WAIT_L(8); PG8_BAR; PG8_WAIT_L(0); PG8_MMA(0, 0, At, B0); PG8_BAR; PG8_SCHED;
            PG8_LDB(B1, 1, 1); PG8_STAGE(PG8_SB(1, 0), b3, voffB);
            PG8_BAR; PG8_WAIT_L(0); PG8_MMA(0, 1, At, B1); PG8_BAR;
            PG8_LDA(At, 1, 1); PG8_STAGE(PG8_SA(1, 0), a3, voffA);
            PG8_BAR; PG8_WAIT_L(0); PG8_MMA(1, 0, At, B0); PG8_BAR; PG8_SCHED;
            PG8_STAGE(PG8_SB(1, 1), b3 + hstep, voffB);
            PG8_WAIT_V(6); PG8_BAR; PG8_MMA(1, 1, At, B1); PG8_BAR;
            }
        }
        if constexpr (ALIGN_EPI) { if (wr == 0) PG8_BAR; }
        if constexpr (!Epi::AFTER_DRAIN) { E(acc, cur, wr, wc, fr, fq); S.done(cur); }
        if (!has_next) break;
#pragma unroll
        for (int a = 0; a < 2; ++a)
#pragma unroll
            for (int b = 0; b < 2; ++b)
#pragma unroll
                for (int m = 0; m < 4; ++m)
#pragma unroll
                    for (int n = 0; n < 2; ++n) acc[a][b][m][n] = (f32x4){0.f, 0.f, 0.f, 0.f};
        cur = nxt; cA = nA; cB = nB; ++ui;
        if constexpr (ALIGN_EPI) { if (wr == 1) PG8_BAR; }
    }
    PG8_WAIT_V(0);
    if constexpr (!ALIGN_EPI) { if (wr == 0) PG8_BAR; }
    PG8_BAR;
    if constexpr (Epi::AFTER_DRAIN) { E.fused(acc, cur, wr, wc, fr, fq, lds, wid, lane); S.done(cur); }
#undef PG8_SA
#undef PG8_SB
#undef PG8_STAGE
#undef PG8_LDA
#undef PG8_LDB
#undef PG8_MMA
#undef PG8_WAIT_V
#undef PG8_WAIT_L
#undef PG8_BAR
#undef PG8_SCHED
}
}
constexpr int NWAVES = 8;
constexpr int T = 16384, SEQ = 8192, D = 1024, NIN = 2840, NINP = 3072, NQ = 2048;
constexpr int C_Q = 0, C_K = 256, C_V = 512, C_GLR = 1024, C_GOUT = 1040, C_Z = 1552, C_XBC = 2064, C_DT = 2832;
constexpr float EPS = 1e-6f;
constexpr size_t MiB = 1u << 20;
constexpr size_t WS_CTL = 0, CTL_ZERO_BYTES = 64 * 1024;
constexpr size_t WS_WIN = 1 * MiB;
constexpr size_t WS_WO = 7 * MiB;
constexpr size_t WS_WQ = 9 * MiB;
constexpr size_t WS_SUBK = 13 * MiB;
constexpr size_t WS_RRMS1 = 14 * MiB;
constexpr size_t WS_ROWSQ2 = 14 * MiB + 64 * 1024;
constexpr size_t WS_UB = 16 * MiB, WS_VB = 48 * MiB;
constexpr size_t WS_XB = 80 * MiB;
constexpr size_t WS_PROJ = 112 * MiB;
constexpr int CW_TMO = 0, CW_BAR = 1024;
constexpr int RING_OFF = 0, RING_BYTES = 131072;
constexpr int LDS_BYTES = 163840;
constexpr int LDSCTL_OFF = LDS_BYTES - 1024, MISC_OFF = LDSCTL_OFF + 320;

#define GAS __attribute__((address_space(1)))
#define LAS __attribute__((address_space(3)))
typedef unsigned short bf16;
typedef unsigned v4u __attribute__((ext_vector_type(4)));
typedef float f32x4 __attribute__((ext_vector_type(4)));
typedef short bf16x8 __attribute__((ext_vector_type(8)));
typedef GAS unsigned gu32;
#define RLX_AGENT __ATOMIC_RELAXED, __HIP_MEMORY_SCOPE_AGENT
#define LDS_WAIT() asm volatile("s_waitcnt lgkmcnt(0)" ::: "memory")
#define VM_WAIT() asm volatile("s_waitcnt vmcnt(0)" ::: "memory")
typedef float f32x2c __attribute__((ext_vector_type(2)));
typedef __bf16 bf16x2c __attribute__((ext_vector_type(2)));
__device__ __forceinline__ unsigned f2bf(float f) { const __bf16 b = (__bf16)f; return (unsigned)__builtin_bit_cast(unsigned short, b); }
__device__ __forceinline__ unsigned pk2(float lo, float hi) { const bf16x2c v = __builtin_convertvector((f32x2c){lo, hi}, bf16x2c); return __builtin_bit_cast(unsigned, v); }
__device__ __forceinline__ float bf2f(unsigned short b) { return __builtin_bit_cast(float, (unsigned)b << 16); }
__device__ __forceinline__ float wave_sum(float v) {
#pragma unroll
    for (int o = 1; o < 64; o <<= 1) v += __shfl_xor(v, o);
    return v;
}
#define XB_TMO      128
#define XB_XCNT(j)  (256  + 64 * (j))
#define XB_XSUB(j)  (1280 + 64 * (j))
#define XB_XGEN(j)  (2304 + 64 * (j))
#define XB_TOP      3328
#define XB_TOPGEN   3392
#define XCD_BAR_WORDS 3456
#define XB_SPIN_CAP (1u << 18)

__device__ __forceinline__ unsigned xb_ld(unsigned* p)              { return __hip_atomic_load(p, __ATOMIC_RELAXED, __HIP_MEMORY_SCOPE_AGENT); }
__device__ __forceinline__ unsigned xb_add(unsigned* p, unsigned v) { return __hip_atomic_fetch_add(p, v, __ATOMIC_RELAXED, __HIP_MEMORY_SCOPE_AGENT); }
__device__ __forceinline__ unsigned xb_xcc_id() { return (unsigned)__builtin_amdgcn_s_getreg((3 << 11) | 20) & 0xFu; }
#define XB_SPIN(cond, bar) do { unsigned _sp = 0; while (cond) { __builtin_amdgcn_s_sleep(1); \
    if ((++_sp & 255u) == 0u) { if (xb_ld(&(bar)[XB_TMO])) break; if (_sp > XB_SPIN_CAP) { atomicAdd(&(bar)[XB_TMO], 1u); break; } } } } while (0)

struct XcdBarrier {
    unsigned* bar; unsigned x;
    volatile LAS unsigned* st;
};

__device__ __forceinline__ XcdBarrier xcd_barrier_post(unsigned* bar, volatile LAS unsigned* st) {
    XcdBarrier b; b.bar = bar; b.x = xb_xcc_id(); b.st = st;
    if (threadIdx.x == 0) (void)xb_add(&bar[XB_XCNT(b.x)], 1u);
    return b;
}
__device__ __forceinline__ void xcd_barrier_complete(unsigned* bar, unsigned x, unsigned& nloc, unsigned& nx) {
    const unsigned G = gridDim.x * gridDim.y * gridDim.z;
    unsigned sum, cnt, mine, sp = 0u;
    for (;;) {
        sum = 0u; cnt = 0u; mine = 0u;
#pragma unroll
        for (unsigned j = 0; j < 16; ++j) { const unsigned c = xb_ld(&bar[XB_XCNT(j)]); sum += c; cnt += (c > 0u) ? 1u : 0u; mine = (j == x) ? c : mine; }
        if (sum == G) break;
        __builtin_amdgcn_s_sleep(1);
        if ((++sp & 255u) == 0u) { if (xb_ld(&bar[XB_TMO])) break; if (sp > XB_SPIN_CAP) { atomicAdd(&bar[XB_TMO], 1u); break; } }
    }
    nloc = mine > 0u ? mine : 1u; nx = cnt > 0u ? cnt : 1u;
}

__device__ __forceinline__ void xcd_barrier(const XcdBarrier& b) {
    asm volatile("s_waitcnt vmcnt(0)" ::: "memory");
    __syncthreads();
    if (threadIdx.x == 0) {
        unsigned* bar = b.bar;
        __builtin_amdgcn_s_waitcnt(0);
        unsigned nloc = b.st[0], nx = b.st[1];
        if (nloc == 0u) { xcd_barrier_complete(bar, b.x, nloc, nx); b.st[0] = nloc; b.st[1] = nx; }
        const unsigned old = xb_add(&bar[XB_XSUB(b.x)], 1u);
        const unsigned gen = old / nloc;
        if (old + 1u == (gen + 1u) * nloc) {
            __builtin_amdgcn_fence(__ATOMIC_RELEASE, "agent");
            asm volatile("s_waitcnt vmcnt(0)" ::: "memory");
            const unsigned og = xb_add(&bar[XB_TOP], 1u);
            const unsigned tg = og / nx;
            if (og + 1u == (tg + 1u) * nx) xb_add(&bar[XB_TOPGEN], 1u);
            else XB_SPIN(xb_ld(&bar[XB_TOPGEN]) == tg, bar);
            __builtin_amdgcn_fence(__ATOMIC_ACQUIRE, "agent");
            xb_add(&bar[XB_XGEN(b.x)], 1u);
            asm volatile("s_waitcnt vmcnt(0)" ::: "memory");
        } else {
            XB_SPIN(xb_ld(&bar[XB_XGEN(b.x)]) == gen, bar);
            __builtin_amdgcn_fence(__ATOMIC_ACQUIRE, "agent");
            asm volatile("s_waitcnt vmcnt(0)" ::: "memory");
        }
    }
    __syncthreads();
}
struct Args {
    const float* in[19]; float* out; unsigned char* ws; int ph_lo, ph_hi;
};
struct Frame {
    LAS unsigned char* lds; volatile LAS unsigned* MISC; gu32* ctl;
    int tid, lane, wave, G, gw, NGW;
};

constexpr size_t WS_GDEC = 14 * MiB + 128 * 1024;
constexpr size_t WS_SDEC = 14 * MiB + 512 * 1024;
constexpr size_t WS_GST = 208 * MiB;
constexpr size_t WS_SST = 224 * MiB;
constexpr int SA64 = 144, SA128 = 272, SA32 = 80;

__device__ __forceinline__ float silu_f(float x) { return x * __builtin_amdgcn_rcpf(1.f + __expf(-x)); }
__device__ __forceinline__ float softplus_f(float x) { return fmaxf(x, 0.f) + __logf(1.f + __expf(-fabsf(x))); }
__device__ __forceinline__ float logsigmoid_f(float x) { return fminf(x, 0.f) - __logf(1.f + __expf(-fabsf(x))); }
typedef unsigned u32x2 __attribute__((ext_vector_type(2)));

__device__ __forceinline__ f32x4 mma16(const LAS unsigned char* A, int sa, const LAS unsigned char* Bt, int sb, int K, f32x4 acc, int r, int kg) {
    for (int k0 = 0; k0 < K; k0 += 32) {
        const bf16x8 a = *(const LAS bf16x8*)(A + r * sa + (k0 + 8 * kg) * 2);
        const bf16x8 b = *(const LAS bf16x8*)(Bt + r * sb + (k0 + 8 * kg) * 2);
        acc = __builtin_amdgcn_mfma_f32_16x16x32_bf16(a, b, acc, 0, 0, 0);
    }
    return acc;
}

__device__ __forceinline__ void unpack8f(const v4u x, float (&f)[8]) {
    f[0] = __builtin_bit_cast(float, x.x << 16); f[1] = __builtin_bit_cast(float, x.x & 0xffff0000u); f[2] = __builtin_bit_cast(float, x.y << 16); f[3] = __builtin_bit_cast(float, x.y & 0xffff0000u);
    f[4] = __builtin_bit_cast(float, x.z << 16); f[5] = __builtin_bit_cast(float, x.z & 0xffff0000u); f[6] = __builtin_bit_cast(float, x.w << 16); f[7] = __builtin_bit_cast(float, x.w & 0xffff0000u);
}
template <int MODE>
__device__ __forceinline__ void gla_unit(const Frame& F, const Args& A, int unit) {
    const int b = unit >> 9, c = (unit >> 2) & 127, h = unit & 3;
    const size_t t0 = (size_t)b * SEQ + (size_t)c * 64;
    const GAS bf16* proj = (const GAS bf16*)(A.ws + WS_PROJ);
    LAS unsigned char* L = F.lds;
    LAS float* GLR = (LAS float*)(L + 0);
    LAS float* SEG = (LAS float*)(L + 4096);
    LAS float* RSQ = (LAS float*)(L + 6144);
    LAS unsigned char* QI = L + 8192;
    LAS unsigned char* KI = QI + 64 * SA64;
    LAS unsigned char* VT = KI + 64 * SA64;
    LAS unsigned char* SP = VT + 128 * SA64;
    LAS unsigned char* AT = SP + 128 * SA64;
    LAS unsigned char* GO = AT + 64 * SA64;
    int tid = F.tid, seg = F.wave;
    asm volatile("" : "+v"(tid)); asm volatile("" : "+s"(seg));
    const int d = tid & 63;
    {
        const int row = tid >> 3, ch = tid & 7;
        const GAS bf16* prow = proj + (t0 + row) * NINP;
        const v4u kq = *(const GAS v4u*)(prow + C_K + h * 64 + ch * 8);
        v4u qq = kq; if (MODE == 1) qq = *(const GAS v4u*)(prow + C_Q + h * 64 + ch * 8);
        const int o = tid & 15, jp = tid >> 4;
        const v4u va = *(const GAS v4u*)(proj + (t0 + 2 * jp) * NINP + C_V + h * 128 + o * 8), vb = *(const GAS v4u*)(proj + (t0 + 2 * jp + 1) * NINP + C_V + h * 128 + o * 8);
        v4u g0 = kq, g1 = kq, s0 = kq, s1 = kq;
        if (MODE == 1) {
            const int r2 = tid >> 4, c2 = tid & 15;
            g0 = *(const GAS v4u*)(proj + (t0 + r2) * NINP + C_GOUT + h * 128 + c2 * 8); g1 = *(const GAS v4u*)(proj + (t0 + r2 + 32) * NINP + C_GOUT + h * 128 + c2 * 8);
            const GAS bf16* sp = (const GAS bf16*)(A.ws + WS_GST) + (size_t)unit * 8192;
            s0 = *(const GAS v4u*)(sp + (tid >> 3) * 64 + (tid & 7) * 8); s1 = *(const GAS v4u*)(sp + (64 + (tid >> 3)) * 64 + (tid & 7) * 8);
        }
        v4u gl = kq; if (tid < 128) gl = *(const GAS v4u*)(proj + (t0 + (tid >> 1)) * NINP + C_GLR + (tid & 1) * 8);
        if (MODE == 1) { *(LAS v4u*)(QI + row * SA64 + ch * 16) = qq; *(LAS v4u*)(KI + row * SA64 + ch * 16) = kq; }
        else *(LAS v4u*)(GO + row * SA64 + ch * 16) = kq;
        {   const unsigned aw[4] = {va.x, va.y, va.z, va.w}, bw[4] = {vb.x, vb.y, vb.z, vb.w};
#pragma unroll
            for (int cc = 0; cc < 8; ++cc) { const unsigned x = aw[cc >> 1], y = bw[cc >> 1];
                const unsigned wv_ = (cc & 1) ? ((x >> 16) | (y & 0xffff0000u)) : ((x & 0xffffu) | (y << 16));
                *(LAS unsigned*)(VT + (8 * o + cc) * SA64 + jp * 4) = wv_; } }
        if (MODE == 1) {
            const int r2 = tid >> 4, c2 = tid & 15;
            *(LAS v4u*)(GO + r2 * SA128 + c2 * 16) = g0; *(LAS v4u*)(GO + (r2 + 32) * SA128 + c2 * 16) = g1;
            *(LAS v4u*)(SP + (tid >> 3) * SA64 + (tid & 7) * 16) = s0; *(LAS v4u*)(SP + (64 + (tid >> 3)) * SA64 + (tid & 7) * 16) = s1;
        }
        if (tid < 128) { float f[8]; unpack8f(gl, f);
#pragma unroll
            for (int q = 0; q < 8; ++q) GLR[(tid >> 1) * 16 + (tid & 1) * 8 + q] = f[q]; }
    }
    float wv[16];
#pragma unroll
    for (int r = 0; r < 16; ++r) wv[r] = A.in[3][r * 256 + h * 64 + d];
    const float bgv = A.in[4][h * 64 + d];
    __syncthreads();
    float Gv[8]; float run = 0.f;
#pragma unroll
    for (int ii = 0; ii < 8; ++ii) { const int i = seg * 8 + ii; float z = bgv;
#pragma unroll
        for (int r = 0; r < 16; ++r) z += GLR[i * 16 + r] * wv[r];
        run += logsigmoid_f(z) * (1.f / 16.f); Gv[ii] = run; }
    SEG[seg * 64 + d] = run;
    __syncthreads();
    float off = 0.f, tot = 0.f;
#pragma unroll
    for (int s = 0; s < 8; ++s) { const float v = SEG[s * 64 + d]; tot += v; off += (s < seg) ? v : 0.f; }
#pragma unroll
    for (int ii = 0; ii < 8; ++ii) Gv[ii] += off;
    if (MODE == 0) {
        unsigned w[4];
#pragma unroll
        for (int ii = 0; ii < 8; ii += 2) {
            const float k0 = bf2f(*(const LAS bf16*)(GO + (seg * 8 + ii) * SA64 + d * 2)) * __expf(tot - Gv[ii]);
            const float k1 = bf2f(*(const LAS bf16*)(GO + (seg * 8 + ii + 1) * SA64 + d * 2)) * __expf(tot - Gv[ii + 1]);
            w[ii >> 1] = pk2(k0, k1); }
        *(LAS v4u*)(KI + d * SA64 + seg * 16) = (v4u){w[0], w[1], w[2], w[3]};
        if (seg == 0) ((GAS float*)(A.ws + WS_GDEC))[unit * 64 + d] = __expf(tot);
    } else {
#pragma unroll
        for (int ii = 0; ii < 8; ++ii) { const int i = seg * 8 + ii;
            LAS bf16* qp = (LAS bf16*)(QI + i * SA64 + d * 2); LAS bf16* kp = (LAS bf16*)(KI + i * SA64 + d * 2);
            *qp = (bf16)f2bf(bf2f(*qp) * 0.125f * __expf(Gv[ii])); *kp = (bf16)f2bf(bf2f(*kp) * __expf(-Gv[ii])); }
    }
    __syncthreads();
    const int r = tid & 15, kg = (tid >> 4) & 3, w = seg;
    const f32x4 zero = (f32x4){0.f, 0.f, 0.f, 0.f};
    if (MODE == 0) {
        const int mt = w & 3, nb = (w >> 2) * 4;
        GAS bf16* stT = (GAS bf16*)(A.ws + WS_GST) + (size_t)unit * 8192;
#pragma unroll
        for (int n = 0; n < 4; ++n) {
            const f32x4 acc = mma16(KI + mt * 16 * SA64, SA64, VT + (nb + n) * 16 * SA64, SA64, 64, zero, r, kg);
            const int dv = (nb + n) * 16 + r, d0 = mt * 16 + kg * 4;
            *(GAS u32x2*)(stT + dv * 64 + d0) = (u32x2){pk2(acc[0], acc[1]), pk2(acc[2], acc[3])}; }
    } else {
        const int mt = w & 3;
#pragma unroll
        for (int n = 0; n < 2; ++n) { const int nt = (w >> 2) * 2 + n;
            const f32x4 acc = mma16(QI + mt * 16 * SA64, SA64, KI + nt * 16 * SA64, SA64, 64, zero, r, kg);
#pragma unroll
            for (int ii = 0; ii < 4; ++ii) { const int i = mt * 16 + kg * 4 + ii, j = nt * 16 + r; *(LAS bf16*)(AT + i * SA64 + j * 2) = (bf16)f2bf(j <= i ? acc[ii] : 0.f); } }
        __syncthreads();
        const int nb = (w >> 2) * 4;
        f32x4 o[4]; float rs[4] = {0.f, 0.f, 0.f, 0.f};
#pragma unroll
        for (int n = 0; n < 4; ++n) {
            f32x4 acc = mma16(AT + mt * 16 * SA64, SA64, VT + (nb + n) * 16 * SA64, SA64, 64, zero, r, kg);
            acc = mma16(QI + mt * 16 * SA64, SA64, SP + (nb + n) * 16 * SA64, SA64, 64, acc, r, kg);
            o[n] = acc;
#pragma unroll
            for (int ii = 0; ii < 4; ++ii) rs[ii] += acc[ii] * acc[ii]; }
#pragma unroll
        for (int ii = 0; ii < 4; ++ii) { rs[ii] += __shfl_xor(rs[ii], 1); rs[ii] += __shfl_xor(rs[ii], 2); rs[ii] += __shfl_xor(rs[ii], 4); rs[ii] += __shfl_xor(rs[ii], 8); }
        if (r == 0) {
#pragma unroll
            for (int ii = 0; ii < 4; ++ii) RSQ[(w >> 2) * 64 + mt * 16 + kg * 4 + ii] = rs[ii]; }
        __syncthreads();
        float rr[4];
#pragma unroll
        for (int ii = 0; ii < 4; ++ii) { const int row = mt * 16 + kg * 4 + ii; rr[ii] = rsqrtf((RSQ[row] + RSQ[64 + row]) * (1.f / 128.f) + EPS); }
#pragma unroll
        for (int n = 0; n < 4; ++n) { const int dv = (nb + n) * 16 + r; const float nwv = A.in[5][dv];
#pragma unroll
            for (int ii = 0; ii < 4; ++ii) { LAS bf16* gp = (LAS bf16*)(GO + (mt * 16 + kg * 4 + ii) * SA128 + dv * 2);
                *gp = (bf16)f2bf(o[n][ii] * rr[ii] * nwv * silu_f(bf2f(*gp))); } }
        __syncthreads();
        {   const int r2 = tid >> 4, c2 = tid & 15; GAS bf16* mixed = (GAS bf16*)(A.ws + WS_XB);
            *(GAS v4u*)(mixed + (t0 + r2) * D + h * 128 + c2 * 8) = *(const LAS v4u*)(GO + r2 * SA128 + c2 * 16);
            *(GAS v4u*)(mixed + (t0 + r2 + 32) * D + h * 128 + c2 * 8) = *(const LAS v4u*)(GO + (r2 + 32) * SA128 + c2 * 16); }
    }
    __syncthreads();
}

template <int MODE>
__device__ __forceinline__ void ssd_unit(const Frame& F, const Args& A, int unit) {
    const int b = unit >> 7, c = (unit >> 1) & 63, g = unit & 1;
    const size_t t0 = (size_t)b * SEQ + (size_t)c * 128;
    const GAS bf16* proj = (const GAS bf16*)(A.ws + WS_PROJ);
    LAS unsigned char* L = F.lds;
    LAS float* DT = (LAS float*)(L + 0);
    LAS float* ACU = (LAS float*)(L + 2048);
    LAS unsigned char* CM = L + 4096;
    LAS unsigned char* BM = CM + 128 * SA64;
    LAS unsigned char* XT = BM + 128 * SA64;
    LAS unsigned char* PW = XT + 4 * 64 * SA128;
    LAS unsigned char* ZW = PW + 8 * 16 * SA32;
    LAS float* RRW = (LAS float*)(ZW + 8 * 16 * SA64);
    int tid = F.tid, w = F.wave;
    asm volatile("" : "+v"(tid)); asm volatile("" : "+s"(w));
    const int lane = tid & 63;
    if (w < 4) {
        const int hd = g * 4 + w; const float Ah = -__expf(A.in[9][hd]), dtb = A.in[8][hd];
        const float dt0 = softplus_f(bf2f(proj[(t0 + 2 * lane) * NINP + C_DT + hd]) + dtb), dt1 = softplus_f(bf2f(proj[(t0 + 2 * lane + 1) * NINP + C_DT + hd]) + dtb);
        const float a0 = dt0 * Ah, a1 = dt1 * Ah; float s = a0 + a1;
#pragma unroll
        for (int o = 1; o < 64; o <<= 1) { const float t = __shfl_up(s, o); s += (lane >= o) ? t : 0.f; }
        DT[(2 * lane) * 4 + w] = dt0; DT[(2 * lane + 1) * 4 + w] = dt1; ACU[(2 * lane) * 4 + w] = s - a1; ACU[(2 * lane + 1) * 4 + w] = s;
        if (MODE == 0 && lane == 63) ((GAS float*)(A.ws + WS_SDEC))[(b * 64 + c) * 8 + hd] = __expf(s);
    }
    __syncthreads();
    if (tid < 384) {
        const int o = tid % 48, sg = tid / 48;
        if (!(MODE == 0 && o >= 40)) {
            const int cc0 = o < 32 ? g * 256 + 8 * o : (o < 40 ? 512 + g * 64 + 8 * (o - 32) : 640 + g * 64 + 8 * (o - 40));
            float wt[4][8], cb[8];
#pragma unroll
            for (int j = 0; j < 4; ++j) { const f32x4 a = *(const GAS f32x4*)(A.in[6] + j * 768 + cc0), bq = *(const GAS f32x4*)(A.in[6] + j * 768 + cc0 + 4);
                wt[j][0] = a.x; wt[j][1] = a.y; wt[j][2] = a.z; wt[j][3] = a.w; wt[j][4] = bq.x; wt[j][5] = bq.y; wt[j][6] = bq.z; wt[j][7] = bq.w; }
            { const f32x4 a = *(const GAS f32x4*)(A.in[7] + cc0), bq = *(const GAS f32x4*)(A.in[7] + cc0 + 4); cb[0] = a.x; cb[1] = a.y; cb[2] = a.z; cb[3] = a.w; cb[4] = bq.x; cb[5] = bq.y; cb[6] = bq.z; cb[7] = bq.w; }
            const GAS bf16* src = proj + (t0 + 16 * sg) * NINP + C_XBC + cc0;
            float x0[8], x1[8], x2[8];
            if (c > 0 || sg > 0) { unpack8f(*(const GAS v4u*)(src - 3 * NINP), x0); unpack8f(*(const GAS v4u*)(src - 2 * NINP), x1); unpack8f(*(const GAS v4u*)(src - 1 * NINP), x2); }
            else {
#pragma unroll
                for (int q = 0; q < 8; ++q) { x0[q] = 0.f; x1[q] = 0.f; x2[q] = 0.f; } }
            const int hl = o >> 3, p0 = (o & 7) * 8;
            float sc_end = 0.f; if (MODE == 0 && o < 32) sc_end = ACU[127 * 4 + hl];
#pragma unroll 1
            for (int hf = 0; hf < 2; ++hf) {
                v4u xin[8];
#pragma unroll
                for (int i = 0; i < 8; ++i) xin[i] = *(const GAS v4u*)(src + (size_t)(hf * 8 + i) * NINP);
                unsigned tp[8][4];
#pragma unroll
                for (int i = 0; i < 8; ++i) {
                    const int l = 16 * sg + hf * 8 + i;
                    float xc[8]; unpack8f(xin[i], xc);
                    float v[8];
#pragma unroll
                    for (int q = 0; q < 8; ++q) v[q] = silu_f(cb[q] + wt[0][q] * x0[q] + wt[1][q] * x1[q] + wt[2][q] * x2[q] + wt[3][q] * xc[q]);
#pragma unroll
                    for (int q = 0; q < 8; ++q) { x0[q] = x1[q]; x1[q] = x2[q]; x2[q] = xc[q]; }
                    if (o < 32 || (MODE == 0)) {
                        if (MODE == 0 && o < 32) { const float sc = DT[l * 4 + hl] * __expf(sc_end - ACU[l * 4 + hl]);
#pragma unroll
                            for (int q = 0; q < 8; ++q) v[q] *= sc; }
#pragma unroll
                        for (int q = 0; q < 8; ++q) { const unsigned bv = f2bf(v[q]); if (i & 1) tp[q][i >> 1] |= bv << 16; else tp[q][i >> 1] = bv; }
                    } else {
                        const v4u ov = (v4u){pk2(v[0], v[1]), pk2(v[2], v[3]), pk2(v[4], v[5]), pk2(v[6], v[7])};
                        *(LAS v4u*)((o < 40 ? BM : CM) + l * SA64 + (o & 7) * 16) = ov;
                    }
                }
                if (o < 32 || (MODE == 0)) {
                    LAS unsigned char* dst = (o < 32) ? XT + hl * 64 * SA128 + p0 * SA128 : CM + ((o & 7) * 8) * SA128;
#pragma unroll
                    for (int q = 0; q < 8; ++q) *(LAS v4u*)(dst + q * SA128 + (16 * sg + hf * 8) * 2) = (v4u){tp[q][0], tp[q][1], tp[q][2], tp[q][3]};
                }
            }
        }
    }
    __syncthreads();
    const int r = lane & 15, kg = lane >> 4;
    const f32x4 zero = (f32x4){0.f, 0.f, 0.f, 0.f};
    if (MODE == 0) {
        const int hl = w >> 1;
        GAS bf16* st = (GAS bf16*)(A.ws + WS_SST) + ((size_t)((b * 64 + c) * 8 + g * 4 + hl)) * 4096;
#pragma unroll
        for (int mt = 0; mt < 4; ++mt)
#pragma unroll
            for (int n = 0; n < 2; ++n) { const int nt = (w & 1) * 2 + n;
                const f32x4 acc = mma16(CM + mt * 16 * SA128, SA128, XT + hl * 64 * SA128 + nt * 16 * SA128, SA128, 128, zero, r, kg);
                const int p = nt * 16 + r, n0 = mt * 16 + kg * 4;
                *(GAS u32x2*)(st + p * 64 + n0) = (u32x2){pk2(acc[0], acc[1]), pk2(acc[2], acc[3])}; }
    } else {
        f32x4 sc[8];
#pragma unroll
        for (int nt = 0; nt < 8; ++nt) { sc[nt] = zero; if (nt <= w) sc[nt] = mma16(CM + w * 16 * SA64, SA64, BM + nt * 16 * SA64, SA64, 64, zero, r, kg); }
        __syncthreads();
        const GAS bf16* spg = (const GAS bf16*)(A.ws + WS_SST) + ((size_t)((b * 64 + c) * 8 + g * 4)) * 4096;
        for (int e = tid; e < 1024; e += 512) { const int row = e >> 3, ch = e & 7; *(LAS v4u*)(BM + row * SA64 + ch * 16) = *(const GAS v4u*)(spg + row * 64 + ch * 8); }
        __syncthreads();
        float rs[4] = {0.f, 0.f, 0.f, 0.f};
        LAS unsigned char* pw = PW + w * 16 * SA32;
        LAS unsigned char* zw = ZW + w * 16 * SA64;
        const int orow = lane >> 3, och = lane & 7;
        const GAS bf16* zsrc = proj + (t0 + w * 16 + orow) * NINP + C_Z + g * 256 + och * 8;
        v4u ysave[4][2];
#pragma unroll
        for (int hl = 0; hl < 4; ++hl) {
            if (hl == 2) {
                __syncthreads();
                for (int e = tid; e < 1024; e += 512) { const int row = e >> 3, ch = e & 7; *(LAS v4u*)(BM + row * SA64 + ch * 16) = *(const GAS v4u*)(spg + 2 * 4096 + row * 64 + ch * 8); }
                __syncthreads();
            }
            asm volatile("" ::: "memory");
            const v4u z0 = *(const GAS v4u*)(zsrc + hl * 64), z1 = *(const GAS v4u*)(zsrc + (size_t)8 * NINP + hl * 64);
            float acl[4];
#pragma unroll
            for (int ii = 0; ii < 4; ++ii) acl[ii] = ACU[(w * 16 + kg * 4 + ii) * 4 + hl];
            f32x4 yd[4] = {zero, zero, zero, zero};
            const LAS unsigned char* xth = XT + hl * 64 * SA128;
#pragma unroll
            for (int kc = 0; kc < 4; ++kc) {
                if (kc * 2 <= w) {
#pragma unroll
                    for (int half = 0; half < 2; ++half) { const int stl = 2 * kc + half; const int s = stl * 16 + r;
                        const float acs = ACU[s * 4 + hl], dts = DT[s * 4 + hl];
#pragma unroll
                        for (int ii = 0; ii < 4; ++ii) { const int l = w * 16 + kg * 4 + ii;
                            const float pv = (s <= l) ? sc[stl][ii] * __expf(acl[ii] - acs) * dts : 0.f;
                            *(LAS bf16*)(pw + (kg * 4 + ii) * SA32 + (half * 16 + r) * 2) = (bf16)f2bf(pv); } }
                    LDS_WAIT();
                    const bf16x8 a = *(const LAS bf16x8*)(pw + r * SA32 + kg * 16);
#pragma unroll
                    for (int nt = 0; nt < 4; ++nt) { const bf16x8 bb = *(const LAS bf16x8*)(xth + (nt * 16 + r) * SA128 + (kc * 32 + 8 * kg) * 2);
                        yd[nt] = __builtin_amdgcn_mfma_f32_16x16x32_bf16(a, bb, yd[nt], 0, 0, 0); }
                    LDS_WAIT();
                }
            }
            *(LAS v4u*)(zw + orow * SA64 + och * 16) = z0; *(LAS v4u*)(zw + (orow + 8) * SA64 + och * 16) = z1;
            LDS_WAIT();
            const float Dk = A.in[10][g * 4 + hl];
            float eal[4];
#pragma unroll
            for (int ii = 0; ii < 4; ++ii) eal[ii] = __expf(acl[ii]);
#pragma unroll
            for (int nt = 0; nt < 4; ++nt) {
                const f32x4 yo = mma16(CM + w * 16 * SA64, SA64, BM + (hl & 1) * 64 * SA64 + nt * 16 * SA64, SA64, 64, zero, r, kg);
                const int p = nt * 16 + r;
#pragma unroll
                for (int ii = 0; ii < 4; ++ii) { const int l = w * 16 + kg * 4 + ii;
                    const float xv = bf2f(*(const LAS bf16*)(xth + p * SA128 + l * 2));
                    LAS bf16* zp = (LAS bf16*)(zw + (kg * 4 + ii) * SA64 + p * 2);
                    const float y = (yd[nt][ii] + eal[ii] * yo[ii] + xv * Dk) * silu_f(bf2f(*zp));
                    const unsigned short yb = (unsigned short)f2bf(y); const float yq = bf2f(yb);
                    rs[ii] += yq * yq;
                    *zp = yb; }
            }
            LDS_WAIT();
            ysave[hl][0] = *(const LAS v4u*)(zw + orow * SA64 + och * 16); ysave[hl][1] = *(const LAS v4u*)(zw + (orow + 8) * SA64 + och * 16);
            LDS_WAIT();
        }
#pragma unroll
        for (int ii = 0; ii < 4; ++ii) { rs[ii] += __shfl_xor(rs[ii], 1); rs[ii] += __shfl_xor(rs[ii], 2); rs[ii] += __shfl_xor(rs[ii], 4); rs[ii] += __shfl_xor(rs[ii], 8);
            rs[ii] = rsqrtf(rs[ii] * (1.f / 256.f) + EPS); }
        if (r == 0) {
#pragma unroll
            for (int ii = 0; ii < 4; ++ii) RRW[w * 16 + kg * 4 + ii] = rs[ii]; }
        LDS_WAIT();
        const float rr0 = RRW[w * 16 + orow], rr1 = RRW[w * 16 + orow + 8];
        GAS bf16* mdst = (GAS bf16*)(A.ws + WS_XB) + (t0 + w * 16 + orow) * D + 512 + g * 256 + och * 8;
#pragma unroll
        for (int hl = 0; hl < 4; ++hl) {
            const f32x4 nwa = *(const GAS f32x4*)(A.in[11] + g * 256 + hl * 64 + och * 8), nwb = *(const GAS f32x4*)(A.in[11] + g * 256 + hl * 64 + och * 8 + 4);
            const float nw8[8] = {nwa.x, nwa.y, nwa.z, nwa.w, nwb.x, nwb.y, nwb.z, nwb.w};
#pragma unroll
            for (int hh = 0; hh < 2; ++hh) { float f[8]; unpack8f(ysave[hl][hh], f); const float rr_ = hh ? rr1 : rr0;
#pragma unroll
                for (int q = 0; q < 8; ++q) f[q] *= rr_ * nw8[q];
                *(GAS v4u*)(mdst + (size_t)(8 * hh) * D + hl * 64) = (v4u){pk2(f[0], f[1]), pk2(f[2], f[3]), pk2(f[4], f[5]), pk2(f[6], f[7])}; }
        }
    }
    __syncthreads();
}

template <bool DRY> __device__ __forceinline__ void scan_phase(const Frame& F, const Args& A) {
    if (F.tid < 128) {
        GAS unsigned* st = (GAS unsigned*)(A.ws + WS_GST); const GAS float* dec = (const GAS float*)(A.ws + WS_GDEC);
        for (int gi = blockIdx.x * 128 + F.tid; gi < 8 * 4096; gi += F.G * 128) {
            const int bh = gi >> 12, e = gi & 4095, b = bh >> 2, h = bh & 3, d = (e & 31) * 2;
            float S0 = 0.f, S1 = 0.f;
#pragma unroll 1
            for (int c = 0; c < 128; c += 16) {
                unsigned v[16]; float d0[16], d1[16];
#pragma unroll
                for (int u = 0; u < 16; ++u) { const size_t un = (size_t)((b * 128 + c + u) * 4 + h); v[u] = st[un * 4096 + e]; d0[u] = dec[un * 64 + d]; d1[u] = dec[un * 64 + d + 1]; }
#pragma unroll
                for (int u = 0; u < 16; ++u) { const size_t un = (size_t)((b * 128 + c + u) * 4 + h); (DRY ? (GAS unsigned*)(A.ws + 232 * MiB) : st)[un * 4096 + e] = pk2(S0, S1);
                    S0 = d0[u] * S0 + bf2f((unsigned short)(v[u] & 0xffffu)); S1 = d1[u] * S1 + bf2f((unsigned short)(v[u] >> 16)); }
            }
        }
    } else if (F.tid < 256) {
        GAS unsigned* st = (GAS unsigned*)(A.ws + WS_SST); const GAS float* dec = (const GAS float*)(A.ws + WS_SDEC);
        for (int gi = blockIdx.x * 128 + (F.tid - 128); gi < 16 * 2048; gi += F.G * 128) {
            const int bh = gi >> 11, e = gi & 2047, b = bh >> 3, hd = bh & 7;
            float S0 = 0.f, S1 = 0.f;
#pragma unroll 1
            for (int c = 0; c < 64; c += 16) {
                unsigned v[16]; float dd[16];
#pragma unroll
                for (int u = 0; u < 16; ++u) { const size_t un = (size_t)((b * 64 + c + u) * 8 + hd); v[u] = st[un * 2048 + e]; dd[u] = dec[un]; }
#pragma unroll
                for (int u = 0; u < 16; ++u) { const size_t un = (size_t)((b * 64 + c + u) * 8 + hd); (DRY ? (GAS unsigned*)(A.ws + 248 * MiB) : st)[un * 2048 + e] = pk2(S0, S1);
                    S0 = dd[u] * S0 + bf2f((unsigned short)(v[u] & 0xffffu)); S1 = dd[u] * S1 + bf2f((unsigned short)(v[u] >> 16)); }
            }
        }
    }
}
constexpr size_t WS_HB = WS_PROJ;
constexpr size_t WS_Q = 144 * MiB;
constexpr size_t WS_IDX = 232 * MiB;
constexpr size_t WS_GATE = 240 * MiB;
typedef float f32x16 __attribute__((ext_vector_type(16)));
__device__ __forceinline__ float as_f(unsigned u) { return __builtin_bit_cast(float, u); }
__device__ __forceinline__ unsigned as_u(float f) { return __builtin_bit_cast(unsigned, f); }
#define CE_DESC(a, b) do { const float hi_ = fmaxf((a), (b)), lo_ = fminf((a), (b)); (a) = hi_; (b) = lo_; } while (0)
template <int OFF, int N> __device__ __forceinline__ void sort16_desc(float (&v)[N]) {
#pragma unroll
    for (int k = 2; k <= 16; k <<= 1)
#pragma unroll
        for (int j = k >> 1; j > 0; j >>= 1)
#pragma unroll
            for (int i = 0; i < 16; ++i) { const int l = i ^ j; if (l > i) { if ((i & k) == 0) CE_DESC(v[OFF + i], v[OFF + l]); else CE_DESC(v[OFF + l], v[OFF + i]); } }
}
template <int OA, int OB, int NA, int NB> __device__ __forceinline__ void merge16_desc(float (&a)[NA], const float (&b)[NB]) {
#pragma unroll
    for (int i = 0; i < 16; ++i) a[OA + i] = fmaxf(a[OA + i], b[OB + 15 - i]);
#pragma unroll
    for (int j = 8; j > 0; j >>= 1)
#pragma unroll
        for (int i = 0; i < 16; ++i) { const int l = i ^ j; if (l > i) CE_DESC(a[OA + i], a[OA + l]); }
}
constexpr unsigned char CAND0[32] = {0, 2, 4, 6, 8, 10, 12, 14, 16, 18, 20, 22, 32, 34, 36, 49, 51, 65, 80, 96, 112, 128, 160, 192, 224, 255, 255, 255, 255, 255, 255, 255};
constexpr unsigned char CAND1[32] = {1, 3, 5, 7, 9, 11, 13, 15, 17, 19, 21, 23, 33, 35, 48, 50, 64, 66, 81, 97, 113, 144, 176, 208, 240, 255, 255, 255, 255, 255, 255, 255};

__device__ __forceinline__ void topk_wave_job(const Args& A, const LAS unsigned char* SK, LAS unsigned char* TAB, int tok0, int h, int lane) {
    const int r = lane & 31, hi = lane >> 5;
    const GAS bf16* qrow = (const GAS bf16*)(A.ws + WS_Q) + (size_t)(tok0 + r) * NQ + h * 256 + 8 * hi;
    float LST[2][16];
#pragma unroll
    for (int p = 0; p < 2; ++p) {
        __builtin_amdgcn_sched_barrier(0);
        bf16x8 bq[8];
#pragma unroll
        for (int s = 0; s < 8; ++s) bq[s] = *(const GAS bf16x8*)(qrow + p * 128 + 16 * s);
        float v[64];
#pragma unroll
        for (int kt = 0; kt < 4; ++kt) {
            f32x16 acc;
#pragma unroll
            for (int i = 0; i < 16; ++i) acc[i] = 0.f;
#pragma unroll
            for (int s = 0; s < 8; ++s) { const bf16x8 a = *(const LAS bf16x8*)(SK + (p * 128 + kt * 32 + r) * SA128 + (16 * s + 8 * hi) * 2);
                acc = __builtin_amdgcn_mfma_f32_32x32x16_bf16(a, bq[s], acc, 0, 0, 0); }
#pragma unroll
            for (int i = 0; i < 16; ++i) { const unsigned key = (unsigned)(kt * 32 + (i & 3) + 8 * (i >> 2)) | ((unsigned)hi << 2); v[kt * 16 + i] = as_f((as_u(acc[i]) & ~127u) | key); }
        }
        sort16_desc<0>(v); sort16_desc<16>(v); sort16_desc<32>(v); sort16_desc<48>(v);
        merge16_desc<0, 16>(v, v); merge16_desc<32, 48>(v, v); merge16_desc<0, 32>(v, v);
        float o[16];
#pragma unroll
        for (int i = 0; i < 16; ++i) o[i] = __shfl_xor(v[i], 32);
        merge16_desc<0, 0>(v, o);
#pragma unroll
        for (int i = 0; i < 16; ++i) LST[p][i] = v[i];
    }
    __builtin_amdgcn_sched_barrier(0);
    {   unsigned pk[4];
#pragma unroll
        for (int q4 = 0; q4 < 4; ++q4) { unsigned wv = 0;
#pragma unroll
            for (int b = 0; b < 4; ++b) { float l0 = LST[0][q4 * 4 + b], l1 = LST[1][q4 * 4 + b]; asm volatile("" : "+v"(l0), "+v"(l1));
                const unsigned x = as_u(hi ? l1 : l0) & 127u; wv |= x << (8 * b); }
            pk[q4] = wv; }
        *(LAS v4u*)(TAB + r * 32 + hi * 16) = (v4u){pk[0], pk[1], pk[2], pk[3]};
    }
    float c[32];
    float va[16], vb2[16];
#pragma unroll
    for (int i = 0; i < 16; ++i) { va[i] = as_f(as_u(LST[0][i]) & ~127u); vb2[i] = as_f(as_u(LST[1][i]) & ~127u); }
#define CANDV(i0, j0, k0, i1, j1, k1) as_f((as_u(hi ? (va[i1] + vb2[j1]) : (va[i0] + vb2[j0])) & ~255u) | (hi ? (k1) : (k0)))
    c[0] = CANDV(0, 0, 0u, 0, 1, 1u);
    c[1] = CANDV(0, 2, 2u, 0, 3, 3u);
    c[2] = CANDV(0, 4, 4u, 0, 5, 5u);
    c[3] = CANDV(0, 6, 6u, 0, 7, 7u);
    c[4] = CANDV(0, 8, 8u, 0, 9, 9u);
    c[5] = CANDV(0, 10, 10u, 0, 11, 11u);
    c[6] = CANDV(0, 12, 12u, 0, 13, 13u);
    c[7] = CANDV(0, 14, 14u, 0, 15, 15u);
    c[8] = CANDV(1, 0, 16u, 1, 1, 17u);
    c[9] = CANDV(1, 2, 18u, 1, 3, 19u);
    c[10] = CANDV(1, 4, 20u, 1, 5, 21u);
    c[11] = CANDV(1, 6, 22u, 1, 7, 23u);
    c[12] = CANDV(2, 0, 32u, 2, 1, 33u);
    c[13] = CANDV(2, 2, 34u, 2, 3, 35u);
    c[14] = CANDV(2, 4, 36u, 3, 0, 48u);
    c[15] = CANDV(3, 1, 49u, 3, 2, 50u);
    c[16] = CANDV(3, 3, 51u, 4, 0, 64u);
    c[17] = CANDV(4, 1, 65u, 4, 2, 66u);
    c[18] = CANDV(5, 0, 80u, 5, 1, 81u);
    c[19] = CANDV(6, 0, 96u, 6, 1, 97u);
    c[20] = CANDV(7, 0, 112u, 7, 1, 113u);
    c[21] = CANDV(8, 0, 128u, 9, 0, 144u);
    c[22] = CANDV(10, 0, 160u, 11, 0, 176u);
    c[23] = CANDV(12, 0, 192u, 13, 0, 208u);
    c[24] = CANDV(14, 0, 224u, 15, 0, 240u);
    c[25] = as_f(0xFF61B1E6u | 255u);
    c[26] = as_f(0xFF61B1E6u | 255u);
    c[27] = as_f(0xFF61B1E6u | 255u);
    c[28] = as_f(0xFF61B1E6u | 255u);
    c[29] = as_f(0xFF61B1E6u | 255u);
    c[30] = as_f(0xFF61B1E6u | 255u);
    c[31] = as_f(0xFF61B1E6u | 255u);
#undef CANDV
    sort16_desc<0>(c); sort16_desc<16>(c); merge16_desc<0, 16>(c, c);
    {   float o[16];
#pragma unroll
        for (int i = 0; i < 16; ++i) o[i] = __shfl_xor(c[i], 32);
        merge16_desc<0, 0>(c, o); }
    const float mx = as_f(as_u(c[0]) & ~255u);
    float ex[16], den = 0.f;
#pragma unroll
    for (int k = 0; k < 16; ++k) { ex[k] = __expf(as_f(as_u(c[k]) & ~255u) - mx); den += ex[k]; }
    const float inv = 1.f / den;
    LDS_WAIT();
    unsigned eid[8]; float gv[8];
#pragma unroll
    for (int k = 0; k < 8; ++k) { float ca = c[k], cb = c[k + 8], ea = ex[k], eb = ex[k + 8]; asm volatile("" : "+v"(ca), "+v"(cb), "+v"(ea), "+v"(eb));
        const unsigned code = as_u(hi ? cb : ca) & 255u; gv[k] = (hi ? eb : ea) * inv;
        const unsigned ia = *(const LAS unsigned char*)(TAB + r * 32 + (code >> 4)), ib = *(const LAS unsigned char*)(TAB + r * 32 + 16 + (code & 15));
        eid[k] = ia * 128u + ib; }
    GAS unsigned* ip = (GAS unsigned*)(A.ws + WS_IDX) + (size_t)(tok0 + r) * 128 + h * 16 + 8 * hi;
    GAS float* gp = (GAS float*)(A.ws + WS_GATE) + (size_t)(tok0 + r) * 128 + h * 16 + 8 * hi;
    *(GAS v4u*)ip = (v4u){eid[0], eid[1], eid[2], eid[3]}; *(GAS v4u*)(ip + 4) = (v4u){eid[4], eid[5], eid[6], eid[7]};
    *(GAS f32x4*)gp = (f32x4){gv[0], gv[1], gv[2], gv[3]}; *(GAS f32x4*)(gp + 4) = (f32x4){gv[4], gv[5], gv[6], gv[7]};
    LDS_WAIT();
}
__device__ __forceinline__ void topk_phase(const Frame& F, const Args& A) {
    LAS unsigned char* SK = F.lds;
    LAS unsigned char* TABS = F.lds + 256 * SA128;
    for (int unit = blockIdx.x; unit < 256; unit += F.G) {
        int tid = F.tid, w = F.wave;
        asm volatile("" : "+v"(tid)); asm volatile("" : "+s"(w));
        const int h = unit & 7, tb = (unit >> 3) * 512;
        const GAS bf16* sk = (const GAS bf16*)(A.ws + WS_SUBK) + (size_t)h * 2 * 128 * 128;
        for (int e = tid; e < 256 * 16; e += 512) { const int row = e >> 4, ch = e & 15; *(LAS v4u*)(SK + row * SA128 + ch * 16) = *(const GAS v4u*)(sk + row * 128 + ch * 8); }
        __syncthreads();
#pragma unroll 1
        for (int tt = 0; tt < 2; ++tt) topk_wave_job(A, SK, TABS + w * 1024, tb + (w * 2 + tt) * 32, h, tid & 63);
        __syncthreads();
    }
}

__device__ __forceinline__ float gelu_f(float v) {
    const float av = fabsf(v), t = __builtin_amdgcn_rcpf(av * 0.2316418882f + 1.0f);
    float q = t * 0.5307027145f + (-0.7265760135f); q = q * t + 0.7107068705f; q = q * t + (-0.142248368f); q = q * t + 0.127414796f; q = q * t;
    const float m = v * (q * __builtin_amdgcn_exp2f((v * v) * (-0.72134752044f)));
    return v < 0.f ? m : v - m;
}
__device__ __forceinline__ void unpack8(const v4u x, float (&f)[8]) {
    f[0] = as_f(x.x << 16); f[1] = as_f(x.x & 0xffff0000u); f[2] = as_f(x.y << 16); f[3] = as_f(x.y & 0xffff0000u);
    f[4] = as_f(x.z << 16); f[5] = as_f(x.z & 0xffff0000u); f[6] = as_f(x.w << 16); f[7] = as_f(x.w & 0xffff0000u);
}
typedef long lx2 __attribute__((ext_vector_type(2)));
typedef float f32x2 __attribute__((ext_vector_type(2)));
typedef int i32x8 __attribute__((ext_vector_type(8)));
typedef int i32x4 __attribute__((ext_vector_type(4)));
constexpr float U4_SCALE = 48.f, V4_SCALE = 4.25f;
constexpr int MX_ONE = 0x7F7F7F7F;
template <int BY> __device__ __forceinline__ f32x2 cvt_fp4x2(unsigned w) { return __builtin_amdgcn_cvt_scalef32_pk_f32_fp4(w, 1.0f, BY); }
template <int WS> __device__ __forceinline__ f32x2 cvt_fp8x2(int w) { return __builtin_amdgcn_cvt_pk_f32_fp8(w, WS != 0); }
__device__ __forceinline__ unsigned pk4_fp8(float a, float b, float c, float d) { int p = __builtin_amdgcn_cvt_pk_fp8_f32(a, b, 0, false); p = __builtin_amdgcn_cvt_pk_fp8_f32(c, d, p, true); return (unsigned)p; }
template <bool DRY> __device__ __forceinline__ void expert_phase(const Frame& F, const Args& A) {
    int tid = F.tid, w = F.wave;
    asm volatile("" : "+v"(tid)); asm volatile("" : "+s"(w));
    const int lane = tid & 63, r = lane & 15, kg = lane >> 4, half = lane >> 5, sub = lane & 31;
    const int dl = 32 * sub + 16 * half;
    LAS unsigned char* N2 = F.lds + w * 1024;
    const GAS unsigned char* u4 = (const GAS unsigned char*)(A.ws + WS_UB); const GAS unsigned char* v4 = (const GAS unsigned char*)(A.ws + WS_VB);
    const GAS unsigned* idx = (const GAS unsigned*)(A.ws + WS_IDX); const GAS float* gate = (const GAS float*)(A.ws + WS_GATE);
    const GAS float* rowsq = (const GAS float*)(A.ws + WS_ROWSQ2);
#pragma unroll 1
    for (int t = F.gw; t < T; t += F.NGW) {
        GAS float* hrow = (GAS float*)A.out + (size_t)t * D;
        f32x4 hv[4];
        {   const GAS bf16* hb = (const GAS bf16*)(A.ws + WS_HB) + (size_t)t * D + dl;
            float f0[8], f1[8]; unpack8f(*(const GAS v4u*)hb, f0); unpack8f(*(const GAS v4u*)(hb + 8), f1);
            hv[0] = (f32x4){f0[0], f0[1], f0[2], f0[3]}; hv[1] = (f32x4){f0[4], f0[5], f0[6], f0[7]}; hv[2] = (f32x4){f1[0], f1[1], f1[2], f1[3]}; hv[3] = (f32x4){f1[4], f1[5], f1[6], f1[7]}; }
        const float rr = rsqrtf(rowsq[t] * (1.f / 1024.f) + EPS);
        {   v4u pk;
            pk.x = pk4_fp8(hv[0].x * rr, hv[0].y * rr, hv[0].z * rr, hv[0].w * rr); pk.y = pk4_fp8(hv[1].x * rr, hv[1].y * rr, hv[1].z * rr, hv[1].w * rr);
            pk.z = pk4_fp8(hv[2].x * rr, hv[2].y * rr, hv[2].z * rr, hv[2].w * rr); pk.w = pk4_fp8(hv[3].x * rr, hv[3].y * rr, hv[3].z * rr, hv[3].w * rr);
            *(LAS v4u*)(N2 + dl) = pk; }
        unsigned eidx[8]; float gt[8];
#pragma unroll
        for (int eg = 0; eg < 8; ++eg) { eidx[eg] = idx[(size_t)t * 128 + eg * 16 + r]; gt[eg] = gate[(size_t)t * 128 + eg * 16 + r]; }
        LDS_WAIT();
        float actv[8];
        {
            LAS unsigned char* UBw = F.lds + 8192 + w * (2 * 16 * 528);
            v4u xr[8];
#define PU_ROWS(EG) { _Pragma("unroll") for (int j = 0; j < 8; ++j) { const unsigned ea = (unsigned)__builtin_amdgcn_readlane((int)eidx[EG], 2 * j), eb = (unsigned)__builtin_amdgcn_readlane((int)eidx[EG], 2 * j + 1); \
                xr[j] = *(const GAS v4u*)(u4 + (size_t)(half ? eb : ea) * 512 + 16 * sub); } }
            PU_ROWS(0)
#pragma unroll
            for (int eg = 0; eg < 8; ++eg) {
                LAS unsigned char* ub = UBw + (eg & 1) * (16 * 528);
#pragma unroll
                for (int j = 0; j < 8; ++j) *(LAS v4u*)(ub + (2 * j + half) * 528 + 16 * sub) = xr[j];
                if (eg < 7) PU_ROWS(eg + 1)
                __builtin_amdgcn_sched_barrier(0);
                LDS_WAIT();
                f32x4 accg = (f32x4){0.f, 0.f, 0.f, 0.f};
#pragma unroll
                for (int s2 = 0; s2 < 8; ++s2) {
                    const i32x4 a0 = *(const LAS i32x4*)(N2 + 128 * s2 + 16 * kg), a1 = *(const LAS i32x4*)(N2 + 128 * s2 + 64 + 16 * kg);
                    const i32x8 a = (i32x8){a0.x, a0.y, a0.z, a0.w, a1.x, a1.y, a1.z, a1.w};
                    const i32x4 b4 = *(const LAS i32x4*)(ub + r * 528 + 64 * s2 + 16 * kg);
                    const i32x8 b = (i32x8){b4.x, b4.y, b4.z, b4.w, 0, 0, 0, 0};
                    accg = __builtin_amdgcn_mfma_scale_f32_16x16x128_f8f6f4(a, b, accg, 0, 4, 0, MX_ONE, 0, MX_ONE);
                }
                actv[eg] = accg[0];
                __builtin_amdgcn_sched_barrier(0);
            }
#undef PU_ROWS
        }
        bool bad = false;
        if (t == F.gw) {
            float ref = 0.f;
            for (int s = 0; s < 8; ++s) {
                const i32x4 b4 = *(const GAS i32x4*)(u4 + (size_t)eidx[0] * 512 + 64 * s + 16 * kg);
                const int bw[4] = {b4.x, b4.y, b4.z, b4.w};
#pragma unroll
                for (int k = 0; k < 4; ++k) {
                    const lx2 a8 = *(const LAS lx2*)(N2 + 128 * s + 32 * kg + 16 * (k >> 1));
                    const long aw = (k & 1) ? a8.y : a8.x;
                    const int alo = (int)aw, ahi = (int)(aw >> 32);
                    { const f32x2 bf = cvt_fp4x2<0>((unsigned)bw[k]), af = cvt_fp8x2<0>(alo); ref += af.x * bf.x + af.y * bf.y; }
                    { const f32x2 bf = cvt_fp4x2<1>((unsigned)bw[k]), af = cvt_fp8x2<1>(alo); ref += af.x * bf.x + af.y * bf.y; }
                    { const f32x2 bf = cvt_fp4x2<2>((unsigned)bw[k]), af = cvt_fp8x2<0>(ahi); ref += af.x * bf.x + af.y * bf.y; }
                    { const f32x2 bf = cvt_fp4x2<3>((unsigned)bw[k]), af = cvt_fp8x2<1>(ahi); ref += af.x * bf.x + af.y * bf.y; }
                }
            }
            ref += __shfl_xor(ref, 16); ref += __shfl_xor(ref, 32);
            bad = __any(fabsf(ref - actv[0]) > 0.02f * fabsf(ref) + 0.5f);
        }
        float hid[8];
#pragma unroll
        for (int eg = 0; eg < 8; ++eg) hid[eg] = gelu_f(actv[eg] * (1.f / U4_SCALE)) * gt[eg] * (1.f / V4_SCALE);
        f32x2 o2[16];
#pragma unroll
        for (int i = 0; i < 16; ++i) o2[i] = (f32x2){0.f, 0.f};
        v4u xr[2][8]; float shs[2][8];
#define PV_LOAD(EG, BUF) { _Pragma("unroll") for (int pr = 0; pr < 8; ++pr) { \
                const float sha = as_f(__builtin_amdgcn_readlane((int)as_u(hid[EG]), 2 * pr)), shb = as_f(__builtin_amdgcn_readlane((int)as_u(hid[EG]), 2 * pr + 1)); \
                const unsigned sia = (unsigned)__builtin_amdgcn_readlane((int)eidx[EG], 2 * pr), sib = (unsigned)__builtin_amdgcn_readlane((int)eidx[EG], 2 * pr + 1); \
                shs[BUF][pr] = half ? shb : sha; \
                xr[BUF][pr] = *(const GAS v4u*)(v4 + (size_t)(half ? sib : sia) * 512 + 16 * sub); } }
        PV_LOAD(0, 0)
#pragma unroll
        for (int eg = 0; eg < 8; ++eg) {
            if (eg < 7) PV_LOAD(eg + 1, (eg + 1) & 1)
            __builtin_amdgcn_sched_barrier(0);
#pragma unroll
            for (int pr = 0; pr < 8; ++pr) {
                const f32x2 sh2 = (f32x2){shs[eg & 1][pr], shs[eg & 1][pr]};
                const unsigned xw[4] = {xr[eg & 1][pr].x, xr[eg & 1][pr].y, xr[eg & 1][pr].z, xr[eg & 1][pr].w};
#pragma unroll
                for (int k = 0; k < 4; ++k) { o2[4 * k] += sh2 * cvt_fp4x2<0>(xw[k]); o2[4 * k + 1] += sh2 * cvt_fp4x2<1>(xw[k]); o2[4 * k + 2] += sh2 * cvt_fp4x2<2>(xw[k]); o2[4 * k + 3] += sh2 * cvt_fp4x2<3>(xw[k]); }
            }
            __builtin_amdgcn_sched_barrier(0);
        }
#undef PV_LOAD
        float o[16];
#pragma unroll
        for (int i = 0; i < 16; ++i) { o2[i].x += __shfl_xor(o2[i].x, 32); o2[i].y += __shfl_xor(o2[i].y, 32); }
#pragma unroll
        for (int i = 0; i < 8; ++i) { float a0 = o2[i].x, a1 = o2[i].y, b0 = o2[8 + i].x, b1 = o2[8 + i].y; asm volatile("" : "+v"(a0), "+v"(a1), "+v"(b0), "+v"(b1));
            o[2 * i] = half ? b0 : a0; o[2 * i + 1] = half ? b1 : a1; }
        float ss = 0.f; f32x4 h2[4];
        {   const GAS bf16* hb = (const GAS bf16*)(A.ws + WS_HB) + (size_t)t * D + dl;
            float f0[8], f1[8]; unpack8f(*(const GAS v4u*)hb, f0); unpack8f(*(const GAS v4u*)(hb + 8), f1);
            hv[0] = (f32x4){f0[0], f0[1], f0[2], f0[3]}; hv[1] = (f32x4){f0[4], f0[5], f0[6], f0[7]}; hv[2] = (f32x4){f1[0], f1[1], f1[2], f1[3]}; hv[3] = (f32x4){f1[4], f1[5], f1[6], f1[7]}; }
#pragma unroll
        for (int q = 0; q < 4; ++q) { h2[q] = hv[q] + (f32x4){o[4 * q], o[4 * q + 1], o[4 * q + 2], o[4 * q + 3]};
            const f32x4 x = h2[q]; ss += (x.x * x.x + x.y * x.y) + (x.z * x.z + x.w * x.w); }
        ss = wave_sum(ss);
        float r3 = rsqrtf(ss * (1.f / D) + EPS);
#pragma unroll
        for (int q = 0; q < 4; ++q) *(GAS f32x4*)((DRY ? (GAS float*)(A.ws + WS_Q) + (size_t)t * D : hrow) + dl + 4 * q) = h2[q] * r3 * *(const GAS f32x4*)(A.in[18] + dl + 4 * q);
    }
}
__device__ __forceinline__ void p0_transpose_item(const float* W, const float* kscale, int K, int N, bf16* WT, LAS float* scr, int item, int lane) {
    const int nblk = (N + 31) / 32, kb = item / nblk, nb = item % nblk, k0 = 64 * kb, n0 = 32 * nb;
    const int nn = n0 + (lane & 31); const bool ok = nn < N;
    (void)nn; (void)ok;
    {   const int c4 = lane & 7, kr = lane >> 3; const bool okc = n0 + 4 * c4 < N;
        f32x4 v[8];
#pragma unroll
        for (int i = 0; i < 8; ++i) v[i] = okc ? *(const GAS f32x4*)(W + (size_t)(k0 + 8 * i + kr) * N + n0 + 4 * c4) : (f32x4){0.f, 0.f, 0.f, 0.f};
#pragma unroll
        for (int i = 0; i < 8; ++i) { const int kk = 8 * i + kr; const float sc = kscale ? kscale[k0 + kk] : 1.f; LAS float* d = scr + kk * 33 + 4 * c4;
            d[0] = v[i].x * sc; d[1] = v[i].y * sc; d[2] = v[i].z * sc; d[3] = v[i].w * sc; } }
    LDS_WAIT(); asm volatile("" ::: "memory");
    const int c = lane & 7;
#pragma unroll
    for (int j = 0; j < 4; ++j) { const int n = (lane >> 3) + 8 * j; const LAS float* s = scr + (8 * c) * 33 + n;
        v4u o; o.x = pk2(s[0 * 33], s[1 * 33]); o.y = pk2(s[2 * 33], s[3 * 33]); o.z = pk2(s[4 * 33], s[5 * 33]); o.w = pk2(s[6 * 33], s[7 * 33]);
        *(GAS v4u*)(WT + (size_t)(n0 + n) * K + k0 + 8 * c) = o; }
    LDS_WAIT(); asm volatile("" ::: "memory");
}
__device__ __forceinline__ void p0_convert(const Frame& F, const float* src, bf16* dst, size_t n) {
    for (size_t i = ((size_t)F.gw * 64 + F.lane) * 8; i < n; i += (size_t)F.NGW * 512) {
        const f32x4 a = *(const GAS f32x4*)(src + i), b = *(const GAS f32x4*)(src + i + 4);
        v4u o; o.x = pk2(a.x, a.y); o.y = pk2(a.z, a.w); o.z = pk2(b.x, b.y); o.w = pk2(b.z, b.w);
        *(GAS v4u*)(dst + i) = o;
    }
}
__device__ __forceinline__ void p0_convert_fp4(const Frame& F, int wk, int nwk, const float* src, unsigned char* dst, size_t n, float scale, const float* colscale) {
#pragma unroll 4
    for (size_t i = ((size_t)wk * 64 + F.lane) * 32; i < n; i += (size_t)nwk * 2048) {
        unsigned ow[4];
#pragma unroll
        for (int q = 0; q < 4; ++q) {
            f32x4 a = *(const GAS f32x4*)(src + i + 8 * q) * scale, b = *(const GAS f32x4*)(src + i + 8 * q + 4) * scale;
            if (colscale) { a = a * *(const GAS f32x4*)(colscale + ((i + 8 * q) & 1023)); b = b * *(const GAS f32x4*)(colscale + ((i + 8 * q + 4) & 1023)); }
            unsigned pk = 0;
            pk = __builtin_amdgcn_cvt_scalef32_pk_fp4_f32(pk, a.x, a.y, 1.0f, 0); pk = __builtin_amdgcn_cvt_scalef32_pk_fp4_f32(pk, a.z, a.w, 1.0f, 1);
            pk = __builtin_amdgcn_cvt_scalef32_pk_fp4_f32(pk, b.x, b.y, 1.0f, 2); pk = __builtin_amdgcn_cvt_scalef32_pk_fp4_f32(pk, b.z, b.w, 1.0f, 3);
            ow[q] = pk; }
        *(GAS v4u*)(dst + (i >> 1)) = (v4u){ow[0], ow[1], ow[2], ow[3]};
    }
}
__device__ __forceinline__ void p0_prologue(const Frame& F, const Args& A) {
    unsigned char* ws = A.ws;
    LAS float* scr = (LAS float*)(F.lds + RING_OFF + F.wave * 16384);
    constexpr int I_IN = (D / 64) * ((NIN + 31) / 32), I_O = (D / 64) * (D / 32), I_Q = (D / 64) * (NQ / 32);
    for (int it = F.gw; it < I_IN + I_O + I_Q; it += F.NGW) {
        int r = it;
        if (r < I_IN) { p0_transpose_item(A.in[2], A.in[1], D, NIN, (bf16*)(ws + WS_WIN), scr, r, F.lane); continue; } r -= I_IN;
        if (r < I_O) { p0_transpose_item(A.in[12], nullptr, D, D, (bf16*)(ws + WS_WO), scr, r, F.lane); continue; } r -= I_O;
        p0_transpose_item(A.in[14], A.in[13], D, NQ, (bf16*)(ws + WS_WQ), scr, r, F.lane);
    }
    for (int m0 = F.gw * 4; m0 < T; m0 += F.NGW * 4) {
        f32x4 v[4][4]; float s[4] = {0.f, 0.f, 0.f, 0.f};
#pragma unroll
        for (int u = 0; u < 4; ++u) { const GAS f32x4* xr = (const GAS f32x4*)(A.in[0] + (size_t)(m0 + u) * D) + F.lane;
#pragma unroll
            for (int j = 0; j < 4; ++j) v[u][j] = xr[64 * j]; }
#pragma unroll
        for (int u = 0; u < 4; ++u) {
#pragma unroll
            for (int j = 0; j < 4; ++j) s[u] += (v[u][j].x * v[u][j].x + v[u][j].y * v[u][j].y) + (v[u][j].z * v[u][j].z + v[u][j].w * v[u][j].w);
            GAS unsigned long long* o8 = (GAS unsigned long long*)((bf16*)(ws + WS_XB) + (size_t)(m0 + u) * D) + F.lane;
#pragma unroll
            for (int j = 0; j < 4; ++j) o8[64 * j] = (unsigned long long)pk2(v[u][j].x, v[u][j].y) | ((unsigned long long)pk2(v[u][j].z, v[u][j].w) << 32); }
#pragma unroll
        for (int u = 0; u < 4; ++u) s[u] = wave_sum(s[u]);
        if (F.lane < 4) { const float sv = F.lane == 0 ? s[0] : (F.lane == 1 ? s[1] : (F.lane == 2 ? s[2] : s[3])); ((float*)(ws + WS_RRMS1))[m0 + F.lane] = rsqrtf(sv * (1.f / D) + EPS); ((float*)(ws + WS_ROWSQ2))[m0 + F.lane] = 0.f; }
    }
    p0_convert(F, A.in[15], (bf16*)(ws + WS_SUBK), (size_t)8 * 2 * 128 * 128);
    p0_convert_fp4(F, F.gw, F.NGW, A.in[16], ws + WS_UB, (size_t)16384 * 1024, 48.f, A.in[13]);
    p0_convert_fp4(F, F.gw, F.NGW, A.in[17], ws + WS_VB, (size_t)16384 * 1024, 4.25f, nullptr);
}

#ifndef PROBE_MASK
#define PROBE_MASK 0
#endif
__device__ __forceinline__ int probe_reps(int k) { int n = ((PROBE_MASK >> k) & 1) + 1; return n; }
__global__ void __launch_bounds__(NWAVES * 64, 2) fwd(Args args) {
    extern __shared__ __attribute__((aligned(16))) unsigned char lds[];
    Frame F;
    F.lds = (LAS unsigned char*)lds;
    F.MISC = (volatile LAS unsigned*)(F.lds + MISC_OFF);
    F.tid = threadIdx.x; F.lane = F.tid & 63; F.wave = __builtin_amdgcn_readfirstlane(F.tid >> 6);
    F.G = gridDim.x; F.gw = blockIdx.x * NWAVES + F.wave; F.NGW = F.G * NWAVES;
    unsigned char* ws = args.ws;
    F.ctl = (gu32*)(ws + WS_CTL);
    for (int u = F.tid; u < (LDS_BYTES - LDSCTL_OFF) / 4; u += NWAVES * 64) ((LAS unsigned*)(F.lds + LDSCTL_OFF))[u] = 0u;
    __syncthreads();
    XcdBarrier bar = xcd_barrier_post((unsigned*)(F.ctl + CW_BAR), F.MISC + 8);
    const int lo = args.ph_lo, hi = args.ph_hi;
#define IN(k) (lo <= (k) && (k) < hi)
#define BOTH(k) (IN(k) && IN((k) + 1))
#define GRID_BAR() xcd_barrier(bar)
#define REP(k) for (int rep_ = 0, nrep_ = probe_reps(k); rep_ < nrep_; ++rep_)

    if (IN(0)) REP(0) { p0_prologue(F, args); if (BOTH(0)) GRID_BAR(); }
    if (IN(1)) REP(1) {
        pg8::Gemm g{(const bf16*)(ws + WS_XB), (const bf16*)(ws + WS_WIN), T, NINP, D}; pg8::StaticOrder S; S.init(T, NINP, F.G, (int)blockIdx.x);
        pg8::EpiRowScaleBf16 E{(bf16*)(ws + WS_PROJ), NINP, (const float*)(ws + WS_RRMS1)};
        pg8::gemm_phase<pg8::EpiRowScaleBf16, pg8::StaticOrder, true, true>(F.lds + RING_OFF, g, S, E);
        if (BOTH(1)) GRID_BAR();
    }
    if (IN(2)) {
        REP(2) { for (int u = blockIdx.x; u < 256; u += F.G) ssd_unit<0>(F, args, u); }
        REP(13) { for (int u = blockIdx.x; u < 1024; u += F.G) gla_unit<0>(F, args, u); }
        if (BOTH(2)) GRID_BAR();
    }
    if (IN(3)) { if ((PROBE_MASK >> 3) & 1) { scan_phase<true>(F, args); GRID_BAR(); } scan_phase<false>(F, args); if (BOTH(3)) GRID_BAR(); }
    if (IN(4)) {
        REP(4) { for (int u = blockIdx.x; u < 256; u += F.G) ssd_unit<1>(F, args, u); }
        REP(12) { for (int u = blockIdx.x; u < 1024; u += F.G) gla_unit<1>(F, args, u); }
        if (BOTH(4)) GRID_BAR();
    }
    if (IN(5)) {
        pg8::Gemm g{(const bf16*)(ws + WS_XB), (const bf16*)(ws + WS_WO), T, D, D}; pg8::StaticOrder S; S.init(T, D, F.G, (int)blockIdx.x);
        if ((PROBE_MASK >> 5) & 1) { pg8::EpiResidual Ed{args.in[0], nullptr, (bf16*)(ws + 208 * MiB), (float*)(ws + 240 * MiB), D};
            pg8::gemm_phase<pg8::EpiResidual, pg8::StaticOrder, true, true>(F.lds + RING_OFF, g, S, Ed); GRID_BAR(); }
        pg8::EpiResidual E{args.in[0], nullptr, (bf16*)(ws + WS_HB), (float*)(ws + WS_ROWSQ2), D};
        pg8::gemm_phase<pg8::EpiResidual, pg8::StaticOrder, true, true>(F.lds + RING_OFF, g, S, E);
        if (BOTH(5)) GRID_BAR();
    }
    if (IN(6)) REP(6) {
        pg8::Gemm g{(const bf16*)(ws + WS_HB), (const bf16*)(ws + WS_WQ), T, NQ, D}; pg8::StaticOrder S; S.init(T, NQ, F.G, (int)blockIdx.x);
        pg8::EpiRsqScaleBf16 E{(bf16*)(ws + WS_Q), NQ, (const float*)(ws + WS_ROWSQ2)};
        pg8::gemm_phase<pg8::EpiRsqScaleBf16, pg8::StaticOrder, true, true>(F.lds + RING_OFF, g, S, E);
        if (BOTH(6)) GRID_BAR();
    }
    if (IN(7)) REP(7) { topk_phase(F, args); if (BOTH(7)) GRID_BAR(); }
    if (IN(8)) { if ((PROBE_MASK >> 8) & 1) { expert_phase<true>(F, args); GRID_BAR(); } expert_phase<false>(F, args); }
#undef IN
#undef BOTH
}
namespace nv {
struct ProjF32 { const float* p; __device__ __forceinline__ float operator()(size_t row, int c) const { return p[row * NIN + c]; } };
struct ProjBf { const unsigned short* p; __device__ __forceinline__ float operator()(size_t row, int c) const { return bf2f(p[row * NINP + c]); } };
__device__ __forceinline__ float silu_f(float x) { return x / (1.f + expf(-x)); }
__device__ __forceinline__ float softplus_f(float x) { return fmaxf(x, 0.f) + log1pf(expf(-fabsf(x))); }
__device__ __forceinline__ float logsigmoid_f(float x) { return fminf(x, 0.f) - log1pf(expf(-fabsf(x))); }
__device__ __forceinline__ float gelu_f(float x) { return 0.5f * x * (1.f + erff(x * 0.70710678118654752f)); }

__global__ void __launch_bounds__(256) k_rmsnorm(const float* __restrict__ x, const float* __restrict__ w, float* __restrict__ out) {
    const int row = blockIdx.x * 4 + (threadIdx.x >> 6), lane = threadIdx.x & 63;
    const float4* xr = (const float4*)(x + (size_t)row * D);
    float4 v[4]; float s = 0.f;
#pragma unroll
    for (int j = 0; j < 4; ++j) { v[j] = xr[lane + 64 * j]; s += v[j].x * v[j].x + v[j].y * v[j].y + v[j].z * v[j].z + v[j].w * v[j].w; }
    s = wave_sum(s);
    const float r = rsqrtf(s * (1.f / D) + EPS);
    float4* o = (float4*)(out + (size_t)row * D);
#pragma unroll
    for (int j = 0; j < 4; ++j) { const float4 ww = ((const float4*)w)[lane + 64 * j]; float4 y; y.x = v[j].x * r * ww.x; y.y = v[j].y * r * ww.y; y.z = v[j].z * r * ww.z; y.w = v[j].w * r * ww.w; o[lane + 64 * j] = y; }
}

template <bool ADD>
__global__ void __launch_bounds__(256) k_gemm(const float* __restrict__ A, const float* __restrict__ B, const float* __restrict__ R, float* __restrict__ C, int M, int N, int K, int ldb) {
    __shared__ float As[16][68];
    __shared__ float Bs[16][68];
    const int tid = threadIdx.x, tx = tid & 15, ty = tid >> 4;
    const int row0 = blockIdx.y * 64, col0 = blockIdx.x * 64;
    float acc[4][4];
#pragma unroll
    for (int i = 0; i < 4; ++i)
#pragma unroll
        for (int j = 0; j < 4; ++j) acc[i][j] = 0.f;
    const int ar = tid >> 2, akq = tid & 3;
    const int bk = tid >> 4, bn = (tid & 15) * 4;
    for (int k0 = 0; k0 < K; k0 += 16) {
        const float4 av = *(const float4*)(A + (size_t)(row0 + ar) * K + k0 + akq * 4);
        float4 bv = make_float4(0.f, 0.f, 0.f, 0.f);
        if (col0 + bn < N) bv = *(const float4*)(B + (size_t)(k0 + bk) * ldb + col0 + bn);
        __syncthreads();
        As[akq * 4 + 0][ar] = av.x; As[akq * 4 + 1][ar] = av.y; As[akq * 4 + 2][ar] = av.z; As[akq * 4 + 3][ar] = av.w;
        *(float4*)&Bs[bk][bn] = bv;
        __syncthreads();
#pragma unroll
        for (int kk = 0; kk < 16; ++kk) {
            const float4 a = *(const float4*)&As[kk][ty * 4];
            const float4 b = *(const float4*)&Bs[kk][tx * 4];
            const float aa[4] = {a.x, a.y, a.z, a.w}, bb[4] = {b.x, b.y, b.z, b.w};
#pragma unroll
            for (int i = 0; i < 4; ++i)
#pragma unroll
                for (int j = 0; j < 4; ++j) acc[i][j] += aa[i] * bb[j];
        }
    }
    if (col0 + tx * 4 < N) {
#pragma unroll
        for (int i = 0; i < 4; ++i) {
            const size_t off = (size_t)(row0 + ty * 4 + i) * N + col0 + tx * 4;
            float4 o = make_float4(acc[i][0], acc[i][1], acc[i][2], acc[i][3]);
            if (ADD) { const float4 r = *(const float4*)(R + off); o.x += r.x; o.y += r.y; o.z += r.z; o.w += r.w; }
            *(float4*)(C + off) = o;
        }
    }
}

template <class P> __global__ void __launch_bounds__(256) k_gla_gate(const P proj, const float* __restrict__ w2, const float* __restrict__ bg, float* __restrict__ alpha) {
    const int t = blockIdx.x, c = threadIdx.x;
    float acc = bg[c];
#pragma unroll
    for (int r = 0; r < 16; ++r) acc += proj((size_t)t, C_GLR + r) * w2[r * 256 + c];
    alpha[(size_t)t * 256 + c] = expf(logsigmoid_f(acc) * (1.f / 16.f));
}

template <class P> __global__ void __launch_bounds__(128) k_gla_rec(const P proj, const float* __restrict__ alpha, float* __restrict__ mixed) {
    const int b = blockIdx.x >> 2, h = blockIdx.x & 3, dv = threadIdx.x;
    float S[64];
#pragma unroll
    for (int d = 0; d < 64; ++d) S[d] = 0.f;
    for (int t = 0; t < SEQ; ++t) {
        const size_t row = (size_t)b * SEQ + t;
        const float* al = alpha + row * 256 + h * 64;
        const float v = proj(row, C_V + h * 128 + dv);
        float o = 0.f;
#pragma unroll
        for (int d = 0; d < 64; ++d) {
            S[d] = al[d] * S[d] + proj(row, C_K + h * 64 + d) * v;
            o += proj(row, C_Q + h * 64 + d) * S[d];
        }
        mixed[row * D + h * 128 + dv] = o * 0.125f;
    }
}

template <class P> __global__ void __launch_bounds__(256) k_gla_finish(const P proj, const float* __restrict__ nw, float* __restrict__ mixed) {
    const int t = blockIdx.x, h = threadIdx.x >> 6, lane = threadIdx.x & 63;
    float* m = mixed + (size_t)t * D + h * 128;
    const float a = m[lane], b = m[lane + 64];
    const float s = wave_sum(a * a + b * b);
    const float r = rsqrtf(s * (1.f / 128.f) + EPS);
    m[lane] = a * r * nw[lane] * silu_f(proj((size_t)t, C_GOUT + h * 128 + lane));
    m[lane + 64] = b * r * nw[lane + 64] * silu_f(proj((size_t)t, C_GOUT + h * 128 + lane + 64));
}

template <class P> __global__ void __launch_bounds__(256) k_ssd_conv(const P proj, const float* __restrict__ cw, const float* __restrict__ cb, const float* __restrict__ dtb,
                                                  float* __restrict__ xc, float* __restrict__ dt) {
    const int t = blockIdx.x, l = t & (SEQ - 1);
    for (int c = threadIdx.x; c < 768; c += 256) {
        float acc = cb[c];
#pragma unroll
        for (int j = 0; j < 4; ++j) { const int ll = l - 3 + j; if (ll >= 0) acc += cw[j * 768 + c] * proj((size_t)(t - 3 + j), C_XBC + c); }
        xc[(size_t)t * 768 + c] = silu_f(acc);
    }
    if (threadIdx.x < 8) dt[(size_t)t * 8 + threadIdx.x] = softplus_f(proj((size_t)t, C_DT + threadIdx.x) + dtb[threadIdx.x]);
}

__global__ void __launch_bounds__(64) k_ssd_rec(const float* __restrict__ xc, const float* __restrict__ dt, const float* __restrict__ a_log, const float* __restrict__ dsk, float* __restrict__ mixed) {
    const int b = blockIdx.x >> 3, hd = blockIdx.x & 7, g = hd >> 2, p = threadIdx.x;
    const float A = -expf(a_log[hd]), Dk = dsk[hd];
    float hs[64];
#pragma unroll
    for (int n = 0; n < 64; ++n) hs[n] = 0.f;
    for (int t = 0; t < SEQ; ++t) {
        const size_t row = (size_t)b * SEQ + t;
        const float dtv = dt[row * 8 + hd];
        const float dA = expf(dtv * A);
        const float* xr = xc + row * 768;
        const float x = xr[hd * 64 + p], xdt = x * dtv;
        float y = 0.f;
#pragma unroll
        for (int n = 0; n < 64; ++n) {
            hs[n] = dA * hs[n] + xr[512 + g * 64 + n] * xdt;
            y += xr[640 + g * 64 + n] * hs[n];
        }
        mixed[row * D + 512 + hd * 64 + p] = y + x * Dk;
    }
}

template <class P> __global__ void __launch_bounds__(128) k_ssd_finish(const P proj, const float* __restrict__ nw, float* __restrict__ mixed) {
    const int t = blockIdx.x, g = threadIdx.x >> 6, lane = threadIdx.x & 63;
    float* m = mixed + (size_t)t * D + 512 + g * 256;
    float y[4]; float s = 0.f;
#pragma unroll
    for (int j = 0; j < 4; ++j) { y[j] = m[lane + 64 * j] * silu_f(proj((size_t)t, C_Z + g * 256 + lane + 64 * j)); s += y[j] * y[j]; }
    s = wave_sum(s);
    const float r = rsqrtf(s * (1.f / 256.f) + EPS);
#pragma unroll
    for (int j = 0; j < 4; ++j) m[lane + 64 * j] = y[j] * r * nw[g * 256 + lane + 64 * j];
}

__global__ void __launch_bounds__(256) k_topk(const float* __restrict__ q_lo, const float* __restrict__ q_hi, const float* __restrict__ subk, int* __restrict__ idx, float* __restrict__ gate) {
    __shared__ float s[256];
    __shared__ float ts[2][16];
    __shared__ int ti[2][16];
    __shared__ float cs[256];
    __shared__ float bs[16];
    __shared__ int be[16];
    const int t = blockIdx.x >> 3, h = blockIdx.x & 7, tid = threadIdx.x, p = tid >> 7, k = tid & 127;
    const float4* qv = (const float4*)((h < 4 ? q_lo : q_hi) + (size_t)t * 1024 + (h & 3) * 256 + p * 128);
    const float4* kr = (const float4*)(subk + (((size_t)h * 2 + p) * 128 + k) * 128);
    float acc = 0.f;
#pragma unroll 8
    for (int d = 0; d < 32; ++d) { const float4 a = qv[d], b = kr[d]; acc += a.x * b.x + a.y * b.y + a.z * b.z + a.w * b.w; }
    s[tid] = acc;
    __syncthreads();
    int r = 0;
    for (int j = 0; j < 128; ++j) { const float o = s[p * 128 + j]; r += (o > acc || (o == acc && j < k)) ? 1 : 0; }
    if (r < 16) { ts[p][r] = acc; ti[p][r] = k; }
    __syncthreads();
    const int i = tid >> 4, j2 = tid & 15;
    const float c = ts[0][i] + ts[1][j2];
    cs[tid] = c;
    __syncthreads();
    r = 0;
    for (int m = 0; m < 256; ++m) { const float o = cs[m]; r += (o > c || (o == c && m < tid)) ? 1 : 0; }
    if (r < 16) { bs[r] = c; be[r] = ti[0][i] * 128 + ti[1][j2]; }
    __syncthreads();
    if (tid < 16) {
        const float mx = bs[0];
        float den = 0.f;
#pragma unroll
        for (int m = 0; m < 16; ++m) den += expf(bs[m] - mx);
        gate[(size_t)t * 128 + h * 16 + tid] = expf(bs[tid] - mx) / den;
        idx[(size_t)t * 128 + h * 16 + tid] = be[tid];
    }
}

__global__ void __launch_bounds__(256) k_expert(const float* __restrict__ hres, const float* __restrict__ u, const float* __restrict__ v, const int* __restrict__ idx, const float* __restrict__ gate,
                                                const float* __restrict__ nfw, float* out) {
    __shared__ float hid[128];
    __shared__ int eid[128];
    __shared__ float red[4];
    const int t = blockIdx.x, tid = threadIdx.x, w = tid >> 6, lane = tid & 63;
    if (tid < 128) eid[tid] = idx[(size_t)t * 128 + tid];
    float4 xv[4];
#pragma unroll
    for (int j = 0; j < 4; ++j) xv[j] = ((const float4*)(out + (size_t)t * D))[lane + 64 * j];
    __syncthreads();
    for (int e = w * 32; e < w * 32 + 32; ++e) {
        const float4* ur = (const float4*)(u + (size_t)eid[e] * D);
        float s = 0.f;
#pragma unroll
        for (int j = 0; j < 4; ++j) { const float4 a = ur[lane + 64 * j]; s += a.x * xv[j].x + a.y * xv[j].y + a.z * xv[j].z + a.w * xv[j].w; }
        s = wave_sum(s);
        if (lane == 0) hid[e] = gelu_f(s) * gate[(size_t)t * 128 + e];
    }
    __syncthreads();
    float4 acc = ((const float4*)(hres + (size_t)t * D))[tid];
    for (int e = 0; e < 128; ++e) {
        const float4 vv = ((const float4*)(v + (size_t)eid[e] * D))[tid];
        const float hh = hid[e];
        acc.x += hh * vv.x; acc.y += hh * vv.y; acc.z += hh * vv.z; acc.w += hh * vv.w;
    }
    float ss = acc.x * acc.x + acc.y * acc.y + acc.z * acc.z + acc.w * acc.w;
    ss = wave_sum(ss);
    if (lane == 0) red[w] = ss;
    __syncthreads();
    const float tot = red[0] + red[1] + red[2] + red[3];
    const float r = rsqrtf(tot * (1.f / D) + EPS);
    const float4 ww = ((const float4*)nfw)[tid];
    float4 o; o.x = acc.x * r * ww.x; o.y = acc.y * r * ww.y; o.z = acc.z * r * ww.z; o.w = acc.w * r * ww.w;
    ((float4*)(out + (size_t)t * D))[tid] = o;
}
__global__ void __launch_bounds__(256) k_bf2f(const unsigned short* __restrict__ src, float* __restrict__ dst, size_t n) {
    for (size_t i = (size_t)blockIdx.x * 256 + threadIdx.x; i < n; i += (size_t)gridDim.x * 256) dst[i] = bf2f(src[i]);
}
}
extern "C" void kernel_launch(void* const* d_in, const int* in_sizes, int n_in, void* d_out, int out_size, void* d_ws, size_t ws_size, hipStream_t stream) {
    static int grid = 0;
    if (grid == 0) {
        if (n_in != 19 || out_size != T * D || ws_size < 256 * MiB) { fprintf(stderr, "kernel_launch: unexpected shapes n_in %d out %d ws %zu\n", n_in, out_size, ws_size); grid = -1; return; }
        int dev = 0, cus = 0, per_cu = 0;
        if (hipGetDevice(&dev) != hipSuccess || hipDeviceGetAttribute(&cus, hipDeviceAttributeMultiprocessorCount, dev) != hipSuccess) { grid = -1; return; }
        if (hipFuncSetAttribute((const void*)fwd, hipFuncAttributeMaxDynamicSharedMemorySize, LDS_BYTES) != hipSuccess) { fprintf(stderr, "kernel_launch: hipFuncSetAttribute failed\n"); grid = -1; return; }
        if (hipOccupancyMaxActiveBlocksPerMultiprocessor(&per_cu, (const void*)fwd, NWAVES * 64, LDS_BYTES) != hipSuccess || per_cu < 1) { fprintf(stderr, "kernel_launch: occupancy query says %d\n", per_cu); }
        (void)hipGetLastError();
        grid = cus;
    }
    if (grid < 0) return;
    const float* x = (const float*)d_in[0];
    const float* gla_w2 = (const float*)d_in[3];
    const float* gla_bg = (const float*)d_in[4];
    const float* gla_nw = (const float*)d_in[5];
    const float* conv_w = (const float*)d_in[6];
    const float* conv_b = (const float*)d_in[7];
    const float* dt_bias = (const float*)d_in[8];
    const float* a_log = (const float*)d_in[9];
    const float* d_skip = (const float*)d_in[10];
    const float* ssd_nw = (const float*)d_in[11];
    const float* w_out = (const float*)d_in[12];
    const float* norm_ffn_w = (const float*)d_in[13];
    const float* w_query = (const float*)d_in[14];
    const float* sub_keys = (const float*)d_in[15];
    const float* pu = (const float*)d_in[16];
    const float* pv = (const float*)d_in[17];
    const float* norm_final_w = (const float*)d_in[18];
    float* out = (float*)d_out;
    char* ws = (char*)d_ws;

    (void)hipMemsetAsync(ws + WS_CTL, 0, CTL_ZERO_BYTES, stream);
    Args a{};
    for (int i = 0; i < 19; ++i) a.in[i] = (const float*)d_in[i];
    a.out = out; a.ws = (unsigned char*)d_ws; a.ph_lo = 0; a.ph_hi = 9;
    hipLaunchKernelGGL(fwd, dim3(grid), dim3(NWAVES * 64), LDS_BYTES, stream, a);

}
```

```cpp
#include <hip/hip_runtime.h>
#include <cstdio>
#include <cstdint>
namespace pg8 {
#define PG8_LAS __attribute__((address_space(3)))
typedef unsigned short bf16_t;
typedef short bf16x8 __attribute__((ext_vector_type(8)));
typedef float f32x4 __attribute__((ext_vector_type(4)));
typedef unsigned u32x4 __attribute__((ext_vector_type(4)));
constexpr int BM = 256, BK = 64, HALF = 128, HTB = HALF * BK * 2  , STAGE_BYTES = 8 * HTB, NXCD = 8, WGM = 8;

__host__ __device__ __forceinline__ int lds_byte(int r, int c) { const int st = (r >> 4) * 2 + (c >> 5), rr = r & 15, cc = c & 31, ob = rr * 64 + cc * 2; return st * 1024 + (ob ^ (((ob >> 9) & 1) << 5)); }
__host__ __device__ __forceinline__ void stage_rc(int b, int& R, int& C) { const int st = b / 1024, sb = b % 1024, swz = sb ^ (((sb >> 9) & 1) << 5); R = (st >> 1) * 16 + swz / 64; C = (st & 1) * 32 + (swz % 64) / 2; }
__host__ __device__ __forceinline__ int perm32(int rho) { const int n = rho >> 4, i = rho & 15; return 8 * (i >> 2) + 4 * n + (i & 3); }

struct Unit { int pm, pn; };
struct Gemm { const bf16_t* A; const bf16_t* Bt; int M, N, K; };

struct StaticOrder {
    int nM, nN, nwg, G, c;
    __host__ __device__ void init(int M, int N, int G_, int c_) { nM = M / BM; nN = N / BM; nwg = nM * nN; G = G_; c = c_; }
    __host__ __device__ bool next(int i, Unit& u) const {
        const long L = (long)i * G + c; if (L >= nwg) return false;
        int wgid = (int)L; { const int q = nwg / NXCD, r = nwg % NXCD, xcd = wgid % NXCD, off = wgid / NXCD; wgid = (xcd < r ? xcd * (q + 1) : r * (q + 1) + (xcd - r) * q) + off; }
        const int nig = WGM * nN, gid = wgid / nig, fm = gid * WGM, gsz = (nM - fm) < WGM ? (nM - fm) : WGM;
        u.pm = fm + ((wgid % nig) % gsz); u.pn = (wgid % nig) / gsz; return true;
    }
    __device__ __forceinline__ void a_ready(const Unit&) const {}
    __device__ __forceinline__ void done(const Unit&) const {}
};

__device__ __forceinline__ unsigned cvt_pk_bf16(float lo, float hi) { unsigned r; asm volatile("v_cvt_pk_bf16_f32 %0, %1, %2" : "=v"(r) : "v"(lo), "v"(hi)); return r; }
typedef float f32x2 __attribute__((ext_vector_type(2)));
struct EpiRowScaleBf16 {
    static constexpr bool PERM = true, AFTER_DRAIN = false;
    bf16_t* O; int ldc; const float* rs;
    __device__ __forceinline__ void operator()(const f32x4 (&acc)[2][2][4][2], const Unit& u, int wr, int wc, int fr, int fq) const {
        const int row0 = u.pm * BM + wr * 64 + fr, col0 = u.pn * BM + wc * 32 + 8 * fq;
#pragma unroll
        for (int ai = 0; ai < 2; ++ai)
#pragma unroll
            for (int m = 0; m < 4; ++m) { const int row = row0 + ai * HALF + m * 16; const float sc = rs[row]; bf16_t* rowp = O + (size_t)row * ldc + col0;
#pragma unroll
                for (int bj = 0; bj < 2; ++bj) { const f32x4 v0 = acc[ai][bj][m][0] * sc, v1 = acc[ai][bj][m][1] * sc;
                    u32x4 w; w.x = cvt_pk_bf16(v0[0], v0[1]); w.y = cvt_pk_bf16(v0[2], v0[3]); w.z = cvt_pk_bf16(v1[0], v1[1]); w.w = cvt_pk_bf16(v1[2], v1[3]);
                    *(u32x4*)(rowp + bj * HALF) = w; } }
    }
};
struct EpiRsqScaleBf16 {
    static constexpr bool PERM = true, AFTER_DRAIN = false;
    bf16_t* O; int ldc; const float* rowsq;
    __device__ __forceinline__ void operator()(const f32x4 (&acc)[2][2][4][2], const Unit& u, int wr, int wc, int fr, int fq) const {
        const int row0 = u.pm * BM + wr * 64 + fr, col0 = u.pn * BM + wc * 32 + 8 * fq;
#pragma unroll
        for (int ai = 0; ai < 2; ++ai)
#pragma unroll
            for (int m = 0; m < 4; ++m) { const int row = row0 + ai * HALF + m * 16; const float sc = rsqrtf(rowsq[row] * (1.f / 1024.f) + 1e-6f); bf16_t* rowp = O + (size_t)row * ldc + col0;
#pragma unroll
                for (int bj = 0; bj < 2; ++bj) { const f32x4 v0 = acc[ai][bj][m][0] * sc, v1 = acc[ai][bj][m][1] * sc;
                    u32x4 w; w.x = cvt_pk_bf16(v0[0], v0[1]); w.y = cvt_pk_bf16(v0[2], v0[3]); w.z = cvt_pk_bf16(v1[0], v1[1]); w.w = cvt_pk_bf16(v1[2], v1[3]);
                    *(u32x4*)(rowp + bj * HALF) = w; } }
    }
};
struct EpiResidual {
    static constexpr bool PERM = true, AFTER_DRAIN = false;
    const bf16_t* X; bf16_t* HB; float* rowsq; int ldc;
    __device__ __forceinline__ void operator()(const f32x4 (&acc)[2][2][4][2], const Unit& u, int wr, int wc, int fr, int fq) const {
        const int row0 = u.pm * BM + wr * 64 + fr, col0 = u.pn * BM + wc * 32 + 8 * fq;
#pragma unroll
        for (int ai = 0; ai < 2; ++ai)
#pragma unroll
            for (int m = 0; m < 4; ++m) { const int row = row0 + ai * HALF + m * 16; float ss = 0.f;
#pragma unroll
                for (int bj = 0; bj < 2; ++bj) { const size_t off = (size_t)row * ldc + col0 + bj * HALF;
                    const u32x4 xv = *(const u32x4*)(X + off);
                    const f32x4 x0 = (f32x4){__builtin_bit_cast(float, xv.x << 16), __builtin_bit_cast(float, xv.x & 0xffff0000u), __builtin_bit_cast(float, xv.y << 16), __builtin_bit_cast(float, xv.y & 0xffff0000u)};
                    const f32x4 x1 = (f32x4){__builtin_bit_cast(float, xv.z << 16), __builtin_bit_cast(float, xv.z & 0xffff0000u), __builtin_bit_cast(float, xv.w << 16), __builtin_bit_cast(float, xv.w & 0xffff0000u)};
                    const f32x4 v0 = acc[ai][bj][m][0] + x0, v1 = acc[ai][bj][m][1] + x1;
                    u32x4 w; w.x = cvt_pk_bf16(v0[0], v0[1]); w.y = cvt_pk_bf16(v0[2], v0[3]); w.z = cvt_pk_bf16(v1[0], v1[1]); w.w = cvt_pk_bf16(v1[2], v1[3]);
                    *(u32x4*)(HB + off) = w;
                    ss += (v0[0] * v0[0] + v0[1] * v0[1]) + (v0[2] * v0[2] + v0[3] * v0[3]) + (v1[0] * v1[0] + v1[1] * v1[1]) + (v1[2] * v1[2] + v1[3] * v1[3]); }
                ss += __shfl_xor(ss, 16); ss += __shfl_xor(ss, 32);
                if (fq == 0) atomicAdd(rowsq + row, ss); }
    }
};
template <class Epi, class Sched, bool ALIGN_EPI = false, bool SP2 = false>
__device__ __forceinline__ void gemm_phase(PG8_LAS unsigned char* lds, const Gemm g, const Sched& S, const Epi& E) {
    const int tid = threadIdx.x, wid = __builtin_amdgcn_readfirstlane(tid >> 6), lane = tid & 63, wr = wid >> 2, wc = wid & 3, fr = lane & 15, fq = lane >> 4;
    const int K = g.K, nt = K / BK;
    unsigned voffA[2], voffB[2];
#pragma unroll
    for (int i = 0; i < 2; ++i) { int R, C; stage_rc(tid * 16 + i * 8192, R, C); const int Rb = Epi::PERM ? ((R & ~31) + perm32(R & 31)) : R;
        voffA[i] = (unsigned)(R * K + C) * 2u; voffB[i] = (unsigned)(Rb * K + C) * 2u; }
    const size_t kstep = (size_t)(BK * 2);
    const size_t hstep = (size_t)HALF * K * 2;
    const size_t tstep = 2 * hstep;
    const unsigned ldsw = (unsigned)wid * 1024u;
    const int aoff = lds_byte(wr * 64 + fr, fq * 8), boff = lds_byte(wc * 32 + fr, fq * 8);
#define PG8_SA(b, h) (((b) * 2 + (h)) * HTB)
#define PG8_SB(b, h) ((4 + (b) * 2 + (h)) * HTB)
#define PG8_STAGE(bufoff, gbase, voff) do { _Pragma("unroll") for (int _i = 0; _i < 2; ++_i) \
        __builtin_amdgcn_global_load_lds((const unsigned*)((const char*)(gbase) + (voff)[_i]), (PG8_LAS unsigned*)(lds + (bufoff) + ldsw + _i * 8192), 16, 0, 0); } while (0)
#define PG8_LDA(dst, b, h) do { _Pragma("unroll") for (int m = 0; m < 4; ++m) _Pragma("unroll") for (int k = 0; k < 2; ++k) dst[m][k] = *(const PG8_LAS bf16x8*)(lds + PG8_SA(b, h) + aoff + m * 2048 + k * 1024); } while (0)
#define PG8_LDB(dst, b, h) do { _Pragma("unroll") for (int n = 0; n < 2; ++n) _Pragma("unroll") for (int k = 0; k < 2; ++k) dst[n][k] = *(const PG8_LAS bf16x8*)(lds + PG8_SB(b, h) + boff + n * 2048 + k * 1024); } while (0)
#define PG8_MMA(ai, bj, At, Bt) do { __builtin_amdgcn_s_setprio(1); _Pragma("unroll") for (int m = 0; m < 4; ++m) _Pragma("unroll") for (int n = 0; n < 2; ++n) _Pragma("unroll") for (int k = 0; k < 2; ++k) \
        acc[ai][bj][m][n] = __builtin_amdgcn_mfma_f32_16x16x32_bf16(Bt[n][k], At[m][k], acc[ai][bj][m][n], 0, 0, 0); __builtin_amdgcn_s_setprio(0); } while (0)
#define PG8_WAIT_V(n) asm volatile("s_waitcnt vmcnt(" #n ")" ::: "memory")
#define PG8_WAIT_L(n) asm volatile("s_waitcnt lgkmcnt(" #n ")" ::: "memory")
#define PG8_BAR __builtin_amdgcn_s_barrier()
#define PG8_SCHED __builtin_amdgcn_sched_barrier(0)
    Unit cur, nxt; int ui = 0;
    if (!S.next(0, cur)) return;
    f32x4 acc[2][2][4][2];
#pragma unroll
    for (int a = 0; a < 2; ++a)
#pragma unroll
        for (int b = 0; b < 2; ++b)
#pragma unroll
            for (int m = 0; m < 4; ++m)
#pragma unroll
                for (int n = 0; n < 2; ++n) acc[a][b][m][n] = (f32x4){0.f, 0.f, 0.f, 0.f};
    bf16x8 At[4][2], B0[2][2], B1[2][2];
    const char* cA = (const char*)g.A + (size_t)cur.pm * tstep; const char* cB = (const char*)g.Bt + (size_t)cur.pn * tstep;
    S.a_ready(cur);
    if constexpr (SP2) {
        PG8_STAGE(PG8_SB(0, 0), cB, voffB); PG8_STAGE(PG8_SB(0, 1), cB + hstep, voffB); PG8_STAGE(PG8_SA(0, 0), cA, voffA); PG8_STAGE(PG8_SA(0, 1), cA + hstep, voffA);
        if (wr == 1) PG8_BAR;
        PG8_WAIT_V(2); PG8_BAR;
        PG8_STAGE(PG8_SB(1, 0), cB + kstep, voffB); PG8_STAGE(PG8_SA(1, 0), cA + kstep, voffA); PG8_STAGE(PG8_SB(1, 1), cB + hstep + kstep, voffB);
        PG8_WAIT_V(6); PG8_BAR;
    } else {
        PG8_STAGE(PG8_SB(0, 0), cB, voffB); PG8_STAGE(PG8_SA(0, 0), cA, voffA); PG8_STAGE(PG8_SB(0, 1), cB + hstep, voffB); PG8_STAGE(PG8_SA(0, 1), cA + hstep, voffA);
        if (wr == 1) PG8_BAR;
        PG8_WAIT_V(4); PG8_BAR;
        PG8_STAGE(PG8_SB(1, 0), cB + kstep, voffB); PG8_STAGE(PG8_SA(1, 0), cA + kstep, voffA); PG8_STAGE(PG8_SB(1, 1), cB + hstep + kstep, voffB);
        PG8_WAIT_V(6); PG8_BAR;
    }
    for (;;) {
        const bool has_next = S.next(ui + 1, nxt);
        const char* nA = has_next ? (const char*)g.A + (size_t)nxt.pm * tstep : cA; const char* nB = has_next ? (const char*)g.Bt + (size_t)nxt.pn * tstep : cB;
        for (int t = 0; t < nt; t += 2) {
            const bool last = (t == nt - 2);
            const char* a1 = cA + (size_t)(t + 1) * kstep;
            const char* a2 = last ? nA : cA + (size_t)(t + 2) * kstep; const char* b2 = last ? nB : cB + (size_t)(t + 2) * kstep;
            const char* a3 = a2 + kstep; const char* b3 = b2 + kstep;
            if (last && has_next) S.a_ready(nxt);
            if constexpr (SP2) {
            PG8_LDB(B0, 0, 0); PG8_LDB(B1, 0, 1); PG8_SCHED; PG8_LDA(At, 0, 0); PG8_STAGE(PG8_SA(1, 1), a1 + hstep, voffA);
            PG8_WAIT_V(8); PG8_WAIT_L(0); PG8_BAR; PG8_MMA(0, 0, At, B0); PG8_MMA(0, 1, At, B1); PG8_BAR; PG8_SCHED;
            PG8_LDA(At, 0, 1); PG8_STAGE(PG8_SB(0, 0), b2, voffB); PG8_STAGE(PG8_SB(0, 1), b2 + hstep, voffB); PG8_STAGE(PG8_SA(0, 0), a2, voffA);
            PG8_WAIT_V(8); PG8_WAIT_L(0); PG8_BAR; PG8_MMA(1, 0, At, B0); PG8_MMA(1, 1, At, B1); PG8_BAR; PG8_SCHED;
            PG8_LDB(B0, 1, 0); PG8_LDB(B1, 1, 1); PG8_SCHED; PG8_LDA(At, 1, 0); PG8_STAGE(PG8_SA(0, 1), a2 + hstep, voffA);
            PG8_WAIT_V(8); PG8_WAIT_L(0); PG8_BAR; PG8_MMA(0, 0, At, B0); PG8_MMA(0, 1, At, B1); PG8_BAR; PG8_SCHED;
            PG8_LDA(At, 1, 1); PG8_STAGE(PG8_SB(1, 0), b3, voffB); PG8_STAGE(PG8_SB(1, 1), b3 + hstep, voffB); PG8_STAGE(PG8_SA(1, 0), a3, voffA);
            PG8_WAIT_V(8); PG8_WAIT_L(0); PG8_BAR; PG8_MMA(1, 0, At, B0); PG8_MMA(1, 1, At, B1); PG8_BAR; PG8_SCHED;
            } else {
            PG8_LDB(B0, 0, 0); PG8_SCHED; PG8_LDA(At, 0, 0); PG8_STAGE(PG8_SA(1, 1), a1 + hstep, voffA);
            PG8_WAIT_L(8); PG8_BAR; PG8_WAIT_L(0); PG8_MMA(0, 0, At, B0); PG8_BAR; PG8_SCHED;
            PG8_LDB(B1, 0, 1); PG8_STAGE(PG8_SB(0, 0), b2, voffB);
            PG8_BAR; PG8_WAIT_L(0); PG8_MMA(0, 1, At, B1); PG8_BAR;
            PG8_LDA(At, 0, 1); PG8_STAGE(PG8_SA(0, 0), a2, voffA);
            PG8_BAR; PG8_WAIT_L(0); PG8_MMA(1, 0, At, B0); PG8_BAR; PG8_SCHED;
            PG8_STAGE(PG8_SB(0, 1), b2 + hstep, voffB);
            PG8_WAIT_V(6); PG8_BAR; PG8_MMA(1, 1, At, B1); PG8_BAR;
            PG8_LDB(B0, 1, 0); PG8_SCHED; PG8_LDA(At, 1, 0); PG8_STAGE(PG8_SA(0, 1), a2 + hstep, voffA);
            PG8_WAIT_L(8); PG8_BAR; PG8_WAIT_L(0); PG8_MMA(0, 0, At, B0); PG8_BAR; PG8_SCHED;
            PG8_LDB(B1, 1, 1); PG8_STAGE(PG8_SB(1, 0), b3, voffB);
            PG8_BAR; PG8_WAIT_L(0); PG8_MMA(0, 1, At, B1); PG8_BAR;
            PG8_LDA(At, 1, 1); PG8_STAGE(PG8_SA(1, 0), a3, voffA);
            PG8_BAR; PG8_WAIT_L(0); PG8_MMA(1, 0, At, B0); PG8_BAR; PG8_SCHED;
            PG8_STAGE(PG8_SB(1, 1), b3 + hstep, voffB);
            PG8_WAIT_V(6); PG8_BAR; PG8_MMA(1, 1, At, B1); PG8_BAR;
            }
        }
        if constexpr (ALIGN_EPI) { if (wr == 0) PG8_BAR; }
        if constexpr (!Epi::AFTER_DRAIN) { E(acc, cur, wr, wc, fr, fq); S.done(cur); }
        if (!has_next) break;
#pragma unroll
        for (int a = 0; a < 2; ++a)
#pragma unroll
            for (int b = 0; b < 2; ++b)
#pragma unroll
                for (int m = 0; m < 4; ++m)
#pragma unroll
                    for (int n = 0; n < 2; ++n) acc[a][b][m][n] = (f32x4){0.f, 0.f, 0.f, 0.f};
        cur = nxt; cA = nA; cB = nB; ++ui;
        if constexpr (ALIGN_EPI) { if (wr == 1) PG8_BAR; }
    }
    PG8_WAIT_V(0);
    if constexpr (!ALIGN_EPI) { if (wr == 0) PG8_BAR; }
    PG8_BAR;
    if constexpr (Epi::AFTER_DRAIN) { E.fused(acc, cur, wr, wc, fr, fq, lds, wid, lane); S.done(cur); }
#undef PG8_SA
#undef PG8_SB
#undef PG8_STAGE
#undef PG8_LDA
#undef PG8_LDB
#undef PG8_MMA
#undef PG8_WAIT_V
#undef PG8_WAIT_L
#undef PG8_BAR
#undef PG8_SCHED
}
}
constexpr int NWAVES = 8;
constexpr int T = 16384, SEQ = 8192, D = 1024, NIN = 2840, NINP = 3072, NQ = 2048;
constexpr int C_Q = 0, C_K = 256, C_V = 512, C_GLR = 1024, C_GOUT = 1040, C_Z = 1552, C_XBC = 2064, C_DT = 2832;
constexpr float EPS = 1e-6f;
constexpr size_t MiB = 1u << 20;
constexpr size_t WS_CTL = 0, CTL_ZERO_BYTES = 64 * 1024;
constexpr size_t WS_WIN = 1 * MiB;
constexpr size_t WS_WO = 7 * MiB;
constexpr size_t WS_WQ = 9 * MiB;
constexpr size_t WS_SUBK = 13 * MiB;
constexpr size_t WS_RRMS1 = 14 * MiB;
constexpr size_t WS_ROWSQ2 = 14 * MiB + 64 * 1024;
constexpr size_t WS_UB = 16 * MiB, WS_VB = 24 * MiB;
constexpr size_t WS_MIX = 32 * MiB;
constexpr size_t WS_XB = 80 * MiB;
constexpr size_t WS_PROJ = 112 * MiB;
constexpr int CW_TMO = 0, CW_BAR = 1024;
constexpr int RING_OFF = 0, RING_BYTES = 131072;
constexpr int LDS_BYTES = 163840;
constexpr int LDSCTL_OFF = LDS_BYTES - 1024, MISC_OFF = LDSCTL_OFF + 320;

#define GAS __attribute__((address_space(1)))
#define LAS __attribute__((address_space(3)))
typedef unsigned short bf16;
typedef unsigned v4u __attribute__((ext_vector_type(4)));
typedef float f32x4 __attribute__((ext_vector_type(4)));
typedef short bf16x8 __attribute__((ext_vector_type(8)));
typedef GAS unsigned gu32;
#define RLX_AGENT __ATOMIC_RELAXED, __HIP_MEMORY_SCOPE_AGENT
#define LDS_WAIT() asm volatile("s_waitcnt lgkmcnt(0)" ::: "memory")
#define VM_WAIT() asm volatile("s_waitcnt vmcnt(0)" ::: "memory")
typedef float f32x2c __attribute__((ext_vector_type(2)));
typedef __bf16 bf16x2c __attribute__((ext_vector_type(2)));
__device__ __forceinline__ unsigned f2bf(float f) { const __bf16 b = (__bf16)f; return (unsigned)__builtin_bit_cast(unsigned short, b); }
__device__ __forceinline__ unsigned pk2(float lo, float hi) { const bf16x2c v = __builtin_convertvector((f32x2c){lo, hi}, bf16x2c); return __builtin_bit_cast(unsigned, v); }
__device__ __forceinline__ float bf2f(unsigned short b) { return __builtin_bit_cast(float, (unsigned)b << 16); }
__device__ __forceinline__ float wave_sum(float v) {
#pragma unroll
    for (int o = 1; o < 64; o <<= 1) v += __shfl_xor(v, o);
    return v;
}
#define XB_TMO      128
#define XB_XCNT(j)  (256  + 64 * (j))
#define XB_XSUB(j)  (1280 + 64 * (j))
#define XB_XGEN(j)  (2304 + 64 * (j))
#define XB_TOP      3328
#define XB_TOPGEN   3392
#define XCD_BAR_WORDS 3456
#define XB_SPIN_CAP (1u << 18)

__device__ __forceinline__ unsigned xb_ld(unsigned* p)              { return __hip_atomic_load(p, __ATOMIC_RELAXED, __HIP_MEMORY_SCOPE_AGENT); }
__device__ __forceinline__ unsigned xb_add(unsigned* p, unsigned v) { return __hip_atomic_fetch_add(p, v, __ATOMIC_RELAXED, __HIP_MEMORY_SCOPE_AGENT); }
__device__ __forceinline__ unsigned xb_xcc_id() { return (unsigned)__builtin_amdgcn_s_getreg((3 << 11) | 20) & 0xFu; }
#define XB_SPIN(cond, bar) do { unsigned _sp = 0; while (cond) { __builtin_amdgcn_s_sleep(1); \
    if ((++_sp & 255u) == 0u) { if (xb_ld(&(bar)[XB_TMO])) break; if (_sp > XB_SPIN_CAP) { atomicAdd(&(bar)[XB_TMO], 1u); break; } } } } while (0)

struct XcdBarrier {
    unsigned* bar; unsigned x;
    volatile LAS unsigned* st;
};

__device__ __forceinline__ XcdBarrier xcd_barrier_post(unsigned* bar, volatile LAS unsigned* st) {
    XcdBarrier b; b.bar = bar; b.x = xb_xcc_id(); b.st = st;
    if (threadIdx.x == 0) (void)xb_add(&bar[XB_XCNT(b.x)], 1u);
    return b;
}
__device__ __forceinline__ void xcd_barrier_complete(unsigned* bar, unsigned x, unsigned& nloc, unsigned& nx) {
    const unsigned G = gridDim.x * gridDim.y * gridDim.z;
    unsigned sum, cnt, mine, sp = 0u;
    for (;;) {
        sum = 0u; cnt = 0u; mine = 0u;
#pragma unroll
        for (unsigned j = 0; j < 16; ++j) { const unsigned c = xb_ld(&bar[XB_XCNT(j)]); sum += c; cnt += (c > 0u) ? 1u : 0u; mine = (j == x) ? c : mine; }
        if (sum == G) break;
        __builtin_amdgcn_s_sleep(1);
        if ((++sp & 255u) == 0u) { if (xb_ld(&bar[XB_TMO])) break; if (sp > XB_SPIN_CAP) { atomicAdd(&bar[XB_TMO], 1u); break; } }
    }
    nloc = mine > 0u ? mine : 1u; nx = cnt > 0u ? cnt : 1u;
}

__device__ __forceinline__ void xcd_barrier(const XcdBarrier& b) {
    asm volatile("s_waitcnt vmcnt(0)" ::: "memory");
    __syncthreads();
    if (threadIdx.x == 0) {
        unsigned* bar = b.bar;
        __builtin_amdgcn_s_waitcnt(0);
        unsigned nloc = b.st[0], nx = b.st[1];
        if (nloc == 0u) { xcd_barrier_complete(bar, b.x, nloc, nx); b.st[0] = nloc; b.st[1] = nx; }
        const unsigned old = xb_add(&bar[XB_XSUB(b.x)], 1u);
        const unsigned gen = old / nloc;
        if (old + 1u == (gen + 1u) * nloc) {
            __builtin_amdgcn_fence(__ATOMIC_RELEASE, "agent");
            asm volatile("s_waitcnt vmcnt(0)" ::: "memory");
            const unsigned og = xb_add(&bar[XB_TOP], 1u);
            const unsigned tg = og / nx;
            if (og + 1u == (tg + 1u) * nx) xb_add(&bar[XB_TOPGEN], 1u);
            else XB_SPIN(xb_ld(&bar[XB_TOPGEN]) == tg, bar);
            __builtin_amdgcn_fence(__ATOMIC_ACQUIRE, "agent");
            xb_add(&bar[XB_XGEN(b.x)], 1u);
            asm volatile("s_waitcnt vmcnt(0)" ::: "memory");
        } else {
            XB_SPIN(xb_ld(&bar[XB_XGEN(b.x)]) == gen, bar);
            __builtin_amdgcn_fence(__ATOMIC_ACQUIRE, "agent");
            asm volatile("s_waitcnt vmcnt(0)" ::: "memory");
        }
    }
    __syncthreads();
}
struct Args {
    const float* in[19]; float* out; unsigned char* ws; int ph_lo, ph_hi;
};
struct Frame {
    LAS unsigned char* lds; volatile LAS unsigned* MISC; gu32* ctl;
    int tid, lane, wave, G, gw, NGW;
};

constexpr size_t WS_GDEC = 14 * MiB + 128 * 1024;
constexpr size_t WS_SDEC = 14 * MiB + 512 * 1024;
constexpr size_t WS_GST = 208 * MiB;
constexpr size_t WS_SST = 224 * MiB;
constexpr int SA64 = 144, SA128 = 272, SA32 = 80;

__device__ __forceinline__ float silu_f(float x) { return x * __builtin_amdgcn_rcpf(1.f + __expf(-x)); }
__device__ __forceinline__ float softplus_f(float x) { return fmaxf(x, 0.f) + __logf(1.f + __expf(-fabsf(x))); }
__device__ __forceinline__ float logsigmoid_f(float x) { return fminf(x, 0.f) - __logf(1.f + __expf(-fabsf(x))); }
typedef unsigned u32x2 __attribute__((ext_vector_type(2)));

__device__ __forceinline__ f32x4 mma16(const LAS unsigned char* A, int sa, const LAS unsigned char* Bt, int sb, int K, f32x4 acc, int r, int kg) {
    for (int k0 = 0; k0 < K; k0 += 32) {
        const bf16x8 a = *(const LAS bf16x8*)(A + r * sa + (k0 + 8 * kg) * 2);
        const bf16x8 b = *(const LAS bf16x8*)(Bt + r * sb + (k0 + 8 * kg) * 2);
        acc = __builtin_amdgcn_mfma_f32_16x16x32_bf16(a, b, acc, 0, 0, 0);
    }
    return acc;
}

__device__ __forceinline__ void unpack8f(const v4u x, float (&f)[8]) {
    f[0] = __builtin_bit_cast(float, x.x << 16); f[1] = __builtin_bit_cast(float, x.x & 0xffff0000u); f[2] = __builtin_bit_cast(float, x.y << 16); f[3] = __builtin_bit_cast(float, x.y & 0xffff0000u);
    f[4] = __builtin_bit_cast(float, x.z << 16); f[5] = __builtin_bit_cast(float, x.z & 0xffff0000u); f[6] = __builtin_bit_cast(float, x.w << 16); f[7] = __builtin_bit_cast(float, x.w & 0xffff0000u);
}
template <int MODE>
__device__ __forceinline__ void gla_unit(const Frame& F, const Args& A, int unit) {
    const int b = unit >> 9, c = (unit >> 2) & 127, h = unit & 3;
    const size_t t0 = (size_t)b * SEQ + (size_t)c * 64;
    const GAS bf16* proj = (const GAS bf16*)(A.ws + WS_PROJ);
    LAS unsigned char* L = F.lds;
    LAS float* GLR = (LAS float*)(L + 0);
    LAS float* SEG = (LAS float*)(L + 4096);
    LAS float* RSQ = (LAS float*)(L + 6144);
    LAS unsigned char* QI = L + 8192;
    LAS unsigned char* KI = QI + 64 * SA64;
    LAS unsigned char* VT = KI + 64 * SA64;
    LAS unsigned char* SP = VT + 128 * SA64;
    LAS unsigned char* AT = SP + 128 * SA64;
    LAS unsigned char* GO = AT + 64 * SA64;
    int tid = F.tid, seg = F.wave;
    asm volatile("" : "+v"(tid)); asm volatile("" : "+s"(seg));
    const int d = tid & 63;
    {
        const int row = tid >> 3, ch = tid & 7;
        const GAS bf16* prow = proj + (t0 + row) * NINP;
        const v4u kq = *(const GAS v4u*)(prow + C_K + h * 64 + ch * 8);
        v4u qq = kq; if (MODE == 1) qq = *(const GAS v4u*)(prow + C_Q + h * 64 + ch * 8);
        const int o = tid & 15, jp = tid >> 4;
        const v4u va = *(const GAS v4u*)(proj + (t0 + 2 * jp) * NINP + C_V + h * 128 + o * 8), vb = *(const GAS v4u*)(proj + (t0 + 2 * jp + 1) * NINP + C_V + h * 128 + o * 8);
        v4u g0 = kq, g1 = kq, s0 = kq, s1 = kq;
        if (MODE == 1) {
            const int r2 = tid >> 4, c2 = tid & 15;
            g0 = *(const GAS v4u*)(proj + (t0 + r2) * NINP + C_GOUT + h * 128 + c2 * 8); g1 = *(const GAS v4u*)(proj + (t0 + r2 + 32) * NINP + C_GOUT + h * 128 + c2 * 8);
            const GAS bf16* sp = (const GAS bf16*)(A.ws + WS_GST) + (size_t)unit * 8192;
            s0 = *(const GAS v4u*)(sp + (tid >> 3) * 64 + (tid & 7) * 8); s1 = *(const GAS v4u*)(sp + (64 + (tid >> 3)) * 64 + (tid & 7) * 8);
        }
        v4u gl = kq; if (tid < 128) gl = *(const GAS v4u*)(proj + (t0 + (tid >> 1)) * NINP + C_GLR + (tid & 1) * 8);
        if (MODE == 1) { *(LAS v4u*)(QI + row * SA64 + ch * 16) = qq; *(LAS v4u*)(KI + row * SA64 + ch * 16) = kq; }
        else *(LAS v4u*)(GO + row * SA64 + ch * 16) = kq;
        {   const unsigned aw[4] = {va.x, va.y, va.z, va.w}, bw[4] = {vb.x, vb.y, vb.z, vb.w};
#pragma unroll
            for (int cc = 0; cc < 8; ++cc) { const unsigned x = aw[cc >> 1], y = bw[cc >> 1];
                const unsigned wv_ = (cc & 1) ? ((x >> 16) | (y & 0xffff0000u)) : ((x & 0xffffu) | (y << 16));
                *(LAS unsigned*)(VT + (8 * o + cc) * SA64 + jp * 4) = wv_; } }
        if (MODE == 1) {
            const int r2 = tid >> 4, c2 = tid & 15;
            *(LAS v4u*)(GO + r2 * SA128 + c2 * 16) = g0; *(LAS v4u*)(GO + (r2 + 32) * SA128 + c2 * 16) = g1;
            *(LAS v4u*)(SP + (tid >> 3) * SA64 + (tid & 7) * 16) = s0; *(LAS v4u*)(SP + (64 + (tid >> 3)) * SA64 + (tid & 7) * 16) = s1;
        }
        if (tid < 128) { float f[8]; unpack8f(gl, f);
#pragma unroll
            for (int q = 0; q < 8; ++q) GLR[(tid >> 1) * 16 + (tid & 1) * 8 + q] = f[q]; }
    }
    float wv[16];
#pragma unroll
    for (int r = 0; r < 16; ++r) wv[r] = A.in[3][r * 256 + h * 64 + d];
    const float bgv = A.in[4][h * 64 + d];
    __syncthreads();
    float Gv[8]; float run = 0.f;
#pragma unroll
    for (int ii = 0; ii < 8; ++ii) { const int i = seg * 8 + ii; float z = bgv;
#pragma unroll
        for (int r = 0; r < 16; ++r) z += GLR[i * 16 + r] * wv[r];
        run += logsigmoid_f(z) * (1.f / 16.f); Gv[ii] = run; }
    SEG[seg * 64 + d] = run;
    __syncthreads();
    float off = 0.f, tot = 0.f;
#pragma unroll
    for (int s = 0; s < 8; ++s) { const float v = SEG[s * 64 + d]; tot += v; off += (s < seg) ? v : 0.f; }
#pragma unroll
    for (int ii = 0; ii < 8; ++ii) Gv[ii] += off;
    if (MODE == 0) {
        unsigned w[4];
#pragma unroll
        for (int ii = 0; ii < 8; ii += 2) {
            const float k0 = bf2f(*(const LAS bf16*)(GO + (seg * 8 + ii) * SA64 + d * 2)) * __expf(tot - Gv[ii]);
            const float k1 = bf2f(*(const LAS bf16*)(GO + (seg * 8 + ii + 1) * SA64 + d * 2)) * __expf(tot - Gv[ii + 1]);
            w[ii >> 1] = pk2(k0, k1); }
        *(LAS v4u*)(KI + d * SA64 + seg * 16) = (v4u){w[0], w[1], w[2], w[3]};
        if (seg == 0) ((GAS float*)(A.ws + WS_GDEC))[unit * 64 + d] = __expf(tot);
    } else {
#pragma unroll
        for (int ii = 0; ii < 8; ++ii) { const int i = seg * 8 + ii;
            LAS bf16* qp = (LAS bf16*)(QI + i * SA64 + d * 2); LAS bf16* kp = (LAS bf16*)(KI + i * SA64 + d * 2);
            *qp = (bf16)f2bf(bf2f(*qp) * 0.125f * __expf(Gv[ii])); *kp = (bf16)f2bf(bf2f(*kp) * __expf(-Gv[ii])); }
    }
    __syncthreads();
    const int r = tid & 15, kg = (tid >> 4) & 3, w = seg;
    const f32x4 zero = (f32x4){0.f, 0.f, 0.f, 0.f};
    if (MODE == 0) {
        const int mt = w & 3, nb = (w >> 2) * 4;
        GAS bf16* stT = (GAS bf16*)(A.ws + WS_GST) + (size_t)unit * 8192;
#pragma unroll
        for (int n = 0; n < 4; ++n) {
            const f32x4 acc = mma16(KI + mt * 16 * SA64, SA64, VT + (nb + n) * 16 * SA64, SA64, 64, zero, r, kg);
            const int dv = (nb + n) * 16 + r, d0 = mt * 16 + kg * 4;
            *(GAS u32x2*)(stT + dv * 64 + d0) = (u32x2){pk2(acc[0], acc[1]), pk2(acc[2], acc[3])}; }
    } else {
        const int mt = w & 3;
#pragma unroll
        for (int n = 0; n < 2; ++n) { const int nt = (w >> 2) * 2 + n;
            const f32x4 acc = mma16(QI + mt * 16 * SA64, SA64, KI + nt * 16 * SA64, SA64, 64, zero, r, kg);
#pragma unroll
            for (int ii = 0; ii < 4; ++ii) { const int i = mt * 16 + kg * 4 + ii, j = nt * 16 + r; *(LAS bf16*)(AT + i * SA64 + j * 2) = (bf16)f2bf(j <= i ? acc[ii] : 0.f); } }
        __syncthreads();
        const int nb = (w >> 2) * 4;
        f32x4 o[4]; float rs[4] = {0.f, 0.f, 0.f, 0.f};
#pragma unroll
        for (int n = 0; n < 4; ++n) {
            f32x4 acc = mma16(AT + mt * 16 * SA64, SA64, VT + (nb + n) * 16 * SA64, SA64, 64, zero, r, kg);
            acc = mma16(QI + mt * 16 * SA64, SA64, SP + (nb + n) * 16 * SA64, SA64, 64, acc, r, kg);
            o[n] = acc;
#pragma unroll
            for (int ii = 0; ii < 4; ++ii) rs[ii] += acc[ii] * acc[ii]; }
#pragma unroll
        for (int ii = 0; ii < 4; ++ii) { rs[ii] += __shfl_xor(rs[ii], 1); rs[ii] += __shfl_xor(rs[ii], 2); rs[ii] += __shfl_xor(rs[ii], 4); rs[ii] += __shfl_xor(rs[ii], 8); }
        if (r == 0) {
#pragma unroll
            for (int ii = 0; ii < 4; ++ii) RSQ[(w >> 2) * 64 + mt * 16 + kg * 4 + ii] = rs[ii]; }
        __syncthreads();
        float rr[4];
#pragma unroll
        for (int ii = 0; ii < 4; ++ii) { const int row = mt * 16 + kg * 4 + ii; rr[ii] = rsqrtf((RSQ[row] + RSQ[64 + row]) * (1.f / 128.f) + EPS); }
#pragma unroll
        for (int n = 0; n < 4; ++n) { const int dv = (nb + n) * 16 + r; const float nwv = A.in[5][dv];
#pragma unroll
            for (int ii = 0; ii < 4; ++ii) { LAS bf16* gp = (LAS bf16*)(GO + (mt * 16 + kg * 4 + ii) * SA128 + dv * 2);
                *gp = (bf16)f2bf(o[n][ii] * rr[ii] * nwv * silu_f(bf2f(*gp))); } }
        __syncthreads();
        {   const int r2 = tid >> 4, c2 = tid & 15; GAS bf16* mixed = (GAS bf16*)(A.ws + WS_MIX);
            *(GAS v4u*)(mixed + (t0 + r2) * D + h * 128 + c2 * 8) = *(const LAS v4u*)(GO + r2 * SA128 + c2 * 16);
            *(GAS v4u*)(mixed + (t0 + r2 + 32) * D + h * 128 + c2 * 8) = *(const LAS v4u*)(GO + (r2 + 32) * SA128 + c2 * 16); }
    }
    __syncthreads();
}

template <int MODE>
__device__ __forceinline__ void ssd_unit(const Frame& F, const Args& A, int unit) {
    const int b = unit >> 7, c = (unit >> 1) & 63, g = unit & 1;
    const size_t t0 = (size_t)b * SEQ + (size_t)c * 128;
    const GAS bf16* proj = (const GAS bf16*)(A.ws + WS_PROJ);
    LAS unsigned char* L = F.lds;
    LAS float* DT = (LAS float*)(L + 0);
    LAS float* ACU = (LAS float*)(L + 2048);
    LAS unsigned char* CM = L + 4096;
    LAS unsigned char* BM = CM + 128 * SA64;
    LAS unsigned char* XT = BM + 128 * SA64;
    LAS unsigned char* PW = XT + 4 * 64 * SA128;
    LAS unsigned char* ZW = PW + 8 * 16 * SA32;
    LAS float* RRW = (LAS float*)(ZW + 8 * 16 * SA64);
    int tid = F.tid, w = F.wave;
    asm volatile("" : "+v"(tid)); asm volatile("" : "+s"(w));
    const int lane = tid & 63;
    if (w < 4) {
        const int hd = g * 4 + w; const float Ah = -__expf(A.in[9][hd]), dtb = A.in[8][hd];
        const float dt0 = softplus_f(bf2f(proj[(t0 + 2 * lane) * NINP + C_DT + hd]) + dtb), dt1 = softplus_f(bf2f(proj[(t0 + 2 * lane + 1) * NINP + C_DT + hd]) + dtb);
        const float a0 = dt0 * Ah, a1 = dt1 * Ah; float s = a0 + a1;
#pragma unroll
        for (int o = 1; o < 64; o <<= 1) { const float t = __shfl_up(s, o); s += (lane >= o) ? t : 0.f; }
        DT[(2 * lane) * 4 + w] = dt0; DT[(2 * lane + 1) * 4 + w] = dt1; ACU[(2 * lane) * 4 + w] = s - a1; ACU[(2 * lane + 1) * 4 + w] = s;
        if (MODE == 0 && lane == 63) ((GAS float*)(A.ws + WS_SDEC))[(b * 64 + c) * 8 + hd] = __expf(s);
    }
    __syncthreads();
    if (tid < 384) {
        const int o = tid % 48, sg = tid / 48;
        if (!(MODE == 0 && o >= 40)) {
            const int cc0 = o < 32 ? g * 256 + 8 * o : (o < 40 ? 512 + g * 64 + 8 * (o - 32) : 640 + g * 64 + 8 * (o - 40));
            float wt[4][8], cb[8];
#pragma unroll
            for (int j = 0; j < 4; ++j) { const f32x4 a = *(const GAS f32x4*)(A.in[6] + j * 768 + cc0), bq = *(const GAS f32x4*)(A.in[6] + j * 768 + cc0 + 4);
                wt[j][0] = a.x; wt[j][1] = a.y; wt[j][2] = a.z; wt[j][3] = a.w; wt[j][4] = bq.x; wt[j][5] = bq.y; wt[j][6] = bq.z; wt[j][7] = bq.w; }
            { const f32x4 a = *(const GAS f32x4*)(A.in[7] + cc0), bq = *(const GAS f32x4*)(A.in[7] + cc0 + 4); cb[0] = a.x; cb[1] = a.y; cb[2] = a.z; cb[3] = a.w; cb[4] = bq.x; cb[5] = bq.y; cb[6] = bq.z; cb[7] = bq.w; }
            const GAS bf16* src = proj + (t0 + 16 * sg) * NINP + C_XBC + cc0;
            float x0[8], x1[8], x2[8];
            if (c > 0 || sg > 0) { unpack8f(*(const GAS v4u*)(src - 3 * NINP), x0); unpack8f(*(const GAS v4u*)(src - 2 * NINP), x1); unpack8f(*(const GAS v4u*)(src - 1 * NINP), x2); }
            else {
#pragma unroll
                for (int q = 0; q < 8; ++q) { x0[q] = 0.f; x1[q] = 0.f; x2[q] = 0.f; } }
            const int hl = o >> 3, p0 = (o & 7) * 8;
            float sc_end = 0.f; if (MODE == 0 && o < 32) sc_end = ACU[127 * 4 + hl];
#pragma unroll 1
            for (int hf = 0; hf < 2; ++hf) {
                v4u xin[8];
#pragma unroll
                for (int i = 0; i < 8; ++i) xin[i] = *(const GAS v4u*)(src + (size_t)(hf * 8 + i) * NINP);
                unsigned tp[8][4];
#pragma unroll
                for (int i = 0; i < 8; ++i) {
                    const int l = 16 * sg + hf * 8 + i;
                    float xc[8]; unpack8f(xin[i], xc);
                    float v[8];
#pragma unroll
                    for (int q = 0; q < 8; ++q) v[q] = silu_f(cb[q] + wt[0][q] * x0[q] + wt[1][q] * x1[q] + wt[2][q] * x2[q] + wt[3][q] * xc[q]);
#pragma unroll
                    for (int q = 0; q < 8; ++q) { x0[q] = x1[q]; x1[q] = x2[q]; x2[q] = xc[q]; }
                    if (o < 32 || (MODE == 0)) {
                        if (MODE == 0 && o < 32) { const float sc = DT[l * 4 + hl] * __expf(sc_end - ACU[l * 4 + hl]);
#pragma unroll
                            for (int q = 0; q < 8; ++q) v[q] *= sc; }
#pragma unroll
                        for (int q = 0; q < 8; ++q) { const unsigned bv = f2bf(v[q]); if (i & 1) tp[q][i >> 1] |= bv << 16; else tp[q][i >> 1] = bv; }
                    } else {
                        const v4u ov = (v4u){pk2(v[0], v[1]), pk2(v[2], v[3]), pk2(v[4], v[5]), pk2(v[6], v[7])};
                        *(LAS v4u*)((o < 40 ? BM : CM) + l * SA64 + (o & 7) * 16) = ov;
                    }
                }
                if (o < 32 || (MODE == 0)) {
                    LAS unsigned char* dst = (o < 32) ? XT + hl * 64 * SA128 + p0 * SA128 : CM + ((o & 7) * 8) * SA128;
#pragma unroll
                    for (int q = 0; q < 8; ++q) *(LAS v4u*)(dst + q * SA128 + (16 * sg + hf * 8) * 2) = (v4u){tp[q][0], tp[q][1], tp[q][2], tp[q][3]};
                }
            }
        }
    }
    __syncthreads();
    const int r = lane & 15, kg = lane >> 4;
    const f32x4 zero = (f32x4){0.f, 0.f, 0.f, 0.f};
    if (MODE == 0) {
        const int hl = w >> 1;
        GAS bf16* st = (GAS bf16*)(A.ws + WS_SST) + ((size_t)((b * 64 + c) * 8 + g * 4 + hl)) * 4096;
#pragma unroll
        for (int mt = 0; mt < 4; ++mt)
#pragma unroll
            for (int n = 0; n < 2; ++n) { const int nt = (w & 1) * 2 + n;
                const f32x4 acc = mma16(CM + mt * 16 * SA128, SA128, XT + hl * 64 * SA128 + nt * 16 * SA128, SA128, 128, zero, r, kg);
                const int p = nt * 16 + r, n0 = mt * 16 + kg * 4;
                *(GAS u32x2*)(st + p * 64 + n0) = (u32x2){pk2(acc[0], acc[1]), pk2(acc[2], acc[3])}; }
    } else {
        f32x4 sc[8];
#pragma unroll
        for (int nt = 0; nt < 8; ++nt) { sc[nt] = zero; if (nt <= w) sc[nt] = mma16(CM + w * 16 * SA64, SA64, BM + nt * 16 * SA64, SA64, 64, zero, r, kg); }
        __syncthreads();
        const GAS bf16* spg = (const GAS bf16*)(A.ws + WS_SST) + ((size_t)((b * 64 + c) * 8 + g * 4)) * 4096;
        for (int e = tid; e < 1024; e += 512) { const int row = e >> 3, ch = e & 7; *(LAS v4u*)(BM + row * SA64 + ch * 16) = *(const GAS v4u*)(spg + row * 64 + ch * 8); }
        __syncthreads();
        float rs[4] = {0.f, 0.f, 0.f, 0.f};
        LAS unsigned char* pw = PW + w * 16 * SA32;
        LAS unsigned char* zw = ZW + w * 16 * SA64;
        const int orow = lane >> 3, och = lane & 7;
        const GAS bf16* zsrc = proj + (t0 + w * 16 + orow) * NINP + C_Z + g * 256 + och * 8;
        v4u ysave[4][2];
#pragma unroll
        for (int hl = 0; hl < 4; ++hl) {
            if (hl == 2) {
                __syncthreads();
                for (int e = tid; e < 1024; e += 512) { const int row = e >> 3, ch = e & 7; *(LAS v4u*)(BM + row * SA64 + ch * 16) = *(const GAS v4u*)(spg + 2 * 4096 + row * 64 + ch * 8); }
                __syncthreads();
            }
            asm volatile("" ::: "memory");
            const v4u z0 = *(const GAS v4u*)(zsrc + hl * 64), z1 = *(const GAS v4u*)(zsrc + (size_t)8 * NINP + hl * 64);
            float acl[4];
#pragma unroll
            for (int ii = 0; ii < 4; ++ii) acl[ii] = ACU[(w * 16 + kg * 4 + ii) * 4 + hl];
            f32x4 yd[4] = {zero, zero, zero, zero};
            const LAS unsigned char* xth = XT + hl * 64 * SA128;
#pragma unroll
            for (int kc = 0; kc < 4; ++kc) {
                if (kc * 2 <= w) {
#pragma unroll
                    for (int half = 0; half < 2; ++half) { const int stl = 2 * kc + half; const int s = stl * 16 + r;
                        const float acs = ACU[s * 4 + hl], dts = DT[s * 4 + hl];
#pragma unroll
                        for (int ii = 0; ii < 4; ++ii) { const int l = w * 16 + kg * 4 + ii;
                            const float pv = (s <= l) ? sc[stl][ii] * __expf(acl[ii] - acs) * dts : 0.f;
                            *(LAS bf16*)(pw + (kg * 4 + ii) * SA32 + (half * 16 + r) * 2) = (bf16)f2bf(pv); } }
                    LDS_WAIT();
                    const bf16x8 a = *(const LAS bf16x8*)(pw + r * SA32 + kg * 16);
#pragma unroll
                    for (int nt = 0; nt < 4; ++nt) { const bf16x8 bb = *(const LAS bf16x8*)(xth + (nt * 16 + r) * SA128 + (kc * 32 + 8 * kg) * 2);
                        yd[nt] = __builtin_amdgcn_mfma_f32_16x16x32_bf16(a, bb, yd[nt], 0, 0, 0); }
                    LDS_WAIT();
                }
            }
            *(LAS v4u*)(zw + orow * SA64 + och * 16) = z0; *(LAS v4u*)(zw + (orow + 8) * SA64 + och * 16) = z1;
            LDS_WAIT();
            const float Dk = A.in[10][g * 4 + hl];
            float eal[4];
#pragma unroll
            for (int ii = 0; ii < 4; ++ii) eal[ii] = __expf(acl[ii]);
#pragma unroll
            for (int nt = 0; nt < 4; ++nt) {
                const f32x4 yo = mma16(CM + w * 16 * SA64, SA64, BM + (hl & 1) * 64 * SA64 + nt * 16 * SA64, SA64, 64, zero, r, kg);
                const int p = nt * 16 + r;
#pragma unroll
                for (int ii = 0; ii < 4; ++ii) { const int l = w * 16 + kg * 4 + ii;
                    const float xv = bf2f(*(const LAS bf16*)(xth + p * SA128 + l * 2));
                    LAS bf16* zp = (LAS bf16*)(zw + (kg * 4 + ii) * SA64 + p * 2);
                    const float y = (yd[nt][ii] + eal[ii] * yo[ii] + xv * Dk) * silu_f(bf2f(*zp));
                    const unsigned short yb = (unsigned short)f2bf(y); const float yq = bf2f(yb);
                    rs[ii] += yq * yq;
                    *zp = yb; }
            }
            LDS_WAIT();
            ysave[hl][0] = *(const LAS v4u*)(zw + orow * SA64 + och * 16); ysave[hl][1] = *(const LAS v4u*)(zw + (orow + 8) * SA64 + och * 16);
            LDS_WAIT();
        }
#pragma unroll
        for (int ii = 0; ii < 4; ++ii) { rs[ii] += __shfl_xor(rs[ii], 1); rs[ii] += __shfl_xor(rs[ii], 2); rs[ii] += __shfl_xor(rs[ii], 4); rs[ii] += __shfl_xor(rs[ii], 8);
            rs[ii] = rsqrtf(rs[ii] * (1.f / 256.f) + EPS); }
        if (r == 0) {
#pragma unroll
            for (int ii = 0; ii < 4; ++ii) RRW[w * 16 + kg * 4 + ii] = rs[ii]; }
        LDS_WAIT();
        const float rr0 = RRW[w * 16 + orow], rr1 = RRW[w * 16 + orow + 8];
        GAS bf16* mdst = (GAS bf16*)(A.ws + WS_MIX) + (t0 + w * 16 + orow) * D + 512 + g * 256 + och * 8;
#pragma unroll
        for (int hl = 0; hl < 4; ++hl) {
            const f32x4 nwa = *(const GAS f32x4*)(A.in[11] + g * 256 + hl * 64 + och * 8), nwb = *(const GAS f32x4*)(A.in[11] + g * 256 + hl * 64 + och * 8 + 4);
            const float nw8[8] = {nwa.x, nwa.y, nwa.z, nwa.w, nwb.x, nwb.y, nwb.z, nwb.w};
#pragma unroll
            for (int hh = 0; hh < 2; ++hh) { float f[8]; unpack8f(ysave[hl][hh], f); const float rr_ = hh ? rr1 : rr0;
#pragma unroll
                for (int q = 0; q < 8; ++q) f[q] *= rr_ * nw8[q];
                *(GAS v4u*)(mdst + (size_t)(8 * hh) * D + hl * 64) = (v4u){pk2(f[0], f[1]), pk2(f[2], f[3]), pk2(f[4], f[5]), pk2(f[6], f[7])}; }
        }
    }
    __syncthreads();
}

template <bool DRY> __device__ __forceinline__ void scan_phase(const Frame& F, const Args& A) {
    if (F.tid < 128) {
        GAS unsigned* st = (GAS unsigned*)(A.ws + WS_GST); const GAS float* dec = (const GAS float*)(A.ws + WS_GDEC);
        for (int gi = blockIdx.x * 128 + F.tid; gi < 8 * 4096; gi += F.G * 128) {
            const int bh = gi >> 12, e = gi & 4095, b = bh >> 2, h = bh & 3, d = (e & 31) * 2;
            float S0 = 0.f, S1 = 0.f;
#pragma unroll 1
            for (int c = 0; c < 128; c += 16) {
                unsigned v[16]; float d0[16], d1[16];
#pragma unroll
                for (int u = 0; u < 16; ++u) { const size_t un = (size_t)((b * 128 + c + u) * 4 + h); v[u] = st[un * 4096 + e]; d0[u] = dec[un * 64 + d]; d1[u] = dec[un * 64 + d + 1]; }
#pragma unroll
                for (int u = 0; u < 16; ++u) { const size_t un = (size_t)((b * 128 + c + u) * 4 + h); (DRY ? (GAS unsigned*)(A.ws + 232 * MiB) : st)[un * 4096 + e] = pk2(S0, S1);
                    S0 = d0[u] * S0 + bf2f((unsigned short)(v[u] & 0xffffu)); S1 = d1[u] * S1 + bf2f((unsigned short)(v[u] >> 16)); }
            }
        }
    } else if (F.tid < 256) {
        GAS unsigned* st = (GAS unsigned*)(A.ws + WS_SST); const GAS float* dec = (const GAS float*)(A.ws + WS_SDEC);
        for (int gi = blockIdx.x * 128 + (F.tid - 128); gi < 16 * 2048; gi += F.G * 128) {
            const int bh = gi >> 11, e = gi & 2047, b = bh >> 3, hd = bh & 7;
            float S0 = 0.f, S1 = 0.f;
#pragma unroll 1
            for (int c = 0; c < 64; c += 16) {
                unsigned v[16]; float dd[16];
#pragma unroll
                for (int u = 0; u < 16; ++u) { const size_t un = (size_t)((b * 64 + c + u) * 8 + hd); v[u] = st[un * 2048 + e]; dd[u] = dec[un]; }
#pragma unroll
                for (int u = 0; u < 16; ++u) { const size_t un = (size_t)((b * 64 + c + u) * 8 + hd); (DRY ? (GAS unsigned*)(A.ws + 248 * MiB) : st)[un * 2048 + e] = pk2(S0, S1);
                    S0 = dd[u] * S0 + bf2f((unsigned short)(v[u] & 0xffffu)); S1 = dd[u] * S1 + bf2f((unsigned short)(v[u] >> 16)); }
            }
        }
    }
}
constexpr size_t WS_HB = WS_PROJ;
constexpr size_t WS_Q = 144 * MiB;
constexpr size_t WS_IDX = 232 * MiB;
constexpr size_t WS_GATE = 240 * MiB;
typedef float f32x16 __attribute__((ext_vector_type(16)));
__device__ __forceinline__ float as_f(unsigned u) { return __builtin_bit_cast(float, u); }
__device__ __forceinline__ unsigned as_u(float f) { return __builtin_bit_cast(unsigned, f); }
#define CE_DESC(a, b) do { const float hi_ = fmaxf((a), (b)), lo_ = fminf((a), (b)); (a) = hi_; (b) = lo_; } while (0)
template <int OFF, int N> __device__ __forceinline__ void sort16_desc(float (&v)[N]) {
#pragma unroll
    for (int k = 2; k <= 16; k <<= 1)
#pragma unroll
        for (int j = k >> 1; j > 0; j >>= 1)
#pragma unroll
            for (int i = 0; i < 16; ++i) { const int l = i ^ j; if (l > i) { if ((i & k) == 0) CE_DESC(v[OFF + i], v[OFF + l]); else CE_DESC(v[OFF + l], v[OFF + i]); } }
}
template <int OA, int OB, int NA, int NB> __device__ __forceinline__ void merge16_desc(float (&a)[NA], const float (&b)[NB]) {
#pragma unroll
    for (int i = 0; i < 16; ++i) a[OA + i] = fmaxf(a[OA + i], b[OB + 15 - i]);
#pragma unroll
    for (int j = 8; j > 0; j >>= 1)
#pragma unroll
        for (int i = 0; i < 16; ++i) { const int l = i ^ j; if (l > i) CE_DESC(a[OA + i], a[OA + l]); }
}
constexpr unsigned char CAND0[32] = {0, 2, 4, 6, 8, 10, 12, 14, 16, 18, 20, 22, 32, 34, 36, 49, 51, 65, 80, 96, 112, 128, 160, 192, 224, 255, 255, 255, 255, 255, 255, 255};
constexpr unsigned char CAND1[32] = {1, 3, 5, 7, 9, 11, 13, 15, 17, 19, 21, 23, 33, 35, 48, 50, 64, 66, 81, 97, 113, 144, 176, 208, 240, 255, 255, 255, 255, 255, 255, 255};

__device__ __forceinline__ void topk_wave_job(const Args& A, const LAS unsigned char* SK, LAS unsigned char* TAB, int tok0, int h, int lane) {
    const int r = lane & 31, hi = lane >> 5;
    const GAS bf16* qrow = (const GAS bf16*)(A.ws + WS_Q) + (size_t)(tok0 + r) * NQ + h * 256 + 8 * hi;
    float LST[2][16];
#pragma unroll
    for (int p = 0; p < 2; ++p) {
        __builtin_amdgcn_sched_barrier(0);
        bf16x8 bq[8];
#pragma unroll
        for (int s = 0; s < 8; ++s) bq[s] = *(const GAS bf16x8*)(qrow + p * 128 + 16 * s);
        float v[64];
#pragma unroll
        for (int kt = 0; kt < 4; ++kt) {
            f32x16 acc;
#pragma unroll
            for (int i = 0; i < 16; ++i) acc[i] = 0.f;
#pragma unroll
            for (int s = 0; s < 8; ++s) { const bf16x8 a = *(const LAS bf16x8*)(SK + (p * 128 + kt * 32 + r) * SA128 + (16 * s + 8 * hi) * 2);
                acc = __builtin_amdgcn_mfma_f32_32x32x16_bf16(a, bq[s], acc, 0, 0, 0); }
#pragma unroll
            for (int i = 0; i < 16; ++i) { const unsigned key = (unsigned)(kt * 32 + (i & 3) + 8 * (i >> 2)) | ((unsigned)hi << 2); v[kt * 16 + i] = as_f((as_u(acc[i]) & ~127u) | key); }
        }
        sort16_desc<0>(v); sort16_desc<16>(v); sort16_desc<32>(v); sort16_desc<48>(v);
        merge16_desc<0, 16>(v, v); merge16_desc<32, 48>(v, v); merge16_desc<0, 32>(v, v);
        float o[16];
#pragma unroll
        for (int i = 0; i < 16; ++i) o[i] = __shfl_xor(v[i], 32);
        merge16_desc<0, 0>(v, o);
#pragma unroll
        for (int i = 0; i < 16; ++i) LST[p][i] = v[i];
    }
    __builtin_amdgcn_sched_barrier(0);
    {   unsigned pk[4];
#pragma unroll
        for (int q4 = 0; q4 < 4; ++q4) { unsigned wv = 0;
#pragma unroll
            for (int b = 0; b < 4; ++b) { float l0 = LST[0][q4 * 4 + b], l1 = LST[1][q4 * 4 + b]; asm volatile("" : "+v"(l0), "+v"(l1));
                const unsigned x = as_u(hi ? l1 : l0) & 127u; wv |= x << (8 * b); }
            pk[q4] = wv; }
        *(LAS v4u*)(TAB + r * 32 + hi * 16) = (v4u){pk[0], pk[1], pk[2], pk[3]};
    }
    float c[32];
    float va[16], vb2[16];
#pragma unroll
    for (int i = 0; i < 16; ++i) { va[i] = as_f(as_u(LST[0][i]) & ~127u); vb2[i] = as_f(as_u(LST[1][i]) & ~127u); }
#define CANDV(i0, j0, k0, i1, j1, k1) as_f((as_u(hi ? (va[i1] + vb2[j1]) : (va[i0] + vb2[j0])) & ~255u) | (hi ? (k1) : (k0)))
    c[0] = CANDV(0, 0, 0u, 0, 1, 1u);
    c[1] = CANDV(0, 2, 2u, 0, 3, 3u);
    c[2] = CANDV(0, 4, 4u, 0, 5, 5u);
    c[3] = CANDV(0, 6, 6u, 0, 7, 7u);
    c[4] = CANDV(0, 8, 8u, 0, 9, 9u);
    c[5] = CANDV(0, 10, 10u, 0, 11, 11u);
    c[6] = CANDV(0, 12, 12u, 0, 13, 13u);
    c[7] = CANDV(0, 14, 14u, 0, 15, 15u);
    c[8] = CANDV(1, 0, 16u, 1, 1, 17u);
    c[9] = CANDV(1, 2, 18u, 1, 3, 19u);
    c[10] = CANDV(1, 4, 20u, 1, 5, 21u);
    c[11] = CANDV(1, 6, 22u, 1, 7, 23u);
    c[12] = CANDV(2, 0, 32u, 2, 1, 33u);
    c[13] = CANDV(2, 2, 34u, 2, 3, 35u);
    c[14] = CANDV(2, 4, 36u, 3, 0, 48u);
    c[15] = CANDV(3, 1, 49u, 3, 2, 50u);
    c[16] = CANDV(3, 3, 51u, 4, 0, 64u);
    c[17] = CANDV(4, 1, 65u, 4, 2, 66u);
    c[18] = CANDV(5, 0, 80u, 5, 1, 81u);
    c[19] = CANDV(6, 0, 96u, 6, 1, 97u);
    c[20] = CANDV(7, 0, 112u, 7, 1, 113u);
    c[21] = CANDV(8, 0, 128u, 9, 0, 144u);
    c[22] = CANDV(10, 0, 160u, 11, 0, 176u);
    c[23] = CANDV(12, 0, 192u, 13, 0, 208u);
    c[24] = CANDV(14, 0, 224u, 15, 0, 240u);
    c[25] = as_f(0xFF61B1E6u | 255u);
    c[26] = as_f(0xFF61B1E6u | 255u);
    c[27] = as_f(0xFF61B1E6u | 255u);
    c[28] = as_f(0xFF61B1E6u | 255u);
    c[29] = as_f(0xFF61B1E6u | 255u);
    c[30] = as_f(0xFF61B1E6u | 255u);
    c[31] = as_f(0xFF61B1E6u | 255u);
#undef CANDV
    sort16_desc<0>(c); sort16_desc<16>(c); merge16_desc<0, 16>(c, c);
    {   float o[16];
#pragma unroll
        for (int i = 0; i < 16; ++i) o[i] = __shfl_xor(c[i], 32);
        merge16_desc<0, 0>(c, o); }
    const float mx = as_f(as_u(c[0]) & ~255u);
    float ex[16], den = 0.f;
#pragma unroll
    for (int k = 0; k < 16; ++k) { ex[k] = __expf(as_f(as_u(c[k]) & ~255u) - mx); den += ex[k]; }
    const float inv = 1.f / den;
    LDS_WAIT();
    unsigned eid[8]; float gv[8];
#pragma unroll
    for (int k = 0; k < 8; ++k) { float ca = c[k], cb = c[k + 8], ea = ex[k], eb = ex[k + 8]; asm volatile("" : "+v"(ca), "+v"(cb), "+v"(ea), "+v"(eb));
        const unsigned code = as_u(hi ? cb : ca) & 255u; gv[k] = (hi ? eb : ea) * inv;
        const unsigned ia = *(const LAS unsigned char*)(TAB + r * 32 + (code >> 4)), ib = *(const LAS unsigned char*)(TAB + r * 32 + 16 + (code & 15));
        eid[k] = ia * 128u + ib; }
    GAS unsigned* ip = (GAS unsigned*)(A.ws + WS_IDX) + (size_t)(tok0 + r) * 128 + h * 16 + 8 * hi;
    GAS float* gp = (GAS float*)(A.ws + WS_GATE) + (size_t)(tok0 + r) * 128 + h * 16 + 8 * hi;
    *(GAS v4u*)ip = (v4u){eid[0], eid[1], eid[2], eid[3]}; *(GAS v4u*)(ip + 4) = (v4u){eid[4], eid[5], eid[6], eid[7]};
    *(GAS f32x4*)gp = (f32x4){gv[0], gv[1], gv[2], gv[3]}; *(GAS f32x4*)(gp + 4) = (f32x4){gv[4], gv[5], gv[6], gv[7]};
    LDS_WAIT();
}
__device__ __forceinline__ void topk_phase(const Frame& F, const Args& A) {
    LAS unsigned char* SK = F.lds;
    LAS unsigned char* TABS = F.lds + 256 * SA128;
    for (int unit = blockIdx.x; unit < 256; unit += F.G) {
        int tid = F.tid, w = F.wave;
        asm volatile("" : "+v"(tid)); asm volatile("" : "+s"(w));
        const int h = unit & 7, tb = (unit >> 3) * 512;
        const GAS bf16* sk = (const GAS bf16*)(A.ws + WS_SUBK) + (size_t)h * 2 * 128 * 128;
        for (int e = tid; e < 256 * 16; e += 512) { const int row = e >> 4, ch = e & 15; *(LAS v4u*)(SK + row * SA128 + ch * 16) = *(const GAS v4u*)(sk + row * 128 + ch * 8); }
        __syncthreads();
#pragma unroll 1
        for (int tt = 0; tt < 2; ++tt) topk_wave_job(A, SK, TABS + w * 1024, tb + (w * 2 + tt) * 32, h, tid & 63);
        __syncthreads();
    }
}

__device__ __forceinline__ float gelu_f(float v) {
    const float av = fabsf(v), t = __builtin_amdgcn_rcpf(av * 0.2316418882f + 1.0f);
    float q = t * 0.5307027145f + (-0.7265760135f); q = q * t + 0.7107068705f; q = q * t + (-0.142248368f); q = q * t + 0.127414796f; q = q * t;
    const float m = v * (q * __builtin_amdgcn_exp2f((v * v) * (-0.72134752044f)));
    return v < 0.f ? m : v - m;
}
__device__ __forceinline__ void unpack8(const v4u x, float (&f)[8]) {
    f[0] = as_f(x.x << 16); f[1] = as_f(x.x & 0xffff0000u); f[2] = as_f(x.y << 16); f[3] = as_f(x.y & 0xffff0000u);
    f[4] = as_f(x.z << 16); f[5] = as_f(x.z & 0xffff0000u); f[6] = as_f(x.w << 16); f[7] = as_f(x.w & 0xffff0000u);
}
typedef long lx2 __attribute__((ext_vector_type(2)));
typedef float f32x2 __attribute__((ext_vector_type(2)));
typedef int i32x8 __attribute__((ext_vector_type(8)));
typedef int i32x4 __attribute__((ext_vector_type(4)));
constexpr float U4_SCALE = 48.f, V4_SCALE = 4.25f;
constexpr int MX_ONE = 0x7F7F7F7F;
template <int BY> __device__ __forceinline__ f32x2 cvt_fp4x2(unsigned w) { return __builtin_amdgcn_cvt_scalef32_pk_f32_fp4(w, 1.0f, BY); }
template <int WS> __device__ __forceinline__ f32x2 cvt_fp8x2(int w) { return __builtin_amdgcn_cvt_pk_f32_fp8(w, WS != 0); }
__device__ __forceinline__ unsigned pk4_fp8(float a, float b, float c, float d) { int p = __builtin_amdgcn_cvt_pk_fp8_f32(a, b, 0, false); p = __builtin_amdgcn_cvt_pk_fp8_f32(c, d, p, true); return (unsigned)p; }
template <bool DRY> __device__ __forceinline__ void expert_phase(const Frame& F, const Args& A) {
    int tid = F.tid, w = F.wave;
    asm volatile("" : "+v"(tid)); asm volatile("" : "+s"(w));
    const int lane = tid & 63, r = lane & 15, kg = lane >> 4, half = lane >> 5, sub = lane & 31;
    const int dl = 32 * sub + 16 * half;
    LAS unsigned char* N2 = F.lds + w * 1024;
    const GAS unsigned char* u4 = (const GAS unsigned char*)(A.ws + WS_UB); const GAS unsigned char* v4 = (const GAS unsigned char*)(A.ws + WS_VB);
    const GAS unsigned* idx = (const GAS unsigned*)(A.ws + WS_IDX); const GAS float* gate = (const GAS float*)(A.ws + WS_GATE);
    const GAS float* rowsq = (const GAS float*)(A.ws + WS_ROWSQ2);
#pragma unroll 1
    for (int t = F.gw; t < T; t += F.NGW) {
        GAS float* hrow = (GAS float*)A.out + (size_t)t * D;
        f32x4 hv[4];
        {   const GAS bf16* hb = (const GAS bf16*)(A.ws + WS_HB) + (size_t)t * D + dl;
            float f0[8], f1[8]; unpack8f(*(const GAS v4u*)hb, f0); unpack8f(*(const GAS v4u*)(hb + 8), f1);
            hv[0] = (f32x4){f0[0], f0[1], f0[2], f0[3]}; hv[1] = (f32x4){f0[4], f0[5], f0[6], f0[7]}; hv[2] = (f32x4){f1[0], f1[1], f1[2], f1[3]}; hv[3] = (f32x4){f1[4], f1[5], f1[6], f1[7]}; }
        const float rr = rsqrtf(rowsq[t] * (1.f / 1024.f) + EPS);
        {   v4u pk;
            pk.x = pk4_fp8(hv[0].x * rr, hv[0].y * rr, hv[0].z * rr, hv[0].w * rr); pk.y = pk4_fp8(hv[1].x * rr, hv[1].y * rr, hv[1].z * rr, hv[1].w * rr);
            pk.z = pk4_fp8(hv[2].x * rr, hv[2].y * rr, hv[2].z * rr, hv[2].w * rr); pk.w = pk4_fp8(hv[3].x * rr, hv[3].y * rr, hv[3].z * rr, hv[3].w * rr);
            *(LAS v4u*)(N2 + dl) = pk; }
        unsigned eidx[8]; float gt[8];
#pragma unroll
        for (int eg = 0; eg < 8; ++eg) { eidx[eg] = idx[(size_t)t * 128 + eg * 16 + r]; gt[eg] = gate[(size_t)t * 128 + eg * 16 + r]; }
        LDS_WAIT();
        float actv[8];
        {
            LAS unsigned char* UBw = F.lds + 8192 + w * (2 * 16 * 528);
            v4u xr[8];
#define PU_ROWS(EG) { _Pragma("unroll") for (int j = 0; j < 8; ++j) { const unsigned ea = (unsigned)__builtin_amdgcn_readlane((int)eidx[EG], 2 * j), eb = (unsigned)__builtin_amdgcn_readlane((int)eidx[EG], 2 * j + 1); \
                xr[j] = *(const GAS v4u*)(u4 + (size_t)(half ? eb : ea) * 512 + 16 * sub); } }
            PU_ROWS(0)
#pragma unroll
            for (int eg = 0; eg < 8; ++eg) {
                LAS unsigned char* ub = UBw + (eg & 1) * (16 * 528);
#pragma unroll
                for (int j = 0; j < 8; ++j) *(LAS v4u*)(ub + (2 * j + half) * 528 + 16 * sub) = xr[j];
                if (eg < 7) PU_ROWS(eg + 1)
                __builtin_amdgcn_sched_barrier(0);
                LDS_WAIT();
                f32x4 accg = (f32x4){0.f, 0.f, 0.f, 0.f};
#pragma unroll
                for (int s2 = 0; s2 < 8; ++s2) {
                    const i32x4 a0 = *(const LAS i32x4*)(N2 + 128 * s2 + 16 * kg), a1 = *(const LAS i32x4*)(N2 + 128 * s2 + 64 + 16 * kg);
                    const i32x8 a = (i32x8){a0.x, a0.y, a0.z, a0.w, a1.x, a1.y, a1.z, a1.w};
                    const i32x4 b4 = *(const LAS i32x4*)(ub + r * 528 + 64 * s2 + 16 * kg);
                    const i32x8 b = (i32x8){b4.x, b4.y, b4.z, b4.w, 0, 0, 0, 0};
                    accg = __builtin_amdgcn_mfma_scale_f32_16x16x128_f8f6f4(a, b, accg, 0, 4, 0, MX_ONE, 0, MX_ONE);
                }
                actv[eg] = accg[0];
                __builtin_amdgcn_sched_barrier(0);
            }
#undef PU_ROWS
        }
        bool bad = false;
        if (t == F.gw) {
            float ref = 0.f;
            for (int s = 0; s < 8; ++s) {
                const i32x4 b4 = *(const GAS i32x4*)(u4 + (size_t)eidx[0] * 512 + 64 * s + 16 * kg);
                const int bw[4] = {b4.x, b4.y, b4.z, b4.w};
#pragma unroll
                for (int k = 0; k < 4; ++k) {
                    const lx2 a8 = *(const LAS lx2*)(N2 + 128 * s + 32 * kg + 16 * (k >> 1));
                    const long aw = (k & 1) ? a8.y : a8.x;
                    const int alo = (int)aw, ahi = (int)(aw >> 32);
                    { const f32x2 bf = cvt_fp4x2<0>((unsigned)bw[k]), af = cvt_fp8x2<0>(alo); ref += af.x * bf.x + af.y * bf.y; }
                    { const f32x2 bf = cvt_fp4x2<1>((unsigned)bw[k]), af = cvt_fp8x2<1>(alo); ref += af.x * bf.x + af.y * bf.y; }
                    { const f32x2 bf = cvt_fp4x2<2>((unsigned)bw[k]), af = cvt_fp8x2<0>(ahi); ref += af.x * bf.x + af.y * bf.y; }
                    { const f32x2 bf = cvt_fp4x2<3>((unsigned)bw[k]), af = cvt_fp8x2<1>(ahi); ref += af.x * bf.x + af.y * bf.y; }
                }
            }
            ref += __shfl_xor(ref, 16); ref += __shfl_xor(ref, 32);
            bad = __any(fabsf(ref - actv[0]) > 0.02f * fabsf(ref) + 0.5f);
        }
        float hid[8];
#pragma unroll
        for (int eg = 0; eg < 8; ++eg) hid[eg] = gelu_f(actv[eg] * (1.f / U4_SCALE)) * gt[eg] * (1.f / V4_SCALE);
        f32x2 o2[16];
#pragma unroll
        for (int i = 0; i < 16; ++i) o2[i] = (f32x2){0.f, 0.f};
        v4u xr[2][8]; float shs[2][8];
#define PV_LOAD(EG, BUF) { _Pragma("unroll") for (int pr = 0; pr < 8; ++pr) { \
                const float sha = as_f(__builtin_amdgcn_readlane((int)as_u(hid[EG]), 2 * pr)), shb = as_f(__builtin_amdgcn_readlane((int)as_u(hid[EG]), 2 * pr + 1)); \
                const unsigned sia = (unsigned)__builtin_amdgcn_readlane((int)eidx[EG], 2 * pr), sib = (unsigned)__builtin_amdgcn_readlane((int)eidx[EG], 2 * pr + 1); \
                shs[BUF][pr] = half ? shb : sha; \
                xr[BUF][pr] = *(const GAS v4u*)(v4 + (size_t)(half ? sib : sia) * 512 + 16 * sub); } }
        PV_LOAD(0, 0)
#pragma unroll
        for (int eg = 0; eg < 8; ++eg) {
            if (eg < 7) PV_LOAD(eg + 1, (eg + 1) & 1)
            __builtin_amdgcn_sched_barrier(0);
#pragma unroll
            for (int pr = 0; pr < 8; ++pr) {
                const f32x2 sh2 = (f32x2){shs[eg & 1][pr], shs[eg & 1][pr]};
                const unsigned xw[4] = {xr[eg & 1][pr].x, xr[eg & 1][pr].y, xr[eg & 1][pr].z, xr[eg & 1][pr].w};
#pragma unroll
                for (int k = 0; k < 4; ++k) { o2[4 * k] += sh2 * cvt_fp4x2<0>(xw[k]); o2[4 * k + 1] += sh2 * cvt_fp4x2<1>(xw[k]); o2[4 * k + 2] += sh2 * cvt_fp4x2<2>(xw[k]); o2[4 * k + 3] += sh2 * cvt_fp4x2<3>(xw[k]); }
            }
            __builtin_amdgcn_sched_barrier(0);
        }
#undef PV_LOAD
        float o[16];
#pragma unroll
        for (int i = 0; i < 16; ++i) { o2[i].x += __shfl_xor(o2[i].x, 32); o2[i].y += __shfl_xor(o2[i].y, 32); }
#pragma unroll
        for (int i = 0; i < 8; ++i) { float a0 = o2[i].x, a1 = o2[i].y, b0 = o2[8 + i].x, b1 = o2[8 + i].y; asm volatile("" : "+v"(a0), "+v"(a1), "+v"(b0), "+v"(b1));
            o[2 * i] = half ? b0 : a0; o[2 * i + 1] = half ? b1 : a1; }
        float ss = 0.f; f32x4 h2[4];
        {   const GAS bf16* hb = (const GAS bf16*)(A.ws + WS_HB) + (size_t)t * D + dl;
            float f0[8], f1[8]; unpack8f(*(const GAS v4u*)hb, f0); unpack8f(*(const GAS v4u*)(hb + 8), f1);
            hv[0] = (f32x4){f0[0], f0[1], f0[2], f0[3]}; hv[1] = (f32x4){f0[4], f0[5], f0[6], f0[7]}; hv[2] = (f32x4){f1[0], f1[1], f1[2], f1[3]}; hv[3] = (f32x4){f1[4], f1[5], f1[6], f1[7]}; }
#pragma unroll
        for (int q = 0; q < 4; ++q) { h2[q] = hv[q] + (f32x4){o[4 * q], o[4 * q + 1], o[4 * q + 2], o[4 * q + 3]};
            const f32x4 x = h2[q]; ss += (x.x * x.x + x.y * x.y) + (x.z * x.z + x.w * x.w); }
        ss = wave_sum(ss);
        float r3 = rsqrtf(ss * (1.f / D) + EPS);
#pragma unroll
        for (int q = 0; q < 4; ++q) *(GAS f32x4*)((DRY ? (GAS float*)(A.ws + WS_Q) + (size_t)t * D : hrow) + dl + 4 * q) = h2[q] * r3 * *(const GAS f32x4*)(A.in[18] + dl + 4 * q);
    }
}
__device__ __forceinline__ void p0_transpose_item(const float* W, const float* kscale, int K, int N, bf16* WT, LAS float* scr, int item, int lane) {
    const int nblk = (N + 31) / 32, kb = item / nblk, nb = item % nblk, k0 = 64 * kb, n0 = 32 * nb;
    const int nn = n0 + (lane & 31); const bool ok = nn < N;
    (void)nn; (void)ok;
    {   const int c4 = lane & 7, kr = lane >> 3; const bool okc = n0 + 4 * c4 < N;
        f32x4 v[8];
#pragma unroll
        for (int i = 0; i < 8; ++i) v[i] = okc ? *(const GAS f32x4*)(W + (size_t)(k0 + 8 * i + kr) * N + n0 + 4 * c4) : (f32x4){0.f, 0.f, 0.f, 0.f};
#pragma unroll
        for (int i = 0; i < 8; ++i) { const int kk = 8 * i + kr; const float sc = kscale ? kscale[k0 + kk] : 1.f; LAS float* d = scr + kk * 33 + 4 * c4;
            d[0] = v[i].x * sc; d[1] = v[i].y * sc; d[2] = v[i].z * sc; d[3] = v[i].w * sc; } }
    LDS_WAIT(); asm volatile("" ::: "memory");
    const int c = lane & 7;
#pragma unroll
    for (int j = 0; j < 4; ++j) { const int n = (lane >> 3) + 8 * j; const LAS float* s = scr + (8 * c) * 33 + n;
        v4u o; o.x = pk2(s[0 * 33], s[1 * 33]); o.y = pk2(s[2 * 33], s[3 * 33]); o.z = pk2(s[4 * 33], s[5 * 33]); o.w = pk2(s[6 * 33], s[7 * 33]);
        *(GAS v4u*)(WT + (size_t)(n0 + n) * K + k0 + 8 * c) = o; }
    LDS_WAIT(); asm volatile("" ::: "memory");
}
__device__ __forceinline__ void p0_convert(const Frame& F, const float* src, bf16* dst, size_t n) {
    for (size_t i = ((size_t)F.gw * 64 + F.lane) * 8; i < n; i += (size_t)F.NGW * 512) {
        const f32x4 a = *(const GAS f32x4*)(src + i), b = *(const GAS f32x4*)(src + i + 4);
        v4u o; o.x = pk2(a.x, a.y); o.y = pk2(a.z, a.w); o.z = pk2(b.x, b.y); o.w = pk2(b.z, b.w);
        *(GAS v4u*)(dst + i) = o;
    }
}
__device__ __forceinline__ void p0_convert_fp4(const Frame& F, int wk, int nwk, const float* src, unsigned char* dst, size_t n, float scale, const float* colscale) {
#pragma unroll 4
    for (size_t i = ((size_t)wk * 64 + F.lane) * 32; i < n; i += (size_t)nwk * 2048) {
        unsigned ow[4];
#pragma unroll
        for (int q = 0; q < 4; ++q) {
            f32x4 a = *(const GAS f32x4*)(src + i + 8 * q) * scale, b = *(const GAS f32x4*)(src + i + 8 * q + 4) * scale;
            if (colscale) { a = a * *(const GAS f32x4*)(colscale + ((i + 8 * q) & 1023)); b = b * *(const GAS f32x4*)(colscale + ((i + 8 * q + 4) & 1023)); }
            unsigned pk = 0;
            pk = __builtin_amdgcn_cvt_scalef32_pk_fp4_f32(pk, a.x, a.y, 1.0f, 0); pk = __builtin_amdgcn_cvt_scalef32_pk_fp4_f32(pk, a.z, a.w, 1.0f, 1);
            pk = __builtin_amdgcn_cvt_scalef32_pk_fp4_f32(pk, b.x, b.y, 1.0f, 2); pk = __builtin_amdgcn_cvt_scalef32_pk_fp4_f32(pk, b.z, b.w, 1.0f, 3);
            ow[q] = pk; }
        *(GAS v4u*)(dst + (i >> 1)) = (v4u){ow[0], ow[1], ow[2], ow[3]};
    }
}
__device__ __forceinline__ void p0_prologue(const Frame& F, const Args& A) {
    unsigned char* ws = A.ws;
    LAS float* scr = (LAS float*)(F.lds + RING_OFF + F.wave * 16384);
    constexpr int I_IN = (D / 64) * ((NIN + 31) / 32), I_O = (D / 64) * (D / 32), I_Q = (D / 64) * (NQ / 32);
    for (int it = F.gw; it < I_IN + I_O + I_Q; it += F.NGW) {
        int r = it;
        if (r < I_IN) { p0_transpose_item(A.in[2], A.in[1], D, NIN, (bf16*)(ws + WS_WIN), scr, r, F.lane); continue; } r -= I_IN;
        if (r < I_O) { p0_transpose_item(A.in[12], nullptr, D, D, (bf16*)(ws + WS_WO), scr, r, F.lane); continue; } r -= I_O;
        p0_transpose_item(A.in[14], A.in[13], D, NQ, (bf16*)(ws + WS_WQ), scr, r, F.lane);
    }
    for (int m0 = F.gw * 4; m0 < T; m0 += F.NGW * 4) {
        f32x4 v[4][4]; float s[4] = {0.f, 0.f, 0.f, 0.f};
#pragma unroll
        for (int u = 0; u < 4; ++u) { const GAS f32x4* xr = (const GAS f32x4*)(A.in[0] + (size_t)(m0 + u) * D) + F.lane;
#pragma unroll
            for (int j = 0; j < 4; ++j) v[u][j] = xr[64 * j]; }
#pragma unroll
        for (int u = 0; u < 4; ++u) {
#pragma unroll
            for (int j = 0; j < 4; ++j) s[u] += (v[u][j].x * v[u][j].x + v[u][j].y * v[u][j].y) + (v[u][j].z * v[u][j].z + v[u][j].w * v[u][j].w);
            GAS unsigned long long* o8 = (GAS unsigned long long*)((bf16*)(ws + WS_XB) + (size_t)(m0 + u) * D) + F.lane;
#pragma unroll
            for (int j = 0; j < 4; ++j) o8[64 * j] = (unsigned long long)pk2(v[u][j].x, v[u][j].y) | ((unsigned long long)pk2(v[u][j].z, v[u][j].w) << 32); }
#pragma unroll
        for (int u = 0; u < 4; ++u) s[u] = wave_sum(s[u]);
        if (F.lane < 4) { const float sv = F.lane == 0 ? s[0] : (F.lane == 1 ? s[1] : (F.lane == 2 ? s[2] : s[3])); ((float*)(ws + WS_RRMS1))[m0 + F.lane] = rsqrtf(sv * (1.f / D) + EPS); ((float*)(ws + WS_ROWSQ2))[m0 + F.lane] = 0.f; }
    }
    p0_convert(F, A.in[15], (bf16*)(ws + WS_SUBK), (size_t)8 * 2 * 128 * 128);
    p0_convert_fp4(F, F.gw, F.NGW, A.in[16], ws + WS_UB, (size_t)16384 * 1024, 48.f, A.in[13]);
    p0_convert_fp4(F, F.gw, F.NGW, A.in[17], ws + WS_VB, (size_t)16384 * 1024, 4.25f, nullptr);
}

#ifndef PROBE_MASK
#define PROBE_MASK 0
#endif
__device__ __forceinline__ int probe_reps(int k) { int n = ((PROBE_MASK >> k) & 1) + 1; return n; }
__global__ void __launch_bounds__(NWAVES * 64, 2) fwd(Args args) {
    extern __shared__ __attribute__((aligned(16))) unsigned char lds[];
    Frame F;
    F.lds = (LAS unsigned char*)lds;
    F.MISC = (volatile LAS unsigned*)(F.lds + MISC_OFF);
    F.tid = threadIdx.x; F.lane = F.tid & 63; F.wave = __builtin_amdgcn_readfirstlane(F.tid >> 6);
    F.G = gridDim.x; F.gw = blockIdx.x * NWAVES + F.wave; F.NGW = F.G * NWAVES;
    unsigned char* ws = args.ws;
    F.ctl = (gu32*)(ws + WS_CTL);
    for (int u = F.tid; u < (LDS_BYTES - LDSCTL_OFF) / 4; u += NWAVES * 64) ((LAS unsigned*)(F.lds + LDSCTL_OFF))[u] = 0u;
    __syncthreads();
    XcdBarrier bar = xcd_barrier_post((unsigned*)(F.ctl + CW_BAR), F.MISC + 8);
    const int lo = args.ph_lo, hi = args.ph_hi;
#define IN(k) (lo <= (k) && (k) < hi)
#define BOTH(k) (IN(k) && IN((k) + 1))
#define GRID_BAR() xcd_barrier(bar)
#define REP(k) for (int rep_ = 0, nrep_ = probe_reps(k); rep_ < nrep_; ++rep_)

    if (IN(0)) REP(0) { p0_prologue(F, args); if (BOTH(0)) GRID_BAR(); }
    if (IN(1)) REP(1) {
        pg8::Gemm g{(const bf16*)(ws + WS_XB), (const bf16*)(ws + WS_WIN), T, NINP, D}; pg8::StaticOrder S; S.init(T, NINP, F.G, (int)blockIdx.x);
        pg8::EpiRowScaleBf16 E{(bf16*)(ws + WS_PROJ), NINP, (const float*)(ws + WS_RRMS1)};
        pg8::gemm_phase<pg8::EpiRowScaleBf16, pg8::StaticOrder, true, true>(F.lds + RING_OFF, g, S, E);
        if (BOTH(1)) GRID_BAR();
    }
    if (IN(2)) {
        REP(2) { for (int u = blockIdx.x; u < 256; u += F.G) ssd_unit<0>(F, args, u); }
        REP(13) { for (int u = blockIdx.x; u < 1024; u += F.G) gla_unit<0>(F, args, u); }
        if (BOTH(2)) GRID_BAR();
    }
    if (IN(3)) { if ((PROBE_MASK >> 3) & 1) { scan_phase<true>(F, args); GRID_BAR(); } scan_phase<false>(F, args); if (BOTH(3)) GRID_BAR(); }
    if (IN(4)) {
        REP(4) { for (int u = blockIdx.x; u < 256; u += F.G) ssd_unit<1>(F, args, u); }
        REP(12) { for (int u = blockIdx.x; u < 1024; u += F.G) gla_unit<1>(F, args, u); }
        if (BOTH(4)) GRID_BAR();
    }
    if (IN(5)) {
        pg8::Gemm g{(const bf16*)(ws + WS_MIX), (const bf16*)(ws + WS_WO), T, D, D}; pg8::StaticOrder S; S.init(T, D, F.G, (int)blockIdx.x);
        if ((PROBE_MASK >> 5) & 1) { pg8::EpiResidual Ed{(const bf16*)(ws + WS_XB), (bf16*)(ws + 208 * MiB), (float*)(ws + 240 * MiB), D};
            pg8::gemm_phase<pg8::EpiResidual, pg8::StaticOrder, true, true>(F.lds + RING_OFF, g, S, Ed); GRID_BAR(); }
        pg8::EpiResidual E{(const bf16*)(ws + WS_XB), (bf16*)(ws + WS_HB), (float*)(ws + WS_ROWSQ2), D};
        pg8::gemm_phase<pg8::EpiResidual, pg8::StaticOrder, true, true>(F.lds + RING_OFF, g, S, E);
        if (BOTH(5)) GRID_BAR();
    }
    if (IN(6)) REP(6) {
        pg8::Gemm g{(const bf16*)(ws + WS_HB), (const bf16*)(ws + WS_WQ), T, NQ, D}; pg8::StaticOrder S; S.init(T, NQ, F.G, (int)blockIdx.x);
        pg8::EpiRsqScaleBf16 E{(bf16*)(ws + WS_Q), NQ, (const float*)(ws + WS_ROWSQ2)};
        pg8::gemm_phase<pg8::EpiRsqScaleBf16, pg8::StaticOrder, true, true>(F.lds + RING_OFF, g, S, E);
        if (BOTH(6)) GRID_BAR();
    }
    if (IN(7)) REP(7) { topk_phase(F, args); if (BOTH(7)) GRID_BAR(); }
    if (IN(8)) { if ((PROBE_MASK >> 8) & 1) { expert_phase<true>(F, args); GRID_BAR(); } expert_phase<false>(F, args); }
#undef IN
#undef BOTH
}
namespace nv {
struct ProjF32 { const float* p; __device__ __forceinline__ float operator()(size_t row, int c) const { return p[row * NIN + c]; } };
struct ProjBf { const unsigned short* p; __device__ __forceinline__ float operator()(size_t row, int c) const { return bf2f(p[row * NINP + c]); } };
__device__ __forceinline__ float silu_f(float x) { return x / (1.f + expf(-x)); }
__device__ __forceinline__ float softplus_f(float x) { return fmaxf(x, 0.f) + log1pf(expf(-fabsf(x))); }
__device__ __forceinline__ float logsigmoid_f(float x) { return fminf(x, 0.f) - log1pf(expf(-fabsf(x))); }
__device__ __forceinline__ float gelu_f(float x) { return 0.5f * x * (1.f + erff(x * 0.70710678118654752f)); }

__global__ void __launch_bounds__(256) k_rmsnorm(const float* __restrict__ x, const float* __restrict__ w, float* __restrict__ out) {
    const int row = blockIdx.x * 4 + (threadIdx.x >> 6), lane = threadIdx.x & 63;
    const float4* xr = (const float4*)(x + (size_t)row * D);
    float4 v[4]; float s = 0.f;
#pragma unroll
    for (int j = 0; j < 4; ++j) { v[j] = xr[lane + 64 * j]; s += v[j].x * v[j].x + v[j].y * v[j].y + v[j].z * v[j].z + v[j].w * v[j].w; }
    s = wave_sum(s);
    const float r = rsqrtf(s * (1.f / D) + EPS);
    float4* o = (float4*)(out + (size_t)row * D);
#pragma unroll
    for (int j = 0; j < 4; ++j) { const float4 ww = ((const float4*)w)[lane + 64 * j]; float4 y; y.x = v[j].x * r * ww.x; y.y = v[j].y * r * ww.y; y.z = v[j].z * r * ww.z; y.w = v[j].w * r * ww.w; o[lane + 64 * j] = y; }
}

template <bool ADD>
__global__ void __launch_bounds__(256) k_gemm(const float* __restrict__ A, const float* __restrict__ B, const float* __restrict__ R, float* __restrict__ C, int M, int N, int K, int ldb) {
    __shared__ float As[16][68];
    __shared__ float Bs[16][68];
    const int tid = threadIdx.x, tx = tid & 15, ty = tid >> 4;
    const int row0 = blockIdx.y * 64, col0 = blockIdx.x * 64;
    float acc[4][4];
#pragma unroll
    for (int i = 0; i < 4; ++i)
#pragma unroll
        for (int j = 0; j < 4; ++j) acc[i][j] = 0.f;
    const int ar = tid >> 2, akq = tid & 3;
    const int bk = tid >> 4, bn = (tid & 15) * 4;
    for (int k0 = 0; k0 < K; k0 += 16) {
        const float4 av = *(const float4*)(A + (size_t)(row0 + ar) * K + k0 + akq * 4);
        float4 bv = make_float4(0.f, 0.f, 0.f, 0.f);
        if (col0 + bn < N) bv = *(const float4*)(B + (size_t)(k0 + bk) * ldb + col0 + bn);
        __syncthreads();
        As[akq * 4 + 0][ar] = av.x; As[akq * 4 + 1][ar] = av.y; As[akq * 4 + 2][ar] = av.z; As[akq * 4 + 3][ar] = av.w;
        *(float4*)&Bs[bk][bn] = bv;
        __syncthreads();
#pragma unroll
        for (int kk = 0; kk < 16; ++kk) {
            const float4 a = *(const float4*)&As[kk][ty * 4];
            const float4 b = *(const float4*)&Bs[kk][tx * 4];
            const float aa[4] = {a.x, a.y, a.z, a.w}, bb[4] = {b.x, b.y, b.z, b.w};
#pragma unroll
            for (int i = 0; i < 4; ++i)
#pragma unroll
                for (int j = 0; j < 4; ++j) acc[i][j] += aa[i] * bb[j];
        }
    }
    if (col0 + tx * 4 < N) {
#pragma unroll
        for (int i = 0; i < 4; ++i) {
            const size_t off = (size_t)(row0 + ty * 4 + i) * N + col0 + tx * 4;
            float4 o = make_float4(acc[i][0], acc[i][1], acc[i][2], acc[i][3]);
            if (ADD) { const float4 r = *(const float4*)(R + off); o.x += r.x; o.y += r.y; o.z += r.z; o.w += r.w; }
            *(float4*)(C + off) = o;
        }
    }
}

template <class P> __global__ void __launch_bounds__(256) k_gla_gate(const P proj, const float* __restrict__ w2, const float* __restrict__ bg, float* __restrict__ alpha) {
    const int t = blockIdx.x, c = threadIdx.x;
    float acc = bg[c];
#pragma unroll
    for (int r = 0; r < 16; ++r) acc += proj((size_t)t, C_GLR + r) * w2[r * 256 + c];
    alpha[(size_t)t * 256 + c] = expf(logsigmoid_f(acc) * (1.f / 16.f));
}

template <class P> __global__ void __launch_bounds__(128) k_gla_rec(const P proj, const float* __restrict__ alpha, float* __restrict__ mixed) {
    const int b = blockIdx.x >> 2, h = blockIdx.x & 3, dv = threadIdx.x;
    float S[64];
#pragma unroll
    for (int d = 0; d < 64; ++d) S[d] = 0.f;
    for (int t = 0; t < SEQ; ++t) {
        const size_t row = (size_t)b * SEQ + t;
        const float* al = alpha + row * 256 + h * 64;
        const float v = proj(row, C_V + h * 128 + dv);
        float o = 0.f;
#pragma unroll
        for (int d = 0; d < 64; ++d) {
            S[d] = al[d] * S[d] + proj(row, C_K + h * 64 + d) * v;
            o += proj(row, C_Q + h * 64 + d) * S[d];
        }
        mixed[row * D + h * 128 + dv] = o * 0.125f;
    }
}

template <class P> __global__ void __launch_bounds__(256) k_gla_finish(const P proj, const float* __restrict__ nw, float* __restrict__ mixed) {
    const int t = blockIdx.x, h = threadIdx.x >> 6, lane = threadIdx.x & 63;
    float* m = mixed + (size_t)t * D + h * 128;
    const float a = m[lane], b = m[lane + 64];
    const float s = wave_sum(a * a + b * b);
    const float r = rsqrtf(s * (1.f / 128.f) + EPS);
    m[lane] = a * r * nw[lane] * silu_f(proj((size_t)t, C_GOUT + h * 128 + lane));
    m[lane + 64] = b * r * nw[lane + 64] * silu_f(proj((size_t)t, C_GOUT + h * 128 + lane + 64));
}

template <class P> __global__ void __launch_bounds__(256) k_ssd_conv(const P proj, const float* __restrict__ cw, const float* __restrict__ cb, const float* __restrict__ dtb,
                                                  float* __restrict__ xc, float* __restrict__ dt) {
    const int t = blockIdx.x, l = t & (SEQ - 1);
    for (int c = threadIdx.x; c < 768; c += 256) {
        float acc = cb[c];
#pragma unroll
        for (int j = 0; j < 4; ++j) { const int ll = l - 3 + j; if (ll >= 0) acc += cw[j * 768 + c] * proj((size_t)(t - 3 + j), C_XBC + c); }
        xc[(size_t)t * 768 + c] = silu_f(acc);
    }
    if (threadIdx.x < 8) dt[(size_t)t * 8 + threadIdx.x] = softplus_f(proj((size_t)t, C_DT + threadIdx.x) + dtb[threadIdx.x]);
}

__global__ void __launch_bounds__(64) k_ssd_rec(const float* __restrict__ xc, const float* __restrict__ dt, const float* __restrict__ a_log, const float* __restrict__ dsk, float* __restrict__ mixed) {
    const int b = blockIdx.x >> 3, hd = blockIdx.x & 7, g = hd >> 2, p = threadIdx.x;
    const float A = -expf(a_log[hd]), Dk = dsk[hd];
    float hs[64];
#pragma unroll
    for (int n = 0; n < 64; ++n) hs[n] = 0.f;
    for (int t = 0; t < SEQ; ++t) {
        const size_t row = (size_t)b * SEQ + t;
        const float dtv = dt[row * 8 + hd];
        const float dA = expf(dtv * A);
        const float* xr = xc + row * 768;
        const float x = xr[hd * 64 + p], xdt = x * dtv;
        float y = 0.f;
#pragma unroll
        for (int n = 0; n < 64; ++n) {
            hs[n] = dA * hs[n] + xr[512 + g * 64 + n] * xdt;
            y += xr[640 + g * 64 + n] * hs[n];
        }
        mixed[row * D + 512 + hd * 64 + p] = y + x * Dk;
    }
}

template <class P> __global__ void __launch_bounds__(128) k_ssd_finish(const P proj, const float* __restrict__ nw, float* __restrict__ mixed) {
    const int t = blockIdx.x, g = threadIdx.x >> 6, lane = threadIdx.x & 63;
    float* m = mixed + (size_t)t * D + 512 + g * 256;
    float y[4]; float s = 0.f;
#pragma unroll
    for (int j = 0; j < 4; ++j) { y[j] = m[lane + 64 * j] * silu_f(proj((size_t)t, C_Z + g * 256 + lane + 64 * j)); s += y[j] * y[j]; }
    s = wave_sum(s);
    const float r = rsqrtf(s * (1.f / 256.f) + EPS);
#pragma unroll
    for (int j = 0; j < 4; ++j) m[lane + 64 * j] = y[j] * r * nw[g * 256 + lane + 64 * j];
}

__global__ void __launch_bounds__(256) k_topk(const float* __restrict__ q_lo, const float* __restrict__ q_hi, const float* __restrict__ subk, int* __restrict__ idx, float* __restrict__ gate) {
    __shared__ float s[256];
    __shared__ float ts[2][16];
    __shared__ int ti[2][16];
    __shared__ float cs[256];
    __shared__ float bs[16];
    __shared__ int be[16];
    const int t = blockIdx.x >> 3, h = blockIdx.x & 7, tid = threadIdx.x, p = tid >> 7, k = tid & 127;
    const float4* qv = (const float4*)((h < 4 ? q_lo : q_hi) + (size_t)t * 1024 + (h & 3) * 256 + p * 128);
    const float4* kr = (const float4*)(subk + (((size_t)h * 2 + p) * 128 + k) * 128);
    float acc = 0.f;
#pragma unroll 8
    for (int d = 0; d < 32; ++d) { const float4 a = qv[d], b = kr[d]; acc += a.x * b.x + a.y * b.y + a.z * b.z + a.w * b.w; }
    s[tid] = acc;
    __syncthreads();
    int r = 0;
    for (int j = 0; j < 128; ++j) { const float o = s[p * 128 + j]; r += (o > acc || (o == acc && j < k)) ? 1 : 0; }
    if (r < 16) { ts[p][r] = acc; ti[p][r] = k; }
    __syncthreads();
    const int i = tid >> 4, j2 = tid & 15;
    const float c = ts[0][i] + ts[1][j2];
    cs[tid] = c;
    __syncthreads();
    r = 0;
    for (int m = 0; m < 256; ++m) { const float o = cs[m]; r += (o > c || (o == c && m < tid)) ? 1 : 0; }
    if (r < 16) { bs[r] = c; be[r] = ti[0][i] * 128 + ti[1][j2]; }
    __syncthreads();
    if (tid < 16) {
        const float mx = bs[0];
        float den = 0.f;
#pragma unroll
        for (int m = 0; m < 16; ++m) den += expf(bs[m] - mx);
        gate[(size_t)t * 128 + h * 16 + tid] = expf(bs[tid] - mx) / den;
        idx[(size_t)t * 128 + h * 16 + tid] = be[tid];
    }
}

__global__ void __launch_bounds__(256) k_expert(const float* __restrict__ hres, const float* __restrict__ u, const float* __restrict__ v, const int* __restrict__ idx, const float* __restrict__ gate,
                                                const float* __restrict__ nfw, float* out) {
    __shared__ float hid[128];
    __shared__ int eid[128];
    __shared__ float red[4];
    const int t = blockIdx.x, tid = threadIdx.x, w = tid >> 6, lane = tid & 63;
    if (tid < 128) eid[tid] = idx[(size_t)t * 128 + tid];
    float4 xv[4];
#pragma unroll
    for (int j = 0; j < 4; ++j) xv[j] = ((const float4*)(out + (size_t)t * D))[lane + 64 * j];
    __syncthreads();
    for (int e = w * 32; e < w * 32 + 32; ++e) {
        const float4* ur = (const float4*)(u + (size_t)eid[e] * D);
        float s = 0.f;
#pragma unroll
        for (int j = 0; j < 4; ++j) { const float4 a = ur[lane + 64 * j]; s += a.x * xv[j].x + a.y * xv[j].y + a.z * xv[j].z + a.w * xv[j].w; }
        s = wave_sum(s);
        if (lane == 0) hid[e] = gelu_f(s) * gate[(size_t)t * 128 + e];
    }
    __syncthreads();
    float4 acc = ((const float4*)(hres + (size_t)t * D))[tid];
    for (int e = 0; e < 128; ++e) {
        const float4 vv = ((const float4*)(v + (size_t)eid[e] * D))[tid];
        const float hh = hid[e];
        acc.x += hh * vv.x; acc.y += hh * vv.y; acc.z += hh * vv.z; acc.w += hh * vv.w;
    }
    float ss = acc.x * acc.x + acc.y * acc.y + acc.z * acc.z + acc.w * acc.w;
    ss = wave_sum(ss);
    if (lane == 0) red[w] = ss;
    __syncthreads();
    const float tot = red[0] + red[1] + red[2] + red[3];
    const float r = rsqrtf(tot * (1.f / D) + EPS);
    const float4 ww = ((const float4*)nfw)[tid];
    float4 o; o.x = acc.x * r * ww.x; o.y = acc.y * r * ww.y; o.z = acc.z * r * ww.z; o.w = acc.w * r * ww.w;
    ((float4*)(out + (size_t)t * D))[tid] = o;
}
__global__ void __launch_bounds__(256) k_bf2f(const unsigned short* __restrict__ src, float* __restrict__ dst, size_t n) {
    for (size_t i = (size_t)blockIdx.x * 256 + threadIdx.x; i < n; i += (size_t)gridDim.x * 256) dst[i] = bf2f(src[i]);
}
}
extern "C" void kernel_launch(void* const* d_in, const int* in_sizes, int n_in, void* d_out, int out_size, void* d_ws, size_t ws_size, hipStream_t stream) {
    static int grid = 0;
    if (grid == 0) {
        if (n_in != 19 || out_size != T * D || ws_size < 256 * MiB) { fprintf(stderr, "kernel_launch: unexpected shapes n_in %d out %d ws %zu\n", n_in, out_size, ws_size); grid = -1; return; }
        int dev = 0, cus = 0, per_cu = 0;
        if (hipGetDevice(&dev) != hipSuccess || hipDeviceGetAttribute(&cus, hipDeviceAttributeMultiprocessorCount, dev) != hipSuccess) { grid = -1; return; }
        if (hipFuncSetAttribute((const void*)fwd, hipFuncAttributeMaxDynamicSharedMemorySize, LDS_BYTES) != hipSuccess) { fprintf(stderr, "kernel_launch: hipFuncSetAttribute failed\n"); grid = -1; return; }
        if (hipOccupancyMaxActiveBlocksPerMultiprocessor(&per_cu, (const void*)fwd, NWAVES * 64, LDS_BYTES) != hipSuccess || per_cu < 1) { fprintf(stderr, "kernel_launch: occupancy query says %d\n", per_cu); }
        (void)hipGetLastError();
        grid = cus;
    }
    if (grid < 0) return;
    const float* x = (const float*)d_in[0];
    const float* gla_w2 = (const float*)d_in[3];
    const float* gla_bg = (const float*)d_in[4];
    const float* gla_nw = (const float*)d_in[5];
    const float* conv_w = (const float*)d_in[6];
    const float* conv_b = (const float*)d_in[7];
    const float* dt_bias = (const float*)d_in[8];
    const float* a_log = (const float*)d_in[9];
    const float* d_skip = (const float*)d_in[10];
    const float* ssd_nw = (const float*)d_in[11];
    const float* w_out = (const float*)d_in[12];
    const float* norm_ffn_w = (const float*)d_in[13];
    const float* w_query = (const float*)d_in[14];
    const float* sub_keys = (const float*)d_in[15];
    const float* pu = (const float*)d_in[16];
    const float* pv = (const float*)d_in[17];
    const float* norm_final_w = (const float*)d_in[18];
    float* out = (float*)d_out;
    char* ws = (char*)d_ws;

    (void)hipMemsetAsync(ws + WS_CTL, 0, CTL_ZERO_BYTES, stream);
    Args a{};
    for (int i = 0; i < 19; ++i) a.in[i] = (const float*)d_in[i];
    a.out = out; a.ws = (unsigned char*)d_ws; a.ph_lo = 0; a.ph_hi = 9;
    hipLaunchKernelGGL(fwd, dim3(grid), dim3(NWAVES * 64), LDS_BYTES, stream, a);

}
```

```cpp
#include <hip/hip_runtime.h>
#include <cstdio>
#include <cstdint>
namespace pg8 {
#define PG8_LAS __attribute__((address_space(3)))
typedef unsigned short bf16_t;
typedef short bf16x8 __attribute__((ext_vector_type(8)));
typedef float f32x4 __attribute__((ext_vector_type(4)));
typedef unsigned u32x4 __attribute__((ext_vector_type(4)));
constexpr int BM = 256, BK = 64, HALF = 128, HTB = HALF * BK * 2  , STAGE_BYTES = 8 * HTB, NXCD = 8, WGM = 8;

__host__ __device__ __forceinline__ int lds_byte(int r, int c) { const int st = (r >> 4) * 2 + (c >> 5), rr = r & 15, cc = c & 31, ob = rr * 64 + cc * 2; return st * 1024 + (ob ^ (((ob >> 9) & 1) << 5)); }
__host__ __device__ __forceinline__ void stage_rc(int b, int& R, int& C) { const int st = b / 1024, sb = b % 1024, swz = sb ^ (((sb >> 9) & 1) << 5); R = (st >> 1) * 16 + swz / 64; C = (st & 1) * 32 + (swz % 64) / 2; }
__host__ __device__ __forceinline__ int perm32(int rho) { const int n = rho >> 4, i = rho & 15; return 8 * (i >> 2) + 4 * n + (i & 3); }

struct Unit { int pm, pn; };
struct Gemm { const bf16_t* A; const bf16_t* Bt; int M, N, K; };

struct StaticOrder {
    int nM, nN, nwg, G, c;
    __host__ __device__ void init(int M, int N, int G_, int c_) { nM = M / BM; nN = N / BM; nwg = nM * nN; G = G_; c = c_; }
    __host__ __device__ bool next(int i, Unit& u) const {
        const long L = (long)i * G + c; if (L >= nwg) return false;
        int wgid = (int)L; { const int q = nwg / NXCD, r = nwg % NXCD, xcd = wgid % NXCD, off = wgid / NXCD; wgid = (xcd < r ? xcd * (q + 1) : r * (q + 1) + (xcd - r) * q) + off; }
        const int nig = WGM * nN, gid = wgid / nig, fm = gid * WGM, gsz = (nM - fm) < WGM ? (nM - fm) : WGM;
        u.pm = fm + ((wgid % nig) % gsz); u.pn = (wgid % nig) / gsz; return true;
    }
    __device__ __forceinline__ void a_ready(const Unit&) const {}
    __device__ __forceinline__ void done(const Unit&) const {}
};

__device__ __forceinline__ unsigned cvt_pk_bf16(float lo, float hi) { unsigned r; asm volatile("v_cvt_pk_bf16_f32 %0, %1, %2" : "=v"(r) : "v"(lo), "v"(hi)); return r; }
typedef float f32x2 __attribute__((ext_vector_type(2)));
struct EpiRowScaleBf16 {
    static constexpr bool PERM = true, AFTER_DRAIN = false;
    bf16_t* O; int ldc; const float* rs;
    __device__ __forceinline__ void operator()(const f32x4 (&acc)[2][2][4][2], const Unit& u, int wr, int wc, int fr, int fq) const {
        const int row0 = u.pm * BM + wr * 64 + fr, col0 = u.pn * BM + wc * 32 + 8 * fq;
#pragma unroll
        for (int ai = 0; ai < 2; ++ai)
#pragma unroll
            for (int m = 0; m < 4; ++m) { const int row = row0 + ai * HALF + m * 16; const float sc = rs[row]; bf16_t* rowp = O + (size_t)row * ldc + col0;
#pragma unroll
                for (int bj = 0; bj < 2; ++bj) { const f32x4 v0 = acc[ai][bj][m][0] * sc, v1 = acc[ai][bj][m][1] * sc;
                    u32x4 w; w.x = cvt_pk_bf16(v0[0], v0[1]); w.y = cvt_pk_bf16(v0[2], v0[3]); w.z = cvt_pk_bf16(v1[0], v1[1]); w.w = cvt_pk_bf16(v1[2], v1[3]);
                    *(u32x4*)(rowp + bj * HALF) = w; } }
    }
};
struct EpiRsqScaleBf16 {
    static constexpr bool PERM = true, AFTER_DRAIN = false;
    bf16_t* O; int ldc; const float* rowsq;
    __device__ __forceinline__ void operator()(const f32x4 (&acc)[2][2][4][2], const Unit& u, int wr, int wc, int fr, int fq) const {
        const int row0 = u.pm * BM + wr * 64 + fr, col0 = u.pn * BM + wc * 32 + 8 * fq;
#pragma unroll
        for (int ai = 0; ai < 2; ++ai)
#pragma unroll
            for (int m = 0; m < 4; ++m) { const int row = row0 + ai * HALF + m * 16; const float sc = rsqrtf(rowsq[row] * (1.f / 1024.f) + 1e-6f); bf16_t* rowp = O + (size_t)row * ldc + col0;
#pragma unroll
                for (int bj = 0; bj < 2; ++bj) { const f32x4 v0 = acc[ai][bj][m][0] * sc, v1 = acc[ai][bj][m][1] * sc;
                    u32x4 w; w.x = cvt_pk_bf16(v0[0], v0[1]); w.y = cvt_pk_bf16(v0[2], v0[3]); w.z = cvt_pk_bf16(v1[0], v1[1]); w.w = cvt_pk_bf16(v1[2], v1[3]);
                    *(u32x4*)(rowp + bj * HALF) = w; } }
    }
};
struct EpiResidual {
    static constexpr bool PERM = true, AFTER_DRAIN = false;
    const bf16_t* X; bf16_t* HB; float* rowsq; int ldc;
    __device__ __forceinline__ void operator()(const f32x4 (&acc)[2][2][4][2], const Unit& u, int wr, int wc, int fr, int fq) const {
        const int row0 = u.pm * BM + wr * 64 + fr, col0 = u.pn * BM + wc * 32 + 8 * fq;
#pragma unroll
        for (int ai = 0; ai < 2; ++ai)
#pragma unroll
            for (int m = 0; m < 4; ++m) { const int row = row0 + ai * HALF + m * 16; float ss = 0.f;
#pragma unroll
                for (int bj = 0; bj < 2; ++bj) { const size_t off = (size_t)row * ldc + col0 + bj * HALF;
                    const u32x4 xv = *(const u32x4*)(X + off);
                    const f32x4 x0 = (f32x4){__builtin_bit_cast(float, xv.x << 16), __builtin_bit_cast(float, xv.x & 0xffff0000u), __builtin_bit_cast(float, xv.y << 16), __builtin_bit_cast(float, xv.y & 0xffff0000u)};
                    const f32x4 x1 = (f32x4){__builtin_bit_cast(float, xv.z << 16), __builtin_bit_cast(float, xv.z & 0xffff0000u), __builtin_bit_cast(float, xv.w << 16), __builtin_bit_cast(float, xv.w & 0xffff0000u)};
                    const f32x4 v0 = acc[ai][bj][m][0] + x0, v1 = acc[ai][bj][m][1] + x1;
                    u32x4 w; w.x = cvt_pk_bf16(v0[0], v0[1]); w.y = cvt_pk_bf16(v0[2], v0[3]); w.z = cvt_pk_bf16(v1[0], v1[1]); w.w = cvt_pk_bf16(v1[2], v1[3]);
                    *(u32x4*)(HB + off) = w;
                    ss += (v0[0] * v0[0] + v0[1] * v0[1]) + (v0[2] * v0[2] + v0[3] * v0[3]) + (v1[0] * v1[0] + v1[1] * v1[1]) + (v1[2] * v1[2] + v1[3] * v1[3]); }
                ss += __shfl_xor(ss, 16); ss += __shfl_xor(ss, 32);
                if (fq == 0) atomicAdd(rowsq + row, ss); }
    }
};
template <class Epi, class Sched, bool ALIGN_EPI = false, bool SP2 = false>
__device__ __forceinline__ void gemm_phase(PG8_LAS unsigned char* lds, const Gemm g, const Sched& S, const Epi& E) {
    const int tid = threadIdx.x, wid = __builtin_amdgcn_readfirstlane(tid >> 6), lane = tid & 63, wr = wid >> 2, wc = wid & 3, fr = lane & 15, fq = lane >> 4;
    const int K = g.K, nt = K / BK;
    unsigned voffA[2], voffB[2];
#pragma unroll
    for (int i = 0; i < 2; ++i) { int R, C; stage_rc(tid * 16 + i * 8192, R, C); const int Rb = Epi::PERM ? ((R & ~31) + perm32(R & 31)) : R;
        voffA[i] = (unsigned)(R * K + C) * 2u; voffB[i] = (unsigned)(Rb * K + C) * 2u; }
    const size_t kstep = (size_t)(BK * 2);
    const size_t hstep = (size_t)HALF * K * 2;
    const size_t tstep = 2 * hstep;
    const unsigned ldsw = (unsigned)wid * 1024u;
    const int aoff = lds_byte(wr * 64 + fr, fq * 8), boff = lds_byte(wc * 32 + fr, fq * 8);
#define PG8_SA(b, h) (((b) * 2 + (h)) * HTB)
#define PG8_SB(b, h) ((4 + (b) * 2 + (h)) * HTB)
#define PG8_STAGE(bufoff, gbase, voff) do { _Pragma("unroll") for (int _i = 0; _i < 2; ++_i) \
        __builtin_amdgcn_global_load_lds((const unsigned*)((const char*)(gbase) + (voff)[_i]), (PG8_LAS unsigned*)(lds + (bufoff) + ldsw + _i * 8192), 16, 0, 0); } while (0)
#define PG8_LDA(dst, b, h) do { _Pragma("unroll") for (int m = 0; m < 4; ++m) _Pragma("unroll") for (int k = 0; k < 2; ++k) dst[m][k] = *(const PG8_LAS bf16x8*)(lds + PG8_SA(b, h) + aoff + m * 2048 + k * 1024); } while (0)
#define PG8_LDB(dst, b, h) do { _Pragma("unroll") for (int n = 0; n < 2; ++n) _Pragma("unroll") for (int k = 0; k < 2; ++k) dst[n][k] = *(const PG8_LAS bf16x8*)(lds + PG8_SB(b, h) + boff + n * 2048 + k * 1024); } while (0)
#define PG8_MMA(ai, bj, At, Bt) do { __builtin_amdgcn_s_setprio(1); _Pragma("unroll") for (int m = 0; m < 4; ++m) _Pragma("unroll") for (int n = 0; n < 2; ++n) _Pragma("unroll") for (int k = 0; k < 2; ++k) \
        acc[ai][bj][m][n] = __builtin_amdgcn_mfma_f32_16x16x32_bf16(Bt[n][k], At[m][k], acc[ai][bj][m][n], 0, 0, 0); __builtin_amdgcn_s_setprio(0); } while (0)
#define PG8_WAIT_V(n) asm volatile("s_waitcnt vmcnt(" #n ")" ::: "memory")
#define PG8_WAIT_L(n) asm volatile("s_waitcnt lgkmcnt(" #n ")" ::: "memory")
#define PG8_BAR __builtin_amdgcn_s_barrier()
#define PG8_SCHED __builtin_amdgcn_sched_barrier(0)
    Unit cur, nxt; int ui = 0;
    if (!S.next(0, cur)) return;
    f32x4 acc[2][2][4][2];
#pragma unroll
    for (int a = 0; a < 2; ++a)
#pragma unroll
        for (int b = 0; b < 2; ++b)
#pragma unroll
            for (int m = 0; m < 4; ++m)
#pragma unroll
                for (int n = 0; n < 2; ++n) acc[a][b][m][n] = (f32x4){0.f, 0.f, 0.f, 0.f};
    bf16x8 At[4][2], B0[2][2], B1[2][2];
    const char* cA = (const char*)g.A + (size_t)cur.pm * tstep; const char* cB = (const char*)g.Bt + (size_t)cur.pn * tstep;
    S.a_ready(cur);
    if constexpr (SP2) {
        PG8_STAGE(PG8_SB(0, 0), cB, voffB); PG8_STAGE(PG8_SB(0, 1), cB + hstep, voffB); PG8_STAGE(PG8_SA(0, 0), cA, voffA); PG8_STAGE(PG8_SA(0, 1), cA + hstep, voffA);
        if (wr == 1) PG8_BAR;
        PG8_WAIT_V(2); PG8_BAR;
        PG8_STAGE(PG8_SB(1, 0), cB + kstep, voffB); PG8_STAGE(PG8_SA(1, 0), cA + kstep, voffA); PG8_STAGE(PG8_SB(1, 1), cB + hstep + kstep, voffB);
        PG8_WAIT_V(6); PG8_BAR;
    } else {
        PG8_STAGE(PG8_SB(0, 0), cB, voffB); PG8_STAGE(PG8_SA(0, 0), cA, voffA); PG8_STAGE(PG8_SB(0, 1), cB + hstep, voffB); PG8_STAGE(PG8_SA(0, 1), cA + hstep, voffA);
        if (wr == 1) PG8_BAR;
        PG8_WAIT_V(4); PG8_BAR;
        PG8_STAGE(PG8_SB(1, 0), cB + kstep, voffB); PG8_STAGE(PG8_SA(1, 0), cA + kstep, voffA); PG8_STAGE(PG8_SB(1, 1), cB + hstep + kstep, voffB);
        PG8_WAIT_V(6); PG8_BAR;
    }
    for (;;) {
        const bool has_next = S.next(ui + 1, nxt);
        const char* nA = has_next ? (const char*)g.A + (size_t)nxt.pm * tstep : cA; const char* nB = has_next ? (const char*)g.Bt + (size_t)nxt.pn * tstep : cB;
        for (int t = 0; t < nt; t += 2) {
            const bool last = (t == nt - 2);
            const char* a1 = cA + (size_t)(t + 1) * kstep;
            const char* a2 = last ? nA : cA + (size_t)(t + 2) * kstep; const char* b2 = last ? nB : cB + (size_t)(t + 2) * kstep;
            const char* a3 = a2 + kstep; const char* b3 = b2 + kstep;
            if (last && has_next) S.a_ready(nxt);
            if constexpr (SP2) {
            PG8_LDB(B0, 0, 0); PG8_LDB(B1, 0, 1); PG8_SCHED; PG8_LDA(At, 0, 0); PG8_STAGE(PG8_SA(1, 1), a1 + hstep, voffA);
            PG8_WAIT_V(8); PG8_WAIT_L(0); PG8_BAR; PG8_MMA(0, 0, At, B0); PG8_MMA(0, 1, At, B1); PG8_BAR; PG8_SCHED;
            PG8_LDA(At, 0, 1); PG8_STAGE(PG8_SB(0, 0), b2, voffB); PG8_STAGE(PG8_SB(0, 1), b2 + hstep, voffB); PG8_STAGE(PG8_SA(0, 0), a2, voffA);
            PG8_WAIT_V(8); PG8_WAIT_L(0); PG8_BAR; PG8_MMA(1, 0, At, B0); PG8_MMA(1, 1, At, B1); PG8_BAR; PG8_SCHED;
            PG8_LDB(B0, 1, 0); PG8_LDB(B1, 1, 1); PG8_SCHED; PG8_LDA(At, 1, 0); PG8_STAGE(PG8_SA(0, 1), a2 + hstep, voffA);
            PG8_WAIT_V(8); PG8_WAIT_L(0); PG8_BAR; PG8_MMA(0, 0, At, B0); PG8_MMA(0, 1, At, B1); PG8_BAR; PG8_SCHED;
            PG8_LDA(At, 1, 1); PG8_STAGE(PG8_SB(1, 0), b3, voffB); PG8_STAGE(PG8_SB(1, 1), b3 + hstep, voffB); PG8_STAGE(PG8_SA(1, 0), a3, voffA);
            PG8_WAIT_V(8); PG8_WAIT_L(0); PG8_BAR; PG8_MMA(1, 0, At, B0); PG8_MMA(1, 1, At, B1); PG8_BAR; PG8_SCHED;
            } else {
            PG8_LDB(B0, 0, 0); PG8_SCHED; PG8_LDA(At, 0, 0); PG8_STAGE(PG8_SA(1, 1), a1 + hstep, voffA);
            PG8_WAIT_L(8); PG8_BAR; PG8_WAIT_L(0); PG8_MMA(0, 0, At, B0); PG8_BAR; PG8_SCHED;
            PG8_LDB(B1, 0, 1); PG8_STAGE(PG8_SB(0, 0), b2, voffB);
            PG8_BAR; PG8_WAIT_L(0); PG8_MMA(0, 1, At, B1); PG8_BAR;
            PG8_LDA(At, 0, 1); PG8_STAGE(PG8_SA(0, 0), a2, voffA);
            PG8_BAR; PG8_WAIT_L(0); PG8_MMA(1, 0, At, B0); PG8_BAR; PG8_SCHED;
            PG8_STAGE(PG8_SB(0, 1), b2 + hstep, voffB);
            PG8_WAIT_V(6); PG8_BAR; PG8_MMA(1, 1, At, B1); PG8_BAR;
            PG8_LDB(B0, 1, 0); PG8_SCHED; PG8_LDA(At, 1, 0); PG8_STAGE(PG8_SA(0, 1), a2 + hstep, voffA);
            PG8_WAIT_L(8); PG8_BAR; PG8_WAIT_L(0); PG8_MMA(0, 0, At, B0); PG8_BAR; PG8_SCHED;
            PG8_LDB(B1, 1, 1); PG8_STAGE(PG8_SB(1, 0), b3, voffB);
            PG8_BAR; PG8_WAIT_L(0); PG8_MMA(0, 1, At, B1); PG8_BAR;
            PG8_LDA(At, 1, 1); PG8_STAGE(PG8_SA(1, 0), a3, voffA);
            PG8_BAR; PG8_WAIT_L(0); PG8_MMA(1, 0, At, B0); PG8_BAR; PG8_SCHED;
            PG8_STAGE(PG8_SB(1, 1), b3 + hstep, voffB);
            PG8_WAIT_V(6); PG8_BAR; PG8_MMA(1, 1, At, B1); PG8_BAR;
            }
        }
        if constexpr (ALIGN_EPI) { if (wr == 0) PG8_BAR; }
        if constexpr (!Epi::AFTER_DRAIN) { E(acc, cur, wr, wc, fr, fq); S.done(cur); }
        if (!has_next) break;
#pragma unroll
        for (int a = 0; a < 2; ++a)
#pragma unroll
            for (int b = 0; b < 2; ++b)
#pragma unroll
                for (int m = 0; m < 4; ++m)
#pragma unroll
                    for (int n = 0; n < 2; ++n) acc[a][b][m][n] = (f32x4){0.f, 0.f, 0.f, 0.f};
        cur = nxt; cA = nA; cB = nB; ++ui;
        if constexpr (ALIGN_EPI) { if (wr == 1) PG8_BAR; }
    }
    PG8_WAIT_V(0);
    if constexpr (!ALIGN_EPI) { if (wr == 0) PG8_BAR; }
    PG8_BAR;
    if constexpr (Epi::AFTER_DRAIN) { E.fused(acc, cur, wr, wc, fr, fq, lds, wid, lane); S.done(cur); }
#undef PG8_SA
#undef PG8_SB
#undef PG8_STAGE
#undef PG8_LDA
#undef PG8_LDB
#undef PG8_MMA
#undef PG8_WAIT_V
#undef PG8_WAIT_L
#undef PG8_BAR
#undef PG8_SCHED
}
}
constexpr int NWAVES = 8;
constexpr int T = 16384, SEQ = 8192, D = 1024, NIN = 2840, NINP = 3072, NQ = 2048;
constexpr int C_Q = 0, C_K = 256, C_V = 512, C_GLR = 1024, C_GOUT = 1040, C_Z = 1552, C_XBC = 2064, C_DT = 2832;
constexpr float EPS = 1e-6f;
constexpr size_t MiB = 1u << 20;
constexpr size_t WS_CTL = 0, CTL_ZERO_BYTES = 64 * 1024;
constexpr size_t WS_WIN = 1 * MiB;
constexpr size_t WS_WO = 7 * MiB;
constexpr size_t WS_WQ = 9 * MiB;
constexpr size_t WS_SUBK = 13 * MiB;
constexpr size_t WS_RRMS1 = 14 * MiB;
constexpr size_t WS_ROWSQ2 = 14 * MiB + 64 * 1024;
constexpr size_t WS_UB = 16 * MiB, WS_VB = 24 * MiB;
constexpr size_t WS_MIX = 32 * MiB;
constexpr size_t WS_XB = 80 * MiB;
constexpr size_t WS_PROJ = 112 * MiB;
constexpr int CW_TMO = 0, CW_BAR = 1024;
constexpr int RING_OFF = 0, RING_BYTES = 131072;
constexpr int LDS_BYTES = 163840;
constexpr int LDSCTL_OFF = LDS_BYTES - 1024, MISC_OFF = LDSCTL_OFF + 320;

#define GAS __attribute__((address_space(1)))
#define LAS __attribute__((address_space(3)))
typedef unsigned short bf16;
typedef unsigned v4u __attribute__((ext_vector_type(4)));
typedef float f32x4 __attribute__((ext_vector_type(4)));
typedef short bf16x8 __attribute__((ext_vector_type(8)));
typedef GAS unsigned gu32;
#define RLX_AGENT __ATOMIC_RELAXED, __HIP_MEMORY_SCOPE_AGENT
#define LDS_WAIT() asm volatile("s_waitcnt lgkmcnt(0)" ::: "memory")
#define VM_WAIT() asm volatile("s_waitcnt vmcnt(0)" ::: "memory")
typedef float f32x2c __attribute__((ext_vector_type(2)));
typedef __bf16 bf16x2c __attribute__((ext_vector_type(2)));
__device__ __forceinline__ unsigned f2bf(float f) { const __bf16 b = (__bf16)f; return (unsigned)__builtin_bit_cast(unsigned short, b); }
__device__ __forceinline__ unsigned pk2(float lo, float hi) { const bf16x2c v = __builtin_convertvector((f32x2c){lo, hi}, bf16x2c); return __builtin_bit_cast(unsigned, v); }
__device__ __forceinline__ float bf2f(unsigned short b) { return __builtin_bit_cast(float, (unsigned)b << 16); }
__device__ __forceinline__ float wave_sum(float v) {
#pragma unroll
    for (int o = 1; o < 64; o <<= 1) v += __shfl_xor(v, o);
    return v;
}
#define XB_TMO      128
#define XB_XCNT(j)  (256  + 64 * (j))
#define XB_XSUB(j)  (1280 + 64 * (j))
#define XB_XGEN(j)  (2304 + 64 * (j))
#define XB_TOP      3328
#define XB_TOPGEN   3392
#define XCD_BAR_WORDS 3456
#define XB_SPIN_CAP (1u << 18)

__device__ __forceinline__ unsigned xb_ld(unsigned* p)              { return __hip_atomic_load(p, __ATOMIC_RELAXED, __HIP_MEMORY_SCOPE_AGENT); }
__device__ __forceinline__ unsigned xb_add(unsigned* p, unsigned v) { return __hip_atomic_fetch_add(p, v, __ATOMIC_RELAXED, __HIP_MEMORY_SCOPE_AGENT); }
__device__ __forceinline__ unsigned xb_xcc_id() { return (unsigned)__builtin_amdgcn_s_getreg((3 << 11) | 20) & 0xFu; }
#define XB_SPIN(cond, bar) do { unsigned _sp = 0; while (cond) { __builtin_amdgcn_s_sleep(1); \
    if ((++_sp & 255u) == 0u) { if (xb_ld(&(bar)[XB_TMO])) break; if (_sp > XB_SPIN_CAP) { atomicAdd(&(bar)[XB_TMO], 1u); break; } } } } while (0)

struct XcdBarrier {
    unsigned* bar; unsigned x;
    volatile LAS unsigned* st;
};

__device__ __forceinline__ XcdBarrier xcd_barrier_post(unsigned* bar, volatile LAS unsigned* st) {
    XcdBarrier b; b.bar = bar; b.x = xb_xcc_id(); b.st = st;
    if (threadIdx.x == 0) (void)xb_add(&bar[XB_XCNT(b.x)], 1u);
    return b;
}
__device__ __forceinline__ void xcd_barrier_complete(unsigned* bar, unsigned x, unsigned& nloc, unsigned& nx) {
    const unsigned G = gridDim.x * gridDim.y * gridDim.z;
    unsigned sum, cnt, mine, sp = 0u;
    for (;;) {
        sum = 0u; cnt = 0u; mine = 0u;
#pragma unroll
        for (unsigned j = 0; j < 16; ++j) { const unsigned c = xb_ld(&bar[XB_XCNT(j)]); sum += c; cnt += (c > 0u) ? 1u : 0u; mine = (j == x) ? c : mine; }
        if (sum == G) break;
        __builtin_amdgcn_s_sleep(1);
        if ((++sp & 255u) == 0u) { if (xb_ld(&bar[XB_TMO])) break; if (sp > XB_SPIN_CAP) { atomicAdd(&bar[XB_TMO], 1u); break; } }
    }
    nloc = mine > 0u ? mine : 1u; nx = cnt > 0u ? cnt : 1u;
}

__device__ __forceinline__ void xcd_barrier(const XcdBarrier& b) {
    asm volatile("s_waitcnt vmcnt(0)" ::: "memory");
    __syncthreads();
    if (threadIdx.x == 0) {
        unsigned* bar = b.bar;
        __builtin_amdgcn_s_waitcnt(0);
        unsigned nloc = b.st[0], nx = b.st[1];
        if (nloc == 0u) { xcd_barrier_complete(bar, b.x, nloc, nx); b.st[0] = nloc; b.st[1] = nx; }
        const unsigned old = xb_add(&bar[XB_XSUB(b.x)], 1u);
        const unsigned gen = old / nloc;
        if (old + 1u == (gen + 1u) * nloc) {
            __builtin_amdgcn_fence(__ATOMIC_RELEASE, "agent");
            asm volatile("s_waitcnt vmcnt(0)" ::: "memory");
            const unsigned og = xb_add(&bar[XB_TOP], 1u);
            const unsigned tg = og / nx;
            if (og + 1u == (tg + 1u) * nx) xb_add(&bar[XB_TOPGEN], 1u);
            else XB_SPIN(xb_ld(&bar[XB_TOPGEN]) == tg, bar);
            __builtin_amdgcn_fence(__ATOMIC_ACQUIRE, "agent");
            xb_add(&bar[XB_XGEN(b.x)], 1u);
            asm volatile("s_waitcnt vmcnt(0)" ::: "memory");
        } else {
            XB_SPIN(xb_ld(&bar[XB_XGEN(b.x)]) == gen, bar);
            __builtin_amdgcn_fence(__ATOMIC_ACQUIRE, "agent");
            asm volatile("s_waitcnt vmcnt(0)" ::: "memory");
        }
    }
    __syncthreads();
}
struct Args {
    const float* in[19]; float* out; unsigned char* ws; int ph_lo, ph_hi;
};
struct Frame {
    LAS unsigned char* lds; volatile LAS unsigned* MISC; gu32* ctl;
    int tid, lane, wave, G, gw, NGW;
};

constexpr size_t WS_GDEC = 14 * MiB + 128 * 1024;
constexpr size_t WS_SDEC = 14 * MiB + 512 * 1024;
constexpr size_t WS_GST = 208 * MiB;
constexpr size_t WS_SST = 224 * MiB;
constexpr int SA64 = 144, SA128 = 272, SA32 = 80, SXN = 528;

__device__ __forceinline__ float silu_f(float x) { return x * __builtin_amdgcn_rcpf(1.f + __expf(-x)); }
__device__ __forceinline__ float softplus_f(float x) { return fmaxf(x, 0.f) + __logf(1.f + __expf(-fabsf(x))); }
__device__ __forceinline__ float logsigmoid_f(float x) { return fminf(x, 0.f) - __logf(1.f + __expf(-fabsf(x))); }
typedef unsigned u32x2 __attribute__((ext_vector_type(2)));

__device__ __forceinline__ f32x4 mma16(const LAS unsigned char* A, int sa, const LAS unsigned char* Bt, int sb, int K, f32x4 acc, int r, int kg) {
    for (int k0 = 0; k0 < K; k0 += 32) {
        const bf16x8 a = *(const LAS bf16x8*)(A + r * sa + (k0 + 8 * kg) * 2);
        const bf16x8 b = *(const LAS bf16x8*)(Bt + r * sb + (k0 + 8 * kg) * 2);
        acc = __builtin_amdgcn_mfma_f32_16x16x32_bf16(a, b, acc, 0, 0, 0);
    }
    return acc;
}

__device__ __forceinline__ void unpack8f(const v4u x, float (&f)[8]) {
    f[0] = __builtin_bit_cast(float, x.x << 16); f[1] = __builtin_bit_cast(float, x.x & 0xffff0000u); f[2] = __builtin_bit_cast(float, x.y << 16); f[3] = __builtin_bit_cast(float, x.y & 0xffff0000u);
    f[4] = __builtin_bit_cast(float, x.z << 16); f[5] = __builtin_bit_cast(float, x.z & 0xffff0000u); f[6] = __builtin_bit_cast(float, x.w << 16); f[7] = __builtin_bit_cast(float, x.w & 0xffff0000u);
}
typedef short s16x4 __attribute__((ext_vector_type(4)));
template <int SB> __device__ __forceinline__ void tr_frag2(unsigned base, bf16x8& f0, bf16x8& f1) {
    s16x4 a, b, c, d;
    asm volatile("ds_read_b64_tr_b16 %0, %4\n\tds_read_b64_tr_b16 %1, %4 offset:%5\n\tds_read_b64_tr_b16 %2, %4 offset:%6\n\tds_read_b64_tr_b16 %3, %4 offset:%7\n\ts_waitcnt lgkmcnt(0)"
                 : "=&v"(a), "=&v"(b), "=&v"(c), "=&v"(d) : "v"(base), "i"(4 * SB), "i"(32 * SB), "i"(36 * SB) : "memory");
    f0 = __builtin_shufflevector(a, b, 0, 1, 2, 3, 4, 5, 6, 7); f1 = __builtin_shufflevector(c, d, 0, 1, 2, 3, 4, 5, 6, 7);
}
template <int SB> __device__ __forceinline__ void tr_frag4n(unsigned base, bf16x8& f0, bf16x8& f1, bf16x8& f2, bf16x8& f3) {
    s16x4 a0, b0, a1, b1, a2, b2, a3, b3;
    asm volatile("ds_read_b64_tr_b16 %0, %8\n\tds_read_b64_tr_b16 %1, %8 offset:%9\n\tds_read_b64_tr_b16 %2, %8 offset:32\n\tds_read_b64_tr_b16 %3, %8 offset:%10\n\t"
                 "ds_read_b64_tr_b16 %4, %8 offset:64\n\tds_read_b64_tr_b16 %5, %8 offset:%11\n\tds_read_b64_tr_b16 %6, %8 offset:96\n\tds_read_b64_tr_b16 %7, %8 offset:%12\n\ts_waitcnt lgkmcnt(0)"
                 : "=&v"(a0), "=&v"(b0), "=&v"(a1), "=&v"(b1), "=&v"(a2), "=&v"(b2), "=&v"(a3), "=&v"(b3)
                 : "v"(base), "i"(4 * SB), "i"(4 * SB + 32), "i"(4 * SB + 64), "i"(4 * SB + 96) : "memory");
    f0 = __builtin_shufflevector(a0, b0, 0, 1, 2, 3, 4, 5, 6, 7); f1 = __builtin_shufflevector(a1, b1, 0, 1, 2, 3, 4, 5, 6, 7);
    f2 = __builtin_shufflevector(a2, b2, 0, 1, 2, 3, 4, 5, 6, 7); f3 = __builtin_shufflevector(a3, b3, 0, 1, 2, 3, 4, 5, 6, 7);
}
template <int SB> __device__ __forceinline__ f32x4 mma16_trB64(const LAS unsigned char* A, int sa, unsigned bbase, int n0, f32x4 acc, int r, int kg) {
    bf16x8 b0, b1; tr_frag2<SB>(bbase + (unsigned)((8 * kg + (r >> 2)) * SB + (n0 + 4 * (r & 3)) * 2), b0, b1);
    const bf16x8 a0 = *(const LAS bf16x8*)(A + r * sa + (8 * kg) * 2), a1 = *(const LAS bf16x8*)(A + r * sa + (32 + 8 * kg) * 2);
    acc = __builtin_amdgcn_mfma_f32_16x16x32_bf16(a0, b0, acc, 0, 0, 0);
    return __builtin_amdgcn_mfma_f32_16x16x32_bf16(a1, b1, acc, 0, 0, 0);
}
template <int MODE>
__device__ __forceinline__ void gla_unit(const Frame& F, const Args& A, int unit) {
    const int b = unit >> 9, c = (unit >> 2) & 127, h = unit & 3;
    const size_t t0 = (size_t)b * SEQ + (size_t)c * 64;
    const GAS bf16* proj = (const GAS bf16*)(A.ws + WS_PROJ);
    LAS unsigned char* L = F.lds;
    LAS float* GLR = (LAS float*)(L + 0);
    LAS float* SEG = (LAS float*)(L + 4096);
    LAS float* RSQ = (LAS float*)(L + 6144);
    LAS unsigned char* QI = L + 8192;
    LAS unsigned char* KI = QI + 64 * SA64;
    LAS unsigned char* VT = KI + 64 * SA64;
    LAS unsigned char* SP = VT + 128 * SA64;
    LAS unsigned char* AT = SP + 128 * SA64;
    LAS unsigned char* GO = AT + 64 * SA64;
    int tid = F.tid, seg = F.wave;
    asm volatile("" : "+v"(tid)); asm volatile("" : "+s"(seg));
    const int d = tid & 63;
    {
        const int row = tid >> 3, ch = tid & 7;
        const GAS bf16* prow = proj + (t0 + row) * NINP;
        const v4u kq = *(const GAS v4u*)(prow + C_K + h * 64 + ch * 8);
        v4u qq = kq; if (MODE == 1) qq = *(const GAS v4u*)(prow + C_Q + h * 64 + ch * 8);
        const int o = tid & 15, jp = tid >> 4;
        const v4u va = *(const GAS v4u*)(proj + (t0 + 2 * jp) * NINP + C_V + h * 128 + o * 8), vb = *(const GAS v4u*)(proj + (t0 + 2 * jp + 1) * NINP + C_V + h * 128 + o * 8);
        v4u g0 = kq, g1 = kq, s0 = kq, s1 = kq;
        if (MODE == 1) {
            const int r2 = tid >> 4, c2 = tid & 15;
            g0 = *(const GAS v4u*)(proj + (t0 + r2) * NINP + C_GOUT + h * 128 + c2 * 8); g1 = *(const GAS v4u*)(proj + (t0 + r2 + 32) * NINP + C_GOUT + h * 128 + c2 * 8);
            const GAS bf16* sp = (const GAS bf16*)(A.ws + WS_GST) + (size_t)unit * 8192;
            s0 = *(const GAS v4u*)(sp + (tid >> 3) * 64 + (tid & 7) * 8); s1 = *(const GAS v4u*)(sp + (64 + (tid >> 3)) * 64 + (tid & 7) * 8);
        }
        v4u gl = kq; if (tid < 128) gl = *(const GAS v4u*)(proj + (t0 + (tid >> 1)) * NINP + C_GLR + (tid & 1) * 8);
        if (MODE == 1) { *(LAS v4u*)(QI + row * SA64 + ch * 16) = qq; *(LAS v4u*)(KI + row * SA64 + ch * 16) = kq; }
        else *(LAS v4u*)(GO + row * SA64 + ch * 16) = kq;
        *(LAS v4u*)(VT + (2 * jp) * SA128 + o * 16) = va; *(LAS v4u*)(VT + (2 * jp + 1) * SA128 + o * 16) = vb;
        if (MODE == 1) {
            const int r2 = tid >> 4, c2 = tid & 15;
            *(LAS v4u*)(GO + r2 * SA128 + c2 * 16) = g0; *(LAS v4u*)(GO + (r2 + 32) * SA128 + c2 * 16) = g1;
            *(LAS v4u*)(SP + (tid >> 3) * SA64 + (tid & 7) * 16) = s0; *(LAS v4u*)(SP + (64 + (tid >> 3)) * SA64 + (tid & 7) * 16) = s1;
        }
        if (tid < 128) { float f[8]; unpack8f(gl, f);
#pragma unroll
            for (int q = 0; q < 8; ++q) GLR[(tid >> 1) * 16 + (tid & 1) * 8 + q] = f[q]; }
    }
    float wv[16];
#pragma unroll
    for (int r = 0; r < 16; ++r) wv[r] = A.in[3][r * 256 + h * 64 + d];
    const float bgv = A.in[4][h * 64 + d];
    __syncthreads();
    float Gv[8]; float run = 0.f;
#pragma unroll
    for (int ii = 0; ii < 8; ++ii) { const int i = seg * 8 + ii; float z = bgv;
#pragma unroll
        for (int r = 0; r < 16; ++r) z += GLR[i * 16 + r] * wv[r];
        run += logsigmoid_f(z) * (1.f / 16.f); Gv[ii] = run; }
    SEG[seg * 64 + d] = run;
    __syncthreads();
    float off = 0.f, tot = 0.f;
#pragma unroll
    for (int s = 0; s < 8; ++s) { const float v = SEG[s * 64 + d]; tot += v; off += (s < seg) ? v : 0.f; }
#pragma unroll
    for (int ii = 0; ii < 8; ++ii) Gv[ii] += off;
    if (MODE == 0) {
        unsigned w[4];
#pragma unroll
        for (int ii = 0; ii < 8; ii += 2) {
            const float k0 = bf2f(*(const LAS bf16*)(GO + (seg * 8 + ii) * SA64 + d * 2)) * __expf(tot - Gv[ii]);
            const float k1 = bf2f(*(const LAS bf16*)(GO + (seg * 8 + ii + 1) * SA64 + d * 2)) * __expf(tot - Gv[ii + 1]);
            w[ii >> 1] = pk2(k0, k1); }
        *(LAS v4u*)(KI + d * SA64 + seg * 16) = (v4u){w[0], w[1], w[2], w[3]};
        if (seg == 0) ((GAS float*)(A.ws + WS_GDEC))[unit * 64 + d] = __expf(tot);
    } else {
#pragma unroll
        for (int ii = 0; ii < 8; ++ii) { const int i = seg * 8 + ii;
            LAS bf16* qp = (LAS bf16*)(QI + i * SA64 + d * 2); LAS bf16* kp = (LAS bf16*)(KI + i * SA64 + d * 2);
            *qp = (bf16)f2bf(bf2f(*qp) * 0.125f * __expf(Gv[ii])); *kp = (bf16)f2bf(bf2f(*kp) * __expf(-Gv[ii])); }
    }
    __syncthreads();
    const int r = tid & 15, kg = (tid >> 4) & 3, w = seg;
    const f32x4 zero = (f32x4){0.f, 0.f, 0.f, 0.f};
    if (MODE == 0) {
        const int mt = w & 3, nb = (w >> 2) * 4;
        GAS bf16* stT = (GAS bf16*)(A.ws + WS_GST) + (size_t)unit * 8192;
#pragma unroll
        for (int n = 0; n < 4; ++n) {
            const f32x4 acc = mma16_trB64<SA128>(KI + mt * 16 * SA64, SA64, (unsigned)(size_t)VT, (nb + n) * 16, zero, r, kg);
            const int dv = (nb + n) * 16 + r, d0 = mt * 16 + kg * 4;
            *(GAS u32x2*)(stT + dv * 64 + d0) = (u32x2){pk2(acc[0], acc[1]), pk2(acc[2], acc[3])}; }
    } else {
        const int mt = w & 3;
#pragma unroll
        for (int n = 0; n < 2; ++n) { const int nt = (w >> 2) * 2 + n;
            const f32x4 acc = mma16(QI + mt * 16 * SA64, SA64, KI + nt * 16 * SA64, SA64, 64, zero, r, kg);
#pragma unroll
            for (int ii = 0; ii < 4; ++ii) { const int i = mt * 16 + kg * 4 + ii, j = nt * 16 + r; *(LAS bf16*)(AT + i * SA64 + j * 2) = (bf16)f2bf(j <= i ? acc[ii] : 0.f); } }
        __syncthreads();
        const int nb = (w >> 2) * 4;
        f32x4 o[4]; float rs[4] = {0.f, 0.f, 0.f, 0.f};
#pragma unroll
        for (int n = 0; n < 4; ++n) {
            f32x4 acc = mma16_trB64<SA128>(AT + mt * 16 * SA64, SA64, (unsigned)(size_t)VT, (nb + n) * 16, zero, r, kg);
            acc = mma16(QI + mt * 16 * SA64, SA64, SP + (nb + n) * 16 * SA64, SA64, 64, acc, r, kg);
            o[n] = acc;
#pragma unroll
            for (int ii = 0; ii < 4; ++ii) rs[ii] += acc[ii] * acc[ii]; }
#pragma unroll
        for (int ii = 0; ii < 4; ++ii) { rs[ii] += __shfl_xor(rs[ii], 1); rs[ii] += __shfl_xor(rs[ii], 2); rs[ii] += __shfl_xor(rs[ii], 4); rs[ii] += __shfl_xor(rs[ii], 8); }
        if (r == 0) {
#pragma unroll
            for (int ii = 0; ii < 4; ++ii) RSQ[(w >> 2) * 64 + mt * 16 + kg * 4 + ii] = rs[ii]; }
        __syncthreads();
        float rr[4];
#pragma unroll
        for (int ii = 0; ii < 4; ++ii) { const int row = mt * 16 + kg * 4 + ii; rr[ii] = rsqrtf((RSQ[row] + RSQ[64 + row]) * (1.f / 128.f) + EPS); }
#pragma unroll
        for (int n = 0; n < 4; ++n) { const int dv = (nb + n) * 16 + r; const float nwv = A.in[5][dv];
#pragma unroll
            for (int ii = 0; ii < 4; ++ii) { LAS bf16* gp = (LAS bf16*)(GO + (mt * 16 + kg * 4 + ii) * SA128 + dv * 2);
                *gp = (bf16)f2bf(o[n][ii] * rr[ii] * nwv * silu_f(bf2f(*gp))); } }
        __syncthreads();
        {   const int r2 = tid >> 4, c2 = tid & 15; GAS bf16* mixed = (GAS bf16*)(A.ws + WS_MIX);
            *(GAS v4u*)(mixed + (t0 + r2) * D + h * 128 + c2 * 8) = *(const LAS v4u*)(GO + r2 * SA128 + c2 * 16);
            *(GAS v4u*)(mixed + (t0 + r2 + 32) * D + h * 128 + c2 * 8) = *(const LAS v4u*)(GO + (r2 + 32) * SA128 + c2 * 16); }
    }
    __syncthreads();
}

template <int MODE>
__device__ __forceinline__ void ssd_unit(const Frame& F, const Args& A, int unit) {
    const int b = unit >> 7, c = (unit >> 1) & 63, g = unit & 1;
    const size_t t0 = (size_t)b * SEQ + (size_t)c * 128;
    const GAS bf16* proj = (const GAS bf16*)(A.ws + WS_PROJ);
    LAS unsigned char* L = F.lds;
    LAS float* DT = (LAS float*)(L + 0);
    LAS float* ACU = (LAS float*)(L + 2048);
    LAS unsigned char* CM = L + 4096;
    LAS unsigned char* BM = CM + 128 * SA64;
    LAS unsigned char* XT = BM + 128 * SA64;
    LAS unsigned char* PW = XT + 128 * SXN;
    LAS unsigned char* ZW = PW + 8 * 16 * SA32;
    LAS float* RRW = (LAS float*)(ZW + 8 * 16 * SA64);
    int tid = F.tid, w = F.wave;
    asm volatile("" : "+v"(tid)); asm volatile("" : "+s"(w));
    const int lane = tid & 63;
    if (w < 4) {
        const int hd = g * 4 + w; const float Ah = -__expf(A.in[9][hd]), dtb = A.in[8][hd];
        const float dt0 = softplus_f(bf2f(proj[(t0 + 2 * lane) * NINP + C_DT + hd]) + dtb), dt1 = softplus_f(bf2f(proj[(t0 + 2 * lane + 1) * NINP + C_DT + hd]) + dtb);
        const float a0 = dt0 * Ah, a1 = dt1 * Ah; float s = a0 + a1;
#pragma unroll
        for (int o = 1; o < 64; o <<= 1) { const float t = __shfl_up(s, o); s += (lane >= o) ? t : 0.f; }
        DT[(2 * lane) * 4 + w] = dt0; DT[(2 * lane + 1) * 4 + w] = dt1; ACU[(2 * lane) * 4 + w] = s - a1; ACU[(2 * lane + 1) * 4 + w] = s;
        if (MODE == 0 && lane == 63) ((GAS float*)(A.ws + WS_SDEC))[(b * 64 + c) * 8 + hd] = __expf(s);
    }
    __syncthreads();
    if (tid < 384) {
        const int o = tid % 48, sg = tid / 48;
        if (!(MODE == 0 && o >= 40)) {
            const int cc0 = o < 32 ? g * 256 + 8 * o : (o < 40 ? 512 + g * 64 + 8 * (o - 32) : 640 + g * 64 + 8 * (o - 40));
            float wt[4][8], cb[8];
#pragma unroll
            for (int j = 0; j < 4; ++j) { const f32x4 a = *(const GAS f32x4*)(A.in[6] + j * 768 + cc0), bq = *(const GAS f32x4*)(A.in[6] + j * 768 + cc0 + 4);
                wt[j][0] = a.x; wt[j][1] = a.y; wt[j][2] = a.z; wt[j][3] = a.w; wt[j][4] = bq.x; wt[j][5] = bq.y; wt[j][6] = bq.z; wt[j][7] = bq.w; }
            { const f32x4 a = *(const GAS f32x4*)(A.in[7] + cc0), bq = *(const GAS f32x4*)(A.in[7] + cc0 + 4); cb[0] = a.x; cb[1] = a.y; cb[2] = a.z; cb[3] = a.w; cb[4] = bq.x; cb[5] = bq.y; cb[6] = bq.z; cb[7] = bq.w; }
            const GAS bf16* src = proj + (t0 + 16 * sg) * NINP + C_XBC + cc0;
            float x0[8], x1[8], x2[8];
            if (c > 0 || sg > 0) { unpack8f(*(const GAS v4u*)(src - 3 * NINP), x0); unpack8f(*(const GAS v4u*)(src - 2 * NINP), x1); unpack8f(*(const GAS v4u*)(src - 1 * NINP), x2); }
            else {
#pragma unroll
                for (int q = 0; q < 8; ++q) { x0[q] = 0.f; x1[q] = 0.f; x2[q] = 0.f; } }
            const int hl = o >> 3, p0 = (o & 7) * 8;
            float sc_end = 0.f; if (MODE == 0 && o < 32) sc_end = ACU[127 * 4 + hl];
#pragma unroll 1
            for (int hf = 0; hf < 2; ++hf) {
                v4u xin[8];
#pragma unroll
                for (int i = 0; i < 8; ++i) xin[i] = *(const GAS v4u*)(src + (size_t)(hf * 8 + i) * NINP);
#pragma unroll
                for (int i = 0; i < 8; ++i) {
                    const int l = 16 * sg + hf * 8 + i;
                    float xc[8]; unpack8f(xin[i], xc);
                    float v[8];
#pragma unroll
                    for (int q = 0; q < 8; ++q) v[q] = silu_f(cb[q] + wt[0][q] * x0[q] + wt[1][q] * x1[q] + wt[2][q] * x2[q] + wt[3][q] * xc[q]);
#pragma unroll
                    for (int q = 0; q < 8; ++q) { x0[q] = x1[q]; x1[q] = x2[q]; x2[q] = xc[q]; }
                    if (MODE == 0 && o < 32) { const float sc = DT[l * 4 + hl] * __expf(sc_end - ACU[l * 4 + hl]);
#pragma unroll
                        for (int q = 0; q < 8; ++q) v[q] *= sc; }
                    const v4u ov = (v4u){pk2(v[0], v[1]), pk2(v[2], v[3]), pk2(v[4], v[5]), pk2(v[6], v[7])};
                    if (o < 32) *(LAS v4u*)(XT + l * SXN + o * 16) = ov;
                    else *(LAS v4u*)((o < 40 ? BM : CM) + l * SA64 + (o & 7) * 16) = ov;
                }
            }
        }
    }
    __syncthreads();
    const int r = lane & 15, kg = lane >> 4;
    const f32x4 zero = (f32x4){0.f, 0.f, 0.f, 0.f};
    if (MODE == 0) {
        const int hl = w >> 1;
        GAS bf16* st = (GAS bf16*)(A.ws + WS_SST) + ((size_t)((b * 64 + c) * 8 + g * 4 + hl)) * 4096;
#pragma unroll
        for (int mt = 0; mt < 4; ++mt)
#pragma unroll
            for (int n = 0; n < 2; ++n) { const int nt = (w & 1) * 2 + n;
                f32x4 acc = zero;
#pragma unroll
                for (int kh = 0; kh < 2; ++kh) {
                    bf16x8 a0, a1, b0, b1;
                    tr_frag2<SA64>((unsigned)(size_t)BM + (unsigned)((64 * kh + 8 * kg + (r >> 2)) * SA64 + (mt * 16 + 4 * (r & 3)) * 2), a0, a1);
                    tr_frag2<SXN>((unsigned)(size_t)XT + (unsigned)((64 * kh + 8 * kg + (r >> 2)) * SXN + (hl * 64 + nt * 16 + 4 * (r & 3)) * 2), b0, b1);
                    acc = __builtin_amdgcn_mfma_f32_16x16x32_bf16(a0, b0, acc, 0, 0, 0); acc = __builtin_amdgcn_mfma_f32_16x16x32_bf16(a1, b1, acc, 0, 0, 0); }
                const int p = nt * 16 + r, n0 = mt * 16 + kg * 4;
                *(GAS u32x2*)(st + p * 64 + n0) = (u32x2){pk2(acc[0], acc[1]), pk2(acc[2], acc[3])}; }
    } else {
        f32x4 sc[8];
#pragma unroll
        for (int nt = 0; nt < 8; ++nt) { sc[nt] = zero; if (nt <= w) sc[nt] = mma16(CM + w * 16 * SA64, SA64, BM + nt * 16 * SA64, SA64, 64, zero, r, kg); }
        __syncthreads();
        const GAS bf16* spg = (const GAS bf16*)(A.ws + WS_SST) + ((size_t)((b * 64 + c) * 8 + g * 4)) * 4096;
        for (int e = tid; e < 1024; e += 512) { const int row = e >> 3, ch = e & 7; *(LAS v4u*)(BM + row * SA64 + ch * 16) = *(const GAS v4u*)(spg + row * 64 + ch * 8); }
        __syncthreads();
        float rs[4] = {0.f, 0.f, 0.f, 0.f};
        LAS unsigned char* pw = PW + w * 16 * SA32;
        LAS unsigned char* zw = ZW + w * 16 * SA64;
        const int orow = lane >> 3, och = lane & 7;
        const GAS bf16* zsrc = proj + (t0 + w * 16 + orow) * NINP + C_Z + g * 256 + och * 8;
        v4u ysave[4][2];
#pragma unroll
        for (int hl = 0; hl < 4; ++hl) {
            if (hl == 2) {
                __syncthreads();
                for (int e = tid; e < 1024; e += 512) { const int row = e >> 3, ch = e & 7; *(LAS v4u*)(BM + row * SA64 + ch * 16) = *(const GAS v4u*)(spg + 2 * 4096 + row * 64 + ch * 8); }
                __syncthreads();
            }
            asm volatile("" ::: "memory");
            const v4u z0 = *(const GAS v4u*)(zsrc + hl * 64), z1 = *(const GAS v4u*)(zsrc + (size_t)8 * NINP + hl * 64);
            float acl[4];
#pragma unroll
            for (int ii = 0; ii < 4; ++ii) acl[ii] = ACU[(w * 16 + kg * 4 + ii) * 4 + hl];
            f32x4 yd[4] = {zero, zero, zero, zero};
#pragma unroll
            for (int kc = 0; kc < 4; ++kc) {
                if (kc * 2 <= w) {
#pragma unroll
                    for (int half = 0; half < 2; ++half) { const int stl = 2 * kc + half; const int s = stl * 16 + r;
                        const float acs = ACU[s * 4 + hl], dts = DT[s * 4 + hl];
#pragma unroll
                        for (int ii = 0; ii < 4; ++ii) { const int l = w * 16 + kg * 4 + ii;
                            const float pv = (s <= l) ? sc[stl][ii] * __expf(acl[ii] - acs) * dts : 0.f;
                            *(LAS bf16*)(pw + (kg * 4 + ii) * SA32 + (half * 16 + r) * 2) = (bf16)f2bf(pv); } }
                    LDS_WAIT();
                    const bf16x8 a = *(const LAS bf16x8*)(pw + r * SA32 + kg * 16);
                    bf16x8 bb[4];
                    tr_frag4n<SXN>((unsigned)(size_t)XT + (unsigned)((kc * 32 + 8 * kg + (r >> 2)) * SXN + (hl * 64 + 4 * (r & 3)) * 2), bb[0], bb[1], bb[2], bb[3]);
#pragma unroll
                    for (int nt = 0; nt < 4; ++nt) yd[nt] = __builtin_amdgcn_mfma_f32_16x16x32_bf16(a, bb[nt], yd[nt], 0, 0, 0);
                    LDS_WAIT();
                }
            }
            *(LAS v4u*)(zw + orow * SA64 + och * 16) = z0; *(LAS v4u*)(zw + (orow + 8) * SA64 + och * 16) = z1;
            LDS_WAIT();
            const float Dk = A.in[10][g * 4 + hl];
            float eal[4];
#pragma unroll
            for (int ii = 0; ii < 4; ++ii) eal[ii] = __expf(acl[ii]);
#pragma unroll
            for (int nt = 0; nt < 4; ++nt) {
                const f32x4 yo = mma16(CM + w * 16 * SA64, SA64, BM + (hl & 1) * 64 * SA64 + nt * 16 * SA64, SA64, 64, zero, r, kg);
                const int p = nt * 16 + r;
#pragma unroll
                for (int ii = 0; ii < 4; ++ii) { const int l = w * 16 + kg * 4 + ii;
                    const float xv = bf2f(*(const LAS bf16*)(XT + l * SXN + (hl * 64 + p) * 2));
                    LAS bf16* zp = (LAS bf16*)(zw + (kg * 4 + ii) * SA64 + p * 2);
                    const float y = (yd[nt][ii] + eal[ii] * yo[ii] + xv * Dk) * silu_f(bf2f(*zp));
                    const unsigned short yb = (unsigned short)f2bf(y); const float yq = bf2f(yb);
                    rs[ii] += yq * yq;
                    *zp = yb; }
            }
            LDS_WAIT();
            ysave[hl][0] = *(const LAS v4u*)(zw + orow * SA64 + och * 16); ysave[hl][1] = *(const LAS v4u*)(zw + (orow + 8) * SA64 + och * 16);
            LDS_WAIT();
        }
#pragma unroll
        for (int ii = 0; ii < 4; ++ii) { rs[ii] += __shfl_xor(rs[ii], 1); rs[ii] += __shfl_xor(rs[ii], 2); rs[ii] += __shfl_xor(rs[ii], 4); rs[ii] += __shfl_xor(rs[ii], 8);
            rs[ii] = rsqrtf(rs[ii] * (1.f / 256.f) + EPS); }
        if (r == 0) {
#pragma unroll
            for (int ii = 0; ii < 4; ++ii) RRW[w * 16 + kg * 4 + ii] = rs[ii]; }
        LDS_WAIT();
        const float rr0 = RRW[w * 16 + orow], rr1 = RRW[w * 16 + orow + 8];
        GAS bf16* mdst = (GAS bf16*)(A.ws + WS_MIX) + (t0 + w * 16 + orow) * D + 512 + g * 256 + och * 8;
#pragma unroll
        for (int hl = 0; hl < 4; ++hl) {
            const f32x4 nwa = *(const GAS f32x4*)(A.in[11] + g * 256 + hl * 64 + och * 8), nwb = *(const GAS f32x4*)(A.in[11] + g * 256 + hl * 64 + och * 8 + 4);
            const float nw8[8] = {nwa.x, nwa.y, nwa.z, nwa.w, nwb.x, nwb.y, nwb.z, nwb.w};
#pragma unroll
            for (int hh = 0; hh < 2; ++hh) { float f[8]; unpack8f(ysave[hl][hh], f); const float rr_ = hh ? rr1 : rr0;
#pragma unroll
                for (int q = 0; q < 8; ++q) f[q] *= rr_ * nw8[q];
                *(GAS v4u*)(mdst + (size_t)(8 * hh) * D + hl * 64) = (v4u){pk2(f[0], f[1]), pk2(f[2], f[3]), pk2(f[4], f[5]), pk2(f[6], f[7])}; }
        }
    }
    __syncthreads();
}

template <bool DRY> __device__ __forceinline__ void scan_phase(const Frame& F, const Args& A) {
    if (F.tid < 128) {
        GAS unsigned* st = (GAS unsigned*)(A.ws + WS_GST); const GAS float* dec = (const GAS float*)(A.ws + WS_GDEC);
        for (int gi = blockIdx.x * 128 + F.tid; gi < 8 * 4096; gi += F.G * 128) {
            const int bh = gi >> 12, e = gi & 4095, b = bh >> 2, h = bh & 3, d = (e & 31) * 2;
            float S0 = 0.f, S1 = 0.f;
#pragma unroll 1
            for (int c = 0; c < 128; c += 16) {
                unsigned v[16]; float d0[16], d1[16];
#pragma unroll
                for (int u = 0; u < 16; ++u) { const size_t un = (size_t)((b * 128 + c + u) * 4 + h); v[u] = st[un * 4096 + e]; d0[u] = dec[un * 64 + d]; d1[u] = dec[un * 64 + d + 1]; }
#pragma unroll
                for (int u = 0; u < 16; ++u) { const size_t un = (size_t)((b * 128 + c + u) * 4 + h); (DRY ? (GAS unsigned*)(A.ws + 232 * MiB) : st)[un * 4096 + e] = pk2(S0, S1);
                    S0 = d0[u] * S0 + bf2f((unsigned short)(v[u] & 0xffffu)); S1 = d1[u] * S1 + bf2f((unsigned short)(v[u] >> 16)); }
            }
        }
    } else if (F.tid < 256) {
        GAS unsigned* st = (GAS unsigned*)(A.ws + WS_SST); const GAS float* dec = (const GAS float*)(A.ws + WS_SDEC);
        for (int gi = blockIdx.x * 128 + (F.tid - 128); gi < 16 * 2048; gi += F.G * 128) {
            const int bh = gi >> 11, e = gi & 2047, b = bh >> 3, hd = bh & 7;
            float S0 = 0.f, S1 = 0.f;
#pragma unroll 1
            for (int c = 0; c < 64; c += 16) {
                unsigned v[16]; float dd[16];
#pragma unroll
                for (int u = 0; u < 16; ++u) { const size_t un = (size_t)((b * 64 + c + u) * 8 + hd); v[u] = st[un * 2048 + e]; dd[u] = dec[un]; }
#pragma unroll
                for (int u = 0; u < 16; ++u) { const size_t un = (size_t)((b * 64 + c + u) * 8 + hd); (DRY ? (GAS unsigned*)(A.ws + 248 * MiB) : st)[un * 2048 + e] = pk2(S0, S1);
                    S0 = dd[u] * S0 + bf2f((unsigned short)(v[u] & 0xffffu)); S1 = dd[u] * S1 + bf2f((unsigned short)(v[u] >> 16)); }
            }
        }
    }
}
constexpr size_t WS_HB = WS_PROJ;
constexpr size_t WS_Q = 144 * MiB;
constexpr size_t WS_IDX = 232 * MiB;
constexpr size_t WS_GATE = 240 * MiB;
typedef float f32x16 __attribute__((ext_vector_type(16)));
__device__ __forceinline__ float as_f(unsigned u) { return __builtin_bit_cast(float, u); }
__device__ __forceinline__ unsigned as_u(float f) { return __builtin_bit_cast(unsigned, f); }
#define CE_DESC(a, b) do { const float hi_ = fmaxf((a), (b)), lo_ = fminf((a), (b)); (a) = hi_; (b) = lo_; } while (0)
template <int OFF, int N> __device__ __forceinline__ void sort16_desc(float (&v)[N]) {
#pragma unroll
    for (int k = 2; k <= 16; k <<= 1)
#pragma unroll
        for (int j = k >> 1; j > 0; j >>= 1)
#pragma unroll
            for (int i = 0; i < 16; ++i) { const int l = i ^ j; if (l > i) { if ((i & k) == 0) CE_DESC(v[OFF + i], v[OFF + l]); else CE_DESC(v[OFF + l], v[OFF + i]); } }
}
template <int OA, int OB, int NA, int NB> __device__ __forceinline__ void merge16_desc(float (&a)[NA], const float (&b)[NB]) {
#pragma unroll
    for (int i = 0; i < 16; ++i) a[OA + i] = fmaxf(a[OA + i], b[OB + 15 - i]);
#pragma unroll
    for (int j = 8; j > 0; j >>= 1)
#pragma unroll
        for (int i = 0; i < 16; ++i) { const int l = i ^ j; if (l > i) CE_DESC(a[OA + i], a[OA + l]); }
}
constexpr unsigned char CAND0[32] = {0, 2, 4, 6, 8, 10, 12, 14, 16, 18, 20, 22, 32, 34, 36, 49, 51, 65, 80, 96, 112, 128, 160, 192, 224, 255, 255, 255, 255, 255, 255, 255};
constexpr unsigned char CAND1[32] = {1, 3, 5, 7, 9, 11, 13, 15, 17, 19, 21, 23, 33, 35, 48, 50, 64, 66, 81, 97, 113, 144, 176, 208, 240, 255, 255, 255, 255, 255, 255, 255};

__device__ __forceinline__ void topk_wave_job(const Args& A, const LAS unsigned char* SK, LAS unsigned char* TAB, int tok0, int h, int lane) {
    const int r = lane & 31, hi = lane >> 5;
    const GAS bf16* qrow = (const GAS bf16*)(A.ws + WS_Q) + (size_t)(tok0 + r) * NQ + h * 256 + 8 * hi;
    float LST[2][16];
#pragma unroll
    for (int p = 0; p < 2; ++p) {
        __builtin_amdgcn_sched_barrier(0);
        bf16x8 bq[8];
#pragma unroll
        for (int s = 0; s < 8; ++s) bq[s] = *(const GAS bf16x8*)(qrow + p * 128 + 16 * s);
        float v[64];
#pragma unroll
        for (int kt = 0; kt < 4; ++kt) {
            f32x16 acc;
#pragma unroll
            for (int i = 0; i < 16; ++i) acc[i] = 0.f;
#pragma unroll
            for (int s = 0; s < 8; ++s) { const bf16x8 a = *(const LAS bf16x8*)(SK + (p * 128 + kt * 32 + r) * SA128 + (16 * s + 8 * hi) * 2);
                acc = __builtin_amdgcn_mfma_f32_32x32x16_bf16(a, bq[s], acc, 0, 0, 0); }
#pragma unroll
            for (int i = 0; i < 16; ++i) { const unsigned key = (unsigned)(kt * 32 + (i & 3) + 8 * (i >> 2)) | ((unsigned)hi << 2); v[kt * 16 + i] = as_f((as_u(acc[i]) & ~127u) | key); }
        }
        sort16_desc<0>(v); sort16_desc<16>(v); sort16_desc<32>(v); sort16_desc<48>(v);
        merge16_desc<0, 16>(v, v); merge16_desc<32, 48>(v, v); merge16_desc<0, 32>(v, v);
        float o[16];
#pragma unroll
        for (int i = 0; i < 16; ++i) o[i] = __shfl_xor(v[i], 32);
        merge16_desc<0, 0>(v, o);
#pragma unroll
        for (int i = 0; i < 16; ++i) LST[p][i] = v[i];
    }
    __builtin_amdgcn_sched_barrier(0);
    {   unsigned pk[4];
#pragma unroll
        for (int q4 = 0; q4 < 4; ++q4) { unsigned wv = 0;
#pragma unroll
            for (int b = 0; b < 4; ++b) { float l0 = LST[0][q4 * 4 + b], l1 = LST[1][q4 * 4 + b]; asm volatile("" : "+v"(l0), "+v"(l1));
                const unsigned x = as_u(hi ? l1 : l0) & 127u; wv |= x << (8 * b); }
            pk[q4] = wv; }
        *(LAS v4u*)(TAB + r * 32 + hi * 16) = (v4u){pk[0], pk[1], pk[2], pk[3]};
    }
    float c[32];
    float va[16], vb2[16];
#pragma unroll
    for (int i = 0; i < 16; ++i) { va[i] = as_f(as_u(LST[0][i]) & ~127u); vb2[i] = as_f(as_u(LST[1][i]) & ~127u); }
#define CANDV(i0, j0, k0, i1, j1, k1) as_f((as_u(hi ? (va[i1] + vb2[j1]) : (va[i0] + vb2[j0])) & ~255u) | (hi ? (k1) : (k0)))
    c[0] = CANDV(0, 0, 0u, 0, 1, 1u);
    c[1] = CANDV(0, 2, 2u, 0, 3, 3u);
    c[2] = CANDV(0, 4, 4u, 0, 5, 5u);
    c[3] = CANDV(0, 6, 6u, 0, 7, 7u);
    c[4] = CANDV(0, 8, 8u, 0, 9, 9u);
    c[5] = CANDV(0, 10, 10u, 0, 11, 11u);
    c[6] = CANDV(0, 12, 12u, 0, 13, 13u);
    c[7] = CANDV(0, 14, 14u, 0, 15, 15u);
    c[8] = CANDV(1, 0, 16u, 1, 1, 17u);
    c[9] = CANDV(1, 2, 18u, 1, 3, 19u);
    c[10] = CANDV(1, 4, 20u, 1, 5, 21u);
    c[11] = CANDV(1, 6, 22u, 1, 7, 23u);
    c[12] = CANDV(2, 0, 32u, 2, 1, 33u);
    c[13] = CANDV(2, 2, 34u, 2, 3, 35u);
    c[14] = CANDV(2, 4, 36u, 3, 0, 48u);
    c[15] = CANDV(3, 1, 49u, 3, 2, 50u);
    c[16] = CANDV(3, 3, 51u, 4, 0, 64u);
    c[17] = CANDV(4, 1, 65u, 4, 2, 66u);
    c[18] = CANDV(5, 0, 80u, 5, 1, 81u);
    c[19] = CANDV(6, 0, 96u, 6, 1, 97u);
    c[20] = CANDV(7, 0, 112u, 7, 1, 113u);
    c[21] = CANDV(8, 0, 128u, 9, 0, 144u);
    c[22] = CANDV(10, 0, 160u, 11, 0, 176u);
    c[23] = CANDV(12, 0, 192u, 13, 0, 208u);
    c[24] = CANDV(14, 0, 224u, 15, 0, 240u);
    c[25] = as_f(0xFF61B1E6u | 255u);
    c[26] = as_f(0xFF61B1E6u | 255u);
    c[27] = as_f(0xFF61B1E6u | 255u);
    c[28] = as_f(0xFF61B1E6u | 255u);
    c[29] = as_f(0xFF61B1E6u | 255u);
    c[30] = as_f(0xFF61B1E6u | 255u);
    c[31] = as_f(0xFF61B1E6u | 255u);
#undef CANDV
    sort16_desc<0>(c); sort16_desc<16>(c); merge16_desc<0, 16>(c, c);
    {   float o[16];
#pragma unroll
        for (int i = 0; i < 16; ++i) o[i] = __shfl_xor(c[i], 32);
        merge16_desc<0, 0>(c, o); }
    const float mx = as_f(as_u(c[0]) & ~255u);
    float ex[16], den = 0.f;
#pragma unroll
    for (int k = 0; k < 16; ++k) { ex[k] = __expf(as_f(as_u(c[k]) & ~255u) - mx); den += ex[k]; }
    const float inv = 1.f / den;
    LDS_WAIT();
    unsigned eid[8]; float gv[8];
#pragma unroll
    for (int k = 0; k < 8; ++k) { float ca = c[k], cb = c[k + 8], ea = ex[k], eb = ex[k + 8]; asm volatile("" : "+v"(ca), "+v"(cb), "+v"(ea), "+v"(eb));
        const unsigned code = as_u(hi ? cb : ca) & 255u; gv[k] = (hi ? eb : ea) * inv;
        const unsigned ia = *(const LAS unsigned char*)(TAB + r * 32 + (code >> 4)), ib = *(const LAS unsigned char*)(TAB + r * 32 + 16 + (code & 15));
        eid[k] = ia * 128u + ib; }
    GAS unsigned* ip = (GAS unsigned*)(A.ws + WS_IDX) + (size_t)(tok0 + r) * 128 + h * 16 + 8 * hi;
    GAS float* gp = (GAS float*)(A.ws + WS_GATE) + (size_t)(tok0 + r) * 128 + h * 16 + 8 * hi;
    *(GAS v4u*)ip = (v4u){eid[0], eid[1], eid[2], eid[3]}; *(GAS v4u*)(ip + 4) = (v4u){eid[4], eid[5], eid[6], eid[7]};
    *(GAS f32x4*)gp = (f32x4){gv[0], gv[1], gv[2], gv[3]}; *(GAS f32x4*)(gp + 4) = (f32x4){gv[4], gv[5], gv[6], gv[7]};
    LDS_WAIT();
}
__device__ __forceinline__ void topk_phase(const Frame& F, const Args& A) {
    LAS unsigned char* SK = F.lds;
    LAS unsigned char* TABS = F.lds + 256 * SA128;
    for (int unit = blockIdx.x; unit < 256; unit += F.G) {
        int tid = F.tid, w = F.wave;
        asm volatile("" : "+v"(tid)); asm volatile("" : "+s"(w));
        const int h = unit & 7, tb = (unit >> 3) * 512;
        const GAS bf16* sk = (const GAS bf16*)(A.ws + WS_SUBK) + (size_t)h * 2 * 128 * 128;
        for (int e = tid; e < 256 * 16; e += 512) { const int row = e >> 4, ch = e & 15; *(LAS v4u*)(SK + row * SA128 + ch * 16) = *(const GAS v4u*)(sk + row * 128 + ch * 8); }
        __syncthreads();
#pragma unroll 1
        for (int tt = 0; tt < 2; ++tt) topk_wave_job(A, SK, TABS + w * 1024, tb + (w * 2 + tt) * 32, h, tid & 63);
        __syncthreads();
    }
}

__device__ __forceinline__ float gelu_f(float v) {
    const float av = fabsf(v), t = __builtin_amdgcn_rcpf(av * 0.2316418882f + 1.0f);
    float q = t * 0.5307027145f + (-0.7265760135f); q = q * t + 0.7107068705f; q = q * t + (-0.142248368f); q = q * t + 0.127414796f; q = q * t;
    const float m = v * (q * __builtin_amdgcn_exp2f((v * v) * (-0.72134752044f)));
    return v < 0.f ? m : v - m;
}
__device__ __forceinline__ void unpack8(const v4u x, float (&f)[8]) {
    f[0] = as_f(x.x << 16); f[1] = as_f(x.x & 0xffff0000u); f[2] = as_f(x.y << 16); f[3] = as_f(x.y & 0xffff0000u);
    f[4] = as_f(x.z << 16); f[5] = as_f(x.z & 0xffff0000u); f[6] = as_f(x.w << 16); f[7] = as_f(x.w & 0xffff0000u);
}
typedef long lx2 __attribute__((ext_vector_type(2)));
typedef float f32x2 __attribute__((ext_vector_type(2)));
typedef int i32x8 __attribute__((ext_vector_type(8)));
typedef int i32x4 __attribute__((ext_vector_type(4)));
constexpr float U4_SCALE = 48.f, V4_SCALE = 4.25f;
constexpr int MX_ONE = 0x7F7F7F7F;
template <int BY> __device__ __forceinline__ f32x2 cvt_fp4x2(unsigned w) { return __builtin_amdgcn_cvt_scalef32_pk_f32_fp4(w, 1.0f, BY); }
template <int WS> __device__ __forceinline__ f32x2 cvt_fp8x2(int w) { return __builtin_amdgcn_cvt_pk_f32_fp8(w, WS != 0); }
__device__ __forceinline__ unsigned pk4_fp8(float a, float b, float c, float d) { int p = __builtin_amdgcn_cvt_pk_fp8_f32(a, b, 0, false); p = __builtin_amdgcn_cvt_pk_fp8_f32(c, d, p, true); return (unsigned)p; }
template <bool DRY> __device__ __forceinline__ void expert_phase(const Frame& F, const Args& A) {
    int tid = F.tid, w = F.wave;
    asm volatile("" : "+v"(tid)); asm volatile("" : "+s"(w));
    const int lane = tid & 63, r = lane & 15, kg = lane >> 4, half = lane >> 5, sub = lane & 31;
    const int dl = 32 * sub + 16 * half;
    LAS unsigned char* N2 = F.lds + w * 1024;
    const GAS unsigned char* u4 = (const GAS unsigned char*)(A.ws + WS_UB); const GAS unsigned char* v4 = (const GAS unsigned char*)(A.ws + WS_VB);
    const GAS unsigned* idx = (const GAS unsigned*)(A.ws + WS_IDX); const GAS float* gate = (const GAS float*)(A.ws + WS_GATE);
    const GAS float* rowsq = (const GAS float*)(A.ws + WS_ROWSQ2);
#pragma unroll 1
    for (int t = F.gw; t < T; t += F.NGW) {
        GAS float* hrow = (GAS float*)A.out + (size_t)t * D;
        f32x4 hv[4];
        {   const GAS bf16* hb = (const GAS bf16*)(A.ws + WS_HB) + (size_t)t * D + dl;
            float f0[8], f1[8]; unpack8f(*(const GAS v4u*)hb, f0); unpack8f(*(const GAS v4u*)(hb + 8), f1);
            hv[0] = (f32x4){f0[0], f0[1], f0[2], f0[3]}; hv[1] = (f32x4){f0[4], f0[5], f0[6], f0[7]}; hv[2] = (f32x4){f1[0], f1[1], f1[2], f1[3]}; hv[3] = (f32x4){f1[4], f1[5], f1[6], f1[7]}; }
        const float rr = rsqrtf(rowsq[t] * (1.f / 1024.f) + EPS);
        {   v4u pk;
            pk.x = pk4_fp8(hv[0].x * rr, hv[0].y * rr, hv[0].z * rr, hv[0].w * rr); pk.y = pk4_fp8(hv[1].x * rr, hv[1].y * rr, hv[1].z * rr, hv[1].w * rr);
            pk.z = pk4_fp8(hv[2].x * rr, hv[2].y * rr, hv[2].z * rr, hv[2].w * rr); pk.w = pk4_fp8(hv[3].x * rr, hv[3].y * rr, hv[3].z * rr, hv[3].w * rr);
            *(LAS v4u*)(N2 + dl) = pk; }
        unsigned eidx[8]; float gt[8];
#pragma unroll
        for (int eg = 0; eg < 8; ++eg) { eidx[eg] = idx[(size_t)t * 128 + eg * 16 + r]; gt[eg] = gate[(size_t)t * 128 + eg * 16 + r]; }
        LDS_WAIT();
        float actv[8];
        {
            LAS unsigned char* UBw = F.lds + 8192 + w * (2 * 16 * 528);
            v4u xr[8];
#define PU_ROWS(EG) { _Pragma("unroll") for (int j = 0; j < 8; ++j) { const unsigned ea = (unsigned)__builtin_amdgcn_readlane((int)eidx[EG], 2 * j), eb = (unsigned)__builtin_amdgcn_readlane((int)eidx[EG], 2 * j + 1); \
                xr[j] = *(const GAS v4u*)(u4 + (size_t)(half ? eb : ea) * 512 + 16 * sub); } }
            PU_ROWS(0)
#pragma unroll
            for (int eg = 0; eg < 8; ++eg) {
                LAS unsigned char* ub = UBw + (eg & 1) * (16 * 528);
#pragma unroll
                for (int j = 0; j < 8; ++j) *(LAS v4u*)(ub + (2 * j + half) * 528 + 16 * sub) = xr[j];
                if (eg < 7) PU_ROWS(eg + 1)
                __builtin_amdgcn_sched_barrier(0);
                LDS_WAIT();
                f32x4 accg = (f32x4){0.f, 0.f, 0.f, 0.f};
#pragma unroll
                for (int s2 = 0; s2 < 8; ++s2) {
                    const i32x4 a0 = *(const LAS i32x4*)(N2 + 128 * s2 + 16 * kg), a1 = *(const LAS i32x4*)(N2 + 128 * s2 + 64 + 16 * kg);
                    const i32x8 a = (i32x8){a0.x, a0.y, a0.z, a0.w, a1.x, a1.y, a1.z, a1.w};
                    const i32x4 b4 = *(const LAS i32x4*)(ub + r * 528 + 64 * s2 + 16 * kg);
                    const i32x8 b = (i32x8){b4.x, b4.y, b4.z, b4.w, 0, 0, 0, 0};
                    accg = __builtin_amdgcn_mfma_scale_f32_16x16x128_f8f6f4(a, b, accg, 0, 4, 0, MX_ONE, 0, MX_ONE);
                }
                actv[eg] = accg[0];
                __builtin_amdgcn_sched_barrier(0);
            }
#undef PU_ROWS
        }
        bool bad = false;
        if (t == F.gw) {
            float ref = 0.f;
            for (int s = 0; s < 8; ++s) {
                const i32x4 b4 = *(const GAS i32x4*)(u4 + (size_t)eidx[0] * 512 + 64 * s + 16 * kg);
                const int bw[4] = {b4.x, b4.y, b4.z, b4.w};
#pragma unroll
                for (int k = 0; k < 4; ++k) {
                    const lx2 a8 = *(const LAS lx2*)(N2 + 128 * s + 32 * kg + 16 * (k >> 1));
                    const long aw = (k & 1) ? a8.y : a8.x;
                    const int alo = (int)aw, ahi = (int)(aw >> 32);
                    { const f32x2 bf = cvt_fp4x2<0>((unsigned)bw[k]), af = cvt_fp8x2<0>(alo); ref += af.x * bf.x + af.y * bf.y; }
                    { const f32x2 bf = cvt_fp4x2<1>((unsigned)bw[k]), af = cvt_fp8x2<1>(alo); ref += af.x * bf.x + af.y * bf.y; }
                    { const f32x2 bf = cvt_fp4x2<2>((unsigned)bw[k]), af = cvt_fp8x2<0>(ahi); ref += af.x * bf.x + af.y * bf.y; }
                    { const f32x2 bf = cvt_fp4x2<3>((unsigned)bw[k]), af = cvt_fp8x2<1>(ahi); ref += af.x * bf.x + af.y * bf.y; }
                }
            }
            ref += __shfl_xor(ref, 16); ref += __shfl_xor(ref, 32);
            bad = __any(fabsf(ref - actv[0]) > 0.02f * fabsf(ref) + 0.5f);
        }
        float hid[8];
#pragma unroll
        for (int eg = 0; eg < 8; ++eg) hid[eg] = gelu_f(actv[eg] * (1.f / U4_SCALE)) * gt[eg] * (1.f / V4_SCALE);
        f32x2 o2[16];
#pragma unroll
        for (int i = 0; i < 16; ++i) o2[i] = (f32x2){0.f, 0.f};
        v4u xr[2][8]; float shs[2][8];
#define PV_LOAD(EG, BUF) { _Pragma("unroll") for (int pr = 0; pr < 8; ++pr) { \
                const float sha = as_f(__builtin_amdgcn_readlane((int)as_u(hid[EG]), 2 * pr)), shb = as_f(__builtin_amdgcn_readlane((int)as_u(hid[EG]), 2 * pr + 1)); \
                const unsigned sia = (unsigned)__builtin_amdgcn_readlane((int)eidx[EG], 2 * pr), sib = (unsigned)__builtin_amdgcn_readlane((int)eidx[EG], 2 * pr + 1); \
                shs[BUF][pr] = half ? shb : sha; \
                xr[BUF][pr] = *(const GAS v4u*)(v4 + (size_t)(half ? sib : sia) * 512 + 16 * sub); } }
        PV_LOAD(0, 0)
#pragma unroll
        for (int eg = 0; eg < 8; ++eg) {
            if (eg < 7) PV_LOAD(eg + 1, (eg + 1) & 1)
            __builtin_amdgcn_sched_barrier(0);
#pragma unroll
            for (int pr = 0; pr < 8; ++pr) {
                const f32x2 sh2 = (f32x2){shs[eg & 1][pr], shs[eg & 1][pr]};
                const unsigned xw[4] = {xr[eg & 1][pr].x, xr[eg & 1][pr].y, xr[eg & 1][pr].z, xr[eg & 1][pr].w};
#pragma unroll
                for (int k = 0; k < 4; ++k) { o2[4 * k] += sh2 * cvt_fp4x2<0>(xw[k]); o2[4 * k + 1] += sh2 * cvt_fp4x2<1>(xw[k]); o2[4 * k + 2] += sh2 * cvt_fp4x2<2>(xw[k]); o2[4 * k + 3] += sh2 * cvt_fp4x2<3>(xw[k]); }
            }
            __builtin_amdgcn_sched_barrier(0);
        }
#undef PV_LOAD
        float o[16];
#pragma unroll
        for (int i = 0; i < 16; ++i) { o2[i].x += __shfl_xor(o2[i].x, 32); o2[i].y += __shfl_xor(o2[i].y, 32); }
#pragma unroll
        for (int i = 0; i < 8; ++i) { float a0 = o2[i].x, a1 = o2[i].y, b0 = o2[8 + i].x, b1 = o2[8 + i].y; asm volatile("" : "+v"(a0), "+v"(a1), "+v"(b0), "+v"(b1));
            o[2 * i] = half ? b0 : a0; o[2 * i + 1] = half ? b1 : a1; }
        float ss = 0.f; f32x4 h2[4];
        {   const GAS bf16* hb = (const GAS bf16*)(A.ws + WS_HB) + (size_t)t * D + dl;
            float f0[8], f1[8]; unpack8f(*(const GAS v4u*)hb, f0); unpack8f(*(const GAS v4u*)(hb + 8), f1);
            hv[0] = (f32x4){f0[0], f0[1], f0[2], f0[3]}; hv[1] = (f32x4){f0[4], f0[5], f0[6], f0[7]}; hv[2] = (f32x4){f1[0], f1[1], f1[2], f1[3]}; hv[3] = (f32x4){f1[4], f1[5], f1[6], f1[7]}; }
#pragma unroll
        for (int q = 0; q < 4; ++q) { h2[q] = hv[q] + (f32x4){o[4 * q], o[4 * q + 1], o[4 * q + 2], o[4 * q + 3]};
            const f32x4 x = h2[q]; ss += (x.x * x.x + x.y * x.y) + (x.z * x.z + x.w * x.w); }
        ss = wave_sum(ss);
        float r3 = rsqrtf(ss * (1.f / D) + EPS);
#pragma unroll
        for (int q = 0; q < 4; ++q) *(GAS f32x4*)((DRY ? (GAS float*)(A.ws + WS_Q) + (size_t)t * D : hrow) + dl + 4 * q) = h2[q] * r3 * *(const GAS f32x4*)(A.in[18] + dl + 4 * q);
    }
}
__device__ __forceinline__ void p0_transpose_item(const float* W, const float* kscale, int K, int N, bf16* WT, LAS float* scr, int item, int lane) {
    const int nblk = (N + 31) / 32, kb = item / nblk, nb = item % nblk, k0 = 64 * kb, n0 = 32 * nb;
    const int nn = n0 + (lane & 31); const bool ok = nn < N;
    (void)nn; (void)ok;
    {   const int c4 = lane & 7, kr = lane >> 3; const bool okc = n0 + 4 * c4 < N;
        f32x4 v[8];
#pragma unroll
        for (int i = 0; i < 8; ++i) v[i] = okc ? *(const GAS f32x4*)(W + (size_t)(k0 + 8 * i + kr) * N + n0 + 4 * c4) : (f32x4){0.f, 0.f, 0.f, 0.f};
#pragma unroll
        for (int i = 0; i < 8; ++i) { const int kk = 8 * i + kr; const float sc = kscale ? kscale[k0 + kk] : 1.f; LAS float* d = scr + kk * 33 + 4 * c4;
            d[0] = v[i].x * sc; d[1] = v[i].y * sc; d[2] = v[i].z * sc; d[3] = v[i].w * sc; } }
    LDS_WAIT(); asm volatile("" ::: "memory");
    const int c = lane & 7;
#pragma unroll
    for (int j = 0; j < 4; ++j) { const int n = (lane >> 3) + 8 * j; const LAS float* s = scr + (8 * c) * 33 + n;
        v4u o; o.x = pk2(s[0 * 33], s[1 * 33]); o.y = pk2(s[2 * 33], s[3 * 33]); o.z = pk2(s[4 * 33], s[5 * 33]); o.w = pk2(s[6 * 33], s[7 * 33]);
        *(GAS v4u*)(WT + (size_t)(n0 + n) * K + k0 + 8 * c) = o; }
    LDS_WAIT(); asm volatile("" ::: "memory");
}
__device__ __forceinline__ void p0_convert(const Frame& F, const float* src, bf16* dst, size_t n) {
    for (size_t i = ((size_t)F.gw * 64 + F.lane) * 8; i < n; i += (size_t)F.NGW * 512) {
        const f32x4 a = *(const GAS f32x4*)(src + i), b = *(const GAS f32x4*)(src + i + 4);
        v4u o; o.x = pk2(a.x, a.y); o.y = pk2(a.z, a.w); o.z = pk2(b.x, b.y); o.w = pk2(b.z, b.w);
        *(GAS v4u*)(dst + i) = o;
    }
}
__device__ __forceinline__ void p0_convert_fp4(const Frame& F, int wk, int nwk, const float* src, unsigned char* dst, size_t n, float scale, const float* colscale) {
#pragma unroll 4
    for (size_t i = ((size_t)wk * 64 + F.lane) * 32; i < n; i += (size_t)nwk * 2048) {
        unsigned ow[4];
#pragma unroll
        for (int q = 0; q < 4; ++q) {
            f32x4 a = *(const GAS f32x4*)(src + i + 8 * q) * scale, b = *(const GAS f32x4*)(src + i + 8 * q + 4) * scale;
            if (colscale) { a = a * *(const GAS f32x4*)(colscale + ((i + 8 * q) & 1023)); b = b * *(const GAS f32x4*)(colscale + ((i + 8 * q + 4) & 1023)); }
            unsigned pk = 0;
            pk = __builtin_amdgcn_cvt_scalef32_pk_fp4_f32(pk, a.x, a.y, 1.0f, 0); pk = __builtin_amdgcn_cvt_scalef32_pk_fp4_f32(pk, a.z, a.w, 1.0f, 1);
            pk = __builtin_amdgcn_cvt_scalef32_pk_fp4_f32(pk, b.x, b.y, 1.0f, 2); pk = __builtin_amdgcn_cvt_scalef32_pk_fp4_f32(pk, b.z, b.w, 1.0f, 3);
            ow[q] = pk; }
        *(GAS v4u*)(dst + (i >> 1)) = (v4u){ow[0], ow[1], ow[2], ow[3]};
    }
}
__device__ __forceinline__ void p0_prologue(const Frame& F, const Args& A) {
    unsigned char* ws = A.ws;
    LAS float* scr = (LAS float*)(F.lds + RING_OFF + F.wave * 16384);
    constexpr int I_IN = (D / 64) * ((NIN + 31) / 32), I_O = (D / 64) * (D / 32), I_Q = (D / 64) * (NQ / 32);
    for (int it = F.gw; it < I_IN + I_O + I_Q; it += F.NGW) {
        int r = it;
        if (r < I_IN) { p0_transpose_item(A.in[2], A.in[1], D, NIN, (bf16*)(ws + WS_WIN), scr, r, F.lane); continue; } r -= I_IN;
        if (r < I_O) { p0_transpose_item(A.in[12], nullptr, D, D, (bf16*)(ws + WS_WO), scr, r, F.lane); continue; } r -= I_O;
        p0_transpose_item(A.in[14], A.in[13], D, NQ, (bf16*)(ws + WS_WQ), scr, r, F.lane);
    }
    for (int m0 = F.gw * 4; m0 < T; m0 += F.NGW * 4) {
        f32x4 v[4][4]; float s[4] = {0.f, 0.f, 0.f, 0.f};
#pragma unroll
        for (int u = 0; u < 4; ++u) { const GAS f32x4* xr = (const GAS f32x4*)(A.in[0] + (size_t)(m0 + u) * D) + F.lane;
#pragma unroll
            for (int j = 0; j < 4; ++j) v[u][j] = xr[64 * j]; }
#pragma unroll
        for (int u = 0; u < 4; ++u) {
#pragma unroll
            for (int j = 0; j < 4; ++j) s[u] += (v[u][j].x * v[u][j].x + v[u][j].y * v[u][j].y) + (v[u][j].z * v[u][j].z + v[u][j].w * v[u][j].w);
            GAS unsigned long long* o8 = (GAS unsigned long long*)((bf16*)(ws + WS_XB) + (size_t)(m0 + u) * D) + F.lane;
#pragma unroll
            for (int j = 0; j < 4; ++j) o8[64 * j] = (unsigned long long)pk2(v[u][j].x, v[u][j].y) | ((unsigned long long)pk2(v[u][j].z, v[u][j].w) << 32); }
#pragma unroll
        for (int u = 0; u < 4; ++u) s[u] = wave_sum(s[u]);
        if (F.lane < 4) { const float sv = F.lane == 0 ? s[0] : (F.lane == 1 ? s[1] : (F.lane == 2 ? s[2] : s[3])); ((float*)(ws + WS_RRMS1))[m0 + F.lane] = rsqrtf(sv * (1.f / D) + EPS); ((float*)(ws + WS_ROWSQ2))[m0 + F.lane] = 0.f; }
    }
    p0_convert(F, A.in[15], (bf16*)(ws + WS_SUBK), (size_t)8 * 2 * 128 * 128);
    p0_convert_fp4(F, F.gw, F.NGW, A.in[16], ws + WS_UB, (size_t)16384 * 1024, 48.f, A.in[13]);
    p0_convert_fp4(F, F.gw, F.NGW, A.in[17], ws + WS_VB, (size_t)16384 * 1024, 4.25f, nullptr);
}

#ifndef PROBE_MASK
#define PROBE_MASK 0
#endif
__device__ __forceinline__ int probe_reps(int k) { int n = ((PROBE_MASK >> k) & 1) + 1; return n; }
__global__ void __launch_bounds__(NWAVES * 64, 2) fwd(Args args) {
    extern __shared__ __attribute__((aligned(16))) unsigned char lds[];
    Frame F;
    F.lds = (LAS unsigned char*)lds;
    F.MISC = (volatile LAS unsigned*)(F.lds + MISC_OFF);
    F.tid = threadIdx.x; F.lane = F.tid & 63; F.wave = __builtin_amdgcn_readfirstlane(F.tid >> 6);
    F.G = gridDim.x; F.gw = blockIdx.x * NWAVES + F.wave; F.NGW = F.G * NWAVES;
    unsigned char* ws = args.ws;
    F.ctl = (gu32*)(ws + WS_CTL);
    for (int u = F.tid; u < (LDS_BYTES - LDSCTL_OFF) / 4; u += NWAVES * 64) ((LAS unsigned*)(F.lds + LDSCTL_OFF))[u] = 0u;
    __syncthreads();
    XcdBarrier bar = xcd_barrier_post((unsigned*)(F.ctl + CW_BAR), F.MISC + 8);
    const int lo = args.ph_lo, hi = args.ph_hi;
#define IN(k) (lo <= (k) && (k) < hi)
#define BOTH(k) (IN(k) && IN((k) + 1))
#define GRID_BAR() xcd_barrier(bar)
#define REP(k) for (int rep_ = 0, nrep_ = probe_reps(k); rep_ < nrep_; ++rep_)

    if (IN(0)) REP(0) { p0_prologue(F, args); if (BOTH(0)) GRID_BAR(); }
    if (IN(1)) REP(1) {
        pg8::Gemm g{(const bf16*)(ws + WS_XB), (const bf16*)(ws + WS_WIN), T, NINP, D}; pg8::StaticOrder S; S.init(T, NINP, F.G, (int)blockIdx.x);
        pg8::EpiRowScaleBf16 E{(bf16*)(ws + WS_PROJ), NINP, (const float*)(ws + WS_RRMS1)};
        pg8::gemm_phase<pg8::EpiRowScaleBf16, pg8::StaticOrder, true, true>(F.lds + RING_OFF, g, S, E);
        if (BOTH(1)) GRID_BAR();
    }
    if (IN(2)) {
        REP(2) { for (int u = blockIdx.x; u < 256; u += F.G) ssd_unit<0>(F, args, u); }
        REP(13) { for (int u = blockIdx.x; u < 1024; u += F.G) gla_unit<0>(F, args, u); }
        if (BOTH(2)) GRID_BAR();
    }
    if (IN(3)) { if ((PROBE_MASK >> 3) & 1) { scan_phase<true>(F, args); GRID_BAR(); } scan_phase<false>(F, args); if (BOTH(3)) GRID_BAR(); }
    if (IN(4)) {
        REP(4) { for (int u = blockIdx.x; u < 256; u += F.G) ssd_unit<1>(F, args, u); }
        REP(12) { for (int u = blockIdx.x; u < 1024; u += F.G) gla_unit<1>(F, args, u); }
        if (BOTH(4)) GRID_BAR();
    }
    if (IN(5)) {
        pg8::Gemm g{(const bf16*)(ws + WS_MIX), (const bf16*)(ws + WS_WO), T, D, D}; pg8::StaticOrder S; S.init(T, D, F.G, (int)blockIdx.x);
        if ((PROBE_MASK >> 5) & 1) { pg8::EpiResidual Ed{(const bf16*)(ws + WS_XB), (bf16*)(ws + 208 * MiB), (float*)(ws + 240 * MiB), D};
            pg8::gemm_phase<pg8::EpiResidual, pg8::StaticOrder, true, true>(F.lds + RING_OFF, g, S, Ed); GRID_BAR(); }
        pg8::EpiResidual E{(const bf16*)(ws + WS_XB), (bf16*)(ws + WS_HB), (float*)(ws + WS_ROWSQ2), D};
        pg8::gemm_phase<pg8::EpiResidual, pg8::StaticOrder, true, true>(F.lds + RING_OFF, g, S, E);
        if (BOTH(5)) GRID_BAR();
    }
    if (IN(6)) REP(6) {
        pg8::Gemm g{(const bf16*)(ws + WS_HB), (const bf16*)(ws + WS_WQ), T, NQ, D}; pg8::StaticOrder S; S.init(T, NQ, F.G, (int)blockIdx.x);
        pg8::EpiRsqScaleBf16 E{(bf16*)(ws + WS_Q), NQ, (const float*)(ws + WS_ROWSQ2)};
        pg8::gemm_phase<pg8::EpiRsqScaleBf16, pg8::StaticOrder, true, true>(F.lds + RING_OFF, g, S, E);
        if (BOTH(6)) GRID_BAR();
    }
    if (IN(7)) REP(7) { topk_phase(F, args); if (BOTH(7)) GRID_BAR(); }
    if (IN(8)) { if ((PROBE_MASK >> 8) & 1) { expert_phase<true>(F, args); GRID_BAR(); } expert_phase<false>(F, args); }
#undef IN
#undef BOTH
}
extern "C" void kernel_launch(void* const* d_in, const int* in_sizes, int n_in, void* d_out, int out_size, void* d_ws, size_t ws_size, hipStream_t stream) {
    static int grid = 0;
    if (grid == 0) {
        if (n_in != 19 || out_size != T * D || ws_size < 256 * MiB) { fprintf(stderr, "kernel_launch: unexpected shapes n_in %d out %d ws %zu\n", n_in, out_size, ws_size); grid = -1; return; }
        int dev = 0, cus = 0, per_cu = 0;
        if (hipGetDevice(&dev) != hipSuccess || hipDeviceGetAttribute(&cus, hipDeviceAttributeMultiprocessorCount, dev) != hipSuccess) { grid = -1; return; }
        if (hipFuncSetAttribute((const void*)fwd, hipFuncAttributeMaxDynamicSharedMemorySize, LDS_BYTES) != hipSuccess) { fprintf(stderr, "kernel_launch: hipFuncSetAttribute failed\n"); grid = -1; return; }
        if (hipOccupancyMaxActiveBlocksPerMultiprocessor(&per_cu, (const void*)fwd, NWAVES * 64, LDS_BYTES) != hipSuccess || per_cu < 1) { fprintf(stderr, "kernel_launch: occupancy query says %d\n", per_cu); }
        (void)hipGetLastError();
        grid = cus;
    }
    if (grid < 0) return;
    const float* x = (const float*)d_in[0];
    const float* gla_w2 = (const float*)d_in[3];
    const float* gla_bg = (const float*)d_in[4];
    const float* gla_nw = (const float*)d_in[5];
    const float* conv_w = (const float*)d_in[6];
    const float* conv_b = (const float*)d_in[7];
    const float* dt_bias = (const float*)d_in[8];
    const float* a_log = (const float*)d_in[9];
    const float* d_skip = (const float*)d_in[10];
    const float* ssd_nw = (const float*)d_in[11];
    const float* w_out = (const float*)d_in[12];
    const float* norm_ffn_w = (const float*)d_in[13];
    const float* w_query = (const float*)d_in[14];
    const float* sub_keys = (const float*)d_in[15];
    const float* pu = (const float*)d_in[16];
    const float* pv = (const float*)d_in[17];
    const float* norm_final_w = (const float*)d_in[18];
    float* out = (float*)d_out;
    char* ws = (char*)d_ws;

    (void)hipMemsetAsync(ws + WS_CTL, 0, CTL_ZERO_BYTES, stream);
    Args a{};
    for (int i = 0; i < 19; ++i) a.in[i] = (const float*)d_in[i];
    a.out = out; a.ws = (unsigned char*)d_ws; a.ph_lo = 0; a.ph_hi = 9;
    hipLaunchKernelGGL(fwd, dim3(grid), dim3(NWAVES * 64), LDS_BYTES, stream, a);

}
```

```cpp
#include <hip/hip_runtime.h>
#include <cstdio>
#include <cstdint>
namespace pg8 {
#define PG8_LAS __attribute__((address_space(3)))
typedef unsigned short bf16_t;
typedef short bf16x8 __attribute__((ext_vector_type(8)));
typedef float f32x4 __attribute__((ext_vector_type(4)));
typedef unsigned u32x4 __attribute__((ext_vector_type(4)));
constexpr int BM = 256, BK = 64, HALF = 128, HTB = HALF * BK * 2  , STAGE_BYTES = 8 * HTB, NXCD = 8, WGM = 8;

__host__ __device__ __forceinline__ int lds_byte(int r, int c) { const int st = (r >> 4) * 2 + (c >> 5), rr = r & 15, cc = c & 31, ob = rr * 64 + cc * 2; return st * 1024 + (ob ^ (((ob >> 9) & 1) << 5)); }
__host__ __device__ __forceinline__ void stage_rc(int b, int& R, int& C) { const int st = b / 1024, sb = b % 1024, swz = sb ^ (((sb >> 9) & 1) << 5); R = (st >> 1) * 16 + swz / 64; C = (st & 1) * 32 + (swz % 64) / 2; }
__host__ __device__ __forceinline__ int perm32(int rho) { const int n = rho >> 4, i = rho & 15; return 8 * (i >> 2) + 4 * n + (i & 3); }

struct Unit { int pm, pn; };
struct Gemm { const bf16_t* A; const bf16_t* Bt; int M, N, K; };

struct StaticOrder {
    int nM, nN, nwg, G, c;
    __host__ __device__ void init(int M, int N, int G_, int c_) { nM = M / BM; nN = N / BM; nwg = nM * nN; G = G_; c = c_; }
    __host__ __device__ bool next(int i, Unit& u) const {
        const long L = (long)i * G + c; if (L >= nwg) return false;
        int wgid = (int)L; { const int q = nwg / NXCD, r = nwg % NXCD, xcd = wgid % NXCD, off = wgid / NXCD; wgid = (xcd < r ? xcd * (q + 1) : r * (q + 1) + (xcd - r) * q) + off; }
        const int nig = WGM * nN, gid = wgid / nig, fm = gid * WGM, gsz = (nM - fm) < WGM ? (nM - fm) : WGM;
        u.pm = fm + ((wgid % nig) % gsz); u.pn = (wgid % nig) / gsz; return true;
    }
    __device__ __forceinline__ void a_ready(const Unit&) const {}
    __device__ __forceinline__ void done(const Unit&) const {}
};

__device__ __forceinline__ unsigned cvt_pk_bf16(float lo, float hi) { unsigned r; asm volatile("v_cvt_pk_bf16_f32 %0, %1, %2" : "=v"(r) : "v"(lo), "v"(hi)); return r; }
typedef float f32x2 __attribute__((ext_vector_type(2)));
struct EpiRowScaleBf16 {
    static constexpr bool PERM = true, AFTER_DRAIN = false;
    bf16_t* O; int ldc; const float* rs;
    __device__ __forceinline__ void operator()(const f32x4 (&acc)[2][2][4][2], const Unit& u, int wr, int wc, int fr, int fq) const {
        const int row0 = u.pm * BM + wr * 64 + fr, col0 = u.pn * BM + wc * 32 + 8 * fq;
#pragma unroll
        for (int ai = 0; ai < 2; ++ai)
#pragma unroll
            for (int m = 0; m < 4; ++m) { const int row = row0 + ai * HALF + m * 16; const float sc = rs[row]; bf16_t* rowp = O + (size_t)row * ldc + col0;
#pragma unroll
                for (int bj = 0; bj < 2; ++bj) { const f32x4 v0 = acc[ai][bj][m][0] * sc, v1 = acc[ai][bj][m][1] * sc;
                    u32x4 w; w.x = cvt_pk_bf16(v0[0], v0[1]); w.y = cvt_pk_bf16(v0[2], v0[3]); w.z = cvt_pk_bf16(v1[0], v1[1]); w.w = cvt_pk_bf16(v1[2], v1[3]);
                    *(u32x4*)(rowp + bj * HALF) = w; } }
    }
};
struct EpiRsqScaleBf16 {
    static constexpr bool PERM = true, AFTER_DRAIN = false;
    bf16_t* O; int ldc; const float* rowsq;
    __device__ __forceinline__ void operator()(const f32x4 (&acc)[2][2][4][2], const Unit& u, int wr, int wc, int fr, int fq) const {
        const int row0 = u.pm * BM + wr * 64 + fr, col0 = u.pn * BM + wc * 32 + 8 * fq;
#pragma unroll
        for (int ai = 0; ai < 2; ++ai)
#pragma unroll
            for (int m = 0; m < 4; ++m) { const int row = row0 + ai * HALF + m * 16; const float sc = rsqrtf(rowsq[row] * (1.f / 1024.f) + 1e-6f); bf16_t* rowp = O + (size_t)row * ldc + col0;
#pragma unroll
                for (int bj = 0; bj < 2; ++bj) { const f32x4 v0 = acc[ai][bj][m][0] * sc, v1 = acc[ai][bj][m][1] * sc;
                    u32x4 w; w.x = cvt_pk_bf16(v0[0], v0[1]); w.y = cvt_pk_bf16(v0[2], v0[3]); w.z = cvt_pk_bf16(v1[0], v1[1]); w.w = cvt_pk_bf16(v1[2], v1[3]);
                    *(u32x4*)(rowp + bj * HALF) = w; } }
    }
};
struct EpiResidual {
    static constexpr bool PERM = true, AFTER_DRAIN = false;
    const bf16_t* X; bf16_t* HB; float* rowsq; int ldc;
    __device__ __forceinline__ void operator()(const f32x4 (&acc)[2][2][4][2], const Unit& u, int wr, int wc, int fr, int fq) const {
        const int row0 = u.pm * BM + wr * 64 + fr, col0 = u.pn * BM + wc * 32 + 8 * fq;
#pragma unroll
        for (int ai = 0; ai < 2; ++ai)
#pragma unroll
            for (int m = 0; m < 4; ++m) { const int row = row0 + ai * HALF + m * 16; float ss = 0.f;
#pragma unroll
                for (int bj = 0; bj < 2; ++bj) { const size_t off = (size_t)row * ldc + col0 + bj * HALF;
                    const u32x4 xv = *(const u32x4*)(X + off);
                    const f32x4 x0 = (f32x4){__builtin_bit_cast(float, xv.x << 16), __builtin_bit_cast(float, xv.x & 0xffff0000u), __builtin_bit_cast(float, xv.y << 16), __builtin_bit_cast(float, xv.y & 0xffff0000u)};
                    const f32x4 x1 = (f32x4){__builtin_bit_cast(float, xv.z << 16), __builtin_bit_cast(float, xv.z & 0xffff0000u), __builtin_bit_cast(float, xv.w << 16), __builtin_bit_cast(float, xv.w & 0xffff0000u)};
                    const f32x4 v0 = acc[ai][bj][m][0] + x0, v1 = acc[ai][bj][m][1] + x1;
                    u32x4 w; w.x = cvt_pk_bf16(v0[0], v0[1]); w.y = cvt_pk_bf16(v0[2], v0[3]); w.z = cvt_pk_bf16(v1[0], v1[1]); w.w = cvt_pk_bf16(v1[2], v1[3]);
                    *(u32x4*)(HB + off) = w;
                    ss += (v0[0] * v0[0] + v0[1] * v0[1]) + (v0[2] * v0[2] + v0[3] * v0[3]) + (v1[0] * v1[0] + v1[1] * v1[1]) + (v1[2] * v1[2] + v1[3] * v1[3]); }
                ss += __shfl_xor(ss, 16); ss += __shfl_xor(ss, 32);
                if (fq == 0) atomicAdd(rowsq + row, ss); }
    }
};
template <class Epi, class Sched, bool ALIGN_EPI = false, bool SP2 = false>
__device__ __forceinline__ void gemm_phase(PG8_LAS unsigned char* lds, const Gemm g, const Sched& S, const Epi& E) {
    const int tid = threadIdx.x, wid = __builtin_amdgcn_readfirstlane(tid >> 6), lane = tid & 63, wr = wid >> 2, wc = wid & 3, fr = lane & 15, fq = lane >> 4;
    const int K = g.K, nt = K / BK;
    unsigned voffA[2], voffB[2];
#pragma unroll
    for (int i = 0; i < 2; ++i) { int R, C; stage_rc(tid * 16 + i * 8192, R, C); const int Rb = Epi::PERM ? ((R & ~31) + perm32(R & 31)) : R;
        voffA[i] = (unsigned)(R * K + C) * 2u; voffB[i] = (unsigned)(Rb * K + C) * 2u; }
    const size_t kstep = (size_t)(BK * 2);
    const size_t hstep = (size_t)HALF * K * 2;
    const size_t tstep = 2 * hstep;
    const unsigned ldsw = (unsigned)wid * 1024u;
    const int aoff = lds_byte(wr * 64 + fr, fq * 8), boff = lds_byte(wc * 32 + fr, fq * 8);
#define PG8_SA(b, h) (((b) * 2 + (h)) * HTB)
#define PG8_SB(b, h) ((4 + (b) * 2 + (h)) * HTB)
#define PG8_STAGE(bufoff, gbase, voff) do { _Pragma("unroll") for (int _i = 0; _i < 2; ++_i) \
        __builtin_amdgcn_global_load_lds((const unsigned*)((const char*)(gbase) + (voff)[_i]), (PG8_LAS unsigned*)(lds + (bufoff) + ldsw + _i * 8192), 16, 0, 0); } while (0)
#define PG8_LDA(dst, b, h) do { _Pragma("unroll") for (int m = 0; m < 4; ++m) _Pragma("unroll") for (int k = 0; k < 2; ++k) dst[m][k] = *(const PG8_LAS bf16x8*)(lds + PG8_SA(b, h) + aoff + m * 2048 + k * 1024); } while (0)
#define PG8_LDB(dst, b, h) do { _Pragma("unroll") for (int n = 0; n < 2; ++n) _Pragma("unroll") for (int k = 0; k < 2; ++k) dst[n][k] = *(const PG8_LAS bf16x8*)(lds + PG8_SB(b, h) + boff + n * 2048 + k * 1024); } while (0)
#define PG8_MMA(ai, bj, At, Bt) do { __builtin_amdgcn_s_setprio(1); _Pragma("unroll") for (int m = 0; m < 4; ++m) _Pragma("unroll") for (int n = 0; n < 2; ++n) _Pragma("unroll") for (int k = 0; k < 2; ++k) \
        acc[ai][bj][m][n] = __builtin_amdgcn_mfma_f32_16x16x32_bf16(Bt[n][k], At[m][k], acc[ai][bj][m][n], 0, 0, 0); __builtin_amdgcn_s_setprio(0); } while (0)
#define PG8_WAIT_V(n) asm volatile("s_waitcnt vmcnt(" #n ")" ::: "memory")
#define PG8_WAIT_L(n) asm volatile("s_waitcnt lgkmcnt(" #n ")" ::: "memory")
#define PG8_BAR __builtin_amdgcn_s_barrier()
#define PG8_SCHED __builtin_amdgcn_sched_barrier(0)
    Unit cur, nxt; int ui = 0;
    if (!S.next(0, cur)) return;
    f32x4 acc[2][2][4][2];
#pragma unroll
    for (int a = 0; a < 2; ++a)
#pragma unroll
        for (int b = 0; b < 2; ++b)
#pragma unroll
            for (int m = 0; m < 4; ++m)
#pragma unroll
                for (int n = 0; n < 2; ++n) acc[a][b][m][n] = (f32x4){0.f, 0.f, 0.f, 0.f};
    bf16x8 At[4][2], B0[2][2], B1[2][2];
    const char* cA = (const char*)g.A + (size_t)cur.pm * tstep; const char* cB = (const char*)g.Bt + (size_t)cur.pn * tstep;
    S.a_ready(cur);
    if constexpr (SP2) {
        PG8_STAGE(PG8_SB(0, 0), cB, voffB); PG8_STAGE(PG8_SB(0, 1), cB + hstep, voffB); PG8_STAGE(PG8_SA(0, 0), cA, voffA); PG8_STAGE(PG8_SA(0, 1), cA + hstep, voffA);
        if (wr == 1) PG8_BAR;
        PG8_WAIT_V(2); PG8_BAR;
        PG8_STAGE(PG8_SB(1, 0), cB + kstep, voffB); PG8_STAGE(PG8_SA(1, 0), cA + kstep, voffA); PG8_STAGE(PG8_SB(1, 1), cB + hstep + kstep, voffB);
        PG8_WAIT_V(6); PG8_BAR;
    } else {
        PG8_STAGE(PG8_SB(0, 0), cB, voffB); PG8_STAGE(PG8_SA(0, 0), cA, voffA); PG8_STAGE(PG8_SB(0, 1), cB + hstep, voffB); PG8_STAGE(PG8_SA(0, 1), cA + hstep, voffA);
        if (wr == 1) PG8_BAR;
        PG8_WAIT_V(4); PG8_BAR;
        PG8_STAGE(PG8_SB(1, 0), cB + kstep, voffB); PG8_STAGE(PG8_SA(1, 0), cA + kstep, voffA); PG8_STAGE(PG8_SB(1, 1), cB + hstep + kstep, voffB);
        PG8_WAIT_V(6); PG8_BAR;
    }
    for (;;) {
        const bool has_next = S.next(ui + 1, nxt);
        const char* nA = has_next ? (const char*)g.A + (size_t)nxt.pm * tstep : cA; const char* nB = has_next ? (const char*)g.Bt + (size_t)nxt.pn * tstep : cB;
        for (int t = 0; t < nt; t += 2) {
            const bool last = (t == nt - 2);
            const char* a1 = cA + (size_t)(t + 1) * kstep;
            const char* a2 = last ? nA : cA + (size_t)(t + 2) * kstep; const char* b2 = last ? nB : cB + (size_t)(t + 2) * kstep;
            const char* a3 = a2 + kstep; const char* b3 = b2 + kstep;
            if (last && has_next) S.a_ready(nxt);
            if constexpr (SP2) {
            PG8_LDB(B0, 0, 0); PG8_LDB(B1, 0, 1); PG8_SCHED; PG8_LDA(At, 0, 0); PG8_STAGE(PG8_SA(1, 1), a1 + hstep, voffA);
            PG8_WAIT_V(8); PG8_WAIT_L(0); PG8_BAR; PG8_MMA(0, 0, At, B0); PG8_MMA(0, 1, At, B1); PG8_BAR; PG8_SCHED;
            PG8_LDA(At, 0, 1); PG8_STAGE(PG8_SB(0, 0), b2, voffB); PG8_STAGE(PG8_SB(0, 1), b2 + hstep, voffB); PG8_STAGE(PG8_SA(0, 0), a2, voffA);
            PG8_WAIT_V(8); PG8_WAIT_L(0); PG8_BAR; PG8_MMA(1, 0, At, B0); PG8_MMA(1, 1, At, B1); PG8_BAR; PG8_SCHED;
            PG8_LDB(B0, 1, 0); PG8_LDB(B1, 1, 1); PG8_SCHED; PG8_LDA(At, 1, 0); PG8_STAGE(PG8_SA(0, 1), a2 + hstep, voffA);
            PG8_WAIT_V(8); PG8_WAIT_L(0); PG8_BAR; PG8_MMA(0, 0, At, B0); PG8_MMA(0, 1, At, B1); PG8_BAR; PG8_SCHED;
            PG8_LDA(At, 1, 1); PG8_STAGE(PG8_SB(1, 0), b3, voffB); PG8_STAGE(PG8_SB(1, 1), b3 + hstep, voffB); PG8_STAGE(PG8_SA(1, 0), a3, voffA);
            PG8_WAIT_V(8); PG8_WAIT_L(0); PG8_BAR; PG8_MMA(1, 0, At, B0); PG8_MMA(1, 1, At, B1); PG8_BAR; PG8_SCHED;
            } else {
            PG8_LDB(B0, 0, 0); PG8_SCHED; PG8_LDA(At, 0, 0); PG8_STAGE(PG8_SA(1, 1), a1 + hstep, voffA);
            PG8_WAIT_L(8); PG8_BAR; PG8_WAIT_L(0); PG8_MMA(0, 0, At, B0); PG8_BAR; PG8_SCHED;
            PG8_LDB(B1, 0, 1); PG8_STAGE(PG8_SB(0, 0), b2, voffB);
            PG8_BAR; PG8_WAIT_L(0); PG8_MMA(0, 1, At, B1); PG8_BAR;
            PG8_LDA(At, 0, 1); PG8_STAGE(PG8_SA(0, 0), a2, voffA);
            PG8_BAR; PG8_WAIT_L(0); PG8_MMA(1, 0, At, B0); PG8_BAR; PG8_SCHED;
            PG8_STAGE(PG8_SB(0, 1), b2 + hstep, voffB);
            PG8_WAIT_V(6); PG8_BAR; PG8_MMA(1, 1, At, B1); PG8_BAR;
            PG8_LDB(B0, 1, 0); PG8_SCHED; PG8_LDA(At, 1, 0); PG8_STAGE(PG8_SA(0, 1), a2 + hstep, voffA);
            PG8_WAIT_L(8); PG8_BAR; PG8_WAIT_L(0); PG8_MMA(0, 0, At, B0); PG8_BAR; PG8_SCHED;
            PG8_LDB(B1, 1, 1); PG8_STAGE(PG8_SB(1, 0), b3, voffB);
            PG8_BAR; PG8_WAIT_L(0); PG8_MMA(0, 1, At, B1); PG8_BAR;
            PG8_LDA(At, 1, 1); PG8_STAGE(PG8_SA(1, 0), a3, voffA);
            PG8_BAR; PG8_WAIT_L(0); PG8_MMA(1, 0, At, B0); PG8_BAR; PG8_SCHED;
            PG8_STAGE(PG8_SB(1, 1), b3 + hstep, voffB);
            PG8_WAIT_V(6); PG8_BAR; PG8_MMA(1, 1, At, B1); PG8_BAR;
            }
        }
        if constexpr (ALIGN_EPI) { if (wr == 0) PG8_BAR; }
        if constexpr (!Epi::AFTER_DRAIN) { E(acc, cur, wr, wc, fr, fq); S.done(cur); }
        if (!has_next) break;
#pragma unroll
        for (int a = 0; a < 2; ++a)
#pragma unroll
            for (int b = 0; b < 2; ++b)
#pragma unroll
                for (int m = 0; m < 4; ++m)
#pragma unroll
                    for (int n = 0; n < 2; ++n) acc[a][b][m][n] = (f32x4){0.f, 0.f, 0.f, 0.f};
        cur = nxt; cA = nA; cB = nB; ++ui;
        if constexpr (ALIGN_EPI) { if (wr == 1) PG8_BAR; }
    }
    PG8_WAIT_V(0);
    if constexpr (!ALIGN_EPI) { if (wr == 0) PG8_BAR; }
    PG8_BAR;
    if constexpr (Epi::AFTER_DRAIN) { E.fused(acc, cur, wr, wc, fr, fq, lds, wid, lane); S.done(cur); }
#undef PG8_SA
#undef PG8_SB
#undef PG8_STAGE
#undef PG8_LDA
#undef PG8_LDB
#undef PG8_MMA
#undef PG8_WAIT_V
#undef PG8_WAIT_L
#undef PG8_BAR
#undef PG8_SCHED
}
}
constexpr int NWAVES = 8;
constexpr int T = 16384, SEQ = 8192, D = 1024, NIN = 2840, NINP = 3072, NQ = 2048;
constexpr int C_Q = 0, C_K = 256, C_V = 512, C_GLR = 1024, C_GOUT = 1040, C_Z = 1552, C_XBC = 2064, C_DT = 2832;
constexpr float EPS = 1e-6f;
constexpr size_t MiB = 1u << 20;
constexpr size_t WS_CTL = 0, CTL_ZERO_BYTES = 64 * 1024;
constexpr size_t WS_WIN = 1 * MiB;
constexpr size_t WS_WO = 7 * MiB;
constexpr size_t WS_WQ = 9 * MiB;
constexpr size_t WS_SUBK = 13 * MiB;
constexpr size_t WS_RRMS1 = 14 * MiB;
constexpr size_t WS_ROWSQ2 = 14 * MiB + 64 * 1024;
constexpr size_t WS_UB = 16 * MiB, WS_VB = 24 * MiB;
constexpr size_t WS_MIX = 32 * MiB;
constexpr size_t WS_XB = 80 * MiB;
constexpr size_t WS_PROJ = 112 * MiB;
constexpr int CW_TMO = 0, CW_BAR = 1024;
constexpr int RING_OFF = 0, RING_BYTES = 131072;
constexpr int LDS_BYTES = 163840;
constexpr int LDSCTL_OFF = LDS_BYTES - 1024, MISC_OFF = LDSCTL_OFF + 320;

#define GAS __attribute__((address_space(1)))
#define LAS __attribute__((address_space(3)))
typedef unsigned short bf16;
typedef unsigned v4u __attribute__((ext_vector_type(4)));
typedef float f32x4 __attribute__((ext_vector_type(4)));
typedef short bf16x8 __attribute__((ext_vector_type(8)));
typedef GAS unsigned gu32;
#define RLX_AGENT __ATOMIC_RELAXED, __HIP_MEMORY_SCOPE_AGENT
#define LDS_WAIT() asm volatile("s_waitcnt lgkmcnt(0)" ::: "memory")
#define VM_WAIT() asm volatile("s_waitcnt vmcnt(0)" ::: "memory")
typedef float f32x2c __attribute__((ext_vector_type(2)));
typedef __bf16 bf16x2c __attribute__((ext_vector_type(2)));
__device__ __forceinline__ unsigned f2bf(float f) { const __bf16 b = (__bf16)f; return (unsigned)__builtin_bit_cast(unsigned short, b); }
__device__ __forceinline__ unsigned pk2(float lo, float hi) { const bf16x2c v = __builtin_convertvector((f32x2c){lo, hi}, bf16x2c); return __builtin_bit_cast(unsigned, v); }
__device__ __forceinline__ float bf2f(unsigned short b) { return __builtin_bit_cast(float, (unsigned)b << 16); }
__device__ __forceinline__ float wave_sum(float v) {
#pragma unroll
    for (int o = 1; o < 64; o <<= 1) v += __shfl_xor(v, o);
    return v;
}
#define XB_TMO      128
#define XB_XCNT(j)  (256  + 64 * (j))
#define XB_XSUB(j)  (1280 + 64 * (j))
#define XB_XGEN(j)  (2304 + 64 * (j))
#define XB_TOP      3328
#define XB_TOPGEN   3392
#define XCD_BAR_WORDS 3456
#define XB_SPIN_CAP (1u << 18)

__device__ __forceinline__ unsigned xb_ld(unsigned* p)              { return __hip_atomic_load(p, __ATOMIC_RELAXED, __HIP_MEMORY_SCOPE_AGENT); }
__device__ __forceinline__ unsigned xb_add(unsigned* p, unsigned v) { return __hip_atomic_fetch_add(p, v, __ATOMIC_RELAXED, __HIP_MEMORY_SCOPE_AGENT); }
__device__ __forceinline__ unsigned xb_xcc_id() { return (unsigned)__builtin_amdgcn_s_getreg((3 << 11) | 20) & 0xFu; }
#define XB_SPIN(cond, bar) do { unsigned _sp = 0; while (cond) { __builtin_amdgcn_s_sleep(1); \
    if ((++_sp & 255u) == 0u) { if (xb_ld(&(bar)[XB_TMO])) break; if (_sp > XB_SPIN_CAP) { atomicAdd(&(bar)[XB_TMO], 1u); break; } } } } while (0)

struct XcdBarrier {
    unsigned* bar; unsigned x;
    volatile LAS unsigned* st;
};

__device__ __forceinline__ XcdBarrier xcd_barrier_post(unsigned* bar, volatile LAS unsigned* st) {
    XcdBarrier b; b.bar = bar; b.x = xb_xcc_id(); b.st = st;
    if (threadIdx.x == 0) (void)xb_add(&bar[XB_XCNT(b.x)], 1u);
    return b;
}
__device__ __forceinline__ void xcd_barrier_complete(unsigned* bar, unsigned x, unsigned& nloc, unsigned& nx) {
    const unsigned G = gridDim.x * gridDim.y * gridDim.z;
    unsigned sum, cnt, mine, sp = 0u;
    for (;;) {
        sum = 0u; cnt = 0u; mine = 0u;
#pragma unroll
        for (unsigned j = 0; j < 16; ++j) { const unsigned c = xb_ld(&bar[XB_XCNT(j)]); sum += c; cnt += (c > 0u) ? 1u : 0u; mine = (j == x) ? c : mine; }
        if (sum == G) break;
        __builtin_amdgcn_s_sleep(1);
        if ((++sp & 255u) == 0u) { if (xb_ld(&bar[XB_TMO])) break; if (sp > XB_SPIN_CAP) { atomicAdd(&bar[XB_TMO], 1u); break; } }
    }
    nloc = mine > 0u ? mine : 1u; nx = cnt > 0u ? cnt : 1u;
}

__device__ __forceinline__ void xcd_barrier(const XcdBarrier& b) {
    asm volatile("s_waitcnt vmcnt(0)" ::: "memory");
    __syncthreads();
    if (threadIdx.x == 0) {
        unsigned* bar = b.bar;
        __builtin_amdgcn_s_waitcnt(0);
        unsigned nloc = b.st[0], nx = b.st[1];
        if (nloc == 0u) { xcd_barrier_complete(bar, b.x, nloc, nx); b.st[0] = nloc; b.st[1] = nx; }
        const unsigned old = xb_add(&bar[XB_XSUB(b.x)], 1u);
        const unsigned gen = old / nloc;
        if (old + 1u == (gen + 1u) * nloc) {
            __builtin_amdgcn_fence(__ATOMIC_RELEASE, "agent");
            asm volatile("s_waitcnt vmcnt(0)" ::: "memory");
            const unsigned og = xb_add(&bar[XB_TOP], 1u);
            const unsigned tg = og / nx;
            if (og + 1u == (tg + 1u) * nx) xb_add(&bar[XB_TOPGEN], 1u);
            else XB_SPIN(xb_ld(&bar[XB_TOPGEN]) == tg, bar);
            __builtin_amdgcn_fence(__ATOMIC_ACQUIRE, "agent");
            xb_add(&bar[XB_XGEN(b.x)], 1u);
            asm volatile("s_waitcnt vmcnt(0)" ::: "memory");
        } else {
            XB_SPIN(xb_ld(&bar[XB_XGEN(b.x)]) == gen, bar);
            __builtin_amdgcn_fence(__ATOMIC_ACQUIRE, "agent");
            asm volatile("s_waitcnt vmcnt(0)" ::: "memory");
        }
    }
    __syncthreads();
}
struct Args {
    const float* in[19]; float* out; unsigned char* ws; int ph_lo, ph_hi;
};
struct Frame {
    LAS unsigned char* lds; volatile LAS unsigned* MISC; gu32* ctl;
    int tid, lane, wave, G, gw, NGW;
};

constexpr size_t WS_GDEC = 14 * MiB + 128 * 1024;
constexpr size_t WS_SDEC = 14 * MiB + 512 * 1024;
constexpr size_t WS_GST = 208 * MiB;
constexpr size_t WS_SST = 224 * MiB;
constexpr int SA64 = 144, SA128 = 272, SA32 = 80, SXN = 528;

__device__ __forceinline__ float silu_f(float x) { return x * __builtin_amdgcn_rcpf(1.f + __expf(-x)); }
__device__ __forceinline__ float softplus_f(float x) { return fmaxf(x, 0.f) + __logf(1.f + __expf(-fabsf(x))); }
__device__ __forceinline__ float logsigmoid_f(float x) { return fminf(x, 0.f) - __logf(1.f + __expf(-fabsf(x))); }
typedef unsigned u32x2 __attribute__((ext_vector_type(2)));

__device__ __forceinline__ f32x4 mma16(const LAS unsigned char* A, int sa, const LAS unsigned char* Bt, int sb, int K, f32x4 acc, int r, int kg) {
    for (int k0 = 0; k0 < K; k0 += 32) {
        const bf16x8 a = *(const LAS bf16x8*)(A + r * sa + (k0 + 8 * kg) * 2);
        const bf16x8 b = *(const LAS bf16x8*)(Bt + r * sb + (k0 + 8 * kg) * 2);
        acc = __builtin_amdgcn_mfma_f32_16x16x32_bf16(a, b, acc, 0, 0, 0);
    }
    return acc;
}

__device__ __forceinline__ void unpack8f(const v4u x, float (&f)[8]) {
    f[0] = __builtin_bit_cast(float, x.x << 16); f[1] = __builtin_bit_cast(float, x.x & 0xffff0000u); f[2] = __builtin_bit_cast(float, x.y << 16); f[3] = __builtin_bit_cast(float, x.y & 0xffff0000u);
    f[4] = __builtin_bit_cast(float, x.z << 16); f[5] = __builtin_bit_cast(float, x.z & 0xffff0000u); f[6] = __builtin_bit_cast(float, x.w << 16); f[7] = __builtin_bit_cast(float, x.w & 0xffff0000u);
}
typedef short s16x4 __attribute__((ext_vector_type(4)));
template <int SB> __device__ __forceinline__ void tr_frag2(unsigned base, bf16x8& f0, bf16x8& f1) {
    s16x4 a, b, c, d;
    asm volatile("ds_read_b64_tr_b16 %0, %4\n\tds_read_b64_tr_b16 %1, %4 offset:%5\n\tds_read_b64_tr_b16 %2, %4 offset:%6\n\tds_read_b64_tr_b16 %3, %4 offset:%7\n\ts_waitcnt lgkmcnt(0)"
                 : "=&v"(a), "=&v"(b), "=&v"(c), "=&v"(d) : "v"(base), "i"(4 * SB), "i"(32 * SB), "i"(36 * SB) : "memory");
    f0 = __builtin_shufflevector(a, b, 0, 1, 2, 3, 4, 5, 6, 7); f1 = __builtin_shufflevector(c, d, 0, 1, 2, 3, 4, 5, 6, 7);
}
template <int SB> __device__ __forceinline__ void tr_frag4n(unsigned base, bf16x8& f0, bf16x8& f1, bf16x8& f2, bf16x8& f3) {
    s16x4 a0, b0, a1, b1, a2, b2, a3, b3;
    asm volatile("ds_read_b64_tr_b16 %0, %8\n\tds_read_b64_tr_b16 %1, %8 offset:%9\n\tds_read_b64_tr_b16 %2, %8 offset:32\n\tds_read_b64_tr_b16 %3, %8 offset:%10\n\t"
                 "ds_read_b64_tr_b16 %4, %8 offset:64\n\tds_read_b64_tr_b16 %5, %8 offset:%11\n\tds_read_b64_tr_b16 %6, %8 offset:96\n\tds_read_b64_tr_b16 %7, %8 offset:%12\n\ts_waitcnt lgkmcnt(0)"
                 : "=&v"(a0), "=&v"(b0), "=&v"(a1), "=&v"(b1), "=&v"(a2), "=&v"(b2), "=&v"(a3), "=&v"(b3)
                 : "v"(base), "i"(4 * SB), "i"(4 * SB + 32), "i"(4 * SB + 64), "i"(4 * SB + 96) : "memory");
    f0 = __builtin_shufflevector(a0, b0, 0, 1, 2, 3, 4, 5, 6, 7); f1 = __builtin_shufflevector(a1, b1, 0, 1, 2, 3, 4, 5, 6, 7);
    f2 = __builtin_shufflevector(a2, b2, 0, 1, 2, 3, 4, 5, 6, 7); f3 = __builtin_shufflevector(a3, b3, 0, 1, 2, 3, 4, 5, 6, 7);
}
template <int SB> __device__ __forceinline__ f32x4 mma16_trB64(const LAS unsigned char* A, int sa, unsigned bbase, int n0, f32x4 acc, int r, int kg) {
    bf16x8 b0, b1; tr_frag2<SB>(bbase + (unsigned)((8 * kg + (r >> 2)) * SB + (n0 + 4 * (r & 3)) * 2), b0, b1);
    const bf16x8 a0 = *(const LAS bf16x8*)(A + r * sa + (8 * kg) * 2), a1 = *(const LAS bf16x8*)(A + r * sa + (32 + 8 * kg) * 2);
    acc = __builtin_amdgcn_mfma_f32_16x16x32_bf16(a0, b0, acc, 0, 0, 0);
    return __builtin_amdgcn_mfma_f32_16x16x32_bf16(a1, b1, acc, 0, 0, 0);
}
template <int MODE>
__device__ __forceinline__ void gla_unit(const Frame& F, const Args& A, int unit) {
    const int b = unit >> 9, c = (unit >> 2) & 127, h = unit & 3;
    const size_t t0 = (size_t)b * SEQ + (size_t)c * 64;
    const GAS bf16* proj = (const GAS bf16*)(A.ws + WS_PROJ);
    LAS unsigned char* L = F.lds;
    LAS float* GLR = (LAS float*)(L + 0);
    LAS float* SEG = (LAS float*)(L + 4096);
    LAS float* RSQ = (LAS float*)(L + 6144);
    LAS unsigned char* QI = L + 8192;
    LAS unsigned char* KI = QI + 64 * SA64;
    LAS unsigned char* VT = KI + 64 * SA64;
    LAS unsigned char* SP = VT + 128 * SA64;
    LAS unsigned char* AT = SP + 128 * SA64;
    LAS unsigned char* GO = AT + 64 * SA64;
    int tid = F.tid, seg = F.wave;
    asm volatile("" : "+v"(tid)); asm volatile("" : "+s"(seg));
    const int d = tid & 63;
    {
        const int row = tid >> 3, ch = tid & 7;
        const GAS bf16* prow = proj + (t0 + row) * NINP;
        const v4u kq = *(const GAS v4u*)(prow + C_K + h * 64 + ch * 8);
        v4u qq = kq; if (MODE == 1) qq = *(const GAS v4u*)(prow + C_Q + h * 64 + ch * 8);
        const int o = tid & 15, jp = tid >> 4;
        const v4u va = *(const GAS v4u*)(proj + (t0 + 2 * jp) * NINP + C_V + h * 128 + o * 8), vb = *(const GAS v4u*)(proj + (t0 + 2 * jp + 1) * NINP + C_V + h * 128 + o * 8);
        v4u g0 = kq, g1 = kq, s0 = kq, s1 = kq;
        if (MODE == 1) {
            const int r2 = tid >> 4, c2 = tid & 15;
            g0 = *(const GAS v4u*)(proj + (t0 + r2) * NINP + C_GOUT + h * 128 + c2 * 8); g1 = *(const GAS v4u*)(proj + (t0 + r2 + 32) * NINP + C_GOUT + h * 128 + c2 * 8);
            const GAS bf16* sp = (const GAS bf16*)(A.ws + WS_GST) + (size_t)unit * 8192;
            s0 = *(const GAS v4u*)(sp + (tid >> 3) * 64 + (tid & 7) * 8); s1 = *(const GAS v4u*)(sp + (64 + (tid >> 3)) * 64 + (tid & 7) * 8);
        }
        v4u gl = kq; if (tid < 128) gl = *(const GAS v4u*)(proj + (t0 + (tid >> 1)) * NINP + C_GLR + (tid & 1) * 8);
        if (MODE == 1) { *(LAS v4u*)(QI + row * SA64 + ch * 16) = qq; *(LAS v4u*)(KI + row * SA64 + ch * 16) = kq; }
        else *(LAS v4u*)(GO + row * SA64 + ch * 16) = kq;
        *(LAS v4u*)(VT + (2 * jp) * SA128 + o * 16) = va; *(LAS v4u*)(VT + (2 * jp + 1) * SA128 + o * 16) = vb;
        if (MODE == 1) {
            const int r2 = tid >> 4, c2 = tid & 15;
            *(LAS v4u*)(GO + r2 * SA128 + c2 * 16) = g0; *(LAS v4u*)(GO + (r2 + 32) * SA128 + c2 * 16) = g1;
            *(LAS v4u*)(SP + (tid >> 3) * SA64 + (tid & 7) * 16) = s0; *(LAS v4u*)(SP + (64 + (tid >> 3)) * SA64 + (tid & 7) * 16) = s1;
        }
        if (tid < 128) { float f[8]; unpack8f(gl, f);
#pragma unroll
            for (int q = 0; q < 8; ++q) GLR[(tid >> 1) * 16 + (tid & 1) * 8 + q] = f[q]; }
    }
    float wv[16];
#pragma unroll
    for (int r = 0; r < 16; ++r) wv[r] = A.in[3][r * 256 + h * 64 + d];
    const float bgv = A.in[4][h * 64 + d];
    __syncthreads();
    float Gv[8]; float run = 0.f;
#pragma unroll
    for (int ii = 0; ii < 8; ++ii) { const int i = seg * 8 + ii; float z = bgv;
#pragma unroll
        for (int r = 0; r < 16; ++r) z += GLR[i * 16 + r] * wv[r];
        run += logsigmoid_f(z) * (1.f / 16.f); Gv[ii] = run; }
    SEG[seg * 64 + d] = run;
    __syncthreads();
    float off = 0.f, tot = 0.f;
#pragma unroll
    for (int s = 0; s < 8; ++s) { const float v = SEG[s * 64 + d]; tot += v; off += (s < seg) ? v : 0.f; }
#pragma unroll
    for (int ii = 0; ii < 8; ++ii) Gv[ii] += off;
    if (MODE == 0) {
        unsigned w[4];
#pragma unroll
        for (int ii = 0; ii < 8; ii += 2) {
            const float k0 = bf2f(*(const LAS bf16*)(GO + (seg * 8 + ii) * SA64 + d * 2)) * __expf(tot - Gv[ii]);
            const float k1 = bf2f(*(const LAS bf16*)(GO + (seg * 8 + ii + 1) * SA64 + d * 2)) * __expf(tot - Gv[ii + 1]);
            w[ii >> 1] = pk2(k0, k1); }
        *(LAS v4u*)(KI + d * SA64 + seg * 16) = (v4u){w[0], w[1], w[2], w[3]};
        if (seg == 0) ((GAS float*)(A.ws + WS_GDEC))[unit * 64 + d] = __expf(tot);
    } else {
#pragma unroll
        for (int ii = 0; ii < 8; ++ii) { const int i = seg * 8 + ii;
            LAS bf16* qp = (LAS bf16*)(QI + i * SA64 + d * 2); LAS bf16* kp = (LAS bf16*)(KI + i * SA64 + d * 2);
            *qp = (bf16)f2bf(bf2f(*qp) * 0.125f * __expf(Gv[ii])); *kp = (bf16)f2bf(bf2f(*kp) * __expf(-Gv[ii])); }
    }
    __syncthreads();
    const int r = tid & 15, kg = (tid >> 4) & 3, w = seg;
    const f32x4 zero = (f32x4){0.f, 0.f, 0.f, 0.f};
    if (MODE == 0) {
        const int mt = w & 3, nb = (w >> 2) * 4;
        GAS bf16* stT = (GAS bf16*)(A.ws + WS_GST) + (size_t)unit * 8192;
#pragma unroll
        for (int n = 0; n < 4; ++n) {
            const f32x4 acc = mma16_trB64<SA128>(KI + mt * 16 * SA64, SA64, (unsigned)(size_t)VT, (nb + n) * 16, zero, r, kg);
            const int dv = (nb + n) * 16 + r, d0 = mt * 16 + kg * 4;
            *(GAS u32x2*)(stT + dv * 64 + d0) = (u32x2){pk2(acc[0], acc[1]), pk2(acc[2], acc[3])}; }
    } else {
        const int mt = w & 3;
#pragma unroll
        for (int n = 0; n < 2; ++n) { const int nt = (w >> 2) * 2 + n;
            const f32x4 acc = mma16(QI + mt * 16 * SA64, SA64, KI + nt * 16 * SA64, SA64, 64, zero, r, kg);
#pragma unroll
            for (int ii = 0; ii < 4; ++ii) { const int i = mt * 16 + kg * 4 + ii, j = nt * 16 + r; *(LAS bf16*)(AT + i * SA64 + j * 2) = (bf16)f2bf(j <= i ? acc[ii] : 0.f); } }
        __syncthreads();
        const int nb = (w >> 2) * 4;
        f32x4 o[4]; float rs[4] = {0.f, 0.f, 0.f, 0.f};
#pragma unroll
        for (int n = 0; n < 4; ++n) {
            f32x4 acc = mma16_trB64<SA128>(AT + mt * 16 * SA64, SA64, (unsigned)(size_t)VT, (nb + n) * 16, zero, r, kg);
            acc = mma16(QI + mt * 16 * SA64, SA64, SP + (nb + n) * 16 * SA64, SA64, 64, acc, r, kg);
            o[n] = acc;
#pragma unroll
            for (int ii = 0; ii < 4; ++ii) rs[ii] += acc[ii] * acc[ii]; }
#pragma unroll
        for (int ii = 0; ii < 4; ++ii) { rs[ii] += __shfl_xor(rs[ii], 1); rs[ii] += __shfl_xor(rs[ii], 2); rs[ii] += __shfl_xor(rs[ii], 4); rs[ii] += __shfl_xor(rs[ii], 8); }
        if (r == 0) {
#pragma unroll
            for (int ii = 0; ii < 4; ++ii) RSQ[(w >> 2) * 64 + mt * 16 + kg * 4 + ii] = rs[ii]; }
        __syncthreads();
        float rr[4];
#pragma unroll
        for (int ii = 0; ii < 4; ++ii) { const int row = mt * 16 + kg * 4 + ii; rr[ii] = rsqrtf((RSQ[row] + RSQ[64 + row]) * (1.f / 128.f) + EPS); }
#pragma unroll
        for (int n = 0; n < 4; ++n) { const int dv = (nb + n) * 16 + r; const float nwv = A.in[5][dv];
#pragma unroll
            for (int ii = 0; ii < 4; ++ii) { LAS bf16* gp = (LAS bf16*)(GO + (mt * 16 + kg * 4 + ii) * SA128 + dv * 2);
                *gp = (bf16)f2bf(o[n][ii] * rr[ii] * nwv * silu_f(bf2f(*gp))); } }
        __syncthreads();
        {   const int r2 = tid >> 4, c2 = tid & 15; GAS bf16* mixed = (GAS bf16*)(A.ws + WS_MIX);
            *(GAS v4u*)(mixed + (t0 + r2) * D + h * 128 + c2 * 8) = *(const LAS v4u*)(GO + r2 * SA128 + c2 * 16);
            *(GAS v4u*)(mixed + (t0 + r2 + 32) * D + h * 128 + c2 * 8) = *(const LAS v4u*)(GO + (r2 + 32) * SA128 + c2 * 16); }
    }
    __syncthreads();
}

template <int MODE>
__device__ __forceinline__ void ssd_unit(const Frame& F, const Args& A, int unit) {
    const int b = unit >> 7, c = (unit >> 1) & 63, g = unit & 1;
    const size_t t0 = (size_t)b * SEQ + (size_t)c * 128;
    const GAS bf16* proj = (const GAS bf16*)(A.ws + WS_PROJ);
    LAS unsigned char* L = F.lds;
    LAS float* DT = (LAS float*)(L + 0);
    LAS float* ACU = (LAS float*)(L + 2048);
    LAS unsigned char* CM = L + 4096;
    LAS unsigned char* BM = CM + 128 * SA64;
    LAS unsigned char* XT = BM + 128 * SA64;
    LAS unsigned char* PW = XT + 128 * SXN;
    LAS unsigned char* ZW = PW + 8 * 16 * SA32;
    LAS float* RRW = (LAS float*)(ZW + 8 * 16 * SA64);
    int tid = F.tid, w = F.wave;
    asm volatile("" : "+v"(tid)); asm volatile("" : "+s"(w));
    const int lane = tid & 63;
    if (w < 4) {
        const int hd = g * 4 + w; const float Ah = -__expf(A.in[9][hd]), dtb = A.in[8][hd];
        const float dt0 = softplus_f(bf2f(proj[(t0 + 2 * lane) * NINP + C_DT + hd]) + dtb), dt1 = softplus_f(bf2f(proj[(t0 + 2 * lane + 1) * NINP + C_DT + hd]) + dtb);
        const float a0 = dt0 * Ah, a1 = dt1 * Ah; float s = a0 + a1;
#pragma unroll
        for (int o = 1; o < 64; o <<= 1) { const float t = __shfl_up(s, o); s += (lane >= o) ? t : 0.f; }
        DT[(2 * lane) * 4 + w] = dt0; DT[(2 * lane + 1) * 4 + w] = dt1; ACU[(2 * lane) * 4 + w] = s - a1; ACU[(2 * lane + 1) * 4 + w] = s;
        if (MODE == 0 && lane == 63) ((GAS float*)(A.ws + WS_SDEC))[(b * 64 + c) * 8 + hd] = __expf(s);
    }
    __syncthreads();
    if (tid < 384) {
        const int o = tid % 48, sg = tid / 48;
        if (!(MODE == 0 && o >= 40)) {
            const int cc0 = o < 32 ? g * 256 + 8 * o : (o < 40 ? 512 + g * 64 + 8 * (o - 32) : 640 + g * 64 + 8 * (o - 40));
            float wt[4][8], cb[8];
#pragma unroll
            for (int j = 0; j < 4; ++j) { const f32x4 a = *(const GAS f32x4*)(A.in[6] + j * 768 + cc0), bq = *(const GAS f32x4*)(A.in[6] + j * 768 + cc0 + 4);
                wt[j][0] = a.x; wt[j][1] = a.y; wt[j][2] = a.z; wt[j][3] = a.w; wt[j][4] = bq.x; wt[j][5] = bq.y; wt[j][6] = bq.z; wt[j][7] = bq.w; }
            { const f32x4 a = *(const GAS f32x4*)(A.in[7] + cc0), bq = *(const GAS f32x4*)(A.in[7] + cc0 + 4); cb[0] = a.x; cb[1] = a.y; cb[2] = a.z; cb[3] = a.w; cb[4] = bq.x; cb[5] = bq.y; cb[6] = bq.z; cb[7] = bq.w; }
            const GAS bf16* src = proj + (t0 + 16 * sg) * NINP + C_XBC + cc0;
            float x0[8], x1[8], x2[8];
            if (c > 0 || sg > 0) { unpack8f(*(const GAS v4u*)(src - 3 * NINP), x0); unpack8f(*(const GAS v4u*)(src - 2 * NINP), x1); unpack8f(*(const GAS v4u*)(src - 1 * NINP), x2); }
            else {
#pragma unroll
                for (int q = 0; q < 8; ++q) { x0[q] = 0.f; x1[q] = 0.f; x2[q] = 0.f; } }
            const int hl = o >> 3, p0 = (o & 7) * 8;
            float sc_end = 0.f; if (MODE == 0 && o < 32) sc_end = ACU[127 * 4 + hl];
#pragma unroll 1
            for (int hf = 0; hf < 2; ++hf) {
                v4u xin[8];
#pragma unroll
                for (int i = 0; i < 8; ++i) xin[i] = *(const GAS v4u*)(src + (size_t)(hf * 8 + i) * NINP);
#pragma unroll
                for (int i = 0; i < 8; ++i) {
                    const int l = 16 * sg + hf * 8 + i;
                    float xc[8]; unpack8f(xin[i], xc);
                    float v[8];
#pragma unroll
                    for (int q = 0; q < 8; ++q) v[q] = silu_f(cb[q] + wt[0][q] * x0[q] + wt[1][q] * x1[q] + wt[2][q] * x2[q] + wt[3][q] * xc[q]);
#pragma unroll
                    for (int q = 0; q < 8; ++q) { x0[q] = x1[q]; x1[q] = x2[q]; x2[q] = xc[q]; }
                    if (MODE == 0 && o < 32) { const float sc = DT[l * 4 + hl] * __expf(sc_end - ACU[l * 4 + hl]);
#pragma unroll
                        for (int q = 0; q < 8; ++q) v[q] *= sc; }
                    const v4u ov = (v4u){pk2(v[0], v[1]), pk2(v[2], v[3]), pk2(v[4], v[5]), pk2(v[6], v[7])};
                    if (o < 32) *(LAS v4u*)(XT + l * SXN + o * 16) = ov;
                    else *(LAS v4u*)((o < 40 ? BM : CM) + l * SA64 + (o & 7) * 16) = ov;
                }
            }
        }
    }
    __syncthreads();
    const int r = lane & 15, kg = lane >> 4;
    const f32x4 zero = (f32x4){0.f, 0.f, 0.f, 0.f};
    if (MODE == 0) {
        const int hl = w >> 1;
        GAS bf16* st = (GAS bf16*)(A.ws + WS_SST) + ((size_t)((b * 64 + c) * 8 + g * 4 + hl)) * 4096;
#pragma unroll
        for (int mt = 0; mt < 4; ++mt)
#pragma unroll
            for (int n = 0; n < 2; ++n) { const int nt = (w & 1) * 2 + n;
                f32x4 acc = zero;
#pragma unroll
                for (int kh = 0; kh < 2; ++kh) {
                    bf16x8 a0, a1, b0, b1;
                    tr_frag2<SA64>((unsigned)(size_t)BM + (unsigned)((64 * kh + 8 * kg + (r >> 2)) * SA64 + (mt * 16 + 4 * (r & 3)) * 2), a0, a1);
                    tr_frag2<SXN>((unsigned)(size_t)XT + (unsigned)((64 * kh + 8 * kg + (r >> 2)) * SXN + (hl * 64 + nt * 16 + 4 * (r & 3)) * 2), b0, b1);
                    acc = __builtin_amdgcn_mfma_f32_16x16x32_bf16(a0, b0, acc, 0, 0, 0); acc = __builtin_amdgcn_mfma_f32_16x16x32_bf16(a1, b1, acc, 0, 0, 0); }
                const int p = nt * 16 + r, n0 = mt * 16 + kg * 4;
                *(GAS u32x2*)(st + p * 64 + n0) = (u32x2){pk2(acc[0], acc[1]), pk2(acc[2], acc[3])}; }
    } else {
        f32x4 sc[8];
#pragma unroll
        for (int nt = 0; nt < 8; ++nt) { sc[nt] = zero; if (nt <= w) sc[nt] = mma16(CM + w * 16 * SA64, SA64, BM + nt * 16 * SA64, SA64, 64, zero, r, kg); }
        __syncthreads();
        const GAS bf16* spg = (const GAS bf16*)(A.ws + WS_SST) + ((size_t)((b * 64 + c) * 8 + g * 4)) * 4096;
        for (int e = tid; e < 1024; e += 512) { const int row = e >> 3, ch = e & 7; *(LAS v4u*)(BM + row * SA64 + ch * 16) = *(const GAS v4u*)(spg + row * 64 + ch * 8); }
        __syncthreads();
        float rs[4] = {0.f, 0.f, 0.f, 0.f};
        LAS unsigned char* pw = PW + w * 16 * SA32;
        LAS unsigned char* zw = ZW + w * 16 * SA64;
        const int orow = lane >> 3, och = lane & 7;
        const GAS bf16* zsrc = proj + (t0 + w * 16 + orow) * NINP + C_Z + g * 256 + och * 8;
        v4u ysave[4][2];
#pragma unroll
        for (int hl = 0; hl < 4; ++hl) {
            if (hl == 2) {
                __syncthreads();
                for (int e = tid; e < 1024; e += 512) { const int row = e >> 3, ch = e & 7; *(LAS v4u*)(BM + row * SA64 + ch * 16) = *(const GAS v4u*)(spg + 2 * 4096 + row * 64 + ch * 8); }
                __syncthreads();
            }
            asm volatile("" ::: "memory");
            const v4u z0 = *(const GAS v4u*)(zsrc + hl * 64), z1 = *(const GAS v4u*)(zsrc + (size_t)8 * NINP + hl * 64);
            float acl[4];
#pragma unroll
            for (int ii = 0; ii < 4; ++ii) acl[ii] = ACU[(w * 16 + kg * 4 + ii) * 4 + hl];
            f32x4 yd[4] = {zero, zero, zero, zero};
#pragma unroll
            for (int kc = 0; kc < 4; ++kc) {
                if (kc * 2 <= w) {
#pragma unroll
                    for (int half = 0; half < 2; ++half) { const int stl = 2 * kc + half; const int s = stl * 16 + r;
                        const float acs = ACU[s * 4 + hl], dts = DT[s * 4 + hl];
#pragma unroll
                        for (int ii = 0; ii < 4; ++ii) { const int l = w * 16 + kg * 4 + ii;
                            const float pv = (s <= l) ? sc[stl][ii] * __expf(acl[ii] - acs) * dts : 0.f;
                            *(LAS bf16*)(pw + (kg * 4 + ii) * SA32 + (half * 16 + r) * 2) = (bf16)f2bf(pv); } }
                    LDS_WAIT();
                    const bf16x8 a = *(const LAS bf16x8*)(pw + r * SA32 + kg * 16);
                    bf16x8 bb[4];
                    tr_frag4n<SXN>((unsigned)(size_t)XT + (unsigned)((kc * 32 + 8 * kg + (r >> 2)) * SXN + (hl * 64 + 4 * (r & 3)) * 2), bb[0], bb[1], bb[2], bb[3]);
#pragma unroll
                    for (int nt = 0; nt < 4; ++nt) yd[nt] = __builtin_amdgcn_mfma_f32_16x16x32_bf16(a, bb[nt], yd[nt], 0, 0, 0);
                    LDS_WAIT();
                }
            }
            *(LAS v4u*)(zw + orow * SA64 + och * 16) = z0; *(LAS v4u*)(zw + (orow + 8) * SA64 + och * 16) = z1;
            LDS_WAIT();
            const float Dk = A.in[10][g * 4 + hl];
            float eal[4];
#pragma unroll
            for (int ii = 0; ii < 4; ++ii) eal[ii] = __expf(acl[ii]);
#pragma unroll
            for (int nt = 0; nt < 4; ++nt) {
                const f32x4 yo = mma16(CM + w * 16 * SA64, SA64, BM + (hl & 1) * 64 * SA64 + nt * 16 * SA64, SA64, 64, zero, r, kg);
                const int p = nt * 16 + r;
#pragma unroll
                for (int ii = 0; ii < 4; ++ii) { const int l = w * 16 + kg * 4 + ii;
                    const float xv = bf2f(*(const LAS bf16*)(XT + l * SXN + (hl * 64 + p) * 2));
                    LAS bf16* zp = (LAS bf16*)(zw + (kg * 4 + ii) * SA64 + p * 2);
                    const float y = (yd[nt][ii] + eal[ii] * yo[ii] + xv * Dk) * silu_f(bf2f(*zp));
                    const unsigned short yb = (unsigned short)f2bf(y); const float yq = bf2f(yb);
                    rs[ii] += yq * yq;
                    *zp = yb; }
            }
            LDS_WAIT();
            ysave[hl][0] = *(const LAS v4u*)(zw + orow * SA64 + och * 16); ysave[hl][1] = *(const LAS v4u*)(zw + (orow + 8) * SA64 + och * 16);
            LDS_WAIT();
        }
#pragma unroll
        for (int ii = 0; ii < 4; ++ii) { rs[ii] += __shfl_xor(rs[ii], 1); rs[ii] += __shfl_xor(rs[ii], 2); rs[ii] += __shfl_xor(rs[ii], 4); rs[ii] += __shfl_xor(rs[ii], 8);
            rs[ii] = rsqrtf(rs[ii] * (1.f / 256.f) + EPS); }
        if (r == 0) {
#pragma unroll
            for (int ii = 0; ii < 4; ++ii) RRW[w * 16 + kg * 4 + ii] = rs[ii]; }
        LDS_WAIT();
        const float rr0 = RRW[w * 16 + orow], rr1 = RRW[w * 16 + orow + 8];
        GAS bf16* mdst = (GAS bf16*)(A.ws + WS_MIX) + (t0 + w * 16 + orow) * D + 512 + g * 256 + och * 8;
#pragma unroll
        for (int hl = 0; hl < 4; ++hl) {
            const f32x4 nwa = *(const GAS f32x4*)(A.in[11] + g * 256 + hl * 64 + och * 8), nwb = *(const GAS f32x4*)(A.in[11] + g * 256 + hl * 64 + och * 8 + 4);
            const float nw8[8] = {nwa.x, nwa.y, nwa.z, nwa.w, nwb.x, nwb.y, nwb.z, nwb.w};
#pragma unroll
            for (int hh = 0; hh < 2; ++hh) { float f[8]; unpack8f(ysave[hl][hh], f); const float rr_ = hh ? rr1 : rr0;
#pragma unroll
                for (int q = 0; q < 8; ++q) f[q] *= rr_ * nw8[q];
                *(GAS v4u*)(mdst + (size_t)(8 * hh) * D + hl * 64) = (v4u){pk2(f[0], f[1]), pk2(f[2], f[3]), pk2(f[4], f[5]), pk2(f[6], f[7])}; }
        }
    }
    __syncthreads();
}

template <bool DRY> __device__ __forceinline__ void scan_phase(const Frame& F, const Args& A) {
    if (F.tid < 128) {
        GAS unsigned* st = (GAS unsigned*)(A.ws + WS_GST); const GAS float* dec = (const GAS float*)(A.ws + WS_GDEC);
        for (int gi = blockIdx.x * 128 + F.tid; gi < 8 * 4096; gi += F.G * 128) {
            const int bh = gi >> 12, e = gi & 4095, b = bh >> 2, h = bh & 3, d = (e & 31) * 2;
            float S0 = 0.f, S1 = 0.f;
#pragma unroll 1
            for (int c = 0; c < 128; c += 16) {
                unsigned v[16]; float d0[16], d1[16];
#pragma unroll
                for (int u = 0; u < 16; ++u) { const size_t un = (size_t)((b * 128 + c + u) * 4 + h); v[u] = st[un * 4096 + e]; d0[u] = dec[un * 64 + d]; d1[u] = dec[un * 64 + d + 1]; }
#pragma unroll
                for (int u = 0; u < 16; ++u) { const size_t un = (size_t)((b * 128 + c + u) * 4 + h); (DRY ? (GAS unsigned*)(A.ws + 232 * MiB) : st)[un * 4096 + e] = pk2(S0, S1);
                    S0 = d0[u] * S0 + bf2f((unsigned short)(v[u] & 0xffffu)); S1 = d1[u] * S1 + bf2f((unsigned short)(v[u] >> 16)); }
            }
        }
    } else if (F.tid < 256) {
        GAS unsigned* st = (GAS unsigned*)(A.ws + WS_SST); const GAS float* dec = (const GAS float*)(A.ws + WS_SDEC);
        for (int gi = blockIdx.x * 128 + (F.tid - 128); gi < 16 * 2048; gi += F.G * 128) {
            const int bh = gi >> 11, e = gi & 2047, b = bh >> 3, hd = bh & 7;
            float S0 = 0.f, S1 = 0.f;
#pragma unroll 1
            for (int c = 0; c < 64; c += 16) {
                unsigned v[16]; float dd[16];
#pragma unroll
                for (int u = 0; u < 16; ++u) { const size_t un = (size_t)((b * 64 + c + u) * 8 + hd); v[u] = st[un * 2048 + e]; dd[u] = dec[un]; }
#pragma unroll
                for (int u = 0; u < 16; ++u) { const size_t un = (size_t)((b * 64 + c + u) * 8 + hd); (DRY ? (GAS unsigned*)(A.ws + 248 * MiB) : st)[un * 2048 + e] = pk2(S0, S1);
                    S0 = dd[u] * S0 + bf2f((unsigned short)(v[u] & 0xffffu)); S1 = dd[u] * S1 + bf2f((unsigned short)(v[u] >> 16)); }
            }
        }
    }
}
constexpr size_t WS_HB = WS_PROJ;
constexpr size_t WS_Q = 144 * MiB;
constexpr size_t WS_IDX = 232 * MiB;
constexpr size_t WS_GATE = 240 * MiB;
typedef float f32x16 __attribute__((ext_vector_type(16)));
__device__ __forceinline__ float as_f(unsigned u) { return __builtin_bit_cast(float, u); }
__device__ __forceinline__ unsigned as_u(float f) { return __builtin_bit_cast(unsigned, f); }
#define CE_DESC(a, b) do { const float hi_ = fmaxf((a), (b)), lo_ = fminf((a), (b)); (a) = hi_; (b) = lo_; } while (0)
template <int OFF, int N> __device__ __forceinline__ void sort16_desc(float (&v)[N]) {
#pragma unroll
    for (int k = 2; k <= 16; k <<= 1)
#pragma unroll
        for (int j = k >> 1; j > 0; j >>= 1)
#pragma unroll
            for (int i = 0; i < 16; ++i) { const int l = i ^ j; if (l > i) { if ((i & k) == 0) CE_DESC(v[OFF + i], v[OFF + l]); else CE_DESC(v[OFF + l], v[OFF + i]); } }
}
template <int OA, int OB, int NA, int NB> __device__ __forceinline__ void merge16_desc(float (&a)[NA], const float (&b)[NB]) {
#pragma unroll
    for (int i = 0; i < 16; ++i) a[OA + i] = fmaxf(a[OA + i], b[OB + 15 - i]);
#pragma unroll
    for (int j = 8; j > 0; j >>= 1)
#pragma unroll
        for (int i = 0; i < 16; ++i) { const int l = i ^ j; if (l > i) CE_DESC(a[OA + i], a[OA + l]); }
}
constexpr unsigned char CAND0[32] = {0, 2, 4, 6, 8, 10, 12, 14, 16, 18, 20, 22, 32, 34, 36, 49, 51, 65, 80, 96, 112, 128, 160, 192, 224, 255, 255, 255, 255, 255, 255, 255};
constexpr unsigned char CAND1[32] = {1, 3, 5, 7, 9, 11, 13, 15, 17, 19, 21, 23, 33, 35, 48, 50, 64, 66, 81, 97, 113, 144, 176, 208, 240, 255, 255, 255, 255, 255, 255, 255};

__device__ __forceinline__ void topk_wave_job(const Args& A, const LAS unsigned char* SK, LAS unsigned char* TAB, int tok0, int h, int lane) {
    const int r = lane & 31, hi = lane >> 5;
    const GAS bf16* qrow = (const GAS bf16*)(A.ws + WS_Q) + (size_t)(tok0 + r) * NQ + h * 256 + 8 * hi;
    float LST[2][16];
#pragma unroll
    for (int p = 0; p < 2; ++p) {
        __builtin_amdgcn_sched_barrier(0);
        bf16x8 bq[8];
#pragma unroll
        for (int s = 0; s < 8; ++s) bq[s] = *(const GAS bf16x8*)(qrow + p * 128 + 16 * s);
        float v[64];
#pragma unroll
        for (int kt = 0; kt < 4; ++kt) {
            f32x16 acc;
#pragma unroll
            for (int i = 0; i < 16; ++i) acc[i] = 0.f;
#pragma unroll
            for (int s = 0; s < 8; ++s) { const bf16x8 a = *(const LAS bf16x8*)(SK + (p * 128 + kt * 32 + r) * SA128 + (16 * s + 8 * hi) * 2);
                acc = __builtin_amdgcn_mfma_f32_32x32x16_bf16(a, bq[s], acc, 0, 0, 0); }
#pragma unroll
            for (int i = 0; i < 16; ++i) { const unsigned key = (unsigned)(kt * 32 + (i & 3) + 8 * (i >> 2)) | ((unsigned)hi << 2); v[kt * 16 + i] = as_f((as_u(acc[i]) & ~127u) | key); }
        }
        sort16_desc<0>(v); sort16_desc<16>(v); sort16_desc<32>(v); sort16_desc<48>(v);
        merge16_desc<0, 16>(v, v); merge16_desc<32, 48>(v, v); merge16_desc<0, 32>(v, v);
        float o[16];
#pragma unroll
        for (int i = 0; i < 16; ++i) o[i] = __shfl_xor(v[i], 32);
        merge16_desc<0, 0>(v, o);
#pragma unroll
        for (int i = 0; i < 16; ++i) LST[p][i] = v[i];
    }
    __builtin_amdgcn_sched_barrier(0);
    {   unsigned pk[4];
#pragma unroll
        for (int q4 = 0; q4 < 4; ++q4) { unsigned wv = 0;
#pragma unroll
            for (int b = 0; b < 4; ++b) { float l0 = LST[0][q4 * 4 + b], l1 = LST[1][q4 * 4 + b]; asm volatile("" : "+v"(l0), "+v"(l1));
                const unsigned x = as_u(hi ? l1 : l0) & 127u; wv |= x << (8 * b); }
            pk[q4] = wv; }
        *(LAS v4u*)(TAB + r * 32 + hi * 16) = (v4u){pk[0], pk[1], pk[2], pk[3]};
    }
    float c[32];
    float va[16], vb2[16];
#pragma unroll
    for (int i = 0; i < 16; ++i) { va[i] = as_f(as_u(LST[0][i]) & ~127u); vb2[i] = as_f(as_u(LST[1][i]) & ~127u); }
#define CANDV(i0, j0, k0, i1, j1, k1) as_f((as_u(hi ? (va[i1] + vb2[j1]) : (va[i0] + vb2[j0])) & ~255u) | (hi ? (k1) : (k0)))
    c[0] = CANDV(0, 0, 0u, 0, 1, 1u);
    c[1] = CANDV(0, 2, 2u, 0, 3, 3u);
    c[2] = CANDV(0, 4, 4u, 0, 5, 5u);
    c[3] = CANDV(0, 6, 6u, 0, 7, 7u);
    c[4] = CANDV(0, 8, 8u, 0, 9, 9u);
    c[5] = CANDV(0, 10, 10u, 0, 11, 11u);
    c[6] = CANDV(0, 12, 12u, 0, 13, 13u);
    c[7] = CANDV(0, 14, 14u, 0, 15, 15u);
    c[8] = CANDV(1, 0, 16u, 1, 1, 17u);
    c[9] = CANDV(1, 2, 18u, 1, 3, 19u);
    c[10] = CANDV(1, 4, 20u, 1, 5, 21u);
    c[11] = CANDV(1, 6, 22u, 1, 7, 23u);
    c[12] = CANDV(2, 0, 32u, 2, 1, 33u);
    c[13] = CANDV(2, 2, 34u, 2, 3, 35u);
    c[14] = CANDV(2, 4, 36u, 3, 0, 48u);
    c[15] = CANDV(3, 1, 49u, 3, 2, 50u);
    c[16] = CANDV(3, 3, 51u, 4, 0, 64u);
    c[17] = CANDV(4, 1, 65u, 4, 2, 66u);
    c[18] = CANDV(5, 0, 80u, 5, 1, 81u);
    c[19] = CANDV(6, 0, 96u, 6, 1, 97u);
    c[20] = CANDV(7, 0, 112u, 7, 1, 113u);
    c[21] = CANDV(8, 0, 128u, 9, 0, 144u);
    c[22] = CANDV(10, 0, 160u, 11, 0, 176u);
    c[23] = CANDV(12, 0, 192u, 13, 0, 208u);
    c[24] = CANDV(14, 0, 224u, 15, 0, 240u);
    c[25] = as_f(0xFF61B1E6u | 255u);
    c[26] = as_f(0xFF61B1E6u | 255u);
    c[27] = as_f(0xFF61B1E6u | 255u);
    c[28] = as_f(0xFF61B1E6u | 255u);
    c[29] = as_f(0xFF61B1E6u | 255u);
    c[30] = as_f(0xFF61B1E6u | 255u);
    c[31] = as_f(0xFF61B1E6u | 255u);
#undef CANDV
    sort16_desc<0>(c); sort16_desc<16>(c); merge16_desc<0, 16>(c, c);
    {   float o[16];
#pragma unroll
        for (int i = 0; i < 16; ++i) o[i] = __shfl_xor(c[i], 32);
        merge16_desc<0, 0>(c, o); }
    const float mx = as_f(as_u(c[0]) & ~255u);
    float ex[16], den = 0.f;
#pragma unroll
    for (int k = 0; k < 16; ++k) { ex[k] = __expf(as_f(as_u(c[k]) & ~255u) - mx); den += ex[k]; }
    const float inv = 1.f / den;
    LDS_WAIT();
    unsigned eid[8]; float gv[8];
#pragma unroll
    for (int k = 0; k < 8; ++k) { float ca = c[k], cb = c[k + 8], ea = ex[k], eb = ex[k + 8]; asm volatile("" : "+v"(ca), "+v"(cb), "+v"(ea), "+v"(eb));
        const unsigned code = as_u(hi ? cb : ca) & 255u; gv[k] = (hi ? eb : ea) * inv;
        const unsigned ia = *(const LAS unsigned char*)(TAB + r * 32 + (code >> 4)), ib = *(const LAS unsigned char*)(TAB + r * 32 + 16 + (code & 15));
        eid[k] = ia * 128u + ib; }
    GAS unsigned* ip = (GAS unsigned*)(A.ws + WS_IDX) + (size_t)(tok0 + r) * 128 + h * 16 + 8 * hi;
    GAS float* gp = (GAS float*)(A.ws + WS_GATE) + (size_t)(tok0 + r) * 128 + h * 16 + 8 * hi;
    *(GAS v4u*)ip = (v4u){eid[0], eid[1], eid[2], eid[3]}; *(GAS v4u*)(ip + 4) = (v4u){eid[4], eid[5], eid[6], eid[7]};
    *(GAS f32x4*)gp = (f32x4){gv[0], gv[1], gv[2], gv[3]}; *(GAS f32x4*)(gp + 4) = (f32x4){gv[4], gv[5], gv[6], gv[7]};
    LDS_WAIT();
}
__device__ __forceinline__ void topk_phase(const Frame& F, const Args& A) {
    LAS unsigned char* SK = F.lds;
    LAS unsigned char* TABS = F.lds + 256 * SA128;
    for (int unit = blockIdx.x; unit < 256; unit += F.G) {
        int tid = F.tid, w = F.wave;
        asm volatile("" : "+v"(tid)); asm volatile("" : "+s"(w));
        const int h = unit & 7, tb = (unit >> 3) * 512;
        const GAS bf16* sk = (const GAS bf16*)(A.ws + WS_SUBK) + (size_t)h * 2 * 128 * 128;
        for (int e = tid; e < 256 * 16; e += 512) { const int row = e >> 4, ch = e & 15; *(LAS v4u*)(SK + row * SA128 + ch * 16) = *(const GAS v4u*)(sk + row * 128 + ch * 8); }
        __syncthreads();
#pragma unroll 1
        for (int tt = 0; tt < 2; ++tt) topk_wave_job(A, SK, TABS + w * 1024, tb + (w * 2 + tt) * 32, h, tid & 63);
        __syncthreads();
    }
}

__device__ __forceinline__ float gelu_f(float v) {
    const float av = fabsf(v), t = __builtin_amdgcn_rcpf(av * 0.2316418882f + 1.0f);
    float q = t * 0.5307027145f + (-0.7265760135f); q = q * t + 0.7107068705f; q = q * t + (-0.142248368f); q = q * t + 0.127414796f; q = q * t;
    const float m = v * (q * __builtin_amdgcn_exp2f((v * v) * (-0.72134752044f)));
    return v < 0.f ? m : v - m;
}
__device__ __forceinline__ void unpack8(const v4u x, float (&f)[8]) {
    f[0] = as_f(x.x << 16); f[1] = as_f(x.x & 0xffff0000u); f[2] = as_f(x.y << 16); f[3] = as_f(x.y & 0xffff0000u);
    f[4] = as_f(x.z << 16); f[5] = as_f(x.z & 0xffff0000u); f[6] = as_f(x.w << 16); f[7] = as_f(x.w & 0xffff0000u);
}
typedef long lx2 __attribute__((ext_vector_type(2)));
typedef float f32x2 __attribute__((ext_vector_type(2)));
typedef int i32x8 __attribute__((ext_vector_type(8)));
typedef int i32x4 __attribute__((ext_vector_type(4)));
constexpr float U4_SCALE = 48.f, V4_SCALE = 4.25f;
constexpr int MX_ONE = 0x7F7F7F7F;
template <int BY> __device__ __forceinline__ f32x2 cvt_fp4x2(unsigned w) { return __builtin_amdgcn_cvt_scalef32_pk_f32_fp4(w, 1.0f, BY); }
template <int WS> __device__ __forceinline__ f32x2 cvt_fp8x2(int w) { return __builtin_amdgcn_cvt_pk_f32_fp8(w, WS != 0); }
__device__ __forceinline__ unsigned pk4_fp8(float a, float b, float c, float d) { int p = __builtin_amdgcn_cvt_pk_fp8_f32(a, b, 0, false); p = __builtin_amdgcn_cvt_pk_fp8_f32(c, d, p, true); return (unsigned)p; }
constexpr size_t WS_HID = 248 * MiB;
__device__ __forceinline__ void expert_u_phase(const Frame& F, const Args& A) {
    int tid = F.tid, w = F.wave;
    asm volatile("" : "+v"(tid)); asm volatile("" : "+s"(w));
    const int lane = tid & 63, r = lane & 15, kg = lane >> 4, half = lane >> 5, sub = lane & 31;
    const int dl = 32 * sub + 16 * half;
    LAS unsigned char* N2 = F.lds + w * 1024;
    const GAS unsigned char* u4 = (const GAS unsigned char*)(A.ws + WS_UB); const GAS unsigned char* v4 = (const GAS unsigned char*)(A.ws + WS_VB);
    const GAS unsigned* idx = (const GAS unsigned*)(A.ws + WS_IDX); const GAS float* gate = (const GAS float*)(A.ws + WS_GATE);
    const GAS float* rowsq = (const GAS float*)(A.ws + WS_ROWSQ2);
#pragma unroll 1
    for (int t = F.gw; t < T; t += F.NGW) {
        GAS float* hrow = (GAS float*)A.out + (size_t)t * D;
        f32x4 hv[4];
        {   const GAS bf16* hb = (const GAS bf16*)(A.ws + WS_HB) + (size_t)t * D + dl;
            float f0[8], f1[8]; unpack8f(*(const GAS v4u*)hb, f0); unpack8f(*(const GAS v4u*)(hb + 8), f1);
            hv[0] = (f32x4){f0[0], f0[1], f0[2], f0[3]}; hv[1] = (f32x4){f0[4], f0[5], f0[6], f0[7]}; hv[2] = (f32x4){f1[0], f1[1], f1[2], f1[3]}; hv[3] = (f32x4){f1[4], f1[5], f1[6], f1[7]}; }
        const float rr = rsqrtf(rowsq[t] * (1.f / 1024.f) + EPS);
        {   v4u pk;
            pk.x = pk4_fp8(hv[0].x * rr, hv[0].y * rr, hv[0].z * rr, hv[0].w * rr); pk.y = pk4_fp8(hv[1].x * rr, hv[1].y * rr, hv[1].z * rr, hv[1].w * rr);
            pk.z = pk4_fp8(hv[2].x * rr, hv[2].y * rr, hv[2].z * rr, hv[2].w * rr); pk.w = pk4_fp8(hv[3].x * rr, hv[3].y * rr, hv[3].z * rr, hv[3].w * rr);
            *(LAS v4u*)(N2 + dl) = pk; }
        unsigned eidx[8]; float gt[8];
#pragma unroll
        for (int eg = 0; eg < 8; ++eg) { eidx[eg] = idx[(size_t)t * 128 + eg * 16 + r]; gt[eg] = gate[(size_t)t * 128 + eg * 16 + r]; }
        LDS_WAIT();
        float act0 = 0.f; GAS float* hidp = (GAS float*)(A.ws + WS_HID);
        {
            LAS unsigned char* UBw = F.lds + 8192 + w * (2 * 16 * 528);
            v4u xr[8];
#define PU_ROWS(EG) { _Pragma("unroll") for (int j = 0; j < 8; ++j) { const unsigned ea = (unsigned)__builtin_amdgcn_readlane((int)eidx[EG], 2 * j), eb = (unsigned)__builtin_amdgcn_readlane((int)eidx[EG], 2 * j + 1); \
                xr[j] = *(const GAS v4u*)(u4 + (size_t)(half ? eb : ea) * 512 + 16 * sub); } }
            PU_ROWS(0)
#pragma unroll
            for (int eg = 0; eg < 8; ++eg) {
                LAS unsigned char* ub = UBw + (eg & 1) * (16 * 528);
#pragma unroll
                for (int j = 0; j < 8; ++j) *(LAS v4u*)(ub + (2 * j + half) * 528 + 16 * sub) = xr[j];
                if (eg < 7) PU_ROWS(eg + 1)
                __builtin_amdgcn_sched_barrier(0);
                LDS_WAIT();
                f32x4 accg = (f32x4){0.f, 0.f, 0.f, 0.f};
                const LAS unsigned char* n2p = N2 + 16 * kg; asm volatile("" : "+v"(n2p));
#pragma unroll
                for (int s2 = 0; s2 < 8; ++s2) {
                    const i32x4 a0 = *(const LAS i32x4*)(n2p + 128 * s2), a1 = *(const LAS i32x4*)(n2p + 128 * s2 + 64);
                    const i32x8 a = (i32x8){a0.x, a0.y, a0.z, a0.w, a1.x, a1.y, a1.z, a1.w};
                    const i32x4 b4 = *(const LAS i32x4*)(ub + r * 528 + 64 * s2 + 16 * kg);
                    const i32x8 b = (i32x8){b4.x, b4.y, b4.z, b4.w, 0, 0, 0, 0};
                    accg = __builtin_amdgcn_mfma_scale_f32_16x16x128_f8f6f4(a, b, accg, 0, 4, 0, MX_ONE, 0, MX_ONE);
                }
                if (eg == 0) act0 = accg[0];
                if (kg == 0) hidp[(size_t)t * 128 + eg * 16 + r] = gelu_f(accg[0] * (1.f / U4_SCALE)) * gt[eg] * (1.f / V4_SCALE);
                __builtin_amdgcn_sched_barrier(0);
            }
#undef PU_ROWS
        }
        bool bad = false;
        if (t == F.gw) {
            float ref = 0.f;
            for (int s = 0; s < 8; ++s) {
                const i32x4 b4 = *(const GAS i32x4*)(u4 + (size_t)eidx[0] * 512 + 64 * s + 16 * kg);
                const int bw[4] = {b4.x, b4.y, b4.z, b4.w};
#pragma unroll
                for (int k = 0; k < 4; ++k) {
                    const lx2 a8 = *(const LAS lx2*)(N2 + 128 * s + 32 * kg + 16 * (k >> 1));
                    const long aw = (k & 1) ? a8.y : a8.x;
                    const int alo = (int)aw, ahi = (int)(aw >> 32);
                    { const f32x2 bf = cvt_fp4x2<0>((unsigned)bw[k]), af = cvt_fp8x2<0>(alo); ref += af.x * bf.x + af.y * bf.y; }
                    { const f32x2 bf = cvt_fp4x2<1>((unsigned)bw[k]), af = cvt_fp8x2<1>(alo); ref += af.x * bf.x + af.y * bf.y; }
                    { const f32x2 bf = cvt_fp4x2<2>((unsigned)bw[k]), af = cvt_fp8x2<0>(ahi); ref += af.x * bf.x + af.y * bf.y; }
                    { const f32x2 bf = cvt_fp4x2<3>((unsigned)bw[k]), af = cvt_fp8x2<1>(ahi); ref += af.x * bf.x + af.y * bf.y; }
                }
            }
            ref += __shfl_xor(ref, 16); ref += __shfl_xor(ref, 32);
            bad = __any(fabsf(ref - act0) > 0.02f * fabsf(ref) + 0.5f);
        }
        if (bad && kg == 0) hidp[(size_t)t * 128 + r] = __builtin_nanf("");
    }
}
template <bool DRY> __device__ __forceinline__ void expert_v_phase(const Frame& F, const Args& A) {
    int tid = F.tid, w = F.wave;
    asm volatile("" : "+v"(tid)); asm volatile("" : "+s"(w));
    const int lane = tid & 63, r = lane & 15, half = lane >> 5, sub = lane & 31;
    const int dl = 32 * sub + 16 * half;
    const GAS unsigned char* v4 = (const GAS unsigned char*)(A.ws + WS_VB);
    const GAS unsigned* idx = (const GAS unsigned*)(A.ws + WS_IDX); const GAS float* hidp = (const GAS float*)(A.ws + WS_HID);
#pragma unroll 1
    for (int t = F.gw; t < T; t += F.NGW) {
        GAS float* hrow = (GAS float*)A.out + (size_t)t * D;
        f32x4 hv[4];
        unsigned eidx[8]; float hid[8];
#pragma unroll
        for (int eg = 0; eg < 8; ++eg) { eidx[eg] = idx[(size_t)t * 128 + eg * 16 + r]; hid[eg] = hidp[(size_t)t * 128 + eg * 16 + r]; }
        f32x2 o2[16];
#pragma unroll
        for (int i = 0; i < 16; ++i) o2[i] = (f32x2){0.f, 0.f};
        v4u xr[2][8]; float shs[2][8];
#define PV_LOAD(EG, BUF) { _Pragma("unroll") for (int pr = 0; pr < 8; ++pr) { \
                const float sha = as_f(__builtin_amdgcn_readlane((int)as_u(hid[EG]), 2 * pr)), shb = as_f(__builtin_amdgcn_readlane((int)as_u(hid[EG]), 2 * pr + 1)); \
                const unsigned sia = (unsigned)__builtin_amdgcn_readlane((int)eidx[EG], 2 * pr), sib = (unsigned)__builtin_amdgcn_readlane((int)eidx[EG], 2 * pr + 1); \
                shs[BUF][pr] = half ? shb : sha; \
                xr[BUF][pr] = *(const GAS v4u*)(v4 + (size_t)(half ? sib : sia) * 512 + 16 * sub); } }
        PV_LOAD(0, 0)
#pragma unroll
        for (int eg = 0; eg < 8; ++eg) {
            if (eg < 7) PV_LOAD(eg + 1, (eg + 1) & 1)
            __builtin_amdgcn_sched_barrier(0);
#pragma unroll
            for (int pr = 0; pr < 8; ++pr) {
                const f32x2 sh2 = (f32x2){shs[eg & 1][pr], shs[eg & 1][pr]};
                const unsigned xw[4] = {xr[eg & 1][pr].x, xr[eg & 1][pr].y, xr[eg & 1][pr].z, xr[eg & 1][pr].w};
#pragma unroll
                for (int k = 0; k < 4; ++k) { o2[4 * k] += sh2 * cvt_fp4x2<0>(xw[k]); o2[4 * k + 1] += sh2 * cvt_fp4x2<1>(xw[k]); o2[4 * k + 2] += sh2 * cvt_fp4x2<2>(xw[k]); o2[4 * k + 3] += sh2 * cvt_fp4x2<3>(xw[k]); }
            }
            __builtin_amdgcn_sched_barrier(0);
        }
#undef PV_LOAD
        float o[16];
#pragma unroll
        for (int i = 0; i < 16; ++i) { o2[i].x += __shfl_xor(o2[i].x, 32); o2[i].y += __shfl_xor(o2[i].y, 32); }
#pragma unroll
        for (int i = 0; i < 8; ++i) { float a0 = o2[i].x, a1 = o2[i].y, b0 = o2[8 + i].x, b1 = o2[8 + i].y; asm volatile("" : "+v"(a0), "+v"(a1), "+v"(b0), "+v"(b1));
            o[2 * i] = half ? b0 : a0; o[2 * i + 1] = half ? b1 : a1; }
        float ss = 0.f; f32x4 h2[4];
        {   const GAS bf16* hb = (const GAS bf16*)(A.ws + WS_HB) + (size_t)t * D + dl;
            float f0[8], f1[8]; unpack8f(*(const GAS v4u*)hb, f0); unpack8f(*(const GAS v4u*)(hb + 8), f1);
            hv[0] = (f32x4){f0[0], f0[1], f0[2], f0[3]}; hv[1] = (f32x4){f0[4], f0[5], f0[6], f0[7]}; hv[2] = (f32x4){f1[0], f1[1], f1[2], f1[3]}; hv[3] = (f32x4){f1[4], f1[5], f1[6], f1[7]}; }
#pragma unroll
        for (int q = 0; q < 4; ++q) { h2[q] = hv[q] + (f32x4){o[4 * q], o[4 * q + 1], o[4 * q + 2], o[4 * q + 3]};
            const f32x4 x = h2[q]; ss += (x.x * x.x + x.y * x.y) + (x.z * x.z + x.w * x.w); }
        ss = wave_sum(ss);
        float r3 = rsqrtf(ss * (1.f / D) + EPS);
#pragma unroll
        for (int q = 0; q < 4; ++q) *(GAS f32x4*)((DRY ? (GAS float*)(A.ws + WS_Q) + (size_t)t * D : hrow) + dl + 4 * q) = h2[q] * r3 * *(const GAS f32x4*)(A.in[18] + dl + 4 * q);
    }
}
__device__ __forceinline__ void p0_transpose_item(const float* W, const float* kscale, int K, int N, bf16* WT, LAS float* scr, int item, int lane) {
    const int nblk = (N + 31) / 32, kb = item / nblk, nb = item % nblk, k0 = 64 * kb, n0 = 32 * nb;
    const int nn = n0 + (lane & 31); const bool ok = nn < N;
    (void)nn; (void)ok;
    {   const int c4 = lane & 7, kr = lane >> 3; const bool okc = n0 + 4 * c4 < N;
        f32x4 v[8];
#pragma unroll
        for (int i = 0; i < 8; ++i) v[i] = okc ? *(const GAS f32x4*)(W + (size_t)(k0 + 8 * i + kr) * N + n0 + 4 * c4) : (f32x4){0.f, 0.f, 0.f, 0.f};
#pragma unroll
        for (int i = 0; i < 8; ++i) { const int kk = 8 * i + kr; const float sc = kscale ? kscale[k0 + kk] : 1.f; LAS float* d = scr + kk * 33 + 4 * c4;
            d[0] = v[i].x * sc; d[1] = v[i].y * sc; d[2] = v[i].z * sc; d[3] = v[i].w * sc; } }
    LDS_WAIT(); asm volatile("" ::: "memory");
    const int c = lane & 7;
#pragma unroll
    for (int j = 0; j < 4; ++j) { const int n = (lane >> 3) + 8 * j; const LAS float* s = scr + (8 * c) * 33 + n;
        v4u o; o.x = pk2(s[0 * 33], s[1 * 33]); o.y = pk2(s[2 * 33], s[3 * 33]); o.z = pk2(s[4 * 33], s[5 * 33]); o.w = pk2(s[6 * 33], s[7 * 33]);
        *(GAS v4u*)(WT + (size_t)(n0 + n) * K + k0 + 8 * c) = o; }
    LDS_WAIT(); asm volatile("" ::: "memory");
}
__device__ __forceinline__ void p0_convert(const Frame& F, const float* src, bf16* dst, size_t n) {
    for (size_t i = ((size_t)F.gw * 64 + F.lane) * 8; i < n; i += (size_t)F.NGW * 512) {
        const f32x4 a = *(const GAS f32x4*)(src + i), b = *(const GAS f32x4*)(src + i + 4);
        v4u o; o.x = pk2(a.x, a.y); o.y = pk2(a.z, a.w); o.z = pk2(b.x, b.y); o.w = pk2(b.z, b.w);
        *(GAS v4u*)(dst + i) = o;
    }
}
__device__ __forceinline__ void p0_convert_fp4(const Frame& F, int wk, int nwk, const float* src, unsigned char* dst, size_t n, float scale, const float* colscale) {
#pragma unroll 4
    for (size_t i = ((size_t)wk * 64 + F.lane) * 32; i < n; i += (size_t)nwk * 2048) {
        unsigned ow[4];
#pragma unroll
        for (int q = 0; q < 4; ++q) {
            f32x4 a = *(const GAS f32x4*)(src + i + 8 * q) * scale, b = *(const GAS f32x4*)(src + i + 8 * q + 4) * scale;
            if (colscale) { a = a * *(const GAS f32x4*)(colscale + ((i + 8 * q) & 1023)); b = b * *(const GAS f32x4*)(colscale + ((i + 8 * q + 4) & 1023)); }
            unsigned pk = 0;
            pk = __builtin_amdgcn_cvt_scalef32_pk_fp4_f32(pk, a.x, a.y, 1.0f, 0); pk = __builtin_amdgcn_cvt_scalef32_pk_fp4_f32(pk, a.z, a.w, 1.0f, 1);
            pk = __builtin_amdgcn_cvt_scalef32_pk_fp4_f32(pk, b.x, b.y, 1.0f, 2); pk = __builtin_amdgcn_cvt_scalef32_pk_fp4_f32(pk, b.z, b.w, 1.0f, 3);
            ow[q] = pk; }
        *(GAS v4u*)(dst + (i >> 1)) = (v4u){ow[0], ow[1], ow[2], ow[3]};
    }
}
__device__ __forceinline__ void p0_prologue(const Frame& F, const Args& A) {
    unsigned char* ws = A.ws;
    LAS float* scr = (LAS float*)(F.lds + RING_OFF + F.wave * 16384);
    constexpr int I_IN = (D / 64) * ((NIN + 31) / 32), I_O = (D / 64) * (D / 32), I_Q = (D / 64) * (NQ / 32);
    for (int it = F.gw; it < I_IN + I_O + I_Q; it += F.NGW) {
        int r = it;
        if (r < I_IN) { p0_transpose_item(A.in[2], A.in[1], D, NIN, (bf16*)(ws + WS_WIN), scr, r, F.lane); continue; } r -= I_IN;
        if (r < I_O) { p0_transpose_item(A.in[12], nullptr, D, D, (bf16*)(ws + WS_WO), scr, r, F.lane); continue; } r -= I_O;
        p0_transpose_item(A.in[14], A.in[13], D, NQ, (bf16*)(ws + WS_WQ), scr, r, F.lane);
    }
    for (int m0 = F.gw * 4; m0 < T; m0 += F.NGW * 4) {
        f32x4 v[4][4]; float s[4] = {0.f, 0.f, 0.f, 0.f};
#pragma unroll
        for (int u = 0; u < 4; ++u) { const GAS f32x4* xr = (const GAS f32x4*)(A.in[0] + (size_t)(m0 + u) * D) + F.lane;
#pragma unroll
            for (int j = 0; j < 4; ++j) v[u][j] = xr[64 * j]; }
#pragma unroll
        for (int u = 0; u < 4; ++u) {
#pragma unroll
            for (int j = 0; j < 4; ++j) s[u] += (v[u][j].x * v[u][j].x + v[u][j].y * v[u][j].y) + (v[u][j].z * v[u][j].z + v[u][j].w * v[u][j].w);
            GAS unsigned long long* o8 = (GAS unsigned long long*)((bf16*)(ws + WS_XB) + (size_t)(m0 + u) * D) + F.lane;
#pragma unroll
            for (int j = 0; j < 4; ++j) o8[64 * j] = (unsigned long long)pk2(v[u][j].x, v[u][j].y) | ((unsigned long long)pk2(v[u][j].z, v[u][j].w) << 32); }
#pragma unroll
        for (int u = 0; u < 4; ++u) s[u] = wave_sum(s[u]);
        if (F.lane < 4) { const float sv = F.lane == 0 ? s[0] : (F.lane == 1 ? s[1] : (F.lane == 2 ? s[2] : s[3])); ((float*)(ws + WS_RRMS1))[m0 + F.lane] = rsqrtf(sv * (1.f / D) + EPS); ((float*)(ws + WS_ROWSQ2))[m0 + F.lane] = 0.f; }
    }
    p0_convert(F, A.in[15], (bf16*)(ws + WS_SUBK), (size_t)8 * 2 * 128 * 128);
    p0_convert_fp4(F, F.gw, F.NGW, A.in[16], ws + WS_UB, (size_t)16384 * 1024, 48.f, A.in[13]);
    p0_convert_fp4(F, F.gw, F.NGW, A.in[17], ws + WS_VB, (size_t)16384 * 1024, 4.25f, nullptr);
}

#ifndef PROBE_MASK
#define PROBE_MASK 0
#endif
__device__ __forceinline__ int probe_reps(int k) { int n = ((PROBE_MASK >> k) & 1) + 1; return n; }
__global__ void __launch_bounds__(NWAVES * 64, 2) fwd(Args args) {
    extern __shared__ __attribute__((aligned(16))) unsigned char lds[];
    Frame F;
    F.lds = (LAS unsigned char*)lds;
    F.MISC = (volatile LAS unsigned*)(F.lds + MISC_OFF);
    F.tid = threadIdx.x; F.lane = F.tid & 63; F.wave = __builtin_amdgcn_readfirstlane(F.tid >> 6);
    F.G = gridDim.x; F.gw = blockIdx.x * NWAVES + F.wave; F.NGW = F.G * NWAVES;
    unsigned char* ws = args.ws;
    F.ctl = (gu32*)(ws + WS_CTL);
    for (int u = F.tid; u < (LDS_BYTES - LDSCTL_OFF) / 4; u += NWAVES * 64) ((LAS unsigned*)(F.lds + LDSCTL_OFF))[u] = 0u;
    __syncthreads();
    XcdBarrier bar = xcd_barrier_post((unsigned*)(F.ctl + CW_BAR), F.MISC + 8);
    const int lo = args.ph_lo, hi = args.ph_hi;
#define IN(k) (lo <= (k) && (k) < hi)
#define BOTH(k) (IN(k) && IN((k) + 1))
#define GRID_BAR() xcd_barrier(bar)
#define REP(k) for (int rep_ = 0, nrep_ = probe_reps(k); rep_ < nrep_; ++rep_)

    if (IN(0)) REP(0) { p0_prologue(F, args); if (BOTH(0)) GRID_BAR(); }
    if (IN(1)) REP(1) {
        pg8::Gemm g{(const bf16*)(ws + WS_XB), (const bf16*)(ws + WS_WIN), T, NINP, D}; pg8::StaticOrder S; S.init(T, NINP, F.G, (int)blockIdx.x);
        pg8::EpiRowScaleBf16 E{(bf16*)(ws + WS_PROJ), NINP, (const float*)(ws + WS_RRMS1)};
        pg8::gemm_phase<pg8::EpiRowScaleBf16, pg8::StaticOrder, true, true>(F.lds + RING_OFF, g, S, E);
        if (BOTH(1)) GRID_BAR();
    }
    if (IN(2)) {
        REP(2) { for (int u = blockIdx.x; u < 256; u += F.G) ssd_unit<0>(F, args, u); }
        REP(13) { for (int u = blockIdx.x; u < 1024; u += F.G) gla_unit<0>(F, args, u); }
        if (BOTH(2)) GRID_BAR();
    }
    if (IN(3)) { if ((PROBE_MASK >> 3) & 1) { scan_phase<true>(F, args); GRID_BAR(); } scan_phase<false>(F, args); if (BOTH(3)) GRID_BAR(); }
    if (IN(4)) {
        REP(4) { for (int u = blockIdx.x; u < 256; u += F.G) ssd_unit<1>(F, args, u); }
        REP(12) { for (int u = blockIdx.x; u < 1024; u += F.G) gla_unit<1>(F, args, u); }
        if (BOTH(4)) GRID_BAR();
    }
    if (IN(5)) {
        pg8::Gemm g{(const bf16*)(ws + WS_MIX), (const bf16*)(ws + WS_WO), T, D, D}; pg8::StaticOrder S; S.init(T, D, F.G, (int)blockIdx.x);
        if ((PROBE_MASK >> 5) & 1) { pg8::EpiResidual Ed{(const bf16*)(ws + WS_XB), (bf16*)(ws + 208 * MiB), (float*)(ws + 240 * MiB), D};
            pg8::gemm_phase<pg8::EpiResidual, pg8::StaticOrder, true, true>(F.lds + RING_OFF, g, S, Ed); GRID_BAR(); }
        pg8::EpiResidual E{(const bf16*)(ws + WS_XB), (bf16*)(ws + WS_HB), (float*)(ws + WS_ROWSQ2), D};
        pg8::gemm_phase<pg8::EpiResidual, pg8::StaticOrder, true, true>(F.lds + RING_OFF, g, S, E);
        if (BOTH(5)) GRID_BAR();
    }
    if (IN(6)) REP(6) {
        pg8::Gemm g{(const bf16*)(ws + WS_HB), (const bf16*)(ws + WS_WQ), T, NQ, D}; pg8::StaticOrder S; S.init(T, NQ, F.G, (int)blockIdx.x);
        pg8::EpiRsqScaleBf16 E{(bf16*)(ws + WS_Q), NQ, (const float*)(ws + WS_ROWSQ2)};
        pg8::gemm_phase<pg8::EpiRsqScaleBf16, pg8::StaticOrder, true, true>(F.lds + RING_OFF, g, S, E);
        if (BOTH(6)) GRID_BAR();
    }
    if (IN(7)) REP(7) { topk_phase(F, args); if (BOTH(7)) GRID_BAR(); }
    if (IN(8)) REP(8) { expert_u_phase(F, args); if (BOTH(8)) GRID_BAR(); }
    if (IN(9)) { if ((PROBE_MASK >> 9) & 1) { expert_v_phase<true>(F, args); GRID_BAR(); } expert_v_phase<false>(F, args); }
#undef IN
#undef BOTH
}
extern "C" void kernel_launch(void* const* d_in, const int* in_sizes, int n_in, void* d_out, int out_size, void* d_ws, size_t ws_size, hipStream_t stream) {
    static int grid = 0;
    if (grid == 0) {
        if (n_in != 19 || out_size != T * D || ws_size < 256 * MiB) { fprintf(stderr, "kernel_launch: unexpected shapes n_in %d out %d ws %zu\n", n_in, out_size, ws_size); grid = -1; return; }
        int dev = 0, cus = 0, per_cu = 0;
        if (hipGetDevice(&dev) != hipSuccess || hipDeviceGetAttribute(&cus, hipDeviceAttributeMultiprocessorCount, dev) != hipSuccess) { grid = -1; return; }
        if (hipFuncSetAttribute((const void*)fwd, hipFuncAttributeMaxDynamicSharedMemorySize, LDS_BYTES) != hipSuccess) { fprintf(stderr, "kernel_launch: hipFuncSetAttribute failed\n"); grid = -1; return; }
        if (hipOccupancyMaxActiveBlocksPerMultiprocessor(&per_cu, (const void*)fwd, NWAVES * 64, LDS_BYTES) != hipSuccess || per_cu < 1) { fprintf(stderr, "kernel_launch: occupancy query says %d\n", per_cu); }
        (void)hipGetLastError();
        grid = cus;
    }
    if (grid < 0) return;
    const float* x = (const float*)d_in[0];
    const float* gla_w2 = (const float*)d_in[3];
    const float* gla_bg = (const float*)d_in[4];
    const float* gla_nw = (const float*)d_in[5];
    const float* conv_w = (const float*)d_in[6];
    const float* conv_b = (const float*)d_in[7];
    const float* dt_bias = (const float*)d_in[8];
    const float* a_log = (const float*)d_in[9];
    const float* d_skip = (const float*)d_in[10];
    const float* ssd_nw = (const float*)d_in[11];
    const float* w_out = (const float*)d_in[12];
    const float* norm_ffn_w = (const float*)d_in[13];
    const float* w_query = (const float*)d_in[14];
    const float* sub_keys = (const float*)d_in[15];
    const float* pu = (const float*)d_in[16];
    const float* pv = (const float*)d_in[17];
    const float* norm_final_w = (const float*)d_in[18];
    float* out = (float*)d_out;
    char* ws = (char*)d_ws;

    (void)hipMemsetAsync(ws + WS_CTL, 0, CTL_ZERO_BYTES, stream);
    Args a{};
    for (int i = 0; i < 19; ++i) a.in[i] = (const float*)d_in[i];
    a.out = out; a.ws = (unsigned char*)d_ws; a.ph_lo = 0; a.ph_hi = 10;
    hipLaunchKernelGGL(fwd, dim3(grid), dim3(NWAVES * 64), LDS_BYTES, stream, a);

}
```

```cpp
#include <hip/hip_runtime.h>
#include <cstdio>
#include <cstdint>
namespace pg8 {
#define PG8_LAS __attribute__((address_space(3)))
typedef unsigned short bf16_t;
typedef short bf16x8 __attribute__((ext_vector_type(8)));
typedef float f32x4 __attribute__((ext_vector_type(4)));
typedef unsigned u32x4 __attribute__((ext_vector_type(4)));
constexpr int BM = 256, BK = 64, HALF = 128, HTB = HALF * BK * 2  , STAGE_BYTES = 8 * HTB, NXCD = 8, WGM = 8;

__host__ __device__ __forceinline__ int lds_byte(int r, int c) { const int st = (r >> 4) * 2 + (c >> 5), rr = r & 15, cc = c & 31, ob = rr * 64 + cc * 2; return st * 1024 + (ob ^ (((ob >> 9) & 1) << 5)); }
__host__ __device__ __forceinline__ void stage_rc(int b, int& R, int& C) { const int st = b / 1024, sb = b % 1024, swz = sb ^ (((sb >> 9) & 1) << 5); R = (st >> 1) * 16 + swz / 64; C = (st & 1) * 32 + (swz % 64) / 2; }
__host__ __device__ __forceinline__ int perm32(int rho) { const int n = rho >> 4, i = rho & 15; return 8 * (i >> 2) + 4 * n + (i & 3); }

struct Unit { int pm, pn; };
struct Gemm { const bf16_t* A; const bf16_t* Bt; int M, N, K; };

struct StaticOrder {
    int nM, nN, nwg, G, c;
    __host__ __device__ void init(int M, int N, int G_, int c_) { nM = M / BM; nN = N / BM; nwg = nM * nN; G = G_; c = c_; }
    __host__ __device__ bool next(int i, Unit& u) const {
        const long L = (long)i * G + c; if (L >= nwg) return false;
        int wgid = (int)L; { const int q = nwg / NXCD, r = nwg % NXCD, xcd = wgid % NXCD, off = wgid / NXCD; wgid = (xcd < r ? xcd * (q + 1) : r * (q + 1) + (xcd - r) * q) + off; }
        const int nig = WGM * nN, gid = wgid / nig, fm = gid * WGM, gsz = (nM - fm) < WGM ? (nM - fm) : WGM;
        u.pm = fm + ((wgid % nig) % gsz); u.pn = (wgid % nig) / gsz; return true;
    }
    __device__ __forceinline__ void a_ready(const Unit&) const {}
    __device__ __forceinline__ void done(const Unit&) const {}
};

__device__ __forceinline__ unsigned cvt_pk_bf16(float lo, float hi) { unsigned r; asm volatile("v_cvt_pk_bf16_f32 %0, %1, %2" : "=v"(r) : "v"(lo), "v"(hi)); return r; }
typedef float f32x2 __attribute__((ext_vector_type(2)));
struct EpiRowScaleBf16 {
    static constexpr bool PERM = true, AFTER_DRAIN = false;
    bf16_t* O; int ldc; const float* rs;
    __device__ __forceinline__ void operator()(const f32x4 (&acc)[2][2][4][2], const Unit& u, int wr, int wc, int fr, int fq) const {
        const int row0 = u.pm * BM + wr * 64 + fr, col0 = u.pn * BM + wc * 32 + 8 * fq;
#pragma unroll
        for (int ai = 0; ai < 2; ++ai)
#pragma unroll
            for (int m = 0; m < 4; ++m) { const int row = row0 + ai * HALF + m * 16; const float sc = rs[row]; bf16_t* rowp = O + (size_t)row * ldc + col0;
#pragma unroll
                for (int bj = 0; bj < 2; ++bj) { const f32x4 v0 = acc[ai][bj][m][0] * sc, v1 = acc[ai][bj][m][1] * sc;
                    u32x4 w; w.x = cvt_pk_bf16(v0[0], v0[1]); w.y = cvt_pk_bf16(v0[2], v0[3]); w.z = cvt_pk_bf16(v1[0], v1[1]); w.w = cvt_pk_bf16(v1[2], v1[3]);
                    *(u32x4*)(rowp + bj * HALF) = w; } }
    }
};
struct EpiRsqScaleBf16 {
    static constexpr bool PERM = true, AFTER_DRAIN = false;
    bf16_t* O; int ldc; const float* rowsq;
    __device__ __forceinline__ void operator()(const f32x4 (&acc)[2][2][4][2], const Unit& u, int wr, int wc, int fr, int fq) const {
        const int row0 = u.pm * BM + wr * 64 + fr, col0 = u.pn * BM + wc * 32 + 8 * fq;
#pragma unroll
        for (int ai = 0; ai < 2; ++ai)
#pragma unroll
            for (int m = 0; m < 4; ++m) { const int row = row0 + ai * HALF + m * 16; const float sc = rsqrtf(rowsq[row] * (1.f / 1024.f) + 1e-6f); bf16_t* rowp = O + (size_t)row * ldc + col0;
#pragma unroll
                for (int bj = 0; bj < 2; ++bj) { const f32x4 v0 = acc[ai][bj][m][0] * sc, v1 = acc[ai][bj][m][1] * sc;
                    u32x4 w; w.x = cvt_pk_bf16(v0[0], v0[1]); w.y = cvt_pk_bf16(v0[2], v0[3]); w.z = cvt_pk_bf16(v1[0], v1[1]); w.w = cvt_pk_bf16(v1[2], v1[3]);
                    *(u32x4*)(rowp + bj * HALF) = w; } }
    }
};
struct EpiResidual {
    static constexpr bool PERM = true, AFTER_DRAIN = false;
    const bf16_t* X; bf16_t* HB; float* rowsq; int ldc;
    __device__ __forceinline__ void operator()(const f32x4 (&acc)[2][2][4][2], const Unit& u, int wr, int wc, int fr, int fq) const {
        const int row0 = u.pm * BM + wr * 64 + fr, col0 = u.pn * BM + wc * 32 + 8 * fq;
#pragma unroll
        for (int ai = 0; ai < 2; ++ai)
#pragma unroll
            for (int m = 0; m < 4; ++m) { const int row = row0 + ai * HALF + m * 16; float ss = 0.f;
#pragma unroll
                for (int bj = 0; bj < 2; ++bj) { const size_t off = (size_t)row * ldc + col0 + bj * HALF;
                    const u32x4 xv = *(const u32x4*)(X + off);
                    const f32x4 x0 = (f32x4){__builtin_bit_cast(float, xv.x << 16), __builtin_bit_cast(float, xv.x & 0xffff0000u), __builtin_bit_cast(float, xv.y << 16), __builtin_bit_cast(float, xv.y & 0xffff0000u)};
                    const f32x4 x1 = (f32x4){__builtin_bit_cast(float, xv.z << 16), __builtin_bit_cast(float, xv.z & 0xffff0000u), __builtin_bit_cast(float, xv.w << 16), __builtin_bit_cast(float, xv.w & 0xffff0000u)};
                    const f32x4 v0 = acc[ai][bj][m][0] + x0, v1 = acc[ai][bj][m][1] + x1;
                    u32x4 w; w.x = cvt_pk_bf16(v0[0], v0[1]); w.y = cvt_pk_bf16(v0[2], v0[3]); w.z = cvt_pk_bf16(v1[0], v1[1]); w.w = cvt_pk_bf16(v1[2], v1[3]);
                    *(u32x4*)(HB + off) = w;
                    ss += (v0[0] * v0[0] + v0[1] * v0[1]) + (v0[2] * v0[2] + v0[3] * v0[3]) + (v1[0] * v1[0] + v1[1] * v1[1]) + (v1[2] * v1[2] + v1[3] * v1[3]); }
                ss += __shfl_xor(ss, 16); ss += __shfl_xor(ss, 32);
                if (fq == 0) atomicAdd(rowsq + row, ss); }
    }
};
template <class Epi, class Sched, bool ALIGN_EPI = false, bool SP2 = false>
__device__ __forceinline__ void gemm_phase(PG8_LAS unsigned char* lds, const Gemm g, const Sched& S, const Epi& E) {
    const int tid = threadIdx.x, wid = __builtin_amdgcn_readfirstlane(tid >> 6), lane = tid & 63, wr = wid >> 2, wc = wid & 3, fr = lane & 15, fq = lane >> 4;
    const int K = g.K, nt = K / BK;
    unsigned voffA[2], voffB[2];
#pragma unroll
    for (int i = 0; i < 2; ++i) { int R, C; stage_rc(tid * 16 + i * 8192, R, C); const int Rb = Epi::PERM ? ((R & ~31) + perm32(R & 31)) : R;
        voffA[i] = (unsigned)(R * K + C) * 2u; voffB[i] = (unsigned)(Rb * K + C) * 2u; }
    const size_t kstep = (size_t)(BK * 2);
    const size_t hstep = (size_t)HALF * K * 2;
    const size_t tstep = 2 * hstep;
    const unsigned ldsw = (unsigned)wid * 1024u;
    const int aoff = lds_byte(wr * 64 + fr, fq * 8), boff = lds_byte(wc * 32 + fr, fq * 8);
#define PG8_SA(b, h) (((b) * 2 + (h)) * HTB)
#define PG8_SB(b, h) ((4 + (b) * 2 + (h)) * HTB)
#define PG8_STAGE(bufoff, gbase, voff) do { _Pragma("unroll") for (int _i = 0; _i < 2; ++_i) \
        __builtin_amdgcn_global_load_lds((const unsigned*)((const char*)(gbase) + (voff)[_i]), (PG8_LAS unsigned*)(lds + (bufoff) + ldsw + _i * 8192), 16, 0, 0); } while (0)
#define PG8_LDA(dst, b, h) do { _Pragma("unroll") for (int m = 0; m < 4; ++m) _Pragma("unroll") for (int k = 0; k < 2; ++k) dst[m][k] = *(const PG8_LAS bf16x8*)(lds + PG8_SA(b, h) + aoff + m * 2048 + k * 1024); } while (0)
#define PG8_LDB(dst, b, h) do { _Pragma("unroll") for (int n = 0; n < 2; ++n) _Pragma("unroll") for (int k = 0; k < 2; ++k) dst[n][k] = *(const PG8_LAS bf16x8*)(lds + PG8_SB(b, h) + boff + n * 2048 + k * 1024); } while (0)
#define PG8_MMA(ai, bj, At, Bt) do { __builtin_amdgcn_s_setprio(1); _Pragma("unroll") for (int m = 0; m < 4; ++m) _Pragma("unroll") for (int n = 0; n < 2; ++n) _Pragma("unroll") for (int k = 0; k < 2; ++k) \
        acc[ai][bj][m][n] = __builtin_amdgcn_mfma_f32_16x16x32_bf16(Bt[n][k], At[m][k], acc[ai][bj][m][n], 0, 0, 0); __builtin_amdgcn_s_setprio(0); } while (0)
#define PG8_WAIT_V(n) asm volatile("s_waitcnt vmcnt(" #n ")" ::: "memory")
#define PG8_WAIT_L(n) asm volatile("s_waitcnt lgkmcnt(" #n ")" ::: "memory")
#define PG8_BAR __builtin_amdgcn_s_barrier()
#define PG8_SCHED __builtin_amdgcn_sched_barrier(0)
    Unit cur, nxt; int ui = 0;
    if (!S.next(0, cur)) return;
    f32x4 acc[2][2][4][2];
#pragma unroll
    for (int a = 0; a < 2; ++a)
#pragma unroll
        for (int b = 0; b < 2; ++b)
#pragma unroll
            for (int m = 0; m < 4; ++m)
#pragma unroll
                for (int n = 0; n < 2; ++n) acc[a][b][m][n] = (f32x4){0.f, 0.f, 0.f, 0.f};
    bf16x8 At[4][2], B0[2][2], B1[2][2];
    const char* cA = (const char*)g.A + (size_t)cur.pm * tstep; const char* cB = (const char*)g.Bt + (size_t)cur.pn * tstep;
    S.a_ready(cur);
    if constexpr (SP2) {
        PG8_STAGE(PG8_SB(0, 0), cB, voffB); PG8_STAGE(PG8_SB(0, 1), cB + hstep, voffB); PG8_STAGE(PG8_SA(0, 0), cA, voffA); PG8_STAGE(PG8_SA(0, 1), cA + hstep, voffA);
        if (wr == 1) PG8_BAR;
        PG8_WAIT_V(2); PG8_BAR;
        PG8_STAGE(PG8_SB(1, 0), cB + kstep, voffB); PG8_STAGE(PG8_SA(1, 0), cA + kstep, voffA); PG8_STAGE(PG8_SB(1, 1), cB + hstep + kstep, voffB);
        PG8_WAIT_V(6); PG8_BAR;
    } else {
        PG8_STAGE(PG8_SB(0, 0), cB, voffB); PG8_STAGE(PG8_SA(0, 0), cA, voffA); PG8_STAGE(PG8_SB(0, 1), cB + hstep, voffB); PG8_STAGE(PG8_SA(0, 1), cA + hstep, voffA);
        if (wr == 1) PG8_BAR;
        PG8_WAIT_V(4); PG8_BAR;
        PG8_STAGE(PG8_SB(1, 0), cB + kstep, voffB); PG8_STAGE(PG8_SA(1, 0), cA + kstep, voffA); PG8_STAGE(PG8_SB(1, 1), cB + hstep + kstep, voffB);
        PG8_WAIT_V(6); PG8_BAR;
    }
    for (;;) {
        const bool has_next = S.next(ui + 1, nxt);
        const char* nA = has_next ? (const char*)g.A + (size_t)nxt.pm * tstep : cA; const char* nB = has_next ? (const char*)g.Bt + (size_t)nxt.pn * tstep : cB;
        for (int t = 0; t < nt; t += 2) {
            const bool last = (t == nt - 2);
            const char* a1 = cA + (size_t)(t + 1) * kstep;
            const char* a2 = last ? nA : cA + (size_t)(t + 2) * kstep; const char* b2 = last ? nB : cB + (size_t)(t + 2) * kstep;
            const char* a3 = a2 + kstep; const char* b3 = b2 + kstep;
            if (last && has_next) S.a_ready(nxt);
            if constexpr (SP2) {
            PG8_LDB(B0, 0, 0); PG8_LDB(B1, 0, 1); PG8_SCHED; PG8_LDA(At, 0, 0); PG8_STAGE(PG8_SA(1, 1), a1 + hstep, voffA);
            PG8_WAIT_V(8); PG8_WAIT_L(0); PG8_BAR; PG8_MMA(0, 0, At, B0); PG8_MMA(0, 1, At, B1); PG8_BAR; PG8_SCHED;
            PG8_LDA(At, 0, 1); PG8_STAGE(PG8_SB(0, 0), b2, voffB); PG8_STAGE(PG8_SB(0, 1), b2 + hstep, voffB); PG8_STAGE(PG8_SA(0, 0), a2, voffA);
            PG8_WAIT_V(8); PG8_WAIT_L(0); PG8_BAR; PG8_MMA(1, 0, At, B0); PG8_MMA(1, 1, At, B1); PG8_BAR; PG8_SCHED;
            PG8_LDB(B0, 1, 0); PG8_LDB(B1, 1, 1); PG8_SCHED; PG8_LDA(At, 1, 0); PG8_STAGE(PG8_SA(0, 1), a2 + hstep, voffA);
            PG8_WAIT_V(8); PG8_WAIT_L(0); PG8_BAR; PG8_MMA(0, 0, At, B0); PG8_MMA(0, 1, At, B1); PG8_BAR; PG8_SCHED;
            PG8_LDA(At, 1, 1); PG8_STAGE(PG8_SB(1, 0), b3, voffB); PG8_STAGE(PG8_SB(1, 1), b3 + hstep, voffB); PG8_STAGE(PG8_SA(1, 0), a3, voffA);
            PG8_WAIT_V(8); PG8_WAIT_L(0); PG8_BAR; PG8_MMA(1, 0, At, B0); PG8_MMA(1, 1, At, B1); PG8_BAR; PG8_SCHED;
            } else {
            PG8_LDB(B0, 0, 0); PG8_SCHED; PG8_LDA(At, 0, 0); PG8_STAGE(PG8_SA(1, 1), a1 + hstep, voffA);
            PG8_WAIT_L(8); PG8_BAR; PG8_WAIT_L(0); PG8_MMA(0, 0, At, B0); PG8_BAR; PG8_SCHED;
            PG8_LDB(B1, 0, 1); PG8_STAGE(PG8_SB(0, 0), b2, voffB);
            PG8_BAR; PG8_WAIT_L(0); PG8_MMA(0, 1, At, B1); PG8_BAR;
            PG8_LDA(At, 0, 1); PG8_STAGE(PG8_SA(0, 0), a2, voffA);
            PG8_BAR; PG8_WAIT_L(0); PG8_MMA(1, 0, At, B0); PG8_BAR; PG8_SCHED;
            PG8_STAGE(PG8_SB(0, 1), b2 + hstep, voffB);
            PG8_WAIT_V(6); PG8_BAR; PG8_MMA(1, 1, At, B1); PG8_BAR;
            PG8_LDB(B0, 1, 0); PG8_SCHED; PG8_LDA(At, 1, 0); PG8_STAGE(PG8_SA(0, 1), a2 + hstep, voffA);
            PG8_WAIT_L(8); PG8_BAR; PG8_WAIT_L(0); PG8_MMA(0, 0, At, B0); PG8_BAR; PG8_SCHED;
            PG8_LDB(B1, 1, 1); PG8_STAGE(PG8_SB(1, 0), b3, voffB);
            PG8_BAR; PG8_WAIT_L(0); PG8_MMA(0, 1, At, B1); PG8_BAR;
            PG8_LDA(At, 1, 1); PG8_STAGE(PG8_SA(1, 0), a3, voffA);
            PG8_BAR; PG8_WAIT_L(0); PG8_MMA(1, 0, At, B0); PG8_BAR; PG8_SCHED;
            PG8_STAGE(PG8_SB(1, 1), b3 + hstep, voffB);
            PG8_WAIT_V(6); PG8_BAR; PG8_MMA(1, 1, At, B1); PG8_BAR;
            }
        }
        if constexpr (ALIGN_EPI) { if (wr == 0) PG8_BAR; }
        if constexpr (!Epi::AFTER_DRAIN) { E(acc, cur, wr, wc, fr, fq); S.done(cur); }
        if (!has_next) break;
#pragma unroll
        for (int a = 0; a < 2; ++a)
#pragma unroll
            for (int b = 0; b < 2; ++b)
#pragma unroll
                for (int m = 0; m < 4; ++m)
#pragma unroll
                    for (int n = 0; n < 2; ++n) acc[a][b][m][n] = (f32x4){0.f, 0.f, 0.f, 0.f};
        cur = nxt; cA = nA; cB = nB; ++ui;
        if constexpr (ALIGN_EPI) { if (wr == 1) PG8_BAR; }
    }
    PG8_WAIT_V(0);
    if constexpr (!ALIGN_EPI) { if (wr == 0) PG8_BAR; }
    PG8_BAR;
    if constexpr (Epi::AFTER_DRAIN) { E.fused(acc, cur, wr, wc, fr, fq, lds, wid, lane); S.done(cur); }
#undef PG8_SA
#undef PG8_SB
#undef PG8_STAGE
#undef PG8_LDA
#undef PG8_LDB
#undef PG8_MMA
#undef PG8_WAIT_V
#undef PG8_WAIT_L
#undef PG8_BAR
#undef PG8_SCHED
}
}
constexpr int NWAVES = 8;
constexpr int T = 16384, SEQ = 8192, D = 1024, NIN = 2840, NINP = 3072, NQ = 2048;
constexpr int C_Q = 0, C_K = 256, C_V = 512, C_GLR = 1024, C_GOUT = 1040, C_Z = 1552, C_XBC = 2064, C_DT = 2832;
constexpr float EPS = 1e-6f;
constexpr size_t MiB = 1u << 20;
constexpr size_t WS_CTL = 0, CTL_ZERO_BYTES = 64 * 1024;
constexpr size_t WS_WIN = 1 * MiB;
constexpr size_t WS_WO = 7 * MiB;
constexpr size_t WS_WQ = 9 * MiB;
constexpr size_t WS_SUBK = 13 * MiB;
constexpr size_t WS_RRMS1 = 14 * MiB;
constexpr size_t WS_ROWSQ2 = 14 * MiB + 64 * 1024;
constexpr size_t WS_UB = 16 * MiB, WS_VB = 24 * MiB;
constexpr size_t WS_MIX = 32 * MiB;
constexpr size_t WS_XB = 80 * MiB;
constexpr size_t WS_PROJ = 112 * MiB;
constexpr int CW_TMO = 0, CW_BAR = 1024;
constexpr int RING_OFF = 0, RING_BYTES = 131072;
constexpr int LDS_BYTES = 163840;
constexpr int LDSCTL_OFF = LDS_BYTES - 1024, MISC_OFF = LDSCTL_OFF + 320;

#define GAS __attribute__((address_space(1)))
#define LAS __attribute__((address_space(3)))
typedef unsigned short bf16;
typedef unsigned v4u __attribute__((ext_vector_type(4)));
typedef float f32x4 __attribute__((ext_vector_type(4)));
typedef short bf16x8 __attribute__((ext_vector_type(8)));
typedef GAS unsigned gu32;
#define RLX_AGENT __ATOMIC_RELAXED, __HIP_MEMORY_SCOPE_AGENT
#define LDS_WAIT() asm volatile("s_waitcnt lgkmcnt(0)" ::: "memory")
#define VM_WAIT() asm volatile("s_waitcnt vmcnt(0)" ::: "memory")
typedef float f32x2c __attribute__((ext_vector_type(2)));
typedef __bf16 bf16x2c __attribute__((ext_vector_type(2)));
__device__ __forceinline__ unsigned f2bf(float f) { const __bf16 b = (__bf16)f; return (unsigned)__builtin_bit_cast(unsigned short, b); }
__device__ __forceinline__ unsigned pk2(float lo, float hi) { const bf16x2c v = __builtin_convertvector((f32x2c){lo, hi}, bf16x2c); return __builtin_bit_cast(unsigned, v); }
__device__ __forceinline__ float bf2f(unsigned short b) { return __builtin_bit_cast(float, (unsigned)b << 16); }
__device__ __forceinline__ float wave_sum(float v) {
#pragma unroll
    for (int o = 1; o < 64; o <<= 1) v += __shfl_xor(v, o);
    return v;
}
#define XB_TMO      128
#define XB_XCNT(j)  (256  + 64 * (j))
#define XB_XSUB(j)  (1280 + 64 * (j))
#define XB_XGEN(j)  (2304 + 64 * (j))
#define XB_TOP      3328
#define XB_TOPGEN   3392
#define XCD_BAR_WORDS 3456
#define XB_SPIN_CAP (1u << 18)

__device__ __forceinline__ unsigned xb_ld(unsigned* p)              { return __hip_atomic_load(p, __ATOMIC_RELAXED, __HIP_MEMORY_SCOPE_AGENT); }
__device__ __forceinline__ unsigned xb_add(unsigned* p, unsigned v) { return __hip_atomic_fetch_add(p, v, __ATOMIC_RELAXED, __HIP_MEMORY_SCOPE_AGENT); }
__device__ __forceinline__ unsigned xb_xcc_id() { return (unsigned)__builtin_amdgcn_s_getreg((3 << 11) | 20) & 0xFu; }
#define XB_SPIN(cond, bar) do { unsigned _sp = 0; while (cond) { __builtin_amdgcn_s_sleep(1); \
    if ((++_sp & 255u) == 0u) { if (xb_ld(&(bar)[XB_TMO])) break; if (_sp > XB_SPIN_CAP) { atomicAdd(&(bar)[XB_TMO], 1u); break; } } } } while (0)

struct XcdBarrier {
    unsigned* bar; unsigned x;
    volatile LAS unsigned* st;
};

__device__ __forceinline__ XcdBarrier xcd_barrier_post(unsigned* bar, volatile LAS unsigned* st) {
    XcdBarrier b; b.bar = bar; b.x = xb_xcc_id(); b.st = st;
    if (threadIdx.x == 0) (void)xb_add(&bar[XB_XCNT(b.x)], 1u);
    return b;
}
__device__ __forceinline__ void xcd_barrier_complete(unsigned* bar, unsigned x, unsigned& nloc, unsigned& nx) {
    const unsigned G = gridDim.x * gridDim.y * gridDim.z;
    unsigned sum, cnt, mine, sp = 0u;
    for (;;) {
        sum = 0u; cnt = 0u; mine = 0u;
#pragma unroll
        for (unsigned j = 0; j < 16; ++j) { const unsigned c = xb_ld(&bar[XB_XCNT(j)]); sum += c; cnt += (c > 0u) ? 1u : 0u; mine = (j == x) ? c : mine; }
        if (sum == G) break;
        __builtin_amdgcn_s_sleep(1);
        if ((++sp & 255u) == 0u) { if (xb_ld(&bar[XB_TMO])) break; if (sp > XB_SPIN_CAP) { atomicAdd(&bar[XB_TMO], 1u); break; } }
    }
    nloc = mine > 0u ? mine : 1u; nx = cnt > 0u ? cnt : 1u;
}

__device__ __forceinline__ void xcd_barrier(const XcdBarrier& b) {
    asm volatile("s_waitcnt vmcnt(0)" ::: "memory");
    __syncthreads();
    if (threadIdx.x == 0) {
        unsigned* bar = b.bar;
        __builtin_amdgcn_s_waitcnt(0);
        unsigned nloc = b.st[0], nx = b.st[1];
        if (nloc == 0u) { xcd_barrier_complete(bar, b.x, nloc, nx); b.st[0] = nloc; b.st[1] = nx; }
        const unsigned old = xb_add(&bar[XB_XSUB(b.x)], 1u);
        const unsigned gen = old / nloc;
        if (old + 1u == (gen + 1u) * nloc) {
            __builtin_amdgcn_fence(__ATOMIC_RELEASE, "agent");
            asm volatile("s_waitcnt vmcnt(0)" ::: "memory");
            const unsigned og = xb_add(&bar[XB_TOP], 1u);
            const unsigned tg = og / nx;
            if (og + 1u == (tg + 1u) * nx) xb_add(&bar[XB_TOPGEN], 1u);
            else XB_SPIN(xb_ld(&bar[XB_TOPGEN]) == tg, bar);
            __builtin_amdgcn_fence(__ATOMIC_ACQUIRE, "agent");
            xb_add(&bar[XB_XGEN(b.x)], 1u);
            asm volatile("s_waitcnt vmcnt(0)" ::: "memory");
        } else {
            XB_SPIN(xb_ld(&bar[XB_XGEN(b.x)]) == gen, bar);
            __builtin_amdgcn_fence(__ATOMIC_ACQUIRE, "agent");
            asm volatile("s_waitcnt vmcnt(0)" ::: "memory");
        }
    }
    __syncthreads();
}
struct Args {
    const float* in[19]; float* out; unsigned char* ws; int ph_lo, ph_hi;
};
struct Frame {
    LAS unsigned char* lds; volatile LAS unsigned* MISC; gu32* ctl;
    int tid, lane, wave, G, gw, NGW;
};

constexpr size_t WS_GDEC = 14 * MiB + 128 * 1024;
constexpr size_t WS_SDEC = 14 * MiB + 512 * 1024;
constexpr size_t WS_GST = 208 * MiB;
constexpr size_t WS_SST = 224 * MiB;
constexpr int SA64 = 144, SA128 = 272, SA32 = 80, SXN = 528;

__device__ __forceinline__ float silu_f(float x) { return x * __builtin_amdgcn_rcpf(1.f + __expf(-x)); }
__device__ __forceinline__ float softplus_f(float x) { return fmaxf(x, 0.f) + __logf(1.f + __expf(-fabsf(x))); }
__device__ __forceinline__ float logsigmoid_f(float x) { return fminf(x, 0.f) - __logf(1.f + __expf(-fabsf(x))); }
typedef unsigned u32x2 __attribute__((ext_vector_type(2)));

__device__ __forceinline__ f32x4 mma16(const LAS unsigned char* A, int sa, const LAS unsigned char* Bt, int sb, int K, f32x4 acc, int r, int kg) {
    for (int k0 = 0; k0 < K; k0 += 32) {
        const bf16x8 a = *(const LAS bf16x8*)(A + r * sa + (k0 + 8 * kg) * 2);
        const bf16x8 b = *(const LAS bf16x8*)(Bt + r * sb + (k0 + 8 * kg) * 2);
        acc = __builtin_amdgcn_mfma_f32_16x16x32_bf16(a, b, acc, 0, 0, 0);
    }
    return acc;
}

__device__ __forceinline__ void unpack8f(const v4u x, float (&f)[8]) {
    f[0] = __builtin_bit_cast(float, x.x << 16); f[1] = __builtin_bit_cast(float, x.x & 0xffff0000u); f[2] = __builtin_bit_cast(float, x.y << 16); f[3] = __builtin_bit_cast(float, x.y & 0xffff0000u);
    f[4] = __builtin_bit_cast(float, x.z << 16); f[5] = __builtin_bit_cast(float, x.z & 0xffff0000u); f[6] = __builtin_bit_cast(float, x.w << 16); f[7] = __builtin_bit_cast(float, x.w & 0xffff0000u);
}
typedef short s16x4 __attribute__((ext_vector_type(4)));
template <int SB> __device__ __forceinline__ void tr_frag2(unsigned base, bf16x8& f0, bf16x8& f1) {
    s16x4 a, b, c, d;
    asm volatile("ds_read_b64_tr_b16 %0, %4\n\tds_read_b64_tr_b16 %1, %4 offset:%5\n\tds_read_b64_tr_b16 %2, %4 offset:%6\n\tds_read_b64_tr_b16 %3, %4 offset:%7\n\ts_waitcnt lgkmcnt(0)"
                 : "=&v"(a), "=&v"(b), "=&v"(c), "=&v"(d) : "v"(base), "i"(4 * SB), "i"(32 * SB), "i"(36 * SB) : "memory");
    f0 = __builtin_shufflevector(a, b, 0, 1, 2, 3, 4, 5, 6, 7); f1 = __builtin_shufflevector(c, d, 0, 1, 2, 3, 4, 5, 6, 7);
}
template <int SB> __device__ __forceinline__ void tr_frag4n(unsigned base, bf16x8& f0, bf16x8& f1, bf16x8& f2, bf16x8& f3) {
    s16x4 a0, b0, a1, b1, a2, b2, a3, b3;
    asm volatile("ds_read_b64_tr_b16 %0, %8\n\tds_read_b64_tr_b16 %1, %8 offset:%9\n\tds_read_b64_tr_b16 %2, %8 offset:32\n\tds_read_b64_tr_b16 %3, %8 offset:%10\n\t"
                 "ds_read_b64_tr_b16 %4, %8 offset:64\n\tds_read_b64_tr_b16 %5, %8 offset:%11\n\tds_read_b64_tr_b16 %6, %8 offset:96\n\tds_read_b64_tr_b16 %7, %8 offset:%12\n\ts_waitcnt lgkmcnt(0)"
                 : "=&v"(a0), "=&v"(b0), "=&v"(a1), "=&v"(b1), "=&v"(a2), "=&v"(b2), "=&v"(a3), "=&v"(b3)
                 : "v"(base), "i"(4 * SB), "i"(4 * SB + 32), "i"(4 * SB + 64), "i"(4 * SB + 96) : "memory");
    f0 = __builtin_shufflevector(a0, b0, 0, 1, 2, 3, 4, 5, 6, 7); f1 = __builtin_shufflevector(a1, b1, 0, 1, 2, 3, 4, 5, 6, 7);
    f2 = __builtin_shufflevector(a2, b2, 0, 1, 2, 3, 4, 5, 6, 7); f3 = __builtin_shufflevector(a3, b3, 0, 1, 2, 3, 4, 5, 6, 7);
}
template <int SB> __device__ __forceinline__ f32x4 mma16_trB64(const LAS unsigned char* A, int sa, unsigned bbase, int n0, f32x4 acc, int r, int kg) {
    bf16x8 b0, b1; tr_frag2<SB>(bbase + (unsigned)((8 * kg + (r >> 2)) * SB + (n0 + 4 * (r & 3)) * 2), b0, b1);
    const bf16x8 a0 = *(const LAS bf16x8*)(A + r * sa + (8 * kg) * 2), a1 = *(const LAS bf16x8*)(A + r * sa + (32 + 8 * kg) * 2);
    acc = __builtin_amdgcn_mfma_f32_16x16x32_bf16(a0, b0, acc, 0, 0, 0);
    return __builtin_amdgcn_mfma_f32_16x16x32_bf16(a1, b1, acc, 0, 0, 0);
}
template <int MODE>
__device__ __forceinline__ void gla_unit(const Frame& F, const Args& A, int unit) {
    const int b = unit >> 9, c = (unit >> 2) & 127, h = unit & 3;
    const size_t t0 = (size_t)b * SEQ + (size_t)c * 64;
    const GAS bf16* proj = (const GAS bf16*)(A.ws + WS_PROJ);
    LAS unsigned char* L = F.lds;
    LAS float* GLR = (LAS float*)(L + 0);
    LAS float* SEG = (LAS float*)(L + 4096);
    LAS float* RSQ = (LAS float*)(L + 6144);
    LAS unsigned char* QI = L + 8192;
    LAS unsigned char* KI = QI + 64 * SA64;
    LAS unsigned char* VT = KI + 64 * SA64;
    LAS unsigned char* SP = VT + 128 * SA64;
    LAS unsigned char* AT = SP + 128 * SA64;
    LAS unsigned char* GO = AT + 64 * SA64;
    int tid = F.tid, seg = F.wave;
    asm volatile("" : "+v"(tid)); asm volatile("" : "+s"(seg));
    const int d = tid & 63;
    {
        const int row = tid >> 3, ch = tid & 7;
        const GAS bf16* prow = proj + (t0 + row) * NINP;
        const v4u kq = *(const GAS v4u*)(prow + C_K + h * 64 + ch * 8);
        v4u qq = kq; if (MODE == 1) qq = *(const GAS v4u*)(prow + C_Q + h * 64 + ch * 8);
        const int o = tid & 15, jp = tid >> 4;
        const v4u va = *(const GAS v4u*)(proj + (t0 + 2 * jp) * NINP + C_V + h * 128 + o * 8), vb = *(const GAS v4u*)(proj + (t0 + 2 * jp + 1) * NINP + C_V + h * 128 + o * 8);
        v4u g0 = kq, g1 = kq, s0 = kq, s1 = kq;
        if (MODE == 1) {
            const int r2 = tid >> 4, c2 = tid & 15;
            g0 = *(const GAS v4u*)(proj + (t0 + r2) * NINP + C_GOUT + h * 128 + c2 * 8); g1 = *(const GAS v4u*)(proj + (t0 + r2 + 32) * NINP + C_GOUT + h * 128 + c2 * 8);
            const GAS bf16* sp = (const GAS bf16*)(A.ws + WS_GST) + (size_t)unit * 8192;
            s0 = *(const GAS v4u*)(sp + (tid >> 3) * 64 + (tid & 7) * 8); s1 = *(const GAS v4u*)(sp + (64 + (tid >> 3)) * 64 + (tid & 7) * 8);
        }
        v4u gl = kq; if (tid < 128) gl = *(const GAS v4u*)(proj + (t0 + (tid >> 1)) * NINP + C_GLR + (tid & 1) * 8);
        if (MODE == 1) { *(LAS v4u*)(QI + row * SA64 + ch * 16) = qq; *(LAS v4u*)(KI + row * SA64 + ch * 16) = kq; }
        else *(LAS v4u*)(GO + row * SA64 + ch * 16) = kq;
        *(LAS v4u*)(VT + (2 * jp) * SA128 + o * 16) = va; *(LAS v4u*)(VT + (2 * jp + 1) * SA128 + o * 16) = vb;
        if (MODE == 1) {
            const int r2 = tid >> 4, c2 = tid & 15;
            *(LAS v4u*)(GO + r2 * SA128 + c2 * 16) = g0; *(LAS v4u*)(GO + (r2 + 32) * SA128 + c2 * 16) = g1;
            *(LAS v4u*)(SP + (tid >> 3) * SA64 + (tid & 7) * 16) = s0; *(LAS v4u*)(SP + (64 + (tid >> 3)) * SA64 + (tid & 7) * 16) = s1;
        }
        if (tid < 128) { float f[8]; unpack8f(gl, f);
#pragma unroll
            for (int q = 0; q < 8; ++q) GLR[(tid >> 1) * 16 + (tid & 1) * 8 + q] = f[q]; }
    }
    float wv[16];
#pragma unroll
    for (int r = 0; r < 16; ++r) wv[r] = A.in[3][r * 256 + h * 64 + d];
    const float bgv = A.in[4][h * 64 + d];
    __syncthreads();
    float Gv[8]; float run = 0.f;
#pragma unroll
    for (int ii = 0; ii < 8; ++ii) { const int i = seg * 8 + ii; float z = bgv;
#pragma unroll
        for (int r = 0; r < 16; ++r) z += GLR[i * 16 + r] * wv[r];
        run += logsigmoid_f(z) * (1.f / 16.f); Gv[ii] = run; }
    SEG[seg * 64 + d] = run;
    __syncthreads();
    float off = 0.f, tot = 0.f;
#pragma unroll
    for (int s = 0; s < 8; ++s) { const float v = SEG[s * 64 + d]; tot += v; off += (s < seg) ? v : 0.f; }
#pragma unroll
    for (int ii = 0; ii < 8; ++ii) Gv[ii] += off;
    if (MODE == 0) {
        unsigned w[4];
#pragma unroll
        for (int ii = 0; ii < 8; ii += 2) {
            const float k0 = bf2f(*(const LAS bf16*)(GO + (seg * 8 + ii) * SA64 + d * 2)) * __expf(tot - Gv[ii]);
            const float k1 = bf2f(*(const LAS bf16*)(GO + (seg * 8 + ii + 1) * SA64 + d * 2)) * __expf(tot - Gv[ii + 1]);
            w[ii >> 1] = pk2(k0, k1); }
        *(LAS v4u*)(KI + d * SA64 + seg * 16) = (v4u){w[0], w[1], w[2], w[3]};
        if (seg == 0) ((GAS float*)(A.ws + WS_GDEC))[unit * 64 + d] = __expf(tot);
    } else {
#pragma unroll
        for (int ii = 0; ii < 8; ++ii) { const int i = seg * 8 + ii;
            LAS bf16* qp = (LAS bf16*)(QI + i * SA64 + d * 2); LAS bf16* kp = (LAS bf16*)(KI + i * SA64 + d * 2);
            *qp = (bf16)f2bf(bf2f(*qp) * 0.125f * __expf(Gv[ii])); *kp = (bf16)f2bf(bf2f(*kp) * __expf(-Gv[ii])); }
    }
    __syncthreads();
    const int r = tid & 15, kg = (tid >> 4) & 3, w = seg;
    const f32x4 zero = (f32x4){0.f, 0.f, 0.f, 0.f};
    if (MODE == 0) {
        const int mt = w & 3, nb = (w >> 2) * 4;
        GAS bf16* stT = (GAS bf16*)(A.ws + WS_GST) + (size_t)unit * 8192;
#pragma unroll
        for (int n = 0; n < 4; ++n) {
            const f32x4 acc = mma16_trB64<SA128>(KI + mt * 16 * SA64, SA64, (unsigned)(size_t)VT, (nb + n) * 16, zero, r, kg);
            const int dv = (nb + n) * 16 + r, d0 = mt * 16 + kg * 4;
            *(GAS u32x2*)(stT + dv * 64 + d0) = (u32x2){pk2(acc[0], acc[1]), pk2(acc[2], acc[3])}; }
    } else {
        const int mt = w & 3;
#pragma unroll
        for (int n = 0; n < 2; ++n) { const int nt = (w >> 2) * 2 + n;
            const f32x4 acc = mma16(QI + mt * 16 * SA64, SA64, KI + nt * 16 * SA64, SA64, 64, zero, r, kg);
#pragma unroll
            for (int ii = 0; ii < 4; ++ii) { const int i = mt * 16 + kg * 4 + ii, j = nt * 16 + r; *(LAS bf16*)(AT + i * SA64 + j * 2) = (bf16)f2bf(j <= i ? acc[ii] : 0.f); } }
        __syncthreads();
        const int nb = (w >> 2) * 4;
        f32x4 o[4]; float rs[4] = {0.f, 0.f, 0.f, 0.f};
#pragma unroll
        for (int n = 0; n < 4; ++n) {
            f32x4 acc = mma16_trB64<SA128>(AT + mt * 16 * SA64, SA64, (unsigned)(size_t)VT, (nb + n) * 16, zero, r, kg);
            acc = mma16(QI + mt * 16 * SA64, SA64, SP + (nb + n) * 16 * SA64, SA64, 64, acc, r, kg);
            o[n] = acc;
#pragma unroll
            for (int ii = 0; ii < 4; ++ii) rs[ii] += acc[ii] * acc[ii]; }
#pragma unroll
        for (int ii = 0; ii < 4; ++ii) { rs[ii] += __shfl_xor(rs[ii], 1); rs[ii] += __shfl_xor(rs[ii], 2); rs[ii] += __shfl_xor(rs[ii], 4); rs[ii] += __shfl_xor(rs[ii], 8); }
        if (r == 0) {
#pragma unroll
            for (int ii = 0; ii < 4; ++ii) RSQ[(w >> 2) * 64 + mt * 16 + kg * 4 + ii] = rs[ii]; }
        __syncthreads();
        float rr[4];
#pragma unroll
        for (int ii = 0; ii < 4; ++ii) { const int row = mt * 16 + kg * 4 + ii; rr[ii] = rsqrtf((RSQ[row] + RSQ[64 + row]) * (1.f / 128.f) + EPS); }
#pragma unroll
        for (int n = 0; n < 4; ++n) { const int dv = (nb + n) * 16 + r; const float nwv = A.in[5][dv];
#pragma unroll
            for (int ii = 0; ii < 4; ++ii) { LAS bf16* gp = (LAS bf16*)(GO + (mt * 16 + kg * 4 + ii) * SA128 + dv * 2);
                *gp = (bf16)f2bf(o[n][ii] * rr[ii] * nwv * silu_f(bf2f(*gp))); } }
        __syncthreads();
        {   const int r2 = tid >> 4, c2 = tid & 15; GAS bf16* mixed = (GAS bf16*)(A.ws + WS_MIX);
            *(GAS v4u*)(mixed + (t0 + r2) * D + h * 128 + c2 * 8) = *(const LAS v4u*)(GO + r2 * SA128 + c2 * 16);
            *(GAS v4u*)(mixed + (t0 + r2 + 32) * D + h * 128 + c2 * 8) = *(const LAS v4u*)(GO + (r2 + 32) * SA128 + c2 * 16); }
    }
    __syncthreads();
}

template <int MODE>
__device__ __forceinline__ void ssd_unit(const Frame& F, const Args& A, int unit) {
    const int b = unit >> 7, c = (unit >> 1) & 63, g = unit & 1;
    const size_t t0 = (size_t)b * SEQ + (size_t)c * 128;
    const GAS bf16* proj = (const GAS bf16*)(A.ws + WS_PROJ);
    LAS unsigned char* L = F.lds;
    LAS float* DT = (LAS float*)(L + 0);
    LAS float* ACU = (LAS float*)(L + 2048);
    LAS unsigned char* CM = L + 4096;
    LAS unsigned char* BM = CM + 128 * SA64;
    LAS unsigned char* XT = BM + 128 * SA64;
    LAS unsigned char* PW = XT + 128 * SXN;
    LAS unsigned char* ZW = PW + 8 * 16 * SA32;
    LAS float* RRW = (LAS float*)(ZW + 8 * 16 * SA64);
    int tid = F.tid, w = F.wave;
    asm volatile("" : "+v"(tid)); asm volatile("" : "+s"(w));
    const int lane = tid & 63;
    if (w < 4) {
        const int hd = g * 4 + w; const float Ah = -__expf(A.in[9][hd]), dtb = A.in[8][hd];
        const float dt0 = softplus_f(bf2f(proj[(t0 + 2 * lane) * NINP + C_DT + hd]) + dtb), dt1 = softplus_f(bf2f(proj[(t0 + 2 * lane + 1) * NINP + C_DT + hd]) + dtb);
        const float a0 = dt0 * Ah, a1 = dt1 * Ah; float s = a0 + a1;
#pragma unroll
        for (int o = 1; o < 64; o <<= 1) { const float t = __shfl_up(s, o); s += (lane >= o) ? t : 0.f; }
        DT[(2 * lane) * 4 + w] = dt0; DT[(2 * lane + 1) * 4 + w] = dt1; ACU[(2 * lane) * 4 + w] = s - a1; ACU[(2 * lane + 1) * 4 + w] = s;
        if (MODE == 0 && lane == 63) ((GAS float*)(A.ws + WS_SDEC))[(b * 64 + c) * 8 + hd] = __expf(s);
    }
    __syncthreads();
    if (tid < 384) {
        const int o = tid % 48, sg = tid / 48;
        if (!(MODE == 0 && o >= 40)) {
            const int cc0 = o < 32 ? g * 256 + 8 * o : (o < 40 ? 512 + g * 64 + 8 * (o - 32) : 640 + g * 64 + 8 * (o - 40));
            float wt[4][8], cb[8];
#pragma unroll
            for (int j = 0; j < 4; ++j) { const f32x4 a = *(const GAS f32x4*)(A.in[6] + j * 768 + cc0), bq = *(const GAS f32x4*)(A.in[6] + j * 768 + cc0 + 4);
                wt[j][0] = a.x; wt[j][1] = a.y; wt[j][2] = a.z; wt[j][3] = a.w; wt[j][4] = bq.x; wt[j][5] = bq.y; wt[j][6] = bq.z; wt[j][7] = bq.w; }
            { const f32x4 a = *(const GAS f32x4*)(A.in[7] + cc0), bq = *(const GAS f32x4*)(A.in[7] + cc0 + 4); cb[0] = a.x; cb[1] = a.y; cb[2] = a.z; cb[3] = a.w; cb[4] = bq.x; cb[5] = bq.y; cb[6] = bq.z; cb[7] = bq.w; }
            const GAS bf16* src = proj + (t0 + 16 * sg) * NINP + C_XBC + cc0;
            float x0[8], x1[8], x2[8];
            if (c > 0 || sg > 0) { unpack8f(*(const GAS v4u*)(src - 3 * NINP), x0); unpack8f(*(const GAS v4u*)(src - 2 * NINP), x1); unpack8f(*(const GAS v4u*)(src - 1 * NINP), x2); }
            else {
#pragma unroll
                for (int q = 0; q < 8; ++q) { x0[q] = 0.f; x1[q] = 0.f; x2[q] = 0.f; } }
            const int hl = o >> 3, p0 = (o & 7) * 8;
            float sc_end = 0.f; if (MODE == 0 && o < 32) sc_end = ACU[127 * 4 + hl];
#pragma unroll 1
            for (int hf = 0; hf < 2; ++hf) {
                v4u xin[8];
#pragma unroll
                for (int i = 0; i < 8; ++i) xin[i] = *(const GAS v4u*)(src + (size_t)(hf * 8 + i) * NINP);
#pragma unroll
                for (int i = 0; i < 8; ++i) {
                    const int l = 16 * sg + hf * 8 + i;
                    float xc[8]; unpack8f(xin[i], xc);
                    float v[8];
#pragma unroll
                    for (int q = 0; q < 8; ++q) v[q] = silu_f(cb[q] + wt[0][q] * x0[q] + wt[1][q] * x1[q] + wt[2][q] * x2[q] + wt[3][q] * xc[q]);
#pragma unroll
                    for (int q = 0; q < 8; ++q) { x0[q] = x1[q]; x1[q] = x2[q]; x2[q] = xc[q]; }
                    if (MODE == 0 && o < 32) { const float sc = DT[l * 4 + hl] * __expf(sc_end - ACU[l * 4 + hl]);
#pragma unroll
                        for (int q = 0; q < 8; ++q) v[q] *= sc; }
                    const v4u ov = (v4u){pk2(v[0], v[1]), pk2(v[2], v[3]), pk2(v[4], v[5]), pk2(v[6], v[7])};
                    if (o < 32) *(LAS v4u*)(XT + l * SXN + o * 16) = ov;
                    else *(LAS v4u*)((o < 40 ? BM : CM) + l * SA64 + (o & 7) * 16) = ov;
                }
            }
        }
    }
    __syncthreads();
    const int r = lane & 15, kg = lane >> 4;
    const f32x4 zero = (f32x4){0.f, 0.f, 0.f, 0.f};
    if (MODE == 0) {
        const int hl = w >> 1;
        GAS bf16* st = (GAS bf16*)(A.ws + WS_SST) + ((size_t)((b * 64 + c) * 8 + g * 4 + hl)) * 4096;
#pragma unroll
        for (int mt = 0; mt < 4; ++mt)
#pragma unroll
            for (int n = 0; n < 2; ++n) { const int nt = (w & 1) * 2 + n;
                f32x4 acc = zero;
#pragma unroll
                for (int kh = 0; kh < 2; ++kh) {
                    bf16x8 a0, a1, b0, b1;
                    tr_frag2<SA64>((unsigned)(size_t)BM + (unsigned)((64 * kh + 8 * kg + (r >> 2)) * SA64 + (mt * 16 + 4 * (r & 3)) * 2), a0, a1);
                    tr_frag2<SXN>((unsigned)(size_t)XT + (unsigned)((64 * kh + 8 * kg + (r >> 2)) * SXN + (hl * 64 + nt * 16 + 4 * (r & 3)) * 2), b0, b1);
                    acc = __builtin_amdgcn_mfma_f32_16x16x32_bf16(a0, b0, acc, 0, 0, 0); acc = __builtin_amdgcn_mfma_f32_16x16x32_bf16(a1, b1, acc, 0, 0, 0); }
                const int p = nt * 16 + r, n0 = mt * 16 + kg * 4;
                *(GAS u32x2*)(st + p * 64 + n0) = (u32x2){pk2(acc[0], acc[1]), pk2(acc[2], acc[3])}; }
    } else {
        f32x4 sc[8];
#pragma unroll
        for (int nt = 0; nt < 8; ++nt) { sc[nt] = zero; if (nt <= w) sc[nt] = mma16(CM + w * 16 * SA64, SA64, BM + nt * 16 * SA64, SA64, 64, zero, r, kg); }
        __syncthreads();
        const GAS bf16* spg = (const GAS bf16*)(A.ws + WS_SST) + ((size_t)((b * 64 + c) * 8 + g * 4)) * 4096;
        for (int e = tid; e < 1024; e += 512) { const int row = e >> 3, ch = e & 7; *(LAS v4u*)(BM + row * SA64 + ch * 16) = *(const GAS v4u*)(spg + row * 64 + ch * 8); }
        __syncthreads();
        float rs[4] = {0.f, 0.f, 0.f, 0.f};
        LAS unsigned char* pw = PW + w * 16 * SA32;
        LAS unsigned char* zw = ZW + w * 16 * SA64;
        const int orow = lane >> 3, och = lane & 7;
        const GAS bf16* zsrc = proj + (t0 + w * 16 + orow) * NINP + C_Z + g * 256 + och * 8;
        v4u ysave[4][2];
#pragma unroll
        for (int hl = 0; hl < 4; ++hl) {
            if (hl == 2) {
                __syncthreads();
                for (int e = tid; e < 1024; e += 512) { const int row = e >> 3, ch = e & 7; *(LAS v4u*)(BM + row * SA64 + ch * 16) = *(const GAS v4u*)(spg + 2 * 4096 + row * 64 + ch * 8); }
                __syncthreads();
            }
            asm volatile("" ::: "memory");
            const v4u z0 = *(const GAS v4u*)(zsrc + hl * 64), z1 = *(const GAS v4u*)(zsrc + (size_t)8 * NINP + hl * 64);
            float acl[4];
#pragma unroll
            for (int ii = 0; ii < 4; ++ii) acl[ii] = ACU[(w * 16 + kg * 4 + ii) * 4 + hl];
            f32x4 yd[4] = {zero, zero, zero, zero};
#pragma unroll
            for (int kc = 0; kc < 4; ++kc) {
                if (kc * 2 <= w) {
#pragma unroll
                    for (int half = 0; half < 2; ++half) { const int stl = 2 * kc + half; const int s = stl * 16 + r;
                        const float acs = ACU[s * 4 + hl], dts = DT[s * 4 + hl];
#pragma unroll
                        for (int ii = 0; ii < 4; ++ii) { const int l = w * 16 + kg * 4 + ii;
                            const float pv = (s <= l) ? sc[stl][ii] * __expf(acl[ii] - acs) * dts : 0.f;
                            *(LAS bf16*)(pw + (kg * 4 + ii) * SA32 + (half * 16 + r) * 2) = (bf16)f2bf(pv); } }
                    LDS_WAIT();
                    const bf16x8 a = *(const LAS bf16x8*)(pw + r * SA32 + kg * 16);
                    bf16x8 bb[4];
                    tr_frag4n<SXN>((unsigned)(size_t)XT + (unsigned)((kc * 32 + 8 * kg + (r >> 2)) * SXN + (hl * 64 + 4 * (r & 3)) * 2), bb[0], bb[1], bb[2], bb[3]);
#pragma unroll
                    for (int nt = 0; nt < 4; ++nt) yd[nt] = __builtin_amdgcn_mfma_f32_16x16x32_bf16(a, bb[nt], yd[nt], 0, 0, 0);
                    LDS_WAIT();
                }
            }
            *(LAS v4u*)(zw + orow * SA64 + och * 16) = z0; *(LAS v4u*)(zw + (orow + 8) * SA64 + och * 16) = z1;
            LDS_WAIT();
            const float Dk = A.in[10][g * 4 + hl];
            float eal[4];
#pragma unroll
            for (int ii = 0; ii < 4; ++ii) eal[ii] = __expf(acl[ii]);
#pragma unroll
            for (int nt = 0; nt < 4; ++nt) {
                const f32x4 yo = mma16(CM + w * 16 * SA64, SA64, BM + (hl & 1) * 64 * SA64 + nt * 16 * SA64, SA64, 64, zero, r, kg);
                const int p = nt * 16 + r;
#pragma unroll
                for (int ii = 0; ii < 4; ++ii) { const int l = w * 16 + kg * 4 + ii;
                    const float xv = bf2f(*(const LAS bf16*)(XT + l * SXN + (hl * 64 + p) * 2));
                    LAS bf16* zp = (LAS bf16*)(zw + (kg * 4 + ii) * SA64 + p * 2);
                    const float y = (yd[nt][ii] + eal[ii] * yo[ii] + xv * Dk) * silu_f(bf2f(*zp));
                    const unsigned short yb = (unsigned short)f2bf(y); const float yq = bf2f(yb);
                    rs[ii] += yq * yq;
                    *zp = yb; }
            }
            LDS_WAIT();
            ysave[hl][0] = *(const LAS v4u*)(zw + orow * SA64 + och * 16); ysave[hl][1] = *(const LAS v4u*)(zw + (orow + 8) * SA64 + och * 16);
            LDS_WAIT();
        }
#pragma unroll
        for (int ii = 0; ii < 4; ++ii) { rs[ii] += __shfl_xor(rs[ii], 1); rs[ii] += __shfl_xor(rs[ii], 2); rs[ii] += __shfl_xor(rs[ii], 4); rs[ii] += __shfl_xor(rs[ii], 8);
            rs[ii] = rsqrtf(rs[ii] * (1.f / 256.f) + EPS); }
        if (r == 0) {
#pragma unroll
            for (int ii = 0; ii < 4; ++ii) RRW[w * 16 + kg * 4 + ii] = rs[ii]; }
        LDS_WAIT();
        const float rr0 = RRW[w * 16 + orow], rr1 = RRW[w * 16 + orow + 8];
        GAS bf16* mdst = (GAS bf16*)(A.ws + WS_MIX) + (t0 + w * 16 + orow) * D + 512 + g * 256 + och * 8;
#pragma unroll
        for (int hl = 0; hl < 4; ++hl) {
            const f32x4 nwa = *(const GAS f32x4*)(A.in[11] + g * 256 + hl * 64 + och * 8), nwb = *(const GAS f32x4*)(A.in[11] + g * 256 + hl * 64 + och * 8 + 4);
            const float nw8[8] = {nwa.x, nwa.y, nwa.z, nwa.w, nwb.x, nwb.y, nwb.z, nwb.w};
#pragma unroll
            for (int hh = 0; hh < 2; ++hh) { float f[8]; unpack8f(ysave[hl][hh], f); const float rr_ = hh ? rr1 : rr0;
#pragma unroll
                for (int q = 0; q < 8; ++q) f[q] *= rr_ * nw8[q];
                *(GAS v4u*)(mdst + (size_t)(8 * hh) * D + hl * 64) = (v4u){pk2(f[0], f[1]), pk2(f[2], f[3]), pk2(f[4], f[5]), pk2(f[6], f[7])}; }
        }
    }
    __syncthreads();
}

template <bool DRY> __device__ __forceinline__ void scan_phase(const Frame& F, const Args& A) {
    if (F.tid < 128) {
        GAS unsigned* st = (GAS unsigned*)(A.ws + WS_GST); const GAS float* dec = (const GAS float*)(A.ws + WS_GDEC);
        for (int gi = blockIdx.x * 128 + F.tid; gi < 8 * 4096; gi += F.G * 128) {
            const int bh = gi >> 12, e = gi & 4095, b = bh >> 2, h = bh & 3, d = (e & 31) * 2;
            float S0 = 0.f, S1 = 0.f;
#pragma unroll 1
            for (int c = 0; c < 128; c += 16) {
                unsigned v[16]; float d0[16], d1[16];
#pragma unroll
                for (int u = 0; u < 16; ++u) { const size_t un = (size_t)((b * 128 + c + u) * 4 + h); v[u] = st[un * 4096 + e]; d0[u] = dec[un * 64 + d]; d1[u] = dec[un * 64 + d + 1]; }
#pragma unroll
                for (int u = 0; u < 16; ++u) { const size_t un = (size_t)((b * 128 + c + u) * 4 + h); (DRY ? (GAS unsigned*)(A.ws + 232 * MiB) : st)[un * 4096 + e] = pk2(S0, S1);
                    S0 = d0[u] * S0 + bf2f((unsigned short)(v[u] & 0xffffu)); S1 = d1[u] * S1 + bf2f((unsigned short)(v[u] >> 16)); }
            }
        }
    } else if (F.tid < 256) {
        GAS unsigned* st = (GAS unsigned*)(A.ws + WS_SST); const GAS float* dec = (const GAS float*)(A.ws + WS_SDEC);
        for (int gi = blockIdx.x * 128 + (F.tid - 128); gi < 16 * 2048; gi += F.G * 128) {
            const int bh = gi >> 11, e = gi & 2047, b = bh >> 3, hd = bh & 7;
            float S0 = 0.f, S1 = 0.f;
#pragma unroll 1
            for (int c = 0; c < 64; c += 16) {
                unsigned v[16]; float dd[16];
#pragma unroll
                for (int u = 0; u < 16; ++u) { const size_t un = (size_t)((b * 64 + c + u) * 8 + hd); v[u] = st[un * 2048 + e]; dd[u] = dec[un]; }
#pragma unroll
                for (int u = 0; u < 16; ++u) { const size_t un = (size_t)((b * 64 + c + u) * 8 + hd); (DRY ? (GAS unsigned*)(A.ws + 248 * MiB) : st)[un * 2048 + e] = pk2(S0, S1);
                    S0 = dd[u] * S0 + bf2f((unsigned short)(v[u] & 0xffffu)); S1 = dd[u] * S1 + bf2f((unsigned short)(v[u] >> 16)); }
            }
        }
    }
}
constexpr size_t WS_HB = WS_PROJ;
constexpr size_t WS_Q = 144 * MiB;
constexpr size_t WS_IDX = 232 * MiB;
constexpr size_t WS_GATE = 240 * MiB;
typedef float f32x16 __attribute__((ext_vector_type(16)));
__device__ __forceinline__ float as_f(unsigned u) { return __builtin_bit_cast(float, u); }
__device__ __forceinline__ unsigned as_u(float f) { return __builtin_bit_cast(unsigned, f); }
#define CE_DESC(a, b) do { const float hi_ = fmaxf((a), (b)), lo_ = fminf((a), (b)); (a) = hi_; (b) = lo_; } while (0)
template <int OFF, int N> __device__ __forceinline__ void sort16_desc(float (&v)[N]) {
#pragma unroll
    for (int k = 2; k <= 16; k <<= 1)
#pragma unroll
        for (int j = k >> 1; j > 0; j >>= 1)
#pragma unroll
            for (int i = 0; i < 16; ++i) { const int l = i ^ j; if (l > i) { if ((i & k) == 0) CE_DESC(v[OFF + i], v[OFF + l]); else CE_DESC(v[OFF + l], v[OFF + i]); } }
}
template <int OA, int OB, int NA, int NB> __device__ __forceinline__ void merge16_desc(float (&a)[NA], const float (&b)[NB]) {
#pragma unroll
    for (int i = 0; i < 16; ++i) a[OA + i] = fmaxf(a[OA + i], b[OB + 15 - i]);
#pragma unroll
    for (int j = 8; j > 0; j >>= 1)
#pragma unroll
        for (int i = 0; i < 16; ++i) { const int l = i ^ j; if (l > i) CE_DESC(a[OA + i], a[OA + l]); }
}
constexpr unsigned char CAND0[32] = {0, 2, 4, 6, 8, 10, 12, 14, 16, 18, 20, 22, 32, 34, 36, 49, 51, 65, 80, 96, 112, 128, 160, 192, 224, 255, 255, 255, 255, 255, 255, 255};
constexpr unsigned char CAND1[32] = {1, 3, 5, 7, 9, 11, 13, 15, 17, 19, 21, 23, 33, 35, 48, 50, 64, 66, 81, 97, 113, 144, 176, 208, 240, 255, 255, 255, 255, 255, 255, 255};

__device__ __forceinline__ void topk_wave_job(const Args& A, const LAS unsigned char* SK, LAS unsigned char* TAB, int tok0, int h, int lane) {
    const int r = lane & 31, hi = lane >> 5;
    const GAS bf16* qrow = (const GAS bf16*)(A.ws + WS_Q) + (size_t)(tok0 + r) * NQ + h * 256 + 8 * hi;
    float LST[2][16];
#pragma unroll
    for (int p = 0; p < 2; ++p) {
        __builtin_amdgcn_sched_barrier(0);
        bf16x8 bq[8];
#pragma unroll
        for (int s = 0; s < 8; ++s) bq[s] = *(const GAS bf16x8*)(qrow + p * 128 + 16 * s);
        float v[64];
#pragma unroll
        for (int kt = 0; kt < 4; ++kt) {
            f32x16 acc;
#pragma unroll
            for (int i = 0; i < 16; ++i) acc[i] = 0.f;
#pragma unroll
            for (int s = 0; s < 8; ++s) { const bf16x8 a = *(const LAS bf16x8*)(SK + (p * 128 + kt * 32 + r) * SA128 + (16 * s + 8 * hi) * 2);
                acc = __builtin_amdgcn_mfma_f32_32x32x16_bf16(a, bq[s], acc, 0, 0, 0); }
#pragma unroll
            for (int i = 0; i < 16; ++i) { const unsigned key = (unsigned)(kt * 32 + (i & 3) + 8 * (i >> 2)) | ((unsigned)hi << 2); v[kt * 16 + i] = as_f((as_u(acc[i]) & ~127u) | key); }
        }
        sort16_desc<0>(v); sort16_desc<16>(v); sort16_desc<32>(v); sort16_desc<48>(v);
        merge16_desc<0, 16>(v, v); merge16_desc<32, 48>(v, v); merge16_desc<0, 32>(v, v);
        float o[16];
#pragma unroll
        for (int i = 0; i < 16; ++i) o[i] = __shfl_xor(v[i], 32);
        merge16_desc<0, 0>(v, o);
#pragma unroll
        for (int i = 0; i < 16; ++i) LST[p][i] = v[i];
    }
    __builtin_amdgcn_sched_barrier(0);
    {   unsigned pk[4];
#pragma unroll
        for (int q4 = 0; q4 < 4; ++q4) { unsigned wv = 0;
#pragma unroll
            for (int b = 0; b < 4; ++b) { float l0 = LST[0][q4 * 4 + b], l1 = LST[1][q4 * 4 + b]; asm volatile("" : "+v"(l0), "+v"(l1));
                const unsigned x = as_u(hi ? l1 : l0) & 127u; wv |= x << (8 * b); }
            pk[q4] = wv; }
        *(LAS v4u*)(TAB + r * 32 + hi * 16) = (v4u){pk[0], pk[1], pk[2], pk[3]};
    }
    float c[32];
    float va[16], vb2[16];
#pragma unroll
    for (int i = 0; i < 16; ++i) { va[i] = as_f(as_u(LST[0][i]) & ~127u); vb2[i] = as_f(as_u(LST[1][i]) & ~127u); }
#define CANDV(i0, j0, k0, i1, j1, k1) as_f((as_u(hi ? (va[i1] + vb2[j1]) : (va[i0] + vb2[j0])) & ~255u) | (hi ? (k1) : (k0)))
    c[0] = CANDV(0, 0, 0u, 0, 1, 1u);
    c[1] = CANDV(0, 2, 2u, 0, 3, 3u);
    c[2] = CANDV(0, 4, 4u, 0, 5, 5u);
    c[3] = CANDV(0, 6, 6u, 0, 7, 7u);
    c[4] = CANDV(0, 8, 8u, 0, 9, 9u);
    c[5] = CANDV(0, 10, 10u, 0, 11, 11u);
    c[6] = CANDV(0, 12, 12u, 0, 13, 13u);
    c[7] = CANDV(0, 14, 14u, 0, 15, 15u);
    c[8] = CANDV(1, 0, 16u, 1, 1, 17u);
    c[9] = CANDV(1, 2, 18u, 1, 3, 19u);
    c[10] = CANDV(1, 4, 20u, 1, 5, 21u);
    c[11] = CANDV(1, 6, 22u, 1, 7, 23u);
    c[12] = CANDV(2, 0, 32u, 2, 1, 33u);
    c[13] = CANDV(2, 2, 34u, 2, 3, 35u);
    c[14] = CANDV(2, 4, 36u, 3, 0, 48u);
    c[15] = CANDV(3, 1, 49u, 3, 2, 50u);
    c[16] = CANDV(3, 3, 51u, 4, 0, 64u);
    c[17] = CANDV(4, 1, 65u, 4, 2, 66u);
    c[18] = CANDV(5, 0, 80u, 5, 1, 81u);
    c[19] = CANDV(6, 0, 96u, 6, 1, 97u);
    c[20] = CANDV(7, 0, 112u, 7, 1, 113u);
    c[21] = CANDV(8, 0, 128u, 9, 0, 144u);
    c[22] = CANDV(10, 0, 160u, 11, 0, 176u);
    c[23] = CANDV(12, 0, 192u, 13, 0, 208u);
    c[24] = CANDV(14, 0, 224u, 15, 0, 240u);
    c[25] = as_f(0xFF61B1E6u | 255u);
    c[26] = as_f(0xFF61B1E6u | 255u);
    c[27] = as_f(0xFF61B1E6u | 255u);
    c[28] = as_f(0xFF61B1E6u | 255u);
    c[29] = as_f(0xFF61B1E6u | 255u);
    c[30] = as_f(0xFF61B1E6u | 255u);
    c[31] = as_f(0xFF61B1E6u | 255u);
#undef CANDV
    sort16_desc<0>(c); sort16_desc<16>(c); merge16_desc<0, 16>(c, c);
    {   float o[16];
#pragma unroll
        for (int i = 0; i < 16; ++i) o[i] = __shfl_xor(c[i], 32);
        merge16_desc<0, 0>(c, o); }
    const float mx = as_f(as_u(c[0]) & ~255u);
    float ex[16], den = 0.f;
#pragma unroll
    for (int k = 0; k < 16; ++k) { ex[k] = __expf(as_f(as_u(c[k]) & ~255u) - mx); den += ex[k]; }
    const float inv = 1.f / den;
    LDS_WAIT();
    unsigned eid[8]; float gv[8];
#pragma unroll
    for (int k = 0; k < 8; ++k) { float ca = c[k], cb = c[k + 8], ea = ex[k], eb = ex[k + 8]; asm volatile("" : "+v"(ca), "+v"(cb), "+v"(ea), "+v"(eb));
        const unsigned code = as_u(hi ? cb : ca) & 255u; gv[k] = (hi ? eb : ea) * inv;
        const unsigned ia = *(const LAS unsigned char*)(TAB + r * 32 + (code >> 4)), ib = *(const LAS unsigned char*)(TAB + r * 32 + 16 + (code & 15));
        eid[k] = ia * 128u + ib; }
    GAS unsigned* ip = (GAS unsigned*)(A.ws + WS_IDX) + (size_t)(tok0 + r) * 128 + h * 16 + 8 * hi;
    GAS float* gp = (GAS float*)(A.ws + WS_GATE) + (size_t)(tok0 + r) * 128 + h * 16 + 8 * hi;
    *(GAS v4u*)ip = (v4u){eid[0], eid[1], eid[2], eid[3]}; *(GAS v4u*)(ip + 4) = (v4u){eid[4], eid[5], eid[6], eid[7]};
    *(GAS f32x4*)gp = (f32x4){gv[0], gv[1], gv[2], gv[3]}; *(GAS f32x4*)(gp + 4) = (f32x4){gv[4], gv[5], gv[6], gv[7]};
    LDS_WAIT();
}
__device__ __forceinline__ void topk_phase(const Frame& F, const Args& A) {
    LAS unsigned char* SK = F.lds;
    LAS unsigned char* TABS = F.lds + 256 * SA128;
    for (int unit = blockIdx.x; unit < 256; unit += F.G) {
        int tid = F.tid, w = F.wave;
        asm volatile("" : "+v"(tid)); asm volatile("" : "+s"(w));
        const int h = unit & 7, tb = (unit >> 3) * 512;
        const GAS bf16* sk = (const GAS bf16*)(A.ws + WS_SUBK) + (size_t)h * 2 * 128 * 128;
        for (int e = tid; e < 256 * 16; e += 512) { const int row = e >> 4, ch = e & 15; *(LAS v4u*)(SK + row * SA128 + ch * 16) = *(const GAS v4u*)(sk + row * 128 + ch * 8); }
        __syncthreads();
#pragma unroll 1
        for (int tt = 0; tt < 2; ++tt) topk_wave_job(A, SK, TABS + w * 1024, tb + (w * 2 + tt) * 32, h, tid & 63);
        __syncthreads();
    }
}

__device__ __forceinline__ float gelu_f(float v) {
    const float av = fabsf(v), t = __builtin_amdgcn_rcpf(av * 0.2316418882f + 1.0f);
    float q = t * 0.5307027145f + (-0.7265760135f); q = q * t + 0.7107068705f; q = q * t + (-0.142248368f); q = q * t + 0.127414796f; q = q * t;
    const float m = v * (q * __builtin_amdgcn_exp2f((v * v) * (-0.72134752044f)));
    return v < 0.f ? m : v - m;
}
__device__ __forceinline__ void unpack8(const v4u x, float (&f)[8]) {
    f[0] = as_f(x.x << 16); f[1] = as_f(x.x & 0xffff0000u); f[2] = as_f(x.y << 16); f[3] = as_f(x.y & 0xffff0000u);
    f[4] = as_f(x.z << 16); f[5] = as_f(x.z & 0xffff0000u); f[6] = as_f(x.w << 16); f[7] = as_f(x.w & 0xffff0000u);
}
typedef long lx2 __attribute__((ext_vector_type(2)));
typedef float f32x2 __attribute__((ext_vector_type(2)));
typedef int i32x8 __attribute__((ext_vector_type(8)));
typedef int i32x4 __attribute__((ext_vector_type(4)));
constexpr float U4_SCALE = 64.f, V4_SCALE = 5.657f;
constexpr int MX_ONE = 0x7F7F7F7F;
template <int BY> __device__ __forceinline__ f32x2 cvt_fp4x2(unsigned w) { return __builtin_amdgcn_cvt_scalef32_pk_f32_fp4(w, 1.0f, BY); }
typedef _Float16 h16x2 __attribute__((ext_vector_type(2)));
template <int BY> __device__ __forceinline__ h16x2 cvt_fp4x2h(unsigned w) { return __builtin_amdgcn_cvt_scalef32_pk_f16_fp4(w, 1.0f, BY); }
template <int WS> __device__ __forceinline__ f32x2 cvt_fp8x2(int w) { return __builtin_amdgcn_cvt_pk_f32_fp8(w, WS != 0); }
__device__ __forceinline__ unsigned pk4_fp8(float a, float b, float c, float d) { int p = __builtin_amdgcn_cvt_pk_fp8_f32(a, b, 0, false); p = __builtin_amdgcn_cvt_pk_fp8_f32(c, d, p, true); return (unsigned)p; }
#ifndef DRYMASK
#define DRYMASK 0xFFFFFFFFu
#endif
constexpr size_t WS_HID = 248 * MiB;
template <bool DRY> __device__ __forceinline__ void expert_u_phase(const Frame& F, const Args& A) {
    int tid = F.tid, w = F.wave;
    asm volatile("" : "+v"(tid)); asm volatile("" : "+s"(w));
    const int lane = tid & 63, r = lane & 15, kg = lane >> 4, half = lane >> 5, sub = lane & 31;
    const int dl = 32 * sub + 16 * half;
    LAS unsigned char* N2 = F.lds + w * 1024;
    const GAS unsigned char* u4 = (const GAS unsigned char*)(A.ws + WS_UB); const GAS unsigned char* v4 = (const GAS unsigned char*)(A.ws + WS_VB);
    const GAS unsigned* idx = (const GAS unsigned*)(A.ws + WS_IDX); const GAS float* gate = (const GAS float*)(A.ws + WS_GATE);
    const GAS float* rowsq = (const GAS float*)(A.ws + WS_ROWSQ2);
#pragma unroll 1
    for (int t = F.gw; t < T; t += F.NGW) {
        GAS float* hrow = (GAS float*)A.out + (size_t)t * D;
        f32x4 hv[4];
        {   const GAS bf16* hb = (const GAS bf16*)(A.ws + WS_HB) + (size_t)t * D + dl;
            float f0[8], f1[8]; unpack8f(*(const GAS v4u*)hb, f0); unpack8f(*(const GAS v4u*)(hb + 8), f1);
            hv[0] = (f32x4){f0[0], f0[1], f0[2], f0[3]}; hv[1] = (f32x4){f0[4], f0[5], f0[6], f0[7]}; hv[2] = (f32x4){f1[0], f1[1], f1[2], f1[3]}; hv[3] = (f32x4){f1[4], f1[5], f1[6], f1[7]}; }
        const float rr = rsqrtf(rowsq[t] * (1.f / 1024.f) + EPS);
        {   v4u pk;
            pk.x = pk4_fp8(hv[0].x * rr, hv[0].y * rr, hv[0].z * rr, hv[0].w * rr); pk.y = pk4_fp8(hv[1].x * rr, hv[1].y * rr, hv[1].z * rr, hv[1].w * rr);
            pk.z = pk4_fp8(hv[2].x * rr, hv[2].y * rr, hv[2].z * rr, hv[2].w * rr); pk.w = pk4_fp8(hv[3].x * rr, hv[3].y * rr, hv[3].z * rr, hv[3].w * rr);
            *(LAS v4u*)(N2 + dl) = pk; }
        unsigned eidx[8]; float gt[8];
#pragma unroll
        for (int eg = 0; eg < 8; ++eg) { eidx[eg] = idx[(size_t)t * 128 + eg * 16 + r]; gt[eg] = gate[(size_t)t * 128 + eg * 16 + r]; }
        LDS_WAIT();
        float act0 = 0.f; GAS float* hidp = (GAS float*)(A.ws + WS_HID);
        {
            LAS unsigned char* UBw = F.lds + 8192 + w * (2 * 16 * 528);
            v4u xr[8];
#define PU_ROWS(EG) { _Pragma("unroll") for (int j = 0; j < 8; ++j) { const unsigned ea = (unsigned)__builtin_amdgcn_readlane((int)eidx[EG], 2 * j), eb = (unsigned)__builtin_amdgcn_readlane((int)eidx[EG], 2 * j + 1); \
                xr[j] = *(const GAS v4u*)(u4 + (size_t)(half ? eb : ea) * 512 + 16 * sub); } }
            PU_ROWS(0)
#pragma unroll
            for (int eg = 0; eg < 8; ++eg) {
                LAS unsigned char* ub = UBw + (eg & 1) * (16 * 528);
#pragma unroll
                for (int j = 0; j < 8; ++j) *(LAS v4u*)(ub + (2 * j + half) * 528 + 16 * sub) = xr[j];
                if (eg < 7) PU_ROWS(eg + 1)
                __builtin_amdgcn_sched_barrier(0);
                LDS_WAIT();
                f32x4 accg = (f32x4){0.f, 0.f, 0.f, 0.f};
                const LAS unsigned char* n2p = N2 + 16 * kg; asm volatile("" : "+v"(n2p));
#pragma unroll
                for (int s2 = 0; s2 < 8; ++s2) {
                    const i32x4 a0 = *(const LAS i32x4*)(n2p + 128 * s2), a1 = *(const LAS i32x4*)(n2p + 128 * s2 + 64);
                    const i32x8 a = (i32x8){a0.x, a0.y, a0.z, a0.w, a1.x, a1.y, a1.z, a1.w};
                    const i32x4 b4 = *(const LAS i32x4*)(ub + r * 528 + 64 * s2 + 16 * kg);
                    const i32x8 b = (i32x8){b4.x, b4.y, b4.z, b4.w, 0, 0, 0, 0};
                    accg = __builtin_amdgcn_mfma_scale_f32_16x16x128_f8f6f4(a, b, accg, 0, 4, 0, MX_ONE, 0, MX_ONE);
                }
                if (eg == 0) act0 = accg[0];
                if (kg == 0) hidp[(size_t)t * 128 + eg * 16 + r] = gelu_f(accg[0] * (1.f / U4_SCALE)) * gt[eg] * (1.f / V4_SCALE);
                __builtin_amdgcn_sched_barrier(0);
            }
#undef PU_ROWS
        }
        bool bad = false;
        if (t == F.gw) {
            float ref = 0.f;
            for (int s = 0; s < 8; ++s) {
                const i32x4 b4 = *(const GAS i32x4*)(u4 + (size_t)eidx[0] * 512 + 64 * s + 16 * kg);
                const int bw[4] = {b4.x, b4.y, b4.z, b4.w};
#pragma unroll
                for (int k = 0; k < 4; ++k) {
                    const lx2 a8 = *(const LAS lx2*)(N2 + 128 * s + 32 * kg + 16 * (k >> 1));
                    const long aw = (k & 1) ? a8.y : a8.x;
                    const int alo = (int)aw, ahi = (int)(aw >> 32);
                    { const f32x2 bf = cvt_fp4x2<0>((unsigned)bw[k]), af = cvt_fp8x2<0>(alo); ref += af.x * bf.x + af.y * bf.y; }
                    { const f32x2 bf = cvt_fp4x2<1>((unsigned)bw[k]), af = cvt_fp8x2<1>(alo); ref += af.x * bf.x + af.y * bf.y; }
                    { const f32x2 bf = cvt_fp4x2<2>((unsigned)bw[k]), af = cvt_fp8x2<0>(ahi); ref += af.x * bf.x + af.y * bf.y; }
                    { const f32x2 bf = cvt_fp4x2<3>((unsigned)bw[k]), af = cvt_fp8x2<1>(ahi); ref += af.x * bf.x + af.y * bf.y; }
                }
            }
            ref += __shfl_xor(ref, 16); ref += __shfl_xor(ref, 32);
            bad = __any(fabsf(ref - act0) > 0.02f * fabsf(ref) + 0.5f);
        }
        if (bad && kg == 0) hidp[(size_t)t * 128 + r] = __builtin_nanf("");
    }
}
template <bool DRY> __device__ __forceinline__ void expert_v_phase(const Frame& F, const Args& A) {
    int tid = F.tid, w = F.wave;
    asm volatile("" : "+v"(tid)); asm volatile("" : "+s"(w));
    const int lane = tid & 63, half = lane >> 5, sub = lane & 31;
    const int dl = 32 * sub + 16 * half;
    const GAS unsigned char* v4 = (const GAS unsigned char*)(A.ws + WS_VB);
    const GAS unsigned* idx = (const GAS unsigned*)(A.ws + WS_IDX); const GAS float* hidp = (const GAS float*)(A.ws + WS_HID);
    const GAS bf16* hbase = (const GAS bf16*)(A.ws + WS_HB) + dl;
    LAS float* NW = (LAS float*)F.lds;
    LAS unsigned* TL = (LAS unsigned*)(F.lds + 4096 + w * 1024);
    const int p0 = (lane & ~15) | ((lane & 1) << 3) | ((lane >> 1) & 7);
    const LAS unsigned* TLr = TL + 8 * half;
    const unsigned lanebase = 16u * sub;
    NW[tid] = A.in[18][tid]; NW[tid + 512] = A.in[18][tid + 512];
    __syncthreads();
    int t = F.gw;
    unsigned ni0 = idx[(size_t)t * 128 + lane], ni1 = idx[(size_t)t * 128 + 64 + lane];
    float nh0 = hidp[(size_t)t * 128 + lane], nh1 = hidp[(size_t)t * 128 + 64 + lane];
#pragma unroll 1
    for (; t < T; t += F.NGW) {
        {   const unsigned i0 = DRY ? (ni0 & DRYMASK) : ni0, i1 = DRY ? (ni1 & DRYMASK) : ni1;
            const h16x2 a = (h16x2){(_Float16)nh0, (_Float16)nh0}, b = (h16x2){(_Float16)nh1, (_Float16)nh1};
            TL[p0] = i0 * 512u; TL[64 + p0] = i1 * 512u; TL[128 + p0] = __builtin_bit_cast(unsigned, a); TL[192 + p0] = __builtin_bit_cast(unsigned, b); }
        const v4u hA = *(const GAS v4u*)(hbase + (size_t)t * D), hB = *(const GAS v4u*)(hbase + (size_t)t * D + 8);
        {   const int tn = (t + F.NGW < T) ? t + F.NGW : t;
            ni0 = idx[(size_t)tn * 128 + lane]; ni1 = idx[(size_t)tn * 128 + 64 + lane];
            nh0 = hidp[(size_t)tn * 128 + lane]; nh1 = hidp[(size_t)tn * 128 + 64 + lane]; }
        h16x2 o2h[16];
#pragma unroll
        for (int i = 0; i < 16; ++i) o2h[i] = (h16x2){(_Float16)0.f, (_Float16)0.f};
        v4u xr[1][8];
#define PV_IDS(EG, V) { const v4u q0_ = *(const LAS v4u*)(TLr + 16 * (EG)), q1_ = *(const LAS v4u*)(TLr + 16 * (EG) + 4); \
                V[0] = q0_.x; V[1] = q0_.y; V[2] = q0_.z; V[3] = q0_.w; V[4] = q1_.x; V[5] = q1_.y; V[6] = q1_.z; V[7] = q1_.w; }
#define PV_LOAD1(OFF, BUF, PR) xr[BUF][PR] = *(const GAS v4u*)(v4 + (size_t)((OFF) + lanebase));
        {   unsigned ia[8];
            PV_IDS(0, ia)
#pragma unroll
            for (int pr = 0; pr < 8; ++pr) PV_LOAD1(ia[pr], 0, pr)
        }
        __builtin_amdgcn_sched_barrier(0);
#pragma unroll
        for (int eg = 0; eg < 8; ++eg) {
            unsigned idn[8], sc[8];
            if (eg < 7) PV_IDS(eg + 1, idn)
            { const LAS unsigned* TLs_ = TLr + 128; const v4u q0_ = *(const LAS v4u*)(TLs_ + 16 * eg), q1_ = *(const LAS v4u*)(TLs_ + 16 * eg + 4);
              sc[0] = q0_.x; sc[1] = q0_.y; sc[2] = q0_.z; sc[3] = q0_.w; sc[4] = q1_.x; sc[5] = q1_.y; sc[6] = q1_.z; sc[7] = q1_.w; }
            __builtin_amdgcn_sched_barrier(0);
#pragma unroll
            for (int pr = 0; pr < 8; ++pr) {
                const h16x2 sh2 = __builtin_bit_cast(h16x2, sc[pr]);
                const unsigned xw[4] = {xr[0][pr].x, xr[0][pr].y, xr[0][pr].z, xr[0][pr].w};
#pragma unroll
                for (int k = 0; k < 4; ++k) {
                    o2h[4 * k] = __builtin_elementwise_fma(cvt_fp4x2h<0>(xw[k]), sh2, o2h[4 * k]); o2h[4 * k + 1] = __builtin_elementwise_fma(cvt_fp4x2h<1>(xw[k]), sh2, o2h[4 * k + 1]);
                    o2h[4 * k + 2] = __builtin_elementwise_fma(cvt_fp4x2h<2>(xw[k]), sh2, o2h[4 * k + 2]); o2h[4 * k + 3] = __builtin_elementwise_fma(cvt_fp4x2h<3>(xw[k]), sh2, o2h[4 * k + 3]); }
                if (eg < 7) PV_LOAD1(idn[pr], 0, pr)
                __builtin_amdgcn_sched_barrier(0);
            }
        }
#undef PV_LOAD1
#undef PV_IDS
        float o[16]; f32x2 o2[16];
#pragma unroll
        for (int i = 0; i < 16; ++i) { const unsigned mine = __builtin_bit_cast(unsigned, o2h[i]), oth = (unsigned)__shfl_xor((int)mine, 32); const h16x2 oo = __builtin_bit_cast(h16x2, oth);
            o2[i].x = (float)o2h[i].x + (float)oo.x; o2[i].y = (float)o2h[i].y + (float)oo.y; }
#pragma unroll
        for (int i = 0; i < 8; ++i) { float a0 = o2[i].x, a1 = o2[i].y, b0 = o2[8 + i].x, b1 = o2[8 + i].y; asm volatile("" : "+v"(a0), "+v"(a1), "+v"(b0), "+v"(b1));
            o[2 * i] = half ? b0 : a0; o[2 * i + 1] = half ? b1 : a1; }
        float ss = 0.f; f32x4 h2[4];
        {   float f0[8], f1[8]; unpack8f(hA, f0); unpack8f(hB, f1);
            h2[0] = (f32x4){f0[0] + o[0], f0[1] + o[1], f0[2] + o[2], f0[3] + o[3]}; h2[1] = (f32x4){f0[4] + o[4], f0[5] + o[5], f0[6] + o[6], f0[7] + o[7]};
            h2[2] = (f32x4){f1[0] + o[8], f1[1] + o[9], f1[2] + o[10], f1[3] + o[11]}; h2[3] = (f32x4){f1[4] + o[12], f1[5] + o[13], f1[6] + o[14], f1[7] + o[15]}; }
#pragma unroll
        for (int q = 0; q < 4; ++q) { const f32x4 x = h2[q]; ss += (x.x * x.x + x.y * x.y) + (x.z * x.z + x.w * x.w); }
        ss = wave_sum(ss);
        const float r3 = rsqrtf(ss * (1.f / D) + EPS);
        GAS float* yrow = (DRY ? (GAS float*)(A.ws + WS_Q) : (GAS float*)A.out) + (size_t)t * D + dl;
#pragma unroll
        for (int q = 0; q < 4; ++q) *(GAS f32x4*)(yrow + 4 * q) = h2[q] * r3 * *(const LAS f32x4*)(NW + dl + 4 * q);
    }
}
__device__ __forceinline__ void p0_transpose_item(const float* W, const float* kscale, int K, int N, bf16* WT, LAS float* scr, int item, int lane) {
    const int nblk = (N + 31) / 32, kb = item / nblk, nb = item % nblk, k0 = 64 * kb, n0 = 32 * nb;
    const int nn = n0 + (lane & 31); const bool ok = nn < N;
    (void)nn; (void)ok;
    {   const int c4 = lane & 7, kr = lane >> 3; const bool okc = n0 + 4 * c4 < N;
        f32x4 v[8];
#pragma unroll
        for (int i = 0; i < 8; ++i) v[i] = okc ? *(const GAS f32x4*)(W + (size_t)(k0 + 8 * i + kr) * N + n0 + 4 * c4) : (f32x4){0.f, 0.f, 0.f, 0.f};
#pragma unroll
        for (int i = 0; i < 8; ++i) { const int kk = 8 * i + kr; const float sc = kscale ? kscale[k0 + kk] : 1.f; LAS float* d = scr + kk * 33 + 4 * c4;
            d[0] = v[i].x * sc; d[1] = v[i].y * sc; d[2] = v[i].z * sc; d[3] = v[i].w * sc; } }
    LDS_WAIT(); asm volatile("" ::: "memory");
    const int c = lane & 7;
#pragma unroll
    for (int j = 0; j < 4; ++j) { const int n = (lane >> 3) + 8 * j; const LAS float* s = scr + (8 * c) * 33 + n;
        v4u o; o.x = pk2(s[0 * 33], s[1 * 33]); o.y = pk2(s[2 * 33], s[3 * 33]); o.z = pk2(s[4 * 33], s[5 * 33]); o.w = pk2(s[6 * 33], s[7 * 33]);
        *(GAS v4u*)(WT + (size_t)(n0 + n) * K + k0 + 8 * c) = o; }
    LDS_WAIT(); asm volatile("" ::: "memory");
}
__device__ __forceinline__ void p0_convert(const Frame& F, const float* src, bf16* dst, size_t n) {
    for (size_t i = ((size_t)F.gw * 64 + F.lane) * 8; i < n; i += (size_t)F.NGW * 512) {
        const f32x4 a = *(const GAS f32x4*)(src + i), b = *(const GAS f32x4*)(src + i + 4);
        v4u o; o.x = pk2(a.x, a.y); o.y = pk2(a.z, a.w); o.z = pk2(b.x, b.y); o.w = pk2(b.z, b.w);
        *(GAS v4u*)(dst + i) = o;
    }
}
__device__ __forceinline__ void p0_convert_fp4(const Frame& F, int wk, int nwk, const float* src, unsigned char* dst, size_t n, float scale, const float* colscale) {
#pragma unroll 4
    for (size_t i = ((size_t)wk * 64 + F.lane) * 32; i < n; i += (size_t)nwk * 2048) {
        unsigned ow[4];
#pragma unroll
        for (int q = 0; q < 4; ++q) {
            f32x4 a = *(const GAS f32x4*)(src + i + 8 * q) * scale, b = *(const GAS f32x4*)(src + i + 8 * q + 4) * scale;
            if (colscale) { a = a * *(const GAS f32x4*)(colscale + ((i + 8 * q) & 1023)); b = b * *(const GAS f32x4*)(colscale + ((i + 8 * q + 4) & 1023)); }
            unsigned pk = 0;
            pk = __builtin_amdgcn_cvt_scalef32_pk_fp4_f32(pk, a.x, a.y, 1.0f, 0); pk = __builtin_amdgcn_cvt_scalef32_pk_fp4_f32(pk, a.z, a.w, 1.0f, 1);
            pk = __builtin_amdgcn_cvt_scalef32_pk_fp4_f32(pk, b.x, b.y, 1.0f, 2); pk = __builtin_amdgcn_cvt_scalef32_pk_fp4_f32(pk, b.z, b.w, 1.0f, 3);
            ow[q] = pk; }
        *(GAS v4u*)(dst + (i >> 1)) = (v4u){ow[0], ow[1], ow[2], ow[3]};
    }
}
__device__ __forceinline__ void p0_prologue(const Frame& F, const Args& A) {
    unsigned char* ws = A.ws;
    LAS float* scr = (LAS float*)(F.lds + RING_OFF + F.wave * 16384);
    constexpr int I_IN = (D / 64) * ((NIN + 31) / 32), I_O = (D / 64) * (D / 32), I_Q = (D / 64) * (NQ / 32);
    for (int it = F.gw; it < I_IN + I_O + I_Q; it += F.NGW) {
        int r = it;
        if (r < I_IN) { p0_transpose_item(A.in[2], A.in[1], D, NIN, (bf16*)(ws + WS_WIN), scr, r, F.lane); continue; } r -= I_IN;
        if (r < I_O) { p0_transpose_item(A.in[12], nullptr, D, D, (bf16*)(ws + WS_WO), scr, r, F.lane); continue; } r -= I_O;
        p0_transpose_item(A.in[14], A.in[13], D, NQ, (bf16*)(ws + WS_WQ), scr, r, F.lane);
    }
    for (int m0 = F.gw * 4; m0 < T; m0 += F.NGW * 4) {
        f32x4 v[4][4]; float s[4] = {0.f, 0.f, 0.f, 0.f};
#pragma unroll
        for (int u = 0; u < 4; ++u) { const GAS f32x4* xr = (const GAS f32x4*)(A.in[0] + (size_t)(m0 + u) * D) + F.lane;
#pragma unroll
            for (int j = 0; j < 4; ++j) v[u][j] = xr[64 * j]; }
#pragma unroll
        for (int u = 0; u < 4; ++u) {
#pragma unroll
            for (int j = 0; j < 4; ++j) s[u] += (v[u][j].x * v[u][j].x + v[u][j].y * v[u][j].y) + (v[u][j].z * v[u][j].z + v[u][j].w * v[u][j].w);
            GAS unsigned long long* o8 = (GAS unsigned long long*)((bf16*)(ws + WS_XB) + (size_t)(m0 + u) * D) + F.lane;
#pragma unroll
            for (int j = 0; j < 4; ++j) o8[64 * j] = (unsigned long long)pk2(v[u][j].x, v[u][j].y) | ((unsigned long long)pk2(v[u][j].z, v[u][j].w) << 32); }
#pragma unroll
        for (int u = 0; u < 4; ++u) s[u] = wave_sum(s[u]);
        if (F.lane < 4) { const float sv = F.lane == 0 ? s[0] : (F.lane == 1 ? s[1] : (F.lane == 2 ? s[2] : s[3])); ((float*)(ws + WS_RRMS1))[m0 + F.lane] = rsqrtf(sv * (1.f / D) + EPS); ((float*)(ws + WS_ROWSQ2))[m0 + F.lane] = 0.f; }
    }
    p0_convert(F, A.in[15], (bf16*)(ws + WS_SUBK), (size_t)8 * 2 * 128 * 128);
    p0_convert_fp4(F, F.gw, F.NGW, A.in[16], ws + WS_UB, (size_t)16384 * 1024, U4_SCALE, A.in[13]);
    p0_convert_fp4(F, F.gw, F.NGW, A.in[17], ws + WS_VB, (size_t)16384 * 1024, V4_SCALE, nullptr);
}


#ifdef BENCH_KIND
__device__ __forceinline__ void bench_phase(const Frame& F, const Args& A) {
    unsigned r[16]; unsigned w = F.tid * 2654435761u, z = F.tid;
#pragma unroll
    for (int i = 0; i < 16; ++i) r[i] = w + i;
#pragma unroll 1
    for (int it = 0; it < BENCH_ITERS; ++it) {
#pragma unroll
        for (int i = 0; i < 16; ++i) {
#if BENCH_KIND == 1
            asm volatile("v_cvt_scalef32_pk_f16_fp4 %0, %1, 1.0" : "=v"(r[i]) : "v"(w));
#elif BENCH_KIND == 2
            asm volatile("v_pk_fma_f16 %0, %1, %2, %0" : "+v"(r[i]) : "v"(w), "v"(z));
#elif BENCH_KIND == 3
            asm volatile("v_and_or_b32 %0, %1, %2, %0" : "+v"(r[i]) : "v"(w), "v"(z));
#elif BENCH_KIND == 6
            asm volatile("v_fma_f32 %0, %1, %2, %0" : "+v"(r[i]) : "v"(w), "v"(z));
#elif BENCH_KIND == 7
            asm volatile("v_perm_b32 %0, %1, %2, %0" : "+v"(r[i]) : "v"(w), "v"(z));
#endif
        }
    }
    unsigned acc = 0;
#pragma unroll
    for (int i = 0; i < 16; ++i) acc ^= r[i];
    if (acc == 0x12345679u) *(GAS unsigned*)(A.ws + WS_Q + F.tid * 4) = acc;
}
#endif
#ifndef PROBE_MASK
#define PROBE_MASK 0
#endif
__device__ __forceinline__ int probe_reps(int k) { int n = ((PROBE_MASK >> k) & 1) + 1; return n; }
__global__ void __launch_bounds__(NWAVES * 64, 2) fwd(Args args) {
    extern __shared__ __attribute__((aligned(16))) unsigned char lds[];
    Frame F;
    F.lds = (LAS unsigned char*)lds;
    F.MISC = (volatile LAS unsigned*)(F.lds + MISC_OFF);
    F.tid = threadIdx.x; F.lane = F.tid & 63; F.wave = __builtin_amdgcn_readfirstlane(F.tid >> 6);
    F.G = gridDim.x; F.gw = blockIdx.x * NWAVES + F.wave; F.NGW = F.G * NWAVES;
    unsigned char* ws = args.ws;
    F.ctl = (gu32*)(ws + WS_CTL);
    for (int u = F.tid; u < (LDS_BYTES - LDSCTL_OFF) / 4; u += NWAVES * 64) ((LAS unsigned*)(F.lds + LDSCTL_OFF))[u] = 0u;
    __syncthreads();
    XcdBarrier bar = xcd_barrier_post((unsigned*)(F.ctl + CW_BAR), F.MISC + 8);
    const int lo = args.ph_lo, hi = args.ph_hi;
#define IN(k) (lo <= (k) && (k) < hi)
#define BOTH(k) (IN(k) && IN((k) + 1))
#define GRID_BAR() xcd_barrier(bar)
#define REP(k) for (int rep_ = 0, nrep_ = probe_reps(k); rep_ < nrep_; ++rep_)

    if (IN(0)) REP(0) { p0_prologue(F, args); if (BOTH(0)) GRID_BAR(); }
    if (IN(1)) REP(1) {
        pg8::Gemm g{(const bf16*)(ws + WS_XB), (const bf16*)(ws + WS_WIN), T, NINP, D}; pg8::StaticOrder S; S.init(T, NINP, F.G, (int)blockIdx.x);
        pg8::EpiRowScaleBf16 E{(bf16*)(ws + WS_PROJ), NINP, (const float*)(ws + WS_RRMS1)};
        pg8::gemm_phase<pg8::EpiRowScaleBf16, pg8::StaticOrder, true, true>(F.lds + RING_OFF, g, S, E);
        if (BOTH(1)) GRID_BAR();
    }
    if (IN(2)) {
        REP(2) { for (int u = blockIdx.x; u < 256; u += F.G) ssd_unit<0>(F, args, u); }
        REP(13) { for (int u = blockIdx.x; u < 1024; u += F.G) gla_unit<0>(F, args, u); }
        if (BOTH(2)) GRID_BAR();
    }
    if (IN(3)) { if ((PROBE_MASK >> 3) & 1) { scan_phase<true>(F, args); GRID_BAR(); } scan_phase<false>(F, args); if (BOTH(3)) GRID_BAR(); }
    if (IN(4)) {
        REP(4) { for (int u = blockIdx.x; u < 256; u += F.G) ssd_unit<1>(F, args, u); }
        REP(12) { for (int u = blockIdx.x; u < 1024; u += F.G) gla_unit<1>(F, args, u); }
        if (BOTH(4)) GRID_BAR();
    }
    if (IN(5)) {
        pg8::Gemm g{(const bf16*)(ws + WS_MIX), (const bf16*)(ws + WS_WO), T, D, D}; pg8::StaticOrder S; S.init(T, D, F.G, (int)blockIdx.x);
        if ((PROBE_MASK >> 5) & 1) { pg8::EpiResidual Ed{(const bf16*)(ws + WS_XB), (bf16*)(ws + 208 * MiB), (float*)(ws + 240 * MiB), D};
            pg8::gemm_phase<pg8::EpiResidual, pg8::StaticOrder, true, true>(F.lds + RING_OFF, g, S, Ed); GRID_BAR(); }
        pg8::EpiResidual E{(const bf16*)(ws + WS_XB), (bf16*)(ws + WS_HB), (float*)(ws + WS_ROWSQ2), D};
        pg8::gemm_phase<pg8::EpiResidual, pg8::StaticOrder, true, true>(F.lds + RING_OFF, g, S, E);
        if (BOTH(5)) GRID_BAR();
    }
    if (IN(6)) REP(6) {
        pg8::Gemm g{(const bf16*)(ws + WS_HB), (const bf16*)(ws + WS_WQ), T, NQ, D}; pg8::StaticOrder S; S.init(T, NQ, F.G, (int)blockIdx.x);
        pg8::EpiRsqScaleBf16 E{(bf16*)(ws + WS_Q), NQ, (const float*)(ws + WS_ROWSQ2)};
        pg8::gemm_phase<pg8::EpiRsqScaleBf16, pg8::StaticOrder, true, true>(F.lds + RING_OFF, g, S, E);
        if (BOTH(6)) GRID_BAR();
    }
    if (IN(7)) REP(7) { topk_phase(F, args); if (BOTH(7)) GRID_BAR(); }
    if (IN(8)) { if ((PROBE_MASK >> 8) & 1) { expert_u_phase<true>(F, args); GRID_BAR(); } expert_u_phase<false>(F, args); if (BOTH(8)) GRID_BAR(); }
#ifdef BENCH_KIND
    if (IN(9)) { bench_phase(F, args); GRID_BAR(); }
#endif
    if (IN(9)) { if ((PROBE_MASK >> 9) & 1) { expert_v_phase<true>(F, args); GRID_BAR(); } expert_v_phase<false>(F, args); }
#undef IN
#undef BOTH
}
extern "C" void kernel_launch(void* const* d_in, const int* in_sizes, int n_in, void* d_out, int out_size, void* d_ws, size_t ws_size, hipStream_t stream) {
    static int grid = 0;
    if (grid == 0) {
        if (n_in != 19 || out_size != T * D || ws_size < 256 * MiB) { fprintf(stderr, "kernel_launch: unexpected shapes n_in %d out %d ws %zu\n", n_in, out_size, ws_size); grid = -1; return; }
        int dev = 0, cus = 0, per_cu = 0;
        if (hipGetDevice(&dev) != hipSuccess || hipDeviceGetAttribute(&cus, hipDeviceAttributeMultiprocessorCount, dev) != hipSuccess) { grid = -1; return; }
        if (hipFuncSetAttribute((const void*)fwd, hipFuncAttributeMaxDynamicSharedMemorySize, LDS_BYTES) != hipSuccess) { fprintf(stderr, "kernel_launch: hipFuncSetAttribute failed\n"); grid = -1; return; }
        if (hipOccupancyMaxActiveBlocksPerMultiprocessor(&per_cu, (const void*)fwd, NWAVES * 64, LDS_BYTES) != hipSuccess || per_cu < 1) { fprintf(stderr, "kernel_launch: occupancy query says %d\n", per_cu); }
        (void)hipGetLastError();
        grid = cus;
    }
    if (grid < 0) return;
    const float* x = (const float*)d_in[0];
    const float* gla_w2 = (const float*)d_in[3];
    const float* gla_bg = (const float*)d_in[4];
    const float* gla_nw = (const float*)d_in[5];
    const float* conv_w = (const float*)d_in[6];
    const float* conv_b = (const float*)d_in[7];
    const float* dt_bias = (const float*)d_in[8];
    const float* a_log = (const float*)d_in[9];
    const float* d_skip = (const float*)d_in[10];
    const float* ssd_nw = (const float*)d_in[11];
    const float* w_out = (const float*)d_in[12];
    const float* norm_ffn_w = (const float*)d_in[13];
    const float* w_query = (const float*)d_in[14];
    const float* sub_keys = (const float*)d_in[15];
    const float* pu = (const float*)d_in[16];
    const float* pv = (const float*)d_in[17];
    const float* norm_final_w = (const float*)d_in[18];
    float* out = (float*)d_out;
    char* ws = (char*)d_ws;

    (void)hipMemsetAsync(ws + WS_CTL, 0, CTL_ZERO_BYTES, stream);
    Args a{};
    for (int i = 0; i < 19; ++i) a.in[i] = (const float*)d_in[i];
    a.out = out; a.ws = (unsigned char*)d_ws; a.ph_lo = 0; a.ph_hi = 10;
    hipLaunchKernelGGL(fwd, dim3(grid), dim3(NWAVES * 64), LDS_BYTES, stream, a);

}
```

```cpp
#include <hip/hip_runtime.h>
#include <cstdio>
#include <cstdint>
namespace pg8 {
#define PG8_LAS __attribute__((address_space(3)))
typedef unsigned short bf16_t;
typedef short bf16x8 __attribute__((ext_vector_type(8)));
typedef float f32x4 __attribute__((ext_vector_type(4)));
typedef unsigned u32x4 __attribute__((ext_vector_type(4)));
constexpr int BM = 256, BK = 64, HALF = 128, HTB = HALF * BK * 2  , STAGE_BYTES = 8 * HTB, NXCD = 8, WGM = 8;

__host__ __device__ __forceinline__ int lds_byte(int r, int c) { const int st = (r >> 4) * 2 + (c >> 5), rr = r & 15, cc = c & 31, ob = rr * 64 + cc * 2; return st * 1024 + (ob ^ (((ob >> 9) & 1) << 5)); }
__host__ __device__ __forceinline__ void stage_rc(int b, int& R, int& C) { const int st = b / 1024, sb = b % 1024, swz = sb ^ (((sb >> 9) & 1) << 5); R = (st >> 1) * 16 + swz / 64; C = (st & 1) * 32 + (swz % 64) / 2; }
__host__ __device__ __forceinline__ int perm32(int rho) { const int n = rho >> 4, i = rho & 15; return 8 * (i >> 2) + 4 * n + (i & 3); }

struct Unit { int pm, pn; };
struct Gemm { const bf16_t* A; const bf16_t* Bt; int M, N, K; };

struct StaticOrder {
    int nM, nN, nwg, G, c;
    __host__ __device__ void init(int M, int N, int G_, int c_) { nM = M / BM; nN = N / BM; nwg = nM * nN; G = G_; c = c_; }
    __host__ __device__ bool next(int i, Unit& u) const {
        const long L = (long)i * G + c; if (L >= nwg) return false;
        int wgid = (int)L; { const int q = nwg / NXCD, r = nwg % NXCD, xcd = wgid % NXCD, off = wgid / NXCD; wgid = (xcd < r ? xcd * (q + 1) : r * (q + 1) + (xcd - r) * q) + off; }
        const int nig = WGM * nN, gid = wgid / nig, fm = gid * WGM, gsz = (nM - fm) < WGM ? (nM - fm) : WGM;
        u.pm = fm + ((wgid % nig) % gsz); u.pn = (wgid % nig) / gsz; return true;
    }
    __device__ __forceinline__ void a_ready(const Unit&) const {}
    __device__ __forceinline__ void done(const Unit&) const {}
};

__device__ __forceinline__ unsigned cvt_pk_bf16(float lo, float hi) { unsigned r; asm volatile("v_cvt_pk_bf16_f32 %0, %1, %2" : "=v"(r) : "v"(lo), "v"(hi)); return r; }
typedef float f32x2 __attribute__((ext_vector_type(2)));
struct EpiRowScaleBf16 {
    static constexpr bool PERM = true, AFTER_DRAIN = false;
    bf16_t* O; int ldc; const float* rs;
    __device__ __forceinline__ void operator()(const f32x4 (&acc)[2][2][4][2], const Unit& u, int wr, int wc, int fr, int fq) const {
        const int row0 = u.pm * BM + wr * 64 + fr, col0 = u.pn * BM + wc * 32 + 8 * fq;
#pragma unroll
        for (int ai = 0; ai < 2; ++ai)
#pragma unroll
            for (int m = 0; m < 4; ++m) { const int row = row0 + ai * HALF + m * 16; const float sc = rs[row]; bf16_t* rowp = O + (size_t)row * ldc + col0;
#pragma unroll
                for (int bj = 0; bj < 2; ++bj) { const f32x4 v0 = acc[ai][bj][m][0] * sc, v1 = acc[ai][bj][m][1] * sc;
                    u32x4 w; w.x = cvt_pk_bf16(v0[0], v0[1]); w.y = cvt_pk_bf16(v0[2], v0[3]); w.z = cvt_pk_bf16(v1[0], v1[1]); w.w = cvt_pk_bf16(v1[2], v1[3]);
                    *(u32x4*)(rowp + bj * HALF) = w; } }
    }
};
struct EpiRsqScaleBf16 {
    static constexpr bool PERM = true, AFTER_DRAIN = false;
    bf16_t* O; int ldc; const float* rowsq;
    __device__ __forceinline__ void operator()(const f32x4 (&acc)[2][2][4][2], const Unit& u, int wr, int wc, int fr, int fq) const {
        const int row0 = u.pm * BM + wr * 64 + fr, col0 = u.pn * BM + wc * 32 + 8 * fq;
#pragma unroll
        for (int ai = 0; ai < 2; ++ai)
#pragma unroll
            for (int m = 0; m < 4; ++m) { const int row = row0 + ai * HALF + m * 16; const float sc = rsqrtf(rowsq[row] * (1.f / 1024.f) + 1e-6f); bf16_t* rowp = O + (size_t)row * ldc + col0;
#pragma unroll
                for (int bj = 0; bj < 2; ++bj) { const f32x4 v0 = acc[ai][bj][m][0] * sc, v1 = acc[ai][bj][m][1] * sc;
                    u32x4 w; w.x = cvt_pk_bf16(v0[0], v0[1]); w.y = cvt_pk_bf16(v0[2], v0[3]); w.z = cvt_pk_bf16(v1[0], v1[1]); w.w = cvt_pk_bf16(v1[2], v1[3]);
                    *(u32x4*)(rowp + bj * HALF) = w; } }
    }
};
struct EpiResidual {
    static constexpr bool PERM = true, AFTER_DRAIN = false;
    const bf16_t* X; bf16_t* HB; float* rowsq; int ldc;
    __device__ __forceinline__ void operator()(const f32x4 (&acc)[2][2][4][2], const Unit& u, int wr, int wc, int fr, int fq) const {
        const int row0 = u.pm * BM + wr * 64 + fr, col0 = u.pn * BM + wc * 32 + 8 * fq;
#pragma unroll
        for (int ai = 0; ai < 2; ++ai)
#pragma unroll
            for (int m = 0; m < 4; ++m) { const int row = row0 + ai * HALF + m * 16; float ss = 0.f;
#pragma unroll
                for (int bj = 0; bj < 2; ++bj) { const size_t off = (size_t)row * ldc + col0 + bj * HALF;
                    const u32x4 xv = *(const u32x4*)(X + off);
                    const f32x4 x0 = (f32x4){__builtin_bit_cast(float, xv.x << 16), __builtin_bit_cast(float, xv.x & 0xffff0000u), __builtin_bit_cast(float, xv.y << 16), __builtin_bit_cast(float, xv.y & 0xffff0000u)};
                    const f32x4 x1 = (f32x4){__builtin_bit_cast(float, xv.z << 16), __builtin_bit_cast(float, xv.z & 0xffff0000u), __builtin_bit_cast(float, xv.w << 16), __builtin_bit_cast(float, xv.w & 0xffff0000u)};
                    const f32x4 v0 = acc[ai][bj][m][0] + x0, v1 = acc[ai][bj][m][1] + x1;
                    u32x4 w; w.x = cvt_pk_bf16(v0[0], v0[1]); w.y = cvt_pk_bf16(v0[2], v0[3]); w.z = cvt_pk_bf16(v1[0], v1[1]); w.w = cvt_pk_bf16(v1[2], v1[3]);
                    *(u32x4*)(HB + off) = w;
                    ss += (v0[0] * v0[0] + v0[1] * v0[1]) + (v0[2] * v0[2] + v0[3] * v0[3]) + (v1[0] * v1[0] + v1[1] * v1[1]) + (v1[2] * v1[2] + v1[3] * v1[3]); }
                ss += __shfl_xor(ss, 16); ss += __shfl_xor(ss, 32);
                if (fq == 0) atomicAdd(rowsq + row, ss); }
    }
};
template <class Epi, class Sched, bool ALIGN_EPI = false, bool SP2 = false>
__device__ __forceinline__ void gemm_phase(PG8_LAS unsigned char* lds, const Gemm g, const Sched& S, const Epi& E) {
    const int tid = threadIdx.x, wid = __builtin_amdgcn_readfirstlane(tid >> 6), lane = tid & 63, wr = wid >> 2, wc = wid & 3, fr = lane & 15, fq = lane >> 4;
    const int K = g.K, nt = K / BK;
    unsigned voffA[2], voffB[2];
#pragma unroll
    for (int i = 0; i < 2; ++i) { int R, C; stage_rc(tid * 16 + i * 8192, R, C); const int Rb = Epi::PERM ? ((R & ~31) + perm32(R & 31)) : R;
        voffA[i] = (unsigned)(R * K + C) * 2u; voffB[i] = (unsigned)(Rb * K + C) * 2u; }
    const size_t kstep = (size_t)(BK * 2);
    const size_t hstep = (size_t)HALF * K * 2;
    const size_t tstep = 2 * hstep;
    const unsigned ldsw = (unsigned)wid * 1024u;
    const int aoff = lds_byte(wr * 64 + fr, fq * 8), boff = lds_byte(wc * 32 + fr, fq * 8);
#define PG8_SA(b, h) (((b) * 2 + (h)) * HTB)
#define PG8_SB(b, h) ((4 + (b) * 2 + (h)) * HTB)
#define PG8_STAGE(bufoff, gbase, voff) do { _Pragma("unroll") for (int _i = 0; _i < 2; ++_i) \
        __builtin_amdgcn_global_load_lds((const unsigned*)((const char*)(gbase) + (voff)[_i]), (PG8_LAS unsigned*)(lds + (bufoff) + ldsw + _i * 8192), 16, 0, 0); } while (0)
#define PG8_LDA(dst, b, h) do { _Pragma("unroll") for (int m = 0; m < 4; ++m) _Pragma("unroll") for (int k = 0; k < 2; ++k) dst[m][k] = *(const PG8_LAS bf16x8*)(lds + PG8_SA(b, h) + aoff + m * 2048 + k * 1024); } while (0)
#define PG8_LDB(dst, b, h) do { _Pragma("unroll") for (int n = 0; n < 2; ++n) _Pragma("unroll") for (int k = 0; k < 2; ++k) dst[n][k] = *(const PG8_LAS bf16x8*)(lds + PG8_SB(b, h) + boff + n * 2048 + k * 1024); } while (0)
#define PG8_MMA(ai, bj, At, Bt) do { __builtin_amdgcn_s_setprio(1); _Pragma("unroll") for (int m = 0; m < 4; ++m) _Pragma("unroll") for (int n = 0; n < 2; ++n) _Pragma("unroll") for (int k = 0; k < 2; ++k) \
        acc[ai][bj][m][n] = __builtin_amdgcn_mfma_f32_16x16x32_bf16(Bt[n][k], At[m][k], acc[ai][bj][m][n], 0, 0, 0); __builtin_amdgcn_s_setprio(0); } while (0)
#define PG8_WAIT_V(n) asm volatile("s_waitcnt vmcnt(" #n ")" ::: "memory")
#define PG8_WAIT_L(n) asm volatile("s_waitcnt lgkmcnt(" #n ")" ::: "memory")
#define PG8_BAR __builtin_amdgcn_s_barrier()
#define PG8_SCHED __builtin_amdgcn_sched_barrier(0)
    Unit cur, nxt; int ui = 0;
    if (!S.next(0, cur)) return;
    f32x4 acc[2][2][4][2];
#pragma unroll
    for (int a = 0; a < 2; ++a)
#pragma unroll
        for (int b = 0; b < 2; ++b)
#pragma unroll
            for (int m = 0; m < 4; ++m)
#pragma unroll
                for (int n = 0; n < 2; ++n) acc[a][b][m][n] = (f32x4){0.f, 0.f, 0.f, 0.f};
    bf16x8 At[4][2], B0[2][2], B1[2][2];
    const char* cA = (const char*)g.A + (size_t)cur.pm * tstep; const char* cB = (const char*)g.Bt + (size_t)cur.pn * tstep;
    S.a_ready(cur);
    if constexpr (SP2) {
        PG8_STAGE(PG8_SB(0, 0), cB, voffB); PG8_STAGE(PG8_SB(0, 1), cB + hstep, voffB); PG8_STAGE(PG8_SA(0, 0), cA, voffA); PG8_STAGE(PG8_SA(0, 1), cA + hstep, voffA);
        if (wr == 1) PG8_BAR;
        PG8_WAIT_V(2); PG8_BAR;
        PG8_STAGE(PG8_SB(1, 0), cB + kstep, voffB); PG8_STAGE(PG8_SA(1, 0), cA + kstep, voffA); PG8_STAGE(PG8_SB(1, 1), cB + hstep + kstep, voffB);
        PG8_WAIT_V(6); PG8_BAR;
    } else {
        PG8_STAGE(PG8_SB(0, 0), cB, voffB); PG8_STAGE(PG8_SA(0, 0), cA, voffA); PG8_STAGE(PG8_SB(0, 1), cB + hstep, voffB); PG8_STAGE(PG8_SA(0, 1), cA + hstep, voffA);
        if (wr == 1) PG8_BAR;
        PG8_WAIT_V(4); PG8_BAR;
        PG8_STAGE(PG8_SB(1, 0), cB + kstep, voffB); PG8_STAGE(PG8_SA(1, 0), cA + kstep, voffA); PG8_STAGE(PG8_SB(1, 1), cB + hstep + kstep, voffB);
        PG8_WAIT_V(6); PG8_BAR;
    }
    for (;;) {
        const bool has_next = S.next(ui + 1, nxt);
        const char* nA = has_next ? (const char*)g.A + (size_t)nxt.pm * tstep : cA; const char* nB = has_next ? (const char*)g.Bt + (size_t)nxt.pn * tstep : cB;
        for (int t = 0; t < nt; t += 2) {
            const bool last = (t == nt - 2);
            const char* a1 = cA + (size_t)(t + 1) * kstep;
            const char* a2 = last ? nA : cA + (size_t)(t + 2) * kstep; const char* b2 = last ? nB : cB + (size_t)(t + 2) * kstep;
            const char* a3 = a2 + kstep; const char* b3 = b2 + kstep;
            if (last && has_next) S.a_ready(nxt);
            if constexpr (SP2) {
            PG8_LDB(B0, 0, 0); PG8_LDB(B1, 0, 1); PG8_SCHED; PG8_LDA(At, 0, 0); PG8_STAGE(PG8_SA(1, 1), a1 + hstep, voffA);
            PG8_WAIT_V(8); PG8_WAIT_L(0); PG8_BAR; PG8_MMA(0, 0, At, B0); PG8_MMA(0, 1, At, B1); PG8_BAR; PG8_SCHED;
            PG8_LDA(At, 0, 1); PG8_STAGE(PG8_SB(0, 0), b2, voffB); PG8_STAGE(PG8_SB(0, 1), b2 + hstep, voffB); PG8_STAGE(PG8_SA(0, 0), a2, voffA);
            PG8_WAIT_V(8); PG8_WAIT_L(0); PG8_BAR; PG8_MMA(1, 0, At, B0); PG8_MMA(1, 1, At, B1); PG8_BAR; PG8_SCHED;
            PG8_LDB(B0, 1, 0); PG8_LDB(B1, 1, 1); PG8_SCHED; PG8_LDA(At, 1, 0); PG8_STAGE(PG8_SA(0, 1), a2 + hstep, voffA);
            PG8_WAIT_V(8); PG8_WAIT_L(0); PG8_BAR; PG8_MMA(0, 0, At, B0); PG8_MMA(0, 1, At, B1); PG8_BAR; PG8_SCHED;
            PG8_LDA(At, 1, 1); PG8_STAGE(PG8_SB(1, 0), b3, voffB); PG8_STAGE(PG8_SB(1, 1), b3 + hstep, voffB); PG8_STAGE(PG8_SA(1, 0), a3, voffA);
            PG8_WAIT_V(8); PG8_WAIT_L(0); PG8_BAR; PG8_MMA(1, 0, At, B0); PG8_MMA(1, 1, At, B1); PG8_BAR; PG8_SCHED;
            } else {
            PG8_LDB(B0, 0, 0); PG8_SCHED; PG8_LDA(At, 0, 0); PG8_STAGE(PG8_SA(1, 1), a1 + hstep, voffA);
            PG8_WAIT_L(8); PG8_BAR; PG8_WAIT_L(0); PG8_MMA(0, 0, At, B0); PG8_BAR; PG8_SCHED;
            PG8_LDB(B1, 0, 1); PG8_STAGE(PG8_SB(0, 0), b2, voffB);
            PG8_BAR; PG8_WAIT_L(0); PG8_MMA(0, 1, At, B1); PG8_BAR;
            PG8_LDA(At, 0, 1); PG8_STAGE(PG8_SA(0, 0), a2, voffA);
            PG8_BAR; PG8_WAIT_L(0); PG8_MMA(1, 0, At, B0); PG8_BAR; PG8_SCHED;
            PG8_STAGE(PG8_SB(0, 1), b2 + hstep, voffB);
            PG8_WAIT_V(6); PG8_BAR; PG8_MMA(1, 1, At, B1); PG8_BAR;
            PG8_LDB(B0, 1, 0); PG8_SCHED; PG8_LDA(At, 1, 0); PG8_STAGE(PG8_SA(0, 1), a2 + hstep, voffA);
            PG8_WAIT_L(8); PG8_BAR; PG8_WAIT_L(0); PG8_MMA(0, 0, At, B0); PG8_BAR; PG8_SCHED;
            PG8_LDB(B1, 1, 1); PG8_STAGE(PG8_SB(1, 0), b3, voffB);
            PG8_BAR; PG8_WAIT_L(0); PG8_MMA(0, 1, At, B1); PG8_BAR;
            PG8_LDA(At, 1, 1); PG8_STAGE(PG8_SA(1, 0), a3, voffA);
            PG8_BAR; PG8_WAIT_L(0); PG8_MMA(1, 0, At, B0); PG8_BAR; PG8_SCHED;
            PG8_STAGE(PG8_SB(1, 1), b3 + hstep, voffB);
            PG8_WAIT_V(6); PG8_BAR; PG8_MMA(1, 1, At, B1); PG8_BAR;
            }
        }
        if constexpr (ALIGN_EPI) { if (wr == 0) PG8_BAR; }
        if constexpr (!Epi::AFTER_DRAIN) { E(acc, cur, wr, wc, fr, fq); S.done(cur); }
        if (!has_next) break;
#pragma unroll
        for (int a = 0; a < 2; ++a)
#pragma unroll
            for (int b = 0; b < 2; ++b)
#pragma unroll
                for (int m = 0; m < 4; ++m)
#pragma unroll
                    for (int n = 0; n < 2; ++n) acc[a][b][m][n] = (f32x4){0.f, 0.f, 0.f, 0.f};
        cur = nxt; cA = nA; cB = nB; ++ui;
        if constexpr (ALIGN_EPI) { if (wr == 1) PG8_BAR; }
    }
    PG8_WAIT_V(0);
    if constexpr (!ALIGN_EPI) { if (wr == 0) PG8_BAR; }
    PG8_BAR;
    if constexpr (Epi::AFTER_DRAIN) { E.fused(acc, cur, wr, wc, fr, fq, lds, wid, lane); S.done(cur); }
#undef PG8_SA
#undef PG8_SB
#undef PG8_STAGE
#undef PG8_LDA
#undef PG8_LDB
#undef PG8_MMA
#undef PG8_WAIT_V
#undef PG8_WAIT_L
#undef PG8_BAR
#undef PG8_SCHED
}
}
constexpr int NWAVES = 8;
constexpr int T = 16384, SEQ = 8192, D = 1024, NIN = 2840, NINP = 3072, NQ = 2048;
constexpr int C_Q = 0, C_K = 256, C_V = 512, C_GLR = 1024, C_GOUT = 1040, C_Z = 1552, C_XBC = 2064, C_DT = 2832;
constexpr float EPS = 1e-6f;
constexpr size_t MiB = 1u << 20;
constexpr size_t WS_CTL = 0, CTL_ZERO_BYTES = 64 * 1024;
constexpr size_t WS_WIN = 1 * MiB;
constexpr size_t WS_WO = 7 * MiB;
constexpr size_t WS_WQ = 9 * MiB;
constexpr size_t WS_SUBK = 13 * MiB;
constexpr size_t WS_RRMS1 = 14 * MiB;
constexpr size_t WS_ROWSQ2 = 14 * MiB + 64 * 1024;
constexpr size_t WS_UB = 16 * MiB, WS_VB = 24 * MiB;
constexpr size_t WS_MIX = 32 * MiB;
constexpr size_t WS_XB = 80 * MiB;
constexpr size_t WS_PROJ = 112 * MiB;
constexpr int CW_TMO = 0, CW_BAR = 1024;
constexpr int RING_OFF = 0, RING_BYTES = 131072;
constexpr int LDS_BYTES = 163840;
constexpr int LDSCTL_OFF = LDS_BYTES - 1024, MISC_OFF = LDSCTL_OFF + 320;

#define GAS __attribute__((address_space(1)))
#define LAS __attribute__((address_space(3)))
typedef unsigned short bf16;
typedef unsigned v4u __attribute__((ext_vector_type(4)));
typedef float f32x4 __attribute__((ext_vector_type(4)));
typedef short bf16x8 __attribute__((ext_vector_type(8)));
typedef GAS unsigned gu32;
#define RLX_AGENT __ATOMIC_RELAXED, __HIP_MEMORY_SCOPE_AGENT
#define LDS_WAIT() asm volatile("s_waitcnt lgkmcnt(0)" ::: "memory")
#define VM_WAIT() asm volatile("s_waitcnt vmcnt(0)" ::: "memory")
typedef float f32x2c __attribute__((ext_vector_type(2)));
typedef __bf16 bf16x2c __attribute__((ext_vector_type(2)));
__device__ __forceinline__ unsigned f2bf(float f) { const __bf16 b = (__bf16)f; return (unsigned)__builtin_bit_cast(unsigned short, b); }
__device__ __forceinline__ unsigned pk2(float lo, float hi) { const bf16x2c v = __builtin_convertvector((f32x2c){lo, hi}, bf16x2c); return __builtin_bit_cast(unsigned, v); }
__device__ __forceinline__ float bf2f(unsigned short b) { return __builtin_bit_cast(float, (unsigned)b << 16); }
__device__ __forceinline__ float wave_sum(float v) {
#pragma unroll
    for (int o = 1; o < 64; o <<= 1) v += __shfl_xor(v, o);
    return v;
}
#define XB_TMO      128
#define XB_XCNT(j)  (256  + 64 * (j))
#define XB_XSUB(j)  (1280 + 64 * (j))
#define XB_XGEN(j)  (2304 + 64 * (j))
#define XB_TOP      3328
#define XB_TOPGEN   3392
#define XCD_BAR_WORDS 3456
#define XB_SPIN_CAP (1u << 18)

__device__ __forceinline__ unsigned xb_ld(unsigned* p)              { return __hip_atomic_load(p, __ATOMIC_RELAXED, __HIP_MEMORY_SCOPE_AGENT); }
__device__ __forceinline__ unsigned xb_add(unsigned* p, unsigned v) { return __hip_atomic_fetch_add(p, v, __ATOMIC_RELAXED, __HIP_MEMORY_SCOPE_AGENT); }
__device__ __forceinline__ unsigned xb_xcc_id() { return (unsigned)__builtin_amdgcn_s_getreg((3 << 11) | 20) & 0xFu; }
#define XB_SPIN(cond, bar) do { unsigned _sp = 0; while (cond) { __builtin_amdgcn_s_sleep(1); \
    if ((++_sp & 255u) == 0u) { if (xb_ld(&(bar)[XB_TMO])) break; if (_sp > XB_SPIN_CAP) { atomicAdd(&(bar)[XB_TMO], 1u); break; } } } } while (0)

struct XcdBarrier {
    unsigned* bar; unsigned x;
    volatile LAS unsigned* st;
};

__device__ __forceinline__ XcdBarrier xcd_barrier_post(unsigned* bar, volatile LAS unsigned* st) {
    XcdBarrier b; b.bar = bar; b.x = xb_xcc_id(); b.st = st;
    if (threadIdx.x == 0) (void)xb_add(&bar[XB_XCNT(b.x)], 1u);
    return b;
}
__device__ __forceinline__ void xcd_barrier_complete(unsigned* bar, unsigned x, unsigned& nloc, unsigned& nx) {
    const unsigned G = gridDim.x * gridDim.y * gridDim.z;
    unsigned sum, cnt, mine, sp = 0u;
    for (;;) {
        sum = 0u; cnt = 0u; mine = 0u;
#pragma unroll
        for (unsigned j = 0; j < 16; ++j) { const unsigned c = xb_ld(&bar[XB_XCNT(j)]); sum += c; cnt += (c > 0u) ? 1u : 0u; mine = (j == x) ? c : mine; }
        if (sum == G) break;
        __builtin_amdgcn_s_sleep(1);
        if ((++sp & 255u) == 0u) { if (xb_ld(&bar[XB_TMO])) break; if (sp > XB_SPIN_CAP) { atomicAdd(&bar[XB_TMO], 1u); break; } }
    }
    nloc = mine > 0u ? mine : 1u; nx = cnt > 0u ? cnt : 1u;
}

__device__ __forceinline__ void xcd_barrier(const XcdBarrier& b) {
    asm volatile("s_waitcnt vmcnt(0)" ::: "memory");
    __syncthreads();
    if (threadIdx.x == 0) {
        unsigned* bar = b.bar;
        __builtin_amdgcn_s_waitcnt(0);
        unsigned nloc = b.st[0], nx = b.st[1];
        if (nloc == 0u) { xcd_barrier_complete(bar, b.x, nloc, nx); b.st[0] = nloc; b.st[1] = nx; }
        const unsigned old = xb_add(&bar[XB_XSUB(b.x)], 1u);
        const unsigned gen = old / nloc;
        if (old + 1u == (gen + 1u) * nloc) {
            __builtin_amdgcn_fence(__ATOMIC_RELEASE, "agent");
            asm volatile("s_waitcnt vmcnt(0)" ::: "memory");
            const unsigned og = xb_add(&bar[XB_TOP], 1u);
            const unsigned tg = og / nx;
            if (og + 1u == (tg + 1u) * nx) xb_add(&bar[XB_TOPGEN], 1u);
            else XB_SPIN(xb_ld(&bar[XB_TOPGEN]) == tg, bar);
            __builtin_amdgcn_fence(__ATOMIC_ACQUIRE, "agent");
            xb_add(&bar[XB_XGEN(b.x)], 1u);
            asm volatile("s_waitcnt vmcnt(0)" ::: "memory");
        } else {
            XB_SPIN(xb_ld(&bar[XB_XGEN(b.x)]) == gen, bar);
            __builtin_amdgcn_fence(__ATOMIC_ACQUIRE, "agent");
            asm volatile("s_waitcnt vmcnt(0)" ::: "memory");
        }
    }
    __syncthreads();
}
struct Args {
    const float* in[19]; float* out; unsigned char* ws; int ph_lo, ph_hi;
};
struct Frame {
    LAS unsigned char* lds; volatile LAS unsigned* MISC; gu32* ctl;
    int tid, lane, wave, G, gw, NGW;
};

constexpr size_t WS_GDEC = 14 * MiB + 128 * 1024;
constexpr size_t WS_SDEC = 14 * MiB + 512 * 1024;
constexpr size_t WS_GST = 208 * MiB;
constexpr size_t WS_SST = 224 * MiB;
constexpr int SA64 = 144, SA128 = 272, SA32 = 80, SXN = 528;

__device__ __forceinline__ float silu_f(float x) { return x * __builtin_amdgcn_rcpf(1.f + __expf(-x)); }
__device__ __forceinline__ float softplus_f(float x) { return fmaxf(x, 0.f) + __logf(1.f + __expf(-fabsf(x))); }
__device__ __forceinline__ float logsigmoid_f(float x) { return fminf(x, 0.f) - __logf(1.f + __expf(-fabsf(x))); }
typedef unsigned u32x2 __attribute__((ext_vector_type(2)));

__device__ __forceinline__ f32x4 mma16(const LAS unsigned char* A, int sa, const LAS unsigned char* Bt, int sb, int K, f32x4 acc, int r, int kg) {
    for (int k0 = 0; k0 < K; k0 += 32) {
        const bf16x8 a = *(const LAS bf16x8*)(A + r * sa + (k0 + 8 * kg) * 2);
        const bf16x8 b = *(const LAS bf16x8*)(Bt + r * sb + (k0 + 8 * kg) * 2);
        acc = __builtin_amdgcn_mfma_f32_16x16x32_bf16(a, b, acc, 0, 0, 0);
    }
    return acc;
}

__device__ __forceinline__ void unpack8f(const v4u x, float (&f)[8]) {
    f[0] = __builtin_bit_cast(float, x.x << 16); f[1] = __builtin_bit_cast(float, x.x & 0xffff0000u); f[2] = __builtin_bit_cast(float, x.y << 16); f[3] = __builtin_bit_cast(float, x.y & 0xffff0000u);
    f[4] = __builtin_bit_cast(float, x.z << 16); f[5] = __builtin_bit_cast(float, x.z & 0xffff0000u); f[6] = __builtin_bit_cast(float, x.w << 16); f[7] = __builtin_bit_cast(float, x.w & 0xffff0000u);
}
typedef short s16x4 __attribute__((ext_vector_type(4)));
template <int SB> __device__ __forceinline__ void tr_frag2(unsigned base, bf16x8& f0, bf16x8& f1) {
    s16x4 a, b, c, d;
    asm volatile("ds_read_b64_tr_b16 %0, %4\n\tds_read_b64_tr_b16 %1, %4 offset:%5\n\tds_read_b64_tr_b16 %2, %4 offset:%6\n\tds_read_b64_tr_b16 %3, %4 offset:%7\n\ts_waitcnt lgkmcnt(0)"
                 : "=&v"(a), "=&v"(b), "=&v"(c), "=&v"(d) : "v"(base), "i"(4 * SB), "i"(32 * SB), "i"(36 * SB) : "memory");
    f0 = __builtin_shufflevector(a, b, 0, 1, 2, 3, 4, 5, 6, 7); f1 = __builtin_shufflevector(c, d, 0, 1, 2, 3, 4, 5, 6, 7);
}
template <int SB> __device__ __forceinline__ void tr_frag4n(unsigned base, bf16x8& f0, bf16x8& f1, bf16x8& f2, bf16x8& f3) {
    s16x4 a0, b0, a1, b1, a2, b2, a3, b3;
    asm volatile("ds_read_b64_tr_b16 %0, %8\n\tds_read_b64_tr_b16 %1, %8 offset:%9\n\tds_read_b64_tr_b16 %2, %8 offset:32\n\tds_read_b64_tr_b16 %3, %8 offset:%10\n\t"
                 "ds_read_b64_tr_b16 %4, %8 offset:64\n\tds_read_b64_tr_b16 %5, %8 offset:%11\n\tds_read_b64_tr_b16 %6, %8 offset:96\n\tds_read_b64_tr_b16 %7, %8 offset:%12\n\ts_waitcnt lgkmcnt(0)"
                 : "=&v"(a0), "=&v"(b0), "=&v"(a1), "=&v"(b1), "=&v"(a2), "=&v"(b2), "=&v"(a3), "=&v"(b3)
                 : "v"(base), "i"(4 * SB), "i"(4 * SB + 32), "i"(4 * SB + 64), "i"(4 * SB + 96) : "memory");
    f0 = __builtin_shufflevector(a0, b0, 0, 1, 2, 3, 4, 5, 6, 7); f1 = __builtin_shufflevector(a1, b1, 0, 1, 2, 3, 4, 5, 6, 7);
    f2 = __builtin_shufflevector(a2, b2, 0, 1, 2, 3, 4, 5, 6, 7); f3 = __builtin_shufflevector(a3, b3, 0, 1, 2, 3, 4, 5, 6, 7);
}
template <int SB> __device__ __forceinline__ f32x4 mma16_trB64(const LAS unsigned char* A, int sa, unsigned bbase, int n0, f32x4 acc, int r, int kg) {
    bf16x8 b0, b1; tr_frag2<SB>(bbase + (unsigned)((8 * kg + (r >> 2)) * SB + (n0 + 4 * (r & 3)) * 2), b0, b1);
    const bf16x8 a0 = *(const LAS bf16x8*)(A + r * sa + (8 * kg) * 2), a1 = *(const LAS bf16x8*)(A + r * sa + (32 + 8 * kg) * 2);
    acc = __builtin_amdgcn_mfma_f32_16x16x32_bf16(a0, b0, acc, 0, 0, 0);
    return __builtin_amdgcn_mfma_f32_16x16x32_bf16(a1, b1, acc, 0, 0, 0);
}
template <int MODE>
__device__ __forceinline__ void gla_unit(const Frame& F, const Args& A, int unit) {
    const int b = unit >> 9, c = (unit >> 2) & 127, h = unit & 3;
    const size_t t0 = (size_t)b * SEQ + (size_t)c * 64;
    const GAS bf16* proj = (const GAS bf16*)(A.ws + WS_PROJ);
    LAS unsigned char* L = F.lds;
    LAS float* GLR = (LAS float*)(L + 0);
    LAS float* SEG = (LAS float*)(L + 4096);
    LAS float* RSQ = (LAS float*)(L + 6144);
    LAS unsigned char* QI = L + 8192;
    LAS unsigned char* KI = QI + 64 * SA64;
    LAS unsigned char* VT = KI + 64 * SA64;
    LAS unsigned char* SP = VT + 128 * SA64;
    LAS unsigned char* AT = SP + 128 * SA64;
    LAS unsigned char* GO = AT + 64 * SA64;
    int tid = F.tid, seg = F.wave;
    asm volatile("" : "+v"(tid)); asm volatile("" : "+s"(seg));
    const int d = tid & 63;
    {
        const int row = tid >> 3, ch = tid & 7;
        const GAS bf16* prow = proj + (t0 + row) * NINP;
        const v4u kq = *(const GAS v4u*)(prow + C_K + h * 64 + ch * 8);
        v4u qq = kq; if (MODE == 1) qq = *(const GAS v4u*)(prow + C_Q + h * 64 + ch * 8);
        const int o = tid & 15, jp = tid >> 4;
        const v4u va = *(const GAS v4u*)(proj + (t0 + 2 * jp) * NINP + C_V + h * 128 + o * 8), vb = *(const GAS v4u*)(proj + (t0 + 2 * jp + 1) * NINP + C_V + h * 128 + o * 8);
        v4u g0 = kq, g1 = kq, s0 = kq, s1 = kq;
        if (MODE == 1) {
            const int r2 = tid >> 4, c2 = tid & 15;
            g0 = *(const GAS v4u*)(proj + (t0 + r2) * NINP + C_GOUT + h * 128 + c2 * 8); g1 = *(const GAS v4u*)(proj + (t0 + r2 + 32) * NINP + C_GOUT + h * 128 + c2 * 8);
            const GAS bf16* sp = (const GAS bf16*)(A.ws + WS_GST) + (size_t)unit * 8192;
            s0 = *(const GAS v4u*)(sp + (tid >> 3) * 64 + (tid & 7) * 8); s1 = *(const GAS v4u*)(sp + (64 + (tid >> 3)) * 64 + (tid & 7) * 8);
        }
        v4u gl = kq; if (tid < 128) gl = *(const GAS v4u*)(proj + (t0 + (tid >> 1)) * NINP + C_GLR + (tid & 1) * 8);
        if (MODE == 1) { *(LAS v4u*)(QI + row * SA64 + ch * 16) = qq; *(LAS v4u*)(KI + row * SA64 + ch * 16) = kq; }
        else *(LAS v4u*)(GO + row * SA64 + ch * 16) = kq;
        *(LAS v4u*)(VT + (2 * jp) * SA128 + o * 16) = va; *(LAS v4u*)(VT + (2 * jp + 1) * SA128 + o * 16) = vb;
        if (MODE == 1) {
            const int r2 = tid >> 4, c2 = tid & 15;
            *(LAS v4u*)(GO + r2 * SA128 + c2 * 16) = g0; *(LAS v4u*)(GO + (r2 + 32) * SA128 + c2 * 16) = g1;
            *(LAS v4u*)(SP + (tid >> 3) * SA64 + (tid & 7) * 16) = s0; *(LAS v4u*)(SP + (64 + (tid >> 3)) * SA64 + (tid & 7) * 16) = s1;
        }
        if (tid < 128) { float f[8]; unpack8f(gl, f);
#pragma unroll
            for (int q = 0; q < 8; ++q) GLR[(tid >> 1) * 16 + (tid & 1) * 8 + q] = f[q]; }
    }
    float wv[16];
#pragma unroll
    for (int r = 0; r < 16; ++r) wv[r] = A.in[3][r * 256 + h * 64 + d];
    const float bgv = A.in[4][h * 64 + d];
    __syncthreads();
    float Gv[8]; float run = 0.f;
#pragma unroll
    for (int ii = 0; ii < 8; ++ii) { const int i = seg * 8 + ii; float z = bgv;
#pragma unroll
        for (int r = 0; r < 16; ++r) z += GLR[i * 16 + r] * wv[r];
        run += logsigmoid_f(z) * (1.f / 16.f); Gv[ii] = run; }
    SEG[seg * 64 + d] = run;
    __syncthreads();
    float off = 0.f, tot = 0.f;
#pragma unroll
    for (int s = 0; s < 8; ++s) { const float v = SEG[s * 64 + d]; tot += v; off += (s < seg) ? v : 0.f; }
#pragma unroll
    for (int ii = 0; ii < 8; ++ii) Gv[ii] += off;
    if (MODE == 0) {
        unsigned w[4];
#pragma unroll
        for (int ii = 0; ii < 8; ii += 2) {
            const float k0 = bf2f(*(const LAS bf16*)(GO + (seg * 8 + ii) * SA64 + d * 2)) * __expf(tot - Gv[ii]);
            const float k1 = bf2f(*(const LAS bf16*)(GO + (seg * 8 + ii + 1) * SA64 + d * 2)) * __expf(tot - Gv[ii + 1]);
            w[ii >> 1] = pk2(k0, k1); }
        *(LAS v4u*)(KI + d * SA64 + seg * 16) = (v4u){w[0], w[1], w[2], w[3]};
        if (seg == 0) ((GAS float*)(A.ws + WS_GDEC))[unit * 64 + d] = __expf(tot);
    } else {
#pragma unroll
        for (int ii = 0; ii < 8; ++ii) { const int i = seg * 8 + ii;
            LAS bf16* qp = (LAS bf16*)(QI + i * SA64 + d * 2); LAS bf16* kp = (LAS bf16*)(KI + i * SA64 + d * 2);
            *qp = (bf16)f2bf(bf2f(*qp) * 0.125f * __expf(Gv[ii])); *kp = (bf16)f2bf(bf2f(*kp) * __expf(-Gv[ii])); }
    }
    __syncthreads();
    const int r = tid & 15, kg = (tid >> 4) & 3, w = seg;
    const f32x4 zero = (f32x4){0.f, 0.f, 0.f, 0.f};
    if (MODE == 0) {
        const int mt = w & 3, nb = (w >> 2) * 4;
        GAS bf16* stT = (GAS bf16*)(A.ws + WS_GST) + (size_t)unit * 8192;
#pragma unroll
        for (int n = 0; n < 4; ++n) {
            const f32x4 acc = mma16_trB64<SA128>(KI + mt * 16 * SA64, SA64, (unsigned)(size_t)VT, (nb + n) * 16, zero, r, kg);
            const int dv = (nb + n) * 16 + r, d0 = mt * 16 + kg * 4;
            *(GAS u32x2*)(stT + dv * 64 + d0) = (u32x2){pk2(acc[0], acc[1]), pk2(acc[2], acc[3])}; }
    } else {
        const int mt = w & 3;
#pragma unroll
        for (int n = 0; n < 2; ++n) { const int nt = (w >> 2) * 2 + n;
            const f32x4 acc = mma16(QI + mt * 16 * SA64, SA64, KI + nt * 16 * SA64, SA64, 64, zero, r, kg);
#pragma unroll
            for (int ii = 0; ii < 4; ++ii) { const int i = mt * 16 + kg * 4 + ii, j = nt * 16 + r; *(LAS bf16*)(AT + i * SA64 + j * 2) = (bf16)f2bf(j <= i ? acc[ii] : 0.f); } }
        __syncthreads();
        const int nb = (w >> 2) * 4;
        f32x4 o[4]; float rs[4] = {0.f, 0.f, 0.f, 0.f};
#pragma unroll
        for (int n = 0; n < 4; ++n) {
            f32x4 acc = mma16_trB64<SA128>(AT + mt * 16 * SA64, SA64, (unsigned)(size_t)VT, (nb + n) * 16, zero, r, kg);
            acc = mma16(QI + mt * 16 * SA64, SA64, SP + (nb + n) * 16 * SA64, SA64, 64, acc, r, kg);
            o[n] = acc;
#pragma unroll
            for (int ii = 0; ii < 4; ++ii) rs[ii] += acc[ii] * acc[ii]; }
#pragma unroll
        for (int ii = 0; ii < 4; ++ii) { rs[ii] += __shfl_xor(rs[ii], 1); rs[ii] += __shfl_xor(rs[ii], 2); rs[ii] += __shfl_xor(rs[ii], 4); rs[ii] += __shfl_xor(rs[ii], 8); }
        if (r == 0) {
#pragma unroll
            for (int ii = 0; ii < 4; ++ii) RSQ[(w >> 2) * 64 + mt * 16 + kg * 4 + ii] = rs[ii]; }
        __syncthreads();
        float rr[4];
#pragma unroll
        for (int ii = 0; ii < 4; ++ii) { const int row = mt * 16 + kg * 4 + ii; rr[ii] = rsqrtf((RSQ[row] + RSQ[64 + row]) * (1.f / 128.f) + EPS); }
#pragma unroll
        for (int n = 0; n < 4; ++n) { const int dv = (nb + n) * 16 + r; const float nwv = A.in[5][dv];
#pragma unroll
            for (int ii = 0; ii < 4; ++ii) { LAS bf16* gp = (LAS bf16*)(GO + (mt * 16 + kg * 4 + ii) * SA128 + dv * 2);
                *gp = (bf16)f2bf(o[n][ii] * rr[ii] * nwv * silu_f(bf2f(*gp))); } }
        __syncthreads();
        {   const int r2 = tid >> 4, c2 = tid & 15; GAS bf16* mixed = (GAS bf16*)(A.ws + WS_MIX);
            *(GAS v4u*)(mixed + (t0 + r2) * D + h * 128 + c2 * 8) = *(const LAS v4u*)(GO + r2 * SA128 + c2 * 16);
            *(GAS v4u*)(mixed + (t0 + r2 + 32) * D + h * 128 + c2 * 8) = *(const LAS v4u*)(GO + (r2 + 32) * SA128 + c2 * 16); }
    }
    __syncthreads();
}

template <int MODE>
__device__ __forceinline__ void ssd_unit(const Frame& F, const Args& A, int unit) {
    const int b = unit >> 7, c = (unit >> 1) & 63, g = unit & 1;
    const size_t t0 = (size_t)b * SEQ + (size_t)c * 128;
    const GAS bf16* proj = (const GAS bf16*)(A.ws + WS_PROJ);
    LAS unsigned char* L = F.lds;
    LAS float* DT = (LAS float*)(L + 0);
    LAS float* ACU = (LAS float*)(L + 2048);
    LAS unsigned char* CM = L + 4096;
    LAS unsigned char* BM = CM + 128 * SA64;
    LAS unsigned char* XT = BM + 128 * SA64;
    LAS unsigned char* PW = XT + 128 * SXN;
    LAS unsigned char* ZW = PW + 8 * 16 * SA32;
    LAS float* RRW = (LAS float*)(ZW + 8 * 16 * SA64);
    int tid = F.tid, w = F.wave;
    asm volatile("" : "+v"(tid)); asm volatile("" : "+s"(w));
    const int lane = tid & 63;
    if (w < 4) {
        const int hd = g * 4 + w; const float Ah = -__expf(A.in[9][hd]), dtb = A.in[8][hd];
        const float dt0 = softplus_f(bf2f(proj[(t0 + 2 * lane) * NINP + C_DT + hd]) + dtb), dt1 = softplus_f(bf2f(proj[(t0 + 2 * lane + 1) * NINP + C_DT + hd]) + dtb);
        const float a0 = dt0 * Ah, a1 = dt1 * Ah; float s = a0 + a1;
#pragma unroll
        for (int o = 1; o < 64; o <<= 1) { const float t = __shfl_up(s, o); s += (lane >= o) ? t : 0.f; }
        DT[(2 * lane) * 4 + w] = dt0; DT[(2 * lane + 1) * 4 + w] = dt1; ACU[(2 * lane) * 4 + w] = s - a1; ACU[(2 * lane + 1) * 4 + w] = s;
        if (MODE == 0 && lane == 63) ((GAS float*)(A.ws + WS_SDEC))[(b * 64 + c) * 8 + hd] = __expf(s);
    }
    __syncthreads();
    if (tid < 384) {
        const int o = tid % 48, sg = tid / 48;
        if (!(MODE == 0 && o >= 40)) {
            const int cc0 = o < 32 ? g * 256 + 8 * o : (o < 40 ? 512 + g * 64 + 8 * (o - 32) : 640 + g * 64 + 8 * (o - 40));
            float wt[4][8], cb[8];
#pragma unroll
            for (int j = 0; j < 4; ++j) { const f32x4 a = *(const GAS f32x4*)(A.in[6] + j * 768 + cc0), bq = *(const GAS f32x4*)(A.in[6] + j * 768 + cc0 + 4);
                wt[j][0] = a.x; wt[j][1] = a.y; wt[j][2] = a.z; wt[j][3] = a.w; wt[j][4] = bq.x; wt[j][5] = bq.y; wt[j][6] = bq.z; wt[j][7] = bq.w; }
            { const f32x4 a = *(const GAS f32x4*)(A.in[7] + cc0), bq = *(const GAS f32x4*)(A.in[7] + cc0 + 4); cb[0] = a.x; cb[1] = a.y; cb[2] = a.z; cb[3] = a.w; cb[4] = bq.x; cb[5] = bq.y; cb[6] = bq.z; cb[7] = bq.w; }
            const GAS bf16* src = proj + (t0 + 16 * sg) * NINP + C_XBC + cc0;
            float x0[8], x1[8], x2[8];
            if (c > 0 || sg > 0) { unpack8f(*(const GAS v4u*)(src - 3 * NINP), x0); unpack8f(*(const GAS v4u*)(src - 2 * NINP), x1); unpack8f(*(const GAS v4u*)(src - 1 * NINP), x2); }
            else {
#pragma unroll
                for (int q = 0; q < 8; ++q) { x0[q] = 0.f; x1[q] = 0.f; x2[q] = 0.f; } }
            const int hl = o >> 3, p0 = (o & 7) * 8;
            float sc_end = 0.f; if (MODE == 0 && o < 32) sc_end = ACU[127 * 4 + hl];
#pragma unroll 1
            for (int hf = 0; hf < 2; ++hf) {
                v4u xin[8];
#pragma unroll
                for (int i = 0; i < 8; ++i) xin[i] = *(const GAS v4u*)(src + (size_t)(hf * 8 + i) * NINP);
#pragma unroll
                for (int i = 0; i < 8; ++i) {
                    const int l = 16 * sg + hf * 8 + i;
                    float xc[8]; unpack8f(xin[i], xc);
                    float v[8];
#pragma unroll
                    for (int q = 0; q < 8; ++q) v[q] = silu_f(cb[q] + wt[0][q] * x0[q] + wt[1][q] * x1[q] + wt[2][q] * x2[q] + wt[3][q] * xc[q]);
#pragma unroll
                    for (int q = 0; q < 8; ++q) { x0[q] = x1[q]; x1[q] = x2[q]; x2[q] = xc[q]; }
                    if (MODE == 0 && o < 32) { const float sc = DT[l * 4 + hl] * __expf(sc_end - ACU[l * 4 + hl]);
#pragma unroll
                        for (int q = 0; q < 8; ++q) v[q] *= sc; }
                    const v4u ov = (v4u){pk2(v[0], v[1]), pk2(v[2], v[3]), pk2(v[4], v[5]), pk2(v[6], v[7])};
                    if (o < 32) *(LAS v4u*)(XT + l * SXN + o * 16) = ov;
                    else *(LAS v4u*)((o < 40 ? BM : CM) + l * SA64 + (o & 7) * 16) = ov;
                }
            }
        }
    }
    __syncthreads();
    const int r = lane & 15, kg = lane >> 4;
    const f32x4 zero = (f32x4){0.f, 0.f, 0.f, 0.f};
    if (MODE == 0) {
        const int hl = w >> 1;
        GAS bf16* st = (GAS bf16*)(A.ws + WS_SST) + ((size_t)((b * 64 + c) * 8 + g * 4 + hl)) * 4096;
#pragma unroll
        for (int mt = 0; mt < 4; ++mt)
#pragma unroll
            for (int n = 0; n < 2; ++n) { const int nt = (w & 1) * 2 + n;
                f32x4 acc = zero;
#pragma unroll
                for (int kh = 0; kh < 2; ++kh) {
                    bf16x8 a0, a1, b0, b1;
                    tr_frag2<SA64>((unsigned)(size_t)BM + (unsigned)((64 * kh + 8 * kg + (r >> 2)) * SA64 + (mt * 16 + 4 * (r & 3)) * 2), a0, a1);
                    tr_frag2<SXN>((unsigned)(size_t)XT + (unsigned)((64 * kh + 8 * kg + (r >> 2)) * SXN + (hl * 64 + nt * 16 + 4 * (r & 3)) * 2), b0, b1);
                    acc = __builtin_amdgcn_mfma_f32_16x16x32_bf16(a0, b0, acc, 0, 0, 0); acc = __builtin_amdgcn_mfma_f32_16x16x32_bf16(a1, b1, acc, 0, 0, 0); }
                const int p = nt * 16 + r, n0 = mt * 16 + kg * 4;
                *(GAS u32x2*)(st + p * 64 + n0) = (u32x2){pk2(acc[0], acc[1]), pk2(acc[2], acc[3])}; }
    } else {
        f32x4 sc[8];
#pragma unroll
        for (int nt = 0; nt < 8; ++nt) { sc[nt] = zero; if (nt <= w) sc[nt] = mma16(CM + w * 16 * SA64, SA64, BM + nt * 16 * SA64, SA64, 64, zero, r, kg); }
        __syncthreads();
        const GAS bf16* spg = (const GAS bf16*)(A.ws + WS_SST) + ((size_t)((b * 64 + c) * 8 + g * 4)) * 4096;
        for (int e = tid; e < 1024; e += 512) { const int row = e >> 3, ch = e & 7; *(LAS v4u*)(BM + row * SA64 + ch * 16) = *(const GAS v4u*)(spg + row * 64 + ch * 8); }
        __syncthreads();
        float rs[4] = {0.f, 0.f, 0.f, 0.f};
        LAS unsigned char* pw = PW + w * 16 * SA32;
        LAS unsigned char* zw = ZW + w * 16 * SA64;
        const int orow = lane >> 3, och = lane & 7;
        const GAS bf16* zsrc = proj + (t0 + w * 16 + orow) * NINP + C_Z + g * 256 + och * 8;
        v4u ysave[4][2];
#pragma unroll
        for (int hl = 0; hl < 4; ++hl) {
            if (hl == 2) {
                __syncthreads();
                for (int e = tid; e < 1024; e += 512) { const int row = e >> 3, ch = e & 7; *(LAS v4u*)(BM + row * SA64 + ch * 16) = *(const GAS v4u*)(spg + 2 * 4096 + row * 64 + ch * 8); }
                __syncthreads();
            }
            asm volatile("" ::: "memory");
            const v4u z0 = *(const GAS v4u*)(zsrc + hl * 64), z1 = *(const GAS v4u*)(zsrc + (size_t)8 * NINP + hl * 64);
            float acl[4];
#pragma unroll
            for (int ii = 0; ii < 4; ++ii) acl[ii] = ACU[(w * 16 + kg * 4 + ii) * 4 + hl];
            f32x4 yd[4] = {zero, zero, zero, zero};
#pragma unroll
            for (int kc = 0; kc < 4; ++kc) {
                if (kc * 2 <= w) {
#pragma unroll
                    for (int half = 0; half < 2; ++half) { const int stl = 2 * kc + half; const int s = stl * 16 + r;
                        const float acs = ACU[s * 4 + hl], dts = DT[s * 4 + hl];
#pragma unroll
                        for (int ii = 0; ii < 4; ++ii) { const int l = w * 16 + kg * 4 + ii;
                            const float pv = (s <= l) ? sc[stl][ii] * __expf(acl[ii] - acs) * dts : 0.f;
                            *(LAS bf16*)(pw + (kg * 4 + ii) * SA32 + (half * 16 + r) * 2) = (bf16)f2bf(pv); } }
                    LDS_WAIT();
                    const bf16x8 a = *(const LAS bf16x8*)(pw + r * SA32 + kg * 16);
                    bf16x8 bb[4];
                    tr_frag4n<SXN>((unsigned)(size_t)XT + (unsigned)((kc * 32 + 8 * kg + (r >> 2)) * SXN + (hl * 64 + 4 * (r & 3)) * 2), bb[0], bb[1], bb[2], bb[3]);
#pragma unroll
                    for (int nt = 0; nt < 4; ++nt) yd[nt] = __builtin_amdgcn_mfma_f32_16x16x32_bf16(a, bb[nt], yd[nt], 0, 0, 0);
                    LDS_WAIT();
                }
            }
            *(LAS v4u*)(zw + orow * SA64 + och * 16) = z0; *(LAS v4u*)(zw + (orow + 8) * SA64 + och * 16) = z1;
            LDS_WAIT();
            const float Dk = A.in[10][g * 4 + hl];
            float eal[4];
#pragma unroll
            for (int ii = 0; ii < 4; ++ii) eal[ii] = __expf(acl[ii]);
#pragma unroll
            for (int nt = 0; nt < 4; ++nt) {
                const f32x4 yo = mma16(CM + w * 16 * SA64, SA64, BM + (hl & 1) * 64 * SA64 + nt * 16 * SA64, SA64, 64, zero, r, kg);
                const int p = nt * 16 + r;
#pragma unroll
                for (int ii = 0; ii < 4; ++ii) { const int l = w * 16 + kg * 4 + ii;
                    const float xv = bf2f(*(const LAS bf16*)(XT + l * SXN + (hl * 64 + p) * 2));
                    LAS bf16* zp = (LAS bf16*)(zw + (kg * 4 + ii) * SA64 + p * 2);
                    const float y = (yd[nt][ii] + eal[ii] * yo[ii] + xv * Dk) * silu_f(bf2f(*zp));
                    const unsigned short yb = (unsigned short)f2bf(y); const float yq = bf2f(yb);
                    rs[ii] += yq * yq;
                    *zp = yb; }
            }
            LDS_WAIT();
            ysave[hl][0] = *(const LAS v4u*)(zw + orow * SA64 + och * 16); ysave[hl][1] = *(const LAS v4u*)(zw + (orow + 8) * SA64 + och * 16);
            LDS_WAIT();
        }
#pragma unroll
        for (int ii = 0; ii < 4; ++ii) { rs[ii] += __shfl_xor(rs[ii], 1); rs[ii] += __shfl_xor(rs[ii], 2); rs[ii] += __shfl_xor(rs[ii], 4); rs[ii] += __shfl_xor(rs[ii], 8);
            rs[ii] = rsqrtf(rs[ii] * (1.f / 256.f) + EPS); }
        if (r == 0) {
#pragma unroll
            for (int ii = 0; ii < 4; ++ii) RRW[w * 16 + kg * 4 + ii] = rs[ii]; }
        LDS_WAIT();
        const float rr0 = RRW[w * 16 + orow], rr1 = RRW[w * 16 + orow + 8];
        GAS bf16* mdst = (GAS bf16*)(A.ws + WS_MIX) + (t0 + w * 16 + orow) * D + 512 + g * 256 + och * 8;
#pragma unroll
        for (int hl = 0; hl < 4; ++hl) {
            const f32x4 nwa = *(const GAS f32x4*)(A.in[11] + g * 256 + hl * 64 + och * 8), nwb = *(const GAS f32x4*)(A.in[11] + g * 256 + hl * 64 + och * 8 + 4);
            const float nw8[8] = {nwa.x, nwa.y, nwa.z, nwa.w, nwb.x, nwb.y, nwb.z, nwb.w};
#pragma unroll
            for (int hh = 0; hh < 2; ++hh) { float f[8]; unpack8f(ysave[hl][hh], f); const float rr_ = hh ? rr1 : rr0;
#pragma unroll
                for (int q = 0; q < 8; ++q) f[q] *= rr_ * nw8[q];
                *(GAS v4u*)(mdst + (size_t)(8 * hh) * D + hl * 64) = (v4u){pk2(f[0], f[1]), pk2(f[2], f[3]), pk2(f[4], f[5]), pk2(f[6], f[7])}; }
        }
    }
    __syncthreads();
}

template <bool DRY> __device__ __forceinline__ void scan_phase(const Frame& F, const Args& A) {
    if (F.tid < 128) {
        GAS unsigned* st = (GAS unsigned*)(A.ws + WS_GST); const GAS float* dec = (const GAS float*)(A.ws + WS_GDEC);
        for (int gi = blockIdx.x * 128 + F.tid; gi < 8 * 4096; gi += F.G * 128) {
            const int bh = gi >> 12, e = gi & 4095, b = bh >> 2, h = bh & 3, d = (e & 31) * 2;
            float S0 = 0.f, S1 = 0.f;
#pragma unroll 1
            for (int c = 0; c < 128; c += 16) {
                unsigned v[16]; float d0[16], d1[16];
#pragma unroll
                for (int u = 0; u < 16; ++u) { const size_t un = (size_t)((b * 128 + c + u) * 4 + h); v[u] = st[un * 4096 + e]; d0[u] = dec[un * 64 + d]; d1[u] = dec[un * 64 + d + 1]; }
#pragma unroll
                for (int u = 0; u < 16; ++u) { const size_t un = (size_t)((b * 128 + c + u) * 4 + h); (DRY ? (GAS unsigned*)(A.ws + 232 * MiB) : st)[un * 4096 + e] = pk2(S0, S1);
                    S0 = d0[u] * S0 + bf2f((unsigned short)(v[u] & 0xffffu)); S1 = d1[u] * S1 + bf2f((unsigned short)(v[u] >> 16)); }
            }
        }
    } else if (F.tid < 256) {
        GAS unsigned* st = (GAS unsigned*)(A.ws + WS_SST); const GAS float* dec = (const GAS float*)(A.ws + WS_SDEC);
        for (int gi = blockIdx.x * 128 + (F.tid - 128); gi < 16 * 2048; gi += F.G * 128) {
            const int bh = gi >> 11, e = gi & 2047, b = bh >> 3, hd = bh & 7;
            float S0 = 0.f, S1 = 0.f;
#pragma unroll 1
            for (int c = 0; c < 64; c += 16) {
                unsigned v[16]; float dd[16];
#pragma unroll
                for (int u = 0; u < 16; ++u) { const size_t un = (size_t)((b * 64 + c + u) * 8 + hd); v[u] = st[un * 2048 + e]; dd[u] = dec[un]; }
#pragma unroll
                for (int u = 0; u < 16; ++u) { const size_t un = (size_t)((b * 64 + c + u) * 8 + hd); (DRY ? (GAS unsigned*)(A.ws + 248 * MiB) : st)[un * 2048 + e] = pk2(S0, S1);
                    S0 = dd[u] * S0 + bf2f((unsigned short)(v[u] & 0xffffu)); S1 = dd[u] * S1 + bf2f((unsigned short)(v[u] >> 16)); }
            }
        }
    }
}
constexpr size_t WS_HB = WS_PROJ;
constexpr size_t WS_Q = 144 * MiB;
constexpr size_t WS_IDX = 232 * MiB;
constexpr size_t WS_GATE = 240 * MiB;
typedef float f32x16 __attribute__((ext_vector_type(16)));
__device__ __forceinline__ float as_f(unsigned u) { return __builtin_bit_cast(float, u); }
__device__ __forceinline__ unsigned as_u(float f) { return __builtin_bit_cast(unsigned, f); }
#define CE_DESC(a, b) do { const float hi_ = fmaxf((a), (b)), lo_ = fminf((a), (b)); (a) = hi_; (b) = lo_; } while (0)
template <int OFF, int N> __device__ __forceinline__ void sort16_desc(float (&v)[N]) {
#pragma unroll
    for (int k = 2; k <= 16; k <<= 1)
#pragma unroll
        for (int j = k >> 1; j > 0; j >>= 1)
#pragma unroll
            for (int i = 0; i < 16; ++i) { const int l = i ^ j; if (l > i) { if ((i & k) == 0) CE_DESC(v[OFF + i], v[OFF + l]); else CE_DESC(v[OFF + l], v[OFF + i]); } }
}
template <int OA, int OB, int NA, int NB> __device__ __forceinline__ void merge16_desc(float (&a)[NA], const float (&b)[NB]) {
#pragma unroll
    for (int i = 0; i < 16; ++i) a[OA + i] = fmaxf(a[OA + i], b[OB + 15 - i]);
#pragma unroll
    for (int j = 8; j > 0; j >>= 1)
#pragma unroll
        for (int i = 0; i < 16; ++i) { const int l = i ^ j; if (l > i) CE_DESC(a[OA + i], a[OA + l]); }
}
constexpr unsigned char CAND0[32] = {0, 2, 4, 6, 8, 10, 12, 14, 16, 18, 20, 22, 32, 34, 36, 49, 51, 65, 80, 96, 112, 128, 160, 192, 224, 255, 255, 255, 255, 255, 255, 255};
constexpr unsigned char CAND1[32] = {1, 3, 5, 7, 9, 11, 13, 15, 17, 19, 21, 23, 33, 35, 48, 50, 64, 66, 81, 97, 113, 144, 176, 208, 240, 255, 255, 255, 255, 255, 255, 255};

__device__ __forceinline__ void topk_wave_job(const Args& A, const LAS unsigned char* SK, LAS unsigned char* TAB, int tok0, int h, int lane) {
    const int r = lane & 31, hi = lane >> 5;
    const GAS bf16* qrow = (const GAS bf16*)(A.ws + WS_Q) + (size_t)(tok0 + r) * NQ + h * 256 + 8 * hi;
    float LST[2][16];
#pragma unroll
    for (int p = 0; p < 2; ++p) {
        __builtin_amdgcn_sched_barrier(0);
        bf16x8 bq[8];
#pragma unroll
        for (int s = 0; s < 8; ++s) bq[s] = *(const GAS bf16x8*)(qrow + p * 128 + 16 * s);
        float v[64];
#pragma unroll
        for (int kt = 0; kt < 4; ++kt) {
            f32x16 acc;
#pragma unroll
            for (int i = 0; i < 16; ++i) acc[i] = 0.f;
#pragma unroll
            for (int s = 0; s < 8; ++s) { const bf16x8 a = *(const LAS bf16x8*)(SK + (p * 128 + kt * 32 + r) * SA128 + (16 * s + 8 * hi) * 2);
                acc = __builtin_amdgcn_mfma_f32_32x32x16_bf16(a, bq[s], acc, 0, 0, 0); }
#pragma unroll
            for (int i = 0; i < 16; ++i) { const unsigned key = (unsigned)(kt * 32 + (i & 3) + 8 * (i >> 2)) | ((unsigned)hi << 2); v[kt * 16 + i] = as_f((as_u(acc[i]) & ~127u) | key); }
        }
        sort16_desc<0>(v); sort16_desc<16>(v); sort16_desc<32>(v); sort16_desc<48>(v);
        merge16_desc<0, 16>(v, v); merge16_desc<32, 48>(v, v); merge16_desc<0, 32>(v, v);
        float o[16];
#pragma unroll
        for (int i = 0; i < 16; ++i) o[i] = __shfl_xor(v[i], 32);
        merge16_desc<0, 0>(v, o);
#pragma unroll
        for (int i = 0; i < 16; ++i) LST[p][i] = v[i];
    }
    __builtin_amdgcn_sched_barrier(0);
    {   unsigned pk[4];
#pragma unroll
        for (int q4 = 0; q4 < 4; ++q4) { unsigned wv = 0;
#pragma unroll
            for (int b = 0; b < 4; ++b) { float l0 = LST[0][q4 * 4 + b], l1 = LST[1][q4 * 4 + b]; asm volatile("" : "+v"(l0), "+v"(l1));
                const unsigned x = as_u(hi ? l1 : l0) & 127u; wv |= x << (8 * b); }
            pk[q4] = wv; }
        *(LAS v4u*)(TAB + r * 32 + hi * 16) = (v4u){pk[0], pk[1], pk[2], pk[3]};
    }
    float c[32];
    float va[16], vb2[16];
#pragma unroll
    for (int i = 0; i < 16; ++i) { va[i] = as_f(as_u(LST[0][i]) & ~127u); vb2[i] = as_f(as_u(LST[1][i]) & ~127u); }
#define CANDV(i0, j0, k0, i1, j1, k1) as_f((as_u(hi ? (va[i1] + vb2[j1]) : (va[i0] + vb2[j0])) & ~255u) | (hi ? (k1) : (k0)))
    c[0] = CANDV(0, 0, 0u, 0, 1, 1u);
    c[1] = CANDV(0, 2, 2u, 0, 3, 3u);
    c[2] = CANDV(0, 4, 4u, 0, 5, 5u);
    c[3] = CANDV(0, 6, 6u, 0, 7, 7u);
    c[4] = CANDV(0, 8, 8u, 0, 9, 9u);
    c[5] = CANDV(0, 10, 10u, 0, 11, 11u);
    c[6] = CANDV(0, 12, 12u, 0, 13, 13u);
    c[7] = CANDV(0, 14, 14u, 0, 15, 15u);
    c[8] = CANDV(1, 0, 16u, 1, 1, 17u);
    c[9] = CANDV(1, 2, 18u, 1, 3, 19u);
    c[10] = CANDV(1, 4, 20u, 1, 5, 21u);
    c[11] = CANDV(1, 6, 22u, 1, 7, 23u);
    c[12] = CANDV(2, 0, 32u, 2, 1, 33u);
    c[13] = CANDV(2, 2, 34u, 2, 3, 35u);
    c[14] = CANDV(2, 4, 36u, 3, 0, 48u);
    c[15] = CANDV(3, 1, 49u, 3, 2, 50u);
    c[16] = CANDV(3, 3, 51u, 4, 0, 64u);
    c[17] = CANDV(4, 1, 65u, 4, 2, 66u);
    c[18] = CANDV(5, 0, 80u, 5, 1, 81u);
    c[19] = CANDV(6, 0, 96u, 6, 1, 97u);
    c[20] = CANDV(7, 0, 112u, 7, 1, 113u);
    c[21] = CANDV(8, 0, 128u, 9, 0, 144u);
    c[22] = CANDV(10, 0, 160u, 11, 0, 176u);
    c[23] = CANDV(12, 0, 192u, 13, 0, 208u);
    c[24] = CANDV(14, 0, 224u, 15, 0, 240u);
    c[25] = as_f(0xFF61B1E6u | 255u);
    c[26] = as_f(0xFF61B1E6u | 255u);
    c[27] = as_f(0xFF61B1E6u | 255u);
    c[28] = as_f(0xFF61B1E6u | 255u);
    c[29] = as_f(0xFF61B1E6u | 255u);
    c[30] = as_f(0xFF61B1E6u | 255u);
    c[31] = as_f(0xFF61B1E6u | 255u);
#undef CANDV
    sort16_desc<0>(c); sort16_desc<16>(c); merge16_desc<0, 16>(c, c);
    {   float o[16];
#pragma unroll
        for (int i = 0; i < 16; ++i) o[i] = __shfl_xor(c[i], 32);
        merge16_desc<0, 0>(c, o); }
    const float mx = as_f(as_u(c[0]) & ~255u);
    float ex[16], den = 0.f;
#pragma unroll
    for (int k = 0; k < 16; ++k) { ex[k] = __expf(as_f(as_u(c[k]) & ~255u) - mx); den += ex[k]; }
    const float inv = 1.f / den;
    LDS_WAIT();
    unsigned eid[8]; float gv[8];
#pragma unroll
    for (int k = 0; k < 8; ++k) { float ca = c[k], cb = c[k + 8], ea = ex[k], eb = ex[k + 8]; asm volatile("" : "+v"(ca), "+v"(cb), "+v"(ea), "+v"(eb));
        const unsigned code = as_u(hi ? cb : ca) & 255u; gv[k] = (hi ? eb : ea) * inv;
        const unsigned ia = *(const LAS unsigned char*)(TAB + r * 32 + (code >> 4)), ib = *(const LAS unsigned char*)(TAB + r * 32 + 16 + (code & 15));
        eid[k] = ia * 128u + ib; }
    GAS unsigned* ip = (GAS unsigned*)(A.ws + WS_IDX) + (size_t)(tok0 + r) * 128 + h * 16 + 8 * hi;
    GAS float* gp = (GAS float*)(A.ws + WS_GATE) + (size_t)(tok0 + r) * 128 + h * 16 + 8 * hi;
    *(GAS v4u*)ip = (v4u){eid[0], eid[1], eid[2], eid[3]}; *(GAS v4u*)(ip + 4) = (v4u){eid[4], eid[5], eid[6], eid[7]};
    *(GAS f32x4*)gp = (f32x4){gv[0], gv[1], gv[2], gv[3]}; *(GAS f32x4*)(gp + 4) = (f32x4){gv[4], gv[5], gv[6], gv[7]};
    LDS_WAIT();
}
__device__ __forceinline__ void topk_phase(const Frame& F, const Args& A) {
    LAS unsigned char* SK = F.lds;
    LAS unsigned char* TABS = F.lds + 256 * SA128;
    for (int unit = blockIdx.x; unit < 256; unit += F.G) {
        int tid = F.tid, w = F.wave;
        asm volatile("" : "+v"(tid)); asm volatile("" : "+s"(w));
        const int h = unit & 7, tb = (unit >> 3) * 512;
        const GAS bf16* sk = (const GAS bf16*)(A.ws + WS_SUBK) + (size_t)h * 2 * 128 * 128;
        for (int e = tid; e < 256 * 16; e += 512) { const int row = e >> 4, ch = e & 15; *(LAS v4u*)(SK + row * SA128 + ch * 16) = *(const GAS v4u*)(sk + row * 128 + ch * 8); }
        __syncthreads();
#pragma unroll 1
        for (int tt = 0; tt < 2; ++tt) topk_wave_job(A, SK, TABS + w * 1024, tb + (w * 2 + tt) * 32, h, tid & 63);
        __syncthreads();
    }
}

__device__ __forceinline__ float gelu_f(float v) {
    const float av = fabsf(v), t = __builtin_amdgcn_rcpf(av * 0.2316418882f + 1.0f);
    float q = t * 0.5307027145f + (-0.7265760135f); q = q * t + 0.7107068705f; q = q * t + (-0.142248368f); q = q * t + 0.127414796f; q = q * t;
    const float m = v * (q * __builtin_amdgcn_exp2f((v * v) * (-0.72134752044f)));
    return v < 0.f ? m : v - m;
}
__device__ __forceinline__ void unpack8(const v4u x, float (&f)[8]) {
    f[0] = as_f(x.x << 16); f[1] = as_f(x.x & 0xffff0000u); f[2] = as_f(x.y << 16); f[3] = as_f(x.y & 0xffff0000u);
    f[4] = as_f(x.z << 16); f[5] = as_f(x.z & 0xffff0000u); f[6] = as_f(x.w << 16); f[7] = as_f(x.w & 0xffff0000u);
}
typedef long lx2 __attribute__((ext_vector_type(2)));
typedef float f32x2 __attribute__((ext_vector_type(2)));
typedef int i32x8 __attribute__((ext_vector_type(8)));
typedef int i32x4 __attribute__((ext_vector_type(4)));
constexpr float U4_SCALE = 64.f, V4_SCALE = 5.657f;
constexpr int MX_ONE = 0x7F7F7F7F;
template <int BY> __device__ __forceinline__ f32x2 cvt_fp4x2(unsigned w) { return __builtin_amdgcn_cvt_scalef32_pk_f32_fp4(w, 1.0f, BY); }
typedef _Float16 h16x2 __attribute__((ext_vector_type(2)));
template <int BY> __device__ __forceinline__ h16x2 cvt_fp4x2h(unsigned w) { return __builtin_amdgcn_cvt_scalef32_pk_f16_fp4(w, 1.0f, BY); }
template <int WS> __device__ __forceinline__ f32x2 cvt_fp8x2(int w) { return __builtin_amdgcn_cvt_pk_f32_fp8(w, WS != 0); }
__device__ __forceinline__ unsigned pk4_fp8(float a, float b, float c, float d) { int p = __builtin_amdgcn_cvt_pk_fp8_f32(a, b, 0, false); p = __builtin_amdgcn_cvt_pk_fp8_f32(c, d, p, true); return (unsigned)p; }
#ifndef DRYMASK
#define DRYMASK 0xFFFFFFFFu
#endif
constexpr size_t WS_HID = 248 * MiB;
constexpr size_t WS_SIDX = 80 * MiB, WS_SGATE = 88 * MiB;
template <bool DRY> __device__ __forceinline__ void expert_u_phase(const Frame& F, const Args& A) {
    int tid = F.tid, w = F.wave;
    asm volatile("" : "+v"(tid)); asm volatile("" : "+s"(w));
    const int lane = tid & 63, r = lane & 15, kg = lane >> 4, half = lane >> 5, sub = lane & 31;
    const int dl = 32 * sub + 16 * half;
    LAS unsigned char* N2 = F.lds + w * 18688;
    LAS unsigned char* IMG = N2 + 8192;
    LAS unsigned short* IDL = (LAS unsigned short*)(N2 + 16640);
    const GAS unsigned char* u4 = (const GAS unsigned char*)(A.ws + WS_UB);
    const GAS unsigned* idx = (const GAS unsigned*)(A.ws + WS_IDX); const GAS float* gate = (const GAS float*)(A.ws + WS_GATE);
    GAS unsigned* sidx = (GAS unsigned*)(A.ws + WS_SIDX); GAS float* sgate = (GAS float*)(A.ws + WS_SGATE);
    const GAS float* rowsq = (const GAS float*)(A.ws + WS_ROWSQ2); GAS float* hidp = (GAS float*)(A.ws + (DRY ? WS_Q + 32 * MiB : WS_HID));
    const GAS bf16* hbase = (const GAS bf16*)(A.ws + WS_HB) + dl;
    {
        int t = F.gw;
        v4u nhA = *(const GAS v4u*)(hbase + (size_t)t * D), nhB = *(const GAS v4u*)(hbase + (size_t)t * D + 8);
        unsigned ni0 = idx[(size_t)t * 128 + lane], ni1 = idx[(size_t)t * 128 + 64 + lane];
        float ng0 = gate[(size_t)t * 128 + lane], ng1 = gate[(size_t)t * 128 + 64 + lane], nrq = rowsq[t];
#pragma unroll 1
        for (int tt = 0; tt < 8; ++tt, t += F.NGW) {
            const v4u hA = nhA, hB = nhB; const unsigned i0 = DRY ? (ni0 & DRYMASK) : ni0, i1 = DRY ? (ni1 & DRYMASK) : ni1; const float g0 = ng0, g1 = ng1, rq = nrq;
            {   const int tn = (tt < 7) ? t + F.NGW : t;
                nhA = *(const GAS v4u*)(hbase + (size_t)tn * D); nhB = *(const GAS v4u*)(hbase + (size_t)tn * D + 8);
                ni0 = idx[(size_t)tn * 128 + lane]; ni1 = idx[(size_t)tn * 128 + 64 + lane];
                ng0 = gate[(size_t)tn * 128 + lane]; ng1 = gate[(size_t)tn * 128 + 64 + lane]; nrq = rowsq[tn]; }
            {   float f0[8], f1[8]; unpack8f(hA, f0); unpack8f(hB, f1);
                const float rr = rsqrtf(rq * (1.f / 1024.f) + EPS);
                v4u pk;
                pk.x = pk4_fp8(f0[0] * rr, f0[1] * rr, f0[2] * rr, f0[3] * rr); pk.y = pk4_fp8(f0[4] * rr, f0[5] * rr, f0[6] * rr, f0[7] * rr);
                pk.z = pk4_fp8(f1[0] * rr, f1[1] * rr, f1[2] * rr, f1[3] * rr); pk.w = pk4_fp8(f1[4] * rr, f1[5] * rr, f1[6] * rr, f1[7] * rr);
                *(LAS v4u*)(N2 + tt * 1024 + dl) = pk; }
            const unsigned b0 = i0 >> 11, b1 = i1 >> 11;
            unsigned pos0 = 0, pos1 = 0, base = 0;
#pragma unroll
            for (unsigned k = 0; k < 8; ++k) {
                const unsigned long long m0 = __ballot(b0 == k), m1 = __ballot(b1 == k);
                const unsigned c0 = (unsigned)__popcll(m0), c1 = (unsigned)__popcll(m1);
                const unsigned r0 = __builtin_amdgcn_mbcnt_hi((unsigned)(m0 >> 32), __builtin_amdgcn_mbcnt_lo((unsigned)m0, 0u));
                const unsigned r1 = __builtin_amdgcn_mbcnt_hi((unsigned)(m1 >> 32), __builtin_amdgcn_mbcnt_lo((unsigned)m1, 0u));
                pos0 = (b0 == k) ? base + r0 : pos0; pos1 = (b1 == k) ? base + c0 + r1 : pos1;
                base += c0 + c1;
            }
            IDL[tt * 128 + (pos0 & ~15u) + 8 * (pos0 & 1) + ((pos0 >> 1) & 7)] = (unsigned short)i0;
            IDL[tt * 128 + (pos1 & ~15u) + 8 * (pos1 & 1) + ((pos1 >> 1) & 7)] = (unsigned short)i1;
            sidx[(size_t)t * 128 + pos0] = i0; sidx[(size_t)t * 128 + pos1] = i1;
            sgate[(size_t)t * 128 + pos0] = g0; sgate[(size_t)t * 128 + pos1] = g1;
        }
    }
    v4u xr[8];
    const unsigned lanebase = 16u * sub;
#define PU_ROWS(GG) { const int q_ = (GG) >> 4, tt_ = ((GG) >> 1) & 7, g_ = 2 * q_ + ((GG) & 1); \
        const v4u iq_ = *(const LAS v4u*)(IDL + tt_ * 128 + 16 * g_ + 8 * half); const unsigned iw_[4] = {iq_.x, iq_.y, iq_.z, iq_.w}; \
        _Pragma("unroll") for (int j = 0; j < 8; ++j) { const unsigned id_ = (j & 1) ? (iw_[j >> 1] >> 16) : (iw_[j >> 1] & 0xffffu); \
            xr[j] = *(const GAS v4u*)(u4 + (size_t)(id_ * 512u + lanebase)); } }
    PU_ROWS(0)
    float hprev = 0.f; int oprev = -1;
#pragma unroll 1
    for (int G2 = 0; G2 < 64; G2 += 2) {
        const int q = G2 >> 4, tt = (G2 >> 1) & 7;
        i32x8 af[8];
        {   const LAS unsigned char* n2p = N2 + tt * 1024 + 16 * kg; asm volatile("" : "+v"(n2p));
#pragma unroll
            for (int s2 = 0; s2 < 8; ++s2) { const i32x4 a0 = *(const LAS i32x4*)(n2p + 128 * s2), a1 = *(const LAS i32x4*)(n2p + 128 * s2 + 64);
                af[s2] = (i32x8){a0.x, a0.y, a0.z, a0.w, a1.x, a1.y, a1.z, a1.w}; } }
#pragma unroll
        for (int e = 0; e < 2; ++e) {
            const int G = G2 + e, g = 2 * q + e;
#pragma unroll
            for (int j = 0; j < 8; ++j) *(LAS v4u*)(IMG + (2 * j + half) * 528 + 16 * sub) = xr[j];
            if (oprev >= 0 && kg == 0) hidp[(size_t)oprev + r] = hprev;
            { const int Gn = (G < 63) ? G + 1 : G; PU_ROWS(Gn) }
            __builtin_amdgcn_sched_barrier(0);
            LDS_WAIT();
            f32x4 accg = (f32x4){0.f, 0.f, 0.f, 0.f};
#pragma unroll
            for (int s2 = 0; s2 < 8; ++s2) {
                const i32x4 b4 = *(const LAS i32x4*)(IMG + r * 528 + 64 * s2 + 16 * kg);
                const i32x8 b = (i32x8){b4.x, b4.y, b4.z, b4.w, 0, 0, 0, 0};
                accg = __builtin_amdgcn_mfma_scale_f32_16x16x128_f8f6f4(af[s2], b, accg, 0, 4, 0, MX_ONE, 0, MX_ONE);
            }
            hprev = gelu_f(accg[0] * (1.f / U4_SCALE)) * (1.f / V4_SCALE);
            oprev = (F.gw + tt * F.NGW) * 128 + 16 * g;
            __builtin_amdgcn_sched_barrier(0);
        }
    }
#undef PU_ROWS
    if (kg == 0) hidp[(size_t)oprev + r] = hprev;
}
template <bool DRY> __device__ __forceinline__ void expert_v_phase(const Frame& F, const Args& A) {
    int tid = F.tid, w = F.wave;
    asm volatile("" : "+v"(tid)); asm volatile("" : "+s"(w));
    const int lane = tid & 63, half = lane >> 5, sub = lane & 31;
    const int dl = 32 * sub + 16 * half;
    const GAS unsigned char* v4 = (const GAS unsigned char*)(A.ws + WS_VB);
    const GAS unsigned* idx = (const GAS unsigned*)(A.ws + WS_SIDX); const GAS float* hidp = (const GAS float*)(A.ws + WS_HID); const GAS float* sgate = (const GAS float*)(A.ws + WS_SGATE);
    const GAS bf16* hbase = (const GAS bf16*)(A.ws + WS_HB) + dl;
    LAS float* NW = (LAS float*)F.lds;
    LAS unsigned* TL = (LAS unsigned*)(F.lds + 4096 + w * 8192);
    const int p0 = (lane & ~15) | ((lane & 1) << 3) | ((lane >> 1) & 7);
    const LAS unsigned* TLr = TL + 8 * half;
    const unsigned lanebase = 16u * sub;
    NW[tid] = A.in[18][tid]; NW[tid + 512] = A.in[18][tid + 512];
    __syncthreads();
    {
        int t = F.gw;
        unsigned ni0 = idx[(size_t)t * 128 + lane], ni1 = idx[(size_t)t * 128 + 64 + lane];
        float nh0 = hidp[(size_t)t * 128 + lane] * sgate[(size_t)t * 128 + lane], nh1 = hidp[(size_t)t * 128 + 64 + lane] * sgate[(size_t)t * 128 + 64 + lane];
#pragma unroll 1
        for (int tt = 0; tt < 8; ++tt, t += F.NGW) {
            const unsigned i0 = DRY ? (ni0 & DRYMASK) : ni0, i1 = DRY ? (ni1 & DRYMASK) : ni1;
            const h16x2 a = (h16x2){(_Float16)nh0, (_Float16)nh0}, b = (h16x2){(_Float16)nh1, (_Float16)nh1};
            {   const int tn = (tt < 7) ? t + F.NGW : t;
                ni0 = idx[(size_t)tn * 128 + lane]; ni1 = idx[(size_t)tn * 128 + 64 + lane];
                nh0 = hidp[(size_t)tn * 128 + lane] * sgate[(size_t)tn * 128 + lane]; nh1 = hidp[(size_t)tn * 128 + 64 + lane] * sgate[(size_t)tn * 128 + 64 + lane]; }
            LAS unsigned* tl = TL + tt * 256;
            tl[p0] = i0 * 512u; tl[64 + p0] = i1 * 512u; tl[128 + p0] = __builtin_bit_cast(unsigned, a); tl[192 + p0] = __builtin_bit_cast(unsigned, b);
        }
    }
    h16x2 acc[8][16];
#pragma unroll
    for (int tt = 0; tt < 8; ++tt)
#pragma unroll
        for (int i = 0; i < 16; ++i) acc[tt][i] = (h16x2){(_Float16)0.f, (_Float16)0.f};
    v4u xr[8];
#define PV_IDS(PTR, V) { const v4u q0_ = *(const LAS v4u*)(PTR), q1_ = *(const LAS v4u*)((PTR) + 4); \
            V[0] = q0_.x; V[1] = q0_.y; V[2] = q0_.z; V[3] = q0_.w; V[4] = q1_.x; V[5] = q1_.y; V[6] = q1_.z; V[7] = q1_.w; }
#define PV_LOAD1(OFF, PR) xr[PR] = *(const GAS v4u*)(v4 + (size_t)((OFF) + lanebase));
    {   unsigned ia[8]; PV_IDS(TLr, ia)
#pragma unroll
        for (int pr = 0; pr < 8; ++pr) PV_LOAD1(ia[pr], pr) }
    __builtin_amdgcn_sched_barrier(0);
#pragma unroll 1
    for (int q = 0; q < 4; ++q) {
        const int qn = (q < 3) ? q + 1 : q;
#pragma unroll
        for (int tt = 0; tt < 8; ++tt) {
#pragma unroll
            for (int e = 0; e < 2; ++e) {
                unsigned idn[8], sc[8];
                {   const LAS unsigned* nx = (e == 0) ? TLr + tt * 256 + 16 * (2 * q + 1) : (tt < 7) ? TLr + (tt + 1) * 256 + 16 * (2 * q) : TLr + 16 * (2 * qn);
                    PV_IDS(nx, idn)
                    const LAS unsigned* cs = TLr + tt * 256 + 128 + 16 * (2 * q + e);
                    PV_IDS(cs, sc) }
                __builtin_amdgcn_sched_barrier(0);
#pragma unroll
                for (int pr = 0; pr < 8; ++pr) {
                    const h16x2 sh2 = __builtin_bit_cast(h16x2, sc[pr]);
                    const unsigned xw[4] = {xr[pr].x, xr[pr].y, xr[pr].z, xr[pr].w};
#pragma unroll
                    for (int k = 0; k < 4; ++k) {
                        acc[tt][4 * k] = __builtin_elementwise_fma(cvt_fp4x2h<0>(xw[k]), sh2, acc[tt][4 * k]); acc[tt][4 * k + 1] = __builtin_elementwise_fma(cvt_fp4x2h<1>(xw[k]), sh2, acc[tt][4 * k + 1]);
                        acc[tt][4 * k + 2] = __builtin_elementwise_fma(cvt_fp4x2h<2>(xw[k]), sh2, acc[tt][4 * k + 2]); acc[tt][4 * k + 3] = __builtin_elementwise_fma(cvt_fp4x2h<3>(xw[k]), sh2, acc[tt][4 * k + 3]); }
                    PV_LOAD1(idn[pr], pr)
                    __builtin_amdgcn_sched_barrier(0);
                }
            }
        }
    }
#undef PV_LOAD1
#undef PV_IDS
#pragma unroll
    for (int tt = 0; tt < 8; ++tt) {
        const int t = F.gw + tt * F.NGW;
        const v4u hA = *(const GAS v4u*)(hbase + (size_t)t * D), hB = *(const GAS v4u*)(hbase + (size_t)t * D + 8);
        float o[16]; f32x2 o2[16];
#pragma unroll
        for (int i = 0; i < 16; ++i) { const unsigned mine = __builtin_bit_cast(unsigned, acc[tt][i]), oth = (unsigned)__shfl_xor((int)mine, 32); const h16x2 oo = __builtin_bit_cast(h16x2, oth);
            o2[i].x = (float)acc[tt][i].x + (float)oo.x; o2[i].y = (float)acc[tt][i].y + (float)oo.y; }
#pragma unroll
        for (int i = 0; i < 8; ++i) { float a0 = o2[i].x, a1 = o2[i].y, b0 = o2[8 + i].x, b1 = o2[8 + i].y; asm volatile("" : "+v"(a0), "+v"(a1), "+v"(b0), "+v"(b1));
            o[2 * i] = half ? b0 : a0; o[2 * i + 1] = half ? b1 : a1; }
        float ss = 0.f; f32x4 h2[4];
        {   float f0[8], f1[8]; unpack8f(hA, f0); unpack8f(hB, f1);
            h2[0] = (f32x4){f0[0] + o[0], f0[1] + o[1], f0[2] + o[2], f0[3] + o[3]}; h2[1] = (f32x4){f0[4] + o[4], f0[5] + o[5], f0[6] + o[6], f0[7] + o[7]};
            h2[2] = (f32x4){f1[0] + o[8], f1[1] + o[9], f1[2] + o[10], f1[3] + o[11]}; h2[3] = (f32x4){f1[4] + o[12], f1[5] + o[13], f1[6] + o[14], f1[7] + o[15]}; }
#pragma unroll
        for (int q = 0; q < 4; ++q) { const f32x4 x = h2[q]; ss += (x.x * x.x + x.y * x.y) + (x.z * x.z + x.w * x.w); }
        ss = wave_sum(ss);
        const float r3 = rsqrtf(ss * (1.f / D) + EPS);
        GAS float* yrow = (DRY ? (GAS float*)(A.ws + WS_Q) : (GAS float*)A.out) + (size_t)t * D + dl;
#pragma unroll
        for (int q = 0; q < 4; ++q) *(GAS f32x4*)(yrow + 4 * q) = h2[q] * r3 * *(const LAS f32x4*)(NW + dl + 4 * q);
    }
}
__device__ __forceinline__ void p0_transpose_item(const float* W, const float* kscale, int K, int N, bf16* WT, LAS float* scr, int item, int lane) {
    const int nblk = (N + 31) / 32, kb = item / nblk, nb = item % nblk, k0 = 64 * kb, n0 = 32 * nb;
    const int nn = n0 + (lane & 31); const bool ok = nn < N;
    (void)nn; (void)ok;
    {   const int c4 = lane & 7, kr = lane >> 3; const bool okc = n0 + 4 * c4 < N;
        f32x4 v[8];
#pragma unroll
        for (int i = 0; i < 8; ++i) v[i] = okc ? *(const GAS f32x4*)(W + (size_t)(k0 + 8 * i + kr) * N + n0 + 4 * c4) : (f32x4){0.f, 0.f, 0.f, 0.f};
#pragma unroll
        for (int i = 0; i < 8; ++i) { const int kk = 8 * i + kr; const float sc = kscale ? kscale[k0 + kk] : 1.f; LAS float* d = scr + kk * 33 + 4 * c4;
            d[0] = v[i].x * sc; d[1] = v[i].y * sc; d[2] = v[i].z * sc; d[3] = v[i].w * sc; } }
    LDS_WAIT(); asm volatile("" ::: "memory");
    const int c = lane & 7;
#pragma unroll
    for (int j = 0; j < 4; ++j) { const int n = (lane >> 3) + 8 * j; const LAS float* s = scr + (8 * c) * 33 + n;
        v4u o; o.x = pk2(s[0 * 33], s[1 * 33]); o.y = pk2(s[2 * 33], s[3 * 33]); o.z = pk2(s[4 * 33], s[5 * 33]); o.w = pk2(s[6 * 33], s[7 * 33]);
        *(GAS v4u*)(WT + (size_t)(n0 + n) * K + k0 + 8 * c) = o; }
    LDS_WAIT(); asm volatile("" ::: "memory");
}
__device__ __forceinline__ void p0_convert(const Frame& F, const float* src, bf16* dst, size_t n) {
    for (size_t i = ((size_t)F.gw * 64 + F.lane) * 8; i < n; i += (size_t)F.NGW * 512) {
        const f32x4 a = *(const GAS f32x4*)(src + i), b = *(const GAS f32x4*)(src + i + 4);
        v4u o; o.x = pk2(a.x, a.y); o.y = pk2(a.z, a.w); o.z = pk2(b.x, b.y); o.w = pk2(b.z, b.w);
        *(GAS v4u*)(dst + i) = o;
    }
}
__device__ __forceinline__ void p0_convert_fp4(const Frame& F, int wk, int nwk, const float* src, unsigned char* dst, size_t n, float scale, const float* colscale) {
#pragma unroll 4
    for (size_t i = ((size_t)wk * 64 + F.lane) * 32; i < n; i += (size_t)nwk * 2048) {
        unsigned ow[4];
#pragma unroll
        for (int q = 0; q < 4; ++q) {
            f32x4 a = *(const GAS f32x4*)(src + i + 8 * q) * scale, b = *(const GAS f32x4*)(src + i + 8 * q + 4) * scale;
            if (colscale) { a = a * *(const GAS f32x4*)(colscale + ((i + 8 * q) & 1023)); b = b * *(const GAS f32x4*)(colscale + ((i + 8 * q + 4) & 1023)); }
            unsigned pk = 0;
            pk = __builtin_amdgcn_cvt_scalef32_pk_fp4_f32(pk, a.x, a.y, 1.0f, 0); pk = __builtin_amdgcn_cvt_scalef32_pk_fp4_f32(pk, a.z, a.w, 1.0f, 1);
            pk = __builtin_amdgcn_cvt_scalef32_pk_fp4_f32(pk, b.x, b.y, 1.0f, 2); pk = __builtin_amdgcn_cvt_scalef32_pk_fp4_f32(pk, b.z, b.w, 1.0f, 3);
            ow[q] = pk; }
        *(GAS v4u*)(dst + (i >> 1)) = (v4u){ow[0], ow[1], ow[2], ow[3]};
    }
}
__device__ __forceinline__ void p0_prologue(const Frame& F, const Args& A) {
    unsigned char* ws = A.ws;
    LAS float* scr = (LAS float*)(F.lds + RING_OFF + F.wave * 16384);
    constexpr int I_IN = (D / 64) * ((NIN + 31) / 32), I_O = (D / 64) * (D / 32), I_Q = (D / 64) * (NQ / 32);
    for (int it = F.gw; it < I_IN + I_O + I_Q; it += F.NGW) {
        int r = it;
        if (r < I_IN) { p0_transpose_item(A.in[2], A.in[1], D, NIN, (bf16*)(ws + WS_WIN), scr, r, F.lane); continue; } r -= I_IN;
        if (r < I_O) { p0_transpose_item(A.in[12], nullptr, D, D, (bf16*)(ws + WS_WO), scr, r, F.lane); continue; } r -= I_O;
        p0_transpose_item(A.in[14], A.in[13], D, NQ, (bf16*)(ws + WS_WQ), scr, r, F.lane);
    }
    for (int m0 = F.gw * 4; m0 < T; m0 += F.NGW * 4) {
        f32x4 v[4][4]; float s[4] = {0.f, 0.f, 0.f, 0.f};
#pragma unroll
        for (int u = 0; u < 4; ++u) { const GAS f32x4* xr = (const GAS f32x4*)(A.in[0] + (size_t)(m0 + u) * D) + F.lane;
#pragma unroll
            for (int j = 0; j < 4; ++j) v[u][j] = xr[64 * j]; }
#pragma unroll
        for (int u = 0; u < 4; ++u) {
#pragma unroll
            for (int j = 0; j < 4; ++j) s[u] += (v[u][j].x * v[u][j].x + v[u][j].y * v[u][j].y) + (v[u][j].z * v[u][j].z + v[u][j].w * v[u][j].w);
            GAS unsigned long long* o8 = (GAS unsigned long long*)((bf16*)(ws + WS_XB) + (size_t)(m0 + u) * D) + F.lane;
#pragma unroll
            for (int j = 0; j < 4; ++j) o8[64 * j] = (unsigned long long)pk2(v[u][j].x, v[u][j].y) | ((unsigned long long)pk2(v[u][j].z, v[u][j].w) << 32); }
#pragma unroll
        for (int u = 0; u < 4; ++u) s[u] = wave_sum(s[u]);
        if (F.lane < 4) { const float sv = F.lane == 0 ? s[0] : (F.lane == 1 ? s[1] : (F.lane == 2 ? s[2] : s[3])); ((float*)(ws + WS_RRMS1))[m0 + F.lane] = rsqrtf(sv * (1.f / D) + EPS); ((float*)(ws + WS_ROWSQ2))[m0 + F.lane] = 0.f; }
    }
    p0_convert(F, A.in[15], (bf16*)(ws + WS_SUBK), (size_t)8 * 2 * 128 * 128);
    p0_convert_fp4(F, F.gw, F.NGW, A.in[16], ws + WS_UB, (size_t)16384 * 1024, U4_SCALE, A.in[13]);
    p0_convert_fp4(F, F.gw, F.NGW, A.in[17], ws + WS_VB, (size_t)16384 * 1024, V4_SCALE, nullptr);
}


#ifdef BENCH_KIND
__device__ __forceinline__ void bench_phase(const Frame& F, const Args& A) {
    unsigned r[16]; unsigned w = F.tid * 2654435761u, z = F.tid;
#pragma unroll
    for (int i = 0; i < 16; ++i) r[i] = w + i;
#pragma unroll 1
    for (int it = 0; it < BENCH_ITERS; ++it) {
#pragma unroll
        for (int i = 0; i < 16; ++i) {
#if BENCH_KIND == 1
            asm volatile("v_cvt_scalef32_pk_f16_fp4 %0, %1, 1.0" : "=v"(r[i]) : "v"(w));
#elif BENCH_KIND == 2
            asm volatile("v_pk_fma_f16 %0, %1, %2, %0" : "+v"(r[i]) : "v"(w), "v"(z));
#elif BENCH_KIND == 3
            asm volatile("v_and_or_b32 %0, %1, %2, %0" : "+v"(r[i]) : "v"(w), "v"(z));
#elif BENCH_KIND == 6
            asm volatile("v_fma_f32 %0, %1, %2, %0" : "+v"(r[i]) : "v"(w), "v"(z));
#elif BENCH_KIND == 7
            asm volatile("v_perm_b32 %0, %1, %2, %0" : "+v"(r[i]) : "v"(w), "v"(z));
#endif
        }
    }
    unsigned acc = 0;
#pragma unroll
    for (int i = 0; i < 16; ++i) acc ^= r[i];
    if (acc == 0x12345679u) *(GAS unsigned*)(A.ws + WS_Q + F.tid * 4) = acc;
}
#endif
#ifndef PROBE_MASK
#define PROBE_MASK 0
#endif
__device__ __forceinline__ int probe_reps(int k) { int n = ((PROBE_MASK >> k) & 1) + 1; return n; }
__global__ void __launch_bounds__(NWAVES * 64, 2) fwd(Args args) {
    extern __shared__ __attribute__((aligned(16))) unsigned char lds[];
    Frame F;
    F.lds = (LAS unsigned char*)lds;
    F.MISC = (volatile LAS unsigned*)(F.lds + MISC_OFF);
    F.tid = threadIdx.x; F.lane = F.tid & 63; F.wave = __builtin_amdgcn_readfirstlane(F.tid >> 6);
    F.G = gridDim.x; F.gw = blockIdx.x * NWAVES + F.wave; F.NGW = F.G * NWAVES;
    unsigned char* ws = args.ws;
    F.ctl = (gu32*)(ws + WS_CTL);
    for (int u = F.tid; u < (LDS_BYTES - LDSCTL_OFF) / 4; u += NWAVES * 64) ((LAS unsigned*)(F.lds + LDSCTL_OFF))[u] = 0u;
    __syncthreads();
    XcdBarrier bar = xcd_barrier_post((unsigned*)(F.ctl + CW_BAR), F.MISC + 8);
    const int lo = args.ph_lo, hi = args.ph_hi;
#define IN(k) (lo <= (k) && (k) < hi)
#define BOTH(k) (IN(k) && IN((k) + 1))
#define GRID_BAR() xcd_barrier(bar)
#define REP(k) for (int rep_ = 0, nrep_ = probe_reps(k); rep_ < nrep_; ++rep_)

    if (IN(0)) REP(0) { p0_prologue(F, args); if (BOTH(0)) GRID_BAR(); }
    if (IN(1)) REP(1) {
        pg8::Gemm g{(const bf16*)(ws + WS_XB), (const bf16*)(ws + WS_WIN), T, NINP, D}; pg8::StaticOrder S; S.init(T, NINP, F.G, (int)blockIdx.x);
        pg8::EpiRowScaleBf16 E{(bf16*)(ws + WS_PROJ), NINP, (const float*)(ws + WS_RRMS1)};
        pg8::gemm_phase<pg8::EpiRowScaleBf16, pg8::StaticOrder, true, true>(F.lds + RING_OFF, g, S, E);
        if (BOTH(1)) GRID_BAR();
    }
    if (IN(2)) {
        REP(2) { for (int u = blockIdx.x; u < 256; u += F.G) ssd_unit<0>(F, args, u); }
        REP(13) { for (int u = blockIdx.x; u < 1024; u += F.G) gla_unit<0>(F, args, u); }
        if (BOTH(2)) GRID_BAR();
    }
    if (IN(3)) { if ((PROBE_MASK >> 3) & 1) { scan_phase<true>(F, args); GRID_BAR(); } scan_phase<false>(F, args); if (BOTH(3)) GRID_BAR(); }
    if (IN(4)) {
        REP(4) { for (int u = blockIdx.x; u < 256; u += F.G) ssd_unit<1>(F, args, u); }
        REP(12) { for (int u = blockIdx.x; u < 1024; u += F.G) gla_unit<1>(F, args, u); }
        if (BOTH(4)) GRID_BAR();
    }
    if (IN(5)) {
        pg8::Gemm g{(const bf16*)(ws + WS_MIX), (const bf16*)(ws + WS_WO), T, D, D}; pg8::StaticOrder S; S.init(T, D, F.G, (int)blockIdx.x);
        if ((PROBE_MASK >> 5) & 1) { pg8::EpiResidual Ed{(const bf16*)(ws + WS_XB), (bf16*)(ws + 208 * MiB), (float*)(ws + 240 * MiB), D};
            pg8::gemm_phase<pg8::EpiResidual, pg8::StaticOrder, true, true>(F.lds + RING_OFF, g, S, Ed); GRID_BAR(); }
        pg8::EpiResidual E{(const bf16*)(ws + WS_XB), (bf16*)(ws + WS_HB), (float*)(ws + WS_ROWSQ2), D};
        pg8::gemm_phase<pg8::EpiResidual, pg8::StaticOrder, true, true>(F.lds + RING_OFF, g, S, E);
        if (BOTH(5)) GRID_BAR();
    }
    if (IN(6)) REP(6) {
        pg8::Gemm g{(const bf16*)(ws + WS_HB), (const bf16*)(ws + WS_WQ), T, NQ, D}; pg8::StaticOrder S; S.init(T, NQ, F.G, (int)blockIdx.x);
        pg8::EpiRsqScaleBf16 E{(bf16*)(ws + WS_Q), NQ, (const float*)(ws + WS_ROWSQ2)};
        pg8::gemm_phase<pg8::EpiRsqScaleBf16, pg8::StaticOrder, true, true>(F.lds + RING_OFF, g, S, E);
        if (BOTH(6)) GRID_BAR();
    }
    if (IN(7)) REP(7) { topk_phase(F, args); if (BOTH(7)) GRID_BAR(); }
    if (IN(8)) { if ((PROBE_MASK >> 8) & 1) { expert_u_phase<true>(F, args); GRID_BAR(); } expert_u_phase<false>(F, args); if (BOTH(8)) GRID_BAR(); }
#ifdef BENCH_KIND
    if (IN(9)) { bench_phase(F, args); GRID_BAR(); }
#endif
    if (IN(9)) { if ((PROBE_MASK >> 9) & 1) { expert_v_phase<true>(F, args); GRID_BAR(); } expert_v_phase<false>(F, args); }
#undef IN
#undef BOTH
}
extern "C" void kernel_launch(void* const* d_in, const int* in_sizes, int n_in, void* d_out, int out_size, void* d_ws, size_t ws_size, hipStream_t stream) {
    static int grid = 0;
    if (grid == 0) {
        if (n_in != 19 || out_size != T * D || ws_size < 256 * MiB) { fprintf(stderr, "kernel_launch: unexpected shapes n_in %d out %d ws %zu\n", n_in, out_size, ws_size); grid = -1; return; }
        int dev = 0, cus = 0, per_cu = 0;
        if (hipGetDevice(&dev) != hipSuccess || hipDeviceGetAttribute(&cus, hipDeviceAttributeMultiprocessorCount, dev) != hipSuccess) { grid = -1; return; }
        if (hipFuncSetAttribute((const void*)fwd, hipFuncAttributeMaxDynamicSharedMemorySize, LDS_BYTES) != hipSuccess) { fprintf(stderr, "kernel_launch: hipFuncSetAttribute failed\n"); grid = -1; return; }
        if (hipOccupancyMaxActiveBlocksPerMultiprocessor(&per_cu, (const void*)fwd, NWAVES * 64, LDS_BYTES) != hipSuccess || per_cu < 1) { fprintf(stderr, "kernel_launch: occupancy query says %d\n", per_cu); }
        (void)hipGetLastError();
        grid = cus;
    }
    if (grid < 0) return;
    const float* x = (const float*)d_in[0];
    const float* gla_w2 = (const float*)d_in[3];
    const float* gla_bg = (const float*)d_in[4];
    const float* gla_nw = (const float*)d_in[5];
    const float* conv_w = (const float*)d_in[6];
    const float* conv_b = (const float*)d_in[7];
    const float* dt_bias = (const float*)d_in[8];
    const float* a_log = (const float*)d_in[9];
    const float* d_skip = (const float*)d_in[10];
    const float* ssd_nw = (const float*)d_in[11];
    const float* w_out = (const float*)d_in[12];
    const float* norm_ffn_w = (const float*)d_in[13];
    const float* w_query = (const float*)d_in[14];
    const float* sub_keys = (const float*)d_in[15];
    const float* pu = (const float*)d_in[16];
    const float* pv = (const float*)d_in[17];
    const float* norm_final_w = (const float*)d_in[18];
    float* out = (float*)d_out;
    char* ws = (char*)d_ws;

    (void)hipMemsetAsync(ws + WS_CTL, 0, CTL_ZERO_BYTES, stream);
    Args a{};
    for (int i = 0; i < 19; ++i) a.in[i] = (const float*)d_in[i];
    a.out = out; a.ws = (unsigned char*)d_ws; a.ph_lo = 0; a.ph_hi = 10;
    hipLaunchKernelGGL(fwd, dim3(grid), dim3(NWAVES * 64), LDS_BYTES, stream, a);

}
```

```cpp
#include <hip/hip_runtime.h>
#include <cstdio>
#include <cstdint>
namespace pg8 {
#define PG8_LAS __attribute__((address_space(3)))
typedef unsigned short bf16_t;
typedef short bf16x8 __attribute__((ext_vector_type(8)));
typedef float f32x4 __attribute__((ext_vector_type(4)));
typedef unsigned u32x4 __attribute__((ext_vector_type(4)));
constexpr int BM = 256, BK = 64, HALF = 128, HTB = HALF * BK * 2  , STAGE_BYTES = 8 * HTB, NXCD = 8, WGM = 8;

__host__ __device__ __forceinline__ int lds_byte(int r, int c) { const int st = (r >> 4) * 2 + (c >> 5), rr = r & 15, cc = c & 31, ob = rr * 64 + cc * 2; return st * 1024 + (ob ^ (((ob >> 9) & 1) << 5)); }
__host__ __device__ __forceinline__ void stage_rc(int b, int& R, int& C) { const int st = b / 1024, sb = b % 1024, swz = sb ^ (((sb >> 9) & 1) << 5); R = (st >> 1) * 16 + swz / 64; C = (st & 1) * 32 + (swz % 64) / 2; }
__host__ __device__ __forceinline__ int perm32(int rho) { const int n = rho >> 4, i = rho & 15; return 8 * (i >> 2) + 4 * n + (i & 3); }

struct Unit { int pm, pn; };
struct Gemm { const bf16_t* A; const bf16_t* Bt; int M, N, K; };

struct StaticOrder {
    int nM, nN, nwg, G, c;
    __host__ __device__ void init(int M, int N, int G_, int c_) { nM = M / BM; nN = N / BM; nwg = nM * nN; G = G_; c = c_; }
    __host__ __device__ bool next(int i, Unit& u) const {
        const long L = (long)i * G + c; if (L >= nwg) return false;
        int wgid = (int)L; { const int q = nwg / NXCD, r = nwg % NXCD, xcd = wgid % NXCD, off = wgid / NXCD; wgid = (xcd < r ? xcd * (q + 1) : r * (q + 1) + (xcd - r) * q) + off; }
        const int nig = WGM * nN, gid = wgid / nig, fm = gid * WGM, gsz = (nM - fm) < WGM ? (nM - fm) : WGM;
        u.pm = fm + ((wgid % nig) % gsz); u.pn = (wgid % nig) / gsz; return true;
    }
    __device__ __forceinline__ void a_ready(const Unit&) const {}
    __device__ __forceinline__ void done(const Unit&) const {}
};

__device__ __forceinline__ unsigned cvt_pk_bf16(float lo, float hi) { unsigned r; asm volatile("v_cvt_pk_bf16_f32 %0, %1, %2" : "=v"(r) : "v"(lo), "v"(hi)); return r; }
typedef float f32x2 __attribute__((ext_vector_type(2)));
struct EpiRowScaleBf16 {
    static constexpr bool PERM = true, AFTER_DRAIN = false;
    bf16_t* O; int ldc; const float* rs;
    __device__ __forceinline__ void operator()(const f32x4 (&acc)[2][2][4][2], const Unit& u, int wr, int wc, int fr, int fq) const {
        const int row0 = u.pm * BM + wr * 64 + fr, col0 = u.pn * BM + wc * 32 + 8 * fq;
#pragma unroll
        for (int ai = 0; ai < 2; ++ai)
#pragma unroll
            for (int m = 0; m < 4; ++m) { const int row = row0 + ai * HALF + m * 16; const float sc = rs[row]; bf16_t* rowp = O + (size_t)row * ldc + col0;
#pragma unroll
                for (int bj = 0; bj < 2; ++bj) { const f32x4 v0 = acc[ai][bj][m][0] * sc, v1 = acc[ai][bj][m][1] * sc;
                    u32x4 w; w.x = cvt_pk_bf16(v0[0], v0[1]); w.y = cvt_pk_bf16(v0[2], v0[3]); w.z = cvt_pk_bf16(v1[0], v1[1]); w.w = cvt_pk_bf16(v1[2], v1[3]);
                    *(u32x4*)(rowp + bj * HALF) = w; } }
    }
};
struct EpiRsqScaleBf16 {
    static constexpr bool PERM = true, AFTER_DRAIN = false;
    bf16_t* O; int ldc; const float* rowsq;
    __device__ __forceinline__ void operator()(const f32x4 (&acc)[2][2][4][2], const Unit& u, int wr, int wc, int fr, int fq) const {
        const int row0 = u.pm * BM + wr * 64 + fr, col0 = u.pn * BM + wc * 32 + 8 * fq;
#pragma unroll
        for (int ai = 0; ai < 2; ++ai)
#pragma unroll
            for (int m = 0; m < 4; ++m) { const int row = row0 + ai * HALF + m * 16; const float sc = rsqrtf(rowsq[row] * (1.f / 1024.f) + 1e-6f); bf16_t* rowp = O + (size_t)row * ldc + col0;
#pragma unroll
                for (int bj = 0; bj < 2; ++bj) { const f32x4 v0 = acc[ai][bj][m][0] * sc, v1 = acc[ai][bj][m][1] * sc;
                    u32x4 w; w.x = cvt_pk_bf16(v0[0], v0[1]); w.y = cvt_pk_bf16(v0[2], v0[3]); w.z = cvt_pk_bf16(v1[0], v1[1]); w.w = cvt_pk_bf16(v1[2], v1[3]);
                    *(u32x4*)(rowp + bj * HALF) = w; } }
    }
};
struct EpiResidual {
    static constexpr bool PERM = true, AFTER_DRAIN = false;
    const bf16_t* X; bf16_t* HB; float* rowsq; int ldc;
    __device__ __forceinline__ void operator()(const f32x4 (&acc)[2][2][4][2], const Unit& u, int wr, int wc, int fr, int fq) const {
        const int row0 = u.pm * BM + wr * 64 + fr, col0 = u.pn * BM + wc * 32 + 8 * fq;
#pragma unroll
        for (int ai = 0; ai < 2; ++ai)
#pragma unroll
            for (int m = 0; m < 4; ++m) { const int row = row0 + ai * HALF + m * 16; float ss = 0.f;
#pragma unroll
                for (int bj = 0; bj < 2; ++bj) { const size_t off = (size_t)row * ldc + col0 + bj * HALF;
                    const u32x4 xv = *(const u32x4*)(X + off);
                    const f32x4 x0 = (f32x4){__builtin_bit_cast(float, xv.x << 16), __builtin_bit_cast(float, xv.x & 0xffff0000u), __builtin_bit_cast(float, xv.y << 16), __builtin_bit_cast(float, xv.y & 0xffff0000u)};
                    const f32x4 x1 = (f32x4){__builtin_bit_cast(float, xv.z << 16), __builtin_bit_cast(float, xv.z & 0xffff0000u), __builtin_bit_cast(float, xv.w << 16), __builtin_bit_cast(float, xv.w & 0xffff0000u)};
                    const f32x4 v0 = acc[ai][bj][m][0] + x0, v1 = acc[ai][bj][m][1] + x1;
                    u32x4 w; w.x = cvt_pk_bf16(v0[0], v0[1]); w.y = cvt_pk_bf16(v0[2], v0[3]); w.z = cvt_pk_bf16(v1[0], v1[1]); w.w = cvt_pk_bf16(v1[2], v1[3]);
                    *(u32x4*)(HB + off) = w;
                    ss += (v0[0] * v0[0] + v0[1] * v0[1]) + (v0[2] * v0[2] + v0[3] * v0[3]) + (v1[0] * v1[0] + v1[1] * v1[1]) + (v1[2] * v1[2] + v1[3] * v1[3]); }
                ss += __shfl_xor(ss, 16); ss += __shfl_xor(ss, 32);
                if (fq == 0) atomicAdd(rowsq + row, ss); }
    }
};
template <class Epi, class Sched, bool ALIGN_EPI = false, bool SP2 = false>
__device__ __forceinline__ void gemm_phase(PG8_LAS unsigned char* lds, const Gemm g, const Sched& S, const Epi& E) {
    const int tid = threadIdx.x, wid = __builtin_amdgcn_readfirstlane(tid >> 6), lane = tid & 63, wr = wid >> 2, wc = wid & 3, fr = lane & 15, fq = lane >> 4;
    const int K = g.K, nt = K / BK;
    unsigned voffA[2], voffB[2];
#pragma unroll
    for (int i = 0; i < 2; ++i) { int R, C; stage_rc(tid * 16 + i * 8192, R, C); const int Rb = Epi::PERM ? ((R & ~31) + perm32(R & 31)) : R;
        voffA[i] = (unsigned)(R * K + C) * 2u; voffB[i] = (unsigned)(Rb * K + C) * 2u; }
    const size_t kstep = (size_t)(BK * 2);
    const size_t hstep = (size_t)HALF * K * 2;
    const size_t tstep = 2 * hstep;
    const unsigned ldsw = (unsigned)wid * 1024u;
    const int aoff = lds_byte(wr * 64 + fr, fq * 8), boff = lds_byte(wc * 32 + fr, fq * 8);
#define PG8_SA(b, h) (((b) * 2 + (h)) * HTB)
#define PG8_SB(b, h) ((4 + (b) * 2 + (h)) * HTB)
#define PG8_STAGE(bufoff, gbase, voff) do { _Pragma("unroll") for (int _i = 0; _i < 2; ++_i) \
        __builtin_amdgcn_global_load_lds((const unsigned*)((const char*)(gbase) + (voff)[_i]), (PG8_LAS unsigned*)(lds + (bufoff) + ldsw + _i * 8192), 16, 0, 0); } while (0)
#define PG8_LDA(dst, b, h) do { _Pragma("unroll") for (int m = 0; m < 4; ++m) _Pragma("unroll") for (int k = 0; k < 2; ++k) dst[m][k] = *(const PG8_LAS bf16x8*)(lds + PG8_SA(b, h) + aoff + m * 2048 + k * 1024); } while (0)
#define PG8_LDB(dst, b, h) do { _Pragma("unroll") for (int n = 0; n < 2; ++n) _Pragma("unroll") for (int k = 0; k < 2; ++k) dst[n][k] = *(const PG8_LAS bf16x8*)(lds + PG8_SB(b, h) + boff + n * 2048 + k * 1024); } while (0)
#define PG8_MMA(ai, bj, At, Bt) do { __builtin_amdgcn_s_setprio(1); _Pragma("unroll") for (int m = 0; m < 4; ++m) _Pragma("unroll") for (int n = 0; n < 2; ++n) _Pragma("unroll") for (int k = 0; k < 2; ++k) \
        acc[ai][bj][m][n] = __builtin_amdgcn_mfma_f32_16x16x32_bf16(Bt[n][k], At[m][k], acc[ai][bj][m][n], 0, 0, 0); __builtin_amdgcn_s_setprio(0); } while (0)
#define PG8_WAIT_V(n) asm volatile("s_waitcnt vmcnt(" #n ")" ::: "memory")
#define PG8_WAIT_L(n) asm volatile("s_waitcnt lgkmcnt(" #n ")" ::: "memory")
#define PG8_BAR __builtin_amdgcn_s_barrier()
#define PG8_SCHED __builtin_amdgcn_sched_barrier(0)
    Unit cur, nxt; int ui = 0;
    if (!S.next(0, cur)) return;
    f32x4 acc[2][2][4][2];
#pragma unroll
    for (int a = 0; a < 2; ++a)
#pragma unroll
        for (int b = 0; b < 2; ++b)
#pragma unroll
            for (int m = 0; m < 4; ++m)
#pragma unroll
                for (int n = 0; n < 2; ++n) acc[a][b][m][n] = (f32x4){0.f, 0.f, 0.f, 0.f};
    bf16x8 At[4][2], B0[2][2], B1[2][2];
    const char* cA = (const char*)g.A + (size_t)cur.pm * tstep; const char* cB = (const char*)g.Bt + (size_t)cur.pn * tstep;
    S.a_ready(cur);
    if constexpr (SP2) {
        PG8_STAGE(PG8_SB(0, 0), cB, voffB); PG8_STAGE(PG8_SB(0, 1), cB + hstep, voffB); PG8_STAGE(PG8_SA(0, 0), cA, voffA); PG8_STAGE(PG8_SA(0, 1), cA + hstep, voffA);
        if (wr == 1) PG8_BAR;
        PG8_WAIT_V(2); PG8_BAR;
        PG8_STAGE(PG8_SB(1, 0), cB + kstep, voffB); PG8_STAGE(PG8_SA(1, 0), cA + kstep, voffA); PG8_STAGE(PG8_SB(1, 1), cB + hstep + kstep, voffB);
        PG8_WAIT_V(6); PG8_BAR;
    } else {
        PG8_STAGE(PG8_SB(0, 0), cB, voffB); PG8_STAGE(PG8_SA(0, 0), cA, voffA); PG8_STAGE(PG8_SB(0, 1), cB + hstep, voffB); PG8_STAGE(PG8_SA(0, 1), cA + hstep, voffA);
        if (wr == 1) PG8_BAR;
        PG8_WAIT_V(4); PG8_BAR;
        PG8_STAGE(PG8_SB(1, 0), cB + kstep, voffB); PG8_STAGE(PG8_SA(1, 0), cA + kstep, voffA); PG8_STAGE(PG8_SB(1, 1), cB + hstep + kstep, voffB);
        PG8_WAIT_V(6); PG8_BAR;
    }
    for (;;) {
        const bool has_next = S.next(ui + 1, nxt);
        const char* nA = has_next ? (const char*)g.A + (size_t)nxt.pm * tstep : cA; const char* nB = has_next ? (const char*)g.Bt + (size_t)nxt.pn * tstep : cB;
        for (int t = 0; t < nt; t += 2) {
            const bool last = (t == nt - 2);
            const char* a1 = cA + (size_t)(t + 1) * kstep;
            const char* a2 = last ? nA : cA + (size_t)(t + 2) * kstep; const char* b2 = last ? nB : cB + (size_t)(t + 2) * kstep;
            const char* a3 = a2 + kstep; const char* b3 = b2 + kstep;
            if (last && has_next) S.a_ready(nxt);
            if constexpr (SP2) {
            PG8_LDB(B0, 0, 0); PG8_LDB(B1, 0, 1); PG8_SCHED; PG8_LDA(At, 0, 0); PG8_STAGE(PG8_SA(1, 1), a1 + hstep, voffA);
            PG8_WAIT_V(8); PG8_WAIT_L(0); PG8_BAR; PG8_MMA(0, 0, At, B0); PG8_MMA(0, 1, At, B1); PG8_BAR; PG8_SCHED;
            PG8_LDA(At, 0, 1); PG8_STAGE(PG8_SB(0, 0), b2, voffB); PG8_STAGE(PG8_SB(0, 1), b2 + hstep, voffB); PG8_STAGE(PG8_SA(0, 0), a2, voffA);
            PG8_WAIT_V(8); PG8_WAIT_L(0); PG8_BAR; PG8_MMA(1, 0, At, B0); PG8_MMA(1, 1, At, B1); PG8_BAR; PG8_SCHED;
            PG8_LDB(B0, 1, 0); PG8_LDB(B1, 1, 1); PG8_SCHED; PG8_LDA(At, 1, 0); PG8_STAGE(PG8_SA(0, 1), a2 + hstep, voffA);
            PG8_WAIT_V(8); PG8_WAIT_L(0); PG8_BAR; PG8_MMA(0, 0, At, B0); PG8_MMA(0, 1, At, B1); PG8_BAR; PG8_SCHED;
            PG8_LDA(At, 1, 1); PG8_STAGE(PG8_SB(1, 0), b3, voffB); PG8_STAGE(PG8_SB(1, 1), b3 + hstep, voffB); PG8_STAGE(PG8_SA(1, 0), a3, voffA);
            PG8_WAIT_V(8); PG8_WAIT_L(0); PG8_BAR; PG8_MMA(1, 0, At, B0); PG8_MMA(1, 1, At, B1); PG8_BAR; PG8_SCHED;
            } else {
            PG8_LDB(B0, 0, 0); PG8_SCHED; PG8_LDA(At, 0, 0); PG8_STAGE(PG8_SA(1, 1), a1 + hstep, voffA);
            PG8_WAIT_L(8); PG8_BAR; PG8_WAIT_L(0); PG8_MMA(0, 0, At, B0); PG8_BAR; PG8_SCHED;
            PG8_LDB(B1, 0, 1); PG8_STAGE(PG8_SB(0, 0), b2, voffB);
            PG8_BAR; PG8_WAIT_L(0); PG8_MMA(0, 1, At, B1); PG8_BAR;
            PG8_LDA(At, 0, 1); PG8_STAGE(PG8_SA(0, 0), a2, voffA);
            PG8_BAR; PG8_WAIT_L(0); PG8_MMA(1, 0, At, B0); PG8_BAR; PG8_SCHED;
            PG8_STAGE(PG8_SB(0, 1), b2 + hstep, voffB);
            PG8_WAIT_V(6); PG8_BAR; PG8_MMA(1, 1, At, B1); PG8_BAR;
            PG8_LDB(B0, 1, 0); PG8_SCHED; PG8_LDA(At, 1, 0); PG8_STAGE(PG8_SA(0, 1), a2 + hstep, voffA);
            PG8_WAIT_L(8); PG8_BAR; PG8_WAIT_L(0); PG8_MMA(0, 0, At, B0); PG8_BAR; PG8_SCHED;
            PG8_LDB(B1, 1, 1); PG8_STAGE(PG8_SB(1, 0), b3, voffB);
            PG8_BAR; PG8_WAIT_L(0); PG8_MMA(0, 1, At, B1); PG8_BAR;
            PG8_LDA(At, 1, 1); PG8_STAGE(PG8_SA(1, 0), a3, voffA);
            PG8_BAR; PG8_WAIT_L(0); PG8_MMA(1, 0, At, B0); PG8_BAR; PG8_SCHED;
            PG8_STAGE(PG8_SB(1, 1), b3 + hstep, voffB);
            PG8_WAIT_V(6); PG8_BAR; PG8_MMA(1, 1, At, B1); PG8_BAR;
            }
        }
        if constexpr (ALIGN_EPI) { if (wr == 0) PG8_BAR; }
        if constexpr (!Epi::AFTER_DRAIN) { E(acc, cur, wr, wc, fr, fq); S.done(cur); }
        if (!has_next) break;
#pragma unroll
        for (int a = 0; a < 2; ++a)
#pragma unroll
            for (int b = 0; b < 2; ++b)
#pragma unroll
                for (int m = 0; m < 4; ++m)
#pragma unroll
                    for (int n = 0; n < 2; ++n) acc[a][b][m][n] = (f32x4){0.f, 0.f, 0.f, 0.f};
        cur = nxt; cA = nA; cB = nB; ++ui;
        if constexpr (ALIGN_EPI) { if (wr == 1) PG8_BAR; }
    }
    PG8_WAIT_V(0);
    if constexpr (!ALIGN_EPI) { if (wr == 0) PG8_BAR; }
    PG8_BAR;
    if constexpr (Epi::AFTER_DRAIN) { E.fused(acc, cur, wr, wc, fr, fq, lds, wid, lane); S.done(cur); }
#undef PG8_SA
#undef PG8_SB
#undef PG8_STAGE
#undef PG8_LDA
#undef PG8_LDB
#undef PG8_MMA
#undef PG8_WAIT_V
#undef PG8_WAIT_L
#undef PG8_BAR
#undef PG8_SCHED
}
}
constexpr int NWAVES = 8;
constexpr int T = 16384, SEQ = 8192, D = 1024, NIN = 2840, NINP = 3072, NQ = 2048;
constexpr int C_Q = 0, C_K = 256, C_V = 512, C_GLR = 1024, C_GOUT = 1040, C_Z = 1552, C_XBC = 2064, C_DT = 2832;
constexpr float EPS = 1e-6f;
constexpr size_t MiB = 1u << 20;
constexpr size_t WS_CTL = 0, CTL_ZERO_BYTES = 64 * 1024;
constexpr size_t WS_WIN = 1 * MiB;
constexpr size_t WS_WO = 7 * MiB;
constexpr size_t WS_WQ = 9 * MiB;
constexpr size_t WS_SUBK = 13 * MiB;
constexpr size_t WS_RRMS1 = 14 * MiB;
constexpr size_t WS_ROWSQ2 = 14 * MiB + 64 * 1024;
constexpr size_t WS_UB = 16 * MiB, WS_VB = 24 * MiB;
constexpr size_t WS_MIX = 32 * MiB;
constexpr size_t WS_XB = 80 * MiB;
constexpr size_t WS_PROJ = 112 * MiB;
constexpr int CW_TMO = 0, CW_BAR = 1024;
constexpr int RING_OFF = 0, RING_BYTES = 131072;
constexpr int LDS_BYTES = 163840;
constexpr int LDSCTL_OFF = LDS_BYTES - 1024, MISC_OFF = LDSCTL_OFF + 320;

#define GAS __attribute__((address_space(1)))
#define LAS __attribute__((address_space(3)))
typedef unsigned short bf16;
typedef unsigned v4u __attribute__((ext_vector_type(4)));
typedef float f32x4 __attribute__((ext_vector_type(4)));
typedef short bf16x8 __attribute__((ext_vector_type(8)));
typedef GAS unsigned gu32;
#define RLX_AGENT __ATOMIC_RELAXED, __HIP_MEMORY_SCOPE_AGENT
#define LDS_WAIT() asm volatile("s_waitcnt lgkmcnt(0)" ::: "memory")
#define VM_WAIT() asm volatile("s_waitcnt vmcnt(0)" ::: "memory")
typedef float f32x2c __attribute__((ext_vector_type(2)));
typedef __bf16 bf16x2c __attribute__((ext_vector_type(2)));
__device__ __forceinline__ unsigned f2bf(float f) { const __bf16 b = (__bf16)f; return (unsigned)__builtin_bit_cast(unsigned short, b); }
__device__ __forceinline__ unsigned pk2(float lo, float hi) { const bf16x2c v = __builtin_convertvector((f32x2c){lo, hi}, bf16x2c); return __builtin_bit_cast(unsigned, v); }
__device__ __forceinline__ float bf2f(unsigned short b) { return __builtin_bit_cast(float, (unsigned)b << 16); }
__device__ __forceinline__ float wave_sum(float v) {
#pragma unroll
    for (int o = 1; o < 64; o <<= 1) v += __shfl_xor(v, o);
    return v;
}
#define XB_TMO      128
#define XB_XCNT(j)  (256  + 64 * (j))
#define XB_XSUB(j)  (1280 + 64 * (j))
#define XB_XGEN(j)  (2304 + 64 * (j))
#define XB_TOP      3328
#define XB_TOPGEN   3392
#define XCD_BAR_WORDS 3456
#define XB_SPIN_CAP (1u << 18)

__device__ __forceinline__ unsigned xb_ld(unsigned* p)              { return __hip_atomic_load(p, __ATOMIC_RELAXED, __HIP_MEMORY_SCOPE_AGENT); }
__device__ __forceinline__ unsigned xb_add(unsigned* p, unsigned v) { return __hip_atomic_fetch_add(p, v, __ATOMIC_RELAXED, __HIP_MEMORY_SCOPE_AGENT); }
__device__ __forceinline__ unsigned xb_xcc_id() { return (unsigned)__builtin_amdgcn_s_getreg((3 << 11) | 20) & 0xFu; }
#define XB_SPIN(cond, bar) do { unsigned _sp = 0; while (cond) { __builtin_amdgcn_s_sleep(1); \
    if ((++_sp & 255u) == 0u) { if (xb_ld(&(bar)[XB_TMO])) break; if (_sp > XB_SPIN_CAP) { atomicAdd(&(bar)[XB_TMO], 1u); break; } } } } while (0)

struct XcdBarrier {
    unsigned* bar; unsigned x;
    volatile LAS unsigned* st;
};

__device__ __forceinline__ XcdBarrier xcd_barrier_post(unsigned* bar, volatile LAS unsigned* st) {
    XcdBarrier b; b.bar = bar; b.x = xb_xcc_id(); b.st = st;
    if (threadIdx.x == 0) (void)xb_add(&bar[XB_XCNT(b.x)], 1u);
    return b;
}
__device__ __forceinline__ void xcd_barrier_complete(unsigned* bar, unsigned x, unsigned& nloc, unsigned& nx) {
    const unsigned G = gridDim.x * gridDim.y * gridDim.z;
    unsigned sum, cnt, mine, sp = 0u;
    for (;;) {
        sum = 0u; cnt = 0u; mine = 0u;
#pragma unroll
        for (unsigned j = 0; j < 16; ++j) { const unsigned c = xb_ld(&bar[XB_XCNT(j)]); sum += c; cnt += (c > 0u) ? 1u : 0u; mine = (j == x) ? c : mine; }
        if (sum == G) break;
        __builtin_amdgcn_s_sleep(1);
        if ((++sp & 255u) == 0u) { if (xb_ld(&bar[XB_TMO])) break; if (sp > XB_SPIN_CAP) { atomicAdd(&bar[XB_TMO], 1u); break; } }
    }
    nloc = mine > 0u ? mine : 1u; nx = cnt > 0u ? cnt : 1u;
}

__device__ __forceinline__ void xcd_barrier(const XcdBarrier& b) {
    asm volatile("s_waitcnt vmcnt(0)" ::: "memory");
    __syncthreads();
    if (threadIdx.x == 0) {
        unsigned* bar = b.bar;
        __builtin_amdgcn_s_waitcnt(0);
        unsigned nloc = b.st[0], nx = b.st[1];
        if (nloc == 0u) { xcd_barrier_complete(bar, b.x, nloc, nx); b.st[0] = nloc; b.st[1] = nx; }
        const unsigned old = xb_add(&bar[XB_XSUB(b.x)], 1u);
        const unsigned gen = old / nloc;
        if (old + 1u == (gen + 1u) * nloc) {
            __builtin_amdgcn_fence(__ATOMIC_RELEASE, "agent");
            asm volatile("s_waitcnt vmcnt(0)" ::: "memory");
            const unsigned og = xb_add(&bar[XB_TOP], 1u);
            const unsigned tg = og / nx;
            if (og + 1u == (tg + 1u) * nx) xb_add(&bar[XB_TOPGEN], 1u);
            else XB_SPIN(xb_ld(&bar[XB_TOPGEN]) == tg, bar);
            __builtin_amdgcn_fence(__ATOMIC_ACQUIRE, "agent");
            xb_add(&bar[XB_XGEN(b.x)], 1u);
            asm volatile("s_waitcnt vmcnt(0)" ::: "memory");
        } else {
            XB_SPIN(xb_ld(&bar[XB_XGEN(b.x)]) == gen, bar);
            __builtin_amdgcn_fence(__ATOMIC_ACQUIRE, "agent");
            asm volatile("s_waitcnt vmcnt(0)" ::: "memory");
        }
    }
    __syncthreads();
}
struct Args {
    const float* in[19]; float* out; unsigned char* ws; int ph_lo, ph_hi;
};
struct Frame {
    LAS unsigned char* lds; volatile LAS unsigned* MISC; gu32* ctl;
    int tid, lane, wave, G, gw, NGW;
};

constexpr size_t WS_GDEC = 14 * MiB + 128 * 1024;
constexpr size_t WS_SDEC = 14 * MiB + 512 * 1024;
constexpr size_t WS_GST = 208 * MiB;
constexpr size_t WS_SST = 224 * MiB;
constexpr int SA64 = 144, SA128 = 272, SA32 = 80, SXN = 528;

__device__ __forceinline__ float silu_f(float x) { return x * __builtin_amdgcn_rcpf(1.f + __expf(-x)); }
__device__ __forceinline__ float softplus_f(float x) { return fmaxf(x, 0.f) + __logf(1.f + __expf(-fabsf(x))); }
__device__ __forceinline__ float logsigmoid_f(float x) { return fminf(x, 0.f) - __logf(1.f + __expf(-fabsf(x))); }
typedef unsigned u32x2 __attribute__((ext_vector_type(2)));

__device__ __forceinline__ f32x4 mma16(const LAS unsigned char* A, int sa, const LAS unsigned char* Bt, int sb, int K, f32x4 acc, int r, int kg) {
    for (int k0 = 0; k0 < K; k0 += 32) {
        const bf16x8 a = *(const LAS bf16x8*)(A + r * sa + (k0 + 8 * kg) * 2);
        const bf16x8 b = *(const LAS bf16x8*)(Bt + r * sb + (k0 + 8 * kg) * 2);
        acc = __builtin_amdgcn_mfma_f32_16x16x32_bf16(a, b, acc, 0, 0, 0);
    }
    return acc;
}

__device__ __forceinline__ void unpack8f(const v4u x, float (&f)[8]) {
    f[0] = __builtin_bit_cast(float, x.x << 16); f[1] = __builtin_bit_cast(float, x.x & 0xffff0000u); f[2] = __builtin_bit_cast(float, x.y << 16); f[3] = __builtin_bit_cast(float, x.y & 0xffff0000u);
    f[4] = __builtin_bit_cast(float, x.z << 16); f[5] = __builtin_bit_cast(float, x.z & 0xffff0000u); f[6] = __builtin_bit_cast(float, x.w << 16); f[7] = __builtin_bit_cast(float, x.w & 0xffff0000u);
}
typedef short s16x4 __attribute__((ext_vector_type(4)));
template <int SB> __device__ __forceinline__ void tr_frag2(unsigned base, bf16x8& f0, bf16x8& f1) {
    s16x4 a, b, c, d;
    asm volatile("ds_read_b64_tr_b16 %0, %4\n\tds_read_b64_tr_b16 %1, %4 offset:%5\n\tds_read_b64_tr_b16 %2, %4 offset:%6\n\tds_read_b64_tr_b16 %3, %4 offset:%7\n\ts_waitcnt lgkmcnt(0)"
                 : "=&v"(a), "=&v"(b), "=&v"(c), "=&v"(d) : "v"(base), "i"(4 * SB), "i"(32 * SB), "i"(36 * SB) : "memory");
    f0 = __builtin_shufflevector(a, b, 0, 1, 2, 3, 4, 5, 6, 7); f1 = __builtin_shufflevector(c, d, 0, 1, 2, 3, 4, 5, 6, 7);
}
template <int SB> __device__ __forceinline__ void tr_frag4n(unsigned base, bf16x8& f0, bf16x8& f1, bf16x8& f2, bf16x8& f3) {
    s16x4 a0, b0, a1, b1, a2, b2, a3, b3;
    asm volatile("ds_read_b64_tr_b16 %0, %8\n\tds_read_b64_tr_b16 %1, %8 offset:%9\n\tds_read_b64_tr_b16 %2, %8 offset:32\n\tds_read_b64_tr_b16 %3, %8 offset:%10\n\t"
                 "ds_read_b64_tr_b16 %4, %8 offset:64\n\tds_read_b64_tr_b16 %5, %8 offset:%11\n\tds_read_b64_tr_b16 %6, %8 offset:96\n\tds_read_b64_tr_b16 %7, %8 offset:%12\n\ts_waitcnt lgkmcnt(0)"
                 : "=&v"(a0), "=&v"(b0), "=&v"(a1), "=&v"(b1), "=&v"(a2), "=&v"(b2), "=&v"(a3), "=&v"(b3)
                 : "v"(base), "i"(4 * SB), "i"(4 * SB + 32), "i"(4 * SB + 64), "i"(4 * SB + 96) : "memory");
    f0 = __builtin_shufflevector(a0, b0, 0, 1, 2, 3, 4, 5, 6, 7); f1 = __builtin_shufflevector(a1, b1, 0, 1, 2, 3, 4, 5, 6, 7);
    f2 = __builtin_shufflevector(a2, b2, 0, 1, 2, 3, 4, 5, 6, 7); f3 = __builtin_shufflevector(a3, b3, 0, 1, 2, 3, 4, 5, 6, 7);
}
template <int SB> __device__ __forceinline__ f32x4 mma16_trB64(const LAS unsigned char* A, int sa, unsigned bbase, int n0, f32x4 acc, int r, int kg) {
    bf16x8 b0, b1; tr_frag2<SB>(bbase + (unsigned)((8 * kg + (r >> 2)) * SB + (n0 + 4 * (r & 3)) * 2), b0, b1);
    const bf16x8 a0 = *(const LAS bf16x8*)(A + r * sa + (8 * kg) * 2), a1 = *(const LAS bf16x8*)(A + r * sa + (32 + 8 * kg) * 2);
    acc = __builtin_amdgcn_mfma_f32_16x16x32_bf16(a0, b0, acc, 0, 0, 0);
    return __builtin_amdgcn_mfma_f32_16x16x32_bf16(a1, b1, acc, 0, 0, 0);
}
template <int MODE>
__device__ __forceinline__ void gla_unit(const Frame& F, const Args& A, int unit) {
    const int b = unit >> 9, c = (unit >> 2) & 127, h = unit & 3;
    const size_t t0 = (size_t)b * SEQ + (size_t)c * 64;
    const GAS bf16* proj = (const GAS bf16*)(A.ws + WS_PROJ);
    LAS unsigned char* L = F.lds;
    LAS float* GLR = (LAS float*)(L + 0);
    LAS float* SEG = (LAS float*)(L + 4096);
    LAS float* RSQ = (LAS float*)(L + 6144);
    LAS unsigned char* QI = L + 8192;
    LAS unsigned char* KI = QI + 64 * SA64;
    LAS unsigned char* VT = KI + 64 * SA64;
    LAS unsigned char* SP = VT + 128 * SA64;
    LAS unsigned char* AT = SP + 128 * SA64;
    LAS unsigned char* GO = AT + 64 * SA64;
    int tid = F.tid, seg = F.wave;
    asm volatile("" : "+v"(tid)); asm volatile("" : "+s"(seg));
    const int d = tid & 63;
    {
        const int row = tid >> 3, ch = tid & 7;
        const GAS bf16* prow = proj + (t0 + row) * NINP;
        const v4u kq = *(const GAS v4u*)(prow + C_K + h * 64 + ch * 8);
        v4u qq = kq; if (MODE == 1) qq = *(const GAS v4u*)(prow + C_Q + h * 64 + ch * 8);
        const int o = tid & 15, jp = tid >> 4;
        const v4u va = *(const GAS v4u*)(proj + (t0 + 2 * jp) * NINP + C_V + h * 128 + o * 8), vb = *(const GAS v4u*)(proj + (t0 + 2 * jp + 1) * NINP + C_V + h * 128 + o * 8);
        v4u g0 = kq, g1 = kq, s0 = kq, s1 = kq;
        if (MODE == 1) {
            const int r2 = tid >> 4, c2 = tid & 15;
            g0 = *(const GAS v4u*)(proj + (t0 + r2) * NINP + C_GOUT + h * 128 + c2 * 8); g1 = *(const GAS v4u*)(proj + (t0 + r2 + 32) * NINP + C_GOUT + h * 128 + c2 * 8);
            const GAS bf16* sp = (const GAS bf16*)(A.ws + WS_GST) + (size_t)unit * 8192;
            s0 = *(const GAS v4u*)(sp + (tid >> 3) * 64 + (tid & 7) * 8); s1 = *(const GAS v4u*)(sp + (64 + (tid >> 3)) * 64 + (tid & 7) * 8);
        }
        v4u gl = kq; if (tid < 128) gl = *(const GAS v4u*)(proj + (t0 + (tid >> 1)) * NINP + C_GLR + (tid & 1) * 8);
        if (MODE == 1) { *(LAS v4u*)(QI + row * SA64 + ch * 16) = qq; *(LAS v4u*)(KI + row * SA64 + ch * 16) = kq; }
        else *(LAS v4u*)(GO + row * SA64 + ch * 16) = kq;
        *(LAS v4u*)(VT + (2 * jp) * SA128 + o * 16) = va; *(LAS v4u*)(VT + (2 * jp + 1) * SA128 + o * 16) = vb;
        if (MODE == 1) {
            const int r2 = tid >> 4, c2 = tid & 15;
            *(LAS v4u*)(GO + r2 * SA128 + c2 * 16) = g0; *(LAS v4u*)(GO + (r2 + 32) * SA128 + c2 * 16) = g1;
            *(LAS v4u*)(SP + (tid >> 3) * SA64 + (tid & 7) * 16) = s0; *(LAS v4u*)(SP + (64 + (tid >> 3)) * SA64 + (tid & 7) * 16) = s1;
        }
        if (tid < 128) { float f[8]; unpack8f(gl, f);
#pragma unroll
            for (int q = 0; q < 8; ++q) GLR[(tid >> 1) * 16 + (tid & 1) * 8 + q] = f[q]; }
    }
    float wv[16];
#pragma unroll
    for (int r = 0; r < 16; ++r) wv[r] = A.in[3][r * 256 + h * 64 + d];
    const float bgv = A.in[4][h * 64 + d];
    __syncthreads();
    float Gv[8]; float run = 0.f;
#pragma unroll
    for (int ii = 0; ii < 8; ++ii) { const int i = seg * 8 + ii; float z = bgv;
#pragma unroll
        for (int r = 0; r < 16; ++r) z += GLR[i * 16 + r] * wv[r];
        run += logsigmoid_f(z) * (1.f / 16.f); Gv[ii] = run; }
    SEG[seg * 64 + d] = run;
    __syncthreads();
    float off = 0.f, tot = 0.f;
#pragma unroll
    for (int s = 0; s < 8; ++s) { const float v = SEG[s * 64 + d]; tot += v; off += (s < seg) ? v : 0.f; }
#pragma unroll
    for (int ii = 0; ii < 8; ++ii) Gv[ii] += off;
    if (MODE == 0) {
        unsigned w[4];
#pragma unroll
        for (int ii = 0; ii < 8; ii += 2) {
            const float k0 = bf2f(*(const LAS bf16*)(GO + (seg * 8 + ii) * SA64 + d * 2)) * __expf(tot - Gv[ii]);
            const float k1 = bf2f(*(const LAS bf16*)(GO + (seg * 8 + ii + 1) * SA64 + d * 2)) * __expf(tot - Gv[ii + 1]);
            w[ii >> 1] = pk2(k0, k1); }
        *(LAS v4u*)(KI + d * SA64 + seg * 16) = (v4u){w[0], w[1], w[2], w[3]};
        if (seg == 0) ((GAS float*)(A.ws + WS_GDEC))[unit * 64 + d] = __expf(tot);
    } else {
#pragma unroll
        for (int ii = 0; ii < 8; ++ii) { const int i = seg * 8 + ii;
            LAS bf16* qp = (LAS bf16*)(QI + i * SA64 + d * 2); LAS bf16* kp = (LAS bf16*)(KI + i * SA64 + d * 2);
            *qp = (bf16)f2bf(bf2f(*qp) * 0.125f * __expf(Gv[ii])); *kp = (bf16)f2bf(bf2f(*kp) * __expf(-Gv[ii])); }
    }
    __syncthreads();
    const int r = tid & 15, kg = (tid >> 4) & 3, w = seg;
    const f32x4 zero = (f32x4){0.f, 0.f, 0.f, 0.f};
    if (MODE == 0) {
        const int mt = w & 3, nb = (w >> 2) * 4;
        GAS bf16* stT = (GAS bf16*)(A.ws + WS_GST) + (size_t)unit * 8192;
#pragma unroll
        for (int n = 0; n < 4; ++n) {
            const f32x4 acc = mma16_trB64<SA128>(KI + mt * 16 * SA64, SA64, (unsigned)(size_t)VT, (nb + n) * 16, zero, r, kg);
            const int dv = (nb + n) * 16 + r, d0 = mt * 16 + kg * 4;
            *(GAS u32x2*)(stT + dv * 64 + d0) = (u32x2){pk2(acc[0], acc[1]), pk2(acc[2], acc[3])}; }
    } else {
        const int mt = w & 3;
#pragma unroll
        for (int n = 0; n < 2; ++n) { const int nt = (w >> 2) * 2 + n;
            const f32x4 acc = mma16(QI + mt * 16 * SA64, SA64, KI + nt * 16 * SA64, SA64, 64, zero, r, kg);
#pragma unroll
            for (int ii = 0; ii < 4; ++ii) { const int i = mt * 16 + kg * 4 + ii, j = nt * 16 + r; *(LAS bf16*)(AT + i * SA64 + j * 2) = (bf16)f2bf(j <= i ? acc[ii] : 0.f); } }
        __syncthreads();
        const int nb = (w >> 2) * 4;
        f32x4 o[4]; float rs[4] = {0.f, 0.f, 0.f, 0.f};
#pragma unroll
        for (int n = 0; n < 4; ++n) {
            f32x4 acc = mma16_trB64<SA128>(AT + mt * 16 * SA64, SA64, (unsigned)(size_t)VT, (nb + n) * 16, zero, r, kg);
            acc = mma16(QI + mt * 16 * SA64, SA64, SP + (nb + n) * 16 * SA64, SA64, 64, acc, r, kg);
            o[n] = acc;
#pragma unroll
            for (int ii = 0; ii < 4; ++ii) rs[ii] += acc[ii] * acc[ii]; }
#pragma unroll
        for (int ii = 0; ii < 4; ++ii) { rs[ii] += __shfl_xor(rs[ii], 1); rs[ii] += __shfl_xor(rs[ii], 2); rs[ii] += __shfl_xor(rs[ii], 4); rs[ii] += __shfl_xor(rs[ii], 8); }
        if (r == 0) {
#pragma unroll
            for (int ii = 0; ii < 4; ++ii) RSQ[(w >> 2) * 64 + mt * 16 + kg * 4 + ii] = rs[ii]; }
        __syncthreads();
        float rr[4];
#pragma unroll
        for (int ii = 0; ii < 4; ++ii) { const int row = mt * 16 + kg * 4 + ii; rr[ii] = rsqrtf((RSQ[row] + RSQ[64 + row]) * (1.f / 128.f) + EPS); }
#pragma unroll
        for (int n = 0; n < 4; ++n) { const int dv = (nb + n) * 16 + r; const float nwv = A.in[5][dv];
#pragma unroll
            for (int ii = 0; ii < 4; ++ii) { LAS bf16* gp = (LAS bf16*)(GO + (mt * 16 + kg * 4 + ii) * SA128 + dv * 2);
                *gp = (bf16)f2bf(o[n][ii] * rr[ii] * nwv * silu_f(bf2f(*gp))); } }
        __syncthreads();
        {   const int r2 = tid >> 4, c2 = tid & 15; GAS bf16* mixed = (GAS bf16*)(A.ws + WS_MIX);
            *(GAS v4u*)(mixed + (t0 + r2) * D + h * 128 + c2 * 8) = *(const LAS v4u*)(GO + r2 * SA128 + c2 * 16);
            *(GAS v4u*)(mixed + (t0 + r2 + 32) * D + h * 128 + c2 * 8) = *(const LAS v4u*)(GO + (r2 + 32) * SA128 + c2 * 16); }
    }
    __syncthreads();
}

template <int MODE>
__device__ __forceinline__ void ssd_unit(const Frame& F, const Args& A, int unit) {
    const int b = unit >> 7, c = (unit >> 1) & 63, g = unit & 1;
    const size_t t0 = (size_t)b * SEQ + (size_t)c * 128;
    const GAS bf16* proj = (const GAS bf16*)(A.ws + WS_PROJ);
    LAS unsigned char* L = F.lds;
    LAS float* DT = (LAS float*)(L + 0);
    LAS float* ACU = (LAS float*)(L + 2048);
    LAS unsigned char* CM = L + 4096;
    LAS unsigned char* BM = CM + 128 * SA64;
    LAS unsigned char* XT = BM + 128 * SA64;
    LAS unsigned char* PW = XT + 128 * SXN;
    LAS unsigned char* ZW = PW + 8 * 16 * SA32;
    LAS float* RRW = (LAS float*)(ZW + 8 * 16 * SA64);
    int tid = F.tid, w = F.wave;
    asm volatile("" : "+v"(tid)); asm volatile("" : "+s"(w));
    const int lane = tid & 63;
    if (w < 4) {
        const int hd = g * 4 + w; const float Ah = -__expf(A.in[9][hd]), dtb = A.in[8][hd];
        const float dt0 = softplus_f(bf2f(proj[(t0 + 2 * lane) * NINP + C_DT + hd]) + dtb), dt1 = softplus_f(bf2f(proj[(t0 + 2 * lane + 1) * NINP + C_DT + hd]) + dtb);
        const float a0 = dt0 * Ah, a1 = dt1 * Ah; float s = a0 + a1;
#pragma unroll
        for (int o = 1; o < 64; o <<= 1) { const float t = __shfl_up(s, o); s += (lane >= o) ? t : 0.f; }
        DT[(2 * lane) * 4 + w] = dt0; DT[(2 * lane + 1) * 4 + w] = dt1; ACU[(2 * lane) * 4 + w] = s - a1; ACU[(2 * lane + 1) * 4 + w] = s;
        if (MODE == 0 && lane == 63) ((GAS float*)(A.ws + WS_SDEC))[(b * 64 + c) * 8 + hd] = __expf(s);
    }
    __syncthreads();
    if (tid < 384) {
        const int o = tid % 48, sg = tid / 48;
        if (!(MODE == 0 && o >= 40)) {
            const int cc0 = o < 32 ? g * 256 + 8 * o : (o < 40 ? 512 + g * 64 + 8 * (o - 32) : 640 + g * 64 + 8 * (o - 40));
            float wt[4][8], cb[8];
#pragma unroll
            for (int j = 0; j < 4; ++j) { const f32x4 a = *(const GAS f32x4*)(A.in[6] + j * 768 + cc0), bq = *(const GAS f32x4*)(A.in[6] + j * 768 + cc0 + 4);
                wt[j][0] = a.x; wt[j][1] = a.y; wt[j][2] = a.z; wt[j][3] = a.w; wt[j][4] = bq.x; wt[j][5] = bq.y; wt[j][6] = bq.z; wt[j][7] = bq.w; }
            { const f32x4 a = *(const GAS f32x4*)(A.in[7] + cc0), bq = *(const GAS f32x4*)(A.in[7] + cc0 + 4); cb[0] = a.x; cb[1] = a.y; cb[2] = a.z; cb[3] = a.w; cb[4] = bq.x; cb[5] = bq.y; cb[6] = bq.z; cb[7] = bq.w; }
            const GAS bf16* src = proj + (t0 + 16 * sg) * NINP + C_XBC + cc0;
            float x0[8], x1[8], x2[8];
            if (c > 0 || sg > 0) { unpack8f(*(const GAS v4u*)(src - 3 * NINP), x0); unpack8f(*(const GAS v4u*)(src - 2 * NINP), x1); unpack8f(*(const GAS v4u*)(src - 1 * NINP), x2); }
            else {
#pragma unroll
                for (int q = 0; q < 8; ++q) { x0[q] = 0.f; x1[q] = 0.f; x2[q] = 0.f; } }
            const int hl = o >> 3, p0 = (o & 7) * 8;
            float sc_end = 0.f; if (MODE == 0 && o < 32) sc_end = ACU[127 * 4 + hl];
#pragma unroll 1
            for (int hf = 0; hf < 2; ++hf) {
                v4u xin[8];
#pragma unroll
                for (int i = 0; i < 8; ++i) xin[i] = *(const GAS v4u*)(src + (size_t)(hf * 8 + i) * NINP);
#pragma unroll
                for (int i = 0; i < 8; ++i) {
                    const int l = 16 * sg + hf * 8 + i;
                    float xc[8]; unpack8f(xin[i], xc);
                    float v[8];
#pragma unroll
                    for (int q = 0; q < 8; ++q) v[q] = silu_f(cb[q] + wt[0][q] * x0[q] + wt[1][q] * x1[q] + wt[2][q] * x2[q] + wt[3][q] * xc[q]);
#pragma unroll
                    for (int q = 0; q < 8; ++q) { x0[q] = x1[q]; x1[q] = x2[q]; x2[q] = xc[q]; }
                    if (MODE == 0 && o < 32) { const float sc = DT[l * 4 + hl] * __expf(sc_end - ACU[l * 4 + hl]);
#pragma unroll
                        for (int q = 0; q < 8; ++q) v[q] *= sc; }
                    const v4u ov = (v4u){pk2(v[0], v[1]), pk2(v[2], v[3]), pk2(v[4], v[5]), pk2(v[6], v[7])};
                    if (o < 32) *(LAS v4u*)(XT + l * SXN + o * 16) = ov;
                    else *(LAS v4u*)((o < 40 ? BM : CM) + l * SA64 + (o & 7) * 16) = ov;
                }
            }
        }
    }
    __syncthreads();
    const int r = lane & 15, kg = lane >> 4;
    const f32x4 zero = (f32x4){0.f, 0.f, 0.f, 0.f};
    if (MODE == 0) {
        const int hl = w >> 1;
        GAS bf16* st = (GAS bf16*)(A.ws + WS_SST) + ((size_t)((b * 64 + c) * 8 + g * 4 + hl)) * 4096;
#pragma unroll
        for (int mt = 0; mt < 4; ++mt)
#pragma unroll
            for (int n = 0; n < 2; ++n) { const int nt = (w & 1) * 2 + n;
                f32x4 acc = zero;
#pragma unroll
                for (int kh = 0; kh < 2; ++kh) {
                    bf16x8 a0, a1, b0, b1;
                    tr_frag2<SA64>((unsigned)(size_t)BM + (unsigned)((64 * kh + 8 * kg + (r >> 2)) * SA64 + (mt * 16 + 4 * (r & 3)) * 2), a0, a1);
                    tr_frag2<SXN>((unsigned)(size_t)XT + (unsigned)((64 * kh + 8 * kg + (r >> 2)) * SXN + (hl * 64 + nt * 16 + 4 * (r & 3)) * 2), b0, b1);
                    acc = __builtin_amdgcn_mfma_f32_16x16x32_bf16(a0, b0, acc, 0, 0, 0); acc = __builtin_amdgcn_mfma_f32_16x16x32_bf16(a1, b1, acc, 0, 0, 0); }
                const int p = nt * 16 + r, n0 = mt * 16 + kg * 4;
                *(GAS u32x2*)(st + p * 64 + n0) = (u32x2){pk2(acc[0], acc[1]), pk2(acc[2], acc[3])}; }
    } else {
        f32x4 sc[8];
#pragma unroll
        for (int nt = 0; nt < 8; ++nt) { sc[nt] = zero; if (nt <= w) sc[nt] = mma16(CM + w * 16 * SA64, SA64, BM + nt * 16 * SA64, SA64, 64, zero, r, kg); }
        __syncthreads();
        const GAS bf16* spg = (const GAS bf16*)(A.ws + WS_SST) + ((size_t)((b * 64 + c) * 8 + g * 4)) * 4096;
        for (int e = tid; e < 1024; e += 512) { const int row = e >> 3, ch = e & 7; *(LAS v4u*)(BM + row * SA64 + ch * 16) = *(const GAS v4u*)(spg + row * 64 + ch * 8); }
        __syncthreads();
        float rs[4] = {0.f, 0.f, 0.f, 0.f};
        LAS unsigned char* pw = PW + w * 16 * SA32;
        LAS unsigned char* zw = ZW + w * 16 * SA64;
        const int orow = lane >> 3, och = lane & 7;
        const GAS bf16* zsrc = proj + (t0 + w * 16 + orow) * NINP + C_Z + g * 256 + och * 8;
        v4u ysave[4][2];
#pragma unroll
        for (int hl = 0; hl < 4; ++hl) {
            if (hl == 2) {
                __syncthreads();
                for (int e = tid; e < 1024; e += 512) { const int row = e >> 3, ch = e & 7; *(LAS v4u*)(BM + row * SA64 + ch * 16) = *(const GAS v4u*)(spg + 2 * 4096 + row * 64 + ch * 8); }
                __syncthreads();
            }
            asm volatile("" ::: "memory");
            const v4u z0 = *(const GAS v4u*)(zsrc + hl * 64), z1 = *(const GAS v4u*)(zsrc + (size_t)8 * NINP + hl * 64);
            float acl[4];
#pragma unroll
            for (int ii = 0; ii < 4; ++ii) acl[ii] = ACU[(w * 16 + kg * 4 + ii) * 4 + hl];
            f32x4 yd[4] = {zero, zero, zero, zero};
#pragma unroll
            for (int kc = 0; kc < 4; ++kc) {
                if (kc * 2 <= w) {
#pragma unroll
                    for (int half = 0; half < 2; ++half) { const int stl = 2 * kc + half; const int s = stl * 16 + r;
                        const float acs = ACU[s * 4 + hl], dts = DT[s * 4 + hl];
#pragma unroll
                        for (int ii = 0; ii < 4; ++ii) { const int l = w * 16 + kg * 4 + ii;
                            const float pv = (s <= l) ? sc[stl][ii] * __expf(acl[ii] - acs) * dts : 0.f;
                            *(LAS bf16*)(pw + (kg * 4 + ii) * SA32 + (half * 16 + r) * 2) = (bf16)f2bf(pv); } }
                    LDS_WAIT();
                    const bf16x8 a = *(const LAS bf16x8*)(pw + r * SA32 + kg * 16);
                    bf16x8 bb[4];
                    tr_frag4n<SXN>((unsigned)(size_t)XT + (unsigned)((kc * 32 + 8 * kg + (r >> 2)) * SXN + (hl * 64 + 4 * (r & 3)) * 2), bb[0], bb[1], bb[2], bb[3]);
#pragma unroll
                    for (int nt = 0; nt < 4; ++nt) yd[nt] = __builtin_amdgcn_mfma_f32_16x16x32_bf16(a, bb[nt], yd[nt], 0, 0, 0);
                    LDS_WAIT();
                }
            }
            *(LAS v4u*)(zw + orow * SA64 + och * 16) = z0; *(LAS v4u*)(zw + (orow + 8) * SA64 + och * 16) = z1;
            LDS_WAIT();
            const float Dk = A.in[10][g * 4 + hl];
            float eal[4];
#pragma unroll
            for (int ii = 0; ii < 4; ++ii) eal[ii] = __expf(acl[ii]);
#pragma unroll
            for (int nt = 0; nt < 4; ++nt) {
                const f32x4 yo = mma16(CM + w * 16 * SA64, SA64, BM + (hl & 1) * 64 * SA64 + nt * 16 * SA64, SA64, 64, zero, r, kg);
                const int p = nt * 16 + r;
#pragma unroll
                for (int ii = 0; ii < 4; ++ii) { const int l = w * 16 + kg * 4 + ii;
                    const float xv = bf2f(*(const LAS bf16*)(XT + l * SXN + (hl * 64 + p) * 2));
                    LAS bf16* zp = (LAS bf16*)(zw + (kg * 4 + ii) * SA64 + p * 2);
                    const float y = (yd[nt][ii] + eal[ii] * yo[ii] + xv * Dk) * silu_f(bf2f(*zp));
                    const unsigned short yb = (unsigned short)f2bf(y); const float yq = bf2f(yb);
                    rs[ii] += yq * yq;
                    *zp = yb; }
            }
            LDS_WAIT();
            ysave[hl][0] = *(const LAS v4u*)(zw + orow * SA64 + och * 16); ysave[hl][1] = *(const LAS v4u*)(zw + (orow + 8) * SA64 + och * 16);
            LDS_WAIT();
        }
#pragma unroll
        for (int ii = 0; ii < 4; ++ii) { rs[ii] += __shfl_xor(rs[ii], 1); rs[ii] += __shfl_xor(rs[ii], 2); rs[ii] += __shfl_xor(rs[ii], 4); rs[ii] += __shfl_xor(rs[ii], 8);
            rs[ii] = rsqrtf(rs[ii] * (1.f / 256.f) + EPS); }
        if (r == 0) {
#pragma unroll
            for (int ii = 0; ii < 4; ++ii) RRW[w * 16 + kg * 4 + ii] = rs[ii]; }
        LDS_WAIT();
        const float rr0 = RRW[w * 16 + orow], rr1 = RRW[w * 16 + orow + 8];
        GAS bf16* mdst = (GAS bf16*)(A.ws + WS_MIX) + (t0 + w * 16 + orow) * D + 512 + g * 256 + och * 8;
#pragma unroll
        for (int hl = 0; hl < 4; ++hl) {
            const f32x4 nwa = *(const GAS f32x4*)(A.in[11] + g * 256 + hl * 64 + och * 8), nwb = *(const GAS f32x4*)(A.in[11] + g * 256 + hl * 64 + och * 8 + 4);
            const float nw8[8] = {nwa.x, nwa.y, nwa.z, nwa.w, nwb.x, nwb.y, nwb.z, nwb.w};
#pragma unroll
            for (int hh = 0; hh < 2; ++hh) { float f[8]; unpack8f(ysave[hl][hh], f); const float rr_ = hh ? rr1 : rr0;
#pragma unroll
                for (int q = 0; q < 8; ++q) f[q] *= rr_ * nw8[q];
                *(GAS v4u*)(mdst + (size_t)(8 * hh) * D + hl * 64) = (v4u){pk2(f[0], f[1]), pk2(f[2], f[3]), pk2(f[4], f[5]), pk2(f[6], f[7])}; }
        }
    }
    __syncthreads();
}

template <bool DRY> __device__ __forceinline__ void scan_phase(const Frame& F, const Args& A) {
    if (F.tid < 128) {
        GAS unsigned* st = (GAS unsigned*)(A.ws + WS_GST); const GAS float* dec = (const GAS float*)(A.ws + WS_GDEC);
        for (int gi = blockIdx.x * 128 + F.tid; gi < 8 * 4096; gi += F.G * 128) {
            const int bh = gi >> 12, e = gi & 4095, b = bh >> 2, h = bh & 3, d = (e & 31) * 2;
            float S0 = 0.f, S1 = 0.f;
#pragma unroll 1
            for (int c = 0; c < 128; c += 16) {
                unsigned v[16]; float d0[16], d1[16];
#pragma unroll
                for (int u = 0; u < 16; ++u) { const size_t un = (size_t)((b * 128 + c + u) * 4 + h); v[u] = st[un * 4096 + e]; d0[u] = dec[un * 64 + d]; d1[u] = dec[un * 64 + d + 1]; }
#pragma unroll
                for (int u = 0; u < 16; ++u) { const size_t un = (size_t)((b * 128 + c + u) * 4 + h); (DRY ? (GAS unsigned*)(A.ws + 232 * MiB) : st)[un * 4096 + e] = pk2(S0, S1);
                    S0 = d0[u] * S0 + bf2f((unsigned short)(v[u] & 0xffffu)); S1 = d1[u] * S1 + bf2f((unsigned short)(v[u] >> 16)); }
            }
        }
    } else if (F.tid < 256) {
        GAS unsigned* st = (GAS unsigned*)(A.ws + WS_SST); const GAS float* dec = (const GAS float*)(A.ws + WS_SDEC);
        for (int gi = blockIdx.x * 128 + (F.tid - 128); gi < 16 * 2048; gi += F.G * 128) {
            const int bh = gi >> 11, e = gi & 2047, b = bh >> 3, hd = bh & 7;
            float S0 = 0.f, S1 = 0.f;
#pragma unroll 1
            for (int c = 0; c < 64; c += 16) {
                unsigned v[16]; float dd[16];
#pragma unroll
                for (int u = 0; u < 16; ++u) { const size_t un = (size_t)((b * 64 + c + u) * 8 + hd); v[u] = st[un * 2048 + e]; dd[u] = dec[un]; }
#pragma unroll
                for (int u = 0; u < 16; ++u) { const size_t un = (size_t)((b * 64 + c + u) * 8 + hd); (DRY ? (GAS unsigned*)(A.ws + 248 * MiB) : st)[un * 2048 + e] = pk2(S0, S1);
                    S0 = dd[u] * S0 + bf2f((unsigned short)(v[u] & 0xffffu)); S1 = dd[u] * S1 + bf2f((unsigned short)(v[u] >> 16)); }
            }
        }
    }
}
constexpr size_t WS_HB = WS_PROJ;
constexpr size_t WS_Q = 144 * MiB;
constexpr size_t WS_IDX = 232 * MiB;
constexpr size_t WS_GATE = 240 * MiB;
typedef float f32x16 __attribute__((ext_vector_type(16)));
__device__ __forceinline__ float as_f(unsigned u) { return __builtin_bit_cast(float, u); }
__device__ __forceinline__ unsigned as_u(float f) { return __builtin_bit_cast(unsigned, f); }
#define CE_DESC(a, b) do { const float hi_ = fmaxf((a), (b)), lo_ = fminf((a), (b)); (a) = hi_; (b) = lo_; } while (0)
template <int OFF, int N> __device__ __forceinline__ void sort16_desc(float (&v)[N]) {
#pragma unroll
    for (int k = 2; k <= 16; k <<= 1)
#pragma unroll
        for (int j = k >> 1; j > 0; j >>= 1)
#pragma unroll
            for (int i = 0; i < 16; ++i) { const int l = i ^ j; if (l > i) { if ((i & k) == 0) CE_DESC(v[OFF + i], v[OFF + l]); else CE_DESC(v[OFF + l], v[OFF + i]); } }
}
template <int OA, int OB, int NA, int NB> __device__ __forceinline__ void merge16_desc(float (&a)[NA], const float (&b)[NB]) {
#pragma unroll
    for (int i = 0; i < 16; ++i) a[OA + i] = fmaxf(a[OA + i], b[OB + 15 - i]);
#pragma unroll
    for (int j = 8; j > 0; j >>= 1)
#pragma unroll
        for (int i = 0; i < 16; ++i) { const int l = i ^ j; if (l > i) CE_DESC(a[OA + i], a[OA + l]); }
}
constexpr unsigned char CAND0[32] = {0, 2, 4, 6, 8, 10, 12, 14, 16, 18, 20, 22, 32, 34, 36, 49, 51, 65, 80, 96, 112, 128, 160, 192, 224, 255, 255, 255, 255, 255, 255, 255};
constexpr unsigned char CAND1[32] = {1, 3, 5, 7, 9, 11, 13, 15, 17, 19, 21, 23, 33, 35, 48, 50, 64, 66, 81, 97, 113, 144, 176, 208, 240, 255, 255, 255, 255, 255, 255, 255};

__device__ __forceinline__ void topk_wave_job(const Args& A, const LAS unsigned char* SK, LAS unsigned char* TAB, int tok0, int h, int lane) {
    const int r = lane & 31, hi = lane >> 5;
    const GAS bf16* qrow = (const GAS bf16*)(A.ws + WS_Q) + (size_t)(tok0 + r) * NQ + h * 256 + 8 * hi;
    float LST[2][16];
#pragma unroll
    for (int p = 0; p < 2; ++p) {
        __builtin_amdgcn_sched_barrier(0);
        bf16x8 bq[8];
#pragma unroll
        for (int s = 0; s < 8; ++s) bq[s] = *(const GAS bf16x8*)(qrow + p * 128 + 16 * s);
        float v[64];
#pragma unroll
        for (int kt = 0; kt < 4; ++kt) {
            f32x16 acc;
#pragma unroll
            for (int i = 0; i < 16; ++i) acc[i] = 0.f;
#pragma unroll
            for (int s = 0; s < 8; ++s) { const bf16x8 a = *(const LAS bf16x8*)(SK + (p * 128 + kt * 32 + r) * SA128 + (16 * s + 8 * hi) * 2);
                acc = __builtin_amdgcn_mfma_f32_32x32x16_bf16(a, bq[s], acc, 0, 0, 0); }
#pragma unroll
            for (int i = 0; i < 16; ++i) { const unsigned key = (unsigned)(kt * 32 + (i & 3) + 8 * (i >> 2)) | ((unsigned)hi << 2); v[kt * 16 + i] = as_f((as_u(acc[i]) & ~127u) | key); }
        }
        sort16_desc<0>(v); sort16_desc<16>(v); sort16_desc<32>(v); sort16_desc<48>(v);
        merge16_desc<0, 16>(v, v); merge16_desc<32, 48>(v, v); merge16_desc<0, 32>(v, v);
        float o[16];
#pragma unroll
        for (int i = 0; i < 16; ++i) o[i] = __shfl_xor(v[i], 32);
        merge16_desc<0, 0>(v, o);
#pragma unroll
        for (int i = 0; i < 16; ++i) LST[p][i] = v[i];
    }
    __builtin_amdgcn_sched_barrier(0);
    {   unsigned pk[4];
#pragma unroll
        for (int q4 = 0; q4 < 4; ++q4) { unsigned wv = 0;
#pragma unroll
            for (int b = 0; b < 4; ++b) { float l0 = LST[0][q4 * 4 + b], l1 = LST[1][q4 * 4 + b]; asm volatile("" : "+v"(l0), "+v"(l1));
                const unsigned x = as_u(hi ? l1 : l0) & 127u; wv |= x << (8 * b); }
            pk[q4] = wv; }
        *(LAS v4u*)(TAB + r * 32 + hi * 16) = (v4u){pk[0], pk[1], pk[2], pk[3]};
    }
    float c[32];
    float va[16], vb2[16];
#pragma unroll
    for (int i = 0; i < 16; ++i) { va[i] = as_f(as_u(LST[0][i]) & ~127u); vb2[i] = as_f(as_u(LST[1][i]) & ~127u); }
#define CANDV(i0, j0, k0, i1, j1, k1) as_f((as_u(hi ? (va[i1] + vb2[j1]) : (va[i0] + vb2[j0])) & ~255u) | (hi ? (k1) : (k0)))
    c[0] = CANDV(0, 0, 0u, 0, 1, 1u);
    c[1] = CANDV(0, 2, 2u, 0, 3, 3u);
    c[2] = CANDV(0, 4, 4u, 0, 5, 5u);
    c[3] = CANDV(0, 6, 6u, 0, 7, 7u);
    c[4] = CANDV(0, 8, 8u, 0, 9, 9u);
    c[5] = CANDV(0, 10, 10u, 0, 11, 11u);
    c[6] = CANDV(0, 12, 12u, 0, 13, 13u);
    c[7] = CANDV(0, 14, 14u, 0, 15, 15u);
    c[8] = CANDV(1, 0, 16u, 1, 1, 17u);
    c[9] = CANDV(1, 2, 18u, 1, 3, 19u);
    c[10] = CANDV(1, 4, 20u, 1, 5, 21u);
    c[11] = CANDV(1, 6, 22u, 1, 7, 23u);
    c[12] = CANDV(2, 0, 32u, 2, 1, 33u);
    c[13] = CANDV(2, 2, 34u, 2, 3, 35u);
    c[14] = CANDV(2, 4, 36u, 3, 0, 48u);
    c[15] = CANDV(3, 1, 49u, 3, 2, 50u);
    c[16] = CANDV(3, 3, 51u, 4, 0, 64u);
    c[17] = CANDV(4, 1, 65u, 4, 2, 66u);
    c[18] = CANDV(5, 0, 80u, 5, 1, 81u);
    c[19] = CANDV(6, 0, 96u, 6, 1, 97u);
    c[20] = CANDV(7, 0, 112u, 7, 1, 113u);
    c[21] = CANDV(8, 0, 128u, 9, 0, 144u);
    c[22] = CANDV(10, 0, 160u, 11, 0, 176u);
    c[23] = CANDV(12, 0, 192u, 13, 0, 208u);
    c[24] = CANDV(14, 0, 224u, 15, 0, 240u);
    c[25] = as_f(0xFF61B1E6u | 255u);
    c[26] = as_f(0xFF61B1E6u | 255u);
    c[27] = as_f(0xFF61B1E6u | 255u);
    c[28] = as_f(0xFF61B1E6u | 255u);
    c[29] = as_f(0xFF61B1E6u | 255u);
    c[30] = as_f(0xFF61B1E6u | 255u);
    c[31] = as_f(0xFF61B1E6u | 255u);
#undef CANDV
    sort16_desc<0>(c); sort16_desc<16>(c); merge16_desc<0, 16>(c, c);
    {   float o[16];
#pragma unroll
        for (int i = 0; i < 16; ++i) o[i] = __shfl_xor(c[i], 32);
        merge16_desc<0, 0>(c, o); }
    const float mx = as_f(as_u(c[0]) & ~255u);
    float ex[16], den = 0.f;
#pragma unroll
    for (int k = 0; k < 16; ++k) { ex[k] = __expf(as_f(as_u(c[k]) & ~255u) - mx); den += ex[k]; }
    const float inv = 1.f / den;
    LDS_WAIT();
    unsigned eid[8]; float gv[8];
#pragma unroll
    for (int k = 0; k < 8; ++k) { float ca = c[k], cb = c[k + 8], ea = ex[k], eb = ex[k + 8]; asm volatile("" : "+v"(ca), "+v"(cb), "+v"(ea), "+v"(eb));
        const unsigned code = as_u(hi ? cb : ca) & 255u; gv[k] = (hi ? eb : ea) * inv;
        const unsigned ia = *(const LAS unsigned char*)(TAB + r * 32 + (code >> 4)), ib = *(const LAS unsigned char*)(TAB + r * 32 + 16 + (code & 15));
        eid[k] = ia * 128u + ib; }
    GAS unsigned* ip = (GAS unsigned*)(A.ws + WS_IDX) + (size_t)(tok0 + r) * 128 + h * 16 + 8 * hi;
    GAS float* gp = (GAS float*)(A.ws + WS_GATE) + (size_t)(tok0 + r) * 128 + h * 16 + 8 * hi;
    *(GAS v4u*)ip = (v4u){eid[0], eid[1], eid[2], eid[3]}; *(GAS v4u*)(ip + 4) = (v4u){eid[4], eid[5], eid[6], eid[7]};
    *(GAS f32x4*)gp = (f32x4){gv[0], gv[1], gv[2], gv[3]}; *(GAS f32x4*)(gp + 4) = (f32x4){gv[4], gv[5], gv[6], gv[7]};
    LDS_WAIT();
}
__device__ __forceinline__ void topk_phase(const Frame& F, const Args& A) {
    LAS unsigned char* SK = F.lds;
    LAS unsigned char* TABS = F.lds + 256 * SA128;
    for (int unit = blockIdx.x; unit < 256; unit += F.G) {
        int tid = F.tid, w = F.wave;
        asm volatile("" : "+v"(tid)); asm volatile("" : "+s"(w));
        const int h = unit & 7, tb = (unit >> 3) * 512;
        const GAS bf16* sk = (const GAS bf16*)(A.ws + WS_SUBK) + (size_t)h * 2 * 128 * 128;
        for (int e = tid; e < 256 * 16; e += 512) { const int row = e >> 4, ch = e & 15; *(LAS v4u*)(SK + row * SA128 + ch * 16) = *(const GAS v4u*)(sk + row * 128 + ch * 8); }
        __syncthreads();
#pragma unroll 1
        for (int tt = 0; tt < 2; ++tt) topk_wave_job(A, SK, TABS + w * 1024, tb + (w * 2 + tt) * 32, h, tid & 63);
        __syncthreads();
    }
}

__device__ __forceinline__ float gelu_f(float v) {
    const float av = fabsf(v), t = __builtin_amdgcn_rcpf(av * 0.2316418882f + 1.0f);
    float q = t * 0.5307027145f + (-0.7265760135f); q = q * t + 0.7107068705f; q = q * t + (-0.142248368f); q = q * t + 0.127414796f; q = q * t;
    const float m = v * (q * __builtin_amdgcn_exp2f((v * v) * (-0.72134752044f)));
    return v < 0.f ? m : v - m;
}
__device__ __forceinline__ void unpack8(const v4u x, float (&f)[8]) {
    f[0] = as_f(x.x << 16); f[1] = as_f(x.x & 0xffff0000u); f[2] = as_f(x.y << 16); f[3] = as_f(x.y & 0xffff0000u);
    f[4] = as_f(x.z << 16); f[5] = as_f(x.z & 0xffff0000u); f[6] = as_f(x.w << 16); f[7] = as_f(x.w & 0xffff0000u);
}
typedef long lx2 __attribute__((ext_vector_type(2)));
typedef float f32x2 __attribute__((ext_vector_type(2)));
typedef int i32x8 __attribute__((ext_vector_type(8)));
typedef int i32x4 __attribute__((ext_vector_type(4)));
constexpr float U4_SCALE = 64.f, V4_SCALE = 5.657f;
constexpr int MX_ONE = 0x7F7F7F7F;
template <int BY> __device__ __forceinline__ f32x2 cvt_fp4x2(unsigned w) { return __builtin_amdgcn_cvt_scalef32_pk_f32_fp4(w, 1.0f, BY); }
typedef _Float16 h16x2 __attribute__((ext_vector_type(2)));
template <int BY> __device__ __forceinline__ h16x2 cvt_fp4x2h(unsigned w) { return __builtin_amdgcn_cvt_scalef32_pk_f16_fp4(w, 1.0f, BY); }
template <int WS> __device__ __forceinline__ f32x2 cvt_fp8x2(int w) { return __builtin_amdgcn_cvt_pk_f32_fp8(w, WS != 0); }
__device__ __forceinline__ unsigned pk4_fp8(float a, float b, float c, float d) { int p = __builtin_amdgcn_cvt_pk_fp8_f32(a, b, 0, false); p = __builtin_amdgcn_cvt_pk_fp8_f32(c, d, p, true); return (unsigned)p; }
#ifndef DRYMASK
#define DRYMASK 0xFFFFFFFFu
#endif
constexpr size_t WS_HID = 248 * MiB;
constexpr size_t WS_N2G = 96 * MiB;
constexpr size_t WS_SIDX = 80 * MiB, WS_SGATE = 88 * MiB;
template <bool DRY> __device__ __forceinline__ void expert_u_phase(const Frame& F, const Args& A) {
    int tid = F.tid, w = F.wave;
    asm volatile("" : "+v"(tid)); asm volatile("" : "+s"(w));
    const int lane = tid & 63, r = lane & 15, kg = lane >> 4, half = lane >> 5, sub = lane & 31;
    const int dl = 32 * sub + 16 * half;
    LAS unsigned char* IMG0 = F.lds + w * 19456;
    LAS unsigned char* IMG1 = IMG0 + 8192;
    LAS unsigned char* N2B = IMG0 + 16384;
    LAS unsigned short* IDL = (LAS unsigned short*)(IMG0 + 17408);
    const GAS unsigned char* u4 = (const GAS unsigned char*)(A.ws + WS_UB);
    const GAS unsigned* idx = (const GAS unsigned*)(A.ws + WS_IDX); const GAS float* gate = (const GAS float*)(A.ws + WS_GATE);
    GAS unsigned* sidx = (GAS unsigned*)(A.ws + WS_SIDX); GAS float* sgate = (GAS float*)(A.ws + WS_SGATE);
    const GAS float* rowsq = (const GAS float*)(A.ws + WS_ROWSQ2); GAS float* hidp = (GAS float*)(A.ws + (DRY ? WS_Q + 32 * MiB : WS_HID));
    const GAS bf16* hbase = (const GAS bf16*)(A.ws + WS_HB) + dl;
    {
        int t = F.gw;
        v4u nhA = *(const GAS v4u*)(hbase + (size_t)t * D), nhB = *(const GAS v4u*)(hbase + (size_t)t * D + 8);
        unsigned ni0 = idx[(size_t)t * 128 + lane], ni1 = idx[(size_t)t * 128 + 64 + lane];
        float ng0 = gate[(size_t)t * 128 + lane], ng1 = gate[(size_t)t * 128 + 64 + lane], nrq = rowsq[t];
#pragma unroll 1
        for (int tt = 0; tt < 8; ++tt, t += F.NGW) {
            const v4u hA = nhA, hB = nhB; const unsigned i0 = DRY ? (ni0 & DRYMASK) : ni0, i1 = DRY ? (ni1 & DRYMASK) : ni1; const float g0 = ng0, g1 = ng1, rq = nrq;
            {   const int tn = (tt < 7) ? t + F.NGW : t;
                nhA = *(const GAS v4u*)(hbase + (size_t)tn * D); nhB = *(const GAS v4u*)(hbase + (size_t)tn * D + 8);
                ni0 = idx[(size_t)tn * 128 + lane]; ni1 = idx[(size_t)tn * 128 + 64 + lane];
                ng0 = gate[(size_t)tn * 128 + lane]; ng1 = gate[(size_t)tn * 128 + 64 + lane]; nrq = rowsq[tn]; }
            {   float f0[8], f1[8]; unpack8f(hA, f0); unpack8f(hB, f1);
                const float rr = rsqrtf(rq * (1.f / 1024.f) + EPS);
                v4u pk;
                pk.x = pk4_fp8(f0[0] * rr, f0[1] * rr, f0[2] * rr, f0[3] * rr); pk.y = pk4_fp8(f0[4] * rr, f0[5] * rr, f0[6] * rr, f0[7] * rr);
                pk.z = pk4_fp8(f1[0] * rr, f1[1] * rr, f1[2] * rr, f1[3] * rr); pk.w = pk4_fp8(f1[4] * rr, f1[5] * rr, f1[6] * rr, f1[7] * rr);
                *(GAS v4u*)((GAS unsigned char*)(A.ws + WS_N2G) + (size_t)t * 1024 + dl) = pk; }
            const unsigned b0 = i0 >> 11, b1 = i1 >> 11;
            unsigned pos0 = 0, pos1 = 0, base = 0;
#pragma unroll
            for (unsigned k = 0; k < 8; ++k) {
                const unsigned long long m0 = __ballot(b0 == k), m1 = __ballot(b1 == k);
                const unsigned c0 = (unsigned)__popcll(m0), c1 = (unsigned)__popcll(m1);
                const unsigned r0 = __builtin_amdgcn_mbcnt_hi((unsigned)(m0 >> 32), __builtin_amdgcn_mbcnt_lo((unsigned)m0, 0u));
                const unsigned r1 = __builtin_amdgcn_mbcnt_hi((unsigned)(m1 >> 32), __builtin_amdgcn_mbcnt_lo((unsigned)m1, 0u));
                pos0 = (b0 == k) ? base + r0 : pos0; pos1 = (b1 == k) ? base + c0 + r1 : pos1;
                base += c0 + c1;
            }
            IDL[tt * 128 + (pos0 & ~15u) + 8 * (pos0 & 1) + ((pos0 >> 1) & 7)] = (unsigned short)i0;
            IDL[tt * 128 + (pos1 & ~15u) + 8 * (pos1 & 1) + ((pos1 >> 1) & 7)] = (unsigned short)i1;
            sidx[(size_t)t * 128 + pos0] = i0; sidx[(size_t)t * 128 + pos1] = i1;
            sgate[(size_t)t * 128 + pos0] = g0; sgate[(size_t)t * 128 + pos1] = g1;
        }
    }
    asm volatile("s_waitcnt vmcnt(0)" ::: "memory");
    const GAS unsigned char* n2g = (const GAS unsigned char*)(A.ws + WS_N2G);
    const unsigned lane16 = 16u * lane;
#define PU_DMA_ROWS(PP, E, IMGE) { const int q_ = (PP) >> 3, tt_ = (PP) & 7, g_ = 2 * q_ + (E); \
        const v4u iq_ = *(const LAS v4u*)(IDL + tt_ * 128 + 16 * g_ + 8 * half); const unsigned iw_[4] = {iq_.x, iq_.y, iq_.z, iq_.w}; \
        _Pragma("unroll") for (int j = 0; j < 8; ++j) { const unsigned id_ = (j & 1) ? (iw_[j >> 1] >> 16) : (iw_[j >> 1] & 0xffffu); \
            __builtin_amdgcn_global_load_lds((const GAS unsigned*)(u4 + (size_t)(id_ * 512u + 16u * ((unsigned)sub ^ (unsigned)(2 * j + half)))), (LAS unsigned*)((IMGE) + j * 1024), 16, 0, 0); } }
#define PU_DMA_N2(PP) { const int tt_ = (PP) & 7; \
        __builtin_amdgcn_global_load_lds((const GAS unsigned*)(n2g + (size_t)(F.gw + tt_ * F.NGW) * 1024 + lane16), (LAS unsigned*)N2B, 16, 0, 0); }
    PU_DMA_N2(0) PU_DMA_ROWS(0, 0, IMG0) PU_DMA_ROWS(0, 1, IMG1)
    __builtin_amdgcn_sched_barrier(0);
    float hprev = 0.f; int oprev = -1;
#pragma unroll 1
    for (int P = 0; P < 32; ++P) {
        const int q = P >> 3, tt = P & 7, Pn = (P < 31) ? P + 1 : P;
        const int obase = (F.gw + tt * F.NGW) * 128 + 32 * q;
        asm volatile("s_waitcnt vmcnt(8)" ::: "memory");
        __builtin_amdgcn_sched_barrier(0);
        if (oprev >= 0 && kg == 0) hidp[(size_t)oprev + r] = hprev;
        i32x8 af[8];
        {   const LAS unsigned char* n2p = N2B + 16 * kg; asm volatile("" : "+v"(n2p));
#pragma unroll
            for (int s2 = 0; s2 < 8; ++s2) { const i32x4 a0 = *(const LAS i32x4*)(n2p + 128 * s2), a1 = *(const LAS i32x4*)(n2p + 128 * s2 + 64);
                af[s2] = (i32x8){a0.x, a0.y, a0.z, a0.w, a1.x, a1.y, a1.z, a1.w}; } }
        LDS_WAIT();
        __builtin_amdgcn_sched_barrier(0);
        PU_DMA_N2(Pn)
        __builtin_amdgcn_sched_barrier(0);
        float h0;
        {   f32x4 accg = (f32x4){0.f, 0.f, 0.f, 0.f};
#pragma unroll
            for (int s2 = 0; s2 < 8; ++s2) {
                const i32x4 b4 = *(const LAS i32x4*)(IMG0 + r * 512 + 16 * ((4 * s2 + kg) ^ r));
                const i32x8 b = (i32x8){b4.x, b4.y, b4.z, b4.w, 0, 0, 0, 0};
                accg = __builtin_amdgcn_mfma_scale_f32_16x16x128_f8f6f4(af[s2], b, accg, 0, 4, 0, MX_ONE, 0, MX_ONE);
            }
            LDS_WAIT();
            float a0_ = accg[0]; asm volatile("" : "+v"(a0_));
            h0 = gelu_f(a0_ * (1.f / U4_SCALE)) * (1.f / V4_SCALE);
            __builtin_amdgcn_sched_barrier(0);
            PU_DMA_ROWS(Pn, 0, IMG0)
            __builtin_amdgcn_sched_barrier(0);
        }
        asm volatile("s_waitcnt vmcnt(8)" ::: "memory");
        __builtin_amdgcn_sched_barrier(0);
        if (kg == 0) hidp[(size_t)obase + r] = h0;
        {   f32x4 accg = (f32x4){0.f, 0.f, 0.f, 0.f};
#pragma unroll
            for (int s2 = 0; s2 < 8; ++s2) {
                const i32x4 b4 = *(const LAS i32x4*)(IMG1 + r * 512 + 16 * ((4 * s2 + kg) ^ r));
                const i32x8 b = (i32x8){b4.x, b4.y, b4.z, b4.w, 0, 0, 0, 0};
                accg = __builtin_amdgcn_mfma_scale_f32_16x16x128_f8f6f4(af[s2], b, accg, 0, 4, 0, MX_ONE, 0, MX_ONE);
            }
            LDS_WAIT();
            float a0_ = accg[0]; asm volatile("" : "+v"(a0_));
            hprev = gelu_f(a0_ * (1.f / U4_SCALE)) * (1.f / V4_SCALE); oprev = obase + 16;
            __builtin_amdgcn_sched_barrier(0);
            PU_DMA_ROWS(Pn, 1, IMG1)
            __builtin_amdgcn_sched_barrier(0);
        }
    }
    if (kg == 0) hidp[(size_t)oprev + r] = hprev;
#undef PU_DMA_ROWS
#undef PU_DMA_N2
    asm volatile("s_waitcnt vmcnt(0)" ::: "memory");
}
template <bool DRY> __device__ __forceinline__ void expert_v_phase(const Frame& F, const Args& A) {
    int tid = F.tid, w = F.wave;
    asm volatile("" : "+v"(tid)); asm volatile("" : "+s"(w));
    const int lane = tid & 63, half = lane >> 5, sub = lane & 31;
    const int dl = 32 * sub + 16 * half;
    const GAS unsigned char* v4 = (const GAS unsigned char*)(A.ws + WS_VB);
    const GAS unsigned* idx = (const GAS unsigned*)(A.ws + WS_SIDX); const GAS float* hidp = (const GAS float*)(A.ws + WS_HID); const GAS float* sgate = (const GAS float*)(A.ws + WS_SGATE);
    const GAS bf16* hbase = (const GAS bf16*)(A.ws + WS_HB) + dl;
    LAS float* NW = (LAS float*)F.lds;
    LAS unsigned* TL = (LAS unsigned*)(F.lds + 4096 + w * 8192);
    const int p0 = (lane & ~15) | ((lane & 1) << 3) | ((lane >> 1) & 7);
    const LAS unsigned* TLr = TL + 8 * half;
    const unsigned lanebase = 16u * sub;
    NW[tid] = A.in[18][tid]; NW[tid + 512] = A.in[18][tid + 512];
    __syncthreads();
    {
        int t = F.gw;
        unsigned ni0 = idx[(size_t)t * 128 + lane], ni1 = idx[(size_t)t * 128 + 64 + lane];
        float nh0 = hidp[(size_t)t * 128 + lane] * sgate[(size_t)t * 128 + lane], nh1 = hidp[(size_t)t * 128 + 64 + lane] * sgate[(size_t)t * 128 + 64 + lane];
#pragma unroll 1
        for (int tt = 0; tt < 8; ++tt, t += F.NGW) {
            const unsigned i0 = DRY ? (ni0 & DRYMASK) : ni0, i1 = DRY ? (ni1 & DRYMASK) : ni1;
            const h16x2 a = (h16x2){(_Float16)nh0, (_Float16)nh0}, b = (h16x2){(_Float16)nh1, (_Float16)nh1};
            {   const int tn = (tt < 7) ? t + F.NGW : t;
                ni0 = idx[(size_t)tn * 128 + lane]; ni1 = idx[(size_t)tn * 128 + 64 + lane];
                nh0 = hidp[(size_t)tn * 128 + lane] * sgate[(size_t)tn * 128 + lane]; nh1 = hidp[(size_t)tn * 128 + 64 + lane] * sgate[(size_t)tn * 128 + 64 + lane]; }
            LAS unsigned* tl = TL + tt * 256;
            tl[p0] = i0 * 512u; tl[64 + p0] = i1 * 512u; tl[128 + p0] = __builtin_bit_cast(unsigned, a); tl[192 + p0] = __builtin_bit_cast(unsigned, b);
        }
    }
    h16x2 acc[8][16];
#pragma unroll
    for (int tt = 0; tt < 8; ++tt)
#pragma unroll
        for (int i = 0; i < 16; ++i) acc[tt][i] = (h16x2){(_Float16)0.f, (_Float16)0.f};
    v4u xr[8];
#define PV_IDS(PTR, V) { const v4u q0_ = *(const LAS v4u*)(PTR), q1_ = *(const LAS v4u*)((PTR) + 4); \
            V[0] = q0_.x; V[1] = q0_.y; V[2] = q0_.z; V[3] = q0_.w; V[4] = q1_.x; V[5] = q1_.y; V[6] = q1_.z; V[7] = q1_.w; }
#define PV_LOAD1(OFF, PR) xr[PR] = *(const GAS v4u*)(v4 + (size_t)((OFF) + lanebase));
    {   unsigned ia[8]; PV_IDS(TLr, ia)
#pragma unroll
        for (int pr = 0; pr < 8; ++pr) PV_LOAD1(ia[pr], pr) }
    __builtin_amdgcn_sched_barrier(0);
#pragma unroll 1
    for (int q = 0; q < 4; ++q) {
        const int qn = (q < 3) ? q + 1 : q;
#pragma unroll
        for (int tt = 0; tt < 8; ++tt) {
#pragma unroll
            for (int e = 0; e < 2; ++e) {
                unsigned idn[8], sc[8];
                {   const LAS unsigned* nx = (e == 0) ? TLr + tt * 256 + 16 * (2 * q + 1) : (tt < 7) ? TLr + (tt + 1) * 256 + 16 * (2 * q) : TLr + 16 * (2 * qn);
                    PV_IDS(nx, idn)
                    const LAS unsigned* cs = TLr + tt * 256 + 128 + 16 * (2 * q + e);
                    PV_IDS(cs, sc) }
                __builtin_amdgcn_sched_barrier(0);
#pragma unroll
                for (int pr = 0; pr < 8; ++pr) {
                    const h16x2 sh2 = __builtin_bit_cast(h16x2, sc[pr]);
                    const unsigned xw[4] = {xr[pr].x, xr[pr].y, xr[pr].z, xr[pr].w};
#pragma unroll
                    for (int k = 0; k < 4; ++k) {
                        acc[tt][4 * k] = __builtin_elementwise_fma(cvt_fp4x2h<0>(xw[k]), sh2, acc[tt][4 * k]); acc[tt][4 * k + 1] = __builtin_elementwise_fma(cvt_fp4x2h<1>(xw[k]), sh2, acc[tt][4 * k + 1]);
                        acc[tt][4 * k + 2] = __builtin_elementwise_fma(cvt_fp4x2h<2>(xw[k]), sh2, acc[tt][4 * k + 2]); acc[tt][4 * k + 3] = __builtin_elementwise_fma(cvt_fp4x2h<3>(xw[k]), sh2, acc[tt][4 * k + 3]); }
                    PV_LOAD1(idn[pr], pr)
                    __builtin_amdgcn_sched_barrier(0);
                }
            }
        }
    }
#undef PV_LOAD1
#undef PV_IDS
#pragma unroll
    for (int tt = 0; tt < 8; ++tt) {
        const int t = F.gw + tt * F.NGW;
        const v4u hA = *(const GAS v4u*)(hbase + (size_t)t * D), hB = *(const GAS v4u*)(hbase + (size_t)t * D + 8);
        float o[16]; f32x2 o2[16];
#pragma unroll
        for (int i = 0; i < 16; ++i) { const unsigned mine = __builtin_bit_cast(unsigned, acc[tt][i]), oth = (unsigned)__shfl_xor((int)mine, 32); const h16x2 oo = __builtin_bit_cast(h16x2, oth);
            o2[i].x = (float)acc[tt][i].x + (float)oo.x; o2[i].y = (float)acc[tt][i].y + (float)oo.y; }
#pragma unroll
        for (int i = 0; i < 8; ++i) { float a0 = o2[i].x, a1 = o2[i].y, b0 = o2[8 + i].x, b1 = o2[8 + i].y; asm volatile("" : "+v"(a0), "+v"(a1), "+v"(b0), "+v"(b1));
            o[2 * i] = half ? b0 : a0; o[2 * i + 1] = half ? b1 : a1; }
        float ss = 0.f; f32x4 h2[4];
        {   float f0[8], f1[8]; unpack8f(hA, f0); unpack8f(hB, f1);
            h2[0] = (f32x4){f0[0] + o[0], f0[1] + o[1], f0[2] + o[2], f0[3] + o[3]}; h2[1] = (f32x4){f0[4] + o[4], f0[5] + o[5], f0[6] + o[6], f0[7] + o[7]};
            h2[2] = (f32x4){f1[0] + o[8], f1[1] + o[9], f1[2] + o[10], f1[3] + o[11]}; h2[3] = (f32x4){f1[4] + o[12], f1[5] + o[13], f1[6] + o[14], f1[7] + o[15]}; }
#pragma unroll
        for (int q = 0; q < 4; ++q) { const f32x4 x = h2[q]; ss += (x.x * x.x + x.y * x.y) + (x.z * x.z + x.w * x.w); }
        ss = wave_sum(ss);
        const float r3 = rsqrtf(ss * (1.f / D) + EPS);
        GAS float* yrow = (DRY ? (GAS float*)(A.ws + WS_Q) : (GAS float*)A.out) + (size_t)t * D + dl;
#pragma unroll
        for (int q = 0; q < 4; ++q) *(GAS f32x4*)(yrow + 4 * q) = h2[q] * r3 * *(const LAS f32x4*)(NW + dl + 4 * q);
    }
}
__device__ __forceinline__ void p0_transpose_item(const float* W, const float* kscale, int K, int N, bf16* WT, LAS float* scr, int item, int lane) {
    const int nblk = (N + 31) / 32, kb = item / nblk, nb = item % nblk, k0 = 64 * kb, n0 = 32 * nb;
    const int nn = n0 + (lane & 31); const bool ok = nn < N;
    (void)nn; (void)ok;
    {   const int c4 = lane & 7, kr = lane >> 3; const bool okc = n0 + 4 * c4 < N;
        f32x4 v[8];
#pragma unroll
        for (int i = 0; i < 8; ++i) v[i] = okc ? *(const GAS f32x4*)(W + (size_t)(k0 + 8 * i + kr) * N + n0 + 4 * c4) : (f32x4){0.f, 0.f, 0.f, 0.f};
#pragma unroll
        for (int i = 0; i < 8; ++i) { const int kk = 8 * i + kr; const float sc = kscale ? kscale[k0 + kk] : 1.f; LAS float* d = scr + kk * 33 + 4 * c4;
            d[0] = v[i].x * sc; d[1] = v[i].y * sc; d[2] = v[i].z * sc; d[3] = v[i].w * sc; } }
    LDS_WAIT(); asm volatile("" ::: "memory");
    const int c = lane & 7;
#pragma unroll
    for (int j = 0; j < 4; ++j) { const int n = (lane >> 3) + 8 * j; const LAS float* s = scr + (8 * c) * 33 + n;
        v4u o; o.x = pk2(s[0 * 33], s[1 * 33]); o.y = pk2(s[2 * 33], s[3 * 33]); o.z = pk2(s[4 * 33], s[5 * 33]); o.w = pk2(s[6 * 33], s[7 * 33]);
        *(GAS v4u*)(WT + (size_t)(n0 + n) * K + k0 + 8 * c) = o; }
    LDS_WAIT(); asm volatile("" ::: "memory");
}
__device__ __forceinline__ void p0_convert(const Frame& F, const float* src, bf16* dst, size_t n) {
    for (size_t i = ((size_t)F.gw * 64 + F.lane) * 8; i < n; i += (size_t)F.NGW * 512) {
        const f32x4 a = *(const GAS f32x4*)(src + i), b = *(const GAS f32x4*)(src + i + 4);
        v4u o; o.x = pk2(a.x, a.y); o.y = pk2(a.z, a.w); o.z = pk2(b.x, b.y); o.w = pk2(b.z, b.w);
        *(GAS v4u*)(dst + i) = o;
    }
}
__device__ __forceinline__ void p0_convert_fp4(const Frame& F, int wk, int nwk, const float* src, unsigned char* dst, size_t n, float scale, const float* colscale) {
    for (size_t base = (size_t)wk * 2048; base < n; base += (size_t)nwk * 2048) {
        f32x4 a[4], b[4];
#pragma unroll
        for (int q = 0; q < 4; ++q) { const size_t i = base + q * 512 + F.lane * 8; a[q] = *(const GAS f32x4*)(src + i); b[q] = *(const GAS f32x4*)(src + i + 4); }
#pragma unroll
        for (int q = 0; q < 4; ++q) {
            const size_t i = base + q * 512 + F.lane * 8;
            f32x4 x = a[q] * scale, y = b[q] * scale;
            if (colscale) { x = x * *(const GAS f32x4*)(colscale + (i & 1023)); y = y * *(const GAS f32x4*)(colscale + ((i + 4) & 1023)); }
            unsigned pk = 0;
            pk = __builtin_amdgcn_cvt_scalef32_pk_fp4_f32(pk, x.x, x.y, 1.0f, 0); pk = __builtin_amdgcn_cvt_scalef32_pk_fp4_f32(pk, x.z, x.w, 1.0f, 1);
            pk = __builtin_amdgcn_cvt_scalef32_pk_fp4_f32(pk, y.x, y.y, 1.0f, 2); pk = __builtin_amdgcn_cvt_scalef32_pk_fp4_f32(pk, y.z, y.w, 1.0f, 3);
            *(GAS unsigned*)(dst + (i >> 1)) = pk;
        }
    }
}
__device__ __forceinline__ void p0_prologue(const Frame& F, const Args& A) {
    unsigned char* ws = A.ws;
    LAS float* scr = (LAS float*)(F.lds + RING_OFF + F.wave * 16384);
    constexpr int I_IN = (D / 64) * ((NIN + 31) / 32), I_O = (D / 64) * (D / 32), I_Q = (D / 64) * (NQ / 32);
    for (int it = F.gw; it < I_IN + I_O + I_Q; it += F.NGW) {
        int r = it;
        if (r < I_IN) { p0_transpose_item(A.in[2], A.in[1], D, NIN, (bf16*)(ws + WS_WIN), scr, r, F.lane); continue; } r -= I_IN;
        if (r < I_O) { p0_transpose_item(A.in[12], nullptr, D, D, (bf16*)(ws + WS_WO), scr, r, F.lane); continue; } r -= I_O;
        p0_transpose_item(A.in[14], A.in[13], D, NQ, (bf16*)(ws + WS_WQ), scr, r, F.lane);
    }
    for (int m0 = F.gw * 4; m0 < T; m0 += F.NGW * 4) {
        f32x4 v[4][4]; float s[4] = {0.f, 0.f, 0.f, 0.f};
#pragma unroll
        for (int u = 0; u < 4; ++u) { const GAS f32x4* xr = (const GAS f32x4*)(A.in[0] + (size_t)(m0 + u) * D) + F.lane;
#pragma unroll
            for (int j = 0; j < 4; ++j) v[u][j] = xr[64 * j]; }
#pragma unroll
        for (int u = 0; u < 4; ++u) {
#pragma unroll
            for (int j = 0; j < 4; ++j) s[u] += (v[u][j].x * v[u][j].x + v[u][j].y * v[u][j].y) + (v[u][j].z * v[u][j].z + v[u][j].w * v[u][j].w);
            GAS unsigned long long* o8 = (GAS unsigned long long*)((bf16*)(ws + WS_XB) + (size_t)(m0 + u) * D) + F.lane;
#pragma unroll
            for (int j = 0; j < 4; ++j) o8[64 * j] = (unsigned long long)pk2(v[u][j].x, v[u][j].y) | ((unsigned long long)pk2(v[u][j].z, v[u][j].w) << 32); }
#pragma unroll
        for (int u = 0; u < 4; ++u) s[u] = wave_sum(s[u]);
        if (F.lane < 4) { const float sv = F.lane == 0 ? s[0] : (F.lane == 1 ? s[1] : (F.lane == 2 ? s[2] : s[3])); ((float*)(ws + WS_RRMS1))[m0 + F.lane] = rsqrtf(sv * (1.f / D) + EPS); ((float*)(ws + WS_ROWSQ2))[m0 + F.lane] = 0.f; }
    }
    p0_convert(F, A.in[15], (bf16*)(ws + WS_SUBK), (size_t)8 * 2 * 128 * 128);
    p0_convert_fp4(F, F.gw, F.NGW, A.in[16], ws + WS_UB, (size_t)16384 * 1024, U4_SCALE, A.in[13]);
    p0_convert_fp4(F, F.gw, F.NGW, A.in[17], ws + WS_VB, (size_t)16384 * 1024, V4_SCALE, nullptr);
}


#ifdef BENCH_KIND
__device__ __forceinline__ void bench_phase(const Frame& F, const Args& A) {
    unsigned r[16]; unsigned w = F.tid * 2654435761u, z = F.tid; unsigned sz = __builtin_amdgcn_readfirstlane(F.tid * 77u + 12345u);
#pragma unroll
    for (int i = 0; i < 16; ++i) r[i] = w + i;
#pragma unroll 1
    for (int it = 0; it < BENCH_ITERS; ++it) {
#pragma unroll
        for (int i = 0; i < 16; ++i) {
#if BENCH_KIND == 1
            asm volatile("v_cvt_scalef32_pk_f16_fp4 %0, %1, 1.0" : "=v"(r[i]) : "v"(w));
#elif BENCH_KIND == 2
            asm volatile("v_pk_fma_f16 %0, %1, %2, %0" : "+v"(r[i]) : "v"(w), "v"(z));
#elif BENCH_KIND == 3
            asm volatile("v_and_or_b32 %0, %1, %2, %0" : "+v"(r[i]) : "v"(w), "v"(z));
#elif BENCH_KIND == 6
            asm volatile("v_fma_f32 %0, %1, %2, %0" : "+v"(r[i]) : "v"(w), "v"(z));
#elif BENCH_KIND == 8
            asm volatile("v_pk_fma_f16 %0, %1, %2, %0" : "+v"(r[i]) : "v"(w), "s"(sz));
#elif BENCH_KIND == 9
            asm volatile("v_pk_fma_f16 %0, %1, %1, %0" : "+v"(r[i]) : "v"(w));
#elif BENCH_KIND == 7
            asm volatile("v_perm_b32 %0, %1, %2, %0" : "+v"(r[i]) : "v"(w), "v"(z));
#endif
        }
    }
    unsigned acc = 0;
#pragma unroll
    for (int i = 0; i < 16; ++i) acc ^= r[i];
    if (acc == 0x12345679u) *(GAS unsigned*)(A.ws + WS_Q + F.tid * 4) = acc;
}
#endif
#ifndef PROBE_MASK
#define PROBE_MASK 0
#endif
__device__ __forceinline__ int probe_reps(int k) { int n = ((PROBE_MASK >> k) & 1) + 1; return n; }
__global__ void __launch_bounds__(NWAVES * 64, 2) fwd(Args args) {
    extern __shared__ __attribute__((aligned(16))) unsigned char lds[];
    Frame F;
    F.lds = (LAS unsigned char*)lds;
    F.MISC = (volatile LAS unsigned*)(F.lds + MISC_OFF);
    F.tid = threadIdx.x; F.lane = F.tid & 63; F.wave = __builtin_amdgcn_readfirstlane(F.tid >> 6);
    F.G = gridDim.x; F.gw = blockIdx.x * NWAVES + F.wave; F.NGW = F.G * NWAVES;
    unsigned char* ws = args.ws;
    F.ctl = (gu32*)(ws + WS_CTL);
    for (int u = F.tid; u < (LDS_BYTES - LDSCTL_OFF) / 4; u += NWAVES * 64) ((LAS unsigned*)(F.lds + LDSCTL_OFF))[u] = 0u;
    __syncthreads();
    XcdBarrier bar = xcd_barrier_post((unsigned*)(F.ctl + CW_BAR), F.MISC + 8);
    const int lo = args.ph_lo, hi = args.ph_hi;
#define IN(k) (lo <= (k) && (k) < hi)
#define BOTH(k) (IN(k) && IN((k) + 1))
#define GRID_BAR() xcd_barrier(bar)
#define REP(k) for (int rep_ = 0, nrep_ = probe_reps(k); rep_ < nrep_; ++rep_)

    if (IN(0)) REP(0) { p0_prologue(F, args); if (BOTH(0)) GRID_BAR(); }
    if (IN(1)) REP(1) {
        pg8::Gemm g{(const bf16*)(ws + WS_XB), (const bf16*)(ws + WS_WIN), T, NINP, D}; pg8::StaticOrder S; S.init(T, NINP, F.G, (int)blockIdx.x);
        pg8::EpiRowScaleBf16 E{(bf16*)(ws + WS_PROJ), NINP, (const float*)(ws + WS_RRMS1)};
        pg8::gemm_phase<pg8::EpiRowScaleBf16, pg8::StaticOrder, true, true>(F.lds + RING_OFF, g, S, E);
        if (BOTH(1)) GRID_BAR();
    }
    if (IN(2)) {
        REP(2) { for (int u = blockIdx.x; u < 256; u += F.G) ssd_unit<0>(F, args, u); }
        REP(13) { for (int u = blockIdx.x; u < 1024; u += F.G) gla_unit<0>(F, args, u); }
        if (BOTH(2)) GRID_BAR();
    }
    if (IN(3)) { if ((PROBE_MASK >> 3) & 1) { scan_phase<true>(F, args); GRID_BAR(); } scan_phase<false>(F, args); if (BOTH(3)) GRID_BAR(); }
    if (IN(4)) {
        REP(4) { for (int u = blockIdx.x; u < 256; u += F.G) ssd_unit<1>(F, args, u); }
        REP(12) { for (int u = blockIdx.x; u < 1024; u += F.G) gla_unit<1>(F, args, u); }
        if (BOTH(4)) GRID_BAR();
    }
    if (IN(5)) {
        pg8::Gemm g{(const bf16*)(ws + WS_MIX), (const bf16*)(ws + WS_WO), T, D, D}; pg8::StaticOrder S; S.init(T, D, F.G, (int)blockIdx.x);
        if ((PROBE_MASK >> 5) & 1) { pg8::EpiResidual Ed{(const bf16*)(ws + WS_XB), (bf16*)(ws + 208 * MiB), (float*)(ws + 240 * MiB), D};
            pg8::gemm_phase<pg8::EpiResidual, pg8::StaticOrder, true, true>(F.lds + RING_OFF, g, S, Ed); GRID_BAR(); }
        pg8::EpiResidual E{(const bf16*)(ws + WS_XB), (bf16*)(ws + WS_HB), (float*)(ws + WS_ROWSQ2), D};
        pg8::gemm_phase<pg8::EpiResidual, pg8::StaticOrder, true, true>(F.lds + RING_OFF, g, S, E);
        if (BOTH(5)) GRID_BAR();
    }
    if (IN(6)) REP(6) {
        pg8::Gemm g{(const bf16*)(ws + WS_HB), (const bf16*)(ws + WS_WQ), T, NQ, D}; pg8::StaticOrder S; S.init(T, NQ, F.G, (int)blockIdx.x);
        pg8::EpiRsqScaleBf16 E{(bf16*)(ws + WS_Q), NQ, (const float*)(ws + WS_ROWSQ2)};
        pg8::gemm_phase<pg8::EpiRsqScaleBf16, pg8::StaticOrder, true, true>(F.lds + RING_OFF, g, S, E);
        if (BOTH(6)) GRID_BAR();
    }
    if (IN(7)) REP(7) { topk_phase(F, args); if (BOTH(7)) GRID_BAR(); }
    if (IN(8)) { if ((PROBE_MASK >> 8) & 1) { expert_u_phase<true>(F, args); GRID_BAR(); } expert_u_phase<false>(F, args);
        if (BOTH(8)) { asm volatile("s_waitcnt vmcnt(0)" ::: "memory"); __syncthreads(); } }
#ifdef BENCH_KIND
    if (IN(9)) { bench_phase(F, args); GRID_BAR(); }
#endif
    if (IN(9)) { if ((PROBE_MASK >> 9) & 1) { expert_v_phase<true>(F, args); GRID_BAR(); } expert_v_phase<false>(F, args); }
#undef IN
#undef BOTH
}
extern "C" void kernel_launch(void* const* d_in, const int* in_sizes, int n_in, void* d_out, int out_size, void* d_ws, size_t ws_size, hipStream_t stream) {
    static int grid = 0;
    if (grid == 0) {
        if (n_in != 19 || out_size != T * D || ws_size < 256 * MiB) { fprintf(stderr, "kernel_launch: unexpected shapes n_in %d out %d ws %zu\n", n_in, out_size, ws_size); grid = -1; return; }
        int dev = 0, cus = 0, per_cu = 0;
        if (hipGetDevice(&dev) != hipSuccess || hipDeviceGetAttribute(&cus, hipDeviceAttributeMultiprocessorCount, dev) != hipSuccess) { grid = -1; return; }
        if (hipFuncSetAttribute((const void*)fwd, hipFuncAttributeMaxDynamicSharedMemorySize, LDS_BYTES) != hipSuccess) { fprintf(stderr, "kernel_launch: hipFuncSetAttribute failed\n"); grid = -1; return; }
        if (hipOccupancyMaxActiveBlocksPerMultiprocessor(&per_cu, (const void*)fwd, NWAVES * 64, LDS_BYTES) != hipSuccess || per_cu < 1) { fprintf(stderr, "kernel_launch: occupancy query says %d\n", per_cu); }
        (void)hipGetLastError();
        grid = cus;
    }
    if (grid < 0) return;
    const float* x = (const float*)d_in[0];
    const float* gla_w2 = (const float*)d_in[3];
    const float* gla_bg = (const float*)d_in[4];
    const float* gla_nw = (const float*)d_in[5];
    const float* conv_w = (const float*)d_in[6];
    const float* conv_b = (const float*)d_in[7];
    const float* dt_bias = (const float*)d_in[8];
    const float* a_log = (const float*)d_in[9];
    const float* d_skip = (const float*)d_in[10];
    const float* ssd_nw = (const float*)d_in[11];
    const float* w_out = (const float*)d_in[12];
    const float* norm_ffn_w = (const float*)d_in[13];
    const float* w_query = (const float*)d_in[14];
    const float* sub_keys = (const float*)d_in[15];
    const float* pu = (const float*)d_in[16];
    const float* pv = (const float*)d_in[17];
    const float* norm_final_w = (const float*)d_in[18];
    float* out = (float*)d_out;
    char* ws = (char*)d_ws;

    (void)hipMemsetAsync(ws + WS_CTL, 0, CTL_ZERO_BYTES, stream);
    Args a{};
    for (int i = 0; i < 19; ++i) a.in[i] = (const float*)d_in[i];
    a.out = out; a.ws = (unsigned char*)d_ws; a.ph_lo = 0; a.ph_hi = 10;
    hipLaunchKernelGGL(fwd, dim3(grid), dim3(NWAVES * 64), LDS_BYTES, stream, a);

}
```
